# Optimizing an MI355X kernel written in HIP

```python
import jax
import jax.numpy as jnp
from jax import lax
import numpy as np

D_MODEL = 1024
BATCH = 8
SEQ = 8192
DEPTH = 2

GLA_HEADS = 4
GLA_DK = 64
GLA_DV = 128
GLA_GATE_RANK = 16
GLA_GATE_TEMP = 16.0
GLA_CHUNK = 64
NSA_HEADS = 8
NSA_KV_GROUPS = 2
NSA_HPG = NSA_HEADS // NSA_KV_GROUPS
NSA_DH = 64
NSA_CMP_BLOCK = 32
NSA_CMP_STRIDE = 16
NSA_CMP_HIDDEN = 128
NSA_SEL_BLOCK = 64
NSA_TOPN = 16
NSA_WINDOW = 512
NSA_QBLOCK = 128
NSA_BRANCHES = 3
SGU_WIDTH = 2 * D_MODEL
SGU_GROUPS = 8
SGU_CHUNK = 128
FFN_HIDDEN = 4 * D_MODEL
NORM_EPS = 1e-6
NEG_BIG = -1e30
POS_BIG = 1e30

EVEN_PROJ_SIZES = (GLA_HEADS * GLA_DK, GLA_HEADS * GLA_DK, GLA_HEADS * GLA_DV, GLA_GATE_RANK, GLA_HEADS * GLA_DV, NSA_HEADS * NSA_DH, NSA_KV_GROUPS * NSA_DH, NSA_KV_GROUPS * NSA_DH, NSA_KV_GROUPS * NSA_DH, NSA_KV_GROUPS * NSA_DH, NSA_KV_GROUPS * NSA_DH, NSA_KV_GROUPS * NSA_DH, NSA_HEADS * NSA_BRANCHES)
EVEN_PROJ_WIDTH = sum(EVEN_PROJ_SIZES)
EVEN_MIX_WIDTH = GLA_HEADS * GLA_DV + NSA_HEADS * NSA_DH

kernel_name = 'hybrid_gla_nsa_sgu_trunk'


def _rms_norm(x, g):
    xf = x.astype(jnp.float32)
    y = xf * lax.rsqrt(jnp.mean(xf * xf, axis=-1, keepdims=True) + NORM_EPS)
    return (y * g).astype(x.dtype)


def _masked_softmax(s, mask):
    m = mask.astype(jnp.float32)
    s = jnp.where(mask, s, NEG_BIG)
    p = jnp.exp(s - jnp.max(s, axis=-1, keepdims=True)) * m
    return p / jnp.maximum(jnp.sum(p, axis=-1, keepdims=True), 1e-30)


def _squared_relu_mlp(x, w1, w2):
    h = jax.nn.relu(x @ w1)
    return (h * h) @ w2


def _gla(q, k, v, g_lr, r, w_gate, b_gate, norm_g):
    f32 = jnp.float32
    bsz, seq, _ = q.shape
    c = GLA_CHUNK
    nc = seq // c
    glog = jax.nn.log_sigmoid((g_lr @ w_gate + b_gate).astype(f32)) / GLA_GATE_TEMP

    def chunks(t, d):
        return t.astype(f32).reshape(bsz, nc, c, GLA_HEADS, d).transpose(0, 3, 1, 2, 4)

    qc = chunks(q, GLA_DK) * (GLA_DK ** -0.5)
    kc = chunks(k, GLA_DK)
    vc = chunks(v, GLA_DV)
    b = jnp.cumsum(chunks(glog, GLA_DK), axis=3)
    b_last = b[:, :, :, -1:, :]
    q_t = qc * jnp.exp(b)
    k_t = kc * jnp.exp(-b)
    k_end = kc * jnp.exp(b_last - b)
    causal = jnp.tril(jnp.ones((c, c), dtype=bool))
    a = jnp.where(causal, jnp.einsum('bhnid,bhnjd->bhnij', q_t, k_t), 0.0)
    o_intra = jnp.einsum('bhnij,bhnjv->bhniv', a, vc)
    ds = jnp.einsum('bhnjd,bhnjv->bhndv', k_end, vc)
    decay = jnp.exp(b_last[:, :, :, 0, :])

    def step(state, inp):
        dec, d = inp
        return dec[..., None] * state + d, state

    s0 = jnp.zeros((bsz, GLA_HEADS, GLA_DK, GLA_DV), f32)
    _, s_prev = lax.scan(step, s0, (jnp.moveaxis(decay, 2, 0), jnp.moveaxis(ds, 2, 0)))
    s_prev = jnp.moveaxis(s_prev, 0, 2)
    o = o_intra + jnp.einsum('bhnid,bhndv->bhniv', q_t, s_prev)
    o = o.transpose(0, 2, 3, 1, 4).reshape(bsz, seq, GLA_HEADS, GLA_DV)
    o = o * lax.rsqrt(jnp.mean(o * o, axis=-1, keepdims=True) + NORM_EPS) * norm_g
    o = o.reshape(bsz, seq, GLA_HEADS * GLA_DV) * jax.nn.silu(r.astype(f32))
    return o.astype(q.dtype)


def _nsa(q, kc, vc, ks, vs, kw, vw, gate_logits, cmp_pos, cmp_w1, cmp_w2):
    f32 = jnp.float32
    bsz, seq, _ = q.shape
    g_n, hpg, dh, qb_len, w = NSA_KV_GROUPS, NSA_HPG, NSA_DH, NSA_QBLOCK, NSA_WINDOW
    n_qb = seq // qb_len
    n_cmp = (seq - NSA_CMP_BLOCK) // NSA_CMP_STRIDE + 1
    n_sel = seq // NSA_SEL_BLOCK
    topn = min(NSA_TOPN, n_sel)
    scale = dh ** -0.5

    def kv_heads(t):
        return t.reshape(bsz, seq, g_n, dh)

    cmp_idx = jnp.arange(n_cmp)[:, None] * NSA_CMP_STRIDE + jnp.arange(NSA_CMP_BLOCK)[None, :]

    def compress(t, i):
        blocks = kv_heads(t)[:, cmp_idx] + cmp_pos[i][None, None, :, None, :]
        blocks = blocks.transpose(0, 3, 1, 2, 4).reshape(bsz, g_n, n_cmp, NSA_CMP_BLOCK * dh)
        return jax.nn.gelu(blocks @ cmp_w1[i]) @ cmp_w2[i]

    k_cmp = compress(kc, 0)
    v_cmp = compress(vc, 1)
    cmp_start = jnp.arange(n_cmp) * NSA_CMP_STRIDE
    cmp_end = cmp_start + NSA_CMP_BLOCK - 1
    sel_start = jnp.arange(n_sel) * NSA_SEL_BLOCK
    overlap = ((cmp_start[:, None] < sel_start[None, :] + NSA_SEL_BLOCK)
               & (cmp_start[:, None] + NSA_CMP_BLOCK > sel_start[None, :])).astype(f32)

    k_sel = kv_heads(ks).reshape(bsz, n_sel, NSA_SEL_BLOCK, g_n, dh).transpose(0, 3, 1, 2, 4)
    v_sel = kv_heads(vs).reshape(bsz, n_sel, NSA_SEL_BLOCK, g_n, dh).transpose(0, 3, 1, 2, 4)
    pad = ((0, 0), (0, 0), (w, 0), (0, 0))
    k_win = jnp.pad(kv_heads(kw).transpose(0, 2, 1, 3), pad)
    v_win = jnp.pad(kv_heads(vw).transpose(0, 2, 1, 3), pad)

    qb = (q * scale).reshape(bsz, n_qb, qb_len, g_n, hpg, dh).transpose(1, 0, 3, 4, 2, 5)
    gb = jax.nn.sigmoid(gate_logits.astype(f32)).reshape(bsz, n_qb, qb_len, g_n, hpg, NSA_BRANCHES)
    gb = gb.transpose(1, 0, 3, 4, 2, 5)
    b_ix = jnp.arange(bsz)[:, None, None, None]
    g_ix = jnp.arange(g_n)[None, :, None, None]
    within = jnp.arange(NSA_SEL_BLOCK)
    win_off = jnp.arange(qb_len + w)
    sel_j = jnp.arange(n_sel)

    def block(args):
        n, qn, gn = args
        t = n * qb_len + jnp.arange(qb_len)
        s_c = jnp.einsum('bghqd,bgcd->bghqc', qn, k_cmp).astype(f32)
        p_c = _masked_softmax(s_c, cmp_end[None, :] <= t[:, None])
        o_c = jnp.einsum('bghqc,bgcd->bghqd', p_c.astype(v_cmp.dtype), v_cmp)
        imp = jnp.einsum('bgqc,cj->bgqj', jnp.sum(p_c, axis=2), overlap)
        cur = t // NSA_SEL_BLOCK
        forced = (sel_j[None, :] == 0) | (sel_j[None, :] == cur[:, None]) | (sel_j[None, :] == cur[:, None] - 1)
        allowed = sel_start[None, :] <= t[:, None]
        score = jnp.where(forced, POS_BIG, jnp.where(allowed, imp, NEG_BIG))
        top_val, top_idx = lax.top_k(score, topn)
        blk_ok = top_val > 0.5 * NEG_BIG
        k_g = k_sel[b_ix, g_ix, top_idx]
        v_g = v_sel[b_ix, g_ix, top_idx]
        kpos = top_idx[..., None] * NSA_SEL_BLOCK + within
        ok = blk_ok[..., None] & (kpos <= t[None, None, :, None, None])
        s_s = jnp.einsum('bghqd,bgqnkd->bghqnk', qn, k_g).astype(f32)
        s_s = s_s.reshape(bsz, g_n, hpg, qb_len, topn * NSA_SEL_BLOCK)
        p_s = _masked_softmax(s_s, ok.reshape(bsz, g_n, 1, qb_len, topn * NSA_SEL_BLOCK))
        p_s = p_s.reshape(bsz, g_n, hpg, qb_len, topn, NSA_SEL_BLOCK).astype(v_g.dtype)
        o_s = jnp.einsum('bghqnk,bgqnkd->bghqd', p_s, v_g)
        k_w = lax.dynamic_slice_in_dim(k_win, n * qb_len, qb_len + w, axis=2)
        v_w = lax.dynamic_slice_in_dim(v_win, n * qb_len, qb_len + w, axis=2)
        kpos_w = n * qb_len - w + win_off
        ok_w = (kpos_w[None, :] >= 0) & (kpos_w[None, :] <= t[:, None]) & (kpos_w[None, :] > t[:, None] - w)
        s_w = jnp.einsum('bghqd,bgkd->bghqk', qn, k_w).astype(f32)
        p_w = _masked_softmax(s_w, ok_w)
        o_w = jnp.einsum('bghqk,bgkd->bghqd', p_w.astype(v_w.dtype), v_w)
        out = gn[..., 0:1] * o_c + gn[..., 1:2] * o_s + gn[..., 2:3] * o_w
        return out.astype(q.dtype)

    o = lax.map(block, (jnp.arange(n_qb), qb, gb))
    return o.transpose(1, 0, 4, 2, 3, 5).reshape(bsz, seq, NSA_HEADS * dh)


def _even_mixer(x, w_in, w_out, gla_w_gate, gla_b_gate, gla_norm, nsa_gate_b, nsa_cmp_pos, nsa_cmp_w1, nsa_cmp_w2):
    offsets = [int(o) for o in np.cumsum(EVEN_PROJ_SIZES)[:-1]]
    gq, gk, gv, glr, gr, nq, kc, vc, ks, vs, kw, vw, ng = jnp.split(x @ w_in, offsets, axis=-1)
    o_a = _gla(gq, gk, gv, glr, gr, gla_w_gate, gla_b_gate, gla_norm)
    o_b = _nsa(nq, kc, vc, ks, vs, kw, vw, ng + nsa_gate_b, nsa_cmp_pos, nsa_cmp_w1, nsa_cmp_w2)
    return jnp.concatenate([o_a, o_b], axis=-1) @ w_out


def _sgu_mixer(x, w_in, ln_g, ln_b, w_s, b_s, w_out):
    bsz, seq, _ = x.shape
    h = jax.nn.gelu(x @ w_in)
    u, v = jnp.split(h, 2, axis=-1)
    vf = v.astype(jnp.float32)
    mu = jnp.mean(vf, axis=-1, keepdims=True)
    var = jnp.mean((vf - mu) ** 2, axis=-1, keepdims=True)
    v = ((vf - mu) * lax.rsqrt(var + NORM_EPS) * ln_g + ln_b).astype(x.dtype)
    n_ch = seq // SGU_CHUNK
    v = v.reshape(bsz, n_ch, SGU_CHUNK, SGU_GROUPS, SGU_WIDTH // SGU_GROUPS)
    w_causal = jnp.where(jnp.tril(jnp.ones((SGU_CHUNK, SGU_CHUNK), dtype=bool)), w_s, 0.0)
    mixed = jnp.einsum('gts,bnsgc->bntgc', w_causal, v) + b_s.T[:, :, None]
    y = u * mixed.reshape(bsz, seq, SGU_WIDTH)
    return y @ w_out


def setup_inputs(seed: int = 0) -> dict:
    key = jax.random.key(seed)
    k = jax.random.split(key, 20)
    ne = (DEPTH + 1) // 2
    no = DEPTH // 2
    f32 = jnp.float32

    def normal(kk, shape):
        return jax.random.normal(kk, shape, f32)

    def dense(kk, shape, fan_in):
        return normal(kk, shape) * (fan_in ** -0.5)

    return {
        'x': normal(k[0], (BATCH, SEQ, D_MODEL)),
        'norm_g': 1.0 + 0.05 * normal(k[1], (DEPTH, 4, D_MODEL)),
        'ffn_w1': dense(k[2], (DEPTH, D_MODEL, FFN_HIDDEN), D_MODEL),
        'ffn_w2': dense(k[3], (DEPTH, FFN_HIDDEN, D_MODEL), FFN_HIDDEN),
        'e_w_in': dense(k[4], (ne, D_MODEL, EVEN_PROJ_WIDTH), D_MODEL),
        'e_w_out': dense(k[5], (ne, EVEN_MIX_WIDTH, D_MODEL), EVEN_MIX_WIDTH),
        'gla_w_gate': dense(k[6], (ne, GLA_GATE_RANK, GLA_HEADS * GLA_DK), GLA_GATE_RANK),
        'gla_b_gate': 0.1 * normal(k[7], (ne, GLA_HEADS * GLA_DK)),
        'gla_norm': 1.0 + 0.05 * normal(k[8], (ne, GLA_HEADS, GLA_DV)),
        'nsa_gate_b': 0.1 * normal(k[9], (ne, NSA_HEADS * NSA_BRANCHES)),
        'nsa_cmp_pos': 0.1 * normal(k[10], (ne, 2, NSA_CMP_BLOCK, NSA_DH)),
        'nsa_cmp_w1': dense(k[11], (ne, 2, NSA_CMP_BLOCK * NSA_DH, NSA_CMP_HIDDEN), NSA_CMP_BLOCK * NSA_DH),
        'nsa_cmp_w2': dense(k[12], (ne, 2, NSA_CMP_HIDDEN, NSA_DH), NSA_CMP_HIDDEN),
        'o_w_in': dense(k[13], (no, D_MODEL, 2 * SGU_WIDTH), D_MODEL),
        'o_ln_g': 1.0 + 0.05 * normal(k[14], (no, SGU_WIDTH)),
        'o_ln_b': 0.02 * normal(k[15], (no, SGU_WIDTH)),
        'o_w_s': dense(k[16], (no, SGU_GROUPS, SGU_CHUNK, SGU_CHUNK), SGU_CHUNK),
        'o_b_s': 1.0 + 0.1 * normal(k[17], (no, SGU_GROUPS, SGU_CHUNK)),
        'o_w_out': dense(k[18], (no, SGU_WIDTH, D_MODEL), SGU_WIDTH),
    }


def reference(x, norm_g, ffn_w1, ffn_w2, e_w_in, e_w_out, gla_w_gate, gla_b_gate, gla_norm, nsa_gate_b, nsa_cmp_pos, nsa_cmp_w1, nsa_cmp_w2, o_w_in, o_ln_g, o_ln_b, o_w_s, o_b_s, o_w_out):
    h = x
    for layer in range(DEPTH):
        i = layer // 2
        xn = _rms_norm(h, norm_g[layer, 0])
        if layer % 2 == 0:
            m = _even_mixer(xn, e_w_in[i], e_w_out[i], gla_w_gate[i], gla_b_gate[i], gla_norm[i],
                            nsa_gate_b[i], nsa_cmp_pos[i], nsa_cmp_w1[i], nsa_cmp_w2[i])
        else:
            m = _sgu_mixer(xn, o_w_in[i], o_ln_g[i], o_ln_b[i], o_w_s[i], o_b_s[i], o_w_out[i])
        h = h + _rms_norm(m, norm_g[layer, 1])
        f = _squared_relu_mlp(_rms_norm(h, norm_g[layer, 2]), ffn_w1[layer], ffn_w2[layer])
        h = h + _rms_norm(f, norm_g[layer, 3])
    return h
```

```cpp
#include <hip/hip_runtime.h>
#include <hip/hip_cooperative_groups.h>
#include <cstdio>
namespace cg = cooperative_groups;

#ifndef MEGA
#define MEGA 0
#endif

typedef unsigned short bf16_t;
typedef short bf16x8 __attribute__((ext_vector_type(8)));
typedef short s16x4 __attribute__((ext_vector_type(4)));
typedef float f32x16 __attribute__((ext_vector_type(16)));
typedef float f32v2 __attribute__((ext_vector_type(2)));
typedef __bf16 bf16v2 __attribute__((ext_vector_type(2)));
typedef unsigned u32x4 __attribute__((ext_vector_type(4)));
typedef unsigned u32x2 __attribute__((ext_vector_type(2)));
#define DI __device__ __forceinline__

constexpr int T_TOK = 65536, SEQ = 8192, DM = 1024;
constexpr int PW = 2944;
constexpr int C_GQ = 0, C_GK = 256, C_GV = 512, C_GLR = 1024, C_GR = 1040, C_NQ = 1552, C_KC = 2064, C_VC = 2192,
              C_KS = 2320, C_VS = 2448, C_KW = 2576, C_VW = 2704, C_NG = 2832;
constexpr float EPS = 1e-6f;
constexpr size_t MiB = 1024ull * 1024ull;
constexpr size_t W_FFN1_0 = 0, W_FFN1_1 = 8 * MiB, W_FFN2_0 = 16 * MiB, W_FFN2_1 = 24 * MiB, W_EIN = 32 * MiB, W_EOUT = 38 * MiB,
                 W_OIN = 40 * MiB, W_OOUT = 48 * MiB, W_CW1 = 52 * MiB, W_CW2 = 53 * MiB, W_BIAS1 = 53 * MiB + 65536,
                 W_CNT = 53 * MiB + 131072;
constexpr size_t R1 = 64 * MiB, R2 = 576 * MiB, R3 = 704 * MiB, R4 = 832 * MiB, R5 = 960 * MiB;
constexpr size_t R_KCMP = R5, R_VCMPT = R5 + 1 * MiB, R_VST = R5 + 2 * MiB, R_VWT = R5 + 18 * MiB, R_DECAY = R5 + 34 * MiB;

struct Params {
  const float* x; const float* norm_g; const float* ffn_w1; const float* ffn_w2; const float* e_w_in; const float* e_w_out;
  const float* gla_w_gate; const float* gla_b_gate; const float* gla_norm; const float* nsa_gate_b; const float* cmp_pos;
  const float* cmp_w1; const float* cmp_w2; const float* o_w_in; const float* o_ln_g; const float* o_ln_b; const float* o_w_s;
  const float* o_b_s; const float* o_w_out;
  float* out; char* ws;
};

DI int crow(int r, int kb) { return (r & 3) + 8 * (r >> 2) + 4 * kb; }
DI f32x16 mfma(bf16x8 a, bf16x8 b, f32x16 c) { return __builtin_amdgcn_mfma_f32_32x32x16_bf16(a, b, c, 0, 0, 0); }
DI unsigned pk2(float a, float b) { f32v2 v = {a, b}; bf16v2 r = __builtin_convertvector(v, bf16v2); return __builtin_bit_cast(unsigned, r); }
DI bf16_t f2bf(float a) { return (bf16_t)(pk2(a, 0.f) & 0xffffu); }
DI float bf2f(bf16_t u) { return __uint_as_float(((unsigned)u) << 16); }
DI float bflo(unsigned u) { return __uint_as_float(u << 16); }
DI float bfhi(unsigned u) { return __uint_as_float(u & 0xffff0000u); }
DI bf16x8 pack8(float a0, float a1, float a2, float a3, float a4, float a5, float a6, float a7) {
  u32x4 p; p[0] = pk2(a0, a1); p[1] = pk2(a2, a3); p[2] = pk2(a4, a5); p[3] = pk2(a6, a7);
  return __builtin_bit_cast(bf16x8, p);
}
DI bf16x8 ld2x4(const bf16_t* p) {
  s16x4 lo = *(const s16x4*)p; s16x4 hi = *(const s16x4*)(p + 8);
  return __builtin_shufflevector(lo, hi, 0, 1, 2, 3, 4, 5, 6, 7);
}
DI float wave_sum(float v) {
#pragma unroll
  for (int o = 32; o > 0; o >>= 1) v += __shfl_xor(v, o);
  return v;
}
DI f32x16 zero16() { f32x16 z;
#pragma unroll
  for (int i = 0; i < 16; ++i) z[i] = 0.f; return z; }
DI float gelu_tanh(float x) { float u = 1.5957691216f * (x + 0.044715f * x * x * x); return x / (1.f + __expf(-u)); }
DI float sigmoidf_(float x) { return 1.f / (1.f + __expf(-x)); }

DI void conv_weight(const float* __restrict__ src, bf16_t* __restrict__ dst, int K, int N, int Npad) {
  const long total = (long)Npad * (K >> 3);
  const long stride = (long)gridDim.x * blockDim.x;
  for (long i = (long)blockIdx.x * blockDim.x + threadIdx.x; i < total; i += stride) {
    const int n = (int)(i % Npad); const int k8 = (int)(i / Npad);
    float v[8];
#pragma unroll
    for (int j = 0; j < 8; ++j) v[j] = (n < N) ? src[(size_t)(k8 * 8 + j) * N + n] : 0.f;
    u32x4 o; o[0] = pk2(v[0], v[1]); o[1] = pk2(v[2], v[3]); o[2] = pk2(v[4], v[5]); o[3] = pk2(v[6], v[7]);
    *(u32x4*)(dst + (size_t)n * K + k8 * 8) = o;
  }
}

DI void prenorm_rows(const float* __restrict__ x, const float* __restrict__ g, bf16_t* __restrict__ xn) {
  const int lane = threadIdx.x & 63, wave = threadIdx.x >> 6;
  const int nw = gridDim.x * 4;
  for (int row = blockIdx.x * 4 + wave; row < T_TOK; row += nw) {
    const float4* xr = (const float4*)(x + (size_t)row * DM);
    float4 a[4]; float ss = 0.f;
#pragma unroll
    for (int k = 0; k < 4; ++k) { a[k] = xr[k * 64 + lane]; ss += a[k].x * a[k].x + a[k].y * a[k].y + a[k].z * a[k].z + a[k].w * a[k].w; }
    ss = wave_sum(ss);
    const float rs = rsqrtf(ss * (1.f / DM) + EPS);
#pragma unroll
    for (int k = 0; k < 4; ++k) {
      const float4 gg = ((const float4*)g)[k * 64 + lane];
      u32x2 o; o[0] = pk2(a[k].x * rs * gg.x, a[k].y * rs * gg.y); o[1] = pk2(a[k].z * rs * gg.z, a[k].w * rs * gg.w);
      *(u32x2*)(xn + (size_t)row * DM + k * 256 + lane * 4) = o;
    }
  }
}

DI void resnorm_rows(const bf16_t* __restrict__ m, const float* hin, float* hout, const float* __restrict__ gpost,
                             const float* __restrict__ gnext, bf16_t* __restrict__ xn) {
  const int lane = threadIdx.x & 63, wave = threadIdx.x >> 6;
  const int nw = gridDim.x * 4;
  for (int row = blockIdx.x * 4 + wave; row < T_TOK; row += nw) {
    float mv[16]; float ss = 0.f;
#pragma unroll
    for (int k = 0; k < 4; ++k) {
      const u32x2 u = *(const u32x2*)(m + (size_t)row * DM + k * 256 + lane * 4);
      mv[k * 4 + 0] = bflo(u[0]); mv[k * 4 + 1] = bfhi(u[0]); mv[k * 4 + 2] = bflo(u[1]); mv[k * 4 + 3] = bfhi(u[1]);
    }
#pragma unroll
    for (int i = 0; i < 16; ++i) ss += mv[i] * mv[i];
    ss = wave_sum(ss);
    const float rs = rsqrtf(ss * (1.f / DM) + EPS);
    float hv[16]; float s2 = 0.f;
#pragma unroll
    for (int k = 0; k < 4; ++k) {
      const float4 h4 = ((const float4*)(hin + (size_t)row * DM))[k * 64 + lane];
      const float4 gg = ((const float4*)gpost)[k * 64 + lane];
      hv[k * 4 + 0] = h4.x + mv[k * 4 + 0] * rs * gg.x; hv[k * 4 + 1] = h4.y + mv[k * 4 + 1] * rs * gg.y;
      hv[k * 4 + 2] = h4.z + mv[k * 4 + 2] * rs * gg.z; hv[k * 4 + 3] = h4.w + mv[k * 4 + 3] * rs * gg.w;
      float4 o; o.x = hv[k * 4 + 0]; o.y = hv[k * 4 + 1]; o.z = hv[k * 4 + 2]; o.w = hv[k * 4 + 3];
      ((float4*)(hout + (size_t)row * DM))[k * 64 + lane] = o;
    }
    if (xn) {
#pragma unroll
      for (int i = 0; i < 16; ++i) s2 += hv[i] * hv[i];
      s2 = wave_sum(s2);
      const float r2 = rsqrtf(s2 * (1.f / DM) + EPS);
#pragma unroll
      for (int k = 0; k < 4; ++k) {
        const float4 gg = ((const float4*)gnext)[k * 64 + lane];
        u32x2 o; o[0] = pk2(hv[k * 4 + 0] * r2 * gg.x, hv[k * 4 + 1] * r2 * gg.y); o[1] = pk2(hv[k * 4 + 2] * r2 * gg.z, hv[k * 4 + 3] * r2 * gg.w);
        *(u32x2*)(xn + (size_t)row * DM + k * 256 + lane * 4) = o;
      }
    }
  }
}

DI void phase_prep(const Params& P) {
  char* ws = P.ws;
  conv_weight(P.ffn_w1, (bf16_t*)(ws + W_FFN1_0), 1024, 4096, 4096);
  conv_weight(P.ffn_w1 + (size_t)1024 * 4096, (bf16_t*)(ws + W_FFN1_1), 1024, 4096, 4096);
  conv_weight(P.ffn_w2, (bf16_t*)(ws + W_FFN2_0), 4096, 1024, 1024);
  conv_weight(P.ffn_w2 + (size_t)1024 * 4096, (bf16_t*)(ws + W_FFN2_1), 4096, 1024, 1024);
  conv_weight(P.e_w_in, (bf16_t*)(ws + W_EIN), 1024, 2856, PW);
  conv_weight(P.e_w_out, (bf16_t*)(ws + W_EOUT), 1024, 1024, 1024);
  conv_weight(P.o_w_in, (bf16_t*)(ws + W_OIN), 1024, 4096, 4096);
  conv_weight(P.o_w_out, (bf16_t*)(ws + W_OOUT), 2048, 1024, 1024);
  conv_weight(P.cmp_w1, (bf16_t*)(ws + W_CW1), 2048, 128, 128);
  conv_weight(P.cmp_w1 + 2048 * 128, (bf16_t*)(ws + W_CW1) + 128 * 2048, 2048, 128, 128);
  conv_weight(P.cmp_w2, (bf16_t*)(ws + W_CW2), 128, 64, 64);
  conv_weight(P.cmp_w2 + 128 * 64, (bf16_t*)(ws + W_CW2) + 64 * 128, 128, 64, 64);
  const int lane = threadIdx.x & 63, wave = threadIdx.x >> 6;
  const int gw = blockIdx.x * 4 + wave;
  if (gw < 256) {
    const int i = gw >> 7, hid = gw & 127;
    float s = 0.f;
    for (int kk = lane; kk < 2048; kk += 64) s += P.cmp_pos[i * 2048 + kk] * P.cmp_w1[((size_t)i * 2048 + kk) * 128 + hid];
    s = wave_sum(s);
    if (lane == 0) ((float*)(ws + W_BIAS1))[gw] = s;
  }
  const int gt = blockIdx.x * blockDim.x + threadIdx.x;
  if (gt < 16) ((unsigned*)(ws + W_CNT))[gt] = 0u;
  if (gt < 16 * 64) {
    const int bg = gt >> 6, d = gt & 63;
    ((bf16_t*)(ws + R_KCMP))[((size_t)bg * 512 + 511) * 64 + d] = 0;
    ((bf16_t*)(ws + R_VCMPT))[((size_t)bg * 64 + d) * 512 + 511] = 0;
  }
  prenorm_rows(P.x, P.norm_g, (bf16_t*)(ws + R2));
}

template <int EPI>
DI void gemm_phase(const bf16_t* __restrict__ A, int lda, const bf16_t* __restrict__ Bt, int K, int NT,
                           bf16_t* __restrict__ C, int ldc, char* smem) {
  bf16_t* sA = (bf16_t*)smem; bf16_t* sB = sA + 128 * 72;
  const int tid = threadIdx.x, lane = tid & 63, wave = tid >> 6, l32 = lane & 31, kb = lane >> 5;
  const int wr = wave >> 1, wc = wave & 1;
  const int nkt = K >> 6;
  const int ntiles = 512 * NT;
  const int lrow = tid >> 3, lcol = (tid & 7) * 8;
  for (int tile = blockIdx.x; tile < ntiles; tile += gridDim.x) {
    const int mt = tile / NT, nt = tile - mt * NT;
    const bf16_t* Ag = A + (size_t)(mt * 128 + lrow) * lda + lcol;
    const bf16_t* Bg = Bt + (size_t)(nt * 128 + lrow) * K + lcol;
    f32x16 acc[2][2];
#pragma unroll
    for (int i = 0; i < 2; ++i)
#pragma unroll
      for (int j = 0; j < 2; ++j) acc[i][j] = zero16();
    u32x4 ra[4], rb[4];
#pragma unroll
    for (int i = 0; i < 4; ++i) { ra[i] = *(const u32x4*)(Ag + (size_t)(32 * i) * lda); rb[i] = *(const u32x4*)(Bg + (size_t)(32 * i) * K); }
    for (int kt = 0; kt < nkt; ++kt) {
      __syncthreads();
#pragma unroll
      for (int i = 0; i < 4; ++i) { *(u32x4*)(sA + (lrow + 32 * i) * 72 + lcol) = ra[i]; *(u32x4*)(sB + (lrow + 32 * i) * 72 + lcol) = rb[i]; }
      __syncthreads();
      if (kt + 1 < nkt) {
        const int k0 = (kt + 1) * 64;
#pragma unroll
        for (int i = 0; i < 4; ++i) { ra[i] = *(const u32x4*)(Ag + (size_t)(32 * i) * lda + k0); rb[i] = *(const u32x4*)(Bg + (size_t)(32 * i) * K + k0); }
      }
#pragma unroll
      for (int kk = 0; kk < 4; ++kk) {
        const bf16x8 a0 = *(const bf16x8*)(sA + (wr * 64 + l32) * 72 + kk * 16 + kb * 8);
        const bf16x8 a1 = *(const bf16x8*)(sA + (wr * 64 + 32 + l32) * 72 + kk * 16 + kb * 8);
        const bf16x8 b0 = *(const bf16x8*)(sB + (wc * 64 + l32) * 72 + kk * 16 + kb * 8);
        const bf16x8 b1 = *(const bf16x8*)(sB + (wc * 64 + 32 + l32) * 72 + kk * 16 + kb * 8);
        acc[0][0] = mfma(a0, b0, acc[0][0]); acc[0][1] = mfma(a0, b1, acc[0][1]);
        acc[1][0] = mfma(a1, b0, acc[1][0]); acc[1][1] = mfma(a1, b1, acc[1][1]);
      }
    }
#pragma unroll
    for (int mi = 0; mi < 2; ++mi)
#pragma unroll
      for (int ni = 0; ni < 2; ++ni)
#pragma unroll
        for (int r = 0; r < 16; ++r) {
          const int row = mt * 128 + wr * 64 + mi * 32 + crow(r, kb);
          const int col = nt * 128 + wc * 64 + ni * 32 + l32;
          float v = acc[mi][ni][r];
          if (EPI == 1) { v = fmaxf(v, 0.f); v = v * v; }
          if (EPI == 2) { v = gelu_tanh(v); }
          C[(size_t)row * ldc + col] = f2bf(v);
        }
  }
}

DI void gla_gates(const Params& P, const bf16_t* proj, int b, int h, int n, float* sb, float* sseg, float* tmp) {
  const int tid = threadIdx.x;
  float* sw = tmp;
  float* sg = tmp + 1024;
  {
    for (int e = tid; e < 1024; e += 256) sw[e] = P.gla_w_gate[(e >> 6) * 256 + h * 64 + (e & 63)];
    const int i = tid >> 2, part = tid & 3;
    const size_t t = (size_t)b * SEQ + n * 64 + i;
    const u32x2 gu = *(const u32x2*)(proj + t * PW + C_GLR + part * 4);
    sg[i * 17 + part * 4 + 0] = bflo(gu[0]); sg[i * 17 + part * 4 + 1] = bfhi(gu[0]);
    sg[i * 17 + part * 4 + 2] = bflo(gu[1]); sg[i * 17 + part * 4 + 3] = bfhi(gu[1]);
  }
  __syncthreads();
  {
    const int i = tid & 63, dq = tid >> 6;
    float z[16];
#pragma unroll
    for (int dd = 0; dd < 16; ++dd) z[dd] = P.gla_b_gate[h * 64 + dq * 16 + dd];
#pragma unroll 1
    for (int r = 0; r < 16; ++r) {
      const float gv = sg[i * 17 + r];
#pragma unroll
      for (int dd = 0; dd < 16; ++dd) z[dd] += gv * sw[r * 64 + dq * 16 + dd];
    }
#pragma unroll
    for (int dd = 0; dd < 16; ++dd) {
      const float zz = z[dd];
      const float ls = fminf(zz, 0.f) - __logf(1.f + __expf(-fabsf(zz)));
      sb[i * 65 + dq * 16 + dd] = ls * (1.f / 16.f);
    }
  }
  __syncthreads();
  const int d = tid & 63, seg = tid >> 6;
  float pre[16]; float run = 0.f;
#pragma unroll
  for (int ii = 0; ii < 16; ++ii) { run += sb[(seg * 16 + ii) * 65 + d]; pre[ii] = run; }
  sseg[seg * 64 + d] = run;
  __syncthreads();
  float off = 0.f;
#pragma unroll
  for (int s = 0; s < 4; ++s) off += (s < seg) ? sseg[s * 64 + d] : 0.f;
#pragma unroll
  for (int ii = 0; ii < 16; ++ii) sb[(seg * 16 + ii) * 65 + d] = pre[ii] + off;
  __syncthreads();
}

DI void gla_stage_vT(const bf16_t* proj, int b, int h, int n, bf16_t* vT) {
  const int tid = threadIdx.x, j = tid & 63, q4 = tid >> 6;
  const size_t t = (size_t)b * SEQ + n * 64 + j;
  const bf16_t* src = proj + t * PW + C_GV + h * 128 + q4 * 32;
#pragma unroll
  for (int c = 0; c < 4; ++c) {
    const u32x4 u = *(const u32x4*)(src + c * 8);
#pragma unroll
    for (int e = 0; e < 4; ++e) {
      vT[(q4 * 32 + c * 8 + 2 * e) * 72 + j] = (bf16_t)(u[e] & 0xffffu);
      vT[(q4 * 32 + c * 8 + 2 * e + 1) * 72 + j] = (bf16_t)(u[e] >> 16);
    }
  }
}

DI void gla_p1_item(const Params& P, int item, char* smem) {
  const bf16_t* proj = (const bf16_t*)(P.ws + R1);
  float* states = (float*)(P.ws + R2);
  float* decay = (float*)(P.ws + R_DECAY);
  float* sb = (float*)smem; float* sseg = sb + 64 * 65;
  bf16_t* kendT = (bf16_t*)(sseg + 256); bf16_t* vT = kendT + 64 * 72;
  const int n = item & 127, h = (item >> 7) & 3, b = item >> 9;
  const int tid = threadIdx.x, lane = tid & 63, wave = tid >> 6, l32 = lane & 31, kb = lane >> 5;
  gla_gates(P, proj, b, h, n, sb, sseg, (float*)vT);
  {
    const int j = tid & 63, dq = tid >> 6;
    const size_t t = (size_t)b * SEQ + n * 64 + j;
    const u32x4 k0 = *(const u32x4*)(proj + t * PW + C_GK + h * 64 + dq * 16), k1 = *(const u32x4*)(proj + t * PW + C_GK + h * 64 + dq * 16 + 8);
    float kv[16];
#pragma unroll
    for (int e = 0; e < 4; ++e) { kv[2 * e] = bflo(k0[e]); kv[2 * e + 1] = bfhi(k0[e]); kv[8 + 2 * e] = bflo(k1[e]); kv[8 + 2 * e + 1] = bfhi(k1[e]); }
#pragma unroll
    for (int dd = 0; dd < 16; ++dd) {
      const int d = dq * 16 + dd;
      kendT[d * 72 + j] = f2bf(kv[dd] * __expf(sb[63 * 65 + d] - sb[j * 65 + d]));
    }
    if (tid < 64) decay[((size_t)(b * 4 + h) * 128 + n) * 64 + tid] = __expf(sb[63 * 65 + tid]);
  }
  gla_stage_vT(proj, b, h, n, vT);
  __syncthreads();
#pragma unroll
  for (int dt = 0; dt < 2; ++dt) {
    f32x16 acc = zero16();
#pragma unroll
    for (int s = 0; s < 4; ++s) {
      const bf16x8 a = *(const bf16x8*)(vT + (wave * 32 + l32) * 72 + s * 16 + kb * 8);
      const bf16x8 bb = *(const bf16x8*)(kendT + (dt * 32 + l32) * 72 + s * 16 + kb * 8);
      acc = mfma(a, bb, acc);
    }
    float* dst = states + ((size_t)((b * 4 + h) * 128 + n) * 128) * 64;
#pragma unroll
    for (int r = 0; r < 16; ++r) dst[(size_t)(wave * 32 + crow(r, kb)) * 64 + dt * 32 + l32] = acc[r];
  }
  __syncthreads();
}

DI void gla_scan(const Params& P) {
  float* states = (float*)(P.ws + R2);
  const float* decay = (const float*)(P.ws + R_DECAY);
  const int total = 32 * 8192;
  for (int e = blockIdx.x * blockDim.x + threadIdx.x; e < total; e += gridDim.x * blockDim.x) {
    const int bh = e >> 13, idx = e & 8191, d = idx & 63;
    float* p = states + (size_t)bh * 128 * 8192 + idx;
    const float* dc = decay + (size_t)bh * 128 * 64 + d;
    float S = 0.f;
#pragma unroll 8
    for (int n = 0; n < 128; ++n) {
      const float ds = p[(size_t)n * 8192];
      const float dec = dc[n * 64];
      p[(size_t)n * 8192] = S;
      S = dec * S + ds;
    }
  }
}

DI void gla_p3_item(const Params& P, int item, char* smem) {
  const bf16_t* proj = (const bf16_t*)(P.ws + R1);
  const float* states = (const float*)(P.ws + R2);
  bf16_t* mix = (bf16_t*)(P.ws + R3);
  float* sb = (float*)smem; float* sseg = sb + 64 * 65; float* sred = sseg + 256;
  bf16_t* sq = (bf16_t*)(sred + 256); bf16_t* sk = sq + 64 * 72; bf16_t* vT = sk + 64 * 72;
  const int n = item & 127, h = (item >> 7) & 3, b = item >> 9;
  const int tid = threadIdx.x, lane = tid & 63, wave = tid >> 6, l32 = lane & 31, kb = lane >> 5;
  gla_gates(P, proj, b, h, n, sb, sseg, (float*)vT);
  {
    const int i = tid & 63, dq = tid >> 6;
    const size_t t = (size_t)b * SEQ + n * 64 + i;
    const u32x4 q0 = *(const u32x4*)(proj + t * PW + C_GQ + h * 64 + dq * 16), q1 = *(const u32x4*)(proj + t * PW + C_GQ + h * 64 + dq * 16 + 8);
    const u32x4 k0 = *(const u32x4*)(proj + t * PW + C_GK + h * 64 + dq * 16), k1 = *(const u32x4*)(proj + t * PW + C_GK + h * 64 + dq * 16 + 8);
    float qv[16], kv[16];
#pragma unroll
    for (int e = 0; e < 4; ++e) {
      qv[2 * e] = bflo(q0[e]); qv[2 * e + 1] = bfhi(q0[e]); qv[8 + 2 * e] = bflo(q1[e]); qv[8 + 2 * e + 1] = bfhi(q1[e]);
      kv[2 * e] = bflo(k0[e]); kv[2 * e + 1] = bfhi(k0[e]); kv[8 + 2 * e] = bflo(k1[e]); kv[8 + 2 * e + 1] = bfhi(k1[e]);
    }
#pragma unroll
    for (int dd = 0; dd < 16; ++dd) {
      const int d = dq * 16 + dd;
      const float bb = sb[i * 65 + d];
      sq[i * 72 + d] = f2bf(qv[dd] * 0.125f * __expf(bb));
      sk[i * 72 + d] = f2bf(kv[dd] * __expf(-bb));
    }
  }
  gla_stage_vT(proj, b, h, n, vT);
  __syncthreads();
  f32x16 x00 = zero16(), x01 = zero16(), x11 = zero16();
#pragma unroll
  for (int s = 0; s < 4; ++s) {
    const bf16x8 kj0 = *(const bf16x8*)(sk + (l32)*72 + s * 16 + kb * 8);
    const bf16x8 kj1 = *(const bf16x8*)(sk + (32 + l32) * 72 + s * 16 + kb * 8);
    const bf16x8 qi0 = *(const bf16x8*)(sq + (l32)*72 + s * 16 + kb * 8);
    const bf16x8 qi1 = *(const bf16x8*)(sq + (32 + l32) * 72 + s * 16 + kb * 8);
    x00 = mfma(kj0, qi0, x00); x01 = mfma(kj0, qi1, x01); x11 = mfma(kj1, qi1, x11);
  }
#pragma unroll
  for (int r = 0; r < 16; ++r) { const bool keep = crow(r, kb) <= l32; x00[r] = keep ? x00[r] : 0.f; x11[r] = keep ? x11[r] : 0.f; }
  f32x16 o0 = zero16(), o1 = zero16();
  const int dvr = wave * 32 + l32;
#pragma unroll
  for (int s = 0; s < 2; ++s) {
    const bf16x8 p00 = pack8(x00[8 * s], x00[8 * s + 1], x00[8 * s + 2], x00[8 * s + 3], x00[8 * s + 4], x00[8 * s + 5], x00[8 * s + 6], x00[8 * s + 7]);
    const bf16x8 p01 = pack8(x01[8 * s], x01[8 * s + 1], x01[8 * s + 2], x01[8 * s + 3], x01[8 * s + 4], x01[8 * s + 5], x01[8 * s + 6], x01[8 * s + 7]);
    const bf16x8 p11 = pack8(x11[8 * s], x11[8 * s + 1], x11[8 * s + 2], x11[8 * s + 3], x11[8 * s + 4], x11[8 * s + 5], x11[8 * s + 6], x11[8 * s + 7]);
    const bf16x8 v0 = ld2x4(vT + dvr * 72 + 16 * s + 4 * kb);
    const bf16x8 v1 = ld2x4(vT + dvr * 72 + 32 + 16 * s + 4 * kb);
    o0 = mfma(v0, p00, o0); o1 = mfma(v0, p01, o1); o1 = mfma(v1, p11, o1);
  }
  {
    const float* sp = states + ((size_t)((b * 4 + h) * 128 + n) * 128 + dvr) * 64;
#pragma unroll
    for (int s = 0; s < 4; ++s) {
      const float4 f0 = *(const float4*)(sp + s * 16 + kb * 8), f1 = *(const float4*)(sp + s * 16 + kb * 8 + 4);
      const bf16x8 a = pack8(f0.x, f0.y, f0.z, f0.w, f1.x, f1.y, f1.z, f1.w);
      const bf16x8 qi0 = *(const bf16x8*)(sq + (l32)*72 + s * 16 + kb * 8);
      const bf16x8 qi1 = *(const bf16x8*)(sq + (32 + l32) * 72 + s * 16 + kb * 8);
      o0 = mfma(a, qi0, o0); o1 = mfma(a, qi1, o1);
    }
  }
  float s0 = 0.f, s1 = 0.f;
#pragma unroll
  for (int r = 0; r < 16; ++r) { s0 += o0[r] * o0[r]; s1 += o1[r] * o1[r]; }
  s0 += __shfl_xor(s0, 32); s1 += __shfl_xor(s1, 32);
  if (kb == 0) { sred[wave * 64 + l32] = s0; sred[wave * 64 + 32 + l32] = s1; }
  __syncthreads();
  const float t0s = sred[l32] + sred[64 + l32] + sred[128 + l32] + sred[192 + l32];
  const float t1s = sred[32 + l32] + sred[64 + 32 + l32] + sred[128 + 32 + l32] + sred[192 + 32 + l32];
  const float r0 = rsqrtf(t0s * (1.f / 128.f) + EPS), r1 = rsqrtf(t1s * (1.f / 128.f) + EPS);
#pragma unroll
  for (int it = 0; it < 2; ++it) {
    const size_t t = (size_t)b * SEQ + n * 64 + it * 32 + l32;
    const float rr = it ? r1 : r0;
#pragma unroll
    for (int gq = 0; gq < 4; ++gq) {
      const int dv = wave * 32 + 8 * gq + 4 * kb;
      const u32x2 ru = *(const u32x2*)(proj + t * PW + C_GR + h * 128 + dv);
      const float4 gn = *(const float4*)(P.gla_norm + h * 128 + dv);
      float rv[4] = {bflo(ru[0]), bfhi(ru[0]), bflo(ru[1]), bfhi(ru[1])};
      float gv[4] = {gn.x, gn.y, gn.z, gn.w};
      float ov[4];
#pragma unroll
      for (int e = 0; e < 4; ++e) {
        const float a = it ? o1[gq * 4 + e] : o0[gq * 4 + e];
        ov[e] = a * rr * gv[e] * (rv[e] / (1.f + __expf(-rv[e])));
      }
      u32x2 o; o[0] = pk2(ov[0], ov[1]); o[1] = pk2(ov[2], ov[3]);
      *(u32x2*)(mix + t * DM + h * 128 + dv) = o;
    }
  }
  __syncthreads();
}

DI void nsa_compress_task(const Params& P, int task) {
  const bf16_t* proj = (const bf16_t*)(P.ws + R1);
  const int lane = threadIdx.x & 63, l32 = lane & 31, kb = lane >> 5;
  const int ct = task & 15, g = (task >> 4) & 1, b = (task >> 5) & 7, br = task >> 8;
  const bf16_t* w1T = (const bf16_t*)(P.ws + W_CW1) + (size_t)br * 128 * 2048;
  const bf16_t* w2T = (const bf16_t*)(P.ws + W_CW2) + (size_t)br * 64 * 128;
  const float* bias1 = (const float*)(P.ws + W_BIAS1) + br * 128;
  const int c = ct * 32 + l32;
  const int cc = c < 511 ? c : 510;
  const bf16_t* src = proj + ((size_t)b * SEQ + cc * 16) * PW + (br ? C_VC : C_KC) + g * 64 + kb * 8;
  f32x16 acc[4];
#pragma unroll
  for (int i = 0; i < 4; ++i) acc[i] = zero16();
#pragma unroll 1
  for (int ks = 0; ks < 128; ++ks) {
    const int l = ks >> 2, dh0 = (ks & 3) * 16;
    const bf16x8 bf = *(const bf16x8*)(src + (size_t)l * PW + dh0);
#pragma unroll
    for (int ht = 0; ht < 4; ++ht) {
      const bf16x8 af = *(const bf16x8*)(w1T + (size_t)(ht * 32 + l32) * 2048 + ks * 16 + kb * 8);
      acc[ht] = mfma(af, bf, acc[ht]);
    }
  }
#pragma unroll
  for (int ht = 0; ht < 4; ++ht)
#pragma unroll
    for (int r = 0; r < 16; ++r) acc[ht][r] = gelu_tanh(acc[ht][r] + bias1[ht * 32 + crow(r, kb)]);
  f32x16 o[2]; o[0] = zero16(); o[1] = zero16();
#pragma unroll
  for (int ht = 0; ht < 4; ++ht)
#pragma unroll
    for (int s = 0; s < 2; ++s) {
      const bf16x8 hf = pack8(acc[ht][8 * s], acc[ht][8 * s + 1], acc[ht][8 * s + 2], acc[ht][8 * s + 3], acc[ht][8 * s + 4], acc[ht][8 * s + 5], acc[ht][8 * s + 6], acc[ht][8 * s + 7]);
#pragma unroll
      for (int dt = 0; dt < 2; ++dt) {
        const bf16x8 wf = ld2x4(w2T + (size_t)(dt * 32 + l32) * 128 + ht * 32 + 16 * s + 4 * kb);
        o[dt] = mfma(wf, hf, o[dt]);
      }
    }
  if (c < 511) {
    if (br == 0) {
      bf16_t* dst = (bf16_t*)(P.ws + R_KCMP) + ((size_t)(b * 2 + g) * 512 + c) * 64;
#pragma unroll
      for (int dt = 0; dt < 2; ++dt)
#pragma unroll
        for (int gq = 0; gq < 4; ++gq) {
          u32x2 u; u[0] = pk2(o[dt][gq * 4], o[dt][gq * 4 + 1]); u[1] = pk2(o[dt][gq * 4 + 2], o[dt][gq * 4 + 3]);
          *(u32x2*)(dst + dt * 32 + 8 * gq + 4 * kb) = u;
        }
    } else {
      bf16_t* dst = (bf16_t*)(P.ws + R_VCMPT) + (size_t)(b * 2 + g) * 64 * 512 + c;
#pragma unroll
      for (int dt = 0; dt < 2; ++dt)
#pragma unroll
        for (int r = 0; r < 16; ++r) dst[(size_t)(dt * 32 + crow(r, kb)) * 512] = f2bf(o[dt][r]);
    }
  }
}

DI void nsa_transpose_v(const Params& P) {
  const bf16_t* proj = (const bf16_t*)(P.ws + R1);
  const int total = 2 * 8 * 2 * 1024 * 64;
  for (int u = blockIdx.x * blockDim.x + threadIdx.x; u < total; u += gridDim.x * blockDim.x) {
    const int dh = u & 63; int rest = u >> 6; const int t8 = rest & 1023; rest >>= 10;
    const int g = rest & 1, b = (rest >> 1) & 7, which = rest >> 4;
    const bf16_t* src = proj + ((size_t)b * SEQ + t8 * 8) * PW + (which ? C_VW : C_VS) + g * 64 + dh;
    bf16_t v[8];
#pragma unroll
    for (int j = 0; j < 8; ++j) v[j] = src[(size_t)j * PW];
    u32x4 o;
#pragma unroll
    for (int j = 0; j < 4; ++j) o[j] = (unsigned)v[2 * j] | ((unsigned)v[2 * j + 1] << 16);
    bf16_t* dst = (bf16_t*)(P.ws + (which ? R_VWT : R_VST)) + ((size_t)(b * 2 + g) * 64 + dh) * SEQ + t8 * 8;
    *(u32x4*)dst = o;
  }
}

DI f32x16 qk_tile(const bf16_t* krow, const bf16x8 (&qf)[4]) {
  f32x16 s = zero16();
#pragma unroll
  for (int i = 0; i < 4; ++i) { const bf16x8 kf = *(const bf16x8*)(krow + i * 16); s = mfma(kf, qf[i], s); }
  return s;
}

DI void attn_tile(const bf16_t* krow, const bf16_t* vt0, const bf16x8 (&qf)[4], int k0, int tq, int lo, bool bit, int kb,
                  f32x16& o0, f32x16& o1, float& m, float& l) {
  f32x16 s = qk_tile(krow, qf);
  float tmax = -1e30f;
  bool vd[16];
#pragma unroll
  for (int r = 0; r < 16; ++r) {
    const int key = k0 + crow(r, kb);
    vd[r] = bit && (key <= tq) && (key > lo);
    s[r] = vd[r] ? s[r] * 0.125f : -1e30f;
    tmax = fmaxf(tmax, s[r]);
  }
  tmax = fmaxf(tmax, __shfl_xor(tmax, 32));
  const float mn = fmaxf(m, tmax);
  const float alpha = __expf(m - mn);
  float ps = 0.f;
#pragma unroll
  for (int r = 0; r < 16; ++r) { s[r] = vd[r] ? __expf(s[r] - mn) : 0.f; ps += s[r]; }
  l = l * alpha + ps; m = mn;
#pragma unroll
  for (int r = 0; r < 16; ++r) { o0[r] *= alpha; o1[r] *= alpha; }
#pragma unroll
  for (int sI = 0; sI < 2; ++sI) {
    const bf16x8 pf = pack8(s[8 * sI], s[8 * sI + 1], s[8 * sI + 2], s[8 * sI + 3], s[8 * sI + 4], s[8 * sI + 5], s[8 * sI + 6], s[8 * sI + 7]);
    const bf16x8 va = ld2x4(vt0 + k0 + 16 * sI);
    const bf16x8 vb = ld2x4(vt0 + (size_t)32 * SEQ + k0 + 16 * sI);
    o0 = mfma(va, pf, o0); o1 = mfma(vb, pf, o1);
  }
}

DI void nsa_task(const Params& P, int b, int g, int qt, float* imp) {
  const bf16_t* proj = (const bf16_t*)(P.ws + R1);
  bf16_t* mix = (bf16_t*)(P.ws + R3);
  const int lane = threadIdx.x & 63, l32 = lane & 31, kb = lane >> 5;
  const int t0 = qt * 32, tq = t0 + l32;
  const size_t tokq = (size_t)b * SEQ + tq;
  const bf16_t* qrow = proj + tokq * PW;
  const bf16_t* kcmp = (const bf16_t*)(P.ws + R_KCMP) + (size_t)(b * 2 + g) * 512 * 64;
  const bf16_t* vcmpT = (const bf16_t*)(P.ws + R_VCMPT) + (size_t)(b * 2 + g) * 64 * 512;
  for (int i = lane; i < 4096; i += 64) imp[i] = 0.f;
  const int nct = (qt >> 4) + 1;
  for (int hh = 0; hh < 4; ++hh) {
    const int head = g * 4 + hh;
    bf16x8 qf[4];
#pragma unroll
    for (int i = 0; i < 4; ++i) qf[i] = *(const bf16x8*)(qrow + C_NQ + head * 64 + i * 16 + kb * 8);
    float m = -1e30f, l = 0.f;
    for (int ct = 0; ct < nct; ++ct) {
      f32x16 s = qk_tile(kcmp + (size_t)(ct * 32 + l32) * 64 + kb * 8, qf);
      float tmax = -1e30f;
#pragma unroll
      for (int r = 0; r < 16; ++r) {
        const int c = ct * 32 + crow(r, kb);
        const bool vd = (c * 16 + 31 <= tq);
        s[r] = vd ? s[r] * 0.125f : -1e30f;
        tmax = fmaxf(tmax, s[r]);
      }
      const float mn = fmaxf(m, tmax);
      float ps = 0.f;
#pragma unroll
      for (int r = 0; r < 16; ++r) ps += (s[r] > -5e29f) ? __expf(s[r] - mn) : 0.f;
      l = l * __expf(m - mn) + ps; m = mn;
    }
    const float mo = __shfl_xor(m, 32), lo_ = __shfl_xor(l, 32);
    const float M = fmaxf(m, mo);
    const float L = l * __expf(m - M) + lo_ * __expf(mo - M);
    const float invL = 1.f / fmaxf(L, 1e-30f);
    f32x16 o0 = zero16(), o1 = zero16();
    float carry = 0.f;
    for (int ct = 0; ct < nct; ++ct) {
      f32x16 s = qk_tile(kcmp + (size_t)(ct * 32 + l32) * 64 + kb * 8, qf);
#pragma unroll
      for (int r = 0; r < 16; ++r) {
        const int c = ct * 32 + crow(r, kb);
        const bool vd = (c * 16 + 31 <= tq);
        s[r] = vd ? __expf(s[r] * 0.125f - M) * invL : 0.f;
      }
      float y[4];
#pragma unroll
      for (int gi = 0; gi < 4; ++gi) y[gi] = __shfl_xor(s[4 * gi + 3], 32);
#pragma unroll
      for (int gi = 0; gi < 4; ++gi) {
        const float s4 = (s[4 * gi] + s[4 * gi + 1]) + (s[4 * gi + 2] + s[4 * gi + 3]);
        const float extra = kb ? y[gi] : (gi == 0 ? carry : y[gi > 0 ? gi - 1 : 0]);
        const int j = ct * 8 + 2 * gi + kb;
        imp[j * 32 + l32] += s4 + extra;
      }
      carry = y[3];
#pragma unroll
      for (int sI = 0; sI < 2; ++sI) {
        const bf16x8 pf = pack8(s[8 * sI], s[8 * sI + 1], s[8 * sI + 2], s[8 * sI + 3], s[8 * sI + 4], s[8 * sI + 5], s[8 * sI + 6], s[8 * sI + 7]);
        const bf16x8 va = ld2x4(vcmpT + (size_t)(l32)*512 + ct * 32 + 16 * sI + 4 * kb);
        const bf16x8 vb = ld2x4(vcmpT + (size_t)(32 + l32) * 512 + ct * 32 + 16 * sI + 4 * kb);
        o0 = mfma(va, pf, o0); o1 = mfma(vb, pf, o1);
      }
    }
    const float g0 = sigmoidf_(bf2f(qrow[C_NG + head * 3 + 0]) + P.nsa_gate_b[head * 3 + 0]);
#pragma unroll
    for (int gq = 0; gq < 4; ++gq) {
      u32x2 u0, u1;
      u0[0] = pk2(g0 * o0[gq * 4], g0 * o0[gq * 4 + 1]); u0[1] = pk2(g0 * o0[gq * 4 + 2], g0 * o0[gq * 4 + 3]);
      u1[0] = pk2(g0 * o1[gq * 4], g0 * o1[gq * 4 + 1]); u1[1] = pk2(g0 * o1[gq * 4 + 2], g0 * o1[gq * 4 + 3]);
      *(u32x2*)(mix + tokq * DM + 512 + head * 64 + 8 * gq + 4 * kb) = u0;
      *(u32x2*)(mix + tokq * DM + 512 + head * 64 + 32 + 8 * gq + 4 * kb) = u1;
    }
  }
  asm volatile("s_waitcnt lgkmcnt(0)" ::: "memory");
  __builtin_amdgcn_wave_barrier();
  unsigned mk0 = 0, mk1 = 0, mk2 = 0, mk3 = 0;
  for (int q = 0; q < 32; ++q) {
    const int tqq = t0 + q, cur = tqq >> 6;
    const float v0 = imp[lane * 32 + q], v1 = imp[(lane + 64) * 32 + q];
    const int j0 = lane, j1 = lane + 64;
    const float s0 = (j0 == 0 || j0 == cur || j0 == cur - 1) ? 1e30f : (j0 <= cur ? v0 : -1e30f);
    const float s1 = (j1 == cur || j1 == cur - 1) ? 1e30f : (j1 <= cur ? v1 : -1e30f);
    int c0 = 0, c1 = 0;
#pragma unroll
    for (int k = 0; k < 64; ++k) {
      const float a0 = __int_as_float(__builtin_amdgcn_readlane(__float_as_int(s0), k));
      const float a1 = __int_as_float(__builtin_amdgcn_readlane(__float_as_int(s1), k));
      c0 += ((a0 > s0) || (a0 == s0 && k < lane)) ? 1 : 0;
      c0 += (a1 > s0) ? 1 : 0;
      c1 += (a0 >= s1) ? 1 : 0;
      c1 += ((a1 > s1) || (a1 == s1 && k < lane)) ? 1 : 0;
    }
    const bool sel0 = (s0 > -5e29f) && (c0 < 16);
    const bool sel1 = (s1 > -5e29f) && (c1 < 16);
    const unsigned long long blo = __ballot(sel0), bhi = __ballot(sel1);
    if (l32 == q) { mk0 = (unsigned)blo; mk1 = (unsigned)(blo >> 32); mk2 = (unsigned)bhi; mk3 = (unsigned)(bhi >> 32); }
  }
  asm volatile("" ::: "memory");
  const bf16_t* ksel = proj + (size_t)b * SEQ * PW + C_KS + g * 64 + kb * 8;
  const bf16_t* kwin = proj + (size_t)b * SEQ * PW + C_KW + g * 64 + kb * 8;
  const bf16_t* vsT = (const bf16_t*)(P.ws + R_VST) + ((size_t)(b * 2 + g) * 64 + l32) * SEQ + 4 * kb;
  const bf16_t* vwT = (const bf16_t*)(P.ws + R_VWT) + ((size_t)(b * 2 + g) * 64 + l32) * SEQ + 4 * kb;
  for (int hh = 0; hh < 4; ++hh) {
    const int head = g * 4 + hh;
    bf16x8 qf[4];
#pragma unroll
    for (int i = 0; i < 4; ++i) qf[i] = *(const bf16x8*)(qrow + C_NQ + head * 64 + i * 16 + kb * 8);
    f32x16 a0 = zero16(), a1 = zero16(); float m = -1e30f, l = 0.f;
    for (int kt = 0; kt <= qt; ++kt) {
      const int j = kt >> 1;
      const unsigned mw = j < 32 ? mk0 : (j < 64 ? mk1 : (j < 96 ? mk2 : mk3));
      const bool bit = (mw >> (j & 31)) & 1u;
      if (__ballot(bit) == 0ull) continue;
      attn_tile(ksel + (size_t)(kt * 32 + l32) * PW, vsT, qf, kt * 32, tq, -1, bit, kb, a0, a1, m, l);
    }
    float lt = l + __shfl_xor(l, 32);
    const float g1 = sigmoidf_(bf2f(qrow[C_NG + head * 3 + 1]) + P.nsa_gate_b[head * 3 + 1]);
    const float f1 = g1 / fmaxf(lt, 1e-30f);
    f32x16 w0 = zero16(), w1 = zero16(); m = -1e30f; l = 0.f;
    const int ktb = qt > 16 ? qt - 16 : 0;
    for (int kt = ktb; kt <= qt; ++kt)
      attn_tile(kwin + (size_t)(kt * 32 + l32) * PW, vwT, qf, kt * 32, tq, tq - 512, true, kb, w0, w1, m, l);
    lt = l + __shfl_xor(l, 32);
    const float g2 = sigmoidf_(bf2f(qrow[C_NG + head * 3 + 2]) + P.nsa_gate_b[head * 3 + 2]);
    const float f2 = g2 / fmaxf(lt, 1e-30f);
#pragma unroll
    for (int gq = 0; gq < 4; ++gq) {
      bf16_t* d0 = mix + tokq * DM + 512 + head * 64 + 8 * gq + 4 * kb;
      bf16_t* d1 = d0 + 32;
      const u32x2 p0 = *(const u32x2*)d0, p1 = *(const u32x2*)d1;
      u32x2 u0, u1;
      u0[0] = pk2(bflo(p0[0]) + f1 * a0[gq * 4] + f2 * w0[gq * 4], bfhi(p0[0]) + f1 * a0[gq * 4 + 1] + f2 * w0[gq * 4 + 1]);
      u0[1] = pk2(bflo(p0[1]) + f1 * a0[gq * 4 + 2] + f2 * w0[gq * 4 + 2], bfhi(p0[1]) + f1 * a0[gq * 4 + 3] + f2 * w0[gq * 4 + 3]);
      u1[0] = pk2(bflo(p1[0]) + f1 * a1[gq * 4] + f2 * w1[gq * 4], bfhi(p1[0]) + f1 * a1[gq * 4 + 1] + f2 * w1[gq * 4 + 1]);
      u1[1] = pk2(bflo(p1[1]) + f1 * a1[gq * 4 + 2] + f2 * w1[gq * 4 + 2], bfhi(p1[1]) + f1 * a1[gq * 4 + 3] + f2 * w1[gq * 4 + 3]);
      *(u32x2*)d0 = u0; *(u32x2*)d1 = u1;
    }
  }
  asm volatile("s_waitcnt lgkmcnt(0)" ::: "memory");
}

DI void sgu_item(const Params& P, int item, char* smem) {
  bf16_t* H = (bf16_t*)(P.ws + R1);
  float* smu = (float*)smem; float* srs = smu + 128; float* sc1 = srs + 128; float* srw = sc1 + 128;
  bf16_t* sW = (bf16_t*)(srw + 128); bf16_t* sV = sW + 128 * 136;
  const int tid = threadIdx.x, lane = tid & 63, wave = tid >> 6, l32 = lane & 31, kb = lane >> 5;
  const size_t tok0 = (size_t)item * 128;
  for (int tt = 0; tt < 32; ++tt) {
    const int t = wave * 32 + tt;
    const bf16_t* vr = H + (tok0 + t) * 4096 + 2048;
    float s = 0.f, s2 = 0.f;
#pragma unroll
    for (int k = 0; k < 4; ++k) {
      const u32x4 u = *(const u32x4*)(vr + k * 512 + lane * 8);
#pragma unroll
      for (int e = 0; e < 4; ++e) { const float a = bflo(u[e]), c = bfhi(u[e]); s += a + c; s2 += a * a + c * c; }
    }
    s = wave_sum(s); s2 = wave_sum(s2);
    const float mu = s * (1.f / 2048.f);
    const float var = fmaxf(s2 * (1.f / 2048.f) - mu * mu, 0.f);
    if (lane == 0) { smu[t] = mu; srs[t] = rsqrtf(var + EPS); }
  }
  __syncthreads();
  for (int g = 0; g < 8; ++g) {
    {
      const int t = tid >> 1, half = tid & 1;
      const float* wrow = P.o_w_s + ((size_t)g * 128 + t) * 128 + half * 64;
      float c1 = 0.f, rw = 0.f;
#pragma unroll 1
      for (int c8 = 0; c8 < 8; ++c8) {
        const float4 f0 = *(const float4*)(wrow + c8 * 8), f1 = *(const float4*)(wrow + c8 * 8 + 4);
        float wv[8] = {f0.x, f0.y, f0.z, f0.w, f1.x, f1.y, f1.z, f1.w};
        float ov[8];
#pragma unroll
        for (int e = 0; e < 8; ++e) {
          const int s = half * 64 + c8 * 8 + e;
          const float w = (s <= t) ? wv[e] : 0.f;
          rw += w;
          const float wp = bf2f(f2bf(w * srs[s]));
          c1 += wp * smu[s];
          ov[e] = wp;
        }
        u32x4 o; o[0] = pk2(ov[0], ov[1]); o[1] = pk2(ov[2], ov[3]); o[2] = pk2(ov[4], ov[5]); o[3] = pk2(ov[6], ov[7]);
        *(u32x4*)(sW + t * 136 + half * 64 + c8 * 8) = o;
      }
      c1 += __shfl_xor(c1, 1); rw += __shfl_xor(rw, 1);
      if (half == 0) { sc1[t] = c1; srw[t] = rw; }
    }
    for (int sub = 0; sub < 4; ++sub) {
      const int ch0 = g * 256 + sub * 64;
      {
        const int s = tid >> 1, half = tid & 1;
        const bf16_t* src = H + (tok0 + s) * 4096 + 2048 + ch0 + half * 32;
#pragma unroll
        for (int c = 0; c < 4; ++c) {
          const u32x4 u = *(const u32x4*)(src + c * 8);
#pragma unroll
          for (int e = 0; e < 4; ++e) {
            sV[(half * 32 + c * 8 + 2 * e) * 136 + s] = (bf16_t)(u[e] & 0xffffu);
            sV[(half * 32 + c * 8 + 2 * e + 1) * 136 + s] = (bf16_t)(u[e] >> 16);
          }
        }
      }
      __syncthreads();
      f32x16 acc0 = zero16(), acc1 = zero16();
      const int nks = 2 * (wave + 1);
      for (int ks = 0; ks < nks; ++ks) {
        const bf16x8 a = *(const bf16x8*)(sW + (wave * 32 + l32) * 136 + ks * 16 + kb * 8);
        const bf16x8 b0 = *(const bf16x8*)(sV + (l32)*136 + ks * 16 + kb * 8);
        const bf16x8 b1 = *(const bf16x8*)(sV + (32 + l32) * 136 + ks * 16 + kb * 8);
        acc0 = mfma(a, b0, acc0); acc1 = mfma(a, b1, acc1);
      }
#pragma unroll
      for (int ct = 0; ct < 2; ++ct) {
        const int ch = ch0 + ct * 32 + l32;
        const float lg = P.o_ln_g[ch], lb = P.o_ln_b[ch];
#pragma unroll
        for (int r = 0; r < 16; ++r) {
          const int t = wave * 32 + crow(r, kb);
          const float a = ct ? acc1[r] : acc0[r];
          const float mixed = lg * (a - sc1[t]) + lb * srw[t] + P.o_b_s[g * 128 + t];
          bf16_t* hp = H + (tok0 + t) * 4096;
          const float u = bf2f(hp[ch]);
          hp[2048 + ch] = f2bf(u * mixed);
        }
      }
      __syncthreads();
    }
  }
}

constexpr int NPHASE = 17;
DI void run_phase(const Params& P, int ph, char* smem) {
  char* ws = P.ws;
  bf16_t* r1 = (bf16_t*)(ws + R1); bf16_t* r2 = (bf16_t*)(ws + R2); bf16_t* r3 = (bf16_t*)(ws + R3); bf16_t* r4 = (bf16_t*)(ws + R4);
  unsigned* cnt = (unsigned*)(ws + W_CNT);
  const int lane = threadIdx.x & 63, wave = threadIdx.x >> 6;
  switch (ph) {
    case 0: phase_prep(P); break;
    case 1: gemm_phase<0>(r2, 1024, (const bf16_t*)(ws + W_EIN), 1024, 23, r1, PW, smem); break;
    case 2: {
      nsa_transpose_v(P);
      if (blockIdx.x < 128) nsa_compress_task(P, blockIdx.x * 4 + wave);
      volatile int* s_item = (volatile int*)(smem + 65536 - 16);
      for (;;) {
        __syncthreads();
        if (threadIdx.x == 0) *s_item = (int)atomicAdd(cnt + 0, 1u);
        __syncthreads();
        const int item = *s_item;
        if (item >= 4096) break;
        gla_p1_item(P, item, smem);
      }
    } break;
    case 3: {
      gla_scan(P);
      float* imp = (float*)smem + wave * 4096;
      for (;;) {
        int tk = 0;
        if (lane == 0) tk = (int)atomicAdd(cnt + 1, 1u);
        tk = __builtin_amdgcn_readfirstlane(tk);
        if (tk >= 4096) break;
        const int qt = 255 - (tk >> 4), bg = tk & 15;
        nsa_task(P, bg >> 1, bg & 1, qt, imp);
      }
    } break;
    case 4:
      for (int item = blockIdx.x; item < 4096; item += gridDim.x) gla_p3_item(P, item, smem);
      break;
    case 5: gemm_phase<0>(r3, 1024, (const bf16_t*)(ws + W_EOUT), 1024, 8, r4, 1024, smem); break;
    case 6: resnorm_rows(r4, P.x, P.out, P.norm_g + 1 * 1024, P.norm_g + 2 * 1024, r2); break;
    case 7: gemm_phase<1>(r2, 1024, (const bf16_t*)(ws + W_FFN1_0), 1024, 32, r1, 4096, smem); break;
    case 8: gemm_phase<0>(r1, 4096, (const bf16_t*)(ws + W_FFN2_0), 4096, 8, r4, 1024, smem); break;
    case 9: resnorm_rows(r4, P.out, P.out, P.norm_g + 3 * 1024, P.norm_g + 4 * 1024, r2); break;
    case 10: gemm_phase<2>(r2, 1024, (const bf16_t*)(ws + W_OIN), 1024, 32, r1, 4096, smem); break;
    case 11:
      for (int item = blockIdx.x; item < 512; item += gridDim.x) sgu_item(P, item, smem);
      break;
    case 12: gemm_phase<0>(r1 + 2048, 4096, (const bf16_t*)(ws + W_OOUT), 2048, 8, r4, 1024, smem); break;
    case 13: resnorm_rows(r4, P.out, P.out, P.norm_g + 5 * 1024, P.norm_g + 6 * 1024, r2); break;
    case 14: gemm_phase<1>(r2, 1024, (const bf16_t*)(ws + W_FFN1_1), 1024, 32, r1, 4096, smem); break;
    case 15: gemm_phase<0>(r1, 4096, (const bf16_t*)(ws + W_FFN2_1), 4096, 8, r4, 1024, smem); break;
    case 16: resnorm_rows(r4, P.out, P.out, P.norm_g + 7 * 1024, nullptr, nullptr); break;
    default: break;
  }
}

#if !MEGA
__global__ void __launch_bounds__(256, 2) k_phase(Params P, int ph) {
  __shared__ __attribute__((aligned(16))) char smem[65536];
  run_phase(P, ph, smem);
}
#endif

#if MEGA
__global__ void __launch_bounds__(256, 2) k_mega(Params P) {
  __shared__ __attribute__((aligned(16))) char smem[65536];
  cg::grid_group grid = cg::this_grid();
  run_phase(P, 0, smem); grid.sync();
  run_phase(P, 1, smem); grid.sync();
  run_phase(P, 2, smem); grid.sync();
  run_phase(P, 3, smem); grid.sync();
  run_phase(P, 4, smem); grid.sync();
  run_phase(P, 5, smem); grid.sync();
  run_phase(P, 6, smem); grid.sync();
  run_phase(P, 7, smem); grid.sync();
  run_phase(P, 8, smem); grid.sync();
  run_phase(P, 9, smem); grid.sync();
  run_phase(P, 10, smem); grid.sync();
  run_phase(P, 11, smem); grid.sync();
  run_phase(P, 12, smem); grid.sync();
  run_phase(P, 13, smem); grid.sync();
  run_phase(P, 14, smem); grid.sync();
  run_phase(P, 15, smem); grid.sync();
  run_phase(P, 16, smem);
}
#endif

extern "C" void kernel_launch(void* const* d_in, const int* in_sizes, int n_in, void* d_out, int out_size, void* d_ws, size_t ws_size,
                              hipStream_t stream) {
  Params p{};
  p.x = (const float*)d_in[0]; p.norm_g = (const float*)d_in[1]; p.ffn_w1 = (const float*)d_in[2]; p.ffn_w2 = (const float*)d_in[3];
  p.e_w_in = (const float*)d_in[4]; p.e_w_out = (const float*)d_in[5]; p.gla_w_gate = (const float*)d_in[6]; p.gla_b_gate = (const float*)d_in[7];
  p.gla_norm = (const float*)d_in[8]; p.nsa_gate_b = (const float*)d_in[9]; p.cmp_pos = (const float*)d_in[10]; p.cmp_w1 = (const float*)d_in[11];
  p.cmp_w2 = (const float*)d_in[12]; p.o_w_in = (const float*)d_in[13]; p.o_ln_g = (const float*)d_in[14]; p.o_ln_b = (const float*)d_in[15];
  p.o_w_s = (const float*)d_in[16]; p.o_b_s = (const float*)d_in[17]; p.o_w_out = (const float*)d_in[18];
  p.out = (float*)d_out; p.ws = (char*)d_ws;
  if (ws_size < 1024ull * MiB) { fprintf(stderr, "workspace too small: %zu\n", ws_size); return; }
  static int grid_blocks = 0;
  if (!grid_blocks) {
    int dev = 0, cus = 0, per_cu = 0;
    hipGetDevice(&dev);
    hipDeviceGetAttribute(&cus, hipDeviceAttributeMultiprocessorCount, dev);
#if MEGA
    hipOccupancyMaxActiveBlocksPerMultiprocessor(&per_cu, k_mega, 256, 0);
#else
    hipOccupancyMaxActiveBlocksPerMultiprocessor(&per_cu, k_phase, 256, 0);
#endif
    if (per_cu < 1) per_cu = 1;
    if (per_cu > 2) per_cu = 2;
    grid_blocks = cus * per_cu;
  }
#if MEGA
  void* args[] = {&p};
  hipError_t e = hipLaunchCooperativeKernel((void*)k_mega, dim3(grid_blocks), dim3(256), args, 0, stream);
  if (e != hipSuccess) fprintf(stderr, "cooperative launch failed: %s (grid %d)\n", hipGetErrorString(e), grid_blocks);
#else
  for (int ph = 0; ph < NPHASE; ++ph) k_phase<<<grid_blocks, 256, 0, stream>>>(p, ph);
#endif
}
```

```cpp
#include <hip/hip_runtime.h>
#include <hip/hip_cooperative_groups.h>
#include <cstdio>
namespace cg = cooperative_groups;

#ifndef MEGA
#define MEGA 1
#endif

typedef unsigned short bf16_t;
typedef short bf16x8 __attribute__((ext_vector_type(8)));
typedef short s16x4 __attribute__((ext_vector_type(4)));
typedef float f32x16 __attribute__((ext_vector_type(16)));
typedef float f32v2 __attribute__((ext_vector_type(2)));
typedef __bf16 bf16v2 __attribute__((ext_vector_type(2)));
typedef unsigned u32x4 __attribute__((ext_vector_type(4)));
typedef unsigned u32x2 __attribute__((ext_vector_type(2)));
#define DI __device__ __forceinline__

constexpr int T_TOK = 65536, SEQ = 8192, DM = 1024;
constexpr int PW = 2944;
constexpr int C_GQ = 0, C_GK = 256, C_GV = 512, C_GLR = 1024, C_GR = 1040, C_NQ = 1552, C_KC = 2064, C_VC = 2192,
              C_KS = 2320, C_VS = 2448, C_KW = 2576, C_VW = 2704, C_NG = 2832;
constexpr float EPS = 1e-6f;
constexpr size_t MiB = 1024ull * 1024ull;
constexpr size_t W_FFN1_0 = 0, W_FFN1_1 = 8 * MiB, W_FFN2_0 = 16 * MiB, W_FFN2_1 = 24 * MiB, W_EIN = 32 * MiB, W_EOUT = 38 * MiB,
                 W_OIN = 40 * MiB, W_OOUT = 48 * MiB, W_CW1 = 52 * MiB, W_CW2 = 53 * MiB, W_BIAS1 = 53 * MiB + 65536,
                 W_CNT = 53 * MiB + 131072;
constexpr size_t R1 = 64 * MiB, R2 = 576 * MiB, R3 = 704 * MiB, R4 = 832 * MiB, R5 = 960 * MiB;
constexpr size_t R_KCMP = R5, R_VCMPT = R5 + 1 * MiB, R_VST = R5 + 2 * MiB, R_VWT = R5 + 18 * MiB, R_DECAY = R5 + 34 * MiB;

struct Params {
  const float* x; const float* norm_g; const float* ffn_w1; const float* ffn_w2; const float* e_w_in; const float* e_w_out;
  const float* gla_w_gate; const float* gla_b_gate; const float* gla_norm; const float* nsa_gate_b; const float* cmp_pos;
  const float* cmp_w1; const float* cmp_w2; const float* o_w_in; const float* o_ln_g; const float* o_ln_b; const float* o_w_s;
  const float* o_b_s; const float* o_w_out;
  float* out; char* ws;
};

DI int crow(int r, int kb) { return (r & 3) + 8 * (r >> 2) + 4 * kb; }
DI f32x16 mfma(bf16x8 a, bf16x8 b, f32x16 c) { return __builtin_amdgcn_mfma_f32_32x32x16_bf16(a, b, c, 0, 0, 0); }
DI unsigned pk2(float a, float b) { f32v2 v = {a, b}; bf16v2 r = __builtin_convertvector(v, bf16v2); return __builtin_bit_cast(unsigned, r); }
DI bf16_t f2bf(float a) { return (bf16_t)(pk2(a, 0.f) & 0xffffu); }
DI float bf2f(bf16_t u) { return __uint_as_float(((unsigned)u) << 16); }
DI float bflo(unsigned u) { return __uint_as_float(u << 16); }
DI float bfhi(unsigned u) { return __uint_as_float(u & 0xffff0000u); }
DI bf16x8 pack8(float a0, float a1, float a2, float a3, float a4, float a5, float a6, float a7) {
  u32x4 p; p[0] = pk2(a0, a1); p[1] = pk2(a2, a3); p[2] = pk2(a4, a5); p[3] = pk2(a6, a7);
  return __builtin_bit_cast(bf16x8, p);
}
DI bf16x8 ld2x4(const bf16_t* p) {
  s16x4 lo = *(const s16x4*)p; s16x4 hi = *(const s16x4*)(p + 8);
  return __builtin_shufflevector(lo, hi, 0, 1, 2, 3, 4, 5, 6, 7);
}
DI float wave_sum(float v) {
#pragma unroll
  for (int o = 32; o > 0; o >>= 1) v += __shfl_xor(v, o);
  return v;
}
DI f32x16 zero16() { f32x16 z;
#pragma unroll
  for (int i = 0; i < 16; ++i) z[i] = 0.f; return z; }
DI float gelu_tanh(float x) { float u = 1.5957691216f * (x + 0.044715f * x * x * x); return x / (1.f + __expf(-u)); }
DI float sigmoidf_(float x) { return 1.f / (1.f + __expf(-x)); }

DI void conv_weight(const float* __restrict__ src, bf16_t* __restrict__ dst, int K, int N, int Npad) {
  const long total = (long)Npad * (K >> 3);
  const long stride = (long)gridDim.x * blockDim.x;
  for (long i = (long)blockIdx.x * blockDim.x + threadIdx.x; i < total; i += stride) {
    const int n = (int)(i % Npad); const int k8 = (int)(i / Npad);
    float v[8];
#pragma unroll
    for (int j = 0; j < 8; ++j) v[j] = (n < N) ? src[(size_t)(k8 * 8 + j) * N + n] : 0.f;
    u32x4 o; o[0] = pk2(v[0], v[1]); o[1] = pk2(v[2], v[3]); o[2] = pk2(v[4], v[5]); o[3] = pk2(v[6], v[7]);
    *(u32x4*)(dst + (size_t)n * K + k8 * 8) = o;
  }
}

DI void prenorm_rows(const float* __restrict__ x, const float* __restrict__ g, bf16_t* __restrict__ xn) {
  const int lane = threadIdx.x & 63, wave = threadIdx.x >> 6;
  const int nw = gridDim.x * 4;
  for (int row = blockIdx.x * 4 + wave; row < T_TOK; row += nw) {
    const float4* xr = (const float4*)(x + (size_t)row * DM);
    float4 a[4]; float ss = 0.f;
#pragma unroll
    for (int k = 0; k < 4; ++k) { a[k] = xr[k * 64 + lane]; ss += a[k].x * a[k].x + a[k].y * a[k].y + a[k].z * a[k].z + a[k].w * a[k].w; }
    ss = wave_sum(ss);
    const float rs = rsqrtf(ss * (1.f / DM) + EPS);
#pragma unroll
    for (int k = 0; k < 4; ++k) {
      const float4 gg = ((const float4*)g)[k * 64 + lane];
      u32x2 o; o[0] = pk2(a[k].x * rs * gg.x, a[k].y * rs * gg.y); o[1] = pk2(a[k].z * rs * gg.z, a[k].w * rs * gg.w);
      *(u32x2*)(xn + (size_t)row * DM + k * 256 + lane * 4) = o;
    }
  }
}

DI void resnorm_rows(const bf16_t* __restrict__ m, const float* hin, float* hout, const float* __restrict__ gpost,
                             const float* __restrict__ gnext, bf16_t* __restrict__ xn) {
  const int lane = threadIdx.x & 63, wave = threadIdx.x >> 6;
  const int nw = gridDim.x * 4;
  for (int row = blockIdx.x * 4 + wave; row < T_TOK; row += nw) {
    float mv[16]; float ss = 0.f;
#pragma unroll
    for (int k = 0; k < 4; ++k) {
      const u32x2 u = *(const u32x2*)(m + (size_t)row * DM + k * 256 + lane * 4);
      mv[k * 4 + 0] = bflo(u[0]); mv[k * 4 + 1] = bfhi(u[0]); mv[k * 4 + 2] = bflo(u[1]); mv[k * 4 + 3] = bfhi(u[1]);
    }
#pragma unroll
    for (int i = 0; i < 16; ++i) ss += mv[i] * mv[i];
    ss = wave_sum(ss);
    const float rs = rsqrtf(ss * (1.f / DM) + EPS);
    float hv[16]; float s2 = 0.f;
#pragma unroll
    for (int k = 0; k < 4; ++k) {
      const float4 h4 = ((const float4*)(hin + (size_t)row * DM))[k * 64 + lane];
      const float4 gg = ((const float4*)gpost)[k * 64 + lane];
      hv[k * 4 + 0] = h4.x + mv[k * 4 + 0] * rs * gg.x; hv[k * 4 + 1] = h4.y + mv[k * 4 + 1] * rs * gg.y;
      hv[k * 4 + 2] = h4.z + mv[k * 4 + 2] * rs * gg.z; hv[k * 4 + 3] = h4.w + mv[k * 4 + 3] * rs * gg.w;
      float4 o; o.x = hv[k * 4 + 0]; o.y = hv[k * 4 + 1]; o.z = hv[k * 4 + 2]; o.w = hv[k * 4 + 3];
      ((float4*)(hout + (size_t)row * DM))[k * 64 + lane] = o;
    }
    if (xn) {
#pragma unroll
      for (int i = 0; i < 16; ++i) s2 += hv[i] * hv[i];
      s2 = wave_sum(s2);
      const float r2 = rsqrtf(s2 * (1.f / DM) + EPS);
#pragma unroll
      for (int k = 0; k < 4; ++k) {
        const float4 gg = ((const float4*)gnext)[k * 64 + lane];
        u32x2 o; o[0] = pk2(hv[k * 4 + 0] * r2 * gg.x, hv[k * 4 + 1] * r2 * gg.y); o[1] = pk2(hv[k * 4 + 2] * r2 * gg.z, hv[k * 4 + 3] * r2 * gg.w);
        *(u32x2*)(xn + (size_t)row * DM + k * 256 + lane * 4) = o;
      }
    }
  }
}

DI void phase_prep(const Params& P) {
  char* ws = P.ws;
  conv_weight(P.ffn_w1, (bf16_t*)(ws + W_FFN1_0), 1024, 4096, 4096);
  conv_weight(P.ffn_w1 + (size_t)1024 * 4096, (bf16_t*)(ws + W_FFN1_1), 1024, 4096, 4096);
  conv_weight(P.ffn_w2, (bf16_t*)(ws + W_FFN2_0), 4096, 1024, 1024);
  conv_weight(P.ffn_w2 + (size_t)1024 * 4096, (bf16_t*)(ws + W_FFN2_1), 4096, 1024, 1024);
  conv_weight(P.e_w_in, (bf16_t*)(ws + W_EIN), 1024, 2856, PW);
  conv_weight(P.e_w_out, (bf16_t*)(ws + W_EOUT), 1024, 1024, 1024);
  conv_weight(P.o_w_in, (bf16_t*)(ws + W_OIN), 1024, 4096, 4096);
  conv_weight(P.o_w_out, (bf16_t*)(ws + W_OOUT), 2048, 1024, 1024);
  conv_weight(P.cmp_w1, (bf16_t*)(ws + W_CW1), 2048, 128, 128);
  conv_weight(P.cmp_w1 + 2048 * 128, (bf16_t*)(ws + W_CW1) + 128 * 2048, 2048, 128, 128);
  conv_weight(P.cmp_w2, (bf16_t*)(ws + W_CW2), 128, 64, 64);
  conv_weight(P.cmp_w2 + 128 * 64, (bf16_t*)(ws + W_CW2) + 64 * 128, 128, 64, 64);
  const int lane = threadIdx.x & 63, wave = threadIdx.x >> 6;
  const int gw = blockIdx.x * 4 + wave;
  if (gw < 256) {
    const int i = gw >> 7, hid = gw & 127;
    float s = 0.f;
    for (int kk = lane; kk < 2048; kk += 64) s += P.cmp_pos[i * 2048 + kk] * P.cmp_w1[((size_t)i * 2048 + kk) * 128 + hid];
    s = wave_sum(s);
    if (lane == 0) ((float*)(ws + W_BIAS1))[gw] = s;
  }
  const int gt = blockIdx.x * blockDim.x + threadIdx.x;
  if (gt < 16) ((unsigned*)(ws + W_CNT))[gt] = 0u;
  if (gt < 16 * 64) {
    const int bg = gt >> 6, d = gt & 63;
    ((bf16_t*)(ws + R_KCMP))[((size_t)bg * 512 + 511) * 64 + d] = 0;
    ((bf16_t*)(ws + R_VCMPT))[((size_t)bg * 64 + d) * 512 + 511] = 0;
  }
  prenorm_rows(P.x, P.norm_g, (bf16_t*)(ws + R2));
}

template <int EPI>
DI void gemm_phase(const bf16_t* __restrict__ A, int lda, const bf16_t* __restrict__ Bt, int K, int NT,
                           bf16_t* __restrict__ C, int ldc, char* smem) {
  bf16_t* sA = (bf16_t*)smem; bf16_t* sB = sA + 128 * 72;
  const int tid = threadIdx.x, lane = tid & 63, wave = tid >> 6, l32 = lane & 31, kb = lane >> 5;
  const int wr = wave >> 1, wc = wave & 1;
  const int nkt = K >> 6;
  const int ntiles = 512 * NT;
  const int lrow = tid >> 3, lcol = (tid & 7) * 8;
  for (int tile = blockIdx.x; tile < ntiles; tile += gridDim.x) {
    const int mt = tile / NT, nt = tile - mt * NT;
    const bf16_t* Ag = A + (size_t)(mt * 128 + lrow) * lda + lcol;
    const bf16_t* Bg = Bt + (size_t)(nt * 128 + lrow) * K + lcol;
    f32x16 acc[2][2];
#pragma unroll
    for (int i = 0; i < 2; ++i)
#pragma unroll
      for (int j = 0; j < 2; ++j) acc[i][j] = zero16();
    u32x4 ra[4], rb[4];
#pragma unroll
    for (int i = 0; i < 4; ++i) { ra[i] = *(const u32x4*)(Ag + (size_t)(32 * i) * lda); rb[i] = *(const u32x4*)(Bg + (size_t)(32 * i) * K); }
    for (int kt = 0; kt < nkt; ++kt) {
      __syncthreads();
#pragma unroll
      for (int i = 0; i < 4; ++i) { *(u32x4*)(sA + (lrow + 32 * i) * 72 + lcol) = ra[i]; *(u32x4*)(sB + (lrow + 32 * i) * 72 + lcol) = rb[i]; }
      __syncthreads();
      if (kt + 1 < nkt) {
        const int k0 = (kt + 1) * 64;
#pragma unroll
        for (int i = 0; i < 4; ++i) { ra[i] = *(const u32x4*)(Ag + (size_t)(32 * i) * lda + k0); rb[i] = *(const u32x4*)(Bg + (size_t)(32 * i) * K + k0); }
      }
#pragma unroll
      for (int kk = 0; kk < 4; ++kk) {
        const bf16x8 a0 = *(const bf16x8*)(sA + (wr * 64 + l32) * 72 + kk * 16 + kb * 8);
        const bf16x8 a1 = *(const bf16x8*)(sA + (wr * 64 + 32 + l32) * 72 + kk * 16 + kb * 8);
        const bf16x8 b0 = *(const bf16x8*)(sB + (wc * 64 + l32) * 72 + kk * 16 + kb * 8);
        const bf16x8 b1 = *(const bf16x8*)(sB + (wc * 64 + 32 + l32) * 72 + kk * 16 + kb * 8);
        acc[0][0] = mfma(a0, b0, acc[0][0]); acc[0][1] = mfma(a0, b1, acc[0][1]);
        acc[1][0] = mfma(a1, b0, acc[1][0]); acc[1][1] = mfma(a1, b1, acc[1][1]);
      }
    }
#pragma unroll
    for (int mi = 0; mi < 2; ++mi)
#pragma unroll
      for (int ni = 0; ni < 2; ++ni)
#pragma unroll
        for (int r = 0; r < 16; ++r) {
          const int row = mt * 128 + wr * 64 + mi * 32 + crow(r, kb);
          const int col = nt * 128 + wc * 64 + ni * 32 + l32;
          float v = acc[mi][ni][r];
          if (EPI == 1) { v = fmaxf(v, 0.f); v = v * v; }
          if (EPI == 2) { v = gelu_tanh(v); }
          C[(size_t)row * ldc + col] = f2bf(v);
        }
  }
}

DI void gla_gates(const Params& P, const bf16_t* proj, int b, int h, int n, float* sb, float* sseg, float* tmp) {
  const int tid = threadIdx.x;
  float* sw = tmp;
  float* sg = tmp + 1024;
  {
    for (int e = tid; e < 1024; e += 256) sw[e] = P.gla_w_gate[(e >> 6) * 256 + h * 64 + (e & 63)];
    const int i = tid >> 2, part = tid & 3;
    const size_t t = (size_t)b * SEQ + n * 64 + i;
    const u32x2 gu = *(const u32x2*)(proj + t * PW + C_GLR + part * 4);
    sg[i * 17 + part * 4 + 0] = bflo(gu[0]); sg[i * 17 + part * 4 + 1] = bfhi(gu[0]);
    sg[i * 17 + part * 4 + 2] = bflo(gu[1]); sg[i * 17 + part * 4 + 3] = bfhi(gu[1]);
  }
  __syncthreads();
  {
    const int i = tid & 63, dq = tid >> 6;
    float z[16];
#pragma unroll
    for (int dd = 0; dd < 16; ++dd) z[dd] = P.gla_b_gate[h * 64 + dq * 16 + dd];
#pragma unroll 1
    for (int r = 0; r < 16; ++r) {
      const float gv = sg[i * 17 + r];
#pragma unroll
      for (int dd = 0; dd < 16; ++dd) z[dd] += gv * sw[r * 64 + dq * 16 + dd];
    }
#pragma unroll
    for (int dd = 0; dd < 16; ++dd) {
      const float zz = z[dd];
      const float ls = fminf(zz, 0.f) - __logf(1.f + __expf(-fabsf(zz)));
      sb[i * 65 + dq * 16 + dd] = ls * (1.f / 16.f);
    }
  }
  __syncthreads();
  const int d = tid & 63, seg = tid >> 6;
  float pre[16]; float run = 0.f;
#pragma unroll
  for (int ii = 0; ii < 16; ++ii) { run += sb[(seg * 16 + ii) * 65 + d]; pre[ii] = run; }
  sseg[seg * 64 + d] = run;
  __syncthreads();
  float off = 0.f;
#pragma unroll
  for (int s = 0; s < 4; ++s) off += (s < seg) ? sseg[s * 64 + d] : 0.f;
#pragma unroll
  for (int ii = 0; ii < 16; ++ii) sb[(seg * 16 + ii) * 65 + d] = pre[ii] + off;
  __syncthreads();
}

DI void gla_stage_vT(const bf16_t* proj, int b, int h, int n, bf16_t* vT) {
  const int tid = threadIdx.x, j = tid & 63, q4 = tid >> 6;
  const size_t t = (size_t)b * SEQ + n * 64 + j;
  const bf16_t* src = proj + t * PW + C_GV + h * 128 + q4 * 32;
#pragma unroll
  for (int c = 0; c < 4; ++c) {
    const u32x4 u = *(const u32x4*)(src + c * 8);
#pragma unroll
    for (int e = 0; e < 4; ++e) {
      vT[(q4 * 32 + c * 8 + 2 * e) * 72 + j] = (bf16_t)(u[e] & 0xffffu);
      vT[(q4 * 32 + c * 8 + 2 * e + 1) * 72 + j] = (bf16_t)(u[e] >> 16);
    }
  }
}

DI void gla_p1_item(const Params& P, int item, char* smem) {
  const bf16_t* proj = (const bf16_t*)(P.ws + R1);
  float* states = (float*)(P.ws + R2);
  float* decay = (float*)(P.ws + R_DECAY);
  float* sb = (float*)smem; float* sseg = sb + 64 * 65;
  bf16_t* kendT = (bf16_t*)(sseg + 256); bf16_t* vT = kendT + 64 * 72;
  const int n = item & 127, h = (item >> 7) & 3, b = item >> 9;
  const int tid = threadIdx.x, lane = tid & 63, wave = tid >> 6, l32 = lane & 31, kb = lane >> 5;
  gla_gates(P, proj, b, h, n, sb, sseg, (float*)vT);
  {
    const int j = tid & 63, dq = tid >> 6;
    const size_t t = (size_t)b * SEQ + n * 64 + j;
    const u32x4 k0 = *(const u32x4*)(proj + t * PW + C_GK + h * 64 + dq * 16), k1 = *(const u32x4*)(proj + t * PW + C_GK + h * 64 + dq * 16 + 8);
    float kv[16];
#pragma unroll
    for (int e = 0; e < 4; ++e) { kv[2 * e] = bflo(k0[e]); kv[2 * e + 1] = bfhi(k0[e]); kv[8 + 2 * e] = bflo(k1[e]); kv[8 + 2 * e + 1] = bfhi(k1[e]); }
#pragma unroll
    for (int dd = 0; dd < 16; ++dd) {
      const int d = dq * 16 + dd;
      kendT[d * 72 + j] = f2bf(kv[dd] * __expf(sb[63 * 65 + d] - sb[j * 65 + d]));
    }
    if (tid < 64) decay[((size_t)(b * 4 + h) * 128 + n) * 64 + tid] = __expf(sb[63 * 65 + tid]);
  }
  gla_stage_vT(proj, b, h, n, vT);
  __syncthreads();
#pragma unroll
  for (int dt = 0; dt < 2; ++dt) {
    f32x16 acc = zero16();
#pragma unroll
    for (int s = 0; s < 4; ++s) {
      const bf16x8 a = *(const bf16x8*)(vT + (wave * 32 + l32) * 72 + s * 16 + kb * 8);
      const bf16x8 bb = *(const bf16x8*)(kendT + (dt * 32 + l32) * 72 + s * 16 + kb * 8);
      acc = mfma(a, bb, acc);
    }
    float* dst = states + ((size_t)((b * 4 + h) * 128 + n) * 128) * 64;
#pragma unroll
    for (int r = 0; r < 16; ++r) dst[(size_t)(wave * 32 + crow(r, kb)) * 64 + dt * 32 + l32] = acc[r];
  }
  __syncthreads();
}

DI void gla_scan(const Params& P) {
  float* states = (float*)(P.ws + R2);
  const float* decay = (const float*)(P.ws + R_DECAY);
  const int total = 32 * 8192;
  for (int e = blockIdx.x * blockDim.x + threadIdx.x; e < total; e += gridDim.x * blockDim.x) {
    const int bh = e >> 13, idx = e & 8191, d = idx & 63;
    float* p = states + (size_t)bh * 128 * 8192 + idx;
    const float* dc = decay + (size_t)bh * 128 * 64 + d;
    float S = 0.f;
#pragma unroll 8
    for (int n = 0; n < 128; ++n) {
      const float ds = p[(size_t)n * 8192];
      const float dec = dc[n * 64];
      p[(size_t)n * 8192] = S;
      S = dec * S + ds;
    }
  }
}

DI void gla_p3_item(const Params& P, int item, char* smem) {
  const bf16_t* proj = (const bf16_t*)(P.ws + R1);
  const float* states = (const float*)(P.ws + R2);
  bf16_t* mix = (bf16_t*)(P.ws + R3);
  float* sb = (float*)smem; float* sseg = sb + 64 * 65; float* sred = sseg + 256;
  bf16_t* sq = (bf16_t*)(sred + 256); bf16_t* sk = sq + 64 * 72; bf16_t* vT = sk + 64 * 72;
  const int n = item & 127, h = (item >> 7) & 3, b = item >> 9;
  const int tid = threadIdx.x, lane = tid & 63, wave = tid >> 6, l32 = lane & 31, kb = lane >> 5;
  gla_gates(P, proj, b, h, n, sb, sseg, (float*)vT);
  {
    const int i = tid & 63, dq = tid >> 6;
    const size_t t = (size_t)b * SEQ + n * 64 + i;
    const u32x4 q0 = *(const u32x4*)(proj + t * PW + C_GQ + h * 64 + dq * 16), q1 = *(const u32x4*)(proj + t * PW + C_GQ + h * 64 + dq * 16 + 8);
    const u32x4 k0 = *(const u32x4*)(proj + t * PW + C_GK + h * 64 + dq * 16), k1 = *(const u32x4*)(proj + t * PW + C_GK + h * 64 + dq * 16 + 8);
    float qv[16], kv[16];
#pragma unroll
    for (int e = 0; e < 4; ++e) {
      qv[2 * e] = bflo(q0[e]); qv[2 * e + 1] = bfhi(q0[e]); qv[8 + 2 * e] = bflo(q1[e]); qv[8 + 2 * e + 1] = bfhi(q1[e]);
      kv[2 * e] = bflo(k0[e]); kv[2 * e + 1] = bfhi(k0[e]); kv[8 + 2 * e] = bflo(k1[e]); kv[8 + 2 * e + 1] = bfhi(k1[e]);
    }
#pragma unroll
    for (int dd = 0; dd < 16; ++dd) {
      const int d = dq * 16 + dd;
      const float bb = sb[i * 65 + d];
      sq[i * 72 + d] = f2bf(qv[dd] * 0.125f * __expf(bb));
      sk[i * 72 + d] = f2bf(kv[dd] * __expf(-bb));
    }
  }
  gla_stage_vT(proj, b, h, n, vT);
  __syncthreads();
  f32x16 x00 = zero16(), x01 = zero16(), x11 = zero16();
#pragma unroll
  for (int s = 0; s < 4; ++s) {
    const bf16x8 kj0 = *(const bf16x8*)(sk + (l32)*72 + s * 16 + kb * 8);
    const bf16x8 kj1 = *(const bf16x8*)(sk + (32 + l32) * 72 + s * 16 + kb * 8);
    const bf16x8 qi0 = *(const bf16x8*)(sq + (l32)*72 + s * 16 + kb * 8);
    const bf16x8 qi1 = *(const bf16x8*)(sq + (32 + l32) * 72 + s * 16 + kb * 8);
    x00 = mfma(kj0, qi0, x00); x01 = mfma(kj0, qi1, x01); x11 = mfma(kj1, qi1, x11);
  }
#pragma unroll
  for (int r = 0; r < 16; ++r) { const bool keep = crow(r, kb) <= l32; x00[r] = keep ? x00[r] : 0.f; x11[r] = keep ? x11[r] : 0.f; }
  f32x16 o0 = zero16(), o1 = zero16();
  const int dvr = wave * 32 + l32;
#pragma unroll
  for (int s = 0; s < 2; ++s) {
    const bf16x8 p00 = pack8(x00[8 * s], x00[8 * s + 1], x00[8 * s + 2], x00[8 * s + 3], x00[8 * s + 4], x00[8 * s + 5], x00[8 * s + 6], x00[8 * s + 7]);
    const bf16x8 p01 = pack8(x01[8 * s], x01[8 * s + 1], x01[8 * s + 2], x01[8 * s + 3], x01[8 * s + 4], x01[8 * s + 5], x01[8 * s + 6], x01[8 * s + 7]);
    const bf16x8 p11 = pack8(x11[8 * s], x11[8 * s + 1], x11[8 * s + 2], x11[8 * s + 3], x11[8 * s + 4], x11[8 * s + 5], x11[8 * s + 6], x11[8 * s + 7]);
    const bf16x8 v0 = ld2x4(vT + dvr * 72 + 16 * s + 4 * kb);
    const bf16x8 v1 = ld2x4(vT + dvr * 72 + 32 + 16 * s + 4 * kb);
    o0 = mfma(v0, p00, o0); o1 = mfma(v0, p01, o1); o1 = mfma(v1, p11, o1);
  }
  {
    const float* sp = states + ((size_t)((b * 4 + h) * 128 + n) * 128 + dvr) * 64;
#pragma unroll
    for (int s = 0; s < 4; ++s) {
      const float4 f0 = *(const float4*)(sp + s * 16 + kb * 8), f1 = *(const float4*)(sp + s * 16 + kb * 8 + 4);
      const bf16x8 a = pack8(f0.x, f0.y, f0.z, f0.w, f1.x, f1.y, f1.z, f1.w);
      const bf16x8 qi0 = *(const bf16x8*)(sq + (l32)*72 + s * 16 + kb * 8);
      const bf16x8 qi1 = *(const bf16x8*)(sq + (32 + l32) * 72 + s * 16 + kb * 8);
      o0 = mfma(a, qi0, o0); o1 = mfma(a, qi1, o1);
    }
  }
  float s0 = 0.f, s1 = 0.f;
#pragma unroll
  for (int r = 0; r < 16; ++r) { s0 += o0[r] * o0[r]; s1 += o1[r] * o1[r]; }
  s0 += __shfl_xor(s0, 32); s1 += __shfl_xor(s1, 32);
  if (kb == 0) { sred[wave * 64 + l32] = s0; sred[wave * 64 + 32 + l32] = s1; }
  __syncthreads();
  const float t0s = sred[l32] + sred[64 + l32] + sred[128 + l32] + sred[192 + l32];
  const float t1s = sred[32 + l32] + sred[64 + 32 + l32] + sred[128 + 32 + l32] + sred[192 + 32 + l32];
  const float r0 = rsqrtf(t0s * (1.f / 128.f) + EPS), r1 = rsqrtf(t1s * (1.f / 128.f) + EPS);
#pragma unroll
  for (int it = 0; it < 2; ++it) {
    const size_t t = (size_t)b * SEQ + n * 64 + it * 32 + l32;
    const float rr = it ? r1 : r0;
#pragma unroll
    for (int gq = 0; gq < 4; ++gq) {
      const int dv = wave * 32 + 8 * gq + 4 * kb;
      const u32x2 ru = *(const u32x2*)(proj + t * PW + C_GR + h * 128 + dv);
      const float4 gn = *(const float4*)(P.gla_norm + h * 128 + dv);
      float rv[4] = {bflo(ru[0]), bfhi(ru[0]), bflo(ru[1]), bfhi(ru[1])};
      float gv[4] = {gn.x, gn.y, gn.z, gn.w};
      float ov[4];
#pragma unroll
      for (int e = 0; e < 4; ++e) {
        const float a = it ? o1[gq * 4 + e] : o0[gq * 4 + e];
        ov[e] = a * rr * gv[e] * (rv[e] / (1.f + __expf(-rv[e])));
      }
      u32x2 o; o[0] = pk2(ov[0], ov[1]); o[1] = pk2(ov[2], ov[3]);
      *(u32x2*)(mix + t * DM + h * 128 + dv) = o;
    }
  }
  __syncthreads();
}

DI void nsa_compress_task(const Params& P, int task) {
  const bf16_t* proj = (const bf16_t*)(P.ws + R1);
  const int lane = threadIdx.x & 63, l32 = lane & 31, kb = lane >> 5;
  const int ct = task & 15, g = (task >> 4) & 1, b = (task >> 5) & 7, br = task >> 8;
  const bf16_t* w1T = (const bf16_t*)(P.ws + W_CW1) + (size_t)br * 128 * 2048;
  const bf16_t* w2T = (const bf16_t*)(P.ws + W_CW2) + (size_t)br * 64 * 128;
  const float* bias1 = (const float*)(P.ws + W_BIAS1) + br * 128;
  const int c = ct * 32 + l32;
  const int cc = c < 511 ? c : 510;
  const bf16_t* src = proj + ((size_t)b * SEQ + cc * 16) * PW + (br ? C_VC : C_KC) + g * 64 + kb * 8;
  f32x16 acc[4];
#pragma unroll
  for (int i = 0; i < 4; ++i) acc[i] = zero16();
#pragma unroll 1
  for (int ks = 0; ks < 128; ++ks) {
    const int l = ks >> 2, dh0 = (ks & 3) * 16;
    const bf16x8 bf = *(const bf16x8*)(src + (size_t)l * PW + dh0);
#pragma unroll
    for (int ht = 0; ht < 4; ++ht) {
      const bf16x8 af = *(const bf16x8*)(w1T + (size_t)(ht * 32 + l32) * 2048 + ks * 16 + kb * 8);
      acc[ht] = mfma(af, bf, acc[ht]);
    }
  }
#pragma unroll
  for (int ht = 0; ht < 4; ++ht)
#pragma unroll
    for (int r = 0; r < 16; ++r) acc[ht][r] = gelu_tanh(acc[ht][r] + bias1[ht * 32 + crow(r, kb)]);
  f32x16 o[2]; o[0] = zero16(); o[1] = zero16();
#pragma unroll
  for (int ht = 0; ht < 4; ++ht)
#pragma unroll
    for (int s = 0; s < 2; ++s) {
      const bf16x8 hf = pack8(acc[ht][8 * s], acc[ht][8 * s + 1], acc[ht][8 * s + 2], acc[ht][8 * s + 3], acc[ht][8 * s + 4], acc[ht][8 * s + 5], acc[ht][8 * s + 6], acc[ht][8 * s + 7]);
#pragma unroll
      for (int dt = 0; dt < 2; ++dt) {
        const bf16x8 wf = ld2x4(w2T + (size_t)(dt * 32 + l32) * 128 + ht * 32 + 16 * s + 4 * kb);
        o[dt] = mfma(wf, hf, o[dt]);
      }
    }
  if (c < 511) {
    if (br == 0) {
      bf16_t* dst = (bf16_t*)(P.ws + R_KCMP) + ((size_t)(b * 2 + g) * 512 + c) * 64;
#pragma unroll
      for (int dt = 0; dt < 2; ++dt)
#pragma unroll
        for (int gq = 0; gq < 4; ++gq) {
          u32x2 u; u[0] = pk2(o[dt][gq * 4], o[dt][gq * 4 + 1]); u[1] = pk2(o[dt][gq * 4 + 2], o[dt][gq * 4 + 3]);
          *(u32x2*)(dst + dt * 32 + 8 * gq + 4 * kb) = u;
        }
    } else {
      bf16_t* dst = (bf16_t*)(P.ws + R_VCMPT) + (size_t)(b * 2 + g) * 64 * 512 + c;
#pragma unroll
      for (int dt = 0; dt < 2; ++dt)
#pragma unroll
        for (int r = 0; r < 16; ++r) dst[(size_t)(dt * 32 + crow(r, kb)) * 512] = f2bf(o[dt][r]);
    }
  }
}

DI void nsa_transpose_v(const Params& P) {
  const bf16_t* proj = (const bf16_t*)(P.ws + R1);
  const int total = 2 * 8 * 2 * 1024 * 64;
  for (int u = blockIdx.x * blockDim.x + threadIdx.x; u < total; u += gridDim.x * blockDim.x) {
    const int dh = u & 63; int rest = u >> 6; const int t8 = rest & 1023; rest >>= 10;
    const int g = rest & 1, b = (rest >> 1) & 7, which = rest >> 4;
    const bf16_t* src = proj + ((size_t)b * SEQ + t8 * 8) * PW + (which ? C_VW : C_VS) + g * 64 + dh;
    bf16_t v[8];
#pragma unroll
    for (int j = 0; j < 8; ++j) v[j] = src[(size_t)j * PW];
    u32x4 o;
#pragma unroll
    for (int j = 0; j < 4; ++j) o[j] = (unsigned)v[2 * j] | ((unsigned)v[2 * j + 1] << 16);
    bf16_t* dst = (bf16_t*)(P.ws + (which ? R_VWT : R_VST)) + ((size_t)(b * 2 + g) * 64 + dh) * SEQ + t8 * 8;
    *(u32x4*)dst = o;
  }
}

DI f32x16 qk_tile(const bf16_t* krow, const bf16x8 (&qf)[4]) {
  f32x16 s = zero16();
#pragma unroll
  for (int i = 0; i < 4; ++i) { const bf16x8 kf = *(const bf16x8*)(krow + i * 16); s = mfma(kf, qf[i], s); }
  return s;
}

DI void attn_tile(const bf16_t* krow, const bf16_t* vt0, const bf16x8 (&qf)[4], int k0, int tq, int lo, bool bit, int kb,
                  f32x16& o0, f32x16& o1, float& m, float& l) {
  f32x16 s = qk_tile(krow, qf);
  float tmax = -1e30f;
  bool vd[16];
#pragma unroll
  for (int r = 0; r < 16; ++r) {
    const int key = k0 + crow(r, kb);
    vd[r] = bit && (key <= tq) && (key > lo);
    s[r] = vd[r] ? s[r] * 0.125f : -1e30f;
    tmax = fmaxf(tmax, s[r]);
  }
  tmax = fmaxf(tmax, __shfl_xor(tmax, 32));
  const float mn = fmaxf(m, tmax);
  const float alpha = __expf(m - mn);
  float ps = 0.f;
#pragma unroll
  for (int r = 0; r < 16; ++r) { s[r] = vd[r] ? __expf(s[r] - mn) : 0.f; ps += s[r]; }
  l = l * alpha + ps; m = mn;
#pragma unroll
  for (int r = 0; r < 16; ++r) { o0[r] *= alpha; o1[r] *= alpha; }
#pragma unroll
  for (int sI = 0; sI < 2; ++sI) {
    const bf16x8 pf = pack8(s[8 * sI], s[8 * sI + 1], s[8 * sI + 2], s[8 * sI + 3], s[8 * sI + 4], s[8 * sI + 5], s[8 * sI + 6], s[8 * sI + 7]);
    const bf16x8 va = ld2x4(vt0 + k0 + 16 * sI);
    const bf16x8 vb = ld2x4(vt0 + (size_t)32 * SEQ + k0 + 16 * sI);
    o0 = mfma(va, pf, o0); o1 = mfma(vb, pf, o1);
  }
}

DI void nsa_task(const Params& P, int b, int g, int qt, float* imp) {
  const bf16_t* proj = (const bf16_t*)(P.ws + R1);
  bf16_t* mix = (bf16_t*)(P.ws + R3);
  const int lane = threadIdx.x & 63, l32 = lane & 31, kb = lane >> 5;
  const int t0 = qt * 32, tq = t0 + l32;
  const size_t tokq = (size_t)b * SEQ + tq;
  const bf16_t* qrow = proj + tokq * PW;
  const bf16_t* kcmp = (const bf16_t*)(P.ws + R_KCMP) + (size_t)(b * 2 + g) * 512 * 64;
  const bf16_t* vcmpT = (const bf16_t*)(P.ws + R_VCMPT) + (size_t)(b * 2 + g) * 64 * 512;
  for (int i = lane; i < 4096; i += 64) imp[i] = 0.f;
  const int nct = (qt >> 4) + 1;
  for (int hh = 0; hh < 4; ++hh) {
    const int head = g * 4 + hh;
    bf16x8 qf[4];
#pragma unroll
    for (int i = 0; i < 4; ++i) qf[i] = *(const bf16x8*)(qrow + C_NQ + head * 64 + i * 16 + kb * 8);
    float m = -1e30f, l = 0.f;
    for (int ct = 0; ct < nct; ++ct) {
      f32x16 s = qk_tile(kcmp + (size_t)(ct * 32 + l32) * 64 + kb * 8, qf);
      float tmax = -1e30f;
#pragma unroll
      for (int r = 0; r < 16; ++r) {
        const int c = ct * 32 + crow(r, kb);
        const bool vd = (c * 16 + 31 <= tq);
        s[r] = vd ? s[r] * 0.125f : -1e30f;
        tmax = fmaxf(tmax, s[r]);
      }
      const float mn = fmaxf(m, tmax);
      float ps = 0.f;
#pragma unroll
      for (int r = 0; r < 16; ++r) ps += (s[r] > -5e29f) ? __expf(s[r] - mn) : 0.f;
      l = l * __expf(m - mn) + ps; m = mn;
    }
    const float mo = __shfl_xor(m, 32), lo_ = __shfl_xor(l, 32);
    const float M = fmaxf(m, mo);
    const float L = l * __expf(m - M) + lo_ * __expf(mo - M);
    const float invL = 1.f / fmaxf(L, 1e-30f);
    f32x16 o0 = zero16(), o1 = zero16();
    float carry = 0.f;
    for (int ct = 0; ct < nct; ++ct) {
      f32x16 s = qk_tile(kcmp + (size_t)(ct * 32 + l32) * 64 + kb * 8, qf);
#pragma unroll
      for (int r = 0; r < 16; ++r) {
        const int c = ct * 32 + crow(r, kb);
        const bool vd = (c * 16 + 31 <= tq);
        s[r] = vd ? __expf(s[r] * 0.125f - M) * invL : 0.f;
      }
      float y[4];
#pragma unroll
      for (int gi = 0; gi < 4; ++gi) y[gi] = __shfl_xor(s[4 * gi + 3], 32);
#pragma unroll
      for (int gi = 0; gi < 4; ++gi) {
        const float s4 = (s[4 * gi] + s[4 * gi + 1]) + (s[4 * gi + 2] + s[4 * gi + 3]);
        const float extra = kb ? y[gi] : (gi == 0 ? carry : y[gi > 0 ? gi - 1 : 0]);
        const int j = ct * 8 + 2 * gi + kb;
        imp[j * 32 + l32] += s4 + extra;
      }
      carry = y[3];
#pragma unroll
      for (int sI = 0; sI < 2; ++sI) {
        const bf16x8 pf = pack8(s[8 * sI], s[8 * sI + 1], s[8 * sI + 2], s[8 * sI + 3], s[8 * sI + 4], s[8 * sI + 5], s[8 * sI + 6], s[8 * sI + 7]);
        const bf16x8 va = ld2x4(vcmpT + (size_t)(l32)*512 + ct * 32 + 16 * sI + 4 * kb);
        const bf16x8 vb = ld2x4(vcmpT + (size_t)(32 + l32) * 512 + ct * 32 + 16 * sI + 4 * kb);
        o0 = mfma(va, pf, o0); o1 = mfma(vb, pf, o1);
      }
    }
    const float g0 = sigmoidf_(bf2f(qrow[C_NG + head * 3 + 0]) + P.nsa_gate_b[head * 3 + 0]);
#pragma unroll
    for (int gq = 0; gq < 4; ++gq) {
      u32x2 u0, u1;
      u0[0] = pk2(g0 * o0[gq * 4], g0 * o0[gq * 4 + 1]); u0[1] = pk2(g0 * o0[gq * 4 + 2], g0 * o0[gq * 4 + 3]);
      u1[0] = pk2(g0 * o1[gq * 4], g0 * o1[gq * 4 + 1]); u1[1] = pk2(g0 * o1[gq * 4 + 2], g0 * o1[gq * 4 + 3]);
      *(u32x2*)(mix + tokq * DM + 512 + head * 64 + 8 * gq + 4 * kb) = u0;
      *(u32x2*)(mix + tokq * DM + 512 + head * 64 + 32 + 8 * gq + 4 * kb) = u1;
    }
  }
  asm volatile("s_waitcnt lgkmcnt(0)" ::: "memory");
  __builtin_amdgcn_wave_barrier();
  unsigned mk0 = 0, mk1 = 0, mk2 = 0, mk3 = 0;
  for (int q = 0; q < 32; ++q) {
    const int tqq = t0 + q, cur = tqq >> 6;
    const float v0 = imp[lane * 32 + q], v1 = imp[(lane + 64) * 32 + q];
    const int j0 = lane, j1 = lane + 64;
    const float s0 = (j0 == 0 || j0 == cur || j0 == cur - 1) ? 1e30f : (j0 <= cur ? v0 : -1e30f);
    const float s1 = (j1 == cur || j1 == cur - 1) ? 1e30f : (j1 <= cur ? v1 : -1e30f);
    int c0 = 0, c1 = 0;
#pragma unroll
    for (int k = 0; k < 64; ++k) {
      const float a0 = __int_as_float(__builtin_amdgcn_readlane(__float_as_int(s0), k));
      const float a1 = __int_as_float(__builtin_amdgcn_readlane(__float_as_int(s1), k));
      c0 += ((a0 > s0) || (a0 == s0 && k < lane)) ? 1 : 0;
      c0 += (a1 > s0) ? 1 : 0;
      c1 += (a0 >= s1) ? 1 : 0;
      c1 += ((a1 > s1) || (a1 == s1 && k < lane)) ? 1 : 0;
    }
    const bool sel0 = (s0 > -5e29f) && (c0 < 16);
    const bool sel1 = (s1 > -5e29f) && (c1 < 16);
    const unsigned long long blo = __ballot(sel0), bhi = __ballot(sel1);
    if (l32 == q) { mk0 = (unsigned)blo; mk1 = (unsigned)(blo >> 32); mk2 = (unsigned)bhi; mk3 = (unsigned)(bhi >> 32); }
  }
  asm volatile("" ::: "memory");
  const bf16_t* ksel = proj + (size_t)b * SEQ * PW + C_KS + g * 64 + kb * 8;
  const bf16_t* kwin = proj + (size_t)b * SEQ * PW + C_KW + g * 64 + kb * 8;
  const bf16_t* vsT = (const bf16_t*)(P.ws + R_VST) + ((size_t)(b * 2 + g) * 64 + l32) * SEQ + 4 * kb;
  const bf16_t* vwT = (const bf16_t*)(P.ws + R_VWT) + ((size_t)(b * 2 + g) * 64 + l32) * SEQ + 4 * kb;
  for (int hh = 0; hh < 4; ++hh) {
    const int head = g * 4 + hh;
    bf16x8 qf[4];
#pragma unroll
    for (int i = 0; i < 4; ++i) qf[i] = *(const bf16x8*)(qrow + C_NQ + head * 64 + i * 16 + kb * 8);
    f32x16 a0 = zero16(), a1 = zero16(); float m = -1e30f, l = 0.f;
    for (int kt = 0; kt <= qt; ++kt) {
      const int j = kt >> 1;
      const unsigned mw = j < 32 ? mk0 : (j < 64 ? mk1 : (j < 96 ? mk2 : mk3));
      const bool bit = (mw >> (j & 31)) & 1u;
      if (__ballot(bit) == 0ull) continue;
      attn_tile(ksel + (size_t)(kt * 32 + l32) * PW, vsT, qf, kt * 32, tq, -1, bit, kb, a0, a1, m, l);
    }
    float lt = l + __shfl_xor(l, 32);
    const float g1 = sigmoidf_(bf2f(qrow[C_NG + head * 3 + 1]) + P.nsa_gate_b[head * 3 + 1]);
    const float f1 = g1 / fmaxf(lt, 1e-30f);
    f32x16 w0 = zero16(), w1 = zero16(); m = -1e30f; l = 0.f;
    const int ktb = qt > 16 ? qt - 16 : 0;
    for (int kt = ktb; kt <= qt; ++kt)
      attn_tile(kwin + (size_t)(kt * 32 + l32) * PW, vwT, qf, kt * 32, tq, tq - 512, true, kb, w0, w1, m, l);
    lt = l + __shfl_xor(l, 32);
    const float g2 = sigmoidf_(bf2f(qrow[C_NG + head * 3 + 2]) + P.nsa_gate_b[head * 3 + 2]);
    const float f2 = g2 / fmaxf(lt, 1e-30f);
#pragma unroll
    for (int gq = 0; gq < 4; ++gq) {
      bf16_t* d0 = mix + tokq * DM + 512 + head * 64 + 8 * gq + 4 * kb;
      bf16_t* d1 = d0 + 32;
      const u32x2 p0 = *(const u32x2*)d0, p1 = *(const u32x2*)d1;
      u32x2 u0, u1;
      u0[0] = pk2(bflo(p0[0]) + f1 * a0[gq * 4] + f2 * w0[gq * 4], bfhi(p0[0]) + f1 * a0[gq * 4 + 1] + f2 * w0[gq * 4 + 1]);
      u0[1] = pk2(bflo(p0[1]) + f1 * a0[gq * 4 + 2] + f2 * w0[gq * 4 + 2], bfhi(p0[1]) + f1 * a0[gq * 4 + 3] + f2 * w0[gq * 4 + 3]);
      u1[0] = pk2(bflo(p1[0]) + f1 * a1[gq * 4] + f2 * w1[gq * 4], bfhi(p1[0]) + f1 * a1[gq * 4 + 1] + f2 * w1[gq * 4 + 1]);
      u1[1] = pk2(bflo(p1[1]) + f1 * a1[gq * 4 + 2] + f2 * w1[gq * 4 + 2], bfhi(p1[1]) + f1 * a1[gq * 4 + 3] + f2 * w1[gq * 4 + 3]);
      *(u32x2*)d0 = u0; *(u32x2*)d1 = u1;
    }
  }
  asm volatile("s_waitcnt lgkmcnt(0)" ::: "memory");
}

DI void sgu_item(const Params& P, int item, char* smem) {
  bf16_t* H = (bf16_t*)(P.ws + R1);
  float* smu = (float*)smem; float* srs = smu + 128; float* sc1 = srs + 128; float* srw = sc1 + 128;
  bf16_t* sW = (bf16_t*)(srw + 128); bf16_t* sV = sW + 128 * 136;
  const int tid = threadIdx.x, lane = tid & 63, wave = tid >> 6, l32 = lane & 31, kb = lane >> 5;
  const size_t tok0 = (size_t)item * 128;
  for (int tt = 0; tt < 32; ++tt) {
    const int t = wave * 32 + tt;
    const bf16_t* vr = H + (tok0 + t) * 4096 + 2048;
    float s = 0.f, s2 = 0.f;
#pragma unroll
    for (int k = 0; k < 4; ++k) {
      const u32x4 u = *(const u32x4*)(vr + k * 512 + lane * 8);
#pragma unroll
      for (int e = 0; e < 4; ++e) { const float a = bflo(u[e]), c = bfhi(u[e]); s += a + c; s2 += a * a + c * c; }
    }
    s = wave_sum(s); s2 = wave_sum(s2);
    const float mu = s * (1.f / 2048.f);
    const float var = fmaxf(s2 * (1.f / 2048.f) - mu * mu, 0.f);
    if (lane == 0) { smu[t] = mu; srs[t] = rsqrtf(var + EPS); }
  }
  __syncthreads();
  for (int g = 0; g < 8; ++g) {
    {
      const int t = tid >> 1, half = tid & 1;
      const float* wrow = P.o_w_s + ((size_t)g * 128 + t) * 128 + half * 64;
      float c1 = 0.f, rw = 0.f;
#pragma unroll 1
      for (int c8 = 0; c8 < 8; ++c8) {
        const float4 f0 = *(const float4*)(wrow + c8 * 8), f1 = *(const float4*)(wrow + c8 * 8 + 4);
        float wv[8] = {f0.x, f0.y, f0.z, f0.w, f1.x, f1.y, f1.z, f1.w};
        float ov[8];
#pragma unroll
        for (int e = 0; e < 8; ++e) {
          const int s = half * 64 + c8 * 8 + e;
          const float w = (s <= t) ? wv[e] : 0.f;
          rw += w;
          const float wp = bf2f(f2bf(w * srs[s]));
          c1 += wp * smu[s];
          ov[e] = wp;
        }
        u32x4 o; o[0] = pk2(ov[0], ov[1]); o[1] = pk2(ov[2], ov[3]); o[2] = pk2(ov[4], ov[5]); o[3] = pk2(ov[6], ov[7]);
        *(u32x4*)(sW + t * 136 + half * 64 + c8 * 8) = o;
      }
      c1 += __shfl_xor(c1, 1); rw += __shfl_xor(rw, 1);
      if (half == 0) { sc1[t] = c1; srw[t] = rw; }
    }
    for (int sub = 0; sub < 4; ++sub) {
      const int ch0 = g * 256 + sub * 64;
      {
        const int s = tid >> 1, half = tid & 1;
        const bf16_t* src = H + (tok0 + s) * 4096 + 2048 + ch0 + half * 32;
#pragma unroll
        for (int c = 0; c < 4; ++c) {
          const u32x4 u = *(const u32x4*)(src + c * 8);
#pragma unroll
          for (int e = 0; e < 4; ++e) {
            sV[(half * 32 + c * 8 + 2 * e) * 136 + s] = (bf16_t)(u[e] & 0xffffu);
            sV[(half * 32 + c * 8 + 2 * e + 1) * 136 + s] = (bf16_t)(u[e] >> 16);
          }
        }
      }
      __syncthreads();
      f32x16 acc0 = zero16(), acc1 = zero16();
      const int nks = 2 * (wave + 1);
      for (int ks = 0; ks < nks; ++ks) {
        const bf16x8 a = *(const bf16x8*)(sW + (wave * 32 + l32) * 136 + ks * 16 + kb * 8);
        const bf16x8 b0 = *(const bf16x8*)(sV + (l32)*136 + ks * 16 + kb * 8);
        const bf16x8 b1 = *(const bf16x8*)(sV + (32 + l32) * 136 + ks * 16 + kb * 8);
        acc0 = mfma(a, b0, acc0); acc1 = mfma(a, b1, acc1);
      }
#pragma unroll
      for (int ct = 0; ct < 2; ++ct) {
        const int ch = ch0 + ct * 32 + l32;
        const float lg = P.o_ln_g[ch], lb = P.o_ln_b[ch];
#pragma unroll
        for (int r = 0; r < 16; ++r) {
          const int t = wave * 32 + crow(r, kb);
          const float a = ct ? acc1[r] : acc0[r];
          const float mixed = lg * (a - sc1[t]) + lb * srw[t] + P.o_b_s[g * 128 + t];
          bf16_t* hp = H + (tok0 + t) * 4096;
          const float u = bf2f(hp[ch]);
          hp[2048 + ch] = f2bf(u * mixed);
        }
      }
      __syncthreads();
    }
  }
}

constexpr int NPHASE = 17;
DI void run_phase(const Params& P, int ph, char* smem) {
  char* ws = P.ws;
  bf16_t* r1 = (bf16_t*)(ws + R1); bf16_t* r2 = (bf16_t*)(ws + R2); bf16_t* r3 = (bf16_t*)(ws + R3); bf16_t* r4 = (bf16_t*)(ws + R4);
  unsigned* cnt = (unsigned*)(ws + W_CNT);
  const int lane = threadIdx.x & 63, wave = threadIdx.x >> 6;
  switch (ph) {
    case 0: phase_prep(P); break;
    case 1: gemm_phase<0>(r2, 1024, (const bf16_t*)(ws + W_EIN), 1024, 23, r1, PW, smem); break;
    case 2: {
      nsa_transpose_v(P);
      if (blockIdx.x < 128) nsa_compress_task(P, blockIdx.x * 4 + wave);
      volatile int* s_item = (volatile int*)(smem + 65536 - 16);
      for (;;) {
        __syncthreads();
        if (threadIdx.x == 0) *s_item = (int)atomicAdd(cnt + 0, 1u);
        __syncthreads();
        const int item = *s_item;
        if (item >= 4096) break;
        gla_p1_item(P, item, smem);
      }
    } break;
    case 3: {
      gla_scan(P);
      float* imp = (float*)smem + wave * 4096;
      for (;;) {
        int tk = 0;
        if (lane == 0) tk = (int)atomicAdd(cnt + 1, 1u);
        tk = __builtin_amdgcn_readfirstlane(tk);
        if (tk >= 4096) break;
        const int qt = 255 - (tk >> 4), bg = tk & 15;
        nsa_task(P, bg >> 1, bg & 1, qt, imp);
      }
    } break;
    case 4:
      for (int item = blockIdx.x; item < 4096; item += gridDim.x) gla_p3_item(P, item, smem);
      break;
    case 5: gemm_phase<0>(r3, 1024, (const bf16_t*)(ws + W_EOUT), 1024, 8, r4, 1024, smem); break;
    case 6: resnorm_rows(r4, P.x, P.out, P.norm_g + 1 * 1024, P.norm_g + 2 * 1024, r2); break;
    case 7: gemm_phase<1>(r2, 1024, (const bf16_t*)(ws + W_FFN1_0), 1024, 32, r1, 4096, smem); break;
    case 8: gemm_phase<0>(r1, 4096, (const bf16_t*)(ws + W_FFN2_0), 4096, 8, r4, 1024, smem); break;
    case 9: resnorm_rows(r4, P.out, P.out, P.norm_g + 3 * 1024, P.norm_g + 4 * 1024, r2); break;
    case 10: gemm_phase<2>(r2, 1024, (const bf16_t*)(ws + W_OIN), 1024, 32, r1, 4096, smem); break;
    case 11:
      for (int item = blockIdx.x; item < 512; item += gridDim.x) sgu_item(P, item, smem);
      break;
    case 12: gemm_phase<0>(r1 + 2048, 4096, (const bf16_t*)(ws + W_OOUT), 2048, 8, r4, 1024, smem); break;
    case 13: resnorm_rows(r4, P.out, P.out, P.norm_g + 5 * 1024, P.norm_g + 6 * 1024, r2); break;
    case 14: gemm_phase<1>(r2, 1024, (const bf16_t*)(ws + W_FFN1_1), 1024, 32, r1, 4096, smem); break;
    case 15: gemm_phase<0>(r1, 4096, (const bf16_t*)(ws + W_FFN2_1), 4096, 8, r4, 1024, smem); break;
    case 16: resnorm_rows(r4, P.out, P.out, P.norm_g + 7 * 1024, nullptr, nullptr); break;
    default: break;
  }
}

#if !MEGA
__global__ void __launch_bounds__(256, 2) k_phase(Params P, int ph) {
  __shared__ __attribute__((aligned(16))) char smem[65536];
  run_phase(P, ph, smem);
}
#endif

#if MEGA
__global__ void __launch_bounds__(256, 2) k_mega(Params P) {
  __shared__ __attribute__((aligned(16))) char smem[65536];
  cg::grid_group grid = cg::this_grid();
  run_phase(P, 0, smem); grid.sync();
  run_phase(P, 1, smem); grid.sync();
  run_phase(P, 2, smem); grid.sync();
  run_phase(P, 3, smem); grid.sync();
  run_phase(P, 4, smem); grid.sync();
  run_phase(P, 5, smem); grid.sync();
  run_phase(P, 6, smem); grid.sync();
  run_phase(P, 7, smem); grid.sync();
  run_phase(P, 8, smem); grid.sync();
  run_phase(P, 9, smem); grid.sync();
  run_phase(P, 10, smem); grid.sync();
  run_phase(P, 11, smem); grid.sync();
  run_phase(P, 12, smem); grid.sync();
  run_phase(P, 13, smem); grid.sync();
  run_phase(P, 14, smem); grid.sync();
  run_phase(P, 15, smem); grid.sync();
  run_phase(P, 16, smem);
}
#endif

extern "C" void kernel_launch(void* const* d_in, const int* in_sizes, int n_in, void* d_out, int out_size, void* d_ws, size_t ws_size,
                              hipStream_t stream) {
  Params p{};
  p.x = (const float*)d_in[0]; p.norm_g = (const float*)d_in[1]; p.ffn_w1 = (const float*)d_in[2]; p.ffn_w2 = (const float*)d_in[3];
  p.e_w_in = (const float*)d_in[4]; p.e_w_out = (const float*)d_in[5]; p.gla_w_gate = (const float*)d_in[6]; p.gla_b_gate = (const float*)d_in[7];
  p.gla_norm = (const float*)d_in[8]; p.nsa_gate_b = (const float*)d_in[9]; p.cmp_pos = (const float*)d_in[10]; p.cmp_w1 = (const float*)d_in[11];
  p.cmp_w2 = (const float*)d_in[12]; p.o_w_in = (const float*)d_in[13]; p.o_ln_g = (const float*)d_in[14]; p.o_ln_b = (const float*)d_in[15];
  p.o_w_s = (const float*)d_in[16]; p.o_b_s = (const float*)d_in[17]; p.o_w_out = (const float*)d_in[18];
  p.out = (float*)d_out; p.ws = (char*)d_ws;
  if (ws_size < 1024ull * MiB) { fprintf(stderr, "workspace too small: %zu\n", ws_size); return; }
  static int grid_blocks = 0;
  if (!grid_blocks) {
    int dev = 0, cus = 0, per_cu = 0;
    hipGetDevice(&dev);
    hipDeviceGetAttribute(&cus, hipDeviceAttributeMultiprocessorCount, dev);
#if MEGA
    hipOccupancyMaxActiveBlocksPerMultiprocessor(&per_cu, k_mega, 256, 0);
#else
    hipOccupancyMaxActiveBlocksPerMultiprocessor(&per_cu, k_phase, 256, 0);
#endif
    if (per_cu < 1) per_cu = 1;
    if (per_cu > 2) per_cu = 2;
    grid_blocks = cus * per_cu;
  }
#if MEGA
  void* args[] = {&p};
  hipError_t e = hipLaunchCooperativeKernel((void*)k_mega, dim3(grid_blocks), dim3(256), args, 0, stream);
  if (e != hipSuccess) fprintf(stderr, "cooperative launch failed: %s (grid %d)\n", hipGetErrorString(e), grid_blocks);
#else
  for (int ph = 0; ph < NPHASE; ++ph) k_phase<<<grid_blocks, 256, 0, stream>>>(p, ph);
#endif
}
```

```cpp
#include <hip/hip_runtime.h>
#include <hip/hip_cooperative_groups.h>
#include <cstdio>
namespace cg = cooperative_groups;

#ifndef MEGA
#define MEGA 1
#endif

typedef unsigned short bf16_t;
typedef short bf16x8 __attribute__((ext_vector_type(8)));
typedef short s16x4 __attribute__((ext_vector_type(4)));
typedef float f32x16 __attribute__((ext_vector_type(16)));
typedef float f32v2 __attribute__((ext_vector_type(2)));
typedef __bf16 bf16v2 __attribute__((ext_vector_type(2)));
typedef unsigned u32x4 __attribute__((ext_vector_type(4)));
typedef unsigned u32x2 __attribute__((ext_vector_type(2)));
#define DI __device__ __forceinline__

constexpr int T_TOK = 65536, SEQ = 8192, DM = 1024;
constexpr int PW = 3072;
constexpr int C_GQ = 0, C_GK = 256, C_GV = 512, C_GLR = 1024, C_GR = 1040, C_NQ = 1552, C_KC = 2064, C_VC = 2192,
              C_KS = 2320, C_VS = 2448, C_KW = 2576, C_VW = 2704, C_NG = 2832;
constexpr float EPS = 1e-6f;
constexpr int NTHR = 512, WPB = 8, LDS_BYTES = 131072;
constexpr size_t MiB = 1024ull * 1024ull;
constexpr size_t W_FFN1_0 = 0, W_FFN1_1 = 8 * MiB, W_FFN2_0 = 16 * MiB, W_FFN2_1 = 24 * MiB, W_EIN = 32 * MiB, W_EOUT = 38 * MiB,
                 W_OIN = 40 * MiB, W_OOUT = 48 * MiB, W_CW1 = 52 * MiB, W_CW2 = 53 * MiB, W_BIAS1 = 53 * MiB + 65536,
                 W_CNT = 53 * MiB + 131072;
constexpr size_t R1 = 64 * MiB, R2 = 576 * MiB, R3 = 704 * MiB, R4 = 832 * MiB, R5 = 960 * MiB;
constexpr size_t R_KCMP = R5, R_VCMPT = R5 + 1 * MiB, R_VST = R5 + 2 * MiB, R_VWT = R5 + 18 * MiB, R_DECAY = R5 + 34 * MiB;

struct Params {
  const float* x; const float* norm_g; const float* ffn_w1; const float* ffn_w2; const float* e_w_in; const float* e_w_out;
  const float* gla_w_gate; const float* gla_b_gate; const float* gla_norm; const float* nsa_gate_b; const float* cmp_pos;
  const float* cmp_w1; const float* cmp_w2; const float* o_w_in; const float* o_ln_g; const float* o_ln_b; const float* o_w_s;
  const float* o_b_s; const float* o_w_out;
  float* out; char* ws;
};

DI int crow(int r, int kb) { return (r & 3) + 8 * (r >> 2) + 4 * kb; }
DI f32x16 mfma(bf16x8 a, bf16x8 b, f32x16 c) { return __builtin_amdgcn_mfma_f32_32x32x16_bf16(a, b, c, 0, 0, 0); }
DI unsigned pk2(float a, float b) { f32v2 v = {a, b}; bf16v2 r = __builtin_convertvector(v, bf16v2); return __builtin_bit_cast(unsigned, r); }
DI bf16_t f2bf(float a) { return (bf16_t)(pk2(a, 0.f) & 0xffffu); }
DI float bf2f(bf16_t u) { return __uint_as_float(((unsigned)u) << 16); }
DI float bflo(unsigned u) { return __uint_as_float(u << 16); }
DI float bfhi(unsigned u) { return __uint_as_float(u & 0xffff0000u); }
DI bf16x8 pack8(float a0, float a1, float a2, float a3, float a4, float a5, float a6, float a7) {
  u32x4 p; p[0] = pk2(a0, a1); p[1] = pk2(a2, a3); p[2] = pk2(a4, a5); p[3] = pk2(a6, a7);
  return __builtin_bit_cast(bf16x8, p);
}
DI bf16x8 ld2x4(const bf16_t* p) {
  s16x4 lo = *(const s16x4*)p; s16x4 hi = *(const s16x4*)(p + 8);
  return __builtin_shufflevector(lo, hi, 0, 1, 2, 3, 4, 5, 6, 7);
}
DI float wave_sum(float v) {
#pragma unroll
  for (int o = 32; o > 0; o >>= 1) v += __shfl_xor(v, o);
  return v;
}
DI f32x16 zero16() { f32x16 z;
#pragma unroll
  for (int i = 0; i < 16; ++i) z[i] = 0.f; return z; }
DI float gelu_tanh(float x) { float u = 1.5957691216f * (x + 0.044715f * x * x * x); return x / (1.f + __expf(-u)); }
DI float sigmoidf_(float x) { return 1.f / (1.f + __expf(-x)); }

DI void conv_weight(const float* __restrict__ src, bf16_t* __restrict__ dst, int K, int N, int Npad) {
  const long total = (long)Npad * (K >> 3);
  const long stride = (long)gridDim.x * blockDim.x;
  for (long i = (long)blockIdx.x * blockDim.x + threadIdx.x; i < total; i += stride) {
    const int n = (int)(i % Npad); const int k8 = (int)(i / Npad);
    float v[8];
#pragma unroll
    for (int j = 0; j < 8; ++j) v[j] = (n < N) ? src[(size_t)(k8 * 8 + j) * N + n] : 0.f;
    u32x4 o; o[0] = pk2(v[0], v[1]); o[1] = pk2(v[2], v[3]); o[2] = pk2(v[4], v[5]); o[3] = pk2(v[6], v[7]);
    *(u32x4*)(dst + (size_t)n * K + k8 * 8) = o;
  }
}

DI void prenorm_rows(const float* __restrict__ x, const float* __restrict__ g, bf16_t* __restrict__ xn) {
  const int lane = threadIdx.x & 63, wave = threadIdx.x >> 6;
  const int nw = gridDim.x * WPB;
  for (int row = blockIdx.x * WPB + wave; row < T_TOK; row += nw) {
    const float4* xr = (const float4*)(x + (size_t)row * DM);
    float4 a[4]; float ss = 0.f;
#pragma unroll
    for (int k = 0; k < 4; ++k) { a[k] = xr[k * 64 + lane]; ss += a[k].x * a[k].x + a[k].y * a[k].y + a[k].z * a[k].z + a[k].w * a[k].w; }
    ss = wave_sum(ss);
    const float rs = rsqrtf(ss * (1.f / DM) + EPS);
#pragma unroll
    for (int k = 0; k < 4; ++k) {
      const float4 gg = ((const float4*)g)[k * 64 + lane];
      u32x2 o; o[0] = pk2(a[k].x * rs * gg.x, a[k].y * rs * gg.y); o[1] = pk2(a[k].z * rs * gg.z, a[k].w * rs * gg.w);
      *(u32x2*)(xn + (size_t)row * DM + k * 256 + lane * 4) = o;
    }
  }
}

DI void resnorm_rows(const bf16_t* __restrict__ m, const float* hin, float* hout, const float* __restrict__ gpost,
                             const float* __restrict__ gnext, bf16_t* __restrict__ xn) {
  const int lane = threadIdx.x & 63, wave = threadIdx.x >> 6;
  const int nw = gridDim.x * WPB;
  for (int row = blockIdx.x * WPB + wave; row < T_TOK; row += nw) {
    float mv[16]; float ss = 0.f;
#pragma unroll
    for (int k = 0; k < 4; ++k) {
      const u32x2 u = *(const u32x2*)(m + (size_t)row * DM + k * 256 + lane * 4);
      mv[k * 4 + 0] = bflo(u[0]); mv[k * 4 + 1] = bfhi(u[0]); mv[k * 4 + 2] = bflo(u[1]); mv[k * 4 + 3] = bfhi(u[1]);
    }
#pragma unroll
    for (int i = 0; i < 16; ++i) ss += mv[i] * mv[i];
    ss = wave_sum(ss);
    const float rs = rsqrtf(ss * (1.f / DM) + EPS);
    float hv[16]; float s2 = 0.f;
#pragma unroll
    for (int k = 0; k < 4; ++k) {
      const float4 h4 = ((const float4*)(hin + (size_t)row * DM))[k * 64 + lane];
      const float4 gg = ((const float4*)gpost)[k * 64 + lane];
      hv[k * 4 + 0] = h4.x + mv[k * 4 + 0] * rs * gg.x; hv[k * 4 + 1] = h4.y + mv[k * 4 + 1] * rs * gg.y;
      hv[k * 4 + 2] = h4.z + mv[k * 4 + 2] * rs * gg.z; hv[k * 4 + 3] = h4.w + mv[k * 4 + 3] * rs * gg.w;
      float4 o; o.x = hv[k * 4 + 0]; o.y = hv[k * 4 + 1]; o.z = hv[k * 4 + 2]; o.w = hv[k * 4 + 3];
      ((float4*)(hout + (size_t)row * DM))[k * 64 + lane] = o;
    }
    if (xn) {
#pragma unroll
      for (int i = 0; i < 16; ++i) s2 += hv[i] * hv[i];
      s2 = wave_sum(s2);
      const float r2 = rsqrtf(s2 * (1.f / DM) + EPS);
#pragma unroll
      for (int k = 0; k < 4; ++k) {
        const float4 gg = ((const float4*)gnext)[k * 64 + lane];
        u32x2 o; o[0] = pk2(hv[k * 4 + 0] * r2 * gg.x, hv[k * 4 + 1] * r2 * gg.y); o[1] = pk2(hv[k * 4 + 2] * r2 * gg.z, hv[k * 4 + 3] * r2 * gg.w);
        *(u32x2*)(xn + (size_t)row * DM + k * 256 + lane * 4) = o;
      }
    }
  }
}

DI void phase_prep(const Params& P) {
  char* ws = P.ws;
  conv_weight(P.ffn_w1, (bf16_t*)(ws + W_FFN1_0), 1024, 4096, 4096);
  conv_weight(P.ffn_w1 + (size_t)1024 * 4096, (bf16_t*)(ws + W_FFN1_1), 1024, 4096, 4096);
  conv_weight(P.ffn_w2, (bf16_t*)(ws + W_FFN2_0), 4096, 1024, 1024);
  conv_weight(P.ffn_w2 + (size_t)1024 * 4096, (bf16_t*)(ws + W_FFN2_1), 4096, 1024, 1024);
  conv_weight(P.e_w_in, (bf16_t*)(ws + W_EIN), 1024, 2856, PW);
  conv_weight(P.e_w_out, (bf16_t*)(ws + W_EOUT), 1024, 1024, 1024);
  conv_weight(P.o_w_in, (bf16_t*)(ws + W_OIN), 1024, 4096, 4096);
  conv_weight(P.o_w_out, (bf16_t*)(ws + W_OOUT), 2048, 1024, 1024);
  conv_weight(P.cmp_w1, (bf16_t*)(ws + W_CW1), 2048, 128, 128);
  conv_weight(P.cmp_w1 + 2048 * 128, (bf16_t*)(ws + W_CW1) + 128 * 2048, 2048, 128, 128);
  conv_weight(P.cmp_w2, (bf16_t*)(ws + W_CW2), 128, 64, 64);
  conv_weight(P.cmp_w2 + 128 * 64, (bf16_t*)(ws + W_CW2) + 64 * 128, 128, 64, 64);
  const int lane = threadIdx.x & 63, wave = threadIdx.x >> 6;
  const int gw = blockIdx.x * WPB + wave;
  if (gw < 256) {
    const int i = gw >> 7, hid = gw & 127;
    float s = 0.f;
    for (int kk = lane; kk < 2048; kk += 64) s += P.cmp_pos[i * 2048 + kk] * P.cmp_w1[((size_t)i * 2048 + kk) * 128 + hid];
    s = wave_sum(s);
    if (lane == 0) ((float*)(ws + W_BIAS1))[gw] = s;
  }
  const int gt = blockIdx.x * blockDim.x + threadIdx.x;
  if (gt < 16) ((unsigned*)(ws + W_CNT))[gt] = 0u;
  if (gt < 16 * 64) {
    const int bg = gt >> 6, d = gt & 63;
    ((bf16_t*)(ws + R_KCMP))[((size_t)bg * 512 + 511) * 64 + d] = 0;
    ((bf16_t*)(ws + R_VCMPT))[((size_t)bg * 64 + d) * 512 + 511] = 0;
  }
  prenorm_rows(P.x, P.norm_g, (bf16_t*)(ws + R2));
}

namespace pg8 {
#define PG8_LAS __attribute__((address_space(3)))
typedef float f32x4 __attribute__((ext_vector_type(4)));
constexpr int BM = 256, BK = 64, HALF = 128, HTB = HALF * BK * 2, STAGE_BYTES = 8 * HTB, NXCD = 8, WGM = 8;
DI int lds_byte(int r, int c) { const int st = (r >> 4) * 2 + (c >> 5), rr = r & 15, cc = c & 31, ob = rr * 64 + cc * 2; return st * 1024 + (ob ^ (((ob >> 9) & 1) << 5)); }
DI void stage_rc(int b, int& R, int& C) { const int st = b / 1024, sb = b % 1024, swz = sb ^ (((sb >> 9) & 1) << 5); R = (st >> 1) * 16 + swz / 64; C = (st & 1) * 32 + (swz % 64) / 2; }
DI int perm32(int rho) { const int n = rho >> 4, i = rho & 15; return 8 * (i >> 2) + 4 * n + (i & 3); }
struct Unit { int pm, pn; };
struct Gemm { const bf16_t* A; const bf16_t* Bt; int M, N, K; };
struct StaticOrder {
  int nM, nN, nwg, G, c;
  DI void init(int M, int N, int G_, int c_) { nM = M / BM; nN = N / BM; nwg = nM * nN; G = G_; c = c_; }
  DI bool next(int i, Unit& u) const {
    const long L = (long)i * G + c; if (L >= nwg) return false;
    int wgid = (int)L; { const int q = nwg / NXCD, r = nwg % NXCD, xcd = wgid % NXCD, off = wgid / NXCD; wgid = (xcd < r ? xcd * (q + 1) : r * (q + 1) + (xcd - r) * q) + off; }
    const int nig = WGM * nN, gid = wgid / nig, fm = gid * WGM, gsz = (nM - fm) < WGM ? (nM - fm) : WGM;
    u.pm = fm + ((wgid % nig) % gsz); u.pn = (wgid % nig) / gsz; return true;
  }
};
template <int ACT> struct EpiB {
  static constexpr bool PERM = true;
  bf16_t* O; int ldc;
  DI void operator()(const f32x4 (&acc)[2][2][4][2], const Unit& u, int wr, int wc, int fr, int fq) const {
    const int row0 = u.pm * BM + wr * 64 + fr; const int col0 = u.pn * BM + wc * 32 + 8 * fq;
#pragma unroll
    for (int ai = 0; ai < 2; ++ai)
#pragma unroll
      for (int m = 0; m < 4; ++m) {
        bf16_t* rowp = O + (size_t)(row0 + ai * HALF + m * 16) * ldc + col0;
#pragma unroll
        for (int bj = 0; bj < 2; ++bj) {
          f32x4 v0 = acc[ai][bj][m][0], v1 = acc[ai][bj][m][1];
          if (ACT == 1) {
#pragma unroll
            for (int j = 0; j < 4; ++j) { const float a = fmaxf(v0[j], 0.f), b = fmaxf(v1[j], 0.f); v0[j] = a * a; v1[j] = b * b; }
          }
          if (ACT == 2) {
#pragma unroll
            for (int j = 0; j < 4; ++j) { v0[j] = gelu_tanh(v0[j]); v1[j] = gelu_tanh(v1[j]); }
          }
          u32x4 w; w[0] = pk2(v0[0], v0[1]); w[1] = pk2(v0[2], v0[3]); w[2] = pk2(v1[0], v1[1]); w[3] = pk2(v1[2], v1[3]);
          *(u32x4*)(rowp + bj * HALF) = w;
        }
      }
  }
};

template <class Epi, class Sched>
DI void gemm_phase(PG8_LAS unsigned char* lds, const Gemm g, const Sched& S, const Epi& E) {
  int tid_ = threadIdx.x; asm volatile("" : "+v"(tid_));
  const int tid = tid_, wid = __builtin_amdgcn_readfirstlane(tid >> 6), lane = tid & 63, wr = wid >> 2, wc = wid & 3, fr = lane & 15, fq = lane >> 4;
  const int K = g.K, nt = K / BK;
  unsigned voffA[2], voffB[2];
#pragma unroll
  for (int i = 0; i < 2; ++i) { int R, C; stage_rc(tid * 16 + i * 8192, R, C); const int Rb = Epi::PERM ? ((R & ~31) + perm32(R & 31)) : R;
    voffA[i] = (unsigned)(R * K + C) * 2u; voffB[i] = (unsigned)(Rb * K + C) * 2u; }
  const size_t kstep = (size_t)(BK * 2);
  const size_t hstep = (size_t)HALF * K * 2;
  const size_t tstep = 2 * hstep;
  const unsigned ldsw = (unsigned)wid * 1024u;
  const int aoff = lds_byte(wr * 64 + fr, fq * 8), boff = lds_byte(wc * 32 + fr, fq * 8);
#define PG8_SA(b, h) (((b) * 2 + (h)) * HTB)
#define PG8_SB(b, h) ((4 + (b) * 2 + (h)) * HTB)
#define PG8_STAGE(bufoff, gbase, voff) do { _Pragma("unroll") for (int _i = 0; _i < 2; ++_i) \
    __builtin_amdgcn_global_load_lds((const unsigned*)((const char*)(gbase) + (voff)[_i]), (PG8_LAS unsigned*)(lds + (bufoff) + ldsw + _i * 8192), 16, 0, 0); } while (0)
#define PG8_LDA(dst, b, h) do { _Pragma("unroll") for (int m = 0; m < 4; ++m) _Pragma("unroll") for (int k = 0; k < 2; ++k) dst[m][k] = *(const PG8_LAS bf16x8*)(lds + PG8_SA(b, h) + aoff + m * 2048 + k * 1024); } while (0)
#define PG8_LDB(dst, b, h) do { _Pragma("unroll") for (int n = 0; n < 2; ++n) _Pragma("unroll") for (int k = 0; k < 2; ++k) dst[n][k] = *(const PG8_LAS bf16x8*)(lds + PG8_SB(b, h) + boff + n * 2048 + k * 1024); } while (0)
#define PG8_MMA(ai, bj, At, Bt) do { __builtin_amdgcn_s_setprio(1); _Pragma("unroll") for (int m = 0; m < 4; ++m) _Pragma("unroll") for (int n = 0; n < 2; ++n) _Pragma("unroll") for (int k = 0; k < 2; ++k) \
    acc[ai][bj][m][n] = __builtin_amdgcn_mfma_f32_16x16x32_bf16(Bt[n][k], At[m][k], acc[ai][bj][m][n], 0, 0, 0); __builtin_amdgcn_s_setprio(0); } while (0)
#define PG8_WAIT_V(n) asm volatile("s_waitcnt vmcnt(" #n ")" ::: "memory")
#define PG8_WAIT_L(n) asm volatile("s_waitcnt lgkmcnt(" #n ")" ::: "memory")
#define PG8_BAR __builtin_amdgcn_s_barrier()
#define PG8_SCHED __builtin_amdgcn_sched_barrier(0)
  Unit cur, nxt; int ui = 0;
  if (!S.next(0, cur)) return;
  f32x4 acc[2][2][4][2];
#pragma unroll
  for (int a = 0; a < 2; ++a)
#pragma unroll
    for (int b = 0; b < 2; ++b)
#pragma unroll
      for (int m = 0; m < 4; ++m)
#pragma unroll
        for (int n = 0; n < 2; ++n) acc[a][b][m][n] = (f32x4){0.f, 0.f, 0.f, 0.f};
  bf16x8 At[4][2], B0[2][2], B1[2][2];
  const char* cA = (const char*)g.A + (size_t)cur.pm * tstep; const char* cB = (const char*)g.Bt + (size_t)cur.pn * tstep;
  PG8_STAGE(PG8_SB(0, 0), cB, voffB); PG8_STAGE(PG8_SA(0, 0), cA, voffA); PG8_STAGE(PG8_SB(0, 1), cB + hstep, voffB); PG8_STAGE(PG8_SA(0, 1), cA + hstep, voffA);
  if (wr == 1) PG8_BAR;
  PG8_WAIT_V(4); PG8_BAR;
  PG8_STAGE(PG8_SB(1, 0), cB + kstep, voffB); PG8_STAGE(PG8_SA(1, 0), cA + kstep, voffA); PG8_STAGE(PG8_SB(1, 1), cB + hstep + kstep, voffB);
  PG8_WAIT_V(6); PG8_BAR;
  for (;;) {
    const bool has_next = S.next(ui + 1, nxt);
    const char* nA = has_next ? (const char*)g.A + (size_t)nxt.pm * tstep : cA; const char* nB = has_next ? (const char*)g.Bt + (size_t)nxt.pn * tstep : cB;
    for (int t = 0; t < nt; t += 2) {
      const bool last = (t == nt - 2);
      const char* a1 = cA + (size_t)(t + 1) * kstep;
      const char* a2 = last ? nA : cA + (size_t)(t + 2) * kstep; const char* b2 = last ? nB : cB + (size_t)(t + 2) * kstep;
      const char* a3 = a2 + kstep; const char* b3 = b2 + kstep;
      PG8_LDB(B0, 0, 0); PG8_SCHED; PG8_LDA(At, 0, 0); PG8_STAGE(PG8_SA(1, 1), a1 + hstep, voffA);
      PG8_WAIT_L(8); PG8_BAR; PG8_WAIT_L(0); PG8_MMA(0, 0, At, B0); PG8_BAR; PG8_SCHED;
      PG8_LDB(B1, 0, 1); PG8_STAGE(PG8_SB(0, 0), b2, voffB);
      PG8_BAR; PG8_WAIT_L(0); PG8_MMA(0, 1, At, B1); PG8_BAR;
      PG8_LDA(At, 0, 1); PG8_STAGE(PG8_SA(0, 0), a2, voffA);
      PG8_BAR; PG8_WAIT_L(0); PG8_MMA(1, 0, At, B0); PG8_BAR; PG8_SCHED;
      PG8_STAGE(PG8_SB(0, 1), b2 + hstep, voffB);
      PG8_WAIT_V(6); PG8_BAR; PG8_MMA(1, 1, At, B1); PG8_BAR;
      PG8_LDB(B0, 1, 0); PG8_SCHED; PG8_LDA(At, 1, 0); PG8_STAGE(PG8_SA(0, 1), a2 + hstep, voffA);
      PG8_WAIT_L(8); PG8_BAR; PG8_WAIT_L(0); PG8_MMA(0, 0, At, B0); PG8_BAR; PG8_SCHED;
      PG8_LDB(B1, 1, 1); PG8_STAGE(PG8_SB(1, 0), b3, voffB);
      PG8_BAR; PG8_WAIT_L(0); PG8_MMA(0, 1, At, B1); PG8_BAR;
      PG8_LDA(At, 1, 1); PG8_STAGE(PG8_SA(1, 0), a3, voffA);
      PG8_BAR; PG8_WAIT_L(0); PG8_MMA(1, 0, At, B0); PG8_BAR; PG8_SCHED;
      PG8_STAGE(PG8_SB(1, 1), b3 + hstep, voffB);
      PG8_WAIT_V(6); PG8_BAR; PG8_MMA(1, 1, At, B1); PG8_BAR;
    }
    E(acc, cur, wr, wc, fr, fq);
    if (!has_next) break;
#pragma unroll
    for (int a = 0; a < 2; ++a)
#pragma unroll
      for (int b = 0; b < 2; ++b)
#pragma unroll
        for (int m = 0; m < 4; ++m)
#pragma unroll
          for (int n = 0; n < 2; ++n) acc[a][b][m][n] = (f32x4){0.f, 0.f, 0.f, 0.f};
    cur = nxt; cA = nA; cB = nB; ++ui;
  }
  PG8_WAIT_V(0);
  if (wr == 0) PG8_BAR;
  PG8_BAR;
#undef PG8_SA
#undef PG8_SB
#undef PG8_STAGE
#undef PG8_LDA
#undef PG8_LDB
#undef PG8_MMA
#undef PG8_WAIT_V
#undef PG8_WAIT_L
#undef PG8_BAR
#undef PG8_SCHED
}
}

template <int ACT>
DI void gemm_run(const bf16_t* A, const bf16_t* Bt, int N, int K, bf16_t* C, int ldc, char* smem) {
  pg8::Gemm g; g.A = A; g.Bt = Bt; g.M = T_TOK; g.N = N; g.K = K;
  pg8::StaticOrder S; S.init(T_TOK, N, (int)gridDim.x, (int)blockIdx.x);
  pg8::EpiB<ACT> E; E.O = C; E.ldc = ldc;
  pg8::gemm_phase(( PG8_LAS unsigned char*)smem, g, S, E);
  __syncthreads();
}

DI void gla_gates(const Params& P, const bf16_t* proj, int b, int h, int n, float* sb, float* sseg, float* tmp) {
  const int tid = threadIdx.x & 255;
  float* sw = tmp;
  float* sg = tmp + 1024;
  {
    for (int e = tid; e < 1024; e += 256) sw[e] = P.gla_w_gate[(e >> 6) * 256 + h * 64 + (e & 63)];
    const int i = tid >> 2, part = tid & 3;
    const size_t t = (size_t)b * SEQ + n * 64 + i;
    const u32x2 gu = *(const u32x2*)(proj + t * PW + C_GLR + part * 4);
    sg[i * 17 + part * 4 + 0] = bflo(gu[0]); sg[i * 17 + part * 4 + 1] = bfhi(gu[0]);
    sg[i * 17 + part * 4 + 2] = bflo(gu[1]); sg[i * 17 + part * 4 + 3] = bfhi(gu[1]);
  }
  __syncthreads();
  {
    const int i = tid & 63, dq = tid >> 6;
    float z[16];
#pragma unroll
    for (int dd = 0; dd < 16; ++dd) z[dd] = P.gla_b_gate[h * 64 + dq * 16 + dd];
#pragma unroll 1
    for (int r = 0; r < 16; ++r) {
      const float gv = sg[i * 17 + r];
#pragma unroll
      for (int dd = 0; dd < 16; ++dd) z[dd] += gv * sw[r * 64 + dq * 16 + dd];
    }
#pragma unroll
    for (int dd = 0; dd < 16; ++dd) {
      const float zz = z[dd];
      const float ls = fminf(zz, 0.f) - __logf(1.f + __expf(-fabsf(zz)));
      sb[i * 65 + dq * 16 + dd] = ls * (1.f / 16.f);
    }
  }
  __syncthreads();
  const int d = tid & 63, seg = tid >> 6;
  float pre[16]; float run = 0.f;
#pragma unroll
  for (int ii = 0; ii < 16; ++ii) { run += sb[(seg * 16 + ii) * 65 + d]; pre[ii] = run; }
  sseg[seg * 64 + d] = run;
  __syncthreads();
  float off = 0.f;
#pragma unroll
  for (int s = 0; s < 4; ++s) off += (s < seg) ? sseg[s * 64 + d] : 0.f;
#pragma unroll
  for (int ii = 0; ii < 16; ++ii) sb[(seg * 16 + ii) * 65 + d] = pre[ii] + off;
  __syncthreads();
}

DI void gla_stage_vT(const bf16_t* proj, int b, int h, int n, bf16_t* vT) {
  const int tid = threadIdx.x & 255, j = tid & 63, q4 = tid >> 6;
  const size_t t = (size_t)b * SEQ + n * 64 + j;
  const bf16_t* src = proj + t * PW + C_GV + h * 128 + q4 * 32;
#pragma unroll
  for (int c = 0; c < 4; ++c) {
    const u32x4 u = *(const u32x4*)(src + c * 8);
#pragma unroll
    for (int e = 0; e < 4; ++e) {
      vT[(q4 * 32 + c * 8 + 2 * e) * 72 + j] = (bf16_t)(u[e] & 0xffffu);
      vT[(q4 * 32 + c * 8 + 2 * e + 1) * 72 + j] = (bf16_t)(u[e] >> 16);
    }
  }
}

DI void gla_p1_item(const Params& P, int item, char* smem) {
  const bf16_t* proj = (const bf16_t*)(P.ws + R1);
  float* states = (float*)(P.ws + R2);
  float* decay = (float*)(P.ws + R_DECAY);
  float* sb = (float*)smem; float* sseg = sb + 64 * 65;
  bf16_t* kendT = (bf16_t*)(sseg + 256); bf16_t* vT = kendT + 64 * 72;
  const int n = item & 127, h = (item >> 7) & 3, b = item >> 9;
  const int tid = threadIdx.x & 255, lane = tid & 63, wave = tid >> 6, l32 = lane & 31, kb = lane >> 5;
  gla_gates(P, proj, b, h, n, sb, sseg, (float*)vT);
  {
    const int j = tid & 63, dq = tid >> 6;
    const size_t t = (size_t)b * SEQ + n * 64 + j;
    const u32x4 k0 = *(const u32x4*)(proj + t * PW + C_GK + h * 64 + dq * 16), k1 = *(const u32x4*)(proj + t * PW + C_GK + h * 64 + dq * 16 + 8);
    float kv[16];
#pragma unroll
    for (int e = 0; e < 4; ++e) { kv[2 * e] = bflo(k0[e]); kv[2 * e + 1] = bfhi(k0[e]); kv[8 + 2 * e] = bflo(k1[e]); kv[8 + 2 * e + 1] = bfhi(k1[e]); }
#pragma unroll
    for (int dd = 0; dd < 16; ++dd) {
      const int d = dq * 16 + dd;
      kendT[d * 72 + j] = f2bf(kv[dd] * __expf(sb[63 * 65 + d] - sb[j * 65 + d]));
    }
    if (tid < 64) decay[((size_t)(b * 4 + h) * 128 + n) * 64 + tid] = __expf(sb[63 * 65 + tid]);
  }
  gla_stage_vT(proj, b, h, n, vT);
  __syncthreads();
#pragma unroll
  for (int dt = 0; dt < 2; ++dt) {
    f32x16 acc = zero16();
#pragma unroll
    for (int s = 0; s < 4; ++s) {
      const bf16x8 a = *(const bf16x8*)(vT + (wave * 32 + l32) * 72 + s * 16 + kb * 8);
      const bf16x8 bb = *(const bf16x8*)(kendT + (dt * 32 + l32) * 72 + s * 16 + kb * 8);
      acc = mfma(a, bb, acc);
    }
    float* dst = states + ((size_t)((b * 4 + h) * 128 + n) * 128) * 64;
#pragma unroll
    for (int r = 0; r < 16; ++r) dst[(size_t)(wave * 32 + crow(r, kb)) * 64 + dt * 32 + l32] = acc[r];
  }
  __syncthreads();
}

DI void gla_scan(const Params& P) {
  float* states = (float*)(P.ws + R2);
  const float* decay = (const float*)(P.ws + R_DECAY);
  const int total = 32 * 8192;
  for (int e = blockIdx.x * blockDim.x + threadIdx.x; e < total; e += gridDim.x * blockDim.x) {
    const int bh = e >> 13, idx = e & 8191, d = idx & 63;
    float* p = states + (size_t)bh * 128 * 8192 + idx;
    const float* dc = decay + (size_t)bh * 128 * 64 + d;
    float S = 0.f;
#pragma unroll 8
    for (int n = 0; n < 128; ++n) {
      const float ds = p[(size_t)n * 8192];
      const float dec = dc[n * 64];
      p[(size_t)n * 8192] = S;
      S = dec * S + ds;
    }
  }
}

DI void gla_p3_item(const Params& P, int item, char* smem) {
  const bf16_t* proj = (const bf16_t*)(P.ws + R1);
  const float* states = (const float*)(P.ws + R2);
  bf16_t* mix = (bf16_t*)(P.ws + R3);
  float* sb = (float*)smem; float* sseg = sb + 64 * 65; float* sred = sseg + 256;
  bf16_t* sq = (bf16_t*)(sred + 256); bf16_t* sk = sq + 64 * 72; bf16_t* vT = sk + 64 * 72;
  const int n = item & 127, h = (item >> 7) & 3, b = item >> 9;
  const int tid = threadIdx.x & 255, lane = tid & 63, wave = tid >> 6, l32 = lane & 31, kb = lane >> 5;
  gla_gates(P, proj, b, h, n, sb, sseg, (float*)vT);
  {
    const int i = tid & 63, dq = tid >> 6;
    const size_t t = (size_t)b * SEQ + n * 64 + i;
    const u32x4 q0 = *(const u32x4*)(proj + t * PW + C_GQ + h * 64 + dq * 16), q1 = *(const u32x4*)(proj + t * PW + C_GQ + h * 64 + dq * 16 + 8);
    const u32x4 k0 = *(const u32x4*)(proj + t * PW + C_GK + h * 64 + dq * 16), k1 = *(const u32x4*)(proj + t * PW + C_GK + h * 64 + dq * 16 + 8);
    float qv[16], kv[16];
#pragma unroll
    for (int e = 0; e < 4; ++e) {
      qv[2 * e] = bflo(q0[e]); qv[2 * e + 1] = bfhi(q0[e]); qv[8 + 2 * e] = bflo(q1[e]); qv[8 + 2 * e + 1] = bfhi(q1[e]);
      kv[2 * e] = bflo(k0[e]); kv[2 * e + 1] = bfhi(k0[e]); kv[8 + 2 * e] = bflo(k1[e]); kv[8 + 2 * e + 1] = bfhi(k1[e]);
    }
#pragma unroll
    for (int dd = 0; dd < 16; ++dd) {
      const int d = dq * 16 + dd;
      const float bb = sb[i * 65 + d];
      sq[i * 72 + d] = f2bf(qv[dd] * 0.125f * __expf(bb));
      sk[i * 72 + d] = f2bf(kv[dd] * __expf(-bb));
    }
  }
  gla_stage_vT(proj, b, h, n, vT);
  __syncthreads();
  f32x16 x00 = zero16(), x01 = zero16(), x11 = zero16();
#pragma unroll
  for (int s = 0; s < 4; ++s) {
    const bf16x8 kj0 = *(const bf16x8*)(sk + (l32)*72 + s * 16 + kb * 8);
    const bf16x8 kj1 = *(const bf16x8*)(sk + (32 + l32) * 72 + s * 16 + kb * 8);
    const bf16x8 qi0 = *(const bf16x8*)(sq + (l32)*72 + s * 16 + kb * 8);
    const bf16x8 qi1 = *(const bf16x8*)(sq + (32 + l32) * 72 + s * 16 + kb * 8);
    x00 = mfma(kj0, qi0, x00); x01 = mfma(kj0, qi1, x01); x11 = mfma(kj1, qi1, x11);
  }
#pragma unroll
  for (int r = 0; r < 16; ++r) { const bool keep = crow(r, kb) <= l32; x00[r] = keep ? x00[r] : 0.f; x11[r] = keep ? x11[r] : 0.f; }
  f32x16 o0 = zero16(), o1 = zero16();
  const int dvr = wave * 32 + l32;
#pragma unroll
  for (int s = 0; s < 2; ++s) {
    const bf16x8 p00 = pack8(x00[8 * s], x00[8 * s + 1], x00[8 * s + 2], x00[8 * s + 3], x00[8 * s + 4], x00[8 * s + 5], x00[8 * s + 6], x00[8 * s + 7]);
    const bf16x8 p01 = pack8(x01[8 * s], x01[8 * s + 1], x01[8 * s + 2], x01[8 * s + 3], x01[8 * s + 4], x01[8 * s + 5], x01[8 * s + 6], x01[8 * s + 7]);
    const bf16x8 p11 = pack8(x11[8 * s], x11[8 * s + 1], x11[8 * s + 2], x11[8 * s + 3], x11[8 * s + 4], x11[8 * s + 5], x11[8 * s + 6], x11[8 * s + 7]);
    const bf16x8 v0 = ld2x4(vT + dvr * 72 + 16 * s + 4 * kb);
    const bf16x8 v1 = ld2x4(vT + dvr * 72 + 32 + 16 * s + 4 * kb);
    o0 = mfma(v0, p00, o0); o1 = mfma(v0, p01, o1); o1 = mfma(v1, p11, o1);
  }
  {
    const float* sp = states + ((size_t)((b * 4 + h) * 128 + n) * 128 + dvr) * 64;
#pragma unroll
    for (int s = 0; s < 4; ++s) {
      const float4 f0 = *(const float4*)(sp + s * 16 + kb * 8), f1 = *(const float4*)(sp + s * 16 + kb * 8 + 4);
      const bf16x8 a = pack8(f0.x, f0.y, f0.z, f0.w, f1.x, f1.y, f1.z, f1.w);
      const bf16x8 qi0 = *(const bf16x8*)(sq + (l32)*72 + s * 16 + kb * 8);
      const bf16x8 qi1 = *(const bf16x8*)(sq + (32 + l32) * 72 + s * 16 + kb * 8);
      o0 = mfma(a, qi0, o0); o1 = mfma(a, qi1, o1);
    }
  }
  float s0 = 0.f, s1 = 0.f;
#pragma unroll
  for (int r = 0; r < 16; ++r) { s0 += o0[r] * o0[r]; s1 += o1[r] * o1[r]; }
  s0 += __shfl_xor(s0, 32); s1 += __shfl_xor(s1, 32);
  if (kb == 0) { sred[wave * 64 + l32] = s0; sred[wave * 64 + 32 + l32] = s1; }
  __syncthreads();
  const float t0s = sred[l32] + sred[64 + l32] + sred[128 + l32] + sred[192 + l32];
  const float t1s = sred[32 + l32] + sred[64 + 32 + l32] + sred[128 + 32 + l32] + sred[192 + 32 + l32];
  const float r0 = rsqrtf(t0s * (1.f / 128.f) + EPS), r1 = rsqrtf(t1s * (1.f / 128.f) + EPS);
#pragma unroll
  for (int it = 0; it < 2; ++it) {
    const size_t t = (size_t)b * SEQ + n * 64 + it * 32 + l32;
    const float rr = it ? r1 : r0;
#pragma unroll
    for (int gq = 0; gq < 4; ++gq) {
      const int dv = wave * 32 + 8 * gq + 4 * kb;
      const u32x2 ru = *(const u32x2*)(proj + t * PW + C_GR + h * 128 + dv);
      const float4 gn = *(const float4*)(P.gla_norm + h * 128 + dv);
      float rv[4] = {bflo(ru[0]), bfhi(ru[0]), bflo(ru[1]), bfhi(ru[1])};
      float gv[4] = {gn.x, gn.y, gn.z, gn.w};
      float ov[4];
#pragma unroll
      for (int e = 0; e < 4; ++e) {
        const float a = it ? o1[gq * 4 + e] : o0[gq * 4 + e];
        ov[e] = a * rr * gv[e] * (rv[e] / (1.f + __expf(-rv[e])));
      }
      u32x2 o; o[0] = pk2(ov[0], ov[1]); o[1] = pk2(ov[2], ov[3]);
      *(u32x2*)(mix + t * DM + h * 128 + dv) = o;
    }
  }
  __syncthreads();
}

DI void nsa_compress_task(const Params& P, int task) {
  const bf16_t* proj = (const bf16_t*)(P.ws + R1);
  const int lane = threadIdx.x & 63, l32 = lane & 31, kb = lane >> 5;
  const int ct = task & 15, g = (task >> 4) & 1, b = (task >> 5) & 7, br = task >> 8;
  const bf16_t* w1T = (const bf16_t*)(P.ws + W_CW1) + (size_t)br * 128 * 2048;
  const bf16_t* w2T = (const bf16_t*)(P.ws + W_CW2) + (size_t)br * 64 * 128;
  const float* bias1 = (const float*)(P.ws + W_BIAS1) + br * 128;
  const int c = ct * 32 + l32;
  const int cc = c < 511 ? c : 510;
  const bf16_t* src = proj + ((size_t)b * SEQ + cc * 16) * PW + (br ? C_VC : C_KC) + g * 64 + kb * 8;
  f32x16 acc[4];
#pragma unroll
  for (int i = 0; i < 4; ++i) acc[i] = zero16();
#pragma unroll 1
  for (int ks = 0; ks < 128; ++ks) {
    const int l = ks >> 2, dh0 = (ks & 3) * 16;
    const bf16x8 bf = *(const bf16x8*)(src + (size_t)l * PW + dh0);
#pragma unroll
    for (int ht = 0; ht < 4; ++ht) {
      const bf16x8 af = *(const bf16x8*)(w1T + (size_t)(ht * 32 + l32) * 2048 + ks * 16 + kb * 8);
      acc[ht] = mfma(af, bf, acc[ht]);
    }
  }
#pragma unroll
  for (int ht = 0; ht < 4; ++ht)
#pragma unroll
    for (int r = 0; r < 16; ++r) acc[ht][r] = gelu_tanh(acc[ht][r] + bias1[ht * 32 + crow(r, kb)]);
  f32x16 o[2]; o[0] = zero16(); o[1] = zero16();
#pragma unroll
  for (int ht = 0; ht < 4; ++ht)
#pragma unroll
    for (int s = 0; s < 2; ++s) {
      const bf16x8 hf = pack8(acc[ht][8 * s], acc[ht][8 * s + 1], acc[ht][8 * s + 2], acc[ht][8 * s + 3], acc[ht][8 * s + 4], acc[ht][8 * s + 5], acc[ht][8 * s + 6], acc[ht][8 * s + 7]);
#pragma unroll
      for (int dt = 0; dt < 2; ++dt) {
        const bf16x8 wf = ld2x4(w2T + (size_t)(dt * 32 + l32) * 128 + ht * 32 + 16 * s + 4 * kb);
        o[dt] = mfma(wf, hf, o[dt]);
      }
    }
  if (c < 511) {
    if (br == 0) {
      bf16_t* dst = (bf16_t*)(P.ws + R_KCMP) + ((size_t)(b * 2 + g) * 512 + c) * 64;
#pragma unroll
      for (int dt = 0; dt < 2; ++dt)
#pragma unroll
        for (int gq = 0; gq < 4; ++gq) {
          u32x2 u; u[0] = pk2(o[dt][gq * 4], o[dt][gq * 4 + 1]); u[1] = pk2(o[dt][gq * 4 + 2], o[dt][gq * 4 + 3]);
          *(u32x2*)(dst + dt * 32 + 8 * gq + 4 * kb) = u;
        }
    } else {
      bf16_t* dst = (bf16_t*)(P.ws + R_VCMPT) + (size_t)(b * 2 + g) * 64 * 512 + c;
#pragma unroll
      for (int dt = 0; dt < 2; ++dt)
#pragma unroll
        for (int r = 0; r < 16; ++r) dst[(size_t)(dt * 32 + crow(r, kb)) * 512] = f2bf(o[dt][r]);
    }
  }
}

DI void nsa_transpose_v(const Params& P) {
  const bf16_t* proj = (const bf16_t*)(P.ws + R1);
  const int total = 2 * 8 * 2 * 1024 * 64;
  for (int u = blockIdx.x * blockDim.x + threadIdx.x; u < total; u += gridDim.x * blockDim.x) {
    const int dh = u & 63; int rest = u >> 6; const int t8 = rest & 1023; rest >>= 10;
    const int g = rest & 1, b = (rest >> 1) & 7, which = rest >> 4;
    const bf16_t* src = proj + ((size_t)b * SEQ + t8 * 8) * PW + (which ? C_VW : C_VS) + g * 64 + dh;
    bf16_t v[8];
#pragma unroll
    for (int j = 0; j < 8; ++j) v[j] = src[(size_t)j * PW];
    u32x4 o;
#pragma unroll
    for (int j = 0; j < 4; ++j) o[j] = (unsigned)v[2 * j] | ((unsigned)v[2 * j + 1] << 16);
    bf16_t* dst = (bf16_t*)(P.ws + (which ? R_VWT : R_VST)) + ((size_t)(b * 2 + g) * 64 + dh) * SEQ + t8 * 8;
    *(u32x4*)dst = o;
  }
}

DI f32x16 qk_tile(const bf16_t* krow, const bf16x8 (&qf)[4]) {
  f32x16 s = zero16();
#pragma unroll
  for (int i = 0; i < 4; ++i) { const bf16x8 kf = *(const bf16x8*)(krow + i * 16); s = mfma(kf, qf[i], s); }
  return s;
}

DI void attn_tile(const bf16_t* krow, const bf16_t* vt0, const bf16x8 (&qf)[4], int k0, int tq, int lo, bool bit, int kb,
                  f32x16& o0, f32x16& o1, float& m, float& l) {
  f32x16 s = qk_tile(krow, qf);
  float tmax = -1e30f;
  bool vd[16];
#pragma unroll
  for (int r = 0; r < 16; ++r) {
    const int key = k0 + crow(r, kb);
    vd[r] = bit && (key <= tq) && (key > lo);
    s[r] = vd[r] ? s[r] * 0.125f : -1e30f;
    tmax = fmaxf(tmax, s[r]);
  }
  tmax = fmaxf(tmax, __shfl_xor(tmax, 32));
  const float mn = fmaxf(m, tmax);
  const float alpha = __expf(m - mn);
  float ps = 0.f;
#pragma unroll
  for (int r = 0; r < 16; ++r) { s[r] = vd[r] ? __expf(s[r] - mn) : 0.f; ps += s[r]; }
  l = l * alpha + ps; m = mn;
#pragma unroll
  for (int r = 0; r < 16; ++r) { o0[r] *= alpha; o1[r] *= alpha; }
#pragma unroll
  for (int sI = 0; sI < 2; ++sI) {
    const bf16x8 pf = pack8(s[8 * sI], s[8 * sI + 1], s[8 * sI + 2], s[8 * sI + 3], s[8 * sI + 4], s[8 * sI + 5], s[8 * sI + 6], s[8 * sI + 7]);
    const bf16x8 va = ld2x4(vt0 + k0 + 16 * sI);
    const bf16x8 vb = ld2x4(vt0 + (size_t)32 * SEQ + k0 + 16 * sI);
    o0 = mfma(va, pf, o0); o1 = mfma(vb, pf, o1);
  }
}

DI void nsa_task(const Params& P, int b, int g, int qt, float* imp) {
  const bf16_t* proj = (const bf16_t*)(P.ws + R1);
  bf16_t* mix = (bf16_t*)(P.ws + R3);
  const int lane = threadIdx.x & 63, l32 = lane & 31, kb = lane >> 5;
  const int t0 = qt * 32, tq = t0 + l32;
  const size_t tokq = (size_t)b * SEQ + tq;
  const bf16_t* qrow = proj + tokq * PW;
  const bf16_t* kcmp = (const bf16_t*)(P.ws + R_KCMP) + (size_t)(b * 2 + g) * 512 * 64;
  const bf16_t* vcmpT = (const bf16_t*)(P.ws + R_VCMPT) + (size_t)(b * 2 + g) * 64 * 512;
  for (int i = lane; i < 4096; i += 64) imp[i] = 0.f;
  const int nct = (qt >> 4) + 1;
  for (int hh = 0; hh < 4; ++hh) {
    const int head = g * 4 + hh;
    bf16x8 qf[4];
#pragma unroll
    for (int i = 0; i < 4; ++i) qf[i] = *(const bf16x8*)(qrow + C_NQ + head * 64 + i * 16 + kb * 8);
    float m = -1e30f, l = 0.f;
    for (int ct = 0; ct < nct; ++ct) {
      f32x16 s = qk_tile(kcmp + (size_t)(ct * 32 + l32) * 64 + kb * 8, qf);
      float tmax = -1e30f;
#pragma unroll
      for (int r = 0; r < 16; ++r) {
        const int c = ct * 32 + crow(r, kb);
        const bool vd = (c * 16 + 31 <= tq);
        s[r] = vd ? s[r] * 0.125f : -1e30f;
        tmax = fmaxf(tmax, s[r]);
      }
      const float mn = fmaxf(m, tmax);
      float ps = 0.f;
#pragma unroll
      for (int r = 0; r < 16; ++r) ps += (s[r] > -5e29f) ? __expf(s[r] - mn) : 0.f;
      l = l * __expf(m - mn) + ps; m = mn;
    }
    const float mo = __shfl_xor(m, 32), lo_ = __shfl_xor(l, 32);
    const float M = fmaxf(m, mo);
    const float L = l * __expf(m - M) + lo_ * __expf(mo - M);
    const float invL = 1.f / fmaxf(L, 1e-30f);
    f32x16 o0 = zero16(), o1 = zero16();
    float carry = 0.f;
    for (int ct = 0; ct < nct; ++ct) {
      f32x16 s = qk_tile(kcmp + (size_t)(ct * 32 + l32) * 64 + kb * 8, qf);
#pragma unroll
      for (int r = 0; r < 16; ++r) {
        const int c = ct * 32 + crow(r, kb);
        const bool vd = (c * 16 + 31 <= tq);
        s[r] = vd ? __expf(s[r] * 0.125f - M) * invL : 0.f;
      }
      float y[4];
#pragma unroll
      for (int gi = 0; gi < 4; ++gi) y[gi] = __shfl_xor(s[4 * gi + 3], 32);
#pragma unroll
      for (int gi = 0; gi < 4; ++gi) {
        const float s4 = (s[4 * gi] + s[4 * gi + 1]) + (s[4 * gi + 2] + s[4 * gi + 3]);
        const float extra = kb ? y[gi] : (gi == 0 ? carry : y[gi > 0 ? gi - 1 : 0]);
        const int j = ct * 8 + 2 * gi + kb;
        imp[j * 32 + l32] += s4 + extra;
      }
      carry = y[3];
#pragma unroll
      for (int sI = 0; sI < 2; ++sI) {
        const bf16x8 pf = pack8(s[8 * sI], s[8 * sI + 1], s[8 * sI + 2], s[8 * sI + 3], s[8 * sI + 4], s[8 * sI + 5], s[8 * sI + 6], s[8 * sI + 7]);
        const bf16x8 va = ld2x4(vcmpT + (size_t)(l32)*512 + ct * 32 + 16 * sI + 4 * kb);
        const bf16x8 vb = ld2x4(vcmpT + (size_t)(32 + l32) * 512 + ct * 32 + 16 * sI + 4 * kb);
        o0 = mfma(va, pf, o0); o1 = mfma(vb, pf, o1);
      }
    }
    const float g0 = sigmoidf_(bf2f(qrow[C_NG + head * 3 + 0]) + P.nsa_gate_b[head * 3 + 0]);
#pragma unroll
    for (int gq = 0; gq < 4; ++gq) {
      u32x2 u0, u1;
      u0[0] = pk2(g0 * o0[gq * 4], g0 * o0[gq * 4 + 1]); u0[1] = pk2(g0 * o0[gq * 4 + 2], g0 * o0[gq * 4 + 3]);
      u1[0] = pk2(g0 * o1[gq * 4], g0 * o1[gq * 4 + 1]); u1[1] = pk2(g0 * o1[gq * 4 + 2], g0 * o1[gq * 4 + 3]);
      *(u32x2*)(mix + tokq * DM + 512 + head * 64 + 8 * gq + 4 * kb) = u0;
      *(u32x2*)(mix + tokq * DM + 512 + head * 64 + 32 + 8 * gq + 4 * kb) = u1;
    }
  }
  asm volatile("s_waitcnt lgkmcnt(0)" ::: "memory");
  __builtin_amdgcn_wave_barrier();
  unsigned mk0 = 0, mk1 = 0, mk2 = 0, mk3 = 0;
  for (int q = 0; q < 32; ++q) {
    const int tqq = t0 + q, cur = tqq >> 6;
    const float v0 = imp[lane * 32 + q], v1 = imp[(lane + 64) * 32 + q];
    const int j0 = lane, j1 = lane + 64;
    const float s0 = (j0 == 0 || j0 == cur || j0 == cur - 1) ? 1e30f : (j0 <= cur ? v0 : -1e30f);
    const float s1 = (j1 == cur || j1 == cur - 1) ? 1e30f : (j1 <= cur ? v1 : -1e30f);
    int c0 = 0, c1 = 0;
#pragma unroll
    for (int k = 0; k < 64; ++k) {
      const float a0 = __int_as_float(__builtin_amdgcn_readlane(__float_as_int(s0), k));
      const float a1 = __int_as_float(__builtin_amdgcn_readlane(__float_as_int(s1), k));
      c0 += ((a0 > s0) || (a0 == s0 && k < lane)) ? 1 : 0;
      c0 += (a1 > s0) ? 1 : 0;
      c1 += (a0 >= s1) ? 1 : 0;
      c1 += ((a1 > s1) || (a1 == s1 && k < lane)) ? 1 : 0;
    }
    const bool sel0 = (s0 > -5e29f) && (c0 < 16);
    const bool sel1 = (s1 > -5e29f) && (c1 < 16);
    const unsigned long long blo = __ballot(sel0), bhi = __ballot(sel1);
    if (l32 == q) { mk0 = (unsigned)blo; mk1 = (unsigned)(blo >> 32); mk2 = (unsigned)bhi; mk3 = (unsigned)(bhi >> 32); }
  }
  asm volatile("" ::: "memory");
  const bf16_t* ksel = proj + (size_t)b * SEQ * PW + C_KS + g * 64 + kb * 8;
  const bf16_t* kwin = proj + (size_t)b * SEQ * PW + C_KW + g * 64 + kb * 8;
  const bf16_t* vsT = (const bf16_t*)(P.ws + R_VST) + ((size_t)(b * 2 + g) * 64 + l32) * SEQ + 4 * kb;
  const bf16_t* vwT = (const bf16_t*)(P.ws + R_VWT) + ((size_t)(b * 2 + g) * 64 + l32) * SEQ + 4 * kb;
  for (int hh = 0; hh < 4; ++hh) {
    const int head = g * 4 + hh;
    bf16x8 qf[4];
#pragma unroll
    for (int i = 0; i < 4; ++i) qf[i] = *(const bf16x8*)(qrow + C_NQ + head * 64 + i * 16 + kb * 8);
    f32x16 a0 = zero16(), a1 = zero16(); float m = -1e30f, l = 0.f;
    for (int kt = 0; kt <= qt; ++kt) {
      const int j = kt >> 1;
      const unsigned mw = j < 32 ? mk0 : (j < 64 ? mk1 : (j < 96 ? mk2 : mk3));
      const bool bit = (mw >> (j & 31)) & 1u;
      if (__ballot(bit) == 0ull) continue;
      attn_tile(ksel + (size_t)(kt * 32 + l32) * PW, vsT, qf, kt * 32, tq, -1, bit, kb, a0, a1, m, l);
    }
    float lt = l + __shfl_xor(l, 32);
    const float g1 = sigmoidf_(bf2f(qrow[C_NG + head * 3 + 1]) + P.nsa_gate_b[head * 3 + 1]);
    const float f1 = g1 / fmaxf(lt, 1e-30f);
    f32x16 w0 = zero16(), w1 = zero16(); m = -1e30f; l = 0.f;
    const int ktb = qt > 16 ? qt - 16 : 0;
    for (int kt = ktb; kt <= qt; ++kt)
      attn_tile(kwin + (size_t)(kt * 32 + l32) * PW, vwT, qf, kt * 32, tq, tq - 512, true, kb, w0, w1, m, l);
    lt = l + __shfl_xor(l, 32);
    const float g2 = sigmoidf_(bf2f(qrow[C_NG + head * 3 + 2]) + P.nsa_gate_b[head * 3 + 2]);
    const float f2 = g2 / fmaxf(lt, 1e-30f);
#pragma unroll
    for (int gq = 0; gq < 4; ++gq) {
      bf16_t* d0 = mix + tokq * DM + 512 + head * 64 + 8 * gq + 4 * kb;
      bf16_t* d1 = d0 + 32;
      const u32x2 p0 = *(const u32x2*)d0, p1 = *(const u32x2*)d1;
      u32x2 u0, u1;
      u0[0] = pk2(bflo(p0[0]) + f1 * a0[gq * 4] + f2 * w0[gq * 4], bfhi(p0[0]) + f1 * a0[gq * 4 + 1] + f2 * w0[gq * 4 + 1]);
      u0[1] = pk2(bflo(p0[1]) + f1 * a0[gq * 4 + 2] + f2 * w0[gq * 4 + 2], bfhi(p0[1]) + f1 * a0[gq * 4 + 3] + f2 * w0[gq * 4 + 3]);
      u1[0] = pk2(bflo(p1[0]) + f1 * a1[gq * 4] + f2 * w1[gq * 4], bfhi(p1[0]) + f1 * a1[gq * 4 + 1] + f2 * w1[gq * 4 + 1]);
      u1[1] = pk2(bflo(p1[1]) + f1 * a1[gq * 4 + 2] + f2 * w1[gq * 4 + 2], bfhi(p1[1]) + f1 * a1[gq * 4 + 3] + f2 * w1[gq * 4 + 3]);
      *(u32x2*)d0 = u0; *(u32x2*)d1 = u1;
    }
  }
  asm volatile("s_waitcnt lgkmcnt(0)" ::: "memory");
}

DI void sgu_item(const Params& P, int item, char* smem) {
  const bf16_t* H = (const bf16_t*)(P.ws + R1);
  bf16_t* Y = (bf16_t*)(P.ws + R2);
  float* smu = (float*)smem; float* srs = smu + 128; float* sc1 = srs + 128; float* srw = sc1 + 128;
  bf16_t* sW = (bf16_t*)(srw + 128); bf16_t* sV = sW + 128 * 136;
  const int tid = threadIdx.x & 255, lane = tid & 63, wave = tid >> 6, l32 = lane & 31, kb = lane >> 5;
  const size_t tok0 = (size_t)item * 128;
  for (int tt = 0; tt < 32; ++tt) {
    const int t = wave * 32 + tt;
    const bf16_t* vr = H + (tok0 + t) * 4096 + 2048;
    float s = 0.f, s2 = 0.f;
#pragma unroll
    for (int k = 0; k < 4; ++k) {
      const u32x4 u = *(const u32x4*)(vr + k * 512 + lane * 8);
#pragma unroll
      for (int e = 0; e < 4; ++e) { const float a = bflo(u[e]), c = bfhi(u[e]); s += a + c; s2 += a * a + c * c; }
    }
    s = wave_sum(s); s2 = wave_sum(s2);
    const float mu = s * (1.f / 2048.f);
    const float var = fmaxf(s2 * (1.f / 2048.f) - mu * mu, 0.f);
    if (lane == 0) { smu[t] = mu; srs[t] = rsqrtf(var + EPS); }
  }
  __syncthreads();
  for (int g = 0; g < 8; ++g) {
    {
      const int t = tid >> 1, half = tid & 1;
      const float* wrow = P.o_w_s + ((size_t)g * 128 + t) * 128 + half * 64;
      float c1 = 0.f, rw = 0.f;
#pragma unroll 1
      for (int c8 = 0; c8 < 8; ++c8) {
        const float4 f0 = *(const float4*)(wrow + c8 * 8), f1 = *(const float4*)(wrow + c8 * 8 + 4);
        float wv[8] = {f0.x, f0.y, f0.z, f0.w, f1.x, f1.y, f1.z, f1.w};
        float ov[8];
#pragma unroll
        for (int e = 0; e < 8; ++e) {
          const int s = half * 64 + c8 * 8 + e;
          const float w = (s <= t) ? wv[e] : 0.f;
          rw += w;
          const float wp = bf2f(f2bf(w * srs[s]));
          c1 += wp * smu[s];
          ov[e] = wp;
        }
        u32x4 o; o[0] = pk2(ov[0], ov[1]); o[1] = pk2(ov[2], ov[3]); o[2] = pk2(ov[4], ov[5]); o[3] = pk2(ov[6], ov[7]);
        *(u32x4*)(sW + t * 136 + half * 64 + c8 * 8) = o;
      }
      c1 += __shfl_xor(c1, 1); rw += __shfl_xor(rw, 1);
      if (half == 0) { sc1[t] = c1; srw[t] = rw; }
    }
    for (int sub = 0; sub < 4; ++sub) {
      const int ch0 = g * 256 + sub * 64;
      {
        const int s = tid >> 1, half = tid & 1;
        const bf16_t* src = H + (tok0 + s) * 4096 + 2048 + ch0 + half * 32;
#pragma unroll
        for (int c = 0; c < 4; ++c) {
          const u32x4 u = *(const u32x4*)(src + c * 8);
#pragma unroll
          for (int e = 0; e < 4; ++e) {
            sV[(half * 32 + c * 8 + 2 * e) * 136 + s] = (bf16_t)(u[e] & 0xffffu);
            sV[(half * 32 + c * 8 + 2 * e + 1) * 136 + s] = (bf16_t)(u[e] >> 16);
          }
        }
      }
      __syncthreads();
      f32x16 acc0 = zero16(), acc1 = zero16();
      const int nks = 2 * (wave + 1);
      for (int ks = 0; ks < nks; ++ks) {
        const bf16x8 a = *(const bf16x8*)(sW + (wave * 32 + l32) * 136 + ks * 16 + kb * 8);
        const bf16x8 b0 = *(const bf16x8*)(sV + (l32)*136 + ks * 16 + kb * 8);
        const bf16x8 b1 = *(const bf16x8*)(sV + (32 + l32) * 136 + ks * 16 + kb * 8);
        acc0 = mfma(a, b0, acc0); acc1 = mfma(a, b1, acc1);
      }
#pragma unroll
      for (int ct = 0; ct < 2; ++ct) {
        const int ch = ch0 + ct * 32 + l32;
        const float lg = P.o_ln_g[ch], lb = P.o_ln_b[ch];
#pragma unroll
        for (int r = 0; r < 16; ++r) {
          const int t = wave * 32 + crow(r, kb);
          const float a = ct ? acc1[r] : acc0[r];
          const float mixed = lg * (a - sc1[t]) + lb * srw[t] + P.o_b_s[g * 128 + t];
          const float u = bf2f(H[(tok0 + t) * 4096 + ch]);
          Y[(tok0 + t) * 2048 + ch] = f2bf(u * mixed);
          if ((r & 3) == 3) __builtin_amdgcn_sched_barrier(0);
        }
      }
      __syncthreads();
    }
  }
}

constexpr int NPHASE = 17;
DI void run_phase(const Params& P, int ph, char* smem) {
  char* ws = P.ws;
  bf16_t* r1 = (bf16_t*)(ws + R1); bf16_t* r2 = (bf16_t*)(ws + R2); bf16_t* r3 = (bf16_t*)(ws + R3); bf16_t* r4 = (bf16_t*)(ws + R4);
  unsigned* cnt = (unsigned*)(ws + W_CNT);
  const int lane = threadIdx.x & 63, wave = threadIdx.x >> 6, half = threadIdx.x >> 8;
  char* hsmem = smem + half * 65536;
  switch (ph) {
    case 0: phase_prep(P); break;
    case 1: gemm_run<0>(r2, (const bf16_t*)(ws + W_EIN), PW, 1024, r1, PW, smem); break;
    case 2: {
      nsa_transpose_v(P);
      if (blockIdx.x < 64) nsa_compress_task(P, blockIdx.x * WPB + wave);
      volatile int* s_item = (volatile int*)(smem + LDS_BYTES - 16);
      for (;;) {
        __syncthreads();
        if (threadIdx.x == 0) *s_item = (int)atomicAdd(cnt + 0, 1u);
        __syncthreads();
        const int pair = *s_item;
        if (pair >= 2048) break;
        gla_p1_item(P, pair * 2 + half, hsmem);
      }
    } break;
    case 3: {
      gla_scan(P);
      float* imp = (float*)smem + wave * 4096;
      for (;;) {
        int tk = 0;
        if (lane == 0) tk = (int)atomicAdd(cnt + 1, 1u);
        tk = __builtin_amdgcn_readfirstlane(tk);
        if (tk >= 4096) break;
        const int qt = 255 - (tk >> 4), bg = tk & 15;
        nsa_task(P, bg >> 1, bg & 1, qt, imp);
      }
    } break;
    case 4:
      for (int item = blockIdx.x * 2 + half; item < 4096; item += gridDim.x * 2) gla_p3_item(P, item, hsmem);
      break;
    case 5: gemm_run<0>(r3, (const bf16_t*)(ws + W_EOUT), 1024, 1024, r4, 1024, smem); break;
    case 6: resnorm_rows(r4, P.x, P.out, P.norm_g + 1 * 1024, P.norm_g + 2 * 1024, r2); break;
    case 7: gemm_run<1>(r2, (const bf16_t*)(ws + W_FFN1_0), 4096, 1024, r1, 4096, smem); break;
    case 8: gemm_run<0>(r1, (const bf16_t*)(ws + W_FFN2_0), 1024, 4096, r4, 1024, smem); break;
    case 9: resnorm_rows(r4, P.out, P.out, P.norm_g + 3 * 1024, P.norm_g + 4 * 1024, r2); break;
    case 10: gemm_run<2>(r2, (const bf16_t*)(ws + W_OIN), 4096, 1024, r1, 4096, smem); break;
    case 11:
      for (int item = blockIdx.x * 2 + half; item < 512; item += gridDim.x * 2) sgu_item(P, item, hsmem);
      break;
    case 12: gemm_run<0>(r2, (const bf16_t*)(ws + W_OOUT), 1024, 2048, r4, 1024, smem); break;
    case 13: resnorm_rows(r4, P.out, P.out, P.norm_g + 5 * 1024, P.norm_g + 6 * 1024, r2); break;
    case 14: gemm_run<1>(r2, (const bf16_t*)(ws + W_FFN1_1), 4096, 1024, r1, 4096, smem); break;
    case 15: gemm_run<0>(r1, (const bf16_t*)(ws + W_FFN2_1), 1024, 4096, r4, 1024, smem); break;
    case 16: resnorm_rows(r4, P.out, P.out, P.norm_g + 7 * 1024, nullptr, nullptr); break;
    default: break;
  }
}

#if !MEGA
extern __shared__ __attribute__((aligned(16))) unsigned char lds_dyn[];
__global__ void __launch_bounds__(NTHR, 2) k_phase(Params P, int ph) {
  char* smem = (char*)lds_dyn;
  run_phase(P, ph, smem);
}
#endif

#if MEGA
extern __shared__ __attribute__((aligned(16))) unsigned char lds_dyn[];
__global__ void __launch_bounds__(NTHR, 2) k_mega(Params P) {
  char* smem = (char*)lds_dyn;
  cg::grid_group grid = cg::this_grid();
  run_phase(P, 0, smem); grid.sync();
  run_phase(P, 1, smem); grid.sync();
  run_phase(P, 2, smem); grid.sync();
  run_phase(P, 3, smem); grid.sync();
  run_phase(P, 4, smem); grid.sync();
  run_phase(P, 5, smem); grid.sync();
  run_phase(P, 6, smem); grid.sync();
  run_phase(P, 7, smem); grid.sync();
  run_phase(P, 8, smem); grid.sync();
  run_phase(P, 9, smem); grid.sync();
  run_phase(P, 10, smem); grid.sync();
  run_phase(P, 11, smem); grid.sync();
  run_phase(P, 12, smem); grid.sync();
  run_phase(P, 13, smem); grid.sync();
  run_phase(P, 14, smem); grid.sync();
  run_phase(P, 15, smem); grid.sync();
  run_phase(P, 16, smem);
}
#endif

extern "C" void kernel_launch(void* const* d_in, const int* in_sizes, int n_in, void* d_out, int out_size, void* d_ws, size_t ws_size,
                              hipStream_t stream) {
  Params p{};
  p.x = (const float*)d_in[0]; p.norm_g = (const float*)d_in[1]; p.ffn_w1 = (const float*)d_in[2]; p.ffn_w2 = (const float*)d_in[3];
  p.e_w_in = (const float*)d_in[4]; p.e_w_out = (const float*)d_in[5]; p.gla_w_gate = (const float*)d_in[6]; p.gla_b_gate = (const float*)d_in[7];
  p.gla_norm = (const float*)d_in[8]; p.nsa_gate_b = (const float*)d_in[9]; p.cmp_pos = (const float*)d_in[10]; p.cmp_w1 = (const float*)d_in[11];
  p.cmp_w2 = (const float*)d_in[12]; p.o_w_in = (const float*)d_in[13]; p.o_ln_g = (const float*)d_in[14]; p.o_ln_b = (const float*)d_in[15];
  p.o_w_s = (const float*)d_in[16]; p.o_b_s = (const float*)d_in[17]; p.o_w_out = (const float*)d_in[18];
  p.out = (float*)d_out; p.ws = (char*)d_ws;
  if (ws_size < 1024ull * MiB) { fprintf(stderr, "workspace too small: %zu\n", ws_size); return; }
  static int grid_blocks = 0;
  if (!grid_blocks) {
    int dev = 0, cus = 0, per_cu = 0;
    (void)hipGetDevice(&dev);
    (void)hipDeviceGetAttribute(&cus, hipDeviceAttributeMultiprocessorCount, dev);
#if MEGA
    if (hipFuncSetAttribute((const void*)k_mega, hipFuncAttributeMaxDynamicSharedMemorySize, LDS_BYTES) != hipSuccess) fprintf(stderr, "hipFuncSetAttribute failed\n");
    (void)hipOccupancyMaxActiveBlocksPerMultiprocessor(&per_cu, (const void*)k_mega, NTHR, LDS_BYTES);
#else
    if (hipFuncSetAttribute((const void*)k_phase, hipFuncAttributeMaxDynamicSharedMemorySize, LDS_BYTES) != hipSuccess) fprintf(stderr, "hipFuncSetAttribute failed\n");
    (void)hipOccupancyMaxActiveBlocksPerMultiprocessor(&per_cu, (const void*)k_phase, NTHR, LDS_BYTES);
#endif
    if (per_cu < 1) fprintf(stderr, "occupancy query returned %d\n", per_cu);
    grid_blocks = cus;
  }
#if MEGA
  void* args[] = {&p};
  hipError_t e = hipLaunchCooperativeKernel((void*)k_mega, dim3(grid_blocks), dim3(NTHR), args, LDS_BYTES, stream);
  if (e != hipSuccess) fprintf(stderr, "cooperative launch failed: %s (grid %d)\n", hipGetErrorString(e), grid_blocks);
#else
  for (int ph = 0; ph < NPHASE; ++ph) k_phase<<<grid_blocks, NTHR, LDS_BYTES, stream>>>(p, ph);
#endif
}
```

```cpp
#include <hip/hip_runtime.h>
#include <hip/hip_cooperative_groups.h>
#include <cstdio>
namespace cg = cooperative_groups;

#ifndef MEGA
#define MEGA 1
#endif

typedef unsigned short bf16_t;
typedef short bf16x8 __attribute__((ext_vector_type(8)));
typedef short s16x4 __attribute__((ext_vector_type(4)));
typedef float f32x16 __attribute__((ext_vector_type(16)));
typedef float f32v2 __attribute__((ext_vector_type(2)));
typedef __bf16 bf16v2 __attribute__((ext_vector_type(2)));
typedef unsigned u32x4 __attribute__((ext_vector_type(4)));
typedef unsigned u32x2 __attribute__((ext_vector_type(2)));
#define DI __device__ __forceinline__
DI int tid_opaque() { int t = threadIdx.x; asm volatile("" : "+v"(t)); return t; }
#define TIDX tid_opaque()

constexpr int T_TOK = 65536, SEQ = 8192, DM = 1024;
constexpr int PW = 3072;
constexpr int C_GQ = 0, C_GK = 256, C_GV = 512, C_GLR = 1024, C_GR = 1040, C_NQ = 1552, C_KC = 2064, C_VC = 2192,
              C_KS = 2320, C_VS = 2448, C_KW = 2576, C_VW = 2704, C_NG = 2832;
constexpr float EPS = 1e-6f;
constexpr int NTHR = 512, WPB = 8, LDS_BYTES = 131072;
constexpr size_t MiB = 1024ull * 1024ull;
constexpr size_t W_FFN1_0 = 0, W_FFN1_1 = 8 * MiB, W_FFN2_0 = 16 * MiB, W_FFN2_1 = 24 * MiB, W_EIN = 32 * MiB, W_EOUT = 38 * MiB,
                 W_OIN = 40 * MiB, W_OOUT = 48 * MiB, W_CW1 = 52 * MiB, W_CW2 = 53 * MiB, W_BIAS1 = 53 * MiB + 65536,
                 W_CNT = 53 * MiB + 131072;
constexpr size_t R1 = 64 * MiB, R2 = 576 * MiB, R3 = 704 * MiB, R4 = 832 * MiB, R5 = 960 * MiB;
constexpr size_t R_KCMP = R5, R_VCMPT = R5 + 1 * MiB, R_VST = R5 + 2 * MiB, R_VWT = R5 + 18 * MiB, R_DECAY = R5 + 34 * MiB;

struct Params {
  const float* x; const float* norm_g; const float* ffn_w1; const float* ffn_w2; const float* e_w_in; const float* e_w_out;
  const float* gla_w_gate; const float* gla_b_gate; const float* gla_norm; const float* nsa_gate_b; const float* cmp_pos;
  const float* cmp_w1; const float* cmp_w2; const float* o_w_in; const float* o_ln_g; const float* o_ln_b; const float* o_w_s;
  const float* o_b_s; const float* o_w_out;
  float* out; char* ws;
};

DI int crow(int r, int kb) { return (r & 3) + 8 * (r >> 2) + 4 * kb; }
DI f32x16 mfma(bf16x8 a, bf16x8 b, f32x16 c) { return __builtin_amdgcn_mfma_f32_32x32x16_bf16(a, b, c, 0, 0, 0); }
DI unsigned pk2(float a, float b) { f32v2 v = {a, b}; bf16v2 r = __builtin_convertvector(v, bf16v2); return __builtin_bit_cast(unsigned, r); }
DI bf16_t f2bf(float a) { return (bf16_t)(pk2(a, 0.f) & 0xffffu); }
DI float bf2f(bf16_t u) { return __uint_as_float(((unsigned)u) << 16); }
DI float bflo(unsigned u) { return __uint_as_float(u << 16); }
DI float bfhi(unsigned u) { return __uint_as_float(u & 0xffff0000u); }
DI bf16x8 pack8(float a0, float a1, float a2, float a3, float a4, float a5, float a6, float a7) {
  u32x4 p; p[0] = pk2(a0, a1); p[1] = pk2(a2, a3); p[2] = pk2(a4, a5); p[3] = pk2(a6, a7);
  return __builtin_bit_cast(bf16x8, p);
}
DI bf16x8 ld2x4(const bf16_t* p) {
  s16x4 lo = *(const s16x4*)p; s16x4 hi = *(const s16x4*)(p + 8);
  return __builtin_shufflevector(lo, hi, 0, 1, 2, 3, 4, 5, 6, 7);
}
DI float wave_sum(float v) {
#pragma unroll
  for (int o = 32; o > 0; o >>= 1) v += __shfl_xor(v, o);
  return v;
}
DI f32x16 zero16() { f32x16 z;
#pragma unroll
  for (int i = 0; i < 16; ++i) z[i] = 0.f; return z; }
DI float gelu_tanh(float x) { float u = 1.5957691216f * (x + 0.044715f * x * x * x); return x / (1.f + __expf(-u)); }
DI float sigmoidf_(float x) { return 1.f / (1.f + __expf(-x)); }

DI void conv_weight(const float* __restrict__ src, bf16_t* __restrict__ dst, int K, int N, int Npad) {
  const long total = (long)Npad * (K >> 3);
  const long stride = (long)gridDim.x * blockDim.x;
  for (long i = (long)blockIdx.x * blockDim.x + TIDX; i < total; i += stride) {
    const int n = (int)(i % Npad); const int k8 = (int)(i / Npad);
    float v[8];
#pragma unroll
    for (int j = 0; j < 8; ++j) v[j] = (n < N) ? src[(size_t)(k8 * 8 + j) * N + n] : 0.f;
    u32x4 o; o[0] = pk2(v[0], v[1]); o[1] = pk2(v[2], v[3]); o[2] = pk2(v[4], v[5]); o[3] = pk2(v[6], v[7]);
    *(u32x4*)(dst + (size_t)n * K + k8 * 8) = o;
  }
}

DI void prenorm_rows(const float* __restrict__ x, const float* __restrict__ g, bf16_t* __restrict__ xn) {
  const int lane = TIDX & 63, wave = TIDX >> 6;
  const int nw = gridDim.x * WPB;
  for (int row = blockIdx.x * WPB + wave; row < T_TOK; row += nw) {
    const float4* xr = (const float4*)(x + (size_t)row * DM);
    float4 a[4]; float ss = 0.f;
#pragma unroll
    for (int k = 0; k < 4; ++k) { a[k] = xr[k * 64 + lane]; ss += a[k].x * a[k].x + a[k].y * a[k].y + a[k].z * a[k].z + a[k].w * a[k].w; }
    ss = wave_sum(ss);
    const float rs = rsqrtf(ss * (1.f / DM) + EPS);
#pragma unroll
    for (int k = 0; k < 4; ++k) {
      const float4 gg = ((const float4*)g)[k * 64 + lane];
      u32x2 o; o[0] = pk2(a[k].x * rs * gg.x, a[k].y * rs * gg.y); o[1] = pk2(a[k].z * rs * gg.z, a[k].w * rs * gg.w);
      *(u32x2*)(xn + (size_t)row * DM + k * 256 + lane * 4) = o;
    }
  }
}

DI void resnorm_rows(const bf16_t* __restrict__ m, const float* hin, float* hout, const float* __restrict__ gpost,
                             const float* __restrict__ gnext, bf16_t* __restrict__ xn) {
  const int lane = TIDX & 63, wave = TIDX >> 6;
  const int nw = gridDim.x * WPB;
  for (int row = blockIdx.x * WPB + wave; row < T_TOK; row += nw) {
    float mv[16]; float ss = 0.f;
#pragma unroll
    for (int k = 0; k < 4; ++k) {
      const u32x2 u = *(const u32x2*)(m + (size_t)row * DM + k * 256 + lane * 4);
      mv[k * 4 + 0] = bflo(u[0]); mv[k * 4 + 1] = bfhi(u[0]); mv[k * 4 + 2] = bflo(u[1]); mv[k * 4 + 3] = bfhi(u[1]);
    }
#pragma unroll
    for (int i = 0; i < 16; ++i) ss += mv[i] * mv[i];
    ss = wave_sum(ss);
    const float rs = rsqrtf(ss * (1.f / DM) + EPS);
    float hv[16]; float s2 = 0.f;
#pragma unroll
    for (int k = 0; k < 4; ++k) {
      const float4 h4 = ((const float4*)(hin + (size_t)row * DM))[k * 64 + lane];
      const float4 gg = ((const float4*)gpost)[k * 64 + lane];
      hv[k * 4 + 0] = h4.x + mv[k * 4 + 0] * rs * gg.x; hv[k * 4 + 1] = h4.y + mv[k * 4 + 1] * rs * gg.y;
      hv[k * 4 + 2] = h4.z + mv[k * 4 + 2] * rs * gg.z; hv[k * 4 + 3] = h4.w + mv[k * 4 + 3] * rs * gg.w;
      float4 o; o.x = hv[k * 4 + 0]; o.y = hv[k * 4 + 1]; o.z = hv[k * 4 + 2]; o.w = hv[k * 4 + 3];
      ((float4*)(hout + (size_t)row * DM))[k * 64 + lane] = o;
    }
    if (xn) {
#pragma unroll
      for (int i = 0; i < 16; ++i) s2 += hv[i] * hv[i];
      s2 = wave_sum(s2);
      const float r2 = rsqrtf(s2 * (1.f / DM) + EPS);
#pragma unroll
      for (int k = 0; k < 4; ++k) {
        const float4 gg = ((const float4*)gnext)[k * 64 + lane];
        u32x2 o; o[0] = pk2(hv[k * 4 + 0] * r2 * gg.x, hv[k * 4 + 1] * r2 * gg.y); o[1] = pk2(hv[k * 4 + 2] * r2 * gg.z, hv[k * 4 + 3] * r2 * gg.w);
        *(u32x2*)(xn + (size_t)row * DM + k * 256 + lane * 4) = o;
      }
    }
  }
}

DI void phase_prep(const Params& P) {
  char* ws = P.ws;
  conv_weight(P.ffn_w1, (bf16_t*)(ws + W_FFN1_0), 1024, 4096, 4096);
  conv_weight(P.ffn_w1 + (size_t)1024 * 4096, (bf16_t*)(ws + W_FFN1_1), 1024, 4096, 4096);
  conv_weight(P.ffn_w2, (bf16_t*)(ws + W_FFN2_0), 4096, 1024, 1024);
  conv_weight(P.ffn_w2 + (size_t)1024 * 4096, (bf16_t*)(ws + W_FFN2_1), 4096, 1024, 1024);
  conv_weight(P.e_w_in, (bf16_t*)(ws + W_EIN), 1024, 2856, PW);
  conv_weight(P.e_w_out, (bf16_t*)(ws + W_EOUT), 1024, 1024, 1024);
  conv_weight(P.o_w_in, (bf16_t*)(ws + W_OIN), 1024, 4096, 4096);
  conv_weight(P.o_w_out, (bf16_t*)(ws + W_OOUT), 2048, 1024, 1024);
  conv_weight(P.cmp_w1, (bf16_t*)(ws + W_CW1), 2048, 128, 128);
  conv_weight(P.cmp_w1 + 2048 * 128, (bf16_t*)(ws + W_CW1) + 128 * 2048, 2048, 128, 128);
  conv_weight(P.cmp_w2, (bf16_t*)(ws + W_CW2), 128, 64, 64);
  conv_weight(P.cmp_w2 + 128 * 64, (bf16_t*)(ws + W_CW2) + 64 * 128, 128, 64, 64);
  const int lane = TIDX & 63, wave = TIDX >> 6;
  const int gw = blockIdx.x * WPB + wave;
  if (gw < 256) {
    const int i = gw >> 7, hid = gw & 127;
    float s = 0.f;
    for (int kk = lane; kk < 2048; kk += 64) s += P.cmp_pos[i * 2048 + kk] * P.cmp_w1[((size_t)i * 2048 + kk) * 128 + hid];
    s = wave_sum(s);
    if (lane == 0) ((float*)(ws + W_BIAS1))[gw] = s;
  }
  const int gt = blockIdx.x * blockDim.x + TIDX;
  if (gt < 16) ((unsigned*)(ws + W_CNT))[gt] = 0u;
  if (gt < 16 * 64) {
    const int bg = gt >> 6, d = gt & 63;
    ((bf16_t*)(ws + R_KCMP))[((size_t)bg * 512 + 511) * 64 + d] = 0;
    ((bf16_t*)(ws + R_VCMPT))[((size_t)bg * 64 + d) * 512 + 511] = 0;
  }
  prenorm_rows(P.x, P.norm_g, (bf16_t*)(ws + R2));
}

namespace pg8 {
#define PG8_LAS __attribute__((address_space(3)))
typedef float f32x4 __attribute__((ext_vector_type(4)));
constexpr int BM = 256, BK = 64, HALF = 128, HTB = HALF * BK * 2, STAGE_BYTES = 8 * HTB, NXCD = 8, WGM = 8;
DI int lds_byte(int r, int c) { const int st = (r >> 4) * 2 + (c >> 5), rr = r & 15, cc = c & 31, ob = rr * 64 + cc * 2; return st * 1024 + (ob ^ (((ob >> 9) & 1) << 5)); }
DI void stage_rc(int b, int& R, int& C) { const int st = b / 1024, sb = b % 1024, swz = sb ^ (((sb >> 9) & 1) << 5); R = (st >> 1) * 16 + swz / 64; C = (st & 1) * 32 + (swz % 64) / 2; }
DI int perm32(int rho) { const int n = rho >> 4, i = rho & 15; return 8 * (i >> 2) + 4 * n + (i & 3); }
struct Unit { int pm, pn; };
struct Gemm { const bf16_t* A; const bf16_t* Bt; int M, N, K; };
struct StaticOrder {
  int nM, nN, nwg, G, c;
  DI void init(int M, int N, int G_, int c_) { nM = M / BM; nN = N / BM; nwg = nM * nN; G = G_; c = c_; }
  DI bool next(int i, Unit& u) const {
    const long L = (long)i * G + c; if (L >= nwg) return false;
    int wgid = (int)L; { const int q = nwg / NXCD, r = nwg % NXCD, xcd = wgid % NXCD, off = wgid / NXCD; wgid = (xcd < r ? xcd * (q + 1) : r * (q + 1) + (xcd - r) * q) + off; }
    const int nig = WGM * nN, gid = wgid / nig, fm = gid * WGM, gsz = (nM - fm) < WGM ? (nM - fm) : WGM;
    u.pm = fm + ((wgid % nig) % gsz); u.pn = (wgid % nig) / gsz; return true;
  }
};
template <int ACT> struct EpiB {
  static constexpr bool PERM = true;
  bf16_t* O; int ldc;
  DI void operator()(const f32x4 (&acc)[2][2][4][2], const Unit& u, int wr, int wc, int fr, int fq) const {
    const int row0 = u.pm * BM + wr * 64 + fr; const int col0 = u.pn * BM + wc * 32 + 8 * fq;
#pragma unroll
    for (int ai = 0; ai < 2; ++ai)
#pragma unroll
      for (int m = 0; m < 4; ++m) {
        bf16_t* rowp = O + (size_t)(row0 + ai * HALF + m * 16) * ldc + col0;
#pragma unroll
        for (int bj = 0; bj < 2; ++bj) {
          f32x4 v0 = acc[ai][bj][m][0], v1 = acc[ai][bj][m][1];
          if (ACT == 1) {
#pragma unroll
            for (int j = 0; j < 4; ++j) { const float a = fmaxf(v0[j], 0.f), b = fmaxf(v1[j], 0.f); v0[j] = a * a; v1[j] = b * b; }
          }
          if (ACT == 2) {
#pragma unroll
            for (int j = 0; j < 4; ++j) { v0[j] = gelu_tanh(v0[j]); v1[j] = gelu_tanh(v1[j]); }
          }
          u32x4 w; w[0] = pk2(v0[0], v0[1]); w[1] = pk2(v0[2], v0[3]); w[2] = pk2(v1[0], v1[1]); w[3] = pk2(v1[2], v1[3]);
          *(u32x4*)(rowp + bj * HALF) = w;
        }
      }
  }
};

template <class Epi, class Sched>
DI void gemm_phase(PG8_LAS unsigned char* lds, const Gemm g, const Sched& S, const Epi& E) {
  const int tid_ = TIDX;
  const int tid = tid_, wid = __builtin_amdgcn_readfirstlane(tid >> 6), lane = tid & 63, wr = wid >> 2, wc = wid & 3, fr = lane & 15, fq = lane >> 4;
  const int K = g.K, nt = K / BK;
  unsigned voffA[2], voffB[2];
#pragma unroll
  for (int i = 0; i < 2; ++i) { int R, C; stage_rc(tid * 16 + i * 8192, R, C); const int Rb = Epi::PERM ? ((R & ~31) + perm32(R & 31)) : R;
    voffA[i] = (unsigned)(R * K + C) * 2u; voffB[i] = (unsigned)(Rb * K + C) * 2u; }
  const size_t kstep = (size_t)(BK * 2);
  const size_t hstep = (size_t)HALF * K * 2;
  const size_t tstep = 2 * hstep;
  const unsigned ldsw = (unsigned)wid * 1024u;
  const int aoff = lds_byte(wr * 64 + fr, fq * 8), boff = lds_byte(wc * 32 + fr, fq * 8);
#define PG8_SA(b, h) (((b) * 2 + (h)) * HTB)
#define PG8_SB(b, h) ((4 + (b) * 2 + (h)) * HTB)
#define PG8_STAGE(bufoff, gbase, voff) do { _Pragma("unroll") for (int _i = 0; _i < 2; ++_i) \
    __builtin_amdgcn_global_load_lds((const unsigned*)((const char*)(gbase) + (voff)[_i]), (PG8_LAS unsigned*)(lds + (bufoff) + ldsw + _i * 8192), 16, 0, 0); } while (0)
#define PG8_LDA(dst, b, h) do { _Pragma("unroll") for (int m = 0; m < 4; ++m) _Pragma("unroll") for (int k = 0; k < 2; ++k) dst[m][k] = *(const PG8_LAS bf16x8*)(lds + PG8_SA(b, h) + aoff + m * 2048 + k * 1024); } while (0)
#define PG8_LDB(dst, b, h) do { _Pragma("unroll") for (int n = 0; n < 2; ++n) _Pragma("unroll") for (int k = 0; k < 2; ++k) dst[n][k] = *(const PG8_LAS bf16x8*)(lds + PG8_SB(b, h) + boff + n * 2048 + k * 1024); } while (0)
#define PG8_MMA(ai, bj, At, Bt) do { __builtin_amdgcn_s_setprio(1); _Pragma("unroll") for (int m = 0; m < 4; ++m) _Pragma("unroll") for (int n = 0; n < 2; ++n) _Pragma("unroll") for (int k = 0; k < 2; ++k) \
    acc[ai][bj][m][n] = __builtin_amdgcn_mfma_f32_16x16x32_bf16(Bt[n][k], At[m][k], acc[ai][bj][m][n], 0, 0, 0); __builtin_amdgcn_s_setprio(0); } while (0)
#define PG8_WAIT_V(n) asm volatile("s_waitcnt vmcnt(" #n ")" ::: "memory")
#define PG8_WAIT_L(n) asm volatile("s_waitcnt lgkmcnt(" #n ")" ::: "memory")
#define PG8_BAR __builtin_amdgcn_s_barrier()
#define PG8_SCHED __builtin_amdgcn_sched_barrier(0)
  Unit cur, nxt; int ui = 0;
  if (!S.next(0, cur)) return;
  f32x4 acc[2][2][4][2];
#pragma unroll
  for (int a = 0; a < 2; ++a)
#pragma unroll
    for (int b = 0; b < 2; ++b)
#pragma unroll
      for (int m = 0; m < 4; ++m)
#pragma unroll
        for (int n = 0; n < 2; ++n) acc[a][b][m][n] = (f32x4){0.f, 0.f, 0.f, 0.f};
  bf16x8 At[4][2], B0[2][2], B1[2][2];
  const char* cA = (const char*)g.A + (size_t)cur.pm * tstep; const char* cB = (const char*)g.Bt + (size_t)cur.pn * tstep;
  PG8_STAGE(PG8_SB(0, 0), cB, voffB); PG8_STAGE(PG8_SA(0, 0), cA, voffA); PG8_STAGE(PG8_SB(0, 1), cB + hstep, voffB); PG8_STAGE(PG8_SA(0, 1), cA + hstep, voffA);
  if (wr == 1) PG8_BAR;
  PG8_WAIT_V(4); PG8_BAR;
  PG8_STAGE(PG8_SB(1, 0), cB + kstep, voffB); PG8_STAGE(PG8_SA(1, 0), cA + kstep, voffA); PG8_STAGE(PG8_SB(1, 1), cB + hstep + kstep, voffB);
  PG8_WAIT_V(6); PG8_BAR;
  for (;;) {
    const bool has_next = S.next(ui + 1, nxt);
    const char* nA = has_next ? (const char*)g.A + (size_t)nxt.pm * tstep : cA; const char* nB = has_next ? (const char*)g.Bt + (size_t)nxt.pn * tstep : cB;
    for (int t = 0; t < nt; t += 2) {
      const bool last = (t == nt - 2);
      const char* a1 = cA + (size_t)(t + 1) * kstep;
      const char* a2 = last ? nA : cA + (size_t)(t + 2) * kstep; const char* b2 = last ? nB : cB + (size_t)(t + 2) * kstep;
      const char* a3 = a2 + kstep; const char* b3 = b2 + kstep;
      PG8_LDB(B0, 0, 0); PG8_SCHED; PG8_LDA(At, 0, 0); PG8_STAGE(PG8_SA(1, 1), a1 + hstep, voffA);
      PG8_WAIT_L(8); PG8_BAR; PG8_WAIT_L(0); PG8_MMA(0, 0, At, B0); PG8_BAR; PG8_SCHED;
      PG8_LDB(B1, 0, 1); PG8_STAGE(PG8_SB(0, 0), b2, voffB);
      PG8_BAR; PG8_WAIT_L(0); PG8_MMA(0, 1, At, B1); PG8_BAR;
      PG8_LDA(At, 0, 1); PG8_STAGE(PG8_SA(0, 0), a2, voffA);
      PG8_BAR; PG8_WAIT_L(0); PG8_MMA(1, 0, At, B0); PG8_BAR; PG8_SCHED;
      PG8_STAGE(PG8_SB(0, 1), b2 + hstep, voffB);
      PG8_WAIT_V(6); PG8_BAR; PG8_MMA(1, 1, At, B1); PG8_BAR;
      PG8_LDB(B0, 1, 0); PG8_SCHED; PG8_LDA(At, 1, 0); PG8_STAGE(PG8_SA(0, 1), a2 + hstep, voffA);
      PG8_WAIT_L(8); PG8_BAR; PG8_WAIT_L(0); PG8_MMA(0, 0, At, B0); PG8_BAR; PG8_SCHED;
      PG8_LDB(B1, 1, 1); PG8_STAGE(PG8_SB(1, 0), b3, voffB);
      PG8_BAR; PG8_WAIT_L(0); PG8_MMA(0, 1, At, B1); PG8_BAR;
      PG8_LDA(At, 1, 1); PG8_STAGE(PG8_SA(1, 0), a3, voffA);
      PG8_BAR; PG8_WAIT_L(0); PG8_MMA(1, 0, At, B0); PG8_BAR; PG8_SCHED;
      PG8_STAGE(PG8_SB(1, 1), b3 + hstep, voffB);
      PG8_WAIT_V(6); PG8_BAR; PG8_MMA(1, 1, At, B1); PG8_BAR;
    }
    E(acc, cur, wr, wc, fr, fq);
    if (!has_next) break;
#pragma unroll
    for (int a = 0; a < 2; ++a)
#pragma unroll
      for (int b = 0; b < 2; ++b)
#pragma unroll
        for (int m = 0; m < 4; ++m)
#pragma unroll
          for (int n = 0; n < 2; ++n) acc[a][b][m][n] = (f32x4){0.f, 0.f, 0.f, 0.f};
    cur = nxt; cA = nA; cB = nB; ++ui;
  }
  PG8_WAIT_V(0);
  if (wr == 0) PG8_BAR;
  PG8_BAR;
#undef PG8_SA
#undef PG8_SB
#undef PG8_STAGE
#undef PG8_LDA
#undef PG8_LDB
#undef PG8_MMA
#undef PG8_WAIT_V
#undef PG8_WAIT_L
#undef PG8_BAR
#undef PG8_SCHED
}
}

template <int ACT>
DI void gemm_run(const bf16_t* A, const bf16_t* Bt, int N, int K, bf16_t* C, int ldc, char* smem) {
  pg8::Gemm g; g.A = A; g.Bt = Bt; g.M = T_TOK; g.N = N; g.K = K;
  pg8::StaticOrder S; S.init(T_TOK, N, (int)gridDim.x, (int)blockIdx.x);
  pg8::EpiB<ACT> E; E.O = C; E.ldc = ldc;
  pg8::gemm_phase(( PG8_LAS unsigned char*)smem, g, S, E);
  __syncthreads();
}

DI void gla_gates(const Params& P, const bf16_t* proj, int b, int h, int n, float* sb, float* sseg, float* tmp) {
  const int tid = TIDX & 255;
  float* sw = tmp;
  float* sg = tmp + 1024;
  {
    for (int e = tid; e < 1024; e += 256) sw[e] = P.gla_w_gate[(e >> 6) * 256 + h * 64 + (e & 63)];
    const int i = tid >> 2, part = tid & 3;
    const size_t t = (size_t)b * SEQ + n * 64 + i;
    const u32x2 gu = *(const u32x2*)(proj + t * PW + C_GLR + part * 4);
    sg[i * 17 + part * 4 + 0] = bflo(gu[0]); sg[i * 17 + part * 4 + 1] = bfhi(gu[0]);
    sg[i * 17 + part * 4 + 2] = bflo(gu[1]); sg[i * 17 + part * 4 + 3] = bfhi(gu[1]);
  }
  __syncthreads();
  {
    const int i = tid & 63, dq = tid >> 6;
    float z[16];
#pragma unroll
    for (int dd = 0; dd < 16; ++dd) z[dd] = P.gla_b_gate[h * 64 + dq * 16 + dd];
#pragma unroll 1
    for (int r = 0; r < 16; ++r) {
      const float gv = sg[i * 17 + r];
#pragma unroll
      for (int dd = 0; dd < 16; ++dd) z[dd] += gv * sw[r * 64 + dq * 16 + dd];
    }
#pragma unroll
    for (int dd = 0; dd < 16; ++dd) {
      const float zz = z[dd];
      const float ls = fminf(zz, 0.f) - __logf(1.f + __expf(-fabsf(zz)));
      sb[i * 65 + dq * 16 + dd] = ls * (1.f / 16.f);
    }
  }
  __syncthreads();
  const int d = tid & 63, seg = tid >> 6;
  float pre[16]; float run = 0.f;
#pragma unroll
  for (int ii = 0; ii < 16; ++ii) { run += sb[(seg * 16 + ii) * 65 + d]; pre[ii] = run; }
  sseg[seg * 64 + d] = run;
  __syncthreads();
  float off = 0.f;
#pragma unroll
  for (int s = 0; s < 4; ++s) off += (s < seg) ? sseg[s * 64 + d] : 0.f;
#pragma unroll
  for (int ii = 0; ii < 16; ++ii) sb[(seg * 16 + ii) * 65 + d] = pre[ii] + off;
  __syncthreads();
}

DI void gla_stage_vT(const bf16_t* proj, int b, int h, int n, bf16_t* vT) {
  const int tid = TIDX & 255, j = tid & 63, q4 = tid >> 6;
  const size_t t = (size_t)b * SEQ + n * 64 + j;
  const bf16_t* src = proj + t * PW + C_GV + h * 128 + q4 * 32;
#pragma unroll
  for (int c = 0; c < 4; ++c) {
    const u32x4 u = *(const u32x4*)(src + c * 8);
#pragma unroll
    for (int e = 0; e < 4; ++e) {
      vT[(q4 * 32 + c * 8 + 2 * e) * 72 + j] = (bf16_t)(u[e] & 0xffffu);
      vT[(q4 * 32 + c * 8 + 2 * e + 1) * 72 + j] = (bf16_t)(u[e] >> 16);
    }
  }
}

DI void gla_p1_item(const Params& P, int item, char* smem) {
  const bf16_t* proj = (const bf16_t*)(P.ws + R1);
  float* states = (float*)(P.ws + R2);
  float* decay = (float*)(P.ws + R_DECAY);
  float* sb = (float*)smem; float* sseg = sb + 64 * 65;
  bf16_t* kendT = (bf16_t*)(sseg + 256); bf16_t* vT = kendT + 64 * 72;
  const int n = item & 127, h = (item >> 7) & 3, b = item >> 9;
  const int tid = TIDX & 255, lane = tid & 63, wave = tid >> 6, l32 = lane & 31, kb = lane >> 5;
  gla_gates(P, proj, b, h, n, sb, sseg, (float*)vT);
  {
    const int j = tid & 63, dq = tid >> 6;
    const size_t t = (size_t)b * SEQ + n * 64 + j;
    const u32x4 k0 = *(const u32x4*)(proj + t * PW + C_GK + h * 64 + dq * 16), k1 = *(const u32x4*)(proj + t * PW + C_GK + h * 64 + dq * 16 + 8);
    float kv[16];
#pragma unroll
    for (int e = 0; e < 4; ++e) { kv[2 * e] = bflo(k0[e]); kv[2 * e + 1] = bfhi(k0[e]); kv[8 + 2 * e] = bflo(k1[e]); kv[8 + 2 * e + 1] = bfhi(k1[e]); }
#pragma unroll
    for (int dd = 0; dd < 16; ++dd) {
      const int d = dq * 16 + dd;
      kendT[d * 72 + j] = f2bf(kv[dd] * __expf(sb[63 * 65 + d] - sb[j * 65 + d]));
    }
    if (tid < 64) decay[((size_t)(b * 4 + h) * 128 + n) * 64 + tid] = __expf(sb[63 * 65 + tid]);
  }
  gla_stage_vT(proj, b, h, n, vT);
  __syncthreads();
#pragma unroll
  for (int dt = 0; dt < 2; ++dt) {
    f32x16 acc = zero16();
#pragma unroll
    for (int s = 0; s < 4; ++s) {
      const bf16x8 a = *(const bf16x8*)(vT + (wave * 32 + l32) * 72 + s * 16 + kb * 8);
      const bf16x8 bb = *(const bf16x8*)(kendT + (dt * 32 + l32) * 72 + s * 16 + kb * 8);
      acc = mfma(a, bb, acc);
    }
    float* dst = states + ((size_t)((b * 4 + h) * 128 + n) * 128) * 64;
#pragma unroll
    for (int r = 0; r < 16; ++r) dst[(size_t)(wave * 32 + crow(r, kb)) * 64 + dt * 32 + l32] = acc[r];
  }
  __syncthreads();
}

DI void gla_scan(const Params& P) {
  float* states = (float*)(P.ws + R2);
  const float* decay = (const float*)(P.ws + R_DECAY);
  const int total = 32 * 8192;
  for (int e = blockIdx.x * blockDim.x + TIDX; e < total; e += gridDim.x * blockDim.x) {
    const int bh = e >> 13, idx = e & 8191, d = idx & 63;
    float* p = states + (size_t)bh * 128 * 8192 + idx;
    const float* dc = decay + (size_t)bh * 128 * 64 + d;
    float S = 0.f;
#pragma unroll 8
    for (int n = 0; n < 128; ++n) {
      const float ds = p[(size_t)n * 8192];
      const float dec = dc[n * 64];
      p[(size_t)n * 8192] = S;
      S = dec * S + ds;
    }
  }
}

DI void gla_p3_item(const Params& P, int item, char* smem) {
  const bf16_t* proj = (const bf16_t*)(P.ws + R1);
  const float* states = (const float*)(P.ws + R2);
  bf16_t* mix = (bf16_t*)(P.ws + R3);
  float* sb = (float*)smem; float* sseg = sb + 64 * 65; float* sred = sseg + 256;
  bf16_t* sq = (bf16_t*)(sred + 256); bf16_t* sk = sq + 64 * 72; bf16_t* vT = sk + 64 * 72;
  const int n = item & 127, h = (item >> 7) & 3, b = item >> 9;
  const int tid = TIDX & 255, lane = tid & 63, wave = tid >> 6, l32 = lane & 31, kb = lane >> 5;
  gla_gates(P, proj, b, h, n, sb, sseg, (float*)vT);
  {
    const int i = tid & 63, dq = tid >> 6;
    const size_t t = (size_t)b * SEQ + n * 64 + i;
    const u32x4 q0 = *(const u32x4*)(proj + t * PW + C_GQ + h * 64 + dq * 16), q1 = *(const u32x4*)(proj + t * PW + C_GQ + h * 64 + dq * 16 + 8);
    const u32x4 k0 = *(const u32x4*)(proj + t * PW + C_GK + h * 64 + dq * 16), k1 = *(const u32x4*)(proj + t * PW + C_GK + h * 64 + dq * 16 + 8);
    float qv[16], kv[16];
#pragma unroll
    for (int e = 0; e < 4; ++e) {
      qv[2 * e] = bflo(q0[e]); qv[2 * e + 1] = bfhi(q0[e]); qv[8 + 2 * e] = bflo(q1[e]); qv[8 + 2 * e + 1] = bfhi(q1[e]);
      kv[2 * e] = bflo(k0[e]); kv[2 * e + 1] = bfhi(k0[e]); kv[8 + 2 * e] = bflo(k1[e]); kv[8 + 2 * e + 1] = bfhi(k1[e]);
    }
#pragma unroll
    for (int dd = 0; dd < 16; ++dd) {
      const int d = dq * 16 + dd;
      const float bb = sb[i * 65 + d];
      sq[i * 72 + d] = f2bf(qv[dd] * 0.125f * __expf(bb));
      sk[i * 72 + d] = f2bf(kv[dd] * __expf(-bb));
    }
  }
  gla_stage_vT(proj, b, h, n, vT);
  __syncthreads();
  f32x16 x00 = zero16(), x01 = zero16(), x11 = zero16();
#pragma unroll
  for (int s = 0; s < 4; ++s) {
    const bf16x8 kj0 = *(const bf16x8*)(sk + (l32)*72 + s * 16 + kb * 8);
    const bf16x8 kj1 = *(const bf16x8*)(sk + (32 + l32) * 72 + s * 16 + kb * 8);
    const bf16x8 qi0 = *(const bf16x8*)(sq + (l32)*72 + s * 16 + kb * 8);
    const bf16x8 qi1 = *(const bf16x8*)(sq + (32 + l32) * 72 + s * 16 + kb * 8);
    x00 = mfma(kj0, qi0, x00); x01 = mfma(kj0, qi1, x01); x11 = mfma(kj1, qi1, x11);
  }
#pragma unroll
  for (int r = 0; r < 16; ++r) { const bool keep = crow(r, kb) <= l32; x00[r] = keep ? x00[r] : 0.f; x11[r] = keep ? x11[r] : 0.f; }
  f32x16 o0 = zero16(), o1 = zero16();
  const int dvr = wave * 32 + l32;
#pragma unroll
  for (int s = 0; s < 2; ++s) {
    const bf16x8 p00 = pack8(x00[8 * s], x00[8 * s + 1], x00[8 * s + 2], x00[8 * s + 3], x00[8 * s + 4], x00[8 * s + 5], x00[8 * s + 6], x00[8 * s + 7]);
    const bf16x8 p01 = pack8(x01[8 * s], x01[8 * s + 1], x01[8 * s + 2], x01[8 * s + 3], x01[8 * s + 4], x01[8 * s + 5], x01[8 * s + 6], x01[8 * s + 7]);
    const bf16x8 p11 = pack8(x11[8 * s], x11[8 * s + 1], x11[8 * s + 2], x11[8 * s + 3], x11[8 * s + 4], x11[8 * s + 5], x11[8 * s + 6], x11[8 * s + 7]);
    const bf16x8 v0 = ld2x4(vT + dvr * 72 + 16 * s + 4 * kb);
    const bf16x8 v1 = ld2x4(vT + dvr * 72 + 32 + 16 * s + 4 * kb);
    o0 = mfma(v0, p00, o0); o1 = mfma(v0, p01, o1); o1 = mfma(v1, p11, o1);
  }
  {
    const float* sp = states + ((size_t)((b * 4 + h) * 128 + n) * 128 + dvr) * 64;
#pragma unroll
    for (int s = 0; s < 4; ++s) {
      const float4 f0 = *(const float4*)(sp + s * 16 + kb * 8), f1 = *(const float4*)(sp + s * 16 + kb * 8 + 4);
      const bf16x8 a = pack8(f0.x, f0.y, f0.z, f0.w, f1.x, f1.y, f1.z, f1.w);
      const bf16x8 qi0 = *(const bf16x8*)(sq + (l32)*72 + s * 16 + kb * 8);
      const bf16x8 qi1 = *(const bf16x8*)(sq + (32 + l32) * 72 + s * 16 + kb * 8);
      o0 = mfma(a, qi0, o0); o1 = mfma(a, qi1, o1);
    }
  }
  float s0 = 0.f, s1 = 0.f;
#pragma unroll
  for (int r = 0; r < 16; ++r) { s0 += o0[r] * o0[r]; s1 += o1[r] * o1[r]; }
  s0 += __shfl_xor(s0, 32); s1 += __shfl_xor(s1, 32);
  if (kb == 0) { sred[wave * 64 + l32] = s0; sred[wave * 64 + 32 + l32] = s1; }
  __syncthreads();
  const float t0s = sred[l32] + sred[64 + l32] + sred[128 + l32] + sred[192 + l32];
  const float t1s = sred[32 + l32] + sred[64 + 32 + l32] + sred[128 + 32 + l32] + sred[192 + 32 + l32];
  const float r0 = rsqrtf(t0s * (1.f / 128.f) + EPS), r1 = rsqrtf(t1s * (1.f / 128.f) + EPS);
#pragma unroll
  for (int it = 0; it < 2; ++it) {
    const size_t t = (size_t)b * SEQ + n * 64 + it * 32 + l32;
    const float rr = it ? r1 : r0;
#pragma unroll
    for (int gq = 0; gq < 4; ++gq) {
      const int dv = wave * 32 + 8 * gq + 4 * kb;
      const u32x2 ru = *(const u32x2*)(proj + t * PW + C_GR + h * 128 + dv);
      const float4 gn = *(const float4*)(P.gla_norm + h * 128 + dv);
      float rv[4] = {bflo(ru[0]), bfhi(ru[0]), bflo(ru[1]), bfhi(ru[1])};
      float gv[4] = {gn.x, gn.y, gn.z, gn.w};
      float ov[4];
#pragma unroll
      for (int e = 0; e < 4; ++e) {
        const float a = it ? o1[gq * 4 + e] : o0[gq * 4 + e];
        ov[e] = a * rr * gv[e] * (rv[e] / (1.f + __expf(-rv[e])));
      }
      u32x2 o; o[0] = pk2(ov[0], ov[1]); o[1] = pk2(ov[2], ov[3]);
      *(u32x2*)(mix + t * DM + h * 128 + dv) = o;
    }
  }
  __syncthreads();
}

DI void nsa_compress_task(const Params& P, int task) {
  const bf16_t* proj = (const bf16_t*)(P.ws + R1);
  const int lane = TIDX & 63, l32 = lane & 31, kb = lane >> 5;
  const int ct = task & 15, g = (task >> 4) & 1, b = (task >> 5) & 7, br = task >> 8;
  const bf16_t* w1T = (const bf16_t*)(P.ws + W_CW1) + (size_t)br * 128 * 2048;
  const bf16_t* w2T = (const bf16_t*)(P.ws + W_CW2) + (size_t)br * 64 * 128;
  const float* bias1 = (const float*)(P.ws + W_BIAS1) + br * 128;
  const int c = ct * 32 + l32;
  const int cc = c < 511 ? c : 510;
  const bf16_t* src = proj + ((size_t)b * SEQ + cc * 16) * PW + (br ? C_VC : C_KC) + g * 64 + kb * 8;
  f32x16 acc[4];
#pragma unroll
  for (int i = 0; i < 4; ++i) acc[i] = zero16();
#pragma unroll 1
  for (int ks = 0; ks < 128; ++ks) {
    const int l = ks >> 2, dh0 = (ks & 3) * 16;
    const bf16x8 bf = *(const bf16x8*)(src + (size_t)l * PW + dh0);
#pragma unroll
    for (int ht = 0; ht < 4; ++ht) {
      const bf16x8 af = *(const bf16x8*)(w1T + (size_t)(ht * 32 + l32) * 2048 + ks * 16 + kb * 8);
      acc[ht] = mfma(af, bf, acc[ht]);
    }
  }
#pragma unroll
  for (int ht = 0; ht < 4; ++ht)
#pragma unroll
    for (int r = 0; r < 16; ++r) acc[ht][r] = gelu_tanh(acc[ht][r] + bias1[ht * 32 + crow(r, kb)]);
  f32x16 o[2]; o[0] = zero16(); o[1] = zero16();
#pragma unroll
  for (int ht = 0; ht < 4; ++ht)
#pragma unroll
    for (int s = 0; s < 2; ++s) {
      const bf16x8 hf = pack8(acc[ht][8 * s], acc[ht][8 * s + 1], acc[ht][8 * s + 2], acc[ht][8 * s + 3], acc[ht][8 * s + 4], acc[ht][8 * s + 5], acc[ht][8 * s + 6], acc[ht][8 * s + 7]);
#pragma unroll
      for (int dt = 0; dt < 2; ++dt) {
        const bf16x8 wf = ld2x4(w2T + (size_t)(dt * 32 + l32) * 128 + ht * 32 + 16 * s + 4 * kb);
        o[dt] = mfma(wf, hf, o[dt]);
      }
    }
  if (c < 511) {
    if (br == 0) {
      bf16_t* dst = (bf16_t*)(P.ws + R_KCMP) + ((size_t)(b * 2 + g) * 512 + c) * 64;
#pragma unroll
      for (int dt = 0; dt < 2; ++dt)
#pragma unroll
        for (int gq = 0; gq < 4; ++gq) {
          u32x2 u; u[0] = pk2(o[dt][gq * 4], o[dt][gq * 4 + 1]); u[1] = pk2(o[dt][gq * 4 + 2], o[dt][gq * 4 + 3]);
          *(u32x2*)(dst + dt * 32 + 8 * gq + 4 * kb) = u;
        }
    } else {
      bf16_t* dst = (bf16_t*)(P.ws + R_VCMPT) + (size_t)(b * 2 + g) * 64 * 512 + c;
#pragma unroll
      for (int dt = 0; dt < 2; ++dt)
#pragma unroll
        for (int r = 0; r < 16; ++r) dst[(size_t)(dt * 32 + crow(r, kb)) * 512] = f2bf(o[dt][r]);
    }
  }
}

DI void nsa_transpose_v(const Params& P) {
  const bf16_t* proj = (const bf16_t*)(P.ws + R1);
  const int total = 2 * 8 * 2 * 1024 * 64;
  for (int u = blockIdx.x * blockDim.x + TIDX; u < total; u += gridDim.x * blockDim.x) {
    const int dh = u & 63; int rest = u >> 6; const int t8 = rest & 1023; rest >>= 10;
    const int g = rest & 1, b = (rest >> 1) & 7, which = rest >> 4;
    const bf16_t* src = proj + ((size_t)b * SEQ + t8 * 8) * PW + (which ? C_VW : C_VS) + g * 64 + dh;
    bf16_t v[8];
#pragma unroll
    for (int j = 0; j < 8; ++j) v[j] = src[(size_t)j * PW];
    u32x4 o;
#pragma unroll
    for (int j = 0; j < 4; ++j) o[j] = (unsigned)v[2 * j] | ((unsigned)v[2 * j + 1] << 16);
    bf16_t* dst = (bf16_t*)(P.ws + (which ? R_VWT : R_VST)) + ((size_t)(b * 2 + g) * 64 + dh) * SEQ + t8 * 8;
    *(u32x4*)dst = o;
  }
}

DI f32x16 qk_tile(const bf16_t* krow, const bf16x8 (&qf)[4]) {
  f32x16 s = zero16();
#pragma unroll
  for (int i = 0; i < 4; ++i) { const bf16x8 kf = *(const bf16x8*)(krow + i * 16); s = mfma(kf, qf[i], s); }
  return s;
}

DI float half_max(float x) {
  const auto r = __builtin_amdgcn_permlane32_swap(__float_as_uint(x), __float_as_uint(x), false, false);
  return fmaxf(__uint_as_float(r[0]), __uint_as_float(r[1]));
}
DI float half_sum(float x) {
  const auto r = __builtin_amdgcn_permlane32_swap(__float_as_uint(x), __float_as_uint(x), false, false);
  return __uint_as_float(r[0]) + __uint_as_float(r[1]);
}
struct KVFrag { bf16x8 k[4]; };
DI void kv_load(KVFrag& f, const bf16_t* krow) {
#pragma unroll
  for (int i = 0; i < 4; ++i) f.k[i] = *(const bf16x8*)(krow + i * 16);
}
template <bool EDGE>
DI void attn_step(const KVFrag& f, const bf16_t* vt0, const bf16x8 (&qf)[4], int k0, int tq, int lo, bool bit, int kb,
                  f32x16& o0, f32x16& o1, float& m, float& l) {
  constexpr float CS = 0.125f * 1.4426950408889634f;
  bf16x8 vf[4];
  vf[0] = ld2x4(vt0 + k0); vf[1] = ld2x4(vt0 + k0 + 16);
  vf[2] = ld2x4(vt0 + (size_t)32 * SEQ + k0); vf[3] = ld2x4(vt0 + (size_t)32 * SEQ + k0 + 16);
  f32x16 s = zero16();
#pragma unroll
  for (int i = 0; i < 4; ++i) s = mfma(f.k[i], qf[i], s);
  float tmax = -1e30f;
  if (EDGE) {
#pragma unroll
    for (int r = 0; r < 16; ++r) {
      const int key = k0 + crow(r, kb);
      const bool vd = (key <= tq) && (key > lo);
      s[r] = vd ? s[r] * CS : -1e30f;
      tmax = fmaxf(tmax, s[r]);
    }
  } else {
#pragma unroll
    for (int r = 0; r < 16; ++r) tmax = fmaxf(tmax, s[r]);
    tmax *= CS;
  }
  tmax = bit ? tmax : -1e30f;
  tmax = half_max(tmax);
  if (__ballot(tmax > m) != 0ull) {
    const float mn = fmaxf(m, tmax);
    const float alpha = __builtin_amdgcn_exp2f(m - mn);
    l *= alpha; m = mn;
#pragma unroll
    for (int r = 0; r < 16; ++r) { o0[r] *= alpha; o1[r] *= alpha; }
  }
  const bool live = bit && (m > -5e29f);
  float ps = 0.f;
#pragma unroll
  for (int r = 0; r < 16; ++r) {
    const float e = EDGE ? __builtin_amdgcn_exp2f(s[r] - m) : __builtin_amdgcn_exp2f(__builtin_fmaf(s[r], CS, -m));
    s[r] = live ? e : 0.f;
    ps += s[r];
  }
  l += ps;
#pragma unroll
  for (int sI = 0; sI < 2; ++sI) {
    const bf16x8 pf = pack8(s[8 * sI], s[8 * sI + 1], s[8 * sI + 2], s[8 * sI + 3], s[8 * sI + 4], s[8 * sI + 5], s[8 * sI + 6], s[8 * sI + 7]);
    o0 = mfma(vf[sI], pf, o0); o1 = mfma(vf[2 + sI], pf, o1);
  }
}

DI void nsa_task(const Params& P, int b, int g, int qt, float* imp) {
  const bf16_t* proj = (const bf16_t*)(P.ws + R1);
  bf16_t* mix = (bf16_t*)(P.ws + R3);
  const int lane = TIDX & 63, l32 = lane & 31, kb = lane >> 5;
  const int t0 = qt * 32, tq = t0 + l32;
  const size_t tokq = (size_t)b * SEQ + tq;
  const bf16_t* qrow = proj + tokq * PW;
  const bf16_t* kcmp = (const bf16_t*)(P.ws + R_KCMP) + (size_t)(b * 2 + g) * 512 * 64;
  const bf16_t* vcmpT = (const bf16_t*)(P.ws + R_VCMPT) + (size_t)(b * 2 + g) * 64 * 512;
  for (int i = lane; i < 4096; i += 64) imp[i] = 0.f;
  const int nct = (qt >> 4) + 1;
  for (int hh = 0; hh < 4; ++hh) {
    const int head = g * 4 + hh;
    bf16x8 qf[4];
#pragma unroll
    for (int i = 0; i < 4; ++i) qf[i] = *(const bf16x8*)(qrow + C_NQ + head * 64 + i * 16 + kb * 8);
    float m = -1e30f, l = 0.f;
    for (int ct = 0; ct < nct; ++ct) {
      f32x16 s = qk_tile(kcmp + (size_t)(ct * 32 + l32) * 64 + kb * 8, qf);
      float tmax = -1e30f;
#pragma unroll
      for (int r = 0; r < 16; ++r) {
        const int c = ct * 32 + crow(r, kb);
        const bool vd = (c * 16 + 31 <= tq);
        s[r] = vd ? s[r] * 0.125f : -1e30f;
        tmax = fmaxf(tmax, s[r]);
      }
      const float mn = fmaxf(m, tmax);
      float ps = 0.f;
#pragma unroll
      for (int r = 0; r < 16; ++r) ps += (s[r] > -5e29f) ? __expf(s[r] - mn) : 0.f;
      l = l * __expf(m - mn) + ps; m = mn;
    }
    const float mo = __shfl_xor(m, 32), lo_ = __shfl_xor(l, 32);
    const float M = fmaxf(m, mo);
    const float L = l * __expf(m - M) + lo_ * __expf(mo - M);
    const float invL = 1.f / fmaxf(L, 1e-30f);
    f32x16 o0 = zero16(), o1 = zero16();
    float carry = 0.f;
    for (int ct = 0; ct < nct; ++ct) {
      f32x16 s = qk_tile(kcmp + (size_t)(ct * 32 + l32) * 64 + kb * 8, qf);
#pragma unroll
      for (int r = 0; r < 16; ++r) {
        const int c = ct * 32 + crow(r, kb);
        const bool vd = (c * 16 + 31 <= tq);
        s[r] = vd ? __expf(s[r] * 0.125f - M) * invL : 0.f;
      }
      float y[4];
#pragma unroll
      for (int gi = 0; gi < 4; ++gi) y[gi] = __shfl_xor(s[4 * gi + 3], 32);
#pragma unroll
      for (int gi = 0; gi < 4; ++gi) {
        const float s4 = (s[4 * gi] + s[4 * gi + 1]) + (s[4 * gi + 2] + s[4 * gi + 3]);
        const float extra = kb ? y[gi] : (gi == 0 ? carry : y[gi > 0 ? gi - 1 : 0]);
        const int j = ct * 8 + 2 * gi + kb;
        imp[j * 32 + l32] += s4 + extra;
      }
      carry = y[3];
#pragma unroll
      for (int sI = 0; sI < 2; ++sI) {
        const bf16x8 pf = pack8(s[8 * sI], s[8 * sI + 1], s[8 * sI + 2], s[8 * sI + 3], s[8 * sI + 4], s[8 * sI + 5], s[8 * sI + 6], s[8 * sI + 7]);
        const bf16x8 va = ld2x4(vcmpT + (size_t)(l32)*512 + ct * 32 + 16 * sI + 4 * kb);
        const bf16x8 vb = ld2x4(vcmpT + (size_t)(32 + l32) * 512 + ct * 32 + 16 * sI + 4 * kb);
        o0 = mfma(va, pf, o0); o1 = mfma(vb, pf, o1);
      }
    }
    const float g0 = sigmoidf_(bf2f(qrow[C_NG + head * 3 + 0]) + P.nsa_gate_b[head * 3 + 0]);
#pragma unroll
    for (int gq = 0; gq < 4; ++gq) {
      u32x2 u0, u1;
      u0[0] = pk2(g0 * o0[gq * 4], g0 * o0[gq * 4 + 1]); u0[1] = pk2(g0 * o0[gq * 4 + 2], g0 * o0[gq * 4 + 3]);
      u1[0] = pk2(g0 * o1[gq * 4], g0 * o1[gq * 4 + 1]); u1[1] = pk2(g0 * o1[gq * 4 + 2], g0 * o1[gq * 4 + 3]);
      *(u32x2*)(mix + tokq * DM + 512 + head * 64 + 8 * gq + 4 * kb) = u0;
      *(u32x2*)(mix + tokq * DM + 512 + head * 64 + 32 + 8 * gq + 4 * kb) = u1;
    }
  }
  asm volatile("s_waitcnt lgkmcnt(0)" ::: "memory");
  __builtin_amdgcn_wave_barrier();
  unsigned mk0 = 0, mk1 = 0, mk2 = 0, mk3 = 0;
  for (int q = 0; q < 32; ++q) {
    const int tqq = t0 + q, cur = tqq >> 6;
    const float v0 = imp[lane * 32 + q], v1 = imp[(lane + 64) * 32 + q];
    const int j0 = lane, j1 = lane + 64;
    const float s0 = (j0 == 0 || j0 == cur || j0 == cur - 1) ? 1e30f : (j0 <= cur ? v0 : -1e30f);
    const float s1 = (j1 == cur || j1 == cur - 1) ? 1e30f : (j1 <= cur ? v1 : -1e30f);
    int c0 = 0, c1 = 0;
#pragma unroll
    for (int k = 0; k < 64; ++k) {
      const float a0 = __int_as_float(__builtin_amdgcn_readlane(__float_as_int(s0), k));
      const float a1 = __int_as_float(__builtin_amdgcn_readlane(__float_as_int(s1), k));
      c0 += ((a0 > s0) || (a0 == s0 && k < lane)) ? 1 : 0;
      c0 += (a1 > s0) ? 1 : 0;
      c1 += (a0 >= s1) ? 1 : 0;
      c1 += ((a1 > s1) || (a1 == s1 && k < lane)) ? 1 : 0;
    }
    const bool sel0 = (s0 > -5e29f) && (c0 < 16);
    const bool sel1 = (s1 > -5e29f) && (c1 < 16);
    const unsigned long long blo = __ballot(sel0), bhi = __ballot(sel1);
    if (l32 == q) { mk0 = (unsigned)blo; mk1 = (unsigned)(blo >> 32); mk2 = (unsigned)bhi; mk3 = (unsigned)(bhi >> 32); }
  }
  asm volatile("" ::: "memory");
  const bf16_t* ksel = proj + (size_t)b * SEQ * PW + C_KS + g * 64 + kb * 8;
  const bf16_t* kwin = proj + (size_t)b * SEQ * PW + C_KW + g * 64 + kb * 8;
  const bf16_t* vsT = (const bf16_t*)(P.ws + R_VST) + ((size_t)(b * 2 + g) * 64 + l32) * SEQ + 4 * kb;
  const bf16_t* vwT = (const bf16_t*)(P.ws + R_VWT) + ((size_t)(b * 2 + g) * 64 + l32) * SEQ + 4 * kb;
  for (int hh = 0; hh < 4; ++hh) {
    const int head = g * 4 + hh;
    bf16x8 qf[4];
#pragma unroll
    for (int i = 0; i < 4; ++i) qf[i] = *(const bf16x8*)(qrow + C_NQ + head * 64 + i * 16 + kb * 8);
    f32x16 a0 = zero16(), a1 = zero16(); float m = -1e30f, l = 0.f;
    {
      KVFrag fn;
      kv_load(fn, ksel + (size_t)(l32)*PW);
      for (int kt = 0; kt <= qt; ++kt) {
        const KVFrag fc = fn;
        if (kt < qt) kv_load(fn, ksel + (size_t)((kt + 1) * 32 + l32) * PW);
        const int j = kt >> 1;
        const unsigned mw = j < 32 ? mk0 : (j < 64 ? mk1 : (j < 96 ? mk2 : mk3));
        const bool bit = (mw >> (j & 31)) & 1u;
        if (kt < qt) attn_step<false>(fc, vsT, qf, kt * 32, tq, -1, bit, kb, a0, a1, m, l);
        else attn_step<true>(fc, vsT, qf, kt * 32, tq, -1, bit, kb, a0, a1, m, l);
      }
    }
    float lt = half_sum(l);
    const float g1 = sigmoidf_(bf2f(qrow[C_NG + head * 3 + 1]) + P.nsa_gate_b[head * 3 + 1]);
    const float f1 = g1 / fmaxf(lt, 1e-30f);
#pragma unroll
    for (int gq = 0; gq < 4; ++gq) {
      bf16_t* d0 = mix + tokq * DM + 512 + head * 64 + 8 * gq + 4 * kb;
      bf16_t* d1 = d0 + 32;
      const u32x2 p0 = *(const u32x2*)d0, p1 = *(const u32x2*)d1;
      u32x2 u0, u1;
      u0[0] = pk2(bflo(p0[0]) + f1 * a0[gq * 4], bfhi(p0[0]) + f1 * a0[gq * 4 + 1]);
      u0[1] = pk2(bflo(p0[1]) + f1 * a0[gq * 4 + 2], bfhi(p0[1]) + f1 * a0[gq * 4 + 3]);
      u1[0] = pk2(bflo(p1[0]) + f1 * a1[gq * 4], bfhi(p1[0]) + f1 * a1[gq * 4 + 1]);
      u1[1] = pk2(bflo(p1[1]) + f1 * a1[gq * 4 + 2], bfhi(p1[1]) + f1 * a1[gq * 4 + 3]);
      *(u32x2*)d0 = u0; *(u32x2*)d1 = u1;
    }
    f32x16 w0 = zero16(), w1 = zero16(); m = -1e30f; l = 0.f;
    {
      const int ktb = qt > 16 ? qt - 16 : 0;
      KVFrag fn;
      kv_load(fn, kwin + (size_t)(ktb * 32 + l32) * PW);
      for (int kt = ktb; kt <= qt; ++kt) {
        const KVFrag fc = fn;
        if (kt < qt) kv_load(fn, kwin + (size_t)((kt + 1) * 32 + l32) * PW);
        if (kt == qt || kt == qt - 16) attn_step<true>(fc, vwT, qf, kt * 32, tq, tq - 512, true, kb, w0, w1, m, l);
        else attn_step<false>(fc, vwT, qf, kt * 32, tq, tq - 512, true, kb, w0, w1, m, l);
      }
    }
    lt = half_sum(l);
    const float g2 = sigmoidf_(bf2f(qrow[C_NG + head * 3 + 2]) + P.nsa_gate_b[head * 3 + 2]);
    const float f2 = g2 / fmaxf(lt, 1e-30f);
#pragma unroll
    for (int gq = 0; gq < 4; ++gq) {
      bf16_t* d0 = mix + tokq * DM + 512 + head * 64 + 8 * gq + 4 * kb;
      bf16_t* d1 = d0 + 32;
      const u32x2 p0 = *(const u32x2*)d0, p1 = *(const u32x2*)d1;
      u32x2 u0, u1;
      u0[0] = pk2(bflo(p0[0]) + f2 * w0[gq * 4], bfhi(p0[0]) + f2 * w0[gq * 4 + 1]);
      u0[1] = pk2(bflo(p0[1]) + f2 * w0[gq * 4 + 2], bfhi(p0[1]) + f2 * w0[gq * 4 + 3]);
      u1[0] = pk2(bflo(p1[0]) + f2 * w1[gq * 4], bfhi(p1[0]) + f2 * w1[gq * 4 + 1]);
      u1[1] = pk2(bflo(p1[1]) + f2 * w1[gq * 4 + 2], bfhi(p1[1]) + f2 * w1[gq * 4 + 3]);
      *(u32x2*)d0 = u0; *(u32x2*)d1 = u1;
    }
  }
  asm volatile("s_waitcnt lgkmcnt(0)" ::: "memory");
}

DI void sgu_item(const Params& P, int item, char* smem) {
  const bf16_t* H = (const bf16_t*)(P.ws + R1);
  bf16_t* Y = (bf16_t*)(P.ws + R2);
  float* smu = (float*)smem; float* srs = smu + 128; float* sc1 = srs + 128; float* srw = sc1 + 128;
  bf16_t* sW = (bf16_t*)(srw + 128); bf16_t* sV = sW + 128 * 136;
  const int tid = TIDX & 255, lane = tid & 63, wave = tid >> 6, l32 = lane & 31, kb = lane >> 5;
  const size_t tok0 = (size_t)item * 128;
  for (int tt = 0; tt < 32; ++tt) {
    const int t = wave * 32 + tt;
    const bf16_t* vr = H + (tok0 + t) * 4096 + 2048;
    float s = 0.f, s2 = 0.f;
#pragma unroll
    for (int k = 0; k < 4; ++k) {
      const u32x4 u = *(const u32x4*)(vr + k * 512 + lane * 8);
#pragma unroll
      for (int e = 0; e < 4; ++e) { const float a = bflo(u[e]), c = bfhi(u[e]); s += a + c; s2 += a * a + c * c; }
    }
    s = wave_sum(s); s2 = wave_sum(s2);
    const float mu = s * (1.f / 2048.f);
    const float var = fmaxf(s2 * (1.f / 2048.f) - mu * mu, 0.f);
    if (lane == 0) { smu[t] = mu; srs[t] = rsqrtf(var + EPS); }
  }
  __syncthreads();
  for (int g = 0; g < 8; ++g) {
    {
      const int t = tid >> 1, half = tid & 1;
      const float* wrow = P.o_w_s + ((size_t)g * 128 + t) * 128 + half * 64;
      float c1 = 0.f, rw = 0.f;
#pragma unroll 1
      for (int c8 = 0; c8 < 8; ++c8) {
        const float4 f0 = *(const float4*)(wrow + c8 * 8), f1 = *(const float4*)(wrow + c8 * 8 + 4);
        float wv[8] = {f0.x, f0.y, f0.z, f0.w, f1.x, f1.y, f1.z, f1.w};
        float ov[8];
#pragma unroll
        for (int e = 0; e < 8; ++e) {
          const int s = half * 64 + c8 * 8 + e;
          const float w = (s <= t) ? wv[e] : 0.f;
          rw += w;
          const float wp = bf2f(f2bf(w * srs[s]));
          c1 += wp * smu[s];
          ov[e] = wp;
        }
        u32x4 o; o[0] = pk2(ov[0], ov[1]); o[1] = pk2(ov[2], ov[3]); o[2] = pk2(ov[4], ov[5]); o[3] = pk2(ov[6], ov[7]);
        *(u32x4*)(sW + t * 136 + half * 64 + c8 * 8) = o;
      }
      c1 += __shfl_xor(c1, 1); rw += __shfl_xor(rw, 1);
      if (half == 0) { sc1[t] = c1; srw[t] = rw; }
    }
    for (int sub = 0; sub < 4; ++sub) {
      const int ch0 = g * 256 + sub * 64;
      {
        const int s = tid >> 1, half = tid & 1;
        const bf16_t* src = H + (tok0 + s) * 4096 + 2048 + ch0 + half * 32;
#pragma unroll
        for (int c = 0; c < 4; ++c) {
          const u32x4 u = *(const u32x4*)(src + c * 8);
#pragma unroll
          for (int e = 0; e < 4; ++e) {
            sV[(half * 32 + c * 8 + 2 * e) * 136 + s] = (bf16_t)(u[e] & 0xffffu);
            sV[(half * 32 + c * 8 + 2 * e + 1) * 136 + s] = (bf16_t)(u[e] >> 16);
          }
        }
      }
      __syncthreads();
      f32x16 acc0 = zero16(), acc1 = zero16();
      const int nks = 2 * (wave + 1);
      for (int ks = 0; ks < nks; ++ks) {
        const bf16x8 a = *(const bf16x8*)(sW + (wave * 32 + l32) * 136 + ks * 16 + kb * 8);
        const bf16x8 b0 = *(const bf16x8*)(sV + (l32)*136 + ks * 16 + kb * 8);
        const bf16x8 b1 = *(const bf16x8*)(sV + (32 + l32) * 136 + ks * 16 + kb * 8);
        acc0 = mfma(a, b0, acc0); acc1 = mfma(a, b1, acc1);
      }
#pragma unroll
      for (int ct = 0; ct < 2; ++ct) {
        const int ch = ch0 + ct * 32 + l32;
        const float lg = P.o_ln_g[ch], lb = P.o_ln_b[ch];
#pragma unroll
        for (int r = 0; r < 16; ++r) {
          const int t = wave * 32 + crow(r, kb);
          const float a = ct ? acc1[r] : acc0[r];
          const float mixed = lg * (a - sc1[t]) + lb * srw[t] + P.o_b_s[g * 128 + t];
          const float u = bf2f(H[(tok0 + t) * 4096 + ch]);
          Y[(tok0 + t) * 2048 + ch] = f2bf(u * mixed);
          if ((r & 3) == 3) __builtin_amdgcn_sched_barrier(0);
        }
      }
      __syncthreads();
    }
  }
}

constexpr int NPHASE = 17;
DI void run_phase(const Params& P, int ph, char* smem) {
  char* ws = P.ws;
  bf16_t* r1 = (bf16_t*)(ws + R1); bf16_t* r2 = (bf16_t*)(ws + R2); bf16_t* r3 = (bf16_t*)(ws + R3); bf16_t* r4 = (bf16_t*)(ws + R4);
  unsigned* cnt = (unsigned*)(ws + W_CNT);
  const int lane = TIDX & 63, wave = TIDX >> 6, half = TIDX >> 8;
  char* hsmem = smem + half * 65536;
  switch (ph) {
    case 0: phase_prep(P); break;
    case 1: gemm_run<0>(r2, (const bf16_t*)(ws + W_EIN), PW, 1024, r1, PW, smem); break;
    case 2: {
      nsa_transpose_v(P);
      if (blockIdx.x < 64) nsa_compress_task(P, blockIdx.x * WPB + wave);
      volatile int* s_item = (volatile int*)(smem + LDS_BYTES - 16);
      for (;;) {
        __syncthreads();
        if (TIDX == 0) *s_item = (int)atomicAdd(cnt + 0, 1u);
        __syncthreads();
        const int pair = *s_item;
        if (pair >= 2048) break;
        gla_p1_item(P, pair * 2 + half, hsmem);
      }
    } break;
    case 3: gla_scan(P);
    case 30: {
      float* imp = (float*)smem + wave * 4096;
      for (;;) {
        int tk = 0;
        if (lane == 0) tk = (int)atomicAdd(cnt + 1, 1u);
        tk = __builtin_amdgcn_readfirstlane(tk);
        if (tk >= 4096) break;
        const int qt = 255 - (tk >> 4), bg = tk & 15;
        nsa_task(P, bg >> 1, bg & 1, qt, imp);
      }
    } break;
    case 4:
      for (int item = blockIdx.x * 2 + half; item < 4096; item += gridDim.x * 2) gla_p3_item(P, item, hsmem);
      break;
    case 5: gemm_run<0>(r3, (const bf16_t*)(ws + W_EOUT), 1024, 1024, r4, 1024, smem); break;
    case 6: resnorm_rows(r4, P.x, P.out, P.norm_g + 1 * 1024, P.norm_g + 2 * 1024, r2); break;
    case 7: gemm_run<1>(r2, (const bf16_t*)(ws + W_FFN1_0), 4096, 1024, r1, 4096, smem); break;
    case 8: gemm_run<0>(r1, (const bf16_t*)(ws + W_FFN2_0), 1024, 4096, r4, 1024, smem); break;
    case 9: resnorm_rows(r4, P.out, P.out, P.norm_g + 3 * 1024, P.norm_g + 4 * 1024, r2); break;
    case 10: gemm_run<2>(r2, (const bf16_t*)(ws + W_OIN), 4096, 1024, r1, 4096, smem); break;
    case 11:
      for (int item = blockIdx.x * 2 + half; item < 512; item += gridDim.x * 2) sgu_item(P, item, hsmem);
      break;
    case 12: gemm_run<0>(r2, (const bf16_t*)(ws + W_OOUT), 1024, 2048, r4, 1024, smem); break;
    case 13: resnorm_rows(r4, P.out, P.out, P.norm_g + 5 * 1024, P.norm_g + 6 * 1024, r2); break;
    case 14: gemm_run<1>(r2, (const bf16_t*)(ws + W_FFN1_1), 4096, 1024, r1, 4096, smem); break;
    case 15: gemm_run<0>(r1, (const bf16_t*)(ws + W_FFN2_1), 1024, 4096, r4, 1024, smem); break;
    case 16: resnorm_rows(r4, P.out, P.out, P.norm_g + 7 * 1024, nullptr, nullptr); break;
    default: break;
  }
}

#if !MEGA
extern __shared__ __attribute__((aligned(16))) unsigned char lds_dyn[];
__global__ void __launch_bounds__(NTHR, 2) k_phase(Params P, int ph) {
  char* smem = (char*)lds_dyn;
  run_phase(P, ph, smem);
}
#endif

#if MEGA
extern __shared__ __attribute__((aligned(16))) unsigned char lds_dyn[];
__global__ void __launch_bounds__(NTHR, 2) k_mega(Params P) {
  char* smem = (char*)lds_dyn;
  cg::grid_group grid = cg::this_grid();
#ifndef PROBE
#define PROBE 0
#endif
#define GEMM_PH(n) run_phase(P, n, smem); grid.sync(); if (PROBE == 1) { run_phase(P, n, smem); grid.sync(); }
  run_phase(P, 0, smem); grid.sync();
  GEMM_PH(1)
  run_phase(P, 2, smem); grid.sync();
  run_phase(P, 3, smem); grid.sync();
  if (PROBE == 2) {
    if (blockIdx.x == 0 && TIDX == 0) ((unsigned*)(P.ws + W_CNT))[1] = 0u;
    grid.sync();
    run_phase(P, 30, smem); grid.sync();
  }
  run_phase(P, 4, smem); grid.sync();
  GEMM_PH(5)
  run_phase(P, 6, smem); grid.sync();
  GEMM_PH(7)
  GEMM_PH(8)
  run_phase(P, 9, smem); grid.sync();
  GEMM_PH(10)
  run_phase(P, 11, smem); grid.sync();
  GEMM_PH(12)
  run_phase(P, 13, smem); grid.sync();
  GEMM_PH(14)
  GEMM_PH(15)
  run_phase(P, 16, smem);
}
#endif

extern "C" void kernel_launch(void* const* d_in, const int* in_sizes, int n_in, void* d_out, int out_size, void* d_ws, size_t ws_size,
                              hipStream_t stream) {
  Params p{};
  p.x = (const float*)d_in[0]; p.norm_g = (const float*)d_in[1]; p.ffn_w1 = (const float*)d_in[2]; p.ffn_w2 = (const float*)d_in[3];
  p.e_w_in = (const float*)d_in[4]; p.e_w_out = (const float*)d_in[5]; p.gla_w_gate = (const float*)d_in[6]; p.gla_b_gate = (const float*)d_in[7];
  p.gla_norm = (const float*)d_in[8]; p.nsa_gate_b = (const float*)d_in[9]; p.cmp_pos = (const float*)d_in[10]; p.cmp_w1 = (const float*)d_in[11];
  p.cmp_w2 = (const float*)d_in[12]; p.o_w_in = (const float*)d_in[13]; p.o_ln_g = (const float*)d_in[14]; p.o_ln_b = (const float*)d_in[15];
  p.o_w_s = (const float*)d_in[16]; p.o_b_s = (const float*)d_in[17]; p.o_w_out = (const float*)d_in[18];
  p.out = (float*)d_out; p.ws = (char*)d_ws;
  if (ws_size < 1024ull * MiB) { fprintf(stderr, "workspace too small: %zu\n", ws_size); return; }
  static int grid_blocks = 0;
  if (!grid_blocks) {
    int dev = 0, cus = 0, per_cu = 0;
    (void)hipGetDevice(&dev);
    (void)hipDeviceGetAttribute(&cus, hipDeviceAttributeMultiprocessorCount, dev);
#if MEGA
    if (hipFuncSetAttribute((const void*)k_mega, hipFuncAttributeMaxDynamicSharedMemorySize, LDS_BYTES) != hipSuccess) fprintf(stderr, "hipFuncSetAttribute failed\n");
    (void)hipOccupancyMaxActiveBlocksPerMultiprocessor(&per_cu, (const void*)k_mega, NTHR, LDS_BYTES);
#else
    if (hipFuncSetAttribute((const void*)k_phase, hipFuncAttributeMaxDynamicSharedMemorySize, LDS_BYTES) != hipSuccess) fprintf(stderr, "hipFuncSetAttribute failed\n");
    (void)hipOccupancyMaxActiveBlocksPerMultiprocessor(&per_cu, (const void*)k_phase, NTHR, LDS_BYTES);
#endif
    if (per_cu < 1) fprintf(stderr, "occupancy query returned %d\n", per_cu);
    grid_blocks = cus;
  }
#if MEGA
  void* args[] = {&p};
  hipError_t e = hipLaunchCooperativeKernel((void*)k_mega, dim3(grid_blocks), dim3(NTHR), args, LDS_BYTES, stream);
  if (e != hipSuccess) fprintf(stderr, "cooperative launch failed: %s (grid %d)\n", hipGetErrorString(e), grid_blocks);
#else
  for (int ph = 0; ph < NPHASE; ++ph) k_phase<<<grid_blocks, NTHR, LDS_BYTES, stream>>>(p, ph);
#endif
}
```

```cpp
#include <hip/hip_runtime.h>
#include <hip/hip_cooperative_groups.h>
#include <cstdio>
namespace cg = cooperative_groups;

#ifndef MEGA
#define MEGA 1
#endif

typedef unsigned short bf16_t;
typedef short bf16x8 __attribute__((ext_vector_type(8)));
typedef short s16x4 __attribute__((ext_vector_type(4)));
typedef float f32x16 __attribute__((ext_vector_type(16)));
typedef float f32v2 __attribute__((ext_vector_type(2)));
typedef __bf16 bf16v2 __attribute__((ext_vector_type(2)));
typedef unsigned u32x4 __attribute__((ext_vector_type(4)));
typedef unsigned u32x2 __attribute__((ext_vector_type(2)));
#define DI __device__ __forceinline__
DI int tid_opaque() { int t = threadIdx.x; asm volatile("" : "+v"(t)); return t; }
#define TIDX tid_opaque()

constexpr int T_TOK = 65536, SEQ = 8192, DM = 1024;
constexpr int PW = 3072;
constexpr int C_GQ = 0, C_GK = 256, C_GV = 512, C_GLR = 1024, C_GR = 1040, C_NQ = 1552, C_KC = 2064, C_VC = 2192,
              C_KS = 2320, C_VS = 2448, C_KW = 2576, C_VW = 2704, C_NG = 2832;
constexpr float EPS = 1e-6f;
constexpr int NTHR = 512, WPB = 8, LDS_BYTES = 131072 + 64;
constexpr size_t MiB = 1024ull * 1024ull;
constexpr size_t W_FFN1_0 = 0, W_FFN1_1 = 8 * MiB, W_FFN2_0 = 16 * MiB, W_FFN2_1 = 24 * MiB, W_EIN = 32 * MiB, W_EOUT = 38 * MiB,
                 W_OIN = 40 * MiB, W_OOUT = 48 * MiB, W_CW1 = 52 * MiB, W_CW2 = 53 * MiB, W_BIAS1 = 53 * MiB + 65536,
                 W_CNT = 53 * MiB + 131072;
constexpr size_t R1 = 64 * MiB, R2 = 576 * MiB, R3 = 704 * MiB, R4 = 832 * MiB, R5 = 960 * MiB;
constexpr size_t R_KCMP = R5, R_VCMPT = R5 + 1 * MiB, R_VST = R5 + 2 * MiB, R_VWT = R5 + 18 * MiB, R_DECAY = R5 + 34 * MiB;

struct Params {
  const float* x; const float* norm_g; const float* ffn_w1; const float* ffn_w2; const float* e_w_in; const float* e_w_out;
  const float* gla_w_gate; const float* gla_b_gate; const float* gla_norm; const float* nsa_gate_b; const float* cmp_pos;
  const float* cmp_w1; const float* cmp_w2; const float* o_w_in; const float* o_ln_g; const float* o_ln_b; const float* o_w_s;
  const float* o_b_s; const float* o_w_out;
  float* out; char* ws;
};

DI int crow(int r, int kb) { return (r & 3) + 8 * (r >> 2) + 4 * kb; }
DI f32x16 mfma(bf16x8 a, bf16x8 b, f32x16 c) { return __builtin_amdgcn_mfma_f32_32x32x16_bf16(a, b, c, 0, 0, 0); }
DI unsigned pk2(float a, float b) { f32v2 v = {a, b}; bf16v2 r = __builtin_convertvector(v, bf16v2); return __builtin_bit_cast(unsigned, r); }
DI bf16_t f2bf(float a) { return (bf16_t)(pk2(a, 0.f) & 0xffffu); }
DI float bf2f(bf16_t u) { return __uint_as_float(((unsigned)u) << 16); }
DI float bflo(unsigned u) { return __uint_as_float(u << 16); }
DI float bfhi(unsigned u) { return __uint_as_float(u & 0xffff0000u); }
DI bf16x8 pack8(float a0, float a1, float a2, float a3, float a4, float a5, float a6, float a7) {
  u32x4 p; p[0] = pk2(a0, a1); p[1] = pk2(a2, a3); p[2] = pk2(a4, a5); p[3] = pk2(a6, a7);
  return __builtin_bit_cast(bf16x8, p);
}
DI bf16x8 ld2x4(const bf16_t* p) {
  s16x4 lo = *(const s16x4*)p; s16x4 hi = *(const s16x4*)(p + 8);
  return __builtin_shufflevector(lo, hi, 0, 1, 2, 3, 4, 5, 6, 7);
}
DI float wave_sum(float v) {
#pragma unroll
  for (int o = 32; o > 0; o >>= 1) v += __shfl_xor(v, o);
  return v;
}
DI f32x16 zero16() { f32x16 z;
#pragma unroll
  for (int i = 0; i < 16; ++i) z[i] = 0.f; return z; }
DI float gelu_tanh(float x) { float u = 1.5957691216f * (x + 0.044715f * x * x * x); return x / (1.f + __expf(-u)); }
DI float sigmoidf_(float x) { return 1.f / (1.f + __expf(-x)); }

DI void conv_weight(const float* __restrict__ src, bf16_t* __restrict__ dst, int K, int N, int Npad) {
  const long total = (long)Npad * (K >> 3);
  const long stride = (long)gridDim.x * blockDim.x;
  for (long i = (long)blockIdx.x * blockDim.x + TIDX; i < total; i += stride) {
    const int n = (int)(i % Npad); const int k8 = (int)(i / Npad);
    float v[8];
#pragma unroll
    for (int j = 0; j < 8; ++j) v[j] = (n < N) ? src[(size_t)(k8 * 8 + j) * N + n] : 0.f;
    u32x4 o; o[0] = pk2(v[0], v[1]); o[1] = pk2(v[2], v[3]); o[2] = pk2(v[4], v[5]); o[3] = pk2(v[6], v[7]);
    *(u32x4*)(dst + (size_t)n * K + k8 * 8) = o;
  }
}

DI void prenorm_rows(const float* __restrict__ x, const float* __restrict__ g, bf16_t* __restrict__ xn) {
  const int lane = TIDX & 63, wave = TIDX >> 6;
  const int nw = gridDim.x * WPB;
  for (int row = blockIdx.x * WPB + wave; row < T_TOK; row += nw) {
    const float4* xr = (const float4*)(x + (size_t)row * DM);
    float4 a[4]; float ss = 0.f;
#pragma unroll
    for (int k = 0; k < 4; ++k) { a[k] = xr[k * 64 + lane]; ss += a[k].x * a[k].x + a[k].y * a[k].y + a[k].z * a[k].z + a[k].w * a[k].w; }
    ss = wave_sum(ss);
    const float rs = rsqrtf(ss * (1.f / DM) + EPS);
#pragma unroll
    for (int k = 0; k < 4; ++k) {
      const float4 gg = ((const float4*)g)[k * 64 + lane];
      u32x2 o; o[0] = pk2(a[k].x * rs * gg.x, a[k].y * rs * gg.y); o[1] = pk2(a[k].z * rs * gg.z, a[k].w * rs * gg.w);
      *(u32x2*)(xn + (size_t)row * DM + k * 256 + lane * 4) = o;
    }
  }
}

DI void resnorm_rows(const bf16_t* __restrict__ m, const float* hin, float* hout, const float* __restrict__ gpost,
                             const float* __restrict__ gnext, bf16_t* __restrict__ xn) {
  const int lane = TIDX & 63, wave = TIDX >> 6;
  const int nw = gridDim.x * WPB;
  for (int row = blockIdx.x * WPB + wave; row < T_TOK; row += nw) {
    float mv[16]; float ss = 0.f;
#pragma unroll
    for (int k = 0; k < 4; ++k) {
      const u32x2 u = *(const u32x2*)(m + (size_t)row * DM + k * 256 + lane * 4);
      mv[k * 4 + 0] = bflo(u[0]); mv[k * 4 + 1] = bfhi(u[0]); mv[k * 4 + 2] = bflo(u[1]); mv[k * 4 + 3] = bfhi(u[1]);
    }
#pragma unroll
    for (int i = 0; i < 16; ++i) ss += mv[i] * mv[i];
    ss = wave_sum(ss);
    const float rs = rsqrtf(ss * (1.f / DM) + EPS);
    float hv[16]; float s2 = 0.f;
#pragma unroll
    for (int k = 0; k < 4; ++k) {
      const float4 h4 = ((const float4*)(hin + (size_t)row * DM))[k * 64 + lane];
      const float4 gg = ((const float4*)gpost)[k * 64 + lane];
      hv[k * 4 + 0] = h4.x + mv[k * 4 + 0] * rs * gg.x; hv[k * 4 + 1] = h4.y + mv[k * 4 + 1] * rs * gg.y;
      hv[k * 4 + 2] = h4.z + mv[k * 4 + 2] * rs * gg.z; hv[k * 4 + 3] = h4.w + mv[k * 4 + 3] * rs * gg.w;
      float4 o; o.x = hv[k * 4 + 0]; o.y = hv[k * 4 + 1]; o.z = hv[k * 4 + 2]; o.w = hv[k * 4 + 3];
      ((float4*)(hout + (size_t)row * DM))[k * 64 + lane] = o;
    }
    if (xn) {
#pragma unroll
      for (int i = 0; i < 16; ++i) s2 += hv[i] * hv[i];
      s2 = wave_sum(s2);
      const float r2 = rsqrtf(s2 * (1.f / DM) + EPS);
#pragma unroll
      for (int k = 0; k < 4; ++k) {
        const float4 gg = ((const float4*)gnext)[k * 64 + lane];
        u32x2 o; o[0] = pk2(hv[k * 4 + 0] * r2 * gg.x, hv[k * 4 + 1] * r2 * gg.y); o[1] = pk2(hv[k * 4 + 2] * r2 * gg.z, hv[k * 4 + 3] * r2 * gg.w);
        *(u32x2*)(xn + (size_t)row * DM + k * 256 + lane * 4) = o;
      }
    }
  }
}

DI void phase_prep(const Params& P) {
  char* ws = P.ws;
  conv_weight(P.ffn_w1, (bf16_t*)(ws + W_FFN1_0), 1024, 4096, 4096);
  conv_weight(P.ffn_w1 + (size_t)1024 * 4096, (bf16_t*)(ws + W_FFN1_1), 1024, 4096, 4096);
  conv_weight(P.ffn_w2, (bf16_t*)(ws + W_FFN2_0), 4096, 1024, 1024);
  conv_weight(P.ffn_w2 + (size_t)1024 * 4096, (bf16_t*)(ws + W_FFN2_1), 4096, 1024, 1024);
  conv_weight(P.e_w_in, (bf16_t*)(ws + W_EIN), 1024, 2856, PW);
  conv_weight(P.e_w_out, (bf16_t*)(ws + W_EOUT), 1024, 1024, 1024);
  conv_weight(P.o_w_in, (bf16_t*)(ws + W_OIN), 1024, 4096, 4096);
  conv_weight(P.o_w_out, (bf16_t*)(ws + W_OOUT), 2048, 1024, 1024);
  conv_weight(P.cmp_w1, (bf16_t*)(ws + W_CW1), 2048, 128, 128);
  conv_weight(P.cmp_w1 + 2048 * 128, (bf16_t*)(ws + W_CW1) + 128 * 2048, 2048, 128, 128);
  conv_weight(P.cmp_w2, (bf16_t*)(ws + W_CW2), 128, 64, 64);
  conv_weight(P.cmp_w2 + 128 * 64, (bf16_t*)(ws + W_CW2) + 64 * 128, 128, 64, 64);
  const int lane = TIDX & 63, wave = TIDX >> 6;
  const int gw = blockIdx.x * WPB + wave;
  if (gw < 256) {
    const int i = gw >> 7, hid = gw & 127;
    float s = 0.f;
    for (int kk = lane; kk < 2048; kk += 64) s += P.cmp_pos[i * 2048 + kk] * P.cmp_w1[((size_t)i * 2048 + kk) * 128 + hid];
    s = wave_sum(s);
    if (lane == 0) ((float*)(ws + W_BIAS1))[gw] = s;
  }
  const int gt = blockIdx.x * blockDim.x + TIDX;
  if (gt < 16) ((unsigned*)(ws + W_CNT))[gt] = 0u;
  if (gt < 16 * 64) {
    const int bg = gt >> 6, d = gt & 63;
    ((bf16_t*)(ws + R_KCMP))[((size_t)bg * 512 + 511) * 64 + d] = 0;
    ((bf16_t*)(ws + R_VCMPT))[((size_t)bg * 64 + d) * 512 + 511] = 0;
  }
  prenorm_rows(P.x, P.norm_g, (bf16_t*)(ws + R2));
}

namespace pg8 {
#define PG8_LAS __attribute__((address_space(3)))
typedef float f32x4 __attribute__((ext_vector_type(4)));
constexpr int BM = 256, BK = 64, HALF = 128, HTB = HALF * BK * 2, STAGE_BYTES = 8 * HTB, NXCD = 8, WGM = 8;
DI int lds_byte(int r, int c) { const int st = (r >> 4) * 2 + (c >> 5), rr = r & 15, cc = c & 31, ob = rr * 64 + cc * 2; return st * 1024 + (ob ^ (((ob >> 9) & 1) << 5)); }
DI void stage_rc(int b, int& R, int& C) { const int st = b / 1024, sb = b % 1024, swz = sb ^ (((sb >> 9) & 1) << 5); R = (st >> 1) * 16 + swz / 64; C = (st & 1) * 32 + (swz % 64) / 2; }
DI int perm32(int rho) { const int n = rho >> 4, i = rho & 15; return 8 * (i >> 2) + 4 * n + (i & 3); }
struct Unit { int pm, pn; };
struct Gemm { const bf16_t* A; const bf16_t* Bt; int M, N, K; };
struct StaticOrder {
  int nM, nN, nwg, G, c;
  DI void init(int M, int N, int G_, int c_) { nM = M / BM; nN = N / BM; nwg = nM * nN; G = G_; c = c_; }
  DI bool next(int i, Unit& u) const {
    const long L = (long)i * G + c; if (L >= nwg) return false;
    int wgid = (int)L; { const int q = nwg / NXCD, r = nwg % NXCD, xcd = wgid % NXCD, off = wgid / NXCD; wgid = (xcd < r ? xcd * (q + 1) : r * (q + 1) + (xcd - r) * q) + off; }
    const int nig = WGM * nN, gid = wgid / nig, fm = gid * WGM, gsz = (nM - fm) < WGM ? (nM - fm) : WGM;
    u.pm = fm + ((wgid % nig) % gsz); u.pn = (wgid % nig) / gsz; return true;
  }
};
template <int ACT> struct EpiB {
  static constexpr bool PERM = true;
  bf16_t* O; int ldc;
  DI void operator()(const f32x4 (&acc)[2][2][4][2], const Unit& u, int wr, int wc, int fr, int fq) const {
    const int row0 = u.pm * BM + wr * 64 + fr; const int col0 = u.pn * BM + wc * 32 + 8 * fq;
#pragma unroll
    for (int ai = 0; ai < 2; ++ai)
#pragma unroll
      for (int m = 0; m < 4; ++m) {
        bf16_t* rowp = O + (size_t)(row0 + ai * HALF + m * 16) * ldc + col0;
#pragma unroll
        for (int bj = 0; bj < 2; ++bj) {
          f32x4 v0 = acc[ai][bj][m][0], v1 = acc[ai][bj][m][1];
          if (ACT == 1) {
#pragma unroll
            for (int j = 0; j < 4; ++j) { const float a = fmaxf(v0[j], 0.f), b = fmaxf(v1[j], 0.f); v0[j] = a * a; v1[j] = b * b; }
          }
          if (ACT == 2) {
#pragma unroll
            for (int j = 0; j < 4; ++j) { v0[j] = gelu_tanh(v0[j]); v1[j] = gelu_tanh(v1[j]); }
          }
          u32x4 w; w[0] = pk2(v0[0], v0[1]); w[1] = pk2(v0[2], v0[3]); w[2] = pk2(v1[0], v1[1]); w[3] = pk2(v1[2], v1[3]);
          *(u32x4*)(rowp + bj * HALF) = w;
        }
      }
  }
};

template <class Epi, class Sched>
DI void gemm_phase(PG8_LAS unsigned char* lds, const Gemm g, const Sched& S, const Epi& E) {
  const int tid_ = TIDX;
  const int tid = tid_, wid = __builtin_amdgcn_readfirstlane(tid >> 6), lane = tid & 63, wr = wid >> 2, wc = wid & 3, fr = lane & 15, fq = lane >> 4;
  const int K = g.K, nt = K / BK;
  unsigned voffA[2], voffB[2];
#pragma unroll
  for (int i = 0; i < 2; ++i) { int R, C; stage_rc(tid * 16 + i * 8192, R, C); const int Rb = Epi::PERM ? ((R & ~31) + perm32(R & 31)) : R;
    voffA[i] = (unsigned)(R * K + C) * 2u; voffB[i] = (unsigned)(Rb * K + C) * 2u; }
  const size_t kstep = (size_t)(BK * 2);
  const size_t hstep = (size_t)HALF * K * 2;
  const size_t tstep = 2 * hstep;
  const unsigned ldsw = (unsigned)wid * 1024u;
  const int aoff = lds_byte(wr * 64 + fr, fq * 8), boff = lds_byte(wc * 32 + fr, fq * 8);
#define PG8_SA(b, h) (((b) * 2 + (h)) * HTB)
#define PG8_SB(b, h) ((4 + (b) * 2 + (h)) * HTB)
#define PG8_STAGE(bufoff, gbase, voff) do { _Pragma("unroll") for (int _i = 0; _i < 2; ++_i) \
    __builtin_amdgcn_global_load_lds((const unsigned*)((const char*)(gbase) + (voff)[_i]), (PG8_LAS unsigned*)(lds + (bufoff) + ldsw + _i * 8192), 16, 0, 0); } while (0)
#define PG8_LDA(dst, b, h) do { _Pragma("unroll") for (int m = 0; m < 4; ++m) _Pragma("unroll") for (int k = 0; k < 2; ++k) dst[m][k] = *(const PG8_LAS bf16x8*)(lds + PG8_SA(b, h) + aoff + m * 2048 + k * 1024); } while (0)
#define PG8_LDB(dst, b, h) do { _Pragma("unroll") for (int n = 0; n < 2; ++n) _Pragma("unroll") for (int k = 0; k < 2; ++k) dst[n][k] = *(const PG8_LAS bf16x8*)(lds + PG8_SB(b, h) + boff + n * 2048 + k * 1024); } while (0)
#define PG8_MMA(ai, bj, At, Bt) do { __builtin_amdgcn_s_setprio(1); _Pragma("unroll") for (int m = 0; m < 4; ++m) _Pragma("unroll") for (int n = 0; n < 2; ++n) _Pragma("unroll") for (int k = 0; k < 2; ++k) \
    acc[ai][bj][m][n] = __builtin_amdgcn_mfma_f32_16x16x32_bf16(Bt[n][k], At[m][k], acc[ai][bj][m][n], 0, 0, 0); __builtin_amdgcn_s_setprio(0); } while (0)
#define PG8_WAIT_V(n) asm volatile("s_waitcnt vmcnt(" #n ")" ::: "memory")
#define PG8_WAIT_L(n) asm volatile("s_waitcnt lgkmcnt(" #n ")" ::: "memory")
#define PG8_BAR __builtin_amdgcn_s_barrier()
#define PG8_SCHED __builtin_amdgcn_sched_barrier(0)
  Unit cur, nxt; int ui = 0;
  if (!S.next(0, cur)) return;
  f32x4 acc[2][2][4][2];
#pragma unroll
  for (int a = 0; a < 2; ++a)
#pragma unroll
    for (int b = 0; b < 2; ++b)
#pragma unroll
      for (int m = 0; m < 4; ++m)
#pragma unroll
        for (int n = 0; n < 2; ++n) acc[a][b][m][n] = (f32x4){0.f, 0.f, 0.f, 0.f};
  bf16x8 At[4][2], B0[2][2], B1[2][2];
  const char* cA = (const char*)g.A + (size_t)cur.pm * tstep; const char* cB = (const char*)g.Bt + (size_t)cur.pn * tstep;
  PG8_STAGE(PG8_SB(0, 0), cB, voffB); PG8_STAGE(PG8_SA(0, 0), cA, voffA); PG8_STAGE(PG8_SB(0, 1), cB + hstep, voffB); PG8_STAGE(PG8_SA(0, 1), cA + hstep, voffA);
  if (wr == 1) PG8_BAR;
  PG8_WAIT_V(4); PG8_BAR;
  PG8_STAGE(PG8_SB(1, 0), cB + kstep, voffB); PG8_STAGE(PG8_SA(1, 0), cA + kstep, voffA); PG8_STAGE(PG8_SB(1, 1), cB + hstep + kstep, voffB);
  PG8_WAIT_V(6); PG8_BAR;
  for (;;) {
    const bool has_next = S.next(ui + 1, nxt);
    const char* nA = has_next ? (const char*)g.A + (size_t)nxt.pm * tstep : cA; const char* nB = has_next ? (const char*)g.Bt + (size_t)nxt.pn * tstep : cB;
    for (int t = 0; t < nt; t += 2) {
      const bool last = (t == nt - 2);
      const char* a1 = cA + (size_t)(t + 1) * kstep;
      const char* a2 = last ? nA : cA + (size_t)(t + 2) * kstep; const char* b2 = last ? nB : cB + (size_t)(t + 2) * kstep;
      const char* a3 = a2 + kstep; const char* b3 = b2 + kstep;
      PG8_LDB(B0, 0, 0); PG8_SCHED; PG8_LDA(At, 0, 0); PG8_STAGE(PG8_SA(1, 1), a1 + hstep, voffA);
      PG8_WAIT_L(8); PG8_BAR; PG8_WAIT_L(0); PG8_MMA(0, 0, At, B0); PG8_BAR; PG8_SCHED;
      PG8_LDB(B1, 0, 1); PG8_STAGE(PG8_SB(0, 0), b2, voffB);
      PG8_BAR; PG8_WAIT_L(0); PG8_MMA(0, 1, At, B1); PG8_BAR;
      PG8_LDA(At, 0, 1); PG8_STAGE(PG8_SA(0, 0), a2, voffA);
      PG8_BAR; PG8_WAIT_L(0); PG8_MMA(1, 0, At, B0); PG8_BAR; PG8_SCHED;
      PG8_STAGE(PG8_SB(0, 1), b2 + hstep, voffB);
      PG8_WAIT_V(6); PG8_BAR; PG8_MMA(1, 1, At, B1); PG8_BAR;
      PG8_LDB(B0, 1, 0); PG8_SCHED; PG8_LDA(At, 1, 0); PG8_STAGE(PG8_SA(0, 1), a2 + hstep, voffA);
      PG8_WAIT_L(8); PG8_BAR; PG8_WAIT_L(0); PG8_MMA(0, 0, At, B0); PG8_BAR; PG8_SCHED;
      PG8_LDB(B1, 1, 1); PG8_STAGE(PG8_SB(1, 0), b3, voffB);
      PG8_BAR; PG8_WAIT_L(0); PG8_MMA(0, 1, At, B1); PG8_BAR;
      PG8_LDA(At, 1, 1); PG8_STAGE(PG8_SA(1, 0), a3, voffA);
      PG8_BAR; PG8_WAIT_L(0); PG8_MMA(1, 0, At, B0); PG8_BAR; PG8_SCHED;
      PG8_STAGE(PG8_SB(1, 1), b3 + hstep, voffB);
      PG8_WAIT_V(6); PG8_BAR; PG8_MMA(1, 1, At, B1); PG8_BAR;
    }
    E(acc, cur, wr, wc, fr, fq);
    if (!has_next) break;
#pragma unroll
    for (int a = 0; a < 2; ++a)
#pragma unroll
      for (int b = 0; b < 2; ++b)
#pragma unroll
        for (int m = 0; m < 4; ++m)
#pragma unroll
          for (int n = 0; n < 2; ++n) acc[a][b][m][n] = (f32x4){0.f, 0.f, 0.f, 0.f};
    cur = nxt; cA = nA; cB = nB; ++ui;
  }
  PG8_WAIT_V(0);
  if (wr == 0) PG8_BAR;
  PG8_BAR;
#undef PG8_SA
#undef PG8_SB
#undef PG8_STAGE
#undef PG8_LDA
#undef PG8_LDB
#undef PG8_MMA
#undef PG8_WAIT_V
#undef PG8_WAIT_L
#undef PG8_BAR
#undef PG8_SCHED
}
}

template <int ACT>
DI void gemm_run(const bf16_t* A, const bf16_t* Bt, int N, int K, bf16_t* C, int ldc, char* smem) {
  pg8::Gemm g; g.A = A; g.Bt = Bt; g.M = T_TOK; g.N = N; g.K = K;
  pg8::StaticOrder S; S.init(T_TOK, N, (int)gridDim.x, (int)blockIdx.x);
  pg8::EpiB<ACT> E; E.O = C; E.ldc = ldc;
  pg8::gemm_phase(( PG8_LAS unsigned char*)smem, g, S, E);
  __syncthreads();
}

DI void gla_gates(const Params& P, const bf16_t* proj, int b, int h, int n, float* sb, float* sseg, float* tmp) {
  const int tid = TIDX & 255;
  float* sw = tmp;
  float* sg = tmp + 1024;
  {
    for (int e = tid; e < 1024; e += 256) sw[e] = P.gla_w_gate[(e >> 6) * 256 + h * 64 + (e & 63)];
    const int i = tid >> 2, part = tid & 3;
    const size_t t = (size_t)b * SEQ + n * 64 + i;
    const u32x2 gu = *(const u32x2*)(proj + t * PW + C_GLR + part * 4);
    sg[i * 17 + part * 4 + 0] = bflo(gu[0]); sg[i * 17 + part * 4 + 1] = bfhi(gu[0]);
    sg[i * 17 + part * 4 + 2] = bflo(gu[1]); sg[i * 17 + part * 4 + 3] = bfhi(gu[1]);
  }
  __syncthreads();
  {
    const int i = tid & 63, dq = tid >> 6;
    float z[16];
#pragma unroll
    for (int dd = 0; dd < 16; ++dd) z[dd] = P.gla_b_gate[h * 64 + dq * 16 + dd];
#pragma unroll 1
    for (int r = 0; r < 16; ++r) {
      const float gv = sg[i * 17 + r];
#pragma unroll
      for (int dd = 0; dd < 16; ++dd) z[dd] += gv * sw[r * 64 + dq * 16 + dd];
    }
#pragma unroll
    for (int dd = 0; dd < 16; ++dd) {
      const float zz = z[dd];
      const float ls = fminf(zz, 0.f) - __logf(1.f + __expf(-fabsf(zz)));
      sb[i * 65 + dq * 16 + dd] = ls * (1.f / 16.f);
    }
  }
  __syncthreads();
  const int d = tid & 63, seg = tid >> 6;
  float pre[16]; float run = 0.f;
#pragma unroll
  for (int ii = 0; ii < 16; ++ii) { run += sb[(seg * 16 + ii) * 65 + d]; pre[ii] = run; }
  sseg[seg * 64 + d] = run;
  __syncthreads();
  float off = 0.f;
#pragma unroll
  for (int s = 0; s < 4; ++s) off += (s < seg) ? sseg[s * 64 + d] : 0.f;
#pragma unroll
  for (int ii = 0; ii < 16; ++ii) sb[(seg * 16 + ii) * 65 + d] = pre[ii] + off;
  __syncthreads();
}

DI void gla_stage_vT(const bf16_t* proj, int b, int h, int n, bf16_t* vT) {
  const int tid = TIDX & 255, j = tid & 63, q4 = tid >> 6;
  const size_t t = (size_t)b * SEQ + n * 64 + j;
  const bf16_t* src = proj + t * PW + C_GV + h * 128 + q4 * 32;
#pragma unroll
  for (int c = 0; c < 4; ++c) {
    const u32x4 u = *(const u32x4*)(src + c * 8);
#pragma unroll
    for (int e = 0; e < 4; ++e) {
      vT[(q4 * 32 + c * 8 + 2 * e) * 72 + j] = (bf16_t)(u[e] & 0xffffu);
      vT[(q4 * 32 + c * 8 + 2 * e + 1) * 72 + j] = (bf16_t)(u[e] >> 16);
    }
  }
}

DI void gla_p1_item(const Params& P, int item, char* smem) {
  const bf16_t* proj = (const bf16_t*)(P.ws + R1);
  float* states = (float*)(P.ws + R2);
  float* decay = (float*)(P.ws + R_DECAY);
  float* sb = (float*)smem; float* sseg = sb + 64 * 65;
  bf16_t* kendT = (bf16_t*)(sseg + 256); bf16_t* vT = kendT + 64 * 72;
  const int n = item & 127, h = (item >> 7) & 3, b = item >> 9;
  const int tid = TIDX & 255, lane = tid & 63, wave = tid >> 6, l32 = lane & 31, kb = lane >> 5;
  gla_gates(P, proj, b, h, n, sb, sseg, (float*)vT);
  {
    const int j = tid & 63, dq = tid >> 6;
    const size_t t = (size_t)b * SEQ + n * 64 + j;
    const u32x4 k0 = *(const u32x4*)(proj + t * PW + C_GK + h * 64 + dq * 16), k1 = *(const u32x4*)(proj + t * PW + C_GK + h * 64 + dq * 16 + 8);
    float kv[16];
#pragma unroll
    for (int e = 0; e < 4; ++e) { kv[2 * e] = bflo(k0[e]); kv[2 * e + 1] = bfhi(k0[e]); kv[8 + 2 * e] = bflo(k1[e]); kv[8 + 2 * e + 1] = bfhi(k1[e]); }
#pragma unroll
    for (int dd = 0; dd < 16; ++dd) {
      const int d = dq * 16 + dd;
      kendT[d * 72 + j] = f2bf(kv[dd] * __expf(sb[63 * 65 + d] - sb[j * 65 + d]));
    }
    if (tid < 64) decay[((size_t)(b * 4 + h) * 128 + n) * 64 + tid] = __expf(sb[63 * 65 + tid]);
  }
  gla_stage_vT(proj, b, h, n, vT);
  __syncthreads();
#pragma unroll
  for (int dt = 0; dt < 2; ++dt) {
    f32x16 acc = zero16();
#pragma unroll
    for (int s = 0; s < 4; ++s) {
      const bf16x8 a = *(const bf16x8*)(vT + (wave * 32 + l32) * 72 + s * 16 + kb * 8);
      const bf16x8 bb = *(const bf16x8*)(kendT + (dt * 32 + l32) * 72 + s * 16 + kb * 8);
      acc = mfma(a, bb, acc);
    }
    float* dst = states + ((size_t)((b * 4 + h) * 128 + n) * 128) * 64;
#pragma unroll
    for (int r = 0; r < 16; ++r) dst[(size_t)(wave * 32 + crow(r, kb)) * 64 + dt * 32 + l32] = acc[r];
  }
  __syncthreads();
}

DI void gla_scan(const Params& P) {
  float* states = (float*)(P.ws + R2);
  const float* decay = (const float*)(P.ws + R_DECAY);
  const int total = 32 * 8192;
  for (int e = blockIdx.x * blockDim.x + TIDX; e < total; e += gridDim.x * blockDim.x) {
    const int bh = e >> 13, idx = e & 8191, d = idx & 63;
    float* p = states + (size_t)bh * 128 * 8192 + idx;
    const float* dc = decay + (size_t)bh * 128 * 64 + d;
    float S = 0.f;
#pragma unroll 8
    for (int n = 0; n < 128; ++n) {
      const float ds = p[(size_t)n * 8192];
      const float dec = dc[n * 64];
      p[(size_t)n * 8192] = S;
      S = dec * S + ds;
    }
  }
}

DI void gla_p3_item(const Params& P, int item, char* smem) {
  const bf16_t* proj = (const bf16_t*)(P.ws + R1);
  const float* states = (const float*)(P.ws + R2);
  bf16_t* mix = (bf16_t*)(P.ws + R3);
  float* sb = (float*)smem; float* sseg = sb + 64 * 65; float* sred = sseg + 256;
  bf16_t* sq = (bf16_t*)(sred + 256); bf16_t* sk = sq + 64 * 72; bf16_t* vT = sk + 64 * 72;
  const int n = item & 127, h = (item >> 7) & 3, b = item >> 9;
  const int tid = TIDX & 255, lane = tid & 63, wave = tid >> 6, l32 = lane & 31, kb = lane >> 5;
  gla_gates(P, proj, b, h, n, sb, sseg, (float*)vT);
  {
    const int i = tid & 63, dq = tid >> 6;
    const size_t t = (size_t)b * SEQ + n * 64 + i;
    const u32x4 q0 = *(const u32x4*)(proj + t * PW + C_GQ + h * 64 + dq * 16), q1 = *(const u32x4*)(proj + t * PW + C_GQ + h * 64 + dq * 16 + 8);
    const u32x4 k0 = *(const u32x4*)(proj + t * PW + C_GK + h * 64 + dq * 16), k1 = *(const u32x4*)(proj + t * PW + C_GK + h * 64 + dq * 16 + 8);
    float qv[16], kv[16];
#pragma unroll
    for (int e = 0; e < 4; ++e) {
      qv[2 * e] = bflo(q0[e]); qv[2 * e + 1] = bfhi(q0[e]); qv[8 + 2 * e] = bflo(q1[e]); qv[8 + 2 * e + 1] = bfhi(q1[e]);
      kv[2 * e] = bflo(k0[e]); kv[2 * e + 1] = bfhi(k0[e]); kv[8 + 2 * e] = bflo(k1[e]); kv[8 + 2 * e + 1] = bfhi(k1[e]);
    }
#pragma unroll
    for (int dd = 0; dd < 16; ++dd) {
      const int d = dq * 16 + dd;
      const float bb = sb[i * 65 + d];
      sq[i * 72 + d] = f2bf(qv[dd] * 0.125f * __expf(bb));
      sk[i * 72 + d] = f2bf(kv[dd] * __expf(-bb));
    }
  }
  gla_stage_vT(proj, b, h, n, vT);
  __syncthreads();
  f32x16 x00 = zero16(), x01 = zero16(), x11 = zero16();
#pragma unroll
  for (int s = 0; s < 4; ++s) {
    const bf16x8 kj0 = *(const bf16x8*)(sk + (l32)*72 + s * 16 + kb * 8);
    const bf16x8 kj1 = *(const bf16x8*)(sk + (32 + l32) * 72 + s * 16 + kb * 8);
    const bf16x8 qi0 = *(const bf16x8*)(sq + (l32)*72 + s * 16 + kb * 8);
    const bf16x8 qi1 = *(const bf16x8*)(sq + (32 + l32) * 72 + s * 16 + kb * 8);
    x00 = mfma(kj0, qi0, x00); x01 = mfma(kj0, qi1, x01); x11 = mfma(kj1, qi1, x11);
  }
#pragma unroll
  for (int r = 0; r < 16; ++r) { const bool keep = crow(r, kb) <= l32; x00[r] = keep ? x00[r] : 0.f; x11[r] = keep ? x11[r] : 0.f; }
  f32x16 o0 = zero16(), o1 = zero16();
  const int dvr = wave * 32 + l32;
#pragma unroll
  for (int s = 0; s < 2; ++s) {
    const bf16x8 p00 = pack8(x00[8 * s], x00[8 * s + 1], x00[8 * s + 2], x00[8 * s + 3], x00[8 * s + 4], x00[8 * s + 5], x00[8 * s + 6], x00[8 * s + 7]);
    const bf16x8 p01 = pack8(x01[8 * s], x01[8 * s + 1], x01[8 * s + 2], x01[8 * s + 3], x01[8 * s + 4], x01[8 * s + 5], x01[8 * s + 6], x01[8 * s + 7]);
    const bf16x8 p11 = pack8(x11[8 * s], x11[8 * s + 1], x11[8 * s + 2], x11[8 * s + 3], x11[8 * s + 4], x11[8 * s + 5], x11[8 * s + 6], x11[8 * s + 7]);
    const bf16x8 v0 = ld2x4(vT + dvr * 72 + 16 * s + 4 * kb);
    const bf16x8 v1 = ld2x4(vT + dvr * 72 + 32 + 16 * s + 4 * kb);
    o0 = mfma(v0, p00, o0); o1 = mfma(v0, p01, o1); o1 = mfma(v1, p11, o1);
  }
  {
    const float* sp = states + ((size_t)((b * 4 + h) * 128 + n) * 128 + dvr) * 64;
#pragma unroll
    for (int s = 0; s < 4; ++s) {
      const float4 f0 = *(const float4*)(sp + s * 16 + kb * 8), f1 = *(const float4*)(sp + s * 16 + kb * 8 + 4);
      const bf16x8 a = pack8(f0.x, f0.y, f0.z, f0.w, f1.x, f1.y, f1.z, f1.w);
      const bf16x8 qi0 = *(const bf16x8*)(sq + (l32)*72 + s * 16 + kb * 8);
      const bf16x8 qi1 = *(const bf16x8*)(sq + (32 + l32) * 72 + s * 16 + kb * 8);
      o0 = mfma(a, qi0, o0); o1 = mfma(a, qi1, o1);
    }
  }
  float s0 = 0.f, s1 = 0.f;
#pragma unroll
  for (int r = 0; r < 16; ++r) { s0 += o0[r] * o0[r]; s1 += o1[r] * o1[r]; }
  s0 += __shfl_xor(s0, 32); s1 += __shfl_xor(s1, 32);
  if (kb == 0) { sred[wave * 64 + l32] = s0; sred[wave * 64 + 32 + l32] = s1; }
  __syncthreads();
  const float t0s = sred[l32] + sred[64 + l32] + sred[128 + l32] + sred[192 + l32];
  const float t1s = sred[32 + l32] + sred[64 + 32 + l32] + sred[128 + 32 + l32] + sred[192 + 32 + l32];
  const float r0 = rsqrtf(t0s * (1.f / 128.f) + EPS), r1 = rsqrtf(t1s * (1.f / 128.f) + EPS);
#pragma unroll
  for (int it = 0; it < 2; ++it) {
    const size_t t = (size_t)b * SEQ + n * 64 + it * 32 + l32;
    const float rr = it ? r1 : r0;
#pragma unroll
    for (int gq = 0; gq < 4; ++gq) {
      const int dv = wave * 32 + 8 * gq + 4 * kb;
      const u32x2 ru = *(const u32x2*)(proj + t * PW + C_GR + h * 128 + dv);
      const float4 gn = *(const float4*)(P.gla_norm + h * 128 + dv);
      float rv[4] = {bflo(ru[0]), bfhi(ru[0]), bflo(ru[1]), bfhi(ru[1])};
      float gv[4] = {gn.x, gn.y, gn.z, gn.w};
      float ov[4];
#pragma unroll
      for (int e = 0; e < 4; ++e) {
        const float a = it ? o1[gq * 4 + e] : o0[gq * 4 + e];
        ov[e] = a * rr * gv[e] * (rv[e] / (1.f + __expf(-rv[e])));
      }
      u32x2 o; o[0] = pk2(ov[0], ov[1]); o[1] = pk2(ov[2], ov[3]);
      *(u32x2*)(mix + t * DM + h * 128 + dv) = o;
    }
  }
  __syncthreads();
}

DI void nsa_compress_task(const Params& P, int task) {
  const bf16_t* proj = (const bf16_t*)(P.ws + R1);
  const int lane = TIDX & 63, l32 = lane & 31, kb = lane >> 5;
  const int ct = task & 15, g = (task >> 4) & 1, b = (task >> 5) & 7, br = task >> 8;
  const bf16_t* w1T = (const bf16_t*)(P.ws + W_CW1) + (size_t)br * 128 * 2048;
  const bf16_t* w2T = (const bf16_t*)(P.ws + W_CW2) + (size_t)br * 64 * 128;
  const float* bias1 = (const float*)(P.ws + W_BIAS1) + br * 128;
  const int c = ct * 32 + l32;
  const int cc = c < 511 ? c : 510;
  const bf16_t* src = proj + ((size_t)b * SEQ + cc * 16) * PW + (br ? C_VC : C_KC) + g * 64 + kb * 8;
  f32x16 acc[4];
#pragma unroll
  for (int i = 0; i < 4; ++i) acc[i] = zero16();
#pragma unroll 1
  for (int ks = 0; ks < 128; ++ks) {
    const int l = ks >> 2, dh0 = (ks & 3) * 16;
    const bf16x8 bf = *(const bf16x8*)(src + (size_t)l * PW + dh0);
#pragma unroll
    for (int ht = 0; ht < 4; ++ht) {
      const bf16x8 af = *(const bf16x8*)(w1T + (size_t)(ht * 32 + l32) * 2048 + ks * 16 + kb * 8);
      acc[ht] = mfma(af, bf, acc[ht]);
    }
  }
#pragma unroll
  for (int ht = 0; ht < 4; ++ht)
#pragma unroll
    for (int r = 0; r < 16; ++r) acc[ht][r] = gelu_tanh(acc[ht][r] + bias1[ht * 32 + crow(r, kb)]);
  f32x16 o[2]; o[0] = zero16(); o[1] = zero16();
#pragma unroll
  for (int ht = 0; ht < 4; ++ht)
#pragma unroll
    for (int s = 0; s < 2; ++s) {
      const bf16x8 hf = pack8(acc[ht][8 * s], acc[ht][8 * s + 1], acc[ht][8 * s + 2], acc[ht][8 * s + 3], acc[ht][8 * s + 4], acc[ht][8 * s + 5], acc[ht][8 * s + 6], acc[ht][8 * s + 7]);
#pragma unroll
      for (int dt = 0; dt < 2; ++dt) {
        const bf16x8 wf = ld2x4(w2T + (size_t)(dt * 32 + l32) * 128 + ht * 32 + 16 * s + 4 * kb);
        o[dt] = mfma(wf, hf, o[dt]);
      }
    }
  if (c < 511) {
    if (br == 0) {
      bf16_t* dst = (bf16_t*)(P.ws + R_KCMP) + ((size_t)(b * 2 + g) * 512 + c) * 64;
#pragma unroll
      for (int dt = 0; dt < 2; ++dt)
#pragma unroll
        for (int gq = 0; gq < 4; ++gq) {
          u32x2 u; u[0] = pk2(o[dt][gq * 4], o[dt][gq * 4 + 1]); u[1] = pk2(o[dt][gq * 4 + 2], o[dt][gq * 4 + 3]);
          *(u32x2*)(dst + dt * 32 + 8 * gq + 4 * kb) = u;
        }
    } else {
      bf16_t* dst = (bf16_t*)(P.ws + R_VCMPT) + (size_t)(b * 2 + g) * 64 * 512 + c;
#pragma unroll
      for (int dt = 0; dt < 2; ++dt)
#pragma unroll
        for (int r = 0; r < 16; ++r) dst[(size_t)(dt * 32 + crow(r, kb)) * 512] = f2bf(o[dt][r]);
    }
  }
}

DI void nsa_transpose_v(const Params& P) {
  const bf16_t* proj = (const bf16_t*)(P.ws + R1);
  const int total = 2 * 8 * 2 * 1024 * 64;
  for (int u = blockIdx.x * blockDim.x + TIDX; u < total; u += gridDim.x * blockDim.x) {
    const int dh = u & 63; int rest = u >> 6; const int t8 = rest & 1023; rest >>= 10;
    const int g = rest & 1, b = (rest >> 1) & 7, which = rest >> 4;
    const bf16_t* src = proj + ((size_t)b * SEQ + t8 * 8) * PW + (which ? C_VW : C_VS) + g * 64 + dh;
    bf16_t v[8];
#pragma unroll
    for (int j = 0; j < 8; ++j) v[j] = src[(size_t)j * PW];
    u32x4 o;
#pragma unroll
    for (int j = 0; j < 4; ++j) o[j] = (unsigned)v[2 * j] | ((unsigned)v[2 * j + 1] << 16);
    bf16_t* dst = (bf16_t*)(P.ws + (which ? R_VWT : R_VST)) + ((size_t)(b * 2 + g) * 64 + dh) * SEQ + t8 * 8;
    *(u32x4*)dst = o;
  }
}

DI f32x16 qk_tile(const bf16_t* krow, const bf16x8 (&qf)[4]) {
  f32x16 s = zero16();
#pragma unroll
  for (int i = 0; i < 4; ++i) { const bf16x8 kf = *(const bf16x8*)(krow + i * 16); s = mfma(kf, qf[i], s); }
  return s;
}

DI float half_max(float x) {
  const auto r = __builtin_amdgcn_permlane32_swap(__float_as_uint(x), __float_as_uint(x), false, false);
  return fmaxf(__uint_as_float(r[0]), __uint_as_float(r[1]));
}
DI float half_sum(float x) {
  const auto r = __builtin_amdgcn_permlane32_swap(__float_as_uint(x), __float_as_uint(x), false, false);
  return __uint_as_float(r[0]) + __uint_as_float(r[1]);
}
struct KVFrag { bf16x8 k[4]; };
DI void kv_load(KVFrag& f, const bf16_t* krow) {
#pragma unroll
  for (int i = 0; i < 4; ++i) f.k[i] = *(const bf16x8*)(krow + i * 16);
}
template <bool EDGE>
DI void attn_step(const KVFrag& f, const bf16_t* vt0, const bf16x8 (&qf)[4], int k0, int tq, int lo, bool bit, int kb,
                  f32x16& o0, f32x16& o1, float& m, float& l) {
  constexpr float CS = 0.125f * 1.4426950408889634f;
  bf16x8 vf[4];
  vf[0] = ld2x4(vt0 + k0); vf[1] = ld2x4(vt0 + k0 + 16);
  vf[2] = ld2x4(vt0 + (size_t)32 * SEQ + k0); vf[3] = ld2x4(vt0 + (size_t)32 * SEQ + k0 + 16);
  f32x16 s = zero16();
#pragma unroll
  for (int i = 0; i < 4; ++i) s = mfma(f.k[i], qf[i], s);
  float tmax = -1e30f;
  if (EDGE) {
#pragma unroll
    for (int r = 0; r < 16; ++r) {
      const int key = k0 + crow(r, kb);
      const bool vd = (key <= tq) && (key > lo);
      s[r] = vd ? s[r] * CS : -1e30f;
      tmax = fmaxf(tmax, s[r]);
    }
  } else {
#pragma unroll
    for (int r = 0; r < 16; ++r) tmax = fmaxf(tmax, s[r]);
    tmax *= CS;
  }
  tmax = bit ? tmax : -1e30f;
  tmax = half_max(tmax);
  if (__ballot(tmax > m) != 0ull) {
    const float mn = fmaxf(m, tmax);
    const float alpha = __builtin_amdgcn_exp2f(m - mn);
    l *= alpha; m = mn;
#pragma unroll
    for (int r = 0; r < 16; ++r) { o0[r] *= alpha; o1[r] *= alpha; }
  }
  const bool live = bit && (m > -5e29f);
  float ps = 0.f;
#pragma unroll
  for (int r = 0; r < 16; ++r) {
    const float e = EDGE ? __builtin_amdgcn_exp2f(s[r] - m) : __builtin_amdgcn_exp2f(__builtin_fmaf(s[r], CS, -m));
    s[r] = live ? e : 0.f;
    ps += s[r];
  }
  l += ps;
#pragma unroll
  for (int sI = 0; sI < 2; ++sI) {
    const bf16x8 pf = pack8(s[8 * sI], s[8 * sI + 1], s[8 * sI + 2], s[8 * sI + 3], s[8 * sI + 4], s[8 * sI + 5], s[8 * sI + 6], s[8 * sI + 7]);
    o0 = mfma(vf[sI], pf, o0); o1 = mfma(vf[2 + sI], pf, o1);
  }
}

template <bool EDGE>
DI void attn_step_lds(const bf16_t* sKt, const bf16_t* sVt, const bf16x8 (&qf)[4], int k0, int tq, int lo, bool bit, int l32, int kb,
                      f32x16& o0, f32x16& o1, float& m, float& l) {
  constexpr float CS = 0.125f * 1.4426950408889634f;
  bf16x8 vf[4];
  f32x16 s = zero16();
#pragma unroll
  for (int i = 0; i < 4; ++i) { const bf16x8 kf = *(const bf16x8*)(sKt + l32 * 72 + i * 16 + kb * 8); s = mfma(kf, qf[i], s); }
  vf[0] = ld2x4(sVt + l32 * 72 + 4 * kb); vf[1] = ld2x4(sVt + l32 * 72 + 16 + 4 * kb);
  vf[2] = ld2x4(sVt + (32 + l32) * 72 + 4 * kb); vf[3] = ld2x4(sVt + (32 + l32) * 72 + 16 + 4 * kb);
  float tmax = -1e30f;
  if (EDGE) {
#pragma unroll
    for (int r = 0; r < 16; ++r) {
      const int key = k0 + crow(r, kb);
      const bool vd = (key <= tq) && (key > lo);
      s[r] = vd ? s[r] * CS : -1e30f;
      tmax = fmaxf(tmax, s[r]);
    }
  } else {
#pragma unroll
    for (int r = 0; r < 16; ++r) tmax = fmaxf(tmax, s[r]);
    tmax *= CS;
  }
  tmax = bit ? tmax : -1e30f;
  tmax = half_max(tmax);
  if (__ballot(tmax > m) != 0ull) {
    const float mn = fmaxf(m, tmax);
    const float alpha = __builtin_amdgcn_exp2f(m - mn);
    l *= alpha; m = mn;
#pragma unroll
    for (int r = 0; r < 16; ++r) { o0[r] *= alpha; o1[r] *= alpha; }
  }
  const bool live = bit && (m > -5e29f);
  float ps = 0.f;
#pragma unroll
  for (int r = 0; r < 16; ++r) {
    const float e = EDGE ? __builtin_amdgcn_exp2f(s[r] - m) : __builtin_amdgcn_exp2f(__builtin_fmaf(s[r], CS, -m));
    s[r] = live ? e : 0.f;
    ps += s[r];
  }
  l += ps;
#pragma unroll
  for (int sI = 0; sI < 2; ++sI) {
    const bf16x8 pf = pack8(s[8 * sI], s[8 * sI + 1], s[8 * sI + 2], s[8 * sI + 3], s[8 * sI + 4], s[8 * sI + 5], s[8 * sI + 6], s[8 * sI + 7]);
    o0 = mfma(vf[sI], pf, o0); o1 = mfma(vf[2 + sI], pf, o1);
  }
}

template <bool WIN>
DI void nsa_branch(const bf16_t* kbase, const bf16_t* vtb, char* smem, int st0, int st1, int qt, int tq, const bf16x8 (&qf)[4],
                   unsigned mk0, unsigned mk1, unsigned mk2, unsigned mk3, f32x16& o0, f32x16& o1, float& m, float& l) {
  const int tid = TIDX, lane = tid & 63, l32 = lane & 31, kb = lane >> 5;
  const int srow = tid >> 3, schunk = (tid & 7) * 8;
  const bf16_t* kg = kbase + (size_t)srow * PW + schunk;
  const bf16_t* vg = vtb + (size_t)srow * SEQ + schunk;
  const int soff = (srow * 72 + schunk) * 2;
  u32x4 rk = *(const u32x4*)(kg + (size_t)st0 * 64 * PW), rv = *(const u32x4*)(vg + st0 * 64);
  *(u32x4*)(smem + soff) = rk; *(u32x4*)(smem + 9216 + soff) = rv;
  __syncthreads();
  for (int st = st0; st <= st1; ++st) {
    const int cur = (st - st0) & 1;
    if (st < st1) { rk = *(const u32x4*)(kg + (size_t)(st + 1) * 64 * PW); rv = *(const u32x4*)(vg + (st + 1) * 64); }
    const bf16_t* bK = (const bf16_t*)(smem + cur * 18432);
    const bf16_t* bV = (const bf16_t*)(smem + cur * 18432 + 9216);
    bool bit = true;
    if (!WIN) { const unsigned mw = st < 32 ? mk0 : (st < 64 ? mk1 : (st < 96 ? mk2 : mk3)); bit = (mw >> (st & 31)) & 1u; }
    const bool any = WIN ? true : (__ballot(bit) != 0ull);
#pragma unroll
    for (int tt = 0; tt < 2; ++tt) {
      const int kt = 2 * st + tt;
      const bool in_range = WIN ? (kt <= qt && kt >= qt - 16) : (kt <= qt);
      if (in_range && any) {
        const bool edge = WIN ? (kt == qt || kt == qt - 16) : (kt == qt);
        if (edge) attn_step_lds<true>(bK + tt * 32 * 72, bV + tt * 32, qf, kt * 32, tq, WIN ? tq - 512 : -1, bit, l32, kb, o0, o1, m, l);
        else attn_step_lds<false>(bK + tt * 32 * 72, bV + tt * 32, qf, kt * 32, tq, WIN ? tq - 512 : -1, bit, l32, kb, o0, o1, m, l);
      }
    }
    if (st < st1) { *(u32x4*)(smem + (cur ^ 1) * 18432 + soff) = rk; *(u32x4*)(smem + (cur ^ 1) * 18432 + 9216 + soff) = rv; }
    __syncthreads();
  }
}

DI void nsa_block(const Params& P, int b, int g, int qb, char* smem) {
  const int wv = __builtin_amdgcn_readfirstlane(TIDX >> 6);
  const int qt = qb * 8 + wv;
  float* imp = (float*)smem + wv * 4096;
  const bf16_t* proj = (const bf16_t*)(P.ws + R1);
  bf16_t* mix = (bf16_t*)(P.ws + R3);
  const int lane = TIDX & 63, l32 = lane & 31, kb = lane >> 5;
  const int t0 = qt * 32, tq = t0 + l32;
  const size_t tokq = (size_t)b * SEQ + tq;
  const bf16_t* qrow = proj + tokq * PW;
  const bf16_t* kcmp = (const bf16_t*)(P.ws + R_KCMP) + (size_t)(b * 2 + g) * 512 * 64;
  const bf16_t* vcmpT = (const bf16_t*)(P.ws + R_VCMPT) + (size_t)(b * 2 + g) * 64 * 512;
  for (int i = lane; i < 4096; i += 64) imp[i] = 0.f;
  const int nct = (qt >> 4) + 1;
  for (int hh = 0; hh < 4; ++hh) {
    const int head = g * 4 + hh;
    bf16x8 qf[4];
#pragma unroll
    for (int i = 0; i < 4; ++i) qf[i] = *(const bf16x8*)(qrow + C_NQ + head * 64 + i * 16 + kb * 8);
    float m = -1e30f, l = 0.f;
    for (int ct = 0; ct < nct; ++ct) {
      f32x16 s = qk_tile(kcmp + (size_t)(ct * 32 + l32) * 64 + kb * 8, qf);
      float tmax = -1e30f;
#pragma unroll
      for (int r = 0; r < 16; ++r) {
        const int c = ct * 32 + crow(r, kb);
        const bool vd = (c * 16 + 31 <= tq);
        s[r] = vd ? s[r] * 0.125f : -1e30f;
        tmax = fmaxf(tmax, s[r]);
      }
      const float mn = fmaxf(m, tmax);
      float ps = 0.f;
#pragma unroll
      for (int r = 0; r < 16; ++r) ps += (s[r] > -5e29f) ? __expf(s[r] - mn) : 0.f;
      l = l * __expf(m - mn) + ps; m = mn;
    }
    const float mo = __shfl_xor(m, 32), lo_ = __shfl_xor(l, 32);
    const float M = fmaxf(m, mo);
    const float L = l * __expf(m - M) + lo_ * __expf(mo - M);
    const float invL = 1.f / fmaxf(L, 1e-30f);
    f32x16 o0 = zero16(), o1 = zero16();
    float carry = 0.f;
    for (int ct = 0; ct < nct; ++ct) {
      f32x16 s = qk_tile(kcmp + (size_t)(ct * 32 + l32) * 64 + kb * 8, qf);
#pragma unroll
      for (int r = 0; r < 16; ++r) {
        const int c = ct * 32 + crow(r, kb);
        const bool vd = (c * 16 + 31 <= tq);
        s[r] = vd ? __expf(s[r] * 0.125f - M) * invL : 0.f;
      }
      float y[4];
#pragma unroll
      for (int gi = 0; gi < 4; ++gi) y[gi] = __shfl_xor(s[4 * gi + 3], 32);
#pragma unroll
      for (int gi = 0; gi < 4; ++gi) {
        const float s4 = (s[4 * gi] + s[4 * gi + 1]) + (s[4 * gi + 2] + s[4 * gi + 3]);
        const float extra = kb ? y[gi] : (gi == 0 ? carry : y[gi > 0 ? gi - 1 : 0]);
        const int j = ct * 8 + 2 * gi + kb;
        imp[j * 32 + l32] += s4 + extra;
      }
      carry = y[3];
#pragma unroll
      for (int sI = 0; sI < 2; ++sI) {
        const bf16x8 pf = pack8(s[8 * sI], s[8 * sI + 1], s[8 * sI + 2], s[8 * sI + 3], s[8 * sI + 4], s[8 * sI + 5], s[8 * sI + 6], s[8 * sI + 7]);
        const bf16x8 va = ld2x4(vcmpT + (size_t)(l32)*512 + ct * 32 + 16 * sI + 4 * kb);
        const bf16x8 vb = ld2x4(vcmpT + (size_t)(32 + l32) * 512 + ct * 32 + 16 * sI + 4 * kb);
        o0 = mfma(va, pf, o0); o1 = mfma(vb, pf, o1);
      }
    }
    const float g0 = sigmoidf_(bf2f(qrow[C_NG + head * 3 + 0]) + P.nsa_gate_b[head * 3 + 0]);
#pragma unroll
    for (int gq = 0; gq < 4; ++gq) {
      u32x2 u0, u1;
      u0[0] = pk2(g0 * o0[gq * 4], g0 * o0[gq * 4 + 1]); u0[1] = pk2(g0 * o0[gq * 4 + 2], g0 * o0[gq * 4 + 3]);
      u1[0] = pk2(g0 * o1[gq * 4], g0 * o1[gq * 4 + 1]); u1[1] = pk2(g0 * o1[gq * 4 + 2], g0 * o1[gq * 4 + 3]);
      *(u32x2*)(mix + tokq * DM + 512 + head * 64 + 8 * gq + 4 * kb) = u0;
      *(u32x2*)(mix + tokq * DM + 512 + head * 64 + 32 + 8 * gq + 4 * kb) = u1;
    }
  }
  asm volatile("s_waitcnt lgkmcnt(0)" ::: "memory");
  __builtin_amdgcn_wave_barrier();
  unsigned mk0 = 0, mk1 = 0, mk2 = 0, mk3 = 0;
  for (int q = 0; q < 32; ++q) {
    const int tqq = t0 + q, cur = tqq >> 6;
    const float v0 = imp[lane * 32 + q], v1 = imp[(lane + 64) * 32 + q];
    const int j0 = lane, j1 = lane + 64;
    const float s0 = (j0 == 0 || j0 == cur || j0 == cur - 1) ? 1e30f : (j0 <= cur ? v0 : -1e30f);
    const float s1 = (j1 == cur || j1 == cur - 1) ? 1e30f : (j1 <= cur ? v1 : -1e30f);
    int c0 = 0, c1 = 0;
#pragma unroll
    for (int k = 0; k < 64; ++k) {
      const float a0 = __int_as_float(__builtin_amdgcn_readlane(__float_as_int(s0), k));
      const float a1 = __int_as_float(__builtin_amdgcn_readlane(__float_as_int(s1), k));
      c0 += ((a0 > s0) || (a0 == s0 && k < lane)) ? 1 : 0;
      c0 += (a1 > s0) ? 1 : 0;
      c1 += (a0 >= s1) ? 1 : 0;
      c1 += ((a1 > s1) || (a1 == s1 && k < lane)) ? 1 : 0;
    }
    const bool sel0 = (s0 > -5e29f) && (c0 < 16);
    const bool sel1 = (s1 > -5e29f) && (c1 < 16);
    const unsigned long long blo = __ballot(sel0), bhi = __ballot(sel1);
    if (l32 == q) { mk0 = (unsigned)blo; mk1 = (unsigned)(blo >> 32); mk2 = (unsigned)bhi; mk3 = (unsigned)(bhi >> 32); }
  }
  asm volatile("" ::: "memory");
  __syncthreads();
  const bf16_t* ksel = proj + (size_t)b * SEQ * PW + C_KS + g * 64;
  const bf16_t* kwin = proj + (size_t)b * SEQ * PW + C_KW + g * 64;
  const bf16_t* vsT = (const bf16_t*)(P.ws + R_VST) + (size_t)(b * 2 + g) * 64 * SEQ;
  const bf16_t* vwT = (const bf16_t*)(P.ws + R_VWT) + (size_t)(b * 2 + g) * 64 * SEQ;
  const int st1 = 4 * qb + 3, wst0 = qb > 2 ? 4 * qb - 8 : 0;
  for (int hh = 0; hh < 4; ++hh) {
    const int head = g * 4 + hh;
    bf16x8 qf[4];
#pragma unroll
    for (int i = 0; i < 4; ++i) qf[i] = *(const bf16x8*)(qrow + C_NQ + head * 64 + i * 16 + kb * 8);
    f32x16 a0 = zero16(), a1 = zero16(); float m = -1e30f, l = 0.f;
    nsa_branch<false>(ksel, vsT, smem, 0, st1, qt, tq, qf, mk0, mk1, mk2, mk3, a0, a1, m, l);
    float lt = half_sum(l);
    const float g1 = sigmoidf_(bf2f(qrow[C_NG + head * 3 + 1]) + P.nsa_gate_b[head * 3 + 1]);
    const float f1 = g1 / fmaxf(lt, 1e-30f);
#pragma unroll
    for (int gq = 0; gq < 4; ++gq) {
      bf16_t* d0 = mix + tokq * DM + 512 + head * 64 + 8 * gq + 4 * kb;
      bf16_t* d1 = d0 + 32;
      const u32x2 p0 = *(const u32x2*)d0, p1 = *(const u32x2*)d1;
      u32x2 u0, u1;
      u0[0] = pk2(bflo(p0[0]) + f1 * a0[gq * 4], bfhi(p0[0]) + f1 * a0[gq * 4 + 1]);
      u0[1] = pk2(bflo(p0[1]) + f1 * a0[gq * 4 + 2], bfhi(p0[1]) + f1 * a0[gq * 4 + 3]);
      u1[0] = pk2(bflo(p1[0]) + f1 * a1[gq * 4], bfhi(p1[0]) + f1 * a1[gq * 4 + 1]);
      u1[1] = pk2(bflo(p1[1]) + f1 * a1[gq * 4 + 2], bfhi(p1[1]) + f1 * a1[gq * 4 + 3]);
      *(u32x2*)d0 = u0; *(u32x2*)d1 = u1;
    }
    a0 = zero16(); a1 = zero16(); m = -1e30f; l = 0.f;
    nsa_branch<true>(kwin, vwT, smem, wst0, st1, qt, tq, qf, 0u, 0u, 0u, 0u, a0, a1, m, l);
    lt = half_sum(l);
    const float g2 = sigmoidf_(bf2f(qrow[C_NG + head * 3 + 2]) + P.nsa_gate_b[head * 3 + 2]);
    const float f2 = g2 / fmaxf(lt, 1e-30f);
#pragma unroll
    for (int gq = 0; gq < 4; ++gq) {
      bf16_t* d0 = mix + tokq * DM + 512 + head * 64 + 8 * gq + 4 * kb;
      bf16_t* d1 = d0 + 32;
      const u32x2 p0 = *(const u32x2*)d0, p1 = *(const u32x2*)d1;
      u32x2 u0, u1;
      u0[0] = pk2(bflo(p0[0]) + f2 * a0[gq * 4], bfhi(p0[0]) + f2 * a0[gq * 4 + 1]);
      u0[1] = pk2(bflo(p0[1]) + f2 * a0[gq * 4 + 2], bfhi(p0[1]) + f2 * a0[gq * 4 + 3]);
      u1[0] = pk2(bflo(p1[0]) + f2 * a1[gq * 4], bfhi(p1[0]) + f2 * a1[gq * 4 + 1]);
      u1[1] = pk2(bflo(p1[1]) + f2 * a1[gq * 4 + 2], bfhi(p1[1]) + f2 * a1[gq * 4 + 3]);
      *(u32x2*)d0 = u0; *(u32x2*)d1 = u1;
    }
  }
}

DI void sgu_item(const Params& P, int item, char* smem) {
  const bf16_t* H = (const bf16_t*)(P.ws + R1);
  bf16_t* Y = (bf16_t*)(P.ws + R2);
  float* smu = (float*)smem; float* srs = smu + 128; float* sc1 = srs + 128; float* srw = sc1 + 128;
  bf16_t* sW = (bf16_t*)(srw + 128); bf16_t* sV = sW + 128 * 136;
  const int tid = TIDX & 255, lane = tid & 63, wave = tid >> 6, l32 = lane & 31, kb = lane >> 5;
  const size_t tok0 = (size_t)item * 128;
  for (int tt = 0; tt < 32; ++tt) {
    const int t = wave * 32 + tt;
    const bf16_t* vr = H + (tok0 + t) * 4096 + 2048;
    float s = 0.f, s2 = 0.f;
#pragma unroll
    for (int k = 0; k < 4; ++k) {
      const u32x4 u = *(const u32x4*)(vr + k * 512 + lane * 8);
#pragma unroll
      for (int e = 0; e < 4; ++e) { const float a = bflo(u[e]), c = bfhi(u[e]); s += a + c; s2 += a * a + c * c; }
    }
    s = wave_sum(s); s2 = wave_sum(s2);
    const float mu = s * (1.f / 2048.f);
    const float var = fmaxf(s2 * (1.f / 2048.f) - mu * mu, 0.f);
    if (lane == 0) { smu[t] = mu; srs[t] = rsqrtf(var + EPS); }
  }
  __syncthreads();
  for (int g = 0; g < 8; ++g) {
    {
      const int t = tid >> 1, half = tid & 1;
      const float* wrow = P.o_w_s + ((size_t)g * 128 + t) * 128 + half * 64;
      float c1 = 0.f, rw = 0.f;
#pragma unroll 1
      for (int c8 = 0; c8 < 8; ++c8) {
        const float4 f0 = *(const float4*)(wrow + c8 * 8), f1 = *(const float4*)(wrow + c8 * 8 + 4);
        float wv[8] = {f0.x, f0.y, f0.z, f0.w, f1.x, f1.y, f1.z, f1.w};
        float ov[8];
#pragma unroll
        for (int e = 0; e < 8; ++e) {
          const int s = half * 64 + c8 * 8 + e;
          const float w = (s <= t) ? wv[e] : 0.f;
          rw += w;
          const float wp = bf2f(f2bf(w * srs[s]));
          c1 += wp * smu[s];
          ov[e] = wp;
        }
        u32x4 o; o[0] = pk2(ov[0], ov[1]); o[1] = pk2(ov[2], ov[3]); o[2] = pk2(ov[4], ov[5]); o[3] = pk2(ov[6], ov[7]);
        *(u32x4*)(sW + t * 136 + half * 64 + c8 * 8) = o;
      }
      c1 += __shfl_xor(c1, 1); rw += __shfl_xor(rw, 1);
      if (half == 0) { sc1[t] = c1; srw[t] = rw; }
    }
    for (int sub = 0; sub < 4; ++sub) {
      const int ch0 = g * 256 + sub * 64;
      {
        const int s = tid >> 1, half = tid & 1;
        const bf16_t* src = H + (tok0 + s) * 4096 + 2048 + ch0 + half * 32;
#pragma unroll
        for (int c = 0; c < 4; ++c) {
          const u32x4 u = *(const u32x4*)(src + c * 8);
#pragma unroll
          for (int e = 0; e < 4; ++e) {
            sV[(half * 32 + c * 8 + 2 * e) * 136 + s] = (bf16_t)(u[e] & 0xffffu);
            sV[(half * 32 + c * 8 + 2 * e + 1) * 136 + s] = (bf16_t)(u[e] >> 16);
          }
        }
      }
      __syncthreads();
      f32x16 acc0 = zero16(), acc1 = zero16();
      const int nks = 2 * (wave + 1);
      for (int ks = 0; ks < nks; ++ks) {
        const bf16x8 a = *(const bf16x8*)(sW + (wave * 32 + l32) * 136 + ks * 16 + kb * 8);
        const bf16x8 b0 = *(const bf16x8*)(sV + (l32)*136 + ks * 16 + kb * 8);
        const bf16x8 b1 = *(const bf16x8*)(sV + (32 + l32) * 136 + ks * 16 + kb * 8);
        acc0 = mfma(a, b0, acc0); acc1 = mfma(a, b1, acc1);
      }
#pragma unroll
      for (int ct = 0; ct < 2; ++ct) {
        const int ch = ch0 + ct * 32 + l32;
        const float lg = P.o_ln_g[ch], lb = P.o_ln_b[ch];
#pragma unroll
        for (int r = 0; r < 16; ++r) {
          const int t = wave * 32 + crow(r, kb);
          const float a = ct ? acc1[r] : acc0[r];
          const float mixed = lg * (a - sc1[t]) + lb * srw[t] + P.o_b_s[g * 128 + t];
          const float u = bf2f(H[(tok0 + t) * 4096 + ch]);
          Y[(tok0 + t) * 2048 + ch] = f2bf(u * mixed);
          if ((r & 3) == 3) __builtin_amdgcn_sched_barrier(0);
        }
      }
      __syncthreads();
    }
  }
}

constexpr int NPHASE = 17;
DI void run_phase(const Params& P, int ph, char* smem) {
  char* ws = P.ws;
  bf16_t* r1 = (bf16_t*)(ws + R1); bf16_t* r2 = (bf16_t*)(ws + R2); bf16_t* r3 = (bf16_t*)(ws + R3); bf16_t* r4 = (bf16_t*)(ws + R4);
  unsigned* cnt = (unsigned*)(ws + W_CNT);
  const int lane = TIDX & 63, wave = TIDX >> 6, half = TIDX >> 8;
  char* hsmem = smem + half * 65536;
  switch (ph) {
    case 0: phase_prep(P); break;
    case 1: gemm_run<0>(r2, (const bf16_t*)(ws + W_EIN), PW, 1024, r1, PW, smem); break;
    case 2: {
      nsa_transpose_v(P);
      if (blockIdx.x < 64) nsa_compress_task(P, blockIdx.x * WPB + wave);
      volatile int* s_item = (volatile int*)(smem + LDS_BYTES - 16);
      for (;;) {
        __syncthreads();
        if (TIDX == 0) *s_item = (int)atomicAdd(cnt + 0, 1u);
        __syncthreads();
        const int pair = *s_item;
        if (pair >= 2048) break;
        gla_p1_item(P, pair * 2 + half, hsmem);
      }
    } break;
    case 3: gla_scan(P);
    case 30: {
      volatile int* s_item = (volatile int*)(smem + 131072);
      for (;;) {
        __syncthreads();
        if (TIDX == 0) *s_item = (int)atomicAdd(cnt + 1, 1u);
        __syncthreads();
        const int it = *s_item;
        if (it >= 512) break;
        nsa_block(P, (it & 15) >> 1, it & 1, 31 - (it >> 4), smem);
      }
    } break;
    case 4:
      for (int item = blockIdx.x * 2 + half; item < 4096; item += gridDim.x * 2) gla_p3_item(P, item, hsmem);
      break;
    case 5: gemm_run<0>(r3, (const bf16_t*)(ws + W_EOUT), 1024, 1024, r4, 1024, smem); break;
    case 6: resnorm_rows(r4, P.x, P.out, P.norm_g + 1 * 1024, P.norm_g + 2 * 1024, r2); break;
    case 7: gemm_run<1>(r2, (const bf16_t*)(ws + W_FFN1_0), 4096, 1024, r1, 4096, smem); break;
    case 8: gemm_run<0>(r1, (const bf16_t*)(ws + W_FFN2_0), 1024, 4096, r4, 1024, smem); break;
    case 9: resnorm_rows(r4, P.out, P.out, P.norm_g + 3 * 1024, P.norm_g + 4 * 1024, r2); break;
    case 10: gemm_run<2>(r2, (const bf16_t*)(ws + W_OIN), 4096, 1024, r1, 4096, smem); break;
    case 11:
      for (int item = blockIdx.x * 2 + half; item < 512; item += gridDim.x * 2) sgu_item(P, item, hsmem);
      break;
    case 12: gemm_run<0>(r2, (const bf16_t*)(ws + W_OOUT), 1024, 2048, r4, 1024, smem); break;
    case 13: resnorm_rows(r4, P.out, P.out, P.norm_g + 5 * 1024, P.norm_g + 6 * 1024, r2); break;
    case 14: gemm_run<1>(r2, (const bf16_t*)(ws + W_FFN1_1), 4096, 1024, r1, 4096, smem); break;
    case 15: gemm_run<0>(r1, (const bf16_t*)(ws + W_FFN2_1), 1024, 4096, r4, 1024, smem); break;
    case 16: resnorm_rows(r4, P.out, P.out, P.norm_g + 7 * 1024, nullptr, nullptr); break;
    default: break;
  }
}

#if !MEGA
extern __shared__ __attribute__((aligned(16))) unsigned char lds_dyn[];
__global__ void __launch_bounds__(NTHR, 2) k_phase(Params P, int ph) {
  char* smem = (char*)lds_dyn;
  run_phase(P, ph, smem);
}
#endif

#if MEGA
extern __shared__ __attribute__((aligned(16))) unsigned char lds_dyn[];
__global__ void __launch_bounds__(NTHR, 2) k_mega(Params P) {
  char* smem = (char*)lds_dyn;
  cg::grid_group grid = cg::this_grid();
#ifndef PROBE
#define PROBE 0
#endif
#define GEMM_PH(n) run_phase(P, n, smem); grid.sync(); if (PROBE == 1) { run_phase(P, n, smem); grid.sync(); }
  run_phase(P, 0, smem); grid.sync();
  GEMM_PH(1)
  run_phase(P, 2, smem); grid.sync();
  run_phase(P, 3, smem); grid.sync();
  if (PROBE == 2) {
    if (blockIdx.x == 0 && TIDX == 0) ((unsigned*)(P.ws + W_CNT))[1] = 0u;
    grid.sync();
    run_phase(P, 30, smem); grid.sync();
  }
  run_phase(P, 4, smem); grid.sync();
  GEMM_PH(5)
  run_phase(P, 6, smem); grid.sync();
  GEMM_PH(7)
  GEMM_PH(8)
  run_phase(P, 9, smem); grid.sync();
  GEMM_PH(10)
  run_phase(P, 11, smem); grid.sync();
  GEMM_PH(12)
  run_phase(P, 13, smem); grid.sync();
  GEMM_PH(14)
  GEMM_PH(15)
  run_phase(P, 16, smem);
}
#endif

extern "C" void kernel_launch(void* const* d_in, const int* in_sizes, int n_in, void* d_out, int out_size, void* d_ws, size_t ws_size,
                              hipStream_t stream) {
  Params p{};
  p.x = (const float*)d_in[0]; p.norm_g = (const float*)d_in[1]; p.ffn_w1 = (const float*)d_in[2]; p.ffn_w2 = (const float*)d_in[3];
  p.e_w_in = (const float*)d_in[4]; p.e_w_out = (const float*)d_in[5]; p.gla_w_gate = (const float*)d_in[6]; p.gla_b_gate = (const float*)d_in[7];
  p.gla_norm = (const float*)d_in[8]; p.nsa_gate_b = (const float*)d_in[9]; p.cmp_pos = (const float*)d_in[10]; p.cmp_w1 = (const float*)d_in[11];
  p.cmp_w2 = (const float*)d_in[12]; p.o_w_in = (const float*)d_in[13]; p.o_ln_g = (const float*)d_in[14]; p.o_ln_b = (const float*)d_in[15];
  p.o_w_s = (const float*)d_in[16]; p.o_b_s = (const float*)d_in[17]; p.o_w_out = (const float*)d_in[18];
  p.out = (float*)d_out; p.ws = (char*)d_ws;
  if (ws_size < 1024ull * MiB) { fprintf(stderr, "workspace too small: %zu\n", ws_size); return; }
  static int grid_blocks = 0;
  if (!grid_blocks) {
    int dev = 0, cus = 0, per_cu = 0;
    (void)hipGetDevice(&dev);
    (void)hipDeviceGetAttribute(&cus, hipDeviceAttributeMultiprocessorCount, dev);
#if MEGA
    if (hipFuncSetAttribute((const void*)k_mega, hipFuncAttributeMaxDynamicSharedMemorySize, LDS_BYTES) != hipSuccess) fprintf(stderr, "hipFuncSetAttribute failed\n");
    (void)hipOccupancyMaxActiveBlocksPerMultiprocessor(&per_cu, (const void*)k_mega, NTHR, LDS_BYTES);
#else
    if (hipFuncSetAttribute((const void*)k_phase, hipFuncAttributeMaxDynamicSharedMemorySize, LDS_BYTES) != hipSuccess) fprintf(stderr, "hipFuncSetAttribute failed\n");
    (void)hipOccupancyMaxActiveBlocksPerMultiprocessor(&per_cu, (const void*)k_phase, NTHR, LDS_BYTES);
#endif
    if (per_cu < 1) fprintf(stderr, "occupancy query returned %d\n", per_cu);
    grid_blocks = cus;
  }
#if MEGA
  void* args[] = {&p};
  hipError_t e = hipLaunchCooperativeKernel((void*)k_mega, dim3(grid_blocks), dim3(NTHR), args, LDS_BYTES, stream);
  if (e != hipSuccess) fprintf(stderr, "cooperative launch failed: %s (grid %d)\n", hipGetErrorString(e), grid_blocks);
#else
  for (int ph = 0; ph < NPHASE; ++ph) k_phase<<<grid_blocks, NTHR, LDS_BYTES, stream>>>(p, ph);
#endif
}
```

```cpp
#include <hip/hip_runtime.h>
#include <hip/hip_cooperative_groups.h>
#include <cstdio>
namespace cg = cooperative_groups;

#ifndef MEGA
#define MEGA 1
#endif

typedef unsigned short bf16_t;
typedef short bf16x8 __attribute__((ext_vector_type(8)));
typedef short s16x4 __attribute__((ext_vector_type(4)));
typedef float f32x16 __attribute__((ext_vector_type(16)));
typedef float f32v2 __attribute__((ext_vector_type(2)));
typedef __bf16 bf16v2 __attribute__((ext_vector_type(2)));
typedef unsigned u32x4 __attribute__((ext_vector_type(4)));
typedef unsigned u32x2 __attribute__((ext_vector_type(2)));
#define DI __device__ __forceinline__
DI int tid_opaque() { int t = threadIdx.x; asm volatile("" : "+v"(t)); return t; }
#define TIDX tid_opaque()

constexpr int T_TOK = 65536, SEQ = 8192, DM = 1024;
constexpr int PW = 3072;
constexpr int C_GQ = 0, C_GK = 256, C_GV = 512, C_GLR = 1024, C_GR = 1040, C_NQ = 1552, C_KC = 2064, C_VC = 2192,
              C_KS = 2320, C_VS = 2448, C_KW = 2576, C_VW = 2704, C_NG = 2832;
constexpr float EPS = 1e-6f;
constexpr int NTHR = 512, WPB = 8, LDS_BYTES = 131072 + 64;
constexpr size_t MiB = 1024ull * 1024ull;
constexpr size_t W_FFN1_0 = 0, W_FFN1_1 = 8 * MiB, W_FFN2_0 = 16 * MiB, W_FFN2_1 = 24 * MiB, W_EIN = 32 * MiB, W_EOUT = 38 * MiB,
                 W_OIN = 40 * MiB, W_OOUT = 48 * MiB, W_CW1 = 52 * MiB, W_CW2 = 53 * MiB, W_BIAS1 = 53 * MiB + 65536,
                 W_CNT = 53 * MiB + 131072;
constexpr size_t R1 = 64 * MiB, R2 = 576 * MiB, R3 = 704 * MiB, R4 = 832 * MiB, R5 = 960 * MiB;
constexpr size_t R_KCMP = R5, R_VCMPT = R5 + 1 * MiB, R_VST = R5 + 2 * MiB, R_VWT = R5 + 18 * MiB, R_DECAY = R5 + 34 * MiB;

struct Params {
  const float* x; const float* norm_g; const float* ffn_w1; const float* ffn_w2; const float* e_w_in; const float* e_w_out;
  const float* gla_w_gate; const float* gla_b_gate; const float* gla_norm; const float* nsa_gate_b; const float* cmp_pos;
  const float* cmp_w1; const float* cmp_w2; const float* o_w_in; const float* o_ln_g; const float* o_ln_b; const float* o_w_s;
  const float* o_b_s; const float* o_w_out;
  float* out; char* ws;
};

DI int crow(int r, int kb) { return (r & 3) + 8 * (r >> 2) + 4 * kb; }
DI f32x16 mfma(bf16x8 a, bf16x8 b, f32x16 c) { return __builtin_amdgcn_mfma_f32_32x32x16_bf16(a, b, c, 0, 0, 0); }
DI unsigned pk2(float a, float b) { f32v2 v = {a, b}; bf16v2 r = __builtin_convertvector(v, bf16v2); return __builtin_bit_cast(unsigned, r); }
DI bf16_t f2bf(float a) { return (bf16_t)(pk2(a, 0.f) & 0xffffu); }
DI float bf2f(bf16_t u) { return __uint_as_float(((unsigned)u) << 16); }
DI float bflo(unsigned u) { return __uint_as_float(u << 16); }
DI float bfhi(unsigned u) { return __uint_as_float(u & 0xffff0000u); }
DI bf16x8 pack8(float a0, float a1, float a2, float a3, float a4, float a5, float a6, float a7) {
  u32x4 p; p[0] = pk2(a0, a1); p[1] = pk2(a2, a3); p[2] = pk2(a4, a5); p[3] = pk2(a6, a7);
  return __builtin_bit_cast(bf16x8, p);
}
DI bf16x8 ld2x4(const bf16_t* p) {
  s16x4 lo = *(const s16x4*)p; s16x4 hi = *(const s16x4*)(p + 8);
  return __builtin_shufflevector(lo, hi, 0, 1, 2, 3, 4, 5, 6, 7);
}
DI float wave_sum(float v) {
#pragma unroll
  for (int o = 32; o > 0; o >>= 1) v += __shfl_xor(v, o);
  return v;
}
DI f32x16 zero16() { f32x16 z;
#pragma unroll
  for (int i = 0; i < 16; ++i) z[i] = 0.f; return z; }
DI float gelu_tanh(float x) { float u = 1.5957691216f * (x + 0.044715f * x * x * x); return x / (1.f + __expf(-u)); }
DI float sigmoidf_(float x) { return 1.f / (1.f + __expf(-x)); }

DI void conv_weight(const float* __restrict__ src, bf16_t* __restrict__ dst, int K, int N, int Npad) {
  const long total = (long)Npad * (K >> 3);
  const long stride = (long)gridDim.x * blockDim.x;
  for (long i = (long)blockIdx.x * blockDim.x + TIDX; i < total; i += stride) {
    const int n = (int)(i % Npad); const int k8 = (int)(i / Npad);
    float v[8];
#pragma unroll
    for (int j = 0; j < 8; ++j) v[j] = (n < N) ? src[(size_t)(k8 * 8 + j) * N + n] : 0.f;
    u32x4 o; o[0] = pk2(v[0], v[1]); o[1] = pk2(v[2], v[3]); o[2] = pk2(v[4], v[5]); o[3] = pk2(v[6], v[7]);
    *(u32x4*)(dst + (size_t)n * K + k8 * 8) = o;
  }
}

DI void prenorm_rows(const float* __restrict__ x, const float* __restrict__ g, bf16_t* __restrict__ xn) {
  const int lane = TIDX & 63, wave = TIDX >> 6;
  const int nw = gridDim.x * WPB;
  for (int row = blockIdx.x * WPB + wave; row < T_TOK; row += nw) {
    const float4* xr = (const float4*)(x + (size_t)row * DM);
    float4 a[4]; float ss = 0.f;
#pragma unroll
    for (int k = 0; k < 4; ++k) { a[k] = xr[k * 64 + lane]; ss += a[k].x * a[k].x + a[k].y * a[k].y + a[k].z * a[k].z + a[k].w * a[k].w; }
    ss = wave_sum(ss);
    const float rs = rsqrtf(ss * (1.f / DM) + EPS);
#pragma unroll
    for (int k = 0; k < 4; ++k) {
      const float4 gg = ((const float4*)g)[k * 64 + lane];
      u32x2 o; o[0] = pk2(a[k].x * rs * gg.x, a[k].y * rs * gg.y); o[1] = pk2(a[k].z * rs * gg.z, a[k].w * rs * gg.w);
      *(u32x2*)(xn + (size_t)row * DM + k * 256 + lane * 4) = o;
    }
  }
}

template <bool HIN_F32, bool HOUT_F32>
DI void resnorm_rows(const bf16_t* __restrict__ m, const float* __restrict__ hin_f, const bf16_t* hin_b, float* __restrict__ hout_f,
                     bf16_t* hout_b, const float* __restrict__ gpost, const float* __restrict__ gnext, bf16_t* __restrict__ xn) {
  const int lane = TIDX & 63, wave = TIDX >> 6;
  const int nw = gridDim.x * WPB;
  for (int row = blockIdx.x * WPB + wave; row < T_TOK; row += nw) {
    float mv[16]; float ss = 0.f;
#pragma unroll
    for (int k = 0; k < 4; ++k) {
      const u32x2 u = *(const u32x2*)(m + (size_t)row * DM + k * 256 + lane * 4);
      mv[k * 4 + 0] = bflo(u[0]); mv[k * 4 + 1] = bfhi(u[0]); mv[k * 4 + 2] = bflo(u[1]); mv[k * 4 + 3] = bfhi(u[1]);
    }
    float hv[16];
#pragma unroll
    for (int k = 0; k < 4; ++k) {
      if (HIN_F32) {
        const float4 h4 = ((const float4*)(hin_f + (size_t)row * DM))[k * 64 + lane];
        hv[k * 4 + 0] = h4.x; hv[k * 4 + 1] = h4.y; hv[k * 4 + 2] = h4.z; hv[k * 4 + 3] = h4.w;
      } else {
        const u32x2 u = *(const u32x2*)(hin_b + (size_t)row * DM + k * 256 + lane * 4);
        hv[k * 4 + 0] = bflo(u[0]); hv[k * 4 + 1] = bfhi(u[0]); hv[k * 4 + 2] = bflo(u[1]); hv[k * 4 + 3] = bfhi(u[1]);
      }
    }
#pragma unroll
    for (int i = 0; i < 16; ++i) ss += mv[i] * mv[i];
    ss = wave_sum(ss);
    const float rs = rsqrtf(ss * (1.f / DM) + EPS);
    float s2 = 0.f;
#pragma unroll
    for (int k = 0; k < 4; ++k) {
      const float4 gg = ((const float4*)gpost)[k * 64 + lane];
      hv[k * 4 + 0] += mv[k * 4 + 0] * rs * gg.x; hv[k * 4 + 1] += mv[k * 4 + 1] * rs * gg.y;
      hv[k * 4 + 2] += mv[k * 4 + 2] * rs * gg.z; hv[k * 4 + 3] += mv[k * 4 + 3] * rs * gg.w;
      if (HOUT_F32) {
        float4 o; o.x = hv[k * 4 + 0]; o.y = hv[k * 4 + 1]; o.z = hv[k * 4 + 2]; o.w = hv[k * 4 + 3];
        ((float4*)(hout_f + (size_t)row * DM))[k * 64 + lane] = o;
      } else {
        u32x2 o; o[0] = pk2(hv[k * 4 + 0], hv[k * 4 + 1]); o[1] = pk2(hv[k * 4 + 2], hv[k * 4 + 3]);
        *(u32x2*)(hout_b + (size_t)row * DM + k * 256 + lane * 4) = o;
      }
    }
    if (xn) {
#pragma unroll
      for (int i = 0; i < 16; ++i) s2 += hv[i] * hv[i];
      s2 = wave_sum(s2);
      const float r2 = rsqrtf(s2 * (1.f / DM) + EPS);
#pragma unroll
      for (int k = 0; k < 4; ++k) {
        const float4 gg = ((const float4*)gnext)[k * 64 + lane];
        u32x2 o; o[0] = pk2(hv[k * 4 + 0] * r2 * gg.x, hv[k * 4 + 1] * r2 * gg.y); o[1] = pk2(hv[k * 4 + 2] * r2 * gg.z, hv[k * 4 + 3] * r2 * gg.w);
        *(u32x2*)(xn + (size_t)row * DM + k * 256 + lane * 4) = o;
      }
    }
  }
}

DI void phase_prep(const Params& P) {
  char* ws = P.ws;
  conv_weight(P.ffn_w1, (bf16_t*)(ws + W_FFN1_0), 1024, 4096, 4096);
  conv_weight(P.ffn_w1 + (size_t)1024 * 4096, (bf16_t*)(ws + W_FFN1_1), 1024, 4096, 4096);
  conv_weight(P.ffn_w2, (bf16_t*)(ws + W_FFN2_0), 4096, 1024, 1024);
  conv_weight(P.ffn_w2 + (size_t)1024 * 4096, (bf16_t*)(ws + W_FFN2_1), 4096, 1024, 1024);
  conv_weight(P.e_w_in, (bf16_t*)(ws + W_EIN), 1024, 2856, PW);
  conv_weight(P.e_w_out, (bf16_t*)(ws + W_EOUT), 1024, 1024, 1024);
  conv_weight(P.o_w_in, (bf16_t*)(ws + W_OIN), 1024, 4096, 4096);
  conv_weight(P.o_w_out, (bf16_t*)(ws + W_OOUT), 2048, 1024, 1024);
  conv_weight(P.cmp_w1, (bf16_t*)(ws + W_CW1), 2048, 128, 128);
  conv_weight(P.cmp_w1 + 2048 * 128, (bf16_t*)(ws + W_CW1) + 128 * 2048, 2048, 128, 128);
  conv_weight(P.cmp_w2, (bf16_t*)(ws + W_CW2), 128, 64, 64);
  conv_weight(P.cmp_w2 + 128 * 64, (bf16_t*)(ws + W_CW2) + 64 * 128, 128, 64, 64);
  const int lane = TIDX & 63, wave = TIDX >> 6;
  const int gw = blockIdx.x * WPB + wave;
  if (gw < 256) {
    const int i = gw >> 7, hid = gw & 127;
    float s = 0.f;
    for (int kk = lane; kk < 2048; kk += 64) s += P.cmp_pos[i * 2048 + kk] * P.cmp_w1[((size_t)i * 2048 + kk) * 128 + hid];
    s = wave_sum(s);
    if (lane == 0) ((float*)(ws + W_BIAS1))[gw] = s;
  }
  const int gt = blockIdx.x * blockDim.x + TIDX;
  if (gt < 16) ((unsigned*)(ws + W_CNT))[gt] = 0u;
  if (gt < 16 * 64) {
    const int bg = gt >> 6, d = gt & 63;
    ((bf16_t*)(ws + R_KCMP))[((size_t)bg * 512 + 511) * 64 + d] = 0;
    ((bf16_t*)(ws + R_VCMPT))[((size_t)bg * 64 + d) * 512 + 511] = 0;
  }
  prenorm_rows(P.x, P.norm_g, (bf16_t*)(ws + R2));
}

namespace pg8 {
#define PG8_LAS __attribute__((address_space(3)))
typedef float f32x4 __attribute__((ext_vector_type(4)));
constexpr int BM = 256, BK = 64, HALF = 128, HTB = HALF * BK * 2, STAGE_BYTES = 8 * HTB, NXCD = 8, WGM = 8;
DI int lds_byte(int r, int c) { const int st = (r >> 4) * 2 + (c >> 5), rr = r & 15, cc = c & 31, ob = rr * 64 + cc * 2; return st * 1024 + (ob ^ (((ob >> 9) & 1) << 5)); }
DI void stage_rc(int b, int& R, int& C) { const int st = b / 1024, sb = b % 1024, swz = sb ^ (((sb >> 9) & 1) << 5); R = (st >> 1) * 16 + swz / 64; C = (st & 1) * 32 + (swz % 64) / 2; }
DI int perm32(int rho) { const int n = rho >> 4, i = rho & 15; return 8 * (i >> 2) + 4 * n + (i & 3); }
struct Unit { int pm, pn; };
struct Gemm { const bf16_t* A; const bf16_t* Bt; int M, N, K; };
struct StaticOrder {
  int nM, nN, nwg, G, c;
  DI void init(int M, int N, int G_, int c_) { nM = M / BM; nN = N / BM; nwg = nM * nN; G = G_; c = c_; }
  DI bool next(int i, Unit& u) const {
    const long L = (long)i * G + c; if (L >= nwg) return false;
    int wgid = (int)L; { const int q = nwg / NXCD, r = nwg % NXCD, xcd = wgid % NXCD, off = wgid / NXCD; wgid = (xcd < r ? xcd * (q + 1) : r * (q + 1) + (xcd - r) * q) + off; }
    const int nig = WGM * nN, gid = wgid / nig, fm = gid * WGM, gsz = (nM - fm) < WGM ? (nM - fm) : WGM;
    u.pm = fm + ((wgid % nig) % gsz); u.pn = (wgid % nig) / gsz; return true;
  }
};
template <int ACT> struct EpiB {
  static constexpr bool PERM = true;
  bf16_t* O; int ldc;
  DI void operator()(const f32x4 (&acc)[2][2][4][2], const Unit& u, int wr, int wc, int fr, int fq) const {
    const int row0 = u.pm * BM + wr * 64 + fr; const int col0 = u.pn * BM + wc * 32 + 8 * fq;
#pragma unroll
    for (int ai = 0; ai < 2; ++ai)
#pragma unroll
      for (int m = 0; m < 4; ++m) {
        bf16_t* rowp = O + (size_t)(row0 + ai * HALF + m * 16) * ldc + col0;
#pragma unroll
        for (int bj = 0; bj < 2; ++bj) {
          f32x4 v0 = acc[ai][bj][m][0], v1 = acc[ai][bj][m][1];
          if (ACT == 1) {
#pragma unroll
            for (int j = 0; j < 4; ++j) { const float a = fmaxf(v0[j], 0.f), b = fmaxf(v1[j], 0.f); v0[j] = a * a; v1[j] = b * b; }
          }
          if (ACT == 2) {
#pragma unroll
            for (int j = 0; j < 4; ++j) { v0[j] = gelu_tanh(v0[j]); v1[j] = gelu_tanh(v1[j]); }
          }
          u32x4 w; w[0] = pk2(v0[0], v0[1]); w[1] = pk2(v0[2], v0[3]); w[2] = pk2(v1[0], v1[1]); w[3] = pk2(v1[2], v1[3]);
          *(u32x4*)(rowp + bj * HALF) = w;
        }
      }
  }
};

template <class Epi, class Sched>
DI void gemm_phase(PG8_LAS unsigned char* lds, const Gemm g, const Sched& S, const Epi& E) {
  const int tid_ = TIDX;
  const int tid = tid_, wid = __builtin_amdgcn_readfirstlane(tid >> 6), lane = tid & 63, wr = wid >> 2, wc = wid & 3, fr = lane & 15, fq = lane >> 4;
  const int K = g.K, nt = K / BK;
  unsigned voffA[2], voffB[2];
#pragma unroll
  for (int i = 0; i < 2; ++i) { int R, C; stage_rc(tid * 16 + i * 8192, R, C); const int Rb = Epi::PERM ? ((R & ~31) + perm32(R & 31)) : R;
    voffA[i] = (unsigned)(R * K + C) * 2u; voffB[i] = (unsigned)(Rb * K + C) * 2u; }
  const size_t kstep = (size_t)(BK * 2);
  const size_t hstep = (size_t)HALF * K * 2;
  const size_t tstep = 2 * hstep;
  const unsigned ldsw = (unsigned)wid * 1024u;
  const int aoff = lds_byte(wr * 64 + fr, fq * 8), boff = lds_byte(wc * 32 + fr, fq * 8);
#define PG8_SA(b, h) (((b) * 2 + (h)) * HTB)
#define PG8_SB(b, h) ((4 + (b) * 2 + (h)) * HTB)
#define PG8_STAGE(bufoff, gbase, voff) do { _Pragma("unroll") for (int _i = 0; _i < 2; ++_i) \
    __builtin_amdgcn_global_load_lds((const unsigned*)((const char*)(gbase) + (voff)[_i]), (PG8_LAS unsigned*)(lds + (bufoff) + ldsw + _i * 8192), 16, 0, 0); } while (0)
#define PG8_LDA(dst, b, h) do { _Pragma("unroll") for (int m = 0; m < 4; ++m) _Pragma("unroll") for (int k = 0; k < 2; ++k) dst[m][k] = *(const PG8_LAS bf16x8*)(lds + PG8_SA(b, h) + aoff + m * 2048 + k * 1024); } while (0)
#define PG8_LDB(dst, b, h) do { _Pragma("unroll") for (int n = 0; n < 2; ++n) _Pragma("unroll") for (int k = 0; k < 2; ++k) dst[n][k] = *(const PG8_LAS bf16x8*)(lds + PG8_SB(b, h) + boff + n * 2048 + k * 1024); } while (0)
#define PG8_MMA(ai, bj, At, Bt) do { __builtin_amdgcn_s_setprio(1); _Pragma("unroll") for (int m = 0; m < 4; ++m) _Pragma("unroll") for (int n = 0; n < 2; ++n) _Pragma("unroll") for (int k = 0; k < 2; ++k) \
    acc[ai][bj][m][n] = __builtin_amdgcn_mfma_f32_16x16x32_bf16(Bt[n][k], At[m][k], acc[ai][bj][m][n], 0, 0, 0); __builtin_amdgcn_s_setprio(0); } while (0)
#define PG8_WAIT_V(n) asm volatile("s_waitcnt vmcnt(" #n ")" ::: "memory")
#define PG8_WAIT_L(n) asm volatile("s_waitcnt lgkmcnt(" #n ")" ::: "memory")
#define PG8_BAR __builtin_amdgcn_s_barrier()
#define PG8_SCHED __builtin_amdgcn_sched_barrier(0)
  Unit cur, nxt; int ui = 0;
  if (!S.next(0, cur)) return;
  f32x4 acc[2][2][4][2];
#pragma unroll
  for (int a = 0; a < 2; ++a)
#pragma unroll
    for (int b = 0; b < 2; ++b)
#pragma unroll
      for (int m = 0; m < 4; ++m)
#pragma unroll
        for (int n = 0; n < 2; ++n) acc[a][b][m][n] = (f32x4){0.f, 0.f, 0.f, 0.f};
  bf16x8 At[4][2], B0[2][2], B1[2][2];
  const char* cA = (const char*)g.A + (size_t)cur.pm * tstep; const char* cB = (const char*)g.Bt + (size_t)cur.pn * tstep;
  PG8_STAGE(PG8_SB(0, 0), cB, voffB); PG8_STAGE(PG8_SA(0, 0), cA, voffA); PG8_STAGE(PG8_SB(0, 1), cB + hstep, voffB); PG8_STAGE(PG8_SA(0, 1), cA + hstep, voffA);
  if (wr == 1) PG8_BAR;
  PG8_WAIT_V(4); PG8_BAR;
  PG8_STAGE(PG8_SB(1, 0), cB + kstep, voffB); PG8_STAGE(PG8_SA(1, 0), cA + kstep, voffA); PG8_STAGE(PG8_SB(1, 1), cB + hstep + kstep, voffB);
  PG8_WAIT_V(6); PG8_BAR;
  for (;;) {
    const bool has_next = S.next(ui + 1, nxt);
    const char* nA = has_next ? (const char*)g.A + (size_t)nxt.pm * tstep : cA; const char* nB = has_next ? (const char*)g.Bt + (size_t)nxt.pn * tstep : cB;
    for (int t = 0; t < nt; t += 2) {
      const bool last = (t == nt - 2);
      const char* a1 = cA + (size_t)(t + 1) * kstep;
      const char* a2 = last ? nA : cA + (size_t)(t + 2) * kstep; const char* b2 = last ? nB : cB + (size_t)(t + 2) * kstep;
      const char* a3 = a2 + kstep; const char* b3 = b2 + kstep;
      PG8_LDB(B0, 0, 0); PG8_SCHED; PG8_LDA(At, 0, 0); PG8_STAGE(PG8_SA(1, 1), a1 + hstep, voffA);
      PG8_WAIT_L(8); PG8_BAR; PG8_WAIT_L(0); PG8_MMA(0, 0, At, B0); PG8_BAR; PG8_SCHED;
      PG8_LDB(B1, 0, 1); PG8_STAGE(PG8_SB(0, 0), b2, voffB);
      PG8_BAR; PG8_WAIT_L(0); PG8_MMA(0, 1, At, B1); PG8_BAR;
      PG8_LDA(At, 0, 1); PG8_STAGE(PG8_SA(0, 0), a2, voffA);
      PG8_BAR; PG8_WAIT_L(0); PG8_MMA(1, 0, At, B0); PG8_BAR; PG8_SCHED;
      PG8_STAGE(PG8_SB(0, 1), b2 + hstep, voffB);
      PG8_WAIT_V(6); PG8_BAR; PG8_MMA(1, 1, At, B1); PG8_BAR;
      PG8_LDB(B0, 1, 0); PG8_SCHED; PG8_LDA(At, 1, 0); PG8_STAGE(PG8_SA(0, 1), a2 + hstep, voffA);
      PG8_WAIT_L(8); PG8_BAR; PG8_WAIT_L(0); PG8_MMA(0, 0, At, B0); PG8_BAR; PG8_SCHED;
      PG8_LDB(B1, 1, 1); PG8_STAGE(PG8_SB(1, 0), b3, voffB);
      PG8_BAR; PG8_WAIT_L(0); PG8_MMA(0, 1, At, B1); PG8_BAR;
      PG8_LDA(At, 1, 1); PG8_STAGE(PG8_SA(1, 0), a3, voffA);
      PG8_BAR; PG8_WAIT_L(0); PG8_MMA(1, 0, At, B0); PG8_BAR; PG8_SCHED;
      PG8_STAGE(PG8_SB(1, 1), b3 + hstep, voffB);
      PG8_WAIT_V(6); PG8_BAR; PG8_MMA(1, 1, At, B1); PG8_BAR;
    }
    E(acc, cur, wr, wc, fr, fq);
    if (!has_next) break;
#pragma unroll
    for (int a = 0; a < 2; ++a)
#pragma unroll
      for (int b = 0; b < 2; ++b)
#pragma unroll
        for (int m = 0; m < 4; ++m)
#pragma unroll
          for (int n = 0; n < 2; ++n) acc[a][b][m][n] = (f32x4){0.f, 0.f, 0.f, 0.f};
    cur = nxt; cA = nA; cB = nB; ++ui;
  }
  PG8_WAIT_V(0);
  if (wr == 0) PG8_BAR;
  PG8_BAR;
#undef PG8_SA
#undef PG8_SB
#undef PG8_STAGE
#undef PG8_LDA
#undef PG8_LDB
#undef PG8_MMA
#undef PG8_WAIT_V
#undef PG8_WAIT_L
#undef PG8_BAR
#undef PG8_SCHED
}
}

template <int ACT>
DI void gemm_run(const bf16_t* A, const bf16_t* Bt, int N, int K, bf16_t* C, int ldc, char* smem) {
  pg8::Gemm g; g.A = A; g.Bt = Bt; g.M = T_TOK; g.N = N; g.K = K;
  pg8::StaticOrder S; S.init(T_TOK, N, (int)gridDim.x, (int)blockIdx.x);
  pg8::EpiB<ACT> E; E.O = C; E.ldc = ldc;
  pg8::gemm_phase(( PG8_LAS unsigned char*)smem, g, S, E);
  __syncthreads();
}

DI void gla_gates(const Params& P, const bf16_t* proj, int b, int h, int n, float* sb, float* sseg, float* tmp) {
  const int tid = TIDX & 255;
  float* sw = tmp;
  float* sg = tmp + 1024;
  {
    for (int e = tid; e < 1024; e += 256) sw[e] = P.gla_w_gate[(e >> 6) * 256 + h * 64 + (e & 63)];
    const int i = tid >> 2, part = tid & 3;
    const size_t t = (size_t)b * SEQ + n * 64 + i;
    const u32x2 gu = *(const u32x2*)(proj + t * PW + C_GLR + part * 4);
    sg[i * 17 + part * 4 + 0] = bflo(gu[0]); sg[i * 17 + part * 4 + 1] = bfhi(gu[0]);
    sg[i * 17 + part * 4 + 2] = bflo(gu[1]); sg[i * 17 + part * 4 + 3] = bfhi(gu[1]);
  }
  __syncthreads();
  {
    const int i = tid & 63, dq = tid >> 6;
    float z[16];
#pragma unroll
    for (int dd = 0; dd < 16; ++dd) z[dd] = P.gla_b_gate[h * 64 + dq * 16 + dd];
#pragma unroll 1
    for (int r = 0; r < 16; ++r) {
      const float gv = sg[i * 17 + r];
#pragma unroll
      for (int dd = 0; dd < 16; ++dd) z[dd] += gv * sw[r * 64 + dq * 16 + dd];
    }
#pragma unroll
    for (int dd = 0; dd < 16; ++dd) {
      const float zz = z[dd];
      const float ls = fminf(zz, 0.f) - __logf(1.f + __expf(-fabsf(zz)));
      sb[i * 65 + dq * 16 + dd] = ls * (1.f / 16.f);
    }
  }
  __syncthreads();
  const int d = tid & 63, seg = tid >> 6;
  float pre[16]; float run = 0.f;
#pragma unroll
  for (int ii = 0; ii < 16; ++ii) { run += sb[(seg * 16 + ii) * 65 + d]; pre[ii] = run; }
  sseg[seg * 64 + d] = run;
  __syncthreads();
  float off = 0.f;
#pragma unroll
  for (int s = 0; s < 4; ++s) off += (s < seg) ? sseg[s * 64 + d] : 0.f;
#pragma unroll
  for (int ii = 0; ii < 16; ++ii) sb[(seg * 16 + ii) * 65 + d] = pre[ii] + off;
  __syncthreads();
}

DI void gla_stage_vT(const bf16_t* proj, int b, int h, int n, bf16_t* vT) {
  const int tid = TIDX & 255, j = tid & 63, q4 = tid >> 6;
  const size_t t = (size_t)b * SEQ + n * 64 + j;
  const bf16_t* src = proj + t * PW + C_GV + h * 128 + q4 * 32;
#pragma unroll
  for (int c = 0; c < 4; ++c) {
    const u32x4 u = *(const u32x4*)(src + c * 8);
#pragma unroll
    for (int e = 0; e < 4; ++e) {
      vT[(q4 * 32 + c * 8 + 2 * e) * 72 + j] = (bf16_t)(u[e] & 0xffffu);
      vT[(q4 * 32 + c * 8 + 2 * e + 1) * 72 + j] = (bf16_t)(u[e] >> 16);
    }
  }
}

DI void gla_p1_item(const Params& P, int item, char* smem) {
  const bf16_t* proj = (const bf16_t*)(P.ws + R1);
  float* states = (float*)(P.ws + R2);
  float* decay = (float*)(P.ws + R_DECAY);
  float* sb = (float*)smem; float* sseg = sb + 64 * 65;
  bf16_t* kendT = (bf16_t*)(sseg + 256); bf16_t* vT = kendT + 64 * 72;
  const int n = item & 127, h = (item >> 7) & 3, b = item >> 9;
  const int tid = TIDX & 255, lane = tid & 63, wave = tid >> 6, l32 = lane & 31, kb = lane >> 5;
  gla_gates(P, proj, b, h, n, sb, sseg, (float*)vT);
  {
    const int j = tid & 63, dq = tid >> 6;
    const size_t t = (size_t)b * SEQ + n * 64 + j;
    const u32x4 k0 = *(const u32x4*)(proj + t * PW + C_GK + h * 64 + dq * 16), k1 = *(const u32x4*)(proj + t * PW + C_GK + h * 64 + dq * 16 + 8);
    float kv[16];
#pragma unroll
    for (int e = 0; e < 4; ++e) { kv[2 * e] = bflo(k0[e]); kv[2 * e + 1] = bfhi(k0[e]); kv[8 + 2 * e] = bflo(k1[e]); kv[8 + 2 * e + 1] = bfhi(k1[e]); }
#pragma unroll
    for (int dd = 0; dd < 16; ++dd) {
      const int d = dq * 16 + dd;
      kendT[d * 72 + j] = f2bf(kv[dd] * __expf(sb[63 * 65 + d] - sb[j * 65 + d]));
    }
    if (tid < 64) decay[((size_t)(b * 4 + h) * 128 + n) * 64 + tid] = __expf(sb[63 * 65 + tid]);
  }
  gla_stage_vT(proj, b, h, n, vT);
  __syncthreads();
#pragma unroll
  for (int dt = 0; dt < 2; ++dt) {
    f32x16 acc = zero16();
#pragma unroll
    for (int s = 0; s < 4; ++s) {
      const bf16x8 a = *(const bf16x8*)(vT + (wave * 32 + l32) * 72 + s * 16 + kb * 8);
      const bf16x8 bb = *(const bf16x8*)(kendT + (dt * 32 + l32) * 72 + s * 16 + kb * 8);
      acc = mfma(a, bb, acc);
    }
    float* dst = states + ((size_t)((b * 4 + h) * 128 + n) * 128) * 64;
#pragma unroll
    for (int r = 0; r < 16; ++r) dst[(size_t)(wave * 32 + crow(r, kb)) * 64 + dt * 32 + l32] = acc[r];
  }
  __syncthreads();
}

DI void gla_scan(const Params& P) {
  float* states = (float*)(P.ws + R2);
  const float* decay = (const float*)(P.ws + R_DECAY);
  const int total = 32 * 8192;
  for (int e = blockIdx.x * blockDim.x + TIDX; e < total; e += gridDim.x * blockDim.x) {
    const int bh = e >> 13, idx = e & 8191, d = idx & 63;
    float* p = states + (size_t)bh * 128 * 8192 + idx;
    const float* dc = decay + (size_t)bh * 128 * 64 + d;
    float S = 0.f;
#pragma unroll 8
    for (int n = 0; n < 128; ++n) {
      const float ds = p[(size_t)n * 8192];
      const float dec = dc[n * 64];
      p[(size_t)n * 8192] = S;
      S = dec * S + ds;
    }
  }
}

DI void gla_p3_item(const Params& P, int item, char* smem) {
  const bf16_t* proj = (const bf16_t*)(P.ws + R1);
  const float* states = (const float*)(P.ws + R2);
  bf16_t* mix = (bf16_t*)(P.ws + R3);
  float* sb = (float*)smem; float* sseg = sb + 64 * 65; float* sred = sseg + 256;
  bf16_t* sq = (bf16_t*)(sred + 256); bf16_t* sk = sq + 64 * 72; bf16_t* vT = sk + 64 * 72;
  const int n = item & 127, h = (item >> 7) & 3, b = item >> 9;
  const int tid = TIDX & 255, lane = tid & 63, wave = tid >> 6, l32 = lane & 31, kb = lane >> 5;
  gla_gates(P, proj, b, h, n, sb, sseg, (float*)vT);
  {
    const int i = tid & 63, dq = tid >> 6;
    const size_t t = (size_t)b * SEQ + n * 64 + i;
    const u32x4 q0 = *(const u32x4*)(proj + t * PW + C_GQ + h * 64 + dq * 16), q1 = *(const u32x4*)(proj + t * PW + C_GQ + h * 64 + dq * 16 + 8);
    const u32x4 k0 = *(const u32x4*)(proj + t * PW + C_GK + h * 64 + dq * 16), k1 = *(const u32x4*)(proj + t * PW + C_GK + h * 64 + dq * 16 + 8);
    float qv[16], kv[16];
#pragma unroll
    for (int e = 0; e < 4; ++e) {
      qv[2 * e] = bflo(q0[e]); qv[2 * e + 1] = bfhi(q0[e]); qv[8 + 2 * e] = bflo(q1[e]); qv[8 + 2 * e + 1] = bfhi(q1[e]);
      kv[2 * e] = bflo(k0[e]); kv[2 * e + 1] = bfhi(k0[e]); kv[8 + 2 * e] = bflo(k1[e]); kv[8 + 2 * e + 1] = bfhi(k1[e]);
    }
#pragma unroll
    for (int dd = 0; dd < 16; ++dd) {
      const int d = dq * 16 + dd;
      const float bb = sb[i * 65 + d];
      sq[i * 72 + d] = f2bf(qv[dd] * 0.125f * __expf(bb));
      sk[i * 72 + d] = f2bf(kv[dd] * __expf(-bb));
    }
  }
  gla_stage_vT(proj, b, h, n, vT);
  __syncthreads();
  f32x16 x00 = zero16(), x01 = zero16(), x11 = zero16();
#pragma unroll
  for (int s = 0; s < 4; ++s) {
    const bf16x8 kj0 = *(const bf16x8*)(sk + (l32)*72 + s * 16 + kb * 8);
    const bf16x8 kj1 = *(const bf16x8*)(sk + (32 + l32) * 72 + s * 16 + kb * 8);
    const bf16x8 qi0 = *(const bf16x8*)(sq + (l32)*72 + s * 16 + kb * 8);
    const bf16x8 qi1 = *(const bf16x8*)(sq + (32 + l32) * 72 + s * 16 + kb * 8);
    x00 = mfma(kj0, qi0, x00); x01 = mfma(kj0, qi1, x01); x11 = mfma(kj1, qi1, x11);
  }
#pragma unroll
  for (int r = 0; r < 16; ++r) { const bool keep = crow(r, kb) <= l32; x00[r] = keep ? x00[r] : 0.f; x11[r] = keep ? x11[r] : 0.f; }
  f32x16 o0 = zero16(), o1 = zero16();
  const int dvr = wave * 32 + l32;
#pragma unroll
  for (int s = 0; s < 2; ++s) {
    const bf16x8 p00 = pack8(x00[8 * s], x00[8 * s + 1], x00[8 * s + 2], x00[8 * s + 3], x00[8 * s + 4], x00[8 * s + 5], x00[8 * s + 6], x00[8 * s + 7]);
    const bf16x8 p01 = pack8(x01[8 * s], x01[8 * s + 1], x01[8 * s + 2], x01[8 * s + 3], x01[8 * s + 4], x01[8 * s + 5], x01[8 * s + 6], x01[8 * s + 7]);
    const bf16x8 p11 = pack8(x11[8 * s], x11[8 * s + 1], x11[8 * s + 2], x11[8 * s + 3], x11[8 * s + 4], x11[8 * s + 5], x11[8 * s + 6], x11[8 * s + 7]);
    const bf16x8 v0 = ld2x4(vT + dvr * 72 + 16 * s + 4 * kb);
    const bf16x8 v1 = ld2x4(vT + dvr * 72 + 32 + 16 * s + 4 * kb);
    o0 = mfma(v0, p00, o0); o1 = mfma(v0, p01, o1); o1 = mfma(v1, p11, o1);
  }
  {
    const float* sp = states + ((size_t)((b * 4 + h) * 128 + n) * 128 + dvr) * 64;
#pragma unroll
    for (int s = 0; s < 4; ++s) {
      const float4 f0 = *(const float4*)(sp + s * 16 + kb * 8), f1 = *(const float4*)(sp + s * 16 + kb * 8 + 4);
      const bf16x8 a = pack8(f0.x, f0.y, f0.z, f0.w, f1.x, f1.y, f1.z, f1.w);
      const bf16x8 qi0 = *(const bf16x8*)(sq + (l32)*72 + s * 16 + kb * 8);
      const bf16x8 qi1 = *(const bf16x8*)(sq + (32 + l32) * 72 + s * 16 + kb * 8);
      o0 = mfma(a, qi0, o0); o1 = mfma(a, qi1, o1);
    }
  }
  float s0 = 0.f, s1 = 0.f;
#pragma unroll
  for (int r = 0; r < 16; ++r) { s0 += o0[r] * o0[r]; s1 += o1[r] * o1[r]; }
  s0 += __shfl_xor(s0, 32); s1 += __shfl_xor(s1, 32);
  if (kb == 0) { sred[wave * 64 + l32] = s0; sred[wave * 64 + 32 + l32] = s1; }
  __syncthreads();
  const float t0s = sred[l32] + sred[64 + l32] + sred[128 + l32] + sred[192 + l32];
  const float t1s = sred[32 + l32] + sred[64 + 32 + l32] + sred[128 + 32 + l32] + sred[192 + 32 + l32];
  const float r0 = rsqrtf(t0s * (1.f / 128.f) + EPS), r1 = rsqrtf(t1s * (1.f / 128.f) + EPS);
#pragma unroll
  for (int it = 0; it < 2; ++it) {
    const size_t t = (size_t)b * SEQ + n * 64 + it * 32 + l32;
    const float rr = it ? r1 : r0;
#pragma unroll
    for (int gq = 0; gq < 4; ++gq) {
      const int dv = wave * 32 + 8 * gq + 4 * kb;
      const u32x2 ru = *(const u32x2*)(proj + t * PW + C_GR + h * 128 + dv);
      const float4 gn = *(const float4*)(P.gla_norm + h * 128 + dv);
      float rv[4] = {bflo(ru[0]), bfhi(ru[0]), bflo(ru[1]), bfhi(ru[1])};
      float gv[4] = {gn.x, gn.y, gn.z, gn.w};
      float ov[4];
#pragma unroll
      for (int e = 0; e < 4; ++e) {
        const float a = it ? o1[gq * 4 + e] : o0[gq * 4 + e];
        ov[e] = a * rr * gv[e] * (rv[e] / (1.f + __expf(-rv[e])));
      }
      u32x2 o; o[0] = pk2(ov[0], ov[1]); o[1] = pk2(ov[2], ov[3]);
      *(u32x2*)(mix + t * DM + h * 128 + dv) = o;
    }
  }
  __syncthreads();
}

DI void nsa_compress_task(const Params& P, int task) {
  const bf16_t* proj = (const bf16_t*)(P.ws + R1);
  const int lane = TIDX & 63, l32 = lane & 31, kb = lane >> 5;
  const int ct = task & 15, g = (task >> 4) & 1, b = (task >> 5) & 7, br = task >> 8;
  const bf16_t* w1T = (const bf16_t*)(P.ws + W_CW1) + (size_t)br * 128 * 2048;
  const bf16_t* w2T = (const bf16_t*)(P.ws + W_CW2) + (size_t)br * 64 * 128;
  const float* bias1 = (const float*)(P.ws + W_BIAS1) + br * 128;
  const int c = ct * 32 + l32;
  const int cc = c < 511 ? c : 510;
  const bf16_t* src = proj + ((size_t)b * SEQ + cc * 16) * PW + (br ? C_VC : C_KC) + g * 64 + kb * 8;
  f32x16 acc[4];
#pragma unroll
  for (int i = 0; i < 4; ++i) acc[i] = zero16();
#pragma unroll 1
  for (int ks = 0; ks < 128; ++ks) {
    const int l = ks >> 2, dh0 = (ks & 3) * 16;
    const bf16x8 bf = *(const bf16x8*)(src + (size_t)l * PW + dh0);
#pragma unroll
    for (int ht = 0; ht < 4; ++ht) {
      const bf16x8 af = *(const bf16x8*)(w1T + (size_t)(ht * 32 + l32) * 2048 + ks * 16 + kb * 8);
      acc[ht] = mfma(af, bf, acc[ht]);
    }
  }
#pragma unroll
  for (int ht = 0; ht < 4; ++ht)
#pragma unroll
    for (int r = 0; r < 16; ++r) acc[ht][r] = gelu_tanh(acc[ht][r] + bias1[ht * 32 + crow(r, kb)]);
  f32x16 o[2]; o[0] = zero16(); o[1] = zero16();
#pragma unroll
  for (int ht = 0; ht < 4; ++ht)
#pragma unroll
    for (int s = 0; s < 2; ++s) {
      const bf16x8 hf = pack8(acc[ht][8 * s], acc[ht][8 * s + 1], acc[ht][8 * s + 2], acc[ht][8 * s + 3], acc[ht][8 * s + 4], acc[ht][8 * s + 5], acc[ht][8 * s + 6], acc[ht][8 * s + 7]);
#pragma unroll
      for (int dt = 0; dt < 2; ++dt) {
        const bf16x8 wf = ld2x4(w2T + (size_t)(dt * 32 + l32) * 128 + ht * 32 + 16 * s + 4 * kb);
        o[dt] = mfma(wf, hf, o[dt]);
      }
    }
  if (c < 511) {
    if (br == 0) {
      bf16_t* dst = (bf16_t*)(P.ws + R_KCMP) + ((size_t)(b * 2 + g) * 512 + c) * 64;
#pragma unroll
      for (int dt = 0; dt < 2; ++dt)
#pragma unroll
        for (int gq = 0; gq < 4; ++gq) {
          u32x2 u; u[0] = pk2(o[dt][gq * 4], o[dt][gq * 4 + 1]); u[1] = pk2(o[dt][gq * 4 + 2], o[dt][gq * 4 + 3]);
          *(u32x2*)(dst + dt * 32 + 8 * gq + 4 * kb) = u;
        }
    } else {
      bf16_t* dst = (bf16_t*)(P.ws + R_VCMPT) + (size_t)(b * 2 + g) * 64 * 512 + c;
#pragma unroll
      for (int dt = 0; dt < 2; ++dt)
#pragma unroll
        for (int r = 0; r < 16; ++r) dst[(size_t)(dt * 32 + crow(r, kb)) * 512] = f2bf(o[dt][r]);
    }
  }
}

DI void nsa_transpose_v(const Params& P) {
  const bf16_t* proj = (const bf16_t*)(P.ws + R1);
  const int total = 2 * 8 * 2 * 1024 * 64;
  for (int u = blockIdx.x * blockDim.x + TIDX; u < total; u += gridDim.x * blockDim.x) {
    const int dh = u & 63; int rest = u >> 6; const int t8 = rest & 1023; rest >>= 10;
    const int g = rest & 1, b = (rest >> 1) & 7, which = rest >> 4;
    const bf16_t* src = proj + ((size_t)b * SEQ + t8 * 8) * PW + (which ? C_VW : C_VS) + g * 64 + dh;
    bf16_t v[8];
#pragma unroll
    for (int j = 0; j < 8; ++j) v[j] = src[(size_t)j * PW];
    u32x4 o;
#pragma unroll
    for (int j = 0; j < 4; ++j) o[j] = (unsigned)v[2 * j] | ((unsigned)v[2 * j + 1] << 16);
    bf16_t* dst = (bf16_t*)(P.ws + (which ? R_VWT : R_VST)) + ((size_t)(b * 2 + g) * 64 + dh) * SEQ + t8 * 8;
    *(u32x4*)dst = o;
  }
}

DI f32x16 qk_tile(const bf16_t* krow, const bf16x8 (&qf)[4]) {
  f32x16 s = zero16();
#pragma unroll
  for (int i = 0; i < 4; ++i) { const bf16x8 kf = *(const bf16x8*)(krow + i * 16); s = mfma(kf, qf[i], s); }
  return s;
}

DI float half_max(float x) {
  const auto r = __builtin_amdgcn_permlane32_swap(__float_as_uint(x), __float_as_uint(x), false, false);
  return fmaxf(__uint_as_float(r[0]), __uint_as_float(r[1]));
}
DI float half_sum(float x) {
  const auto r = __builtin_amdgcn_permlane32_swap(__float_as_uint(x), __float_as_uint(x), false, false);
  return __uint_as_float(r[0]) + __uint_as_float(r[1]);
}
struct KVFrag { bf16x8 k[4]; };
DI void kv_load(KVFrag& f, const bf16_t* krow) {
#pragma unroll
  for (int i = 0; i < 4; ++i) f.k[i] = *(const bf16x8*)(krow + i * 16);
}
template <bool EDGE>
DI void attn_step(const KVFrag& f, const bf16_t* vt0, const bf16x8 (&qf)[4], int k0, int tq, int lo, bool bit, int kb,
                  f32x16& o0, f32x16& o1, float& m, float& l) {
  constexpr float CS = 0.125f * 1.4426950408889634f;
  bf16x8 vf[4];
  vf[0] = ld2x4(vt0 + k0); vf[1] = ld2x4(vt0 + k0 + 16);
  vf[2] = ld2x4(vt0 + (size_t)32 * SEQ + k0); vf[3] = ld2x4(vt0 + (size_t)32 * SEQ + k0 + 16);
  f32x16 s = zero16();
#pragma unroll
  for (int i = 0; i < 4; ++i) s = mfma(f.k[i], qf[i], s);
  float tmax = -1e30f;
  if (EDGE) {
#pragma unroll
    for (int r = 0; r < 16; ++r) {
      const int key = k0 + crow(r, kb);
      const bool vd = (key <= tq) && (key > lo);
      s[r] = vd ? s[r] * CS : -1e30f;
      tmax = fmaxf(tmax, s[r]);
    }
  } else {
#pragma unroll
    for (int r = 0; r < 16; ++r) tmax = fmaxf(tmax, s[r]);
    tmax *= CS;
  }
  tmax = bit ? tmax : -1e30f;
  tmax = half_max(tmax);
  if (__ballot(tmax > m) != 0ull) {
    const float mn = fmaxf(m, tmax);
    const float alpha = __builtin_amdgcn_exp2f(m - mn);
    l *= alpha; m = mn;
#pragma unroll
    for (int r = 0; r < 16; ++r) { o0[r] *= alpha; o1[r] *= alpha; }
  }
  const bool live = bit && (m > -5e29f);
  float ps = 0.f;
#pragma unroll
  for (int r = 0; r < 16; ++r) {
    const float e = EDGE ? __builtin_amdgcn_exp2f(s[r] - m) : __builtin_amdgcn_exp2f(__builtin_fmaf(s[r], CS, -m));
    s[r] = live ? e : 0.f;
    ps += s[r];
  }
  l += ps;
#pragma unroll
  for (int sI = 0; sI < 2; ++sI) {
    const bf16x8 pf = pack8(s[8 * sI], s[8 * sI + 1], s[8 * sI + 2], s[8 * sI + 3], s[8 * sI + 4], s[8 * sI + 5], s[8 * sI + 6], s[8 * sI + 7]);
    o0 = mfma(vf[sI], pf, o0); o1 = mfma(vf[2 + sI], pf, o1);
  }
}

template <bool EDGE>
DI void attn_step_lds(const bf16_t* sKt, const bf16_t* sVt, const bf16x8 (&qf)[4], int k0, int tq, int lo, bool bit, int l32, int kb,
                      f32x16& o0, f32x16& o1, float& m, float& l) {
  constexpr float CS = 0.125f * 1.4426950408889634f;
  bf16x8 vf[4];
  f32x16 s = zero16();
#pragma unroll
  for (int i = 0; i < 4; ++i) { const bf16x8 kf = *(const bf16x8*)(sKt + l32 * 72 + i * 16 + kb * 8); s = mfma(kf, qf[i], s); }
  vf[0] = ld2x4(sVt + l32 * 72 + 4 * kb); vf[1] = ld2x4(sVt + l32 * 72 + 16 + 4 * kb);
  vf[2] = ld2x4(sVt + (32 + l32) * 72 + 4 * kb); vf[3] = ld2x4(sVt + (32 + l32) * 72 + 16 + 4 * kb);
  float tmax = -1e30f;
  if (EDGE) {
#pragma unroll
    for (int r = 0; r < 16; ++r) {
      const int key = k0 + crow(r, kb);
      const bool vd = (key <= tq) && (key > lo);
      s[r] = vd ? s[r] * CS : -1e30f;
      tmax = fmaxf(tmax, s[r]);
    }
  } else {
#pragma unroll
    for (int r = 0; r < 16; ++r) tmax = fmaxf(tmax, s[r]);
    tmax *= CS;
  }
  tmax = bit ? tmax : -1e30f;
  tmax = half_max(tmax);
  if (__ballot(tmax > m) != 0ull) {
    const float mn = fmaxf(m, tmax);
    const float alpha = __builtin_amdgcn_exp2f(m - mn);
    l *= alpha; m = mn;
#pragma unroll
    for (int r = 0; r < 16; ++r) { o0[r] *= alpha; o1[r] *= alpha; }
  }
  const bool live = bit && (m > -5e29f);
  float ps = 0.f;
#pragma unroll
  for (int r = 0; r < 16; ++r) {
    const float e = EDGE ? __builtin_amdgcn_exp2f(s[r] - m) : __builtin_amdgcn_exp2f(__builtin_fmaf(s[r], CS, -m));
    s[r] = live ? e : 0.f;
    ps += s[r];
  }
  l += ps;
#pragma unroll
  for (int sI = 0; sI < 2; ++sI) {
    const bf16x8 pf = pack8(s[8 * sI], s[8 * sI + 1], s[8 * sI + 2], s[8 * sI + 3], s[8 * sI + 4], s[8 * sI + 5], s[8 * sI + 6], s[8 * sI + 7]);
    o0 = mfma(vf[sI], pf, o0); o1 = mfma(vf[2 + sI], pf, o1);
  }
}

template <bool WIN>
DI void nsa_branch(const bf16_t* kbase, const bf16_t* vtb, char* smem, int st0, int st1, int qt, int tq, const bf16x8 (&qf)[4],
                   unsigned mk0, unsigned mk1, unsigned mk2, unsigned mk3, f32x16& o0, f32x16& o1, float& m, float& l) {
  const int tid = TIDX, lane = tid & 63, l32 = lane & 31, kb = lane >> 5;
  const int srow = tid >> 3, schunk = (tid & 7) * 8;
  const bf16_t* kg = kbase + (size_t)srow * PW + schunk;
  const bf16_t* vg = vtb + (size_t)srow * SEQ + schunk;
  const int soff = (srow * 72 + schunk) * 2;
  u32x4 rk = *(const u32x4*)(kg + (size_t)st0 * 64 * PW), rv = *(const u32x4*)(vg + st0 * 64);
  *(u32x4*)(smem + soff) = rk; *(u32x4*)(smem + 9216 + soff) = rv;
  __syncthreads();
  for (int st = st0; st <= st1; ++st) {
    const int cur = (st - st0) & 1;
    if (st < st1) { rk = *(const u32x4*)(kg + (size_t)(st + 1) * 64 * PW); rv = *(const u32x4*)(vg + (st + 1) * 64); }
    const bf16_t* bK = (const bf16_t*)(smem + cur * 18432);
    const bf16_t* bV = (const bf16_t*)(smem + cur * 18432 + 9216);
    bool bit = true;
    if (!WIN) { const unsigned mw = st < 32 ? mk0 : (st < 64 ? mk1 : (st < 96 ? mk2 : mk3)); bit = (mw >> (st & 31)) & 1u; }
    const bool any = WIN ? true : (__ballot(bit) != 0ull);
#pragma unroll
    for (int tt = 0; tt < 2; ++tt) {
      const int kt = 2 * st + tt;
      const bool in_range = WIN ? (kt <= qt && kt >= qt - 16) : (kt <= qt);
      if (in_range && any) {
        const bool edge = WIN ? (kt == qt || kt == qt - 16) : (kt == qt);
        if (edge) attn_step_lds<true>(bK + tt * 32 * 72, bV + tt * 32, qf, kt * 32, tq, WIN ? tq - 512 : -1, bit, l32, kb, o0, o1, m, l);
        else attn_step_lds<false>(bK + tt * 32 * 72, bV + tt * 32, qf, kt * 32, tq, WIN ? tq - 512 : -1, bit, l32, kb, o0, o1, m, l);
      }
    }
    if (st < st1) { *(u32x4*)(smem + (cur ^ 1) * 18432 + soff) = rk; *(u32x4*)(smem + (cur ^ 1) * 18432 + 9216 + soff) = rv; }
    __syncthreads();
  }
}

DI void nsa_block(const Params& P, int b, int g, int qb, char* smem) {
  const int wv = __builtin_amdgcn_readfirstlane(TIDX >> 6);
  const int qt = qb * 8 + wv;
  float* imp = (float*)smem + wv * 4096;
  const bf16_t* proj = (const bf16_t*)(P.ws + R1);
  bf16_t* mix = (bf16_t*)(P.ws + R3);
  const int lane = TIDX & 63, l32 = lane & 31, kb = lane >> 5;
  const int t0 = qt * 32, tq = t0 + l32;
  const size_t tokq = (size_t)b * SEQ + tq;
  const bf16_t* qrow = proj + tokq * PW;
  const bf16_t* kcmp = (const bf16_t*)(P.ws + R_KCMP) + (size_t)(b * 2 + g) * 512 * 64;
  const bf16_t* vcmpT = (const bf16_t*)(P.ws + R_VCMPT) + (size_t)(b * 2 + g) * 64 * 512;
  for (int i = lane; i < 4096; i += 64) imp[i] = 0.f;
  const int nct = (qt >> 4) + 1;
  for (int hh = 0; hh < 4; ++hh) {
    const int head = g * 4 + hh;
    bf16x8 qf[4];
#pragma unroll
    for (int i = 0; i < 4; ++i) qf[i] = *(const bf16x8*)(qrow + C_NQ + head * 64 + i * 16 + kb * 8);
    float m = -1e30f, l = 0.f;
    for (int ct = 0; ct < nct; ++ct) {
      f32x16 s = qk_tile(kcmp + (size_t)(ct * 32 + l32) * 64 + kb * 8, qf);
      float tmax = -1e30f;
#pragma unroll
      for (int r = 0; r < 16; ++r) {
        const int c = ct * 32 + crow(r, kb);
        const bool vd = (c * 16 + 31 <= tq);
        s[r] = vd ? s[r] * 0.125f : -1e30f;
        tmax = fmaxf(tmax, s[r]);
      }
      const float mn = fmaxf(m, tmax);
      float ps = 0.f;
#pragma unroll
      for (int r = 0; r < 16; ++r) ps += (s[r] > -5e29f) ? __expf(s[r] - mn) : 0.f;
      l = l * __expf(m - mn) + ps; m = mn;
    }
    const float mo = __shfl_xor(m, 32), lo_ = __shfl_xor(l, 32);
    const float M = fmaxf(m, mo);
    const float L = l * __expf(m - M) + lo_ * __expf(mo - M);
    const float invL = 1.f / fmaxf(L, 1e-30f);
    f32x16 o0 = zero16(), o1 = zero16();
    float carry = 0.f;
    for (int ct = 0; ct < nct; ++ct) {
      f32x16 s = qk_tile(kcmp + (size_t)(ct * 32 + l32) * 64 + kb * 8, qf);
#pragma unroll
      for (int r = 0; r < 16; ++r) {
        const int c = ct * 32 + crow(r, kb);
        const bool vd = (c * 16 + 31 <= tq);
        s[r] = vd ? __expf(s[r] * 0.125f - M) * invL : 0.f;
      }
      float y[4];
#pragma unroll
      for (int gi = 0; gi < 4; ++gi) y[gi] = __shfl_xor(s[4 * gi + 3], 32);
#pragma unroll
      for (int gi = 0; gi < 4; ++gi) {
        const float s4 = (s[4 * gi] + s[4 * gi + 1]) + (s[4 * gi + 2] + s[4 * gi + 3]);
        const float extra = kb ? y[gi] : (gi == 0 ? carry : y[gi > 0 ? gi - 1 : 0]);
        const int j = ct * 8 + 2 * gi + kb;
        imp[j * 32 + l32] += s4 + extra;
      }
      carry = y[3];
#pragma unroll
      for (int sI = 0; sI < 2; ++sI) {
        const bf16x8 pf = pack8(s[8 * sI], s[8 * sI + 1], s[8 * sI + 2], s[8 * sI + 3], s[8 * sI + 4], s[8 * sI + 5], s[8 * sI + 6], s[8 * sI + 7]);
        const bf16x8 va = ld2x4(vcmpT + (size_t)(l32)*512 + ct * 32 + 16 * sI + 4 * kb);
        const bf16x8 vb = ld2x4(vcmpT + (size_t)(32 + l32) * 512 + ct * 32 + 16 * sI + 4 * kb);
        o0 = mfma(va, pf, o0); o1 = mfma(vb, pf, o1);
      }
    }
    const float g0 = sigmoidf_(bf2f(qrow[C_NG + head * 3 + 0]) + P.nsa_gate_b[head * 3 + 0]);
#pragma unroll
    for (int gq = 0; gq < 4; ++gq) {
      u32x2 u0, u1;
      u0[0] = pk2(g0 * o0[gq * 4], g0 * o0[gq * 4 + 1]); u0[1] = pk2(g0 * o0[gq * 4 + 2], g0 * o0[gq * 4 + 3]);
      u1[0] = pk2(g0 * o1[gq * 4], g0 * o1[gq * 4 + 1]); u1[1] = pk2(g0 * o1[gq * 4 + 2], g0 * o1[gq * 4 + 3]);
      *(u32x2*)(mix + tokq * DM + 512 + head * 64 + 8 * gq + 4 * kb) = u0;
      *(u32x2*)(mix + tokq * DM + 512 + head * 64 + 32 + 8 * gq + 4 * kb) = u1;
    }
  }
  asm volatile("s_waitcnt lgkmcnt(0)" ::: "memory");
  __builtin_amdgcn_wave_barrier();
  unsigned mk0 = 0, mk1 = 0, mk2 = 0, mk3 = 0;
  for (int q = 0; q < 32; ++q) {
    const int tqq = t0 + q, cur = tqq >> 6;
    const float v0 = imp[lane * 32 + q], v1 = imp[(lane + 64) * 32 + q];
    const int j0 = lane, j1 = lane + 64;
    const float s0 = (j0 == 0 || j0 == cur || j0 == cur - 1) ? 1e30f : (j0 <= cur ? v0 : -1e30f);
    const float s1 = (j1 == cur || j1 == cur - 1) ? 1e30f : (j1 <= cur ? v1 : -1e30f);
    int c0 = 0, c1 = 0;
#pragma unroll
    for (int k = 0; k < 64; ++k) {
      const float a0 = __int_as_float(__builtin_amdgcn_readlane(__float_as_int(s0), k));
      const float a1 = __int_as_float(__builtin_amdgcn_readlane(__float_as_int(s1), k));
      c0 += ((a0 > s0) || (a0 == s0 && k < lane)) ? 1 : 0;
      c0 += (a1 > s0) ? 1 : 0;
      c1 += (a0 >= s1) ? 1 : 0;
      c1 += ((a1 > s1) || (a1 == s1 && k < lane)) ? 1 : 0;
    }
    const bool sel0 = (s0 > -5e29f) && (c0 < 16);
    const bool sel1 = (s1 > -5e29f) && (c1 < 16);
    const unsigned long long blo = __ballot(sel0), bhi = __ballot(sel1);
    if (l32 == q) { mk0 = (unsigned)blo; mk1 = (unsigned)(blo >> 32); mk2 = (unsigned)bhi; mk3 = (unsigned)(bhi >> 32); }
  }
  asm volatile("" ::: "memory");
  __syncthreads();
  const bf16_t* ksel = proj + (size_t)b * SEQ * PW + C_KS + g * 64;
  const bf16_t* kwin = proj + (size_t)b * SEQ * PW + C_KW + g * 64;
  const bf16_t* vsT = (const bf16_t*)(P.ws + R_VST) + (size_t)(b * 2 + g) * 64 * SEQ;
  const bf16_t* vwT = (const bf16_t*)(P.ws + R_VWT) + (size_t)(b * 2 + g) * 64 * SEQ;
  const int st1 = 4 * qb + 3, wst0 = qb > 2 ? 4 * qb - 8 : 0;
  for (int hh = 0; hh < 4; ++hh) {
    const int head = g * 4 + hh;
    bf16x8 qf[4];
#pragma unroll
    for (int i = 0; i < 4; ++i) qf[i] = *(const bf16x8*)(qrow + C_NQ + head * 64 + i * 16 + kb * 8);
    f32x16 a0 = zero16(), a1 = zero16(); float m = -1e30f, l = 0.f;
    nsa_branch<false>(ksel, vsT, smem, 0, st1, qt, tq, qf, mk0, mk1, mk2, mk3, a0, a1, m, l);
    float lt = half_sum(l);
    const float g1 = sigmoidf_(bf2f(qrow[C_NG + head * 3 + 1]) + P.nsa_gate_b[head * 3 + 1]);
    const float f1 = g1 / fmaxf(lt, 1e-30f);
#pragma unroll
    for (int gq = 0; gq < 4; ++gq) {
      bf16_t* d0 = mix + tokq * DM + 512 + head * 64 + 8 * gq + 4 * kb;
      bf16_t* d1 = d0 + 32;
      const u32x2 p0 = *(const u32x2*)d0, p1 = *(const u32x2*)d1;
      u32x2 u0, u1;
      u0[0] = pk2(bflo(p0[0]) + f1 * a0[gq * 4], bfhi(p0[0]) + f1 * a0[gq * 4 + 1]);
      u0[1] = pk2(bflo(p0[1]) + f1 * a0[gq * 4 + 2], bfhi(p0[1]) + f1 * a0[gq * 4 + 3]);
      u1[0] = pk2(bflo(p1[0]) + f1 * a1[gq * 4], bfhi(p1[0]) + f1 * a1[gq * 4 + 1]);
      u1[1] = pk2(bflo(p1[1]) + f1 * a1[gq * 4 + 2], bfhi(p1[1]) + f1 * a1[gq * 4 + 3]);
      *(u32x2*)d0 = u0; *(u32x2*)d1 = u1;
    }
    a0 = zero16(); a1 = zero16(); m = -1e30f; l = 0.f;
    nsa_branch<true>(kwin, vwT, smem, wst0, st1, qt, tq, qf, 0u, 0u, 0u, 0u, a0, a1, m, l);
    lt = half_sum(l);
    const float g2 = sigmoidf_(bf2f(qrow[C_NG + head * 3 + 2]) + P.nsa_gate_b[head * 3 + 2]);
    const float f2 = g2 / fmaxf(lt, 1e-30f);
#pragma unroll
    for (int gq = 0; gq < 4; ++gq) {
      bf16_t* d0 = mix + tokq * DM + 512 + head * 64 + 8 * gq + 4 * kb;
      bf16_t* d1 = d0 + 32;
      const u32x2 p0 = *(const u32x2*)d0, p1 = *(const u32x2*)d1;
      u32x2 u0, u1;
      u0[0] = pk2(bflo(p0[0]) + f2 * a0[gq * 4], bfhi(p0[0]) + f2 * a0[gq * 4 + 1]);
      u0[1] = pk2(bflo(p0[1]) + f2 * a0[gq * 4 + 2], bfhi(p0[1]) + f2 * a0[gq * 4 + 3]);
      u1[0] = pk2(bflo(p1[0]) + f2 * a1[gq * 4], bfhi(p1[0]) + f2 * a1[gq * 4 + 1]);
      u1[1] = pk2(bflo(p1[1]) + f2 * a1[gq * 4 + 2], bfhi(p1[1]) + f2 * a1[gq * 4 + 3]);
      *(u32x2*)d0 = u0; *(u32x2*)d1 = u1;
    }
  }
}

DI s16x4 lds_tr(const char* p) { return __builtin_amdgcn_ds_read_tr16_b64_v4i16((__attribute__((address_space(3))) s16x4*)p); }
DI void sgu_item(const Params& P, int item, char* smem) {
  const bf16_t* H = (const bf16_t*)(P.ws + R1);
  bf16_t* Y = (bf16_t*)P.out;
  float* smu = (float*)smem; float* srs = smu + 128; float* sc1 = srs + 128; float* srw = sc1 + 128;
  bf16_t* sW = (bf16_t*)(smem + 2048);
  char* sV = smem + 2048 + 34816;
  const int tid = TIDX, lane = tid & 63, wave = __builtin_amdgcn_readfirstlane(tid >> 6), l32 = lane & 31, kb = lane >> 5;
  const size_t tok0 = (size_t)item * 128;
#pragma unroll 1
  for (int tb = 0; tb < 16; tb += 4) {
    u32x4 uu[4][4];
#pragma unroll
    for (int a = 0; a < 4; ++a)
#pragma unroll
      for (int k = 0; k < 4; ++k) uu[a][k] = *(const u32x4*)(H + (tok0 + wave * 16 + tb + a) * 4096 + 2048 + k * 512 + lane * 8);
#pragma unroll
    for (int a = 0; a < 4; ++a) {
      float sm = 0.f, s2 = 0.f;
#pragma unroll
      for (int k = 0; k < 4; ++k)
#pragma unroll
        for (int e = 0; e < 4; ++e) { const float x0 = bflo(uu[a][k][e]), x1 = bfhi(uu[a][k][e]); sm += x0 + x1; s2 += x0 * x0 + x1 * x1; }
      sm = wave_sum(sm); s2 = wave_sum(s2);
      const float mu = sm * (1.f / 2048.f);
      const float var = fmaxf(s2 * (1.f / 2048.f) - mu * mu, 0.f);
      if (lane == 0) { smu[wave * 16 + tb + a] = mu; srs[wave * 16 + tb + a] = rsqrtf(var + EPS); }
    }
  }
  __syncthreads();
  const int srow = tid >> 5, schunk = tid & 31;
#pragma unroll 1
  for (int g = 0; g < 8; ++g) {
    u32x4 vreg[8], ureg[8];
#pragma unroll
    for (int i = 0; i < 8; ++i) {
      const bf16_t* hp = H + (tok0 + srow + 16 * i) * 4096 + g * 256 + schunk * 8;
      vreg[i] = *(const u32x4*)(hp + 2048);
      ureg[i] = *(const u32x4*)hp;
    }
    {
      const int t = tid >> 2, qr = tid & 3;
      const float* wrow = P.o_w_s + ((size_t)g * 128 + t) * 128 + qr * 32;
      float c1 = 0.f, rw = 0.f;
#pragma unroll 1
      for (int c8 = 0; c8 < 4; ++c8) {
        const float4 f0 = *(const float4*)(wrow + c8 * 8), f1 = *(const float4*)(wrow + c8 * 8 + 4);
        float wv[8] = {f0.x, f0.y, f0.z, f0.w, f1.x, f1.y, f1.z, f1.w};
        float ov[8];
#pragma unroll
        for (int e = 0; e < 8; ++e) {
          const int sx = qr * 32 + c8 * 8 + e;
          const float w = (sx <= t) ? wv[e] : 0.f;
          rw += w;
          const float wp = bf2f(f2bf(w * srs[sx]));
          c1 += wp * smu[sx];
          ov[e] = wp;
        }
        u32x4 o; o[0] = pk2(ov[0], ov[1]); o[1] = pk2(ov[2], ov[3]); o[2] = pk2(ov[4], ov[5]); o[3] = pk2(ov[6], ov[7]);
        *(u32x4*)(sW + t * 136 + qr * 32 + c8 * 8) = o;
      }
      c1 += __shfl_xor(c1, 1); rw += __shfl_xor(rw, 1);
      c1 += __shfl_xor(c1, 2); rw += __shfl_xor(rw, 2);
      if (qr == 0) { sc1[t] = c1; srw[t] = rw; }
    }
#pragma unroll
    for (int i = 0; i < 8; ++i) *(u32x4*)(sV + (srow + 16 * i) * 544 + schunk * 16) = vreg[i];
    __syncthreads();
    const int tt = wave & 3, chh = wave >> 2;
    f32x16 acc[4];
#pragma unroll
    for (int c = 0; c < 4; ++c) acc[c] = zero16();
    {
      const int i16 = lane & 15, q = i16 >> 2, p = i16 & 3, gc = (lane >> 4) & 1;
      const char* vb = sV + (8 * kb + q) * 544 + (chh * 128 + gc * 16 + 4 * p) * 2;
      const bf16_t* wb = sW + (tt * 32 + l32) * 136 + kb * 8;
      const int nks = 2 * (tt + 1);
      for (int ks = 0; ks < nks; ++ks) {
        const bf16x8 wf = *(const bf16x8*)(wb + ks * 16);
#pragma unroll
        for (int c = 0; c < 4; ++c) {
          const s16x4 lo = lds_tr(vb + ks * 16 * 544 + c * 64);
          const s16x4 hi = lds_tr(vb + (ks * 16 + 4) * 544 + c * 64);
          const bf16x8 vf = __builtin_shufflevector(lo, hi, 0, 1, 2, 3, 4, 5, 6, 7);
          acc[c] = mfma(vf, wf, acc[c]);
        }
      }
    }
    __syncthreads();
    {
      const int t = tt * 32 + l32;
      const float c1 = sc1[t], rw = srw[t], bs = P.o_b_s[g * 128 + t];
#pragma unroll
      for (int c = 0; c < 4; ++c)
#pragma unroll
        for (int gq = 0; gq < 4; ++gq) {
          const int chl = (chh * 4 + c) * 32 + 8 * gq + 4 * kb;
          const float4 lg = *(const float4*)(P.o_ln_g + g * 256 + chl), lb = *(const float4*)(P.o_ln_b + g * 256 + chl);
          const float m0 = lg.x * (acc[c][gq * 4 + 0] - c1) + lb.x * rw + bs;
          const float m1 = lg.y * (acc[c][gq * 4 + 1] - c1) + lb.y * rw + bs;
          const float m2 = lg.z * (acc[c][gq * 4 + 2] - c1) + lb.z * rw + bs;
          const float m3 = lg.w * (acc[c][gq * 4 + 3] - c1) + lb.w * rw + bs;
          u32x2 o; o[0] = pk2(m0, m1); o[1] = pk2(m2, m3);
          *(u32x2*)(sV + t * 520 + chl * 2) = o;
        }
    }
    __syncthreads();
#pragma unroll
    for (int i = 0; i < 8; ++i) {
      const char* mp = sV + (srow + 16 * i) * 520 + schunk * 16;
      const u32x2 ma = *(const u32x2*)mp, mb = *(const u32x2*)(mp + 8);
      const u32x4 uu = ureg[i];
      u32x4 o;
      o[0] = pk2(bflo(uu[0]) * bflo(ma[0]), bfhi(uu[0]) * bfhi(ma[0]));
      o[1] = pk2(bflo(uu[1]) * bflo(ma[1]), bfhi(uu[1]) * bfhi(ma[1]));
      o[2] = pk2(bflo(uu[2]) * bflo(mb[0]), bfhi(uu[2]) * bfhi(mb[0]));
      o[3] = pk2(bflo(uu[3]) * bflo(mb[1]), bfhi(uu[3]) * bfhi(mb[1]));
      *(u32x4*)(Y + (tok0 + srow + 16 * i) * 2048 + g * 256 + schunk * 8) = o;
    }
    __syncthreads();
  }
}

constexpr int NPHASE = 17;
DI void run_phase(const Params& P, int ph, char* smem) {
  char* ws = P.ws;
  bf16_t* r1 = (bf16_t*)(ws + R1); bf16_t* r2 = (bf16_t*)(ws + R2); bf16_t* r3 = (bf16_t*)(ws + R3); bf16_t* r4 = (bf16_t*)(ws + R4);
  unsigned* cnt = (unsigned*)(ws + W_CNT);
  const int lane = TIDX & 63, wave = TIDX >> 6, half = TIDX >> 8;
  char* hsmem = smem + half * 65536;
  switch (ph) {
    case 0: phase_prep(P); break;
    case 1: gemm_run<0>(r2, (const bf16_t*)(ws + W_EIN), PW, 1024, r1, PW, smem); break;
    case 2: {
      nsa_transpose_v(P);
      if (blockIdx.x < 64) nsa_compress_task(P, blockIdx.x * WPB + wave);
      volatile int* s_item = (volatile int*)(smem + LDS_BYTES - 16);
      for (;;) {
        __syncthreads();
        if (TIDX == 0) *s_item = (int)atomicAdd(cnt + 0, 1u);
        __syncthreads();
        const int pair = *s_item;
        if (pair >= 2048) break;
        gla_p1_item(P, pair * 2 + half, hsmem);
      }
    } break;
    case 3: gla_scan(P);
    case 30: {
      volatile int* s_item = (volatile int*)(smem + 131072);
      for (;;) {
        __syncthreads();
        if (TIDX == 0) *s_item = (int)atomicAdd(cnt + 1, 1u);
        __syncthreads();
        const int it = *s_item;
        if (it >= 512) break;
        nsa_block(P, (it & 15) >> 1, it & 1, 31 - (it >> 4), smem);
      }
    } break;
    case 4:
      for (int item = blockIdx.x * 2 + half; item < 4096; item += gridDim.x * 2) gla_p3_item(P, item, hsmem);
      break;
    case 5: gemm_run<0>(r3, (const bf16_t*)(ws + W_EOUT), 1024, 1024, r4, 1024, smem); break;
    case 6: resnorm_rows<true, false>(r4, P.x, nullptr, nullptr, r3, P.norm_g + 1 * 1024, P.norm_g + 2 * 1024, r2); break;
    case 7: gemm_run<1>(r2, (const bf16_t*)(ws + W_FFN1_0), 4096, 1024, r1, 4096, smem); break;
    case 8: gemm_run<0>(r1, (const bf16_t*)(ws + W_FFN2_0), 1024, 4096, r4, 1024, smem); break;
    case 9: resnorm_rows<false, false>(r4, nullptr, r3, nullptr, r3, P.norm_g + 3 * 1024, P.norm_g + 4 * 1024, r2); break;
    case 10: gemm_run<2>(r2, (const bf16_t*)(ws + W_OIN), 4096, 1024, r1, 4096, smem); break;
    case 11:
      for (int item = blockIdx.x; item < 512; item += gridDim.x) sgu_item(P, item, smem);
      break;
    case 12: gemm_run<0>((const bf16_t*)P.out, (const bf16_t*)(ws + W_OOUT), 1024, 2048, r4, 1024, smem); break;
    case 13: resnorm_rows<false, false>(r4, nullptr, r3, nullptr, r3, P.norm_g + 5 * 1024, P.norm_g + 6 * 1024, r2); break;
    case 14: gemm_run<1>(r2, (const bf16_t*)(ws + W_FFN1_1), 4096, 1024, r1, 4096, smem); break;
    case 15: gemm_run<0>(r1, (const bf16_t*)(ws + W_FFN2_1), 1024, 4096, r4, 1024, smem); break;
    case 16: resnorm_rows<false, true>(r4, nullptr, r3, P.out, nullptr, P.norm_g + 7 * 1024, nullptr, nullptr); break;
    default: break;
  }
}

#if !MEGA
extern __shared__ __attribute__((aligned(16))) unsigned char lds_dyn[];
__global__ void __launch_bounds__(NTHR, 2) k_phase(Params P, int ph) {
  char* smem = (char*)lds_dyn;
  run_phase(P, ph, smem);
}
#endif

#if MEGA
extern __shared__ __attribute__((aligned(16))) unsigned char lds_dyn[];
__global__ void __launch_bounds__(NTHR, 2) k_mega(Params P) {
  char* smem = (char*)lds_dyn;
  cg::grid_group grid = cg::this_grid();
#ifndef PROBE
#define PROBE 0
#endif
#define GEMM_PH(n) run_phase(P, n, smem); grid.sync(); if (PROBE == 1) { run_phase(P, n, smem); grid.sync(); }
  run_phase(P, 0, smem); grid.sync();
  if (PROBE == 3) { run_phase(P, 0, smem); grid.sync(); }
  GEMM_PH(1)
  run_phase(P, 2, smem); grid.sync();
  if (PROBE == 4) { if (blockIdx.x == 0 && TIDX == 0) ((unsigned*)(P.ws + W_CNT))[0] = 0u; grid.sync(); run_phase(P, 2, smem); grid.sync(); }
  run_phase(P, 3, smem); grid.sync();
  if (PROBE == 2) {
    if (blockIdx.x == 0 && TIDX == 0) ((unsigned*)(P.ws + W_CNT))[1] = 0u;
    grid.sync();
    run_phase(P, 30, smem); grid.sync();
  }
  run_phase(P, 4, smem); grid.sync();
  if (PROBE == 5) { run_phase(P, 4, smem); grid.sync(); }
  GEMM_PH(5)
  run_phase(P, 6, smem); grid.sync();
  if (PROBE == 6) { run_phase(P, 6, smem); grid.sync(); run_phase(P, 6, smem); grid.sync(); run_phase(P, 6, smem); grid.sync(); }
  GEMM_PH(7)
  GEMM_PH(8)
  run_phase(P, 9, smem); grid.sync();
  GEMM_PH(10)
  run_phase(P, 11, smem); grid.sync();
  if (PROBE == 7) { run_phase(P, 11, smem); grid.sync(); }
  GEMM_PH(12)
  run_phase(P, 13, smem); grid.sync();
  GEMM_PH(14)
  GEMM_PH(15)
  run_phase(P, 16, smem);
}
#endif

extern "C" void kernel_launch(void* const* d_in, const int* in_sizes, int n_in, void* d_out, int out_size, void* d_ws, size_t ws_size,
                              hipStream_t stream) {
  Params p{};
  p.x = (const float*)d_in[0]; p.norm_g = (const float*)d_in[1]; p.ffn_w1 = (const float*)d_in[2]; p.ffn_w2 = (const float*)d_in[3];
  p.e_w_in = (const float*)d_in[4]; p.e_w_out = (const float*)d_in[5]; p.gla_w_gate = (const float*)d_in[6]; p.gla_b_gate = (const float*)d_in[7];
  p.gla_norm = (const float*)d_in[8]; p.nsa_gate_b = (const float*)d_in[9]; p.cmp_pos = (const float*)d_in[10]; p.cmp_w1 = (const float*)d_in[11];
  p.cmp_w2 = (const float*)d_in[12]; p.o_w_in = (const float*)d_in[13]; p.o_ln_g = (const float*)d_in[14]; p.o_ln_b = (const float*)d_in[15];
  p.o_w_s = (const float*)d_in[16]; p.o_b_s = (const float*)d_in[17]; p.o_w_out = (const float*)d_in[18];
  p.out = (float*)d_out; p.ws = (char*)d_ws;
  if (ws_size < 1024ull * MiB) { fprintf(stderr, "workspace too small: %zu\n", ws_size); return; }
  static int grid_blocks = 0;
  if (!grid_blocks) {
    int dev = 0, cus = 0, per_cu = 0;
    (void)hipGetDevice(&dev);
    (void)hipDeviceGetAttribute(&cus, hipDeviceAttributeMultiprocessorCount, dev);
#if MEGA
    if (hipFuncSetAttribute((const void*)k_mega, hipFuncAttributeMaxDynamicSharedMemorySize, LDS_BYTES) != hipSuccess) fprintf(stderr, "hipFuncSetAttribute failed\n");
    (void)hipOccupancyMaxActiveBlocksPerMultiprocessor(&per_cu, (const void*)k_mega, NTHR, LDS_BYTES);
#else
    if (hipFuncSetAttribute((const void*)k_phase, hipFuncAttributeMaxDynamicSharedMemorySize, LDS_BYTES) != hipSuccess) fprintf(stderr, "hipFuncSetAttribute failed\n");
    (void)hipOccupancyMaxActiveBlocksPerMultiprocessor(&per_cu, (const void*)k_phase, NTHR, LDS_BYTES);
#endif
    if (per_cu < 1) fprintf(stderr, "occupancy query returned %d\n", per_cu);
    grid_blocks = cus;
  }
#if MEGA
  void* args[] = {&p};
  hipError_t e = hipLaunchCooperativeKernel((void*)k_mega, dim3(grid_blocks), dim3(NTHR), args, LDS_BYTES, stream);
  if (e != hipSuccess) fprintf(stderr, "cooperative launch failed: %s (grid %d)\n", hipGetErrorString(e), grid_blocks);
#else
  for (int ph = 0; ph < NPHASE; ++ph) k_phase<<<grid_blocks, NTHR, LDS_BYTES, stream>>>(p, ph);
#endif
}
```

```cpp
#include <hip/hip_runtime.h>
#include <hip/hip_cooperative_groups.h>
#include <cstdio>
namespace cg = cooperative_groups;

#ifndef MEGA
#define MEGA 1
#endif

typedef unsigned short bf16_t;
typedef short bf16x8 __attribute__((ext_vector_type(8)));
typedef short s16x4 __attribute__((ext_vector_type(4)));
typedef float f32x16 __attribute__((ext_vector_type(16)));
typedef float f32v2 __attribute__((ext_vector_type(2)));
typedef __bf16 bf16v2 __attribute__((ext_vector_type(2)));
typedef unsigned u32x4 __attribute__((ext_vector_type(4)));
typedef unsigned u32x2 __attribute__((ext_vector_type(2)));
#define DI __device__ __forceinline__
DI int tid_opaque() { int t = threadIdx.x; asm volatile("" : "+v"(t)); return t; }
#define TIDX tid_opaque()

constexpr int T_TOK = 65536, SEQ = 8192, DM = 1024;
constexpr int PW = 3072;
constexpr int C_GQ = 0, C_GK = 256, C_GV = 512, C_GLR = 1024, C_GR = 1040, C_NQ = 1552, C_KC = 2064, C_VC = 2192,
              C_KS = 2320, C_VS = 2448, C_KW = 2576, C_VW = 2704, C_NG = 2832;
constexpr float EPS = 1e-6f;
constexpr int NTHR = 512, WPB = 8, LDS_BYTES = 131072 + 64;
constexpr size_t MiB = 1024ull * 1024ull;
constexpr size_t W_FFN1_0 = 0, W_FFN1_1 = 8 * MiB, W_FFN2_0 = 16 * MiB, W_FFN2_1 = 24 * MiB, W_EIN = 32 * MiB, W_EOUT = 38 * MiB,
                 W_OIN = 40 * MiB, W_OOUT = 48 * MiB, W_CW1 = 52 * MiB, W_CW2 = 53 * MiB, W_BIAS1 = 53 * MiB + 65536,
                 W_CNT = 53 * MiB + 131072;
constexpr size_t R1 = 64 * MiB, R2 = 576 * MiB, R3 = 704 * MiB, R4 = 832 * MiB, R5 = 960 * MiB;
constexpr size_t R_KCMP = R5, R_VCMPT = R5 + 1 * MiB, R_VST = R5 + 2 * MiB, R_VWT = R5 + 18 * MiB, R_DECAY = R5 + 34 * MiB;

struct Params {
  const float* x; const float* norm_g; const float* ffn_w1; const float* ffn_w2; const float* e_w_in; const float* e_w_out;
  const float* gla_w_gate; const float* gla_b_gate; const float* gla_norm; const float* nsa_gate_b; const float* cmp_pos;
  const float* cmp_w1; const float* cmp_w2; const float* o_w_in; const float* o_ln_g; const float* o_ln_b; const float* o_w_s;
  const float* o_b_s; const float* o_w_out;
  float* out; char* ws;
};

DI int crow(int r, int kb) { return (r & 3) + 8 * (r >> 2) + 4 * kb; }
DI f32x16 mfma(bf16x8 a, bf16x8 b, f32x16 c) { return __builtin_amdgcn_mfma_f32_32x32x16_bf16(a, b, c, 0, 0, 0); }
DI unsigned pk2(float a, float b) { f32v2 v = {a, b}; bf16v2 r = __builtin_convertvector(v, bf16v2); return __builtin_bit_cast(unsigned, r); }
DI bf16_t f2bf(float a) { return (bf16_t)(pk2(a, 0.f) & 0xffffu); }
DI float bf2f(bf16_t u) { return __uint_as_float(((unsigned)u) << 16); }
DI float bflo(unsigned u) { return __uint_as_float(u << 16); }
DI float bfhi(unsigned u) { return __uint_as_float(u & 0xffff0000u); }
DI bf16x8 pack8(float a0, float a1, float a2, float a3, float a4, float a5, float a6, float a7) {
  u32x4 p; p[0] = pk2(a0, a1); p[1] = pk2(a2, a3); p[2] = pk2(a4, a5); p[3] = pk2(a6, a7);
  return __builtin_bit_cast(bf16x8, p);
}
DI bf16x8 ld2x4(const bf16_t* p) {
  s16x4 lo = *(const s16x4*)p; s16x4 hi = *(const s16x4*)(p + 8);
  return __builtin_shufflevector(lo, hi, 0, 1, 2, 3, 4, 5, 6, 7);
}
DI float wave_sum(float v) {
#pragma unroll
  for (int o = 32; o > 0; o >>= 1) v += __shfl_xor(v, o);
  return v;
}
DI f32x16 zero16() { f32x16 z;
#pragma unroll
  for (int i = 0; i < 16; ++i) z[i] = 0.f; return z; }
DI float gelu_tanh(float x) { float u = 1.5957691216f * (x + 0.044715f * x * x * x); return x / (1.f + __expf(-u)); }
DI float sigmoidf_(float x) { return 1.f / (1.f + __expf(-x)); }

DI void conv_weight(const float* __restrict__ src, bf16_t* __restrict__ dst, int K, int N, int Npad) {
  const long total = (long)Npad * (K >> 3);
  const long stride = (long)gridDim.x * blockDim.x;
  for (long i = (long)blockIdx.x * blockDim.x + TIDX; i < total; i += stride) {
    const int n = (int)(i % Npad); const int k8 = (int)(i / Npad);
    float v[8];
#pragma unroll
    for (int j = 0; j < 8; ++j) v[j] = (n < N) ? src[(size_t)(k8 * 8 + j) * N + n] : 0.f;
    u32x4 o; o[0] = pk2(v[0], v[1]); o[1] = pk2(v[2], v[3]); o[2] = pk2(v[4], v[5]); o[3] = pk2(v[6], v[7]);
    *(u32x4*)(dst + (size_t)n * K + k8 * 8) = o;
  }
}

DI void prenorm_rows(const float* __restrict__ x, const float* __restrict__ g, bf16_t* __restrict__ xn) {
  const int lane = TIDX & 63, wave = TIDX >> 6;
  const int nw = gridDim.x * WPB;
  for (int row = blockIdx.x * WPB + wave; row < T_TOK; row += nw) {
    const float4* xr = (const float4*)(x + (size_t)row * DM);
    float4 a[4]; float ss = 0.f;
#pragma unroll
    for (int k = 0; k < 4; ++k) { a[k] = xr[k * 64 + lane]; ss += a[k].x * a[k].x + a[k].y * a[k].y + a[k].z * a[k].z + a[k].w * a[k].w; }
    ss = wave_sum(ss);
    const float rs = rsqrtf(ss * (1.f / DM) + EPS);
#pragma unroll
    for (int k = 0; k < 4; ++k) {
      const float4 gg = ((const float4*)g)[k * 64 + lane];
      u32x2 o; o[0] = pk2(a[k].x * rs * gg.x, a[k].y * rs * gg.y); o[1] = pk2(a[k].z * rs * gg.z, a[k].w * rs * gg.w);
      *(u32x2*)(xn + (size_t)row * DM + k * 256 + lane * 4) = o;
    }
  }
}

template <bool HIN_F32, bool HOUT_F32>
DI void resnorm_rows(const bf16_t* __restrict__ m, const float* __restrict__ hin_f, const bf16_t* hin_b, float* __restrict__ hout_f,
                     bf16_t* hout_b, const float* __restrict__ gpost, const float* __restrict__ gnext, bf16_t* __restrict__ xn) {
  const int lane = TIDX & 63, wave = TIDX >> 6;
  const int nw = gridDim.x * WPB;
  for (int row = blockIdx.x * WPB + wave; row < T_TOK; row += nw) {
    float mv[16]; float ss = 0.f;
#pragma unroll
    for (int k = 0; k < 4; ++k) {
      const u32x2 u = *(const u32x2*)(m + (size_t)row * DM + k * 256 + lane * 4);
      mv[k * 4 + 0] = bflo(u[0]); mv[k * 4 + 1] = bfhi(u[0]); mv[k * 4 + 2] = bflo(u[1]); mv[k * 4 + 3] = bfhi(u[1]);
    }
    float hv[16];
#pragma unroll
    for (int k = 0; k < 4; ++k) {
      if (HIN_F32) {
        const float4 h4 = ((const float4*)(hin_f + (size_t)row * DM))[k * 64 + lane];
        hv[k * 4 + 0] = h4.x; hv[k * 4 + 1] = h4.y; hv[k * 4 + 2] = h4.z; hv[k * 4 + 3] = h4.w;
      } else {
        const u32x2 u = *(const u32x2*)(hin_b + (size_t)row * DM + k * 256 + lane * 4);
        hv[k * 4 + 0] = bflo(u[0]); hv[k * 4 + 1] = bfhi(u[0]); hv[k * 4 + 2] = bflo(u[1]); hv[k * 4 + 3] = bfhi(u[1]);
      }
    }
#pragma unroll
    for (int i = 0; i < 16; ++i) ss += mv[i] * mv[i];
    ss = wave_sum(ss);
    const float rs = rsqrtf(ss * (1.f / DM) + EPS);
    float s2 = 0.f;
#pragma unroll
    for (int k = 0; k < 4; ++k) {
      const float4 gg = ((const float4*)gpost)[k * 64 + lane];
      hv[k * 4 + 0] += mv[k * 4 + 0] * rs * gg.x; hv[k * 4 + 1] += mv[k * 4 + 1] * rs * gg.y;
      hv[k * 4 + 2] += mv[k * 4 + 2] * rs * gg.z; hv[k * 4 + 3] += mv[k * 4 + 3] * rs * gg.w;
      if (HOUT_F32) {
        float4 o; o.x = hv[k * 4 + 0]; o.y = hv[k * 4 + 1]; o.z = hv[k * 4 + 2]; o.w = hv[k * 4 + 3];
        ((float4*)(hout_f + (size_t)row * DM))[k * 64 + lane] = o;
      } else {
        u32x2 o; o[0] = pk2(hv[k * 4 + 0], hv[k * 4 + 1]); o[1] = pk2(hv[k * 4 + 2], hv[k * 4 + 3]);
        *(u32x2*)(hout_b + (size_t)row * DM + k * 256 + lane * 4) = o;
      }
    }
    if (xn) {
#pragma unroll
      for (int i = 0; i < 16; ++i) s2 += hv[i] * hv[i];
      s2 = wave_sum(s2);
      const float r2 = rsqrtf(s2 * (1.f / DM) + EPS);
#pragma unroll
      for (int k = 0; k < 4; ++k) {
        const float4 gg = ((const float4*)gnext)[k * 64 + lane];
        u32x2 o; o[0] = pk2(hv[k * 4 + 0] * r2 * gg.x, hv[k * 4 + 1] * r2 * gg.y); o[1] = pk2(hv[k * 4 + 2] * r2 * gg.z, hv[k * 4 + 3] * r2 * gg.w);
        *(u32x2*)(xn + (size_t)row * DM + k * 256 + lane * 4) = o;
      }
    }
  }
}

DI void phase_prep(const Params& P) {
  char* ws = P.ws;
  conv_weight(P.ffn_w1, (bf16_t*)(ws + W_FFN1_0), 1024, 4096, 4096);
  conv_weight(P.ffn_w1 + (size_t)1024 * 4096, (bf16_t*)(ws + W_FFN1_1), 1024, 4096, 4096);
  conv_weight(P.ffn_w2, (bf16_t*)(ws + W_FFN2_0), 4096, 1024, 1024);
  conv_weight(P.ffn_w2 + (size_t)1024 * 4096, (bf16_t*)(ws + W_FFN2_1), 4096, 1024, 1024);
  conv_weight(P.e_w_in, (bf16_t*)(ws + W_EIN), 1024, 2856, PW);
  conv_weight(P.e_w_out, (bf16_t*)(ws + W_EOUT), 1024, 1024, 1024);
  conv_weight(P.o_w_in, (bf16_t*)(ws + W_OIN), 1024, 4096, 4096);
  conv_weight(P.o_w_out, (bf16_t*)(ws + W_OOUT), 2048, 1024, 1024);
  conv_weight(P.cmp_w1, (bf16_t*)(ws + W_CW1), 2048, 128, 128);
  conv_weight(P.cmp_w1 + 2048 * 128, (bf16_t*)(ws + W_CW1) + 128 * 2048, 2048, 128, 128);
  conv_weight(P.cmp_w2, (bf16_t*)(ws + W_CW2), 128, 64, 64);
  conv_weight(P.cmp_w2 + 128 * 64, (bf16_t*)(ws + W_CW2) + 64 * 128, 128, 64, 64);
  const int lane = TIDX & 63, wave = TIDX >> 6;
  const int gw = blockIdx.x * WPB + wave;
  if (gw < 256) {
    const int i = gw >> 7, hid = gw & 127;
    float s = 0.f;
    for (int kk = lane; kk < 2048; kk += 64) s += P.cmp_pos[i * 2048 + kk] * P.cmp_w1[((size_t)i * 2048 + kk) * 128 + hid];
    s = wave_sum(s);
    if (lane == 0) ((float*)(ws + W_BIAS1))[gw] = s;
  }
  const int gt = blockIdx.x * blockDim.x + TIDX;
  if (gt < 16) ((unsigned*)(ws + W_CNT))[gt] = 0u;
  if (gt < 16 * 64) {
    const int bg = gt >> 6, d = gt & 63;
    ((bf16_t*)(ws + R_KCMP))[((size_t)bg * 512 + 511) * 64 + d] = 0;
    ((bf16_t*)(ws + R_VCMPT))[((size_t)bg * 64 + d) * 512 + 511] = 0;
  }
  prenorm_rows(P.x, P.norm_g, (bf16_t*)(ws + R2));
}

namespace pg8 {
#define PG8_LAS __attribute__((address_space(3)))
typedef float f32x4 __attribute__((ext_vector_type(4)));
constexpr int BM = 256, BK = 64, HALF = 128, HTB = HALF * BK * 2, STAGE_BYTES = 8 * HTB, NXCD = 8, WGM = 8;
DI int lds_byte(int r, int c) { const int st = (r >> 4) * 2 + (c >> 5), rr = r & 15, cc = c & 31, ob = rr * 64 + cc * 2; return st * 1024 + (ob ^ (((ob >> 9) & 1) << 5)); }
DI void stage_rc(int b, int& R, int& C) { const int st = b / 1024, sb = b % 1024, swz = sb ^ (((sb >> 9) & 1) << 5); R = (st >> 1) * 16 + swz / 64; C = (st & 1) * 32 + (swz % 64) / 2; }
DI int perm32(int rho) { const int n = rho >> 4, i = rho & 15; return 8 * (i >> 2) + 4 * n + (i & 3); }
struct Unit { int pm, pn; };
struct Gemm { const bf16_t* A; const bf16_t* Bt; int M, N, K; };
struct StaticOrder {
  int nM, nN, nwg, G, c;
  DI void init(int M, int N, int G_, int c_) { nM = M / BM; nN = N / BM; nwg = nM * nN; G = G_; c = c_; }
  DI bool next(int i, Unit& u) const {
    const long L = (long)i * G + c; if (L >= nwg) return false;
    int wgid = (int)L; { const int q = nwg / NXCD, r = nwg % NXCD, xcd = wgid % NXCD, off = wgid / NXCD; wgid = (xcd < r ? xcd * (q + 1) : r * (q + 1) + (xcd - r) * q) + off; }
    const int nig = WGM * nN, gid = wgid / nig, fm = gid * WGM, gsz = (nM - fm) < WGM ? (nM - fm) : WGM;
    u.pm = fm + ((wgid % nig) % gsz); u.pn = (wgid % nig) / gsz; return true;
  }
};
template <int ACT> struct EpiB {
  static constexpr bool PERM = true;
  bf16_t* O; int ldc;
  DI void operator()(const f32x4 (&acc)[2][2][4][2], const Unit& u, int wr, int wc, int fr, int fq) const {
    const int row0 = u.pm * BM + wr * 64 + fr; const int col0 = u.pn * BM + wc * 32 + 8 * fq;
#pragma unroll
    for (int ai = 0; ai < 2; ++ai)
#pragma unroll
      for (int m = 0; m < 4; ++m) {
        bf16_t* rowp = O + (size_t)(row0 + ai * HALF + m * 16) * ldc + col0;
#pragma unroll
        for (int bj = 0; bj < 2; ++bj) {
          f32x4 v0 = acc[ai][bj][m][0], v1 = acc[ai][bj][m][1];
          if (ACT == 1) {
#pragma unroll
            for (int j = 0; j < 4; ++j) { const float a = fmaxf(v0[j], 0.f), b = fmaxf(v1[j], 0.f); v0[j] = a * a; v1[j] = b * b; }
          }
          if (ACT == 2) {
#pragma unroll
            for (int j = 0; j < 4; ++j) { v0[j] = gelu_tanh(v0[j]); v1[j] = gelu_tanh(v1[j]); }
          }
          u32x4 w; w[0] = pk2(v0[0], v0[1]); w[1] = pk2(v0[2], v0[3]); w[2] = pk2(v1[0], v1[1]); w[3] = pk2(v1[2], v1[3]);
          *(u32x4*)(rowp + bj * HALF) = w;
        }
      }
  }
};

template <class Epi, class Sched>
DI void gemm_phase(PG8_LAS unsigned char* lds, const Gemm g, const Sched& S, const Epi& E) {
  const int tid_ = TIDX;
  const int tid = tid_, wid = __builtin_amdgcn_readfirstlane(tid >> 6), lane = tid & 63, wr = wid >> 2, wc = wid & 3, fr = lane & 15, fq = lane >> 4;
  const int K = g.K, nt = K / BK;
  unsigned voffA[2], voffB[2];
#pragma unroll
  for (int i = 0; i < 2; ++i) { int R, C; stage_rc(tid * 16 + i * 8192, R, C); const int Rb = Epi::PERM ? ((R & ~31) + perm32(R & 31)) : R;
    voffA[i] = (unsigned)(R * K + C) * 2u; voffB[i] = (unsigned)(Rb * K + C) * 2u; }
  const size_t kstep = (size_t)(BK * 2);
  const size_t hstep = (size_t)HALF * K * 2;
  const size_t tstep = 2 * hstep;
  const unsigned ldsw = (unsigned)wid * 1024u;
  const int aoff = lds_byte(wr * 64 + fr, fq * 8), boff = lds_byte(wc * 32 + fr, fq * 8);
#define PG8_SA(b, h) (((b) * 2 + (h)) * HTB)
#define PG8_SB(b, h) ((4 + (b) * 2 + (h)) * HTB)
#define PG8_STAGE(bufoff, gbase, voff) do { _Pragma("unroll") for (int _i = 0; _i < 2; ++_i) \
    __builtin_amdgcn_global_load_lds((const unsigned*)((const char*)(gbase) + (voff)[_i]), (PG8_LAS unsigned*)(lds + (bufoff) + ldsw + _i * 8192), 16, 0, 0); } while (0)
#define PG8_LDA(dst, b, h) do { _Pragma("unroll") for (int m = 0; m < 4; ++m) _Pragma("unroll") for (int k = 0; k < 2; ++k) dst[m][k] = *(const PG8_LAS bf16x8*)(lds + PG8_SA(b, h) + aoff + m * 2048 + k * 1024); } while (0)
#define PG8_LDB(dst, b, h) do { _Pragma("unroll") for (int n = 0; n < 2; ++n) _Pragma("unroll") for (int k = 0; k < 2; ++k) dst[n][k] = *(const PG8_LAS bf16x8*)(lds + PG8_SB(b, h) + boff + n * 2048 + k * 1024); } while (0)
#define PG8_MMA(ai, bj, At, Bt) do { __builtin_amdgcn_s_setprio(1); _Pragma("unroll") for (int m = 0; m < 4; ++m) _Pragma("unroll") for (int n = 0; n < 2; ++n) _Pragma("unroll") for (int k = 0; k < 2; ++k) \
    acc[ai][bj][m][n] = __builtin_amdgcn_mfma_f32_16x16x32_bf16(Bt[n][k], At[m][k], acc[ai][bj][m][n], 0, 0, 0); __builtin_amdgcn_s_setprio(0); } while (0)
#define PG8_WAIT_V(n) asm volatile("s_waitcnt vmcnt(" #n ")" ::: "memory")
#define PG8_WAIT_L(n) asm volatile("s_waitcnt lgkmcnt(" #n ")" ::: "memory")
#define PG8_BAR __builtin_amdgcn_s_barrier()
#define PG8_SCHED __builtin_amdgcn_sched_barrier(0)
  Unit cur, nxt; int ui = 0;
  if (!S.next(0, cur)) return;
  f32x4 acc[2][2][4][2];
#pragma unroll
  for (int a = 0; a < 2; ++a)
#pragma unroll
    for (int b = 0; b < 2; ++b)
#pragma unroll
      for (int m = 0; m < 4; ++m)
#pragma unroll
        for (int n = 0; n < 2; ++n) acc[a][b][m][n] = (f32x4){0.f, 0.f, 0.f, 0.f};
  bf16x8 At[4][2], B0[2][2], B1[2][2];
  const char* cA = (const char*)g.A + (size_t)cur.pm * tstep; const char* cB = (const char*)g.Bt + (size_t)cur.pn * tstep;
  PG8_STAGE(PG8_SB(0, 0), cB, voffB); PG8_STAGE(PG8_SA(0, 0), cA, voffA); PG8_STAGE(PG8_SB(0, 1), cB + hstep, voffB); PG8_STAGE(PG8_SA(0, 1), cA + hstep, voffA);
  if (wr == 1) PG8_BAR;
  PG8_WAIT_V(4); PG8_BAR;
  PG8_STAGE(PG8_SB(1, 0), cB + kstep, voffB); PG8_STAGE(PG8_SA(1, 0), cA + kstep, voffA); PG8_STAGE(PG8_SB(1, 1), cB + hstep + kstep, voffB);
  PG8_WAIT_V(6); PG8_BAR;
  for (;;) {
    const bool has_next = S.next(ui + 1, nxt);
    const char* nA = has_next ? (const char*)g.A + (size_t)nxt.pm * tstep : cA; const char* nB = has_next ? (const char*)g.Bt + (size_t)nxt.pn * tstep : cB;
    for (int t = 0; t < nt; t += 2) {
      const bool last = (t == nt - 2);
      const char* a1 = cA + (size_t)(t + 1) * kstep;
      const char* a2 = last ? nA : cA + (size_t)(t + 2) * kstep; const char* b2 = last ? nB : cB + (size_t)(t + 2) * kstep;
      const char* a3 = a2 + kstep; const char* b3 = b2 + kstep;
      PG8_LDB(B0, 0, 0); PG8_SCHED; PG8_LDA(At, 0, 0); PG8_STAGE(PG8_SA(1, 1), a1 + hstep, voffA);
      PG8_WAIT_L(8); PG8_BAR; PG8_WAIT_L(0); PG8_MMA(0, 0, At, B0); PG8_BAR; PG8_SCHED;
      PG8_LDB(B1, 0, 1); PG8_STAGE(PG8_SB(0, 0), b2, voffB);
      PG8_BAR; PG8_WAIT_L(0); PG8_MMA(0, 1, At, B1); PG8_BAR;
      PG8_LDA(At, 0, 1); PG8_STAGE(PG8_SA(0, 0), a2, voffA);
      PG8_BAR; PG8_WAIT_L(0); PG8_MMA(1, 0, At, B0); PG8_BAR; PG8_SCHED;
      PG8_STAGE(PG8_SB(0, 1), b2 + hstep, voffB);
      PG8_WAIT_V(6); PG8_BAR; PG8_MMA(1, 1, At, B1); PG8_BAR;
      PG8_LDB(B0, 1, 0); PG8_SCHED; PG8_LDA(At, 1, 0); PG8_STAGE(PG8_SA(0, 1), a2 + hstep, voffA);
      PG8_WAIT_L(8); PG8_BAR; PG8_WAIT_L(0); PG8_MMA(0, 0, At, B0); PG8_BAR; PG8_SCHED;
      PG8_LDB(B1, 1, 1); PG8_STAGE(PG8_SB(1, 0), b3, voffB);
      PG8_BAR; PG8_WAIT_L(0); PG8_MMA(0, 1, At, B1); PG8_BAR;
      PG8_LDA(At, 1, 1); PG8_STAGE(PG8_SA(1, 0), a3, voffA);
      PG8_BAR; PG8_WAIT_L(0); PG8_MMA(1, 0, At, B0); PG8_BAR; PG8_SCHED;
      PG8_STAGE(PG8_SB(1, 1), b3 + hstep, voffB);
      PG8_WAIT_V(6); PG8_BAR; PG8_MMA(1, 1, At, B1); PG8_BAR;
    }
    E(acc, cur, wr, wc, fr, fq);
    if (!has_next) break;
#pragma unroll
    for (int a = 0; a < 2; ++a)
#pragma unroll
      for (int b = 0; b < 2; ++b)
#pragma unroll
        for (int m = 0; m < 4; ++m)
#pragma unroll
          for (int n = 0; n < 2; ++n) acc[a][b][m][n] = (f32x4){0.f, 0.f, 0.f, 0.f};
    cur = nxt; cA = nA; cB = nB; ++ui;
  }
  PG8_WAIT_V(0);
  if (wr == 0) PG8_BAR;
  PG8_BAR;
#undef PG8_SA
#undef PG8_SB
#undef PG8_STAGE
#undef PG8_LDA
#undef PG8_LDB
#undef PG8_MMA
#undef PG8_WAIT_V
#undef PG8_WAIT_L
#undef PG8_BAR
#undef PG8_SCHED
}
}

template <int ACT>
DI void gemm_run(const bf16_t* A, const bf16_t* Bt, int N, int K, bf16_t* C, int ldc, char* smem) {
  pg8::Gemm g; g.A = A; g.Bt = Bt; g.M = T_TOK; g.N = N; g.K = K;
  pg8::StaticOrder S; S.init(T_TOK, N, (int)gridDim.x, (int)blockIdx.x);
  pg8::EpiB<ACT> E; E.O = C; E.ldc = ldc;
  pg8::gemm_phase(( PG8_LAS unsigned char*)smem, g, S, E);
  __syncthreads();
}

DI void gla_gates(const Params& P, const bf16_t* proj, int b, int h, int n, float* sb, float* sseg, float* tmp) {
  const int tid = TIDX & 255;
  float* sw = tmp;
  float* sg = tmp + 1024;
  {
    for (int e = tid; e < 1024; e += 256) sw[e] = P.gla_w_gate[(e >> 6) * 256 + h * 64 + (e & 63)];
    const int i = tid >> 2, part = tid & 3;
    const size_t t = (size_t)b * SEQ + n * 64 + i;
    const u32x2 gu = *(const u32x2*)(proj + t * PW + C_GLR + part * 4);
    sg[i * 17 + part * 4 + 0] = bflo(gu[0]); sg[i * 17 + part * 4 + 1] = bfhi(gu[0]);
    sg[i * 17 + part * 4 + 2] = bflo(gu[1]); sg[i * 17 + part * 4 + 3] = bfhi(gu[1]);
  }
  __syncthreads();
  {
    const int i = tid & 63, dq = tid >> 6;
    float z[16];
#pragma unroll
    for (int dd = 0; dd < 16; ++dd) z[dd] = P.gla_b_gate[h * 64 + dq * 16 + dd];
#pragma unroll 1
    for (int r = 0; r < 16; ++r) {
      const float gv = sg[i * 17 + r];
#pragma unroll
      for (int dd = 0; dd < 16; ++dd) z[dd] += gv * sw[r * 64 + dq * 16 + dd];
    }
#pragma unroll
    for (int dd = 0; dd < 16; ++dd) {
      const float zz = z[dd];
      const float ls = fminf(zz, 0.f) - __logf(1.f + __expf(-fabsf(zz)));
      sb[i * 65 + dq * 16 + dd] = ls * (1.f / 16.f);
    }
  }
  __syncthreads();
  const int d = tid & 63, seg = tid >> 6;
  float pre[16]; float run = 0.f;
#pragma unroll
  for (int ii = 0; ii < 16; ++ii) { run += sb[(seg * 16 + ii) * 65 + d]; pre[ii] = run; }
  sseg[seg * 64 + d] = run;
  __syncthreads();
  float off = 0.f;
#pragma unroll
  for (int s = 0; s < 4; ++s) off += (s < seg) ? sseg[s * 64 + d] : 0.f;
#pragma unroll
  for (int ii = 0; ii < 16; ++ii) sb[(seg * 16 + ii) * 65 + d] = pre[ii] + off;
  __syncthreads();
}

DI void gla_stage_vT(const bf16_t* proj, int b, int h, int n, bf16_t* vT) {
  const int tid = TIDX & 255, j = tid & 63, q4 = tid >> 6;
  const size_t t = (size_t)b * SEQ + n * 64 + j;
  const bf16_t* src = proj + t * PW + C_GV + h * 128 + q4 * 32;
#pragma unroll
  for (int c = 0; c < 4; ++c) {
    const u32x4 u = *(const u32x4*)(src + c * 8);
#pragma unroll
    for (int e = 0; e < 4; ++e) {
      vT[(q4 * 32 + c * 8 + 2 * e) * 72 + j] = (bf16_t)(u[e] & 0xffffu);
      vT[(q4 * 32 + c * 8 + 2 * e + 1) * 72 + j] = (bf16_t)(u[e] >> 16);
    }
  }
}

DI void gla_p1_item(const Params& P, int item, char* smem) {
  const bf16_t* proj = (const bf16_t*)(P.ws + R1);
  float* states = (float*)(P.ws + R2);
  float* decay = (float*)(P.ws + R_DECAY);
  float* sb = (float*)smem; float* sseg = sb + 64 * 65;
  bf16_t* kendT = (bf16_t*)(sseg + 256); bf16_t* vT = kendT + 64 * 72;
  const int n = item & 127, h = (item >> 7) & 3, b = item >> 9;
  const int tid = TIDX & 255, lane = tid & 63, wave = tid >> 6, l32 = lane & 31, kb = lane >> 5;
  gla_gates(P, proj, b, h, n, sb, sseg, (float*)vT);
  {
    const int j = tid & 63, dq = tid >> 6;
    const size_t t = (size_t)b * SEQ + n * 64 + j;
    const u32x4 k0 = *(const u32x4*)(proj + t * PW + C_GK + h * 64 + dq * 16), k1 = *(const u32x4*)(proj + t * PW + C_GK + h * 64 + dq * 16 + 8);
    float kv[16];
#pragma unroll
    for (int e = 0; e < 4; ++e) { kv[2 * e] = bflo(k0[e]); kv[2 * e + 1] = bfhi(k0[e]); kv[8 + 2 * e] = bflo(k1[e]); kv[8 + 2 * e + 1] = bfhi(k1[e]); }
#pragma unroll
    for (int dd = 0; dd < 16; ++dd) {
      const int d = dq * 16 + dd;
      kendT[d * 72 + j] = f2bf(kv[dd] * __expf(sb[63 * 65 + d] - sb[j * 65 + d]));
    }
    if (tid < 64) decay[((size_t)(b * 4 + h) * 128 + n) * 64 + tid] = __expf(sb[63 * 65 + tid]);
  }
  gla_stage_vT(proj, b, h, n, vT);
  __syncthreads();
#pragma unroll
  for (int dt = 0; dt < 2; ++dt) {
    f32x16 acc = zero16();
#pragma unroll
    for (int s = 0; s < 4; ++s) {
      const bf16x8 a = *(const bf16x8*)(vT + (wave * 32 + l32) * 72 + s * 16 + kb * 8);
      const bf16x8 bb = *(const bf16x8*)(kendT + (dt * 32 + l32) * 72 + s * 16 + kb * 8);
      acc = mfma(a, bb, acc);
    }
    float* dst = states + ((size_t)((b * 4 + h) * 128 + n) * 128) * 64;
#pragma unroll
    for (int r = 0; r < 16; ++r) dst[(size_t)(wave * 32 + crow(r, kb)) * 64 + dt * 32 + l32] = acc[r];
  }
  __syncthreads();
}

DI void gla_scan(const Params& P) {
  float* states = (float*)(P.ws + R2);
  const float* decay = (const float*)(P.ws + R_DECAY);
  const int total = 32 * 8192;
  for (int e = blockIdx.x * blockDim.x + TIDX; e < total; e += gridDim.x * blockDim.x) {
    const int bh = e >> 13, idx = e & 8191, d = idx & 63;
    float* p = states + (size_t)bh * 128 * 8192 + idx;
    const float* dc = decay + (size_t)bh * 128 * 64 + d;
    float S = 0.f;
#pragma unroll 8
    for (int n = 0; n < 128; ++n) {
      const float ds = p[(size_t)n * 8192];
      const float dec = dc[n * 64];
      p[(size_t)n * 8192] = S;
      S = dec * S + ds;
    }
  }
}

DI void gla_p3_item(const Params& P, int item, char* smem) {
  const bf16_t* proj = (const bf16_t*)(P.ws + R1);
  const float* states = (const float*)(P.ws + R2);
  bf16_t* mix = (bf16_t*)(P.ws + R3);
  float* sb = (float*)smem; float* sseg = sb + 64 * 65; float* sred = sseg + 256;
  bf16_t* sq = (bf16_t*)(sred + 256); bf16_t* sk = sq + 64 * 72; bf16_t* vT = sk + 64 * 72;
  const int n = item & 127, h = (item >> 7) & 3, b = item >> 9;
  const int tid = TIDX & 255, lane = tid & 63, wave = tid >> 6, l32 = lane & 31, kb = lane >> 5;
  gla_gates(P, proj, b, h, n, sb, sseg, (float*)vT);
  {
    const int i = tid & 63, dq = tid >> 6;
    const size_t t = (size_t)b * SEQ + n * 64 + i;
    const u32x4 q0 = *(const u32x4*)(proj + t * PW + C_GQ + h * 64 + dq * 16), q1 = *(const u32x4*)(proj + t * PW + C_GQ + h * 64 + dq * 16 + 8);
    const u32x4 k0 = *(const u32x4*)(proj + t * PW + C_GK + h * 64 + dq * 16), k1 = *(const u32x4*)(proj + t * PW + C_GK + h * 64 + dq * 16 + 8);
    float qv[16], kv[16];
#pragma unroll
    for (int e = 0; e < 4; ++e) {
      qv[2 * e] = bflo(q0[e]); qv[2 * e + 1] = bfhi(q0[e]); qv[8 + 2 * e] = bflo(q1[e]); qv[8 + 2 * e + 1] = bfhi(q1[e]);
      kv[2 * e] = bflo(k0[e]); kv[2 * e + 1] = bfhi(k0[e]); kv[8 + 2 * e] = bflo(k1[e]); kv[8 + 2 * e + 1] = bfhi(k1[e]);
    }
#pragma unroll
    for (int dd = 0; dd < 16; ++dd) {
      const int d = dq * 16 + dd;
      const float bb = sb[i * 65 + d];
      sq[i * 72 + d] = f2bf(qv[dd] * 0.125f * __expf(bb));
      sk[i * 72 + d] = f2bf(kv[dd] * __expf(-bb));
    }
  }
  gla_stage_vT(proj, b, h, n, vT);
  __syncthreads();
  f32x16 x00 = zero16(), x01 = zero16(), x11 = zero16();
#pragma unroll
  for (int s = 0; s < 4; ++s) {
    const bf16x8 kj0 = *(const bf16x8*)(sk + (l32)*72 + s * 16 + kb * 8);
    const bf16x8 kj1 = *(const bf16x8*)(sk + (32 + l32) * 72 + s * 16 + kb * 8);
    const bf16x8 qi0 = *(const bf16x8*)(sq + (l32)*72 + s * 16 + kb * 8);
    const bf16x8 qi1 = *(const bf16x8*)(sq + (32 + l32) * 72 + s * 16 + kb * 8);
    x00 = mfma(kj0, qi0, x00); x01 = mfma(kj0, qi1, x01); x11 = mfma(kj1, qi1, x11);
  }
#pragma unroll
  for (int r = 0; r < 16; ++r) { const bool keep = crow(r, kb) <= l32; x00[r] = keep ? x00[r] : 0.f; x11[r] = keep ? x11[r] : 0.f; }
  f32x16 o0 = zero16(), o1 = zero16();
  const int dvr = wave * 32 + l32;
#pragma unroll
  for (int s = 0; s < 2; ++s) {
    const bf16x8 p00 = pack8(x00[8 * s], x00[8 * s + 1], x00[8 * s + 2], x00[8 * s + 3], x00[8 * s + 4], x00[8 * s + 5], x00[8 * s + 6], x00[8 * s + 7]);
    const bf16x8 p01 = pack8(x01[8 * s], x01[8 * s + 1], x01[8 * s + 2], x01[8 * s + 3], x01[8 * s + 4], x01[8 * s + 5], x01[8 * s + 6], x01[8 * s + 7]);
    const bf16x8 p11 = pack8(x11[8 * s], x11[8 * s + 1], x11[8 * s + 2], x11[8 * s + 3], x11[8 * s + 4], x11[8 * s + 5], x11[8 * s + 6], x11[8 * s + 7]);
    const bf16x8 v0 = ld2x4(vT + dvr * 72 + 16 * s + 4 * kb);
    const bf16x8 v1 = ld2x4(vT + dvr * 72 + 32 + 16 * s + 4 * kb);
    o0 = mfma(v0, p00, o0); o1 = mfma(v0, p01, o1); o1 = mfma(v1, p11, o1);
  }
  {
    const float* sp = states + ((size_t)((b * 4 + h) * 128 + n) * 128 + dvr) * 64;
#pragma unroll
    for (int s = 0; s < 4; ++s) {
      const float4 f0 = *(const float4*)(sp + s * 16 + kb * 8), f1 = *(const float4*)(sp + s * 16 + kb * 8 + 4);
      const bf16x8 a = pack8(f0.x, f0.y, f0.z, f0.w, f1.x, f1.y, f1.z, f1.w);
      const bf16x8 qi0 = *(const bf16x8*)(sq + (l32)*72 + s * 16 + kb * 8);
      const bf16x8 qi1 = *(const bf16x8*)(sq + (32 + l32) * 72 + s * 16 + kb * 8);
      o0 = mfma(a, qi0, o0); o1 = mfma(a, qi1, o1);
    }
  }
  float s0 = 0.f, s1 = 0.f;
#pragma unroll
  for (int r = 0; r < 16; ++r) { s0 += o0[r] * o0[r]; s1 += o1[r] * o1[r]; }
  s0 += __shfl_xor(s0, 32); s1 += __shfl_xor(s1, 32);
  if (kb == 0) { sred[wave * 64 + l32] = s0; sred[wave * 64 + 32 + l32] = s1; }
  __syncthreads();
  const float t0s = sred[l32] + sred[64 + l32] + sred[128 + l32] + sred[192 + l32];
  const float t1s = sred[32 + l32] + sred[64 + 32 + l32] + sred[128 + 32 + l32] + sred[192 + 32 + l32];
  const float r0 = rsqrtf(t0s * (1.f / 128.f) + EPS), r1 = rsqrtf(t1s * (1.f / 128.f) + EPS);
#pragma unroll
  for (int it = 0; it < 2; ++it) {
    const size_t t = (size_t)b * SEQ + n * 64 + it * 32 + l32;
    const float rr = it ? r1 : r0;
#pragma unroll
    for (int gq = 0; gq < 4; ++gq) {
      const int dv = wave * 32 + 8 * gq + 4 * kb;
      const u32x2 ru = *(const u32x2*)(proj + t * PW + C_GR + h * 128 + dv);
      const float4 gn = *(const float4*)(P.gla_norm + h * 128 + dv);
      float rv[4] = {bflo(ru[0]), bfhi(ru[0]), bflo(ru[1]), bfhi(ru[1])};
      float gv[4] = {gn.x, gn.y, gn.z, gn.w};
      float ov[4];
#pragma unroll
      for (int e = 0; e < 4; ++e) {
        const float a = it ? o1[gq * 4 + e] : o0[gq * 4 + e];
        ov[e] = a * rr * gv[e] * (rv[e] / (1.f + __expf(-rv[e])));
      }
      u32x2 o; o[0] = pk2(ov[0], ov[1]); o[1] = pk2(ov[2], ov[3]);
      *(u32x2*)(mix + t * DM + h * 128 + dv) = o;
    }
  }
  __syncthreads();
}

DI void nsa_compress_task(const Params& P, int task) {
  const bf16_t* proj = (const bf16_t*)(P.ws + R1);
  const int lane = TIDX & 63, l32 = lane & 31, kb = lane >> 5;
  const int ct = task & 15, g = (task >> 4) & 1, b = (task >> 5) & 7, br = task >> 8;
  const bf16_t* w1T = (const bf16_t*)(P.ws + W_CW1) + (size_t)br * 128 * 2048;
  const bf16_t* w2T = (const bf16_t*)(P.ws + W_CW2) + (size_t)br * 64 * 128;
  const float* bias1 = (const float*)(P.ws + W_BIAS1) + br * 128;
  const int c = ct * 32 + l32;
  const int cc = c < 511 ? c : 510;
  const bf16_t* src = proj + ((size_t)b * SEQ + cc * 16) * PW + (br ? C_VC : C_KC) + g * 64 + kb * 8;
  f32x16 acc[4];
#pragma unroll
  for (int i = 0; i < 4; ++i) acc[i] = zero16();
#pragma unroll 1
  for (int ks = 0; ks < 128; ++ks) {
    const int l = ks >> 2, dh0 = (ks & 3) * 16;
    const bf16x8 bf = *(const bf16x8*)(src + (size_t)l * PW + dh0);
#pragma unroll
    for (int ht = 0; ht < 4; ++ht) {
      const bf16x8 af = *(const bf16x8*)(w1T + (size_t)(ht * 32 + l32) * 2048 + ks * 16 + kb * 8);
      acc[ht] = mfma(af, bf, acc[ht]);
    }
  }
#pragma unroll
  for (int ht = 0; ht < 4; ++ht)
#pragma unroll
    for (int r = 0; r < 16; ++r) acc[ht][r] = gelu_tanh(acc[ht][r] + bias1[ht * 32 + crow(r, kb)]);
  f32x16 o[2]; o[0] = zero16(); o[1] = zero16();
#pragma unroll
  for (int ht = 0; ht < 4; ++ht)
#pragma unroll
    for (int s = 0; s < 2; ++s) {
      const bf16x8 hf = pack8(acc[ht][8 * s], acc[ht][8 * s + 1], acc[ht][8 * s + 2], acc[ht][8 * s + 3], acc[ht][8 * s + 4], acc[ht][8 * s + 5], acc[ht][8 * s + 6], acc[ht][8 * s + 7]);
#pragma unroll
      for (int dt = 0; dt < 2; ++dt) {
        const bf16x8 wf = ld2x4(w2T + (size_t)(dt * 32 + l32) * 128 + ht * 32 + 16 * s + 4 * kb);
        o[dt] = mfma(wf, hf, o[dt]);
      }
    }
  if (c < 511) {
    if (br == 0) {
      bf16_t* dst = (bf16_t*)(P.ws + R_KCMP) + ((size_t)(b * 2 + g) * 512 + c) * 64;
#pragma unroll
      for (int dt = 0; dt < 2; ++dt)
#pragma unroll
        for (int gq = 0; gq < 4; ++gq) {
          u32x2 u; u[0] = pk2(o[dt][gq * 4], o[dt][gq * 4 + 1]); u[1] = pk2(o[dt][gq * 4 + 2], o[dt][gq * 4 + 3]);
          *(u32x2*)(dst + dt * 32 + 8 * gq + 4 * kb) = u;
        }
    } else {
      bf16_t* dst = (bf16_t*)(P.ws + R_VCMPT) + (size_t)(b * 2 + g) * 64 * 512 + c;
#pragma unroll
      for (int dt = 0; dt < 2; ++dt)
#pragma unroll
        for (int r = 0; r < 16; ++r) dst[(size_t)(dt * 32 + crow(r, kb)) * 512] = f2bf(o[dt][r]);
    }
  }
}

DI void nsa_transpose_v(const Params& P) {
  const bf16_t* proj = (const bf16_t*)(P.ws + R1);
  const int total = 2 * 8 * 2 * 1024 * 64;
  for (int u = blockIdx.x * blockDim.x + TIDX; u < total; u += gridDim.x * blockDim.x) {
    const int dh = u & 63; int rest = u >> 6; const int t8 = rest & 1023; rest >>= 10;
    const int g = rest & 1, b = (rest >> 1) & 7, which = rest >> 4;
    const bf16_t* src = proj + ((size_t)b * SEQ + t8 * 8) * PW + (which ? C_VW : C_VS) + g * 64 + dh;
    bf16_t v[8];
#pragma unroll
    for (int j = 0; j < 8; ++j) v[j] = src[(size_t)j * PW];
    u32x4 o;
#pragma unroll
    for (int j = 0; j < 4; ++j) o[j] = (unsigned)v[2 * j] | ((unsigned)v[2 * j + 1] << 16);
    bf16_t* dst = (bf16_t*)(P.ws + (which ? R_VWT : R_VST)) + ((size_t)(b * 2 + g) * 64 + dh) * SEQ + t8 * 8;
    *(u32x4*)dst = o;
  }
}

DI f32x16 qk_tile(const bf16_t* krow, const bf16x8 (&qf)[4]) {
  f32x16 s = zero16();
#pragma unroll
  for (int i = 0; i < 4; ++i) { const bf16x8 kf = *(const bf16x8*)(krow + i * 16); s = mfma(kf, qf[i], s); }
  return s;
}

DI float half_max(float x) {
  const auto r = __builtin_amdgcn_permlane32_swap(__float_as_uint(x), __float_as_uint(x), false, false);
  return fmaxf(__uint_as_float(r[0]), __uint_as_float(r[1]));
}
DI float half_sum(float x) {
  const auto r = __builtin_amdgcn_permlane32_swap(__float_as_uint(x), __float_as_uint(x), false, false);
  return __uint_as_float(r[0]) + __uint_as_float(r[1]);
}
DI s16x4 lds_tr(const char* p) { return __builtin_amdgcn_ds_read_tr16_b64_v4i16((__attribute__((address_space(3))) s16x4*)p); }

template <bool EDGE>
DI void softmax_tile(f32x16& s, int k0, int tq, int lo, bool bit, int kb, f32x16& o0, f32x16& o1, float& m, float& l) {
  constexpr float CS = 0.125f * 1.4426950408889634f;
  float tmax = -1e30f;
  if (EDGE) {
#pragma unroll
    for (int r = 0; r < 16; ++r) {
      const int key = k0 + crow(r, kb);
      const bool vd = (key <= tq) && (key > lo);
      s[r] = vd ? s[r] * CS : -1e30f;
      tmax = fmaxf(tmax, s[r]);
    }
  } else {
#pragma unroll
    for (int r = 0; r < 16; ++r) tmax = fmaxf(tmax, s[r]);
    tmax *= CS;
  }
  tmax = bit ? tmax : -1e30f;
  tmax = half_max(tmax);
  if (__ballot(tmax > m) != 0ull) {
    const float mn = fmaxf(m, tmax);
    const float alpha = __builtin_amdgcn_exp2f(m - mn);
    l *= alpha; m = mn;
#pragma unroll
    for (int r = 0; r < 16; ++r) { o0[r] *= alpha; o1[r] *= alpha; }
  }
  const bool live = bit && (m > -5e29f);
  float ps = 0.f;
#pragma unroll
  for (int r = 0; r < 16; ++r) {
    const float e = EDGE ? __builtin_amdgcn_exp2f(s[r] - m) : __builtin_amdgcn_exp2f(__builtin_fmaf(s[r], CS, -m));
    s[r] = live ? e : 0.f;
    ps += s[r];
  }
  l += ps;
}

struct HeadAcc { f32x16 o0, o1; float m, l; };

template <bool EDGE>
DI void attn_step2(const bf16_t* sKt, const char* sVt, const bf16x8 (&qa)[4], const bf16x8 (&qb)[4], int k0, int tq, int lo, bool bit,
                   int lane, HeadAcc& A, HeadAcc& B) {
  const int l32 = lane & 31, kb = lane >> 5, i16 = lane & 15, q = i16 >> 2, p = i16 & 3, gc = (lane >> 4) & 1;
  f32x16 sa = zero16(), sb = zero16();
#pragma unroll
  for (int i = 0; i < 4; ++i) {
    const bf16x8 kf = *(const bf16x8*)(sKt + l32 * 72 + i * 16 + kb * 8);
    sa = mfma(kf, qa[i], sa); sb = mfma(kf, qb[i], sb);
  }
  bf16x8 vf[2][2];
#pragma unroll
  for (int dt = 0; dt < 2; ++dt)
#pragma unroll
    for (int sI = 0; sI < 2; ++sI) {
      const char* vp = sVt + (16 * sI + 4 * kb + q) * 144 + (dt * 32 + gc * 16 + 4 * p) * 2;
      const s16x4 lo4 = lds_tr(vp), hi4 = lds_tr(vp + 8 * 144);
      vf[dt][sI] = __builtin_shufflevector(lo4, hi4, 0, 1, 2, 3, 4, 5, 6, 7);
    }
  softmax_tile<EDGE>(sa, k0, tq, lo, bit, kb, A.o0, A.o1, A.m, A.l);
  softmax_tile<EDGE>(sb, k0, tq, lo, bit, kb, B.o0, B.o1, B.m, B.l);
#pragma unroll
  for (int sI = 0; sI < 2; ++sI) {
    const bf16x8 pa = pack8(sa[8 * sI], sa[8 * sI + 1], sa[8 * sI + 2], sa[8 * sI + 3], sa[8 * sI + 4], sa[8 * sI + 5], sa[8 * sI + 6], sa[8 * sI + 7]);
    const bf16x8 pb = pack8(sb[8 * sI], sb[8 * sI + 1], sb[8 * sI + 2], sb[8 * sI + 3], sb[8 * sI + 4], sb[8 * sI + 5], sb[8 * sI + 6], sb[8 * sI + 7]);
    A.o0 = mfma(vf[0][sI], pa, A.o0); A.o1 = mfma(vf[1][sI], pa, A.o1);
    B.o0 = mfma(vf[0][sI], pb, B.o0); B.o1 = mfma(vf[1][sI], pb, B.o1);
  }
}

template <bool WIN>
DI void nsa_branch2(const bf16_t* kbase, const bf16_t* vbase, char* smem, int st0, int st1, int qt, int tq, const bf16x8 (&qa)[4],
                    const bf16x8 (&qb)[4], unsigned mk0, unsigned mk1, unsigned mk2, unsigned mk3, HeadAcc& A, HeadAcc& B) {
  const int tid = TIDX, lane = tid & 63;
  const int srow = tid >> 3, schunk = (tid & 7) * 8;
  const bf16_t* kg = kbase + (size_t)srow * PW + schunk;
  const bf16_t* vg = vbase + (size_t)srow * PW + schunk;
  const int soff = (srow * 72 + schunk) * 2;
  u32x4 rk = *(const u32x4*)(kg + (size_t)st0 * 64 * PW), rv = *(const u32x4*)(vg + (size_t)st0 * 64 * PW);
  *(u32x4*)(smem + soff) = rk; *(u32x4*)(smem + 9216 + soff) = rv;
  __syncthreads();
  for (int st = st0; st <= st1; ++st) {
    const int cur = (st - st0) & 1;
    if (st < st1) { rk = *(const u32x4*)(kg + (size_t)(st + 1) * 64 * PW); rv = *(const u32x4*)(vg + (size_t)(st + 1) * 64 * PW); }
    const bf16_t* bK = (const bf16_t*)(smem + cur * 18432);
    const char* bV = smem + cur * 18432 + 9216;
    bool bit = true;
    if (!WIN) { const unsigned mw = st < 32 ? mk0 : (st < 64 ? mk1 : (st < 96 ? mk2 : mk3)); bit = (mw >> (st & 31)) & 1u; }
    const bool any = WIN ? true : (__ballot(bit) != 0ull);
#pragma unroll
    for (int tt = 0; tt < 2; ++tt) {
      const int kt = 2 * st + tt;
      const bool in_range = WIN ? (kt <= qt && kt >= qt - 16) : (kt <= qt);
      if (in_range && any) {
        const bool edge = WIN ? (kt == qt || kt == qt - 16) : (kt == qt);
        if (edge) attn_step2<true>(bK + tt * 32 * 72, bV + tt * 32 * 144, qa, qb, kt * 32, tq, WIN ? tq - 512 : -1, bit, lane, A, B);
        else attn_step2<false>(bK + tt * 32 * 72, bV + tt * 32 * 144, qa, qb, kt * 32, tq, WIN ? tq - 512 : -1, bit, lane, A, B);
      }
    }
    if (st < st1) { *(u32x4*)(smem + (cur ^ 1) * 18432 + soff) = rk; *(u32x4*)(smem + (cur ^ 1) * 18432 + 9216 + soff) = rv; }
    __syncthreads();
  }
}

DI void fold_partial(bf16_t* dst, float f, const f32x16& a0, const f32x16& a1, int kb) {
#pragma unroll
  for (int gq = 0; gq < 4; ++gq) {
    bf16_t* d0 = dst + 8 * gq + 4 * kb;
    bf16_t* d1 = d0 + 32;
    const u32x2 p0 = *(const u32x2*)d0, p1 = *(const u32x2*)d1;
    u32x2 u0, u1;
    u0[0] = pk2(bflo(p0[0]) + f * a0[gq * 4], bfhi(p0[0]) + f * a0[gq * 4 + 1]);
    u0[1] = pk2(bflo(p0[1]) + f * a0[gq * 4 + 2], bfhi(p0[1]) + f * a0[gq * 4 + 3]);
    u1[0] = pk2(bflo(p1[0]) + f * a1[gq * 4], bfhi(p1[0]) + f * a1[gq * 4 + 1]);
    u1[1] = pk2(bflo(p1[1]) + f * a1[gq * 4 + 2], bfhi(p1[1]) + f * a1[gq * 4 + 3]);
    *(u32x2*)d0 = u0; *(u32x2*)d1 = u1;
  }
}

DI void nsa_block(const Params& P, int b, int g, int qb, char* smem) {
  const int wv = __builtin_amdgcn_readfirstlane(TIDX >> 6);
  const int qt = qb * 8 + wv;
  float* imp = (float*)smem + wv * 4096;
  const bf16_t* proj = (const bf16_t*)(P.ws + R1);
  bf16_t* mix = (bf16_t*)(P.ws + R3);
  const int lane = TIDX & 63, l32 = lane & 31, kb = lane >> 5;
  const int t0 = qt * 32, tq = t0 + l32;
  const size_t tokq = (size_t)b * SEQ + tq;
  const bf16_t* qrow = proj + tokq * PW;
  const bf16_t* kcmp = (const bf16_t*)(P.ws + R_KCMP) + (size_t)(b * 2 + g) * 512 * 64;
  const bf16_t* vcmpT = (const bf16_t*)(P.ws + R_VCMPT) + (size_t)(b * 2 + g) * 64 * 512;
  for (int i = lane; i < 4096; i += 64) imp[i] = 0.f;
  const int nct = (qt >> 4) + 1;
  for (int hh = 0; hh < 4; ++hh) {
    const int head = g * 4 + hh;
    bf16x8 qf[4];
#pragma unroll
    for (int i = 0; i < 4; ++i) qf[i] = *(const bf16x8*)(qrow + C_NQ + head * 64 + i * 16 + kb * 8);
    float m = -1e30f, l = 0.f;
    for (int ct = 0; ct < nct; ++ct) {
      f32x16 s = qk_tile(kcmp + (size_t)(ct * 32 + l32) * 64 + kb * 8, qf);
      float tmax = -1e30f;
#pragma unroll
      for (int r = 0; r < 16; ++r) {
        const int c = ct * 32 + crow(r, kb);
        const bool vd = (c * 16 + 31 <= tq);
        s[r] = vd ? s[r] * 0.125f : -1e30f;
        tmax = fmaxf(tmax, s[r]);
      }
      const float mn = fmaxf(m, tmax);
      float ps = 0.f;
#pragma unroll
      for (int r = 0; r < 16; ++r) ps += (s[r] > -5e29f) ? __expf(s[r] - mn) : 0.f;
      l = l * __expf(m - mn) + ps; m = mn;
    }
    const float mo = __shfl_xor(m, 32), lo_ = __shfl_xor(l, 32);
    const float M = fmaxf(m, mo);
    const float L = l * __expf(m - M) + lo_ * __expf(mo - M);
    const float invL = 1.f / fmaxf(L, 1e-30f);
    f32x16 o0 = zero16(), o1 = zero16();
    float carry = 0.f;
    for (int ct = 0; ct < nct; ++ct) {
      f32x16 s = qk_tile(kcmp + (size_t)(ct * 32 + l32) * 64 + kb * 8, qf);
#pragma unroll
      for (int r = 0; r < 16; ++r) {
        const int c = ct * 32 + crow(r, kb);
        const bool vd = (c * 16 + 31 <= tq);
        s[r] = vd ? __expf(s[r] * 0.125f - M) * invL : 0.f;
      }
      float y[4];
#pragma unroll
      for (int gi = 0; gi < 4; ++gi) y[gi] = __shfl_xor(s[4 * gi + 3], 32);
#pragma unroll
      for (int gi = 0; gi < 4; ++gi) {
        const float s4 = (s[4 * gi] + s[4 * gi + 1]) + (s[4 * gi + 2] + s[4 * gi + 3]);
        const float extra = kb ? y[gi] : (gi == 0 ? carry : y[gi > 0 ? gi - 1 : 0]);
        const int j = ct * 8 + 2 * gi + kb;
        imp[j * 32 + l32] += s4 + extra;
      }
      carry = y[3];
#pragma unroll
      for (int sI = 0; sI < 2; ++sI) {
        const bf16x8 pf = pack8(s[8 * sI], s[8 * sI + 1], s[8 * sI + 2], s[8 * sI + 3], s[8 * sI + 4], s[8 * sI + 5], s[8 * sI + 6], s[8 * sI + 7]);
        const bf16x8 va = ld2x4(vcmpT + (size_t)(l32)*512 + ct * 32 + 16 * sI + 4 * kb);
        const bf16x8 vb = ld2x4(vcmpT + (size_t)(32 + l32) * 512 + ct * 32 + 16 * sI + 4 * kb);
        o0 = mfma(va, pf, o0); o1 = mfma(vb, pf, o1);
      }
    }
    const float g0 = sigmoidf_(bf2f(qrow[C_NG + head * 3 + 0]) + P.nsa_gate_b[head * 3 + 0]);
#pragma unroll
    for (int gq = 0; gq < 4; ++gq) {
      u32x2 u0, u1;
      u0[0] = pk2(g0 * o0[gq * 4], g0 * o0[gq * 4 + 1]); u0[1] = pk2(g0 * o0[gq * 4 + 2], g0 * o0[gq * 4 + 3]);
      u1[0] = pk2(g0 * o1[gq * 4], g0 * o1[gq * 4 + 1]); u1[1] = pk2(g0 * o1[gq * 4 + 2], g0 * o1[gq * 4 + 3]);
      *(u32x2*)(mix + tokq * DM + 512 + head * 64 + 8 * gq + 4 * kb) = u0;
      *(u32x2*)(mix + tokq * DM + 512 + head * 64 + 32 + 8 * gq + 4 * kb) = u1;
    }
  }
  asm volatile("s_waitcnt lgkmcnt(0)" ::: "memory");
  __builtin_amdgcn_wave_barrier();
  unsigned mk0 = 0, mk1 = 0, mk2 = 0, mk3 = 0;
  for (int q = 0; q < 32; ++q) {
    const int tqq = t0 + q, cur = tqq >> 6;
    const float v0 = imp[lane * 32 + q], v1 = imp[(lane + 64) * 32 + q];
    const int j0 = lane, j1 = lane + 64;
    const float s0 = (j0 == 0 || j0 == cur || j0 == cur - 1) ? 1e30f : (j0 <= cur ? v0 : -1e30f);
    const float s1 = (j1 == cur || j1 == cur - 1) ? 1e30f : (j1 <= cur ? v1 : -1e30f);
    int c0 = 0, c1 = 0;
#pragma unroll
    for (int k = 0; k < 64; ++k) {
      const float a0 = __int_as_float(__builtin_amdgcn_readlane(__float_as_int(s0), k));
      const float a1 = __int_as_float(__builtin_amdgcn_readlane(__float_as_int(s1), k));
      c0 += ((a0 > s0) || (a0 == s0 && k < lane)) ? 1 : 0;
      c0 += (a1 > s0) ? 1 : 0;
      c1 += (a0 >= s1) ? 1 : 0;
      c1 += ((a1 > s1) || (a1 == s1 && k < lane)) ? 1 : 0;
    }
    const bool sel0 = (s0 > -5e29f) && (c0 < 16);
    const bool sel1 = (s1 > -5e29f) && (c1 < 16);
    const unsigned long long blo = __ballot(sel0), bhi = __ballot(sel1);
    if (l32 == q) { mk0 = (unsigned)blo; mk1 = (unsigned)(blo >> 32); mk2 = (unsigned)bhi; mk3 = (unsigned)(bhi >> 32); }
  }
  asm volatile("" ::: "memory");
  __syncthreads();
  const bf16_t* ksel = proj + (size_t)b * SEQ * PW + C_KS + g * 64;
  const bf16_t* vsel = proj + (size_t)b * SEQ * PW + C_VS + g * 64;
  const bf16_t* kwin = proj + (size_t)b * SEQ * PW + C_KW + g * 64;
  const bf16_t* vwin = proj + (size_t)b * SEQ * PW + C_VW + g * 64;
  const int st1 = 4 * qb + 3, wst0 = qb > 2 ? 4 * qb - 8 : 0;
#pragma unroll 1
  for (int hp = 0; hp < 2; ++hp) {
    const int head = g * 4 + hp * 2;
    bf16x8 qa[4], qb_[4];
#pragma unroll
    for (int i = 0; i < 4; ++i) {
      qa[i] = *(const bf16x8*)(qrow + C_NQ + head * 64 + i * 16 + kb * 8);
      qb_[i] = *(const bf16x8*)(qrow + C_NQ + (head + 1) * 64 + i * 16 + kb * 8);
    }
    bf16_t* dstA = mix + tokq * DM + 512 + head * 64;
    bf16_t* dstB = dstA + 64;
    HeadAcc A, B;
    A.o0 = zero16(); A.o1 = zero16(); A.m = -1e30f; A.l = 0.f; B.o0 = zero16(); B.o1 = zero16(); B.m = -1e30f; B.l = 0.f;
    nsa_branch2<false>(ksel, vsel, smem, 0, st1, qt, tq, qa, qb_, mk0, mk1, mk2, mk3, A, B);
    {
      const float gA = sigmoidf_(bf2f(qrow[C_NG + head * 3 + 1]) + P.nsa_gate_b[head * 3 + 1]);
      const float gB = sigmoidf_(bf2f(qrow[C_NG + (head + 1) * 3 + 1]) + P.nsa_gate_b[(head + 1) * 3 + 1]);
      fold_partial(dstA, gA / fmaxf(half_sum(A.l), 1e-30f), A.o0, A.o1, kb);
      fold_partial(dstB, gB / fmaxf(half_sum(B.l), 1e-30f), B.o0, B.o1, kb);
    }
    A.o0 = zero16(); A.o1 = zero16(); A.m = -1e30f; A.l = 0.f; B.o0 = zero16(); B.o1 = zero16(); B.m = -1e30f; B.l = 0.f;
    nsa_branch2<true>(kwin, vwin, smem, wst0, st1, qt, tq, qa, qb_, 0u, 0u, 0u, 0u, A, B);
    {
      const float gA = sigmoidf_(bf2f(qrow[C_NG + head * 3 + 2]) + P.nsa_gate_b[head * 3 + 2]);
      const float gB = sigmoidf_(bf2f(qrow[C_NG + (head + 1) * 3 + 2]) + P.nsa_gate_b[(head + 1) * 3 + 2]);
      fold_partial(dstA, gA / fmaxf(half_sum(A.l), 1e-30f), A.o0, A.o1, kb);
      fold_partial(dstB, gB / fmaxf(half_sum(B.l), 1e-30f), B.o0, B.o1, kb);
    }
  }
}

DI void sgu_item(const Params& P, int item, char* smem) {
  const bf16_t* H = (const bf16_t*)(P.ws + R1);
  bf16_t* Y = (bf16_t*)P.out;
  float* smu = (float*)smem; float* srs = smu + 128; float* sc1 = srs + 128; float* srw = sc1 + 128;
  bf16_t* sW = (bf16_t*)(smem + 2048);
  char* sV = smem + 2048 + 34816;
  const int tid = TIDX, lane = tid & 63, wave = __builtin_amdgcn_readfirstlane(tid >> 6), l32 = lane & 31, kb = lane >> 5;
  const size_t tok0 = (size_t)item * 128;
#pragma unroll 1
  for (int tb = 0; tb < 16; tb += 4) {
    u32x4 uu[4][4];
#pragma unroll
    for (int a = 0; a < 4; ++a)
#pragma unroll
      for (int k = 0; k < 4; ++k) uu[a][k] = *(const u32x4*)(H + (tok0 + wave * 16 + tb + a) * 4096 + 2048 + k * 512 + lane * 8);
#pragma unroll
    for (int a = 0; a < 4; ++a) {
      float sm = 0.f, s2 = 0.f;
#pragma unroll
      for (int k = 0; k < 4; ++k)
#pragma unroll
        for (int e = 0; e < 4; ++e) { const float x0 = bflo(uu[a][k][e]), x1 = bfhi(uu[a][k][e]); sm += x0 + x1; s2 += x0 * x0 + x1 * x1; }
      sm = wave_sum(sm); s2 = wave_sum(s2);
      const float mu = sm * (1.f / 2048.f);
      const float var = fmaxf(s2 * (1.f / 2048.f) - mu * mu, 0.f);
      if (lane == 0) { smu[wave * 16 + tb + a] = mu; srs[wave * 16 + tb + a] = rsqrtf(var + EPS); }
    }
  }
  __syncthreads();
  const int srow = tid >> 5, schunk = tid & 31;
#pragma unroll 1
  for (int g = 0; g < 8; ++g) {
    u32x4 vreg[8], ureg[8];
#pragma unroll
    for (int i = 0; i < 8; ++i) {
      const bf16_t* hp = H + (tok0 + srow + 16 * i) * 4096 + g * 256 + schunk * 8;
      vreg[i] = *(const u32x4*)(hp + 2048);
      ureg[i] = *(const u32x4*)hp;
    }
    {
      const int t = tid >> 2, qr = tid & 3;
      const float* wrow = P.o_w_s + ((size_t)g * 128 + t) * 128 + qr * 32;
      float c1 = 0.f, rw = 0.f;
#pragma unroll 1
      for (int c8 = 0; c8 < 4; ++c8) {
        const float4 f0 = *(const float4*)(wrow + c8 * 8), f1 = *(const float4*)(wrow + c8 * 8 + 4);
        float wv[8] = {f0.x, f0.y, f0.z, f0.w, f1.x, f1.y, f1.z, f1.w};
        float ov[8];
#pragma unroll
        for (int e = 0; e < 8; ++e) {
          const int sx = qr * 32 + c8 * 8 + e;
          const float w = (sx <= t) ? wv[e] : 0.f;
          rw += w;
          const float wp = bf2f(f2bf(w * srs[sx]));
          c1 += wp * smu[sx];
          ov[e] = wp;
        }
        u32x4 o; o[0] = pk2(ov[0], ov[1]); o[1] = pk2(ov[2], ov[3]); o[2] = pk2(ov[4], ov[5]); o[3] = pk2(ov[6], ov[7]);
        *(u32x4*)(sW + t * 136 + qr * 32 + c8 * 8) = o;
      }
      c1 += __shfl_xor(c1, 1); rw += __shfl_xor(rw, 1);
      c1 += __shfl_xor(c1, 2); rw += __shfl_xor(rw, 2);
      if (qr == 0) { sc1[t] = c1; srw[t] = rw; }
    }
#pragma unroll
    for (int i = 0; i < 8; ++i) *(u32x4*)(sV + (srow + 16 * i) * 544 + schunk * 16) = vreg[i];
    __syncthreads();
    const int tt = wave & 3, chh = wave >> 2;
    f32x16 acc[4];
#pragma unroll
    for (int c = 0; c < 4; ++c) acc[c] = zero16();
    {
      const int i16 = lane & 15, q = i16 >> 2, p = i16 & 3, gc = (lane >> 4) & 1;
      const char* vb = sV + (8 * kb + q) * 544 + (chh * 128 + gc * 16 + 4 * p) * 2;
      const bf16_t* wb = sW + (tt * 32 + l32) * 136 + kb * 8;
      const int nks = 2 * (tt + 1);
      for (int ks = 0; ks < nks; ++ks) {
        const bf16x8 wf = *(const bf16x8*)(wb + ks * 16);
#pragma unroll
        for (int c = 0; c < 4; ++c) {
          const s16x4 lo = lds_tr(vb + ks * 16 * 544 + c * 64);
          const s16x4 hi = lds_tr(vb + (ks * 16 + 4) * 544 + c * 64);
          const bf16x8 vf = __builtin_shufflevector(lo, hi, 0, 1, 2, 3, 4, 5, 6, 7);
          acc[c] = mfma(vf, wf, acc[c]);
        }
      }
    }
    __syncthreads();
    {
      const int t = tt * 32 + l32;
      const float c1 = sc1[t], rw = srw[t], bs = P.o_b_s[g * 128 + t];
#pragma unroll
      for (int c = 0; c < 4; ++c)
#pragma unroll
        for (int gq = 0; gq < 4; ++gq) {
          const int chl = (chh * 4 + c) * 32 + 8 * gq + 4 * kb;
          const float4 lg = *(const float4*)(P.o_ln_g + g * 256 + chl), lb = *(const float4*)(P.o_ln_b + g * 256 + chl);
          const float m0 = lg.x * (acc[c][gq * 4 + 0] - c1) + lb.x * rw + bs;
          const float m1 = lg.y * (acc[c][gq * 4 + 1] - c1) + lb.y * rw + bs;
          const float m2 = lg.z * (acc[c][gq * 4 + 2] - c1) + lb.z * rw + bs;
          const float m3 = lg.w * (acc[c][gq * 4 + 3] - c1) + lb.w * rw + bs;
          u32x2 o; o[0] = pk2(m0, m1); o[1] = pk2(m2, m3);
          *(u32x2*)(sV + t * 520 + chl * 2) = o;
        }
    }
    __syncthreads();
#pragma unroll
    for (int i = 0; i < 8; ++i) {
      const char* mp = sV + (srow + 16 * i) * 520 + schunk * 16;
      const u32x2 ma = *(const u32x2*)mp, mb = *(const u32x2*)(mp + 8);
      const u32x4 uu = ureg[i];
      u32x4 o;
      o[0] = pk2(bflo(uu[0]) * bflo(ma[0]), bfhi(uu[0]) * bfhi(ma[0]));
      o[1] = pk2(bflo(uu[1]) * bflo(ma[1]), bfhi(uu[1]) * bfhi(ma[1]));
      o[2] = pk2(bflo(uu[2]) * bflo(mb[0]), bfhi(uu[2]) * bfhi(mb[0]));
      o[3] = pk2(bflo(uu[3]) * bflo(mb[1]), bfhi(uu[3]) * bfhi(mb[1]));
      *(u32x4*)(Y + (tok0 + srow + 16 * i) * 2048 + g * 256 + schunk * 8) = o;
    }
    __syncthreads();
  }
}

constexpr int NPHASE = 17;
DI void run_phase(const Params& P, int ph, char* smem) {
  char* ws = P.ws;
  bf16_t* r1 = (bf16_t*)(ws + R1); bf16_t* r2 = (bf16_t*)(ws + R2); bf16_t* r3 = (bf16_t*)(ws + R3); bf16_t* r4 = (bf16_t*)(ws + R4);
  unsigned* cnt = (unsigned*)(ws + W_CNT);
  const int lane = TIDX & 63, wave = TIDX >> 6, half = TIDX >> 8;
  char* hsmem = smem + half * 65536;
  switch (ph) {
    case 0: phase_prep(P); break;
    case 1: gemm_run<0>(r2, (const bf16_t*)(ws + W_EIN), PW, 1024, r1, PW, smem); break;
    case 2: {
      if (blockIdx.x < 64) nsa_compress_task(P, blockIdx.x * WPB + wave);
      volatile int* s_item = (volatile int*)(smem + LDS_BYTES - 16);
      for (;;) {
        __syncthreads();
        if (TIDX == 0) *s_item = (int)atomicAdd(cnt + 0, 1u);
        __syncthreads();
        const int pair = *s_item;
        if (pair >= 2048) break;
        gla_p1_item(P, pair * 2 + half, hsmem);
      }
    } break;
    case 3: gla_scan(P);
    case 30: {
      volatile int* s_item = (volatile int*)(smem + 131072);
      for (;;) {
        __syncthreads();
        if (TIDX == 0) *s_item = (int)atomicAdd(cnt + 1, 1u);
        __syncthreads();
        const int it = *s_item;
        if (it >= 512) break;
        nsa_block(P, (it & 15) >> 1, it & 1, 31 - (it >> 4), smem);
      }
    } break;
    case 4:
      for (int item = blockIdx.x * 2 + half; item < 4096; item += gridDim.x * 2) gla_p3_item(P, item, hsmem);
      break;
    case 5: gemm_run<0>(r3, (const bf16_t*)(ws + W_EOUT), 1024, 1024, r4, 1024, smem); break;
    case 6: resnorm_rows<true, false>(r4, P.x, nullptr, nullptr, r3, P.norm_g + 1 * 1024, P.norm_g + 2 * 1024, r2); break;
    case 7: gemm_run<1>(r2, (const bf16_t*)(ws + W_FFN1_0), 4096, 1024, r1, 4096, smem); break;
    case 8: gemm_run<0>(r1, (const bf16_t*)(ws + W_FFN2_0), 1024, 4096, r4, 1024, smem); break;
    case 9: resnorm_rows<false, false>(r4, nullptr, r3, nullptr, r3, P.norm_g + 3 * 1024, P.norm_g + 4 * 1024, r2); break;
    case 10: gemm_run<2>(r2, (const bf16_t*)(ws + W_OIN), 4096, 1024, r1, 4096, smem); break;
    case 11:
      for (int item = blockIdx.x; item < 512; item += gridDim.x) sgu_item(P, item, smem);
      break;
    case 12: gemm_run<0>((const bf16_t*)P.out, (const bf16_t*)(ws + W_OOUT), 1024, 2048, r4, 1024, smem); break;
    case 13: resnorm_rows<false, false>(r4, nullptr, r3, nullptr, r3, P.norm_g + 5 * 1024, P.norm_g + 6 * 1024, r2); break;
    case 14: gemm_run<1>(r2, (const bf16_t*)(ws + W_FFN1_1), 4096, 1024, r1, 4096, smem); break;
    case 15: gemm_run<0>(r1, (const bf16_t*)(ws + W_FFN2_1), 1024, 4096, r4, 1024, smem); break;
    case 16: resnorm_rows<false, true>(r4, nullptr, r3, P.out, nullptr, P.norm_g + 7 * 1024, nullptr, nullptr); break;
    default: break;
  }
}

#if !MEGA
extern __shared__ __attribute__((aligned(16))) unsigned char lds_dyn[];
__global__ void __launch_bounds__(NTHR, 2) k_phase(Params P, int ph) {
  char* smem = (char*)lds_dyn;
  run_phase(P, ph, smem);
}
#endif

#if MEGA
extern __shared__ __attribute__((aligned(16))) unsigned char lds_dyn[];
__global__ void __launch_bounds__(NTHR, 2) k_mega(Params P) {
  char* smem = (char*)lds_dyn;
  cg::grid_group grid = cg::this_grid();
#ifndef PROBE
#define PROBE 0
#endif
#define GEMM_PH(n) run_phase(P, n, smem); grid.sync(); if (PROBE == 1) { run_phase(P, n, smem); grid.sync(); }
  run_phase(P, 0, smem); grid.sync();
  if (PROBE == 3) { run_phase(P, 0, smem); grid.sync(); }
  GEMM_PH(1)
  run_phase(P, 2, smem); grid.sync();
  if (PROBE == 4) { if (blockIdx.x == 0 && TIDX == 0) ((unsigned*)(P.ws + W_CNT))[0] = 0u; grid.sync(); run_phase(P, 2, smem); grid.sync(); }
  run_phase(P, 3, smem); grid.sync();
  if (PROBE == 2) {
    if (blockIdx.x == 0 && TIDX == 0) ((unsigned*)(P.ws + W_CNT))[1] = 0u;
    grid.sync();
    run_phase(P, 30, smem); grid.sync();
  }
  run_phase(P, 4, smem); grid.sync();
  if (PROBE == 5) { run_phase(P, 4, smem); grid.sync(); }
  GEMM_PH(5)
  run_phase(P, 6, smem); grid.sync();
  if (PROBE == 6) { run_phase(P, 6, smem); grid.sync(); run_phase(P, 6, smem); grid.sync(); run_phase(P, 6, smem); grid.sync(); }
  GEMM_PH(7)
  GEMM_PH(8)
  run_phase(P, 9, smem); grid.sync();
  GEMM_PH(10)
  run_phase(P, 11, smem); grid.sync();
  if (PROBE == 7) { run_phase(P, 11, smem); grid.sync(); }
  GEMM_PH(12)
  run_phase(P, 13, smem); grid.sync();
  GEMM_PH(14)
  GEMM_PH(15)
  run_phase(P, 16, smem);
}
#endif

extern "C" void kernel_launch(void* const* d_in, const int* in_sizes, int n_in, void* d_out, int out_size, void* d_ws, size_t ws_size,
                              hipStream_t stream) {
  Params p{};
  p.x = (const float*)d_in[0]; p.norm_g = (const float*)d_in[1]; p.ffn_w1 = (const float*)d_in[2]; p.ffn_w2 = (const float*)d_in[3];
  p.e_w_in = (const float*)d_in[4]; p.e_w_out = (const float*)d_in[5]; p.gla_w_gate = (const float*)d_in[6]; p.gla_b_gate = (const float*)d_in[7];
  p.gla_norm = (const float*)d_in[8]; p.nsa_gate_b = (const float*)d_in[9]; p.cmp_pos = (const float*)d_in[10]; p.cmp_w1 = (const float*)d_in[11];
  p.cmp_w2 = (const float*)d_in[12]; p.o_w_in = (const float*)d_in[13]; p.o_ln_g = (const float*)d_in[14]; p.o_ln_b = (const float*)d_in[15];
  p.o_w_s = (const float*)d_in[16]; p.o_b_s = (const float*)d_in[17]; p.o_w_out = (const float*)d_in[18];
  p.out = (float*)d_out; p.ws = (char*)d_ws;
  if (ws_size < 1024ull * MiB) { fprintf(stderr, "workspace too small: %zu\n", ws_size); return; }
  static int grid_blocks = 0;
  if (!grid_blocks) {
    int dev = 0, cus = 0, per_cu = 0;
    (void)hipGetDevice(&dev);
    (void)hipDeviceGetAttribute(&cus, hipDeviceAttributeMultiprocessorCount, dev);
#if MEGA
    if (hipFuncSetAttribute((const void*)k_mega, hipFuncAttributeMaxDynamicSharedMemorySize, LDS_BYTES) != hipSuccess) fprintf(stderr, "hipFuncSetAttribute failed\n");
    (void)hipOccupancyMaxActiveBlocksPerMultiprocessor(&per_cu, (const void*)k_mega, NTHR, LDS_BYTES);
#else
    if (hipFuncSetAttribute((const void*)k_phase, hipFuncAttributeMaxDynamicSharedMemorySize, LDS_BYTES) != hipSuccess) fprintf(stderr, "hipFuncSetAttribute failed\n");
    (void)hipOccupancyMaxActiveBlocksPerMultiprocessor(&per_cu, (const void*)k_phase, NTHR, LDS_BYTES);
#endif
    if (per_cu < 1) fprintf(stderr, "occupancy query returned %d\n", per_cu);
    grid_blocks = cus;
  }
#if MEGA
  void* args[] = {&p};
  hipError_t e = hipLaunchCooperativeKernel((void*)k_mega, dim3(grid_blocks), dim3(NTHR), args, LDS_BYTES, stream);
  if (e != hipSuccess) fprintf(stderr, "cooperative launch failed: %s (grid %d)\n", hipGetErrorString(e), grid_blocks);
#else
  for (int ph = 0; ph < NPHASE; ++ph) k_phase<<<grid_blocks, NTHR, LDS_BYTES, stream>>>(p, ph);
#endif
}
```

```cpp
#include <hip/hip_runtime.h>
#include <hip/hip_cooperative_groups.h>
#include <cstdio>
namespace cg = cooperative_groups;

#ifndef MEGA
#define MEGA 1
#endif
#ifndef PROBE
#define PROBE 0
#endif

typedef unsigned short bf16_t;
typedef short bf16x8 __attribute__((ext_vector_type(8)));
typedef short s16x4 __attribute__((ext_vector_type(4)));
typedef float f32x16 __attribute__((ext_vector_type(16)));
typedef float f32v2 __attribute__((ext_vector_type(2)));
typedef __bf16 bf16v2 __attribute__((ext_vector_type(2)));
typedef unsigned u32x4 __attribute__((ext_vector_type(4)));
typedef unsigned u32x2 __attribute__((ext_vector_type(2)));
#define DI __device__ __forceinline__
DI int tid_opaque() { int t = threadIdx.x; asm volatile("" : "+v"(t)); return t; }
#define TIDX tid_opaque()

constexpr int T_TOK = 65536, SEQ = 8192, DM = 1024;
constexpr int PW = 3072;
constexpr int C_GQ = 0, C_GK = 256, C_GV = 512, C_GLR = 1024, C_GR = 1040, C_NQ = 1552, C_KC = 2064, C_VC = 2192,
              C_KS = 2320, C_VS = 2448, C_KW = 2576, C_VW = 2704, C_NG = 2832;
constexpr float EPS = 1e-6f;
constexpr int NTHR = 512, WPB = 8, LDS_BYTES = 131072 + 64;
constexpr size_t MiB = 1024ull * 1024ull;
constexpr size_t W_FFN1_0 = 0, W_FFN1_1 = 8 * MiB, W_FFN2_0 = 16 * MiB, W_FFN2_1 = 24 * MiB, W_EIN = 32 * MiB, W_EOUT = 38 * MiB,
                 W_OIN = 40 * MiB, W_OOUT = 48 * MiB, W_CW1 = 52 * MiB, W_CW2 = 53 * MiB, W_BIAS1 = 53 * MiB + 65536,
                 W_CNT = 53 * MiB + 131072;
constexpr size_t R1 = 64 * MiB, R2 = 576 * MiB, R3 = 704 * MiB, R4 = 832 * MiB, R5 = 960 * MiB;
constexpr size_t R_KCMP = R5, R_VCMPT = R5 + 1 * MiB, R_VST = R5 + 2 * MiB, R_VWT = R5 + 18 * MiB, R_DECAY = R5 + 34 * MiB;

struct Params {
  const float* x; const float* norm_g; const float* ffn_w1; const float* ffn_w2; const float* e_w_in; const float* e_w_out;
  const float* gla_w_gate; const float* gla_b_gate; const float* gla_norm; const float* nsa_gate_b; const float* cmp_pos;
  const float* cmp_w1; const float* cmp_w2; const float* o_w_in; const float* o_ln_g; const float* o_ln_b; const float* o_w_s;
  const float* o_b_s; const float* o_w_out;
  float* out; char* ws;
};

DI int crow(int r, int kb) { return (r & 3) + 8 * (r >> 2) + 4 * kb; }
DI f32x16 mfma(bf16x8 a, bf16x8 b, f32x16 c) { return __builtin_amdgcn_mfma_f32_32x32x16_bf16(a, b, c, 0, 0, 0); }
DI unsigned pk2(float a, float b) { f32v2 v = {a, b}; bf16v2 r = __builtin_convertvector(v, bf16v2); return __builtin_bit_cast(unsigned, r); }
DI bf16_t f2bf(float a) { return (bf16_t)(pk2(a, 0.f) & 0xffffu); }
DI float bf2f(bf16_t u) { return __uint_as_float(((unsigned)u) << 16); }
DI float bflo(unsigned u) { return __uint_as_float(u << 16); }
DI float bfhi(unsigned u) { return __uint_as_float(u & 0xffff0000u); }
DI bf16x8 pack8(float a0, float a1, float a2, float a3, float a4, float a5, float a6, float a7) {
  u32x4 p; p[0] = pk2(a0, a1); p[1] = pk2(a2, a3); p[2] = pk2(a4, a5); p[3] = pk2(a6, a7);
  return __builtin_bit_cast(bf16x8, p);
}
DI bf16x8 ld2x4(const bf16_t* p) {
  s16x4 lo = *(const s16x4*)p; s16x4 hi = *(const s16x4*)(p + 8);
  return __builtin_shufflevector(lo, hi, 0, 1, 2, 3, 4, 5, 6, 7);
}
DI float wave_sum(float v) {
#pragma unroll
  for (int o = 32; o > 0; o >>= 1) v += __shfl_xor(v, o);
  return v;
}
DI f32x16 zero16() { f32x16 z;
#pragma unroll
  for (int i = 0; i < 16; ++i) z[i] = 0.f; return z; }
DI float gelu_tanh(float x) { float u = 1.5957691216f * (x + 0.044715f * x * x * x); return x / (1.f + __expf(-u)); }
DI float sigmoidf_(float x) { return 1.f / (1.f + __expf(-x)); }

DI void conv_weight(const float* __restrict__ src, bf16_t* __restrict__ dst, int K, int N, int Npad) {
  const long total = (long)Npad * (K >> 3);
  const long stride = (long)gridDim.x * blockDim.x;
  for (long i = (long)blockIdx.x * blockDim.x + TIDX; i < total; i += stride) {
    const int n = (int)(i % Npad); const int k8 = (int)(i / Npad);
    float v[8];
#pragma unroll
    for (int j = 0; j < 8; ++j) v[j] = (n < N) ? src[(size_t)(k8 * 8 + j) * N + n] : 0.f;
    u32x4 o; o[0] = pk2(v[0], v[1]); o[1] = pk2(v[2], v[3]); o[2] = pk2(v[4], v[5]); o[3] = pk2(v[6], v[7]);
    *(u32x4*)(dst + (size_t)n * K + k8 * 8) = o;
  }
}

DI void prenorm_rows(const float* __restrict__ x, const float* __restrict__ g, bf16_t* __restrict__ xn) {
  const int lane = TIDX & 63, wave = TIDX >> 6;
  const int nw = gridDim.x * WPB;
  for (int row = blockIdx.x * WPB + wave; row < T_TOK; row += nw) {
    const float4* xr = (const float4*)(x + (size_t)row * DM);
    float4 a[4]; float ss = 0.f;
#pragma unroll
    for (int k = 0; k < 4; ++k) { a[k] = xr[k * 64 + lane]; ss += a[k].x * a[k].x + a[k].y * a[k].y + a[k].z * a[k].z + a[k].w * a[k].w; }
    ss = wave_sum(ss);
    const float rs = rsqrtf(ss * (1.f / DM) + EPS);
#pragma unroll
    for (int k = 0; k < 4; ++k) {
      const float4 gg = ((const float4*)g)[k * 64 + lane];
      u32x2 o; o[0] = pk2(a[k].x * rs * gg.x, a[k].y * rs * gg.y); o[1] = pk2(a[k].z * rs * gg.z, a[k].w * rs * gg.w);
      *(u32x2*)(xn + (size_t)row * DM + k * 256 + lane * 4) = o;
    }
  }
}

template <bool HIN_F32, bool HOUT_F32>
DI void resnorm_rows(const bf16_t* __restrict__ m, const float* __restrict__ hin_f, const bf16_t* hin_b, float* __restrict__ hout_f,
                     bf16_t* hout_b, const float* __restrict__ gpost, const float* __restrict__ gnext, bf16_t* __restrict__ xn) {
  const int lane = TIDX & 63, wave = TIDX >> 6;
  const int nw = gridDim.x * WPB;
  for (int row = blockIdx.x * WPB + wave; row < T_TOK; row += nw) {
    float mv[16]; float ss = 0.f;
#pragma unroll
    for (int k = 0; k < 4; ++k) {
      const u32x2 u = *(const u32x2*)(m + (size_t)row * DM + k * 256 + lane * 4);
      mv[k * 4 + 0] = bflo(u[0]); mv[k * 4 + 1] = bfhi(u[0]); mv[k * 4 + 2] = bflo(u[1]); mv[k * 4 + 3] = bfhi(u[1]);
    }
    float hv[16];
#pragma unroll
    for (int k = 0; k < 4; ++k) {
      if (HIN_F32) {
        const float4 h4 = ((const float4*)(hin_f + (size_t)row * DM))[k * 64 + lane];
        hv[k * 4 + 0] = h4.x; hv[k * 4 + 1] = h4.y; hv[k * 4 + 2] = h4.z; hv[k * 4 + 3] = h4.w;
      } else {
        const u32x2 u = *(const u32x2*)(hin_b + (size_t)row * DM + k * 256 + lane * 4);
        hv[k * 4 + 0] = bflo(u[0]); hv[k * 4 + 1] = bfhi(u[0]); hv[k * 4 + 2] = bflo(u[1]); hv[k * 4 + 3] = bfhi(u[1]);
      }
    }
#pragma unroll
    for (int i = 0; i < 16; ++i) ss += mv[i] * mv[i];
    ss = wave_sum(ss);
    const float rs = rsqrtf(ss * (1.f / DM) + EPS);
    float s2 = 0.f;
#pragma unroll
    for (int k = 0; k < 4; ++k) {
      const float4 gg = ((const float4*)gpost)[k * 64 + lane];
      hv[k * 4 + 0] += mv[k * 4 + 0] * rs * gg.x; hv[k * 4 + 1] += mv[k * 4 + 1] * rs * gg.y;
      hv[k * 4 + 2] += mv[k * 4 + 2] * rs * gg.z; hv[k * 4 + 3] += mv[k * 4 + 3] * rs * gg.w;
      if (HOUT_F32) {
        float4 o; o.x = hv[k * 4 + 0]; o.y = hv[k * 4 + 1]; o.z = hv[k * 4 + 2]; o.w = hv[k * 4 + 3];
        ((float4*)(hout_f + (size_t)row * DM))[k * 64 + lane] = o;
      } else {
        u32x2 o; o[0] = pk2(hv[k * 4 + 0], hv[k * 4 + 1]); o[1] = pk2(hv[k * 4 + 2], hv[k * 4 + 3]);
        *(u32x2*)(hout_b + (size_t)row * DM + k * 256 + lane * 4) = o;
      }
    }
    if (xn) {
#pragma unroll
      for (int i = 0; i < 16; ++i) s2 += hv[i] * hv[i];
      s2 = wave_sum(s2);
      const float r2 = rsqrtf(s2 * (1.f / DM) + EPS);
#pragma unroll
      for (int k = 0; k < 4; ++k) {
        const float4 gg = ((const float4*)gnext)[k * 64 + lane];
        u32x2 o; o[0] = pk2(hv[k * 4 + 0] * r2 * gg.x, hv[k * 4 + 1] * r2 * gg.y); o[1] = pk2(hv[k * 4 + 2] * r2 * gg.z, hv[k * 4 + 3] * r2 * gg.w);
        *(u32x2*)(xn + (size_t)row * DM + k * 256 + lane * 4) = o;
      }
    }
  }
}

DI void phase_prep(const Params& P) {
  char* ws = P.ws;
  conv_weight(P.ffn_w1, (bf16_t*)(ws + W_FFN1_0), 1024, 4096, 4096);
  conv_weight(P.ffn_w1 + (size_t)1024 * 4096, (bf16_t*)(ws + W_FFN1_1), 1024, 4096, 4096);
  conv_weight(P.ffn_w2, (bf16_t*)(ws + W_FFN2_0), 4096, 1024, 1024);
  conv_weight(P.ffn_w2 + (size_t)1024 * 4096, (bf16_t*)(ws + W_FFN2_1), 4096, 1024, 1024);
  conv_weight(P.e_w_in, (bf16_t*)(ws + W_EIN), 1024, 2856, PW);
  conv_weight(P.e_w_out, (bf16_t*)(ws + W_EOUT), 1024, 1024, 1024);
  conv_weight(P.o_w_in, (bf16_t*)(ws + W_OIN), 1024, 4096, 4096);
  conv_weight(P.o_w_out, (bf16_t*)(ws + W_OOUT), 2048, 1024, 1024);
  conv_weight(P.cmp_w1, (bf16_t*)(ws + W_CW1), 2048, 128, 128);
  conv_weight(P.cmp_w1 + 2048 * 128, (bf16_t*)(ws + W_CW1) + 128 * 2048, 2048, 128, 128);
  conv_weight(P.cmp_w2, (bf16_t*)(ws + W_CW2), 128, 64, 64);
  conv_weight(P.cmp_w2 + 128 * 64, (bf16_t*)(ws + W_CW2) + 64 * 128, 128, 64, 64);
  const int lane = TIDX & 63, wave = TIDX >> 6;
  const int gw = blockIdx.x * WPB + wave;
  if (gw < 256) {
    const int i = gw >> 7, hid = gw & 127;
    float s = 0.f;
    for (int kk = lane; kk < 2048; kk += 64) s += P.cmp_pos[i * 2048 + kk] * P.cmp_w1[((size_t)i * 2048 + kk) * 128 + hid];
    s = wave_sum(s);
    if (lane == 0) ((float*)(ws + W_BIAS1))[gw] = s;
  }
  const int gt = blockIdx.x * blockDim.x + TIDX;
  if (gt < 16) ((unsigned*)(ws + W_CNT))[gt] = 0u;
  if (gt < 16 * 64) {
    const int bg = gt >> 6, d = gt & 63;
    ((bf16_t*)(ws + R_KCMP))[((size_t)bg * 512 + 511) * 64 + d] = 0;
    ((bf16_t*)(ws + R_VCMPT))[((size_t)bg * 64 + d) * 512 + 511] = 0;
  }
  prenorm_rows(P.x, P.norm_g, (bf16_t*)(ws + R2));
}

namespace pg8 {
#define PG8_LAS __attribute__((address_space(3)))
typedef float f32x4 __attribute__((ext_vector_type(4)));
constexpr int BM = 256, BK = 64, HALF = 128, HTB = HALF * BK * 2, STAGE_BYTES = 8 * HTB, NXCD = 8, WGM = 8;
DI int lds_byte(int r, int c) { const int st = (r >> 4) * 2 + (c >> 5), rr = r & 15, cc = c & 31, ob = rr * 64 + cc * 2; return st * 1024 + (ob ^ (((ob >> 9) & 1) << 5)); }
DI void stage_rc(int b, int& R, int& C) { const int st = b / 1024, sb = b % 1024, swz = sb ^ (((sb >> 9) & 1) << 5); R = (st >> 1) * 16 + swz / 64; C = (st & 1) * 32 + (swz % 64) / 2; }
DI int perm32(int rho) { const int n = rho >> 4, i = rho & 15; return 8 * (i >> 2) + 4 * n + (i & 3); }
struct Unit { int pm, pn; };
struct Gemm { const bf16_t* A; const bf16_t* Bt; int M, N, K; };
struct StaticOrder {
  int nM, nN, nwg, G, c;
  DI void init(int M, int N, int G_, int c_) { nM = M / BM; nN = N / BM; nwg = nM * nN; G = G_; c = c_; }
  DI bool next(int i, Unit& u) const {
    const long L = (long)i * G + c; if (L >= nwg) return false;
    int wgid = (int)L; { const int q = nwg / NXCD, r = nwg % NXCD, xcd = wgid % NXCD, off = wgid / NXCD; wgid = (xcd < r ? xcd * (q + 1) : r * (q + 1) + (xcd - r) * q) + off; }
    const int nig = WGM * nN, gid = wgid / nig, fm = gid * WGM, gsz = (nM - fm) < WGM ? (nM - fm) : WGM;
    u.pm = fm + ((wgid % nig) % gsz); u.pn = (wgid % nig) / gsz; return true;
  }
};
template <int ACT> struct EpiB {
  static constexpr bool PERM = true;
  bf16_t* O; int ldc;
  DI void operator()(const f32x4 (&acc)[2][2][4][2], const Unit& u, int wr, int wc, int fr, int fq) const {
    const int row0 = u.pm * BM + wr * 64 + fr; const int col0 = u.pn * BM + wc * 32 + 8 * fq;
#pragma unroll
    for (int ai = 0; ai < 2; ++ai)
#pragma unroll
      for (int m = 0; m < 4; ++m) {
        bf16_t* rowp = O + (size_t)(row0 + ai * HALF + m * 16) * ldc + col0;
#pragma unroll
        for (int bj = 0; bj < 2; ++bj) {
          f32x4 v0 = acc[ai][bj][m][0], v1 = acc[ai][bj][m][1];
          if (ACT == 1) {
#pragma unroll
            for (int j = 0; j < 4; ++j) { const float a = fmaxf(v0[j], 0.f), b = fmaxf(v1[j], 0.f); v0[j] = a * a; v1[j] = b * b; }
          }
          if (ACT == 2) {
#pragma unroll
            for (int j = 0; j < 4; ++j) { v0[j] = gelu_tanh(v0[j]); v1[j] = gelu_tanh(v1[j]); }
          }
          u32x4 w; w[0] = pk2(v0[0], v0[1]); w[1] = pk2(v0[2], v0[3]); w[2] = pk2(v1[0], v1[1]); w[3] = pk2(v1[2], v1[3]);
          *(u32x4*)(rowp + bj * HALF) = w;
        }
      }
  }
};

template <class Epi, class Sched>
DI void gemm_phase(PG8_LAS unsigned char* lds, const Gemm g, const Sched& S, const Epi& E) {
  const int tid_ = TIDX;
  const int tid = tid_, wid = __builtin_amdgcn_readfirstlane(tid >> 6), lane = tid & 63, wr = wid >> 2, wc = wid & 3, fr = lane & 15, fq = lane >> 4;
  const int K = g.K, nt = K / BK;
  unsigned voffA[2], voffB[2];
#pragma unroll
  for (int i = 0; i < 2; ++i) { int R, C; stage_rc(tid * 16 + i * 8192, R, C); const int Rb = Epi::PERM ? ((R & ~31) + perm32(R & 31)) : R;
    voffA[i] = (unsigned)(R * K + C) * 2u; voffB[i] = (unsigned)(Rb * K + C) * 2u; }
  const size_t kstep = (size_t)(BK * 2);
  const size_t hstep = (size_t)HALF * K * 2;
  const size_t tstep = 2 * hstep;
  const unsigned ldsw = (unsigned)wid * 1024u;
  const int aoff = lds_byte(wr * 64 + fr, fq * 8), boff = lds_byte(wc * 32 + fr, fq * 8);
#define PG8_SA(b, h) (((b) * 2 + (h)) * HTB)
#define PG8_SB(b, h) ((4 + (b) * 2 + (h)) * HTB)
#define PG8_STAGE(bufoff, gbase, voff) do { _Pragma("unroll") for (int _i = 0; _i < 2; ++_i) \
    __builtin_amdgcn_global_load_lds((const unsigned*)((const char*)(gbase) + (voff)[_i]), (PG8_LAS unsigned*)(lds + (bufoff) + ldsw + _i * 8192), 16, 0, 0); } while (0)
#define PG8_LDA(dst, b, h) do { _Pragma("unroll") for (int m = 0; m < 4; ++m) _Pragma("unroll") for (int k = 0; k < 2; ++k) dst[m][k] = *(const PG8_LAS bf16x8*)(lds + PG8_SA(b, h) + aoff + m * 2048 + k * 1024); } while (0)
#define PG8_LDB(dst, b, h) do { _Pragma("unroll") for (int n = 0; n < 2; ++n) _Pragma("unroll") for (int k = 0; k < 2; ++k) dst[n][k] = *(const PG8_LAS bf16x8*)(lds + PG8_SB(b, h) + boff + n * 2048 + k * 1024); } while (0)
#define PG8_MMA(ai, bj, At, Bt) do { __builtin_amdgcn_s_setprio(1); _Pragma("unroll") for (int m = 0; m < 4; ++m) _Pragma("unroll") for (int n = 0; n < 2; ++n) _Pragma("unroll") for (int k = 0; k < 2; ++k) \
    acc[ai][bj][m][n] = __builtin_amdgcn_mfma_f32_16x16x32_bf16(Bt[n][k], At[m][k], acc[ai][bj][m][n], 0, 0, 0); __builtin_amdgcn_s_setprio(0); } while (0)
#define PG8_WAIT_V(n) asm volatile("s_waitcnt vmcnt(" #n ")" ::: "memory")
#define PG8_WAIT_L(n) asm volatile("s_waitcnt lgkmcnt(" #n ")" ::: "memory")
#define PG8_BAR __builtin_amdgcn_s_barrier()
#define PG8_SCHED __builtin_amdgcn_sched_barrier(0)
  Unit cur, nxt; int ui = 0;
  if (!S.next(0, cur)) return;
  f32x4 acc[2][2][4][2];
#pragma unroll
  for (int a = 0; a < 2; ++a)
#pragma unroll
    for (int b = 0; b < 2; ++b)
#pragma unroll
      for (int m = 0; m < 4; ++m)
#pragma unroll
        for (int n = 0; n < 2; ++n) acc[a][b][m][n] = (f32x4){0.f, 0.f, 0.f, 0.f};
  bf16x8 At[4][2], B0[2][2], B1[2][2];
  const char* cA = (const char*)g.A + (size_t)cur.pm * tstep; const char* cB = (const char*)g.Bt + (size_t)cur.pn * tstep;
  PG8_STAGE(PG8_SB(0, 0), cB, voffB); PG8_STAGE(PG8_SA(0, 0), cA, voffA); PG8_STAGE(PG8_SB(0, 1), cB + hstep, voffB); PG8_STAGE(PG8_SA(0, 1), cA + hstep, voffA);
  if (wr == 1) PG8_BAR;
  PG8_WAIT_V(4); PG8_BAR;
  PG8_STAGE(PG8_SB(1, 0), cB + kstep, voffB); PG8_STAGE(PG8_SA(1, 0), cA + kstep, voffA); PG8_STAGE(PG8_SB(1, 1), cB + hstep + kstep, voffB);
  PG8_WAIT_V(6); PG8_BAR;
  for (;;) {
    const bool has_next = S.next(ui + 1, nxt);
    const char* nA = has_next ? (const char*)g.A + (size_t)nxt.pm * tstep : cA; const char* nB = has_next ? (const char*)g.Bt + (size_t)nxt.pn * tstep : cB;
    for (int t = 0; t < nt; t += 2) {
      const bool last = (t == nt - 2);
      const char* a1 = cA + (size_t)(t + 1) * kstep;
      const char* a2 = last ? nA : cA + (size_t)(t + 2) * kstep; const char* b2 = last ? nB : cB + (size_t)(t + 2) * kstep;
      const char* a3 = a2 + kstep; const char* b3 = b2 + kstep;
      PG8_LDB(B0, 0, 0); PG8_SCHED; PG8_LDA(At, 0, 0); PG8_STAGE(PG8_SA(1, 1), a1 + hstep, voffA);
      PG8_WAIT_L(8); PG8_BAR; PG8_WAIT_L(0); PG8_MMA(0, 0, At, B0); PG8_BAR; PG8_SCHED;
      PG8_LDB(B1, 0, 1); PG8_STAGE(PG8_SB(0, 0), b2, voffB);
      PG8_BAR; PG8_WAIT_L(0); PG8_MMA(0, 1, At, B1); PG8_BAR;
      PG8_LDA(At, 0, 1); PG8_STAGE(PG8_SA(0, 0), a2, voffA);
      PG8_BAR; PG8_WAIT_L(0); PG8_MMA(1, 0, At, B0); PG8_BAR; PG8_SCHED;
      PG8_STAGE(PG8_SB(0, 1), b2 + hstep, voffB);
      PG8_WAIT_V(6); PG8_BAR; PG8_MMA(1, 1, At, B1); PG8_BAR;
      PG8_LDB(B0, 1, 0); PG8_SCHED; PG8_LDA(At, 1, 0); PG8_STAGE(PG8_SA(0, 1), a2 + hstep, voffA);
      PG8_WAIT_L(8); PG8_BAR; PG8_WAIT_L(0); PG8_MMA(0, 0, At, B0); PG8_BAR; PG8_SCHED;
      PG8_LDB(B1, 1, 1); PG8_STAGE(PG8_SB(1, 0), b3, voffB);
      PG8_BAR; PG8_WAIT_L(0); PG8_MMA(0, 1, At, B1); PG8_BAR;
      PG8_LDA(At, 1, 1); PG8_STAGE(PG8_SA(1, 0), a3, voffA);
      PG8_BAR; PG8_WAIT_L(0); PG8_MMA(1, 0, At, B0); PG8_BAR; PG8_SCHED;
      PG8_STAGE(PG8_SB(1, 1), b3 + hstep, voffB);
      PG8_WAIT_V(6); PG8_BAR; PG8_MMA(1, 1, At, B1); PG8_BAR;
    }
    E(acc, cur, wr, wc, fr, fq);
    if (!has_next) break;
#pragma unroll
    for (int a = 0; a < 2; ++a)
#pragma unroll
      for (int b = 0; b < 2; ++b)
#pragma unroll
        for (int m = 0; m < 4; ++m)
#pragma unroll
          for (int n = 0; n < 2; ++n) acc[a][b][m][n] = (f32x4){0.f, 0.f, 0.f, 0.f};
    cur = nxt; cA = nA; cB = nB; ++ui;
  }
  PG8_WAIT_V(0);
  if (wr == 0) PG8_BAR;
  PG8_BAR;
#undef PG8_SA
#undef PG8_SB
#undef PG8_STAGE
#undef PG8_LDA
#undef PG8_LDB
#undef PG8_MMA
#undef PG8_WAIT_V
#undef PG8_WAIT_L
#undef PG8_BAR
#undef PG8_SCHED
}
}

template <int ACT>
DI void gemm_run(const bf16_t* A, const bf16_t* Bt, int N, int K, bf16_t* C, int ldc, char* smem) {
  pg8::Gemm g; g.A = A; g.Bt = Bt; g.M = T_TOK; g.N = N; g.K = K;
  pg8::StaticOrder S; S.init(T_TOK, N, (int)gridDim.x, (int)blockIdx.x);
  pg8::EpiB<ACT> E; E.O = C; E.ldc = ldc;
  pg8::gemm_phase(( PG8_LAS unsigned char*)smem, g, S, E);
  __syncthreads();
}

DI void gla_gates(const Params& P, const bf16_t* proj, int b, int h, int n, float* sb, float* sseg, float* tmp) {
  const int tid = TIDX & 255;
  float* sw = tmp;
  float* sg = tmp + 1024;
  {
    for (int e = tid; e < 1024; e += 256) sw[e] = P.gla_w_gate[(e >> 6) * 256 + h * 64 + (e & 63)];
    const int i = tid >> 2, part = tid & 3;
    const size_t t = (size_t)b * SEQ + n * 64 + i;
    const u32x2 gu = *(const u32x2*)(proj + t * PW + C_GLR + part * 4);
    sg[i * 17 + part * 4 + 0] = bflo(gu[0]); sg[i * 17 + part * 4 + 1] = bfhi(gu[0]);
    sg[i * 17 + part * 4 + 2] = bflo(gu[1]); sg[i * 17 + part * 4 + 3] = bfhi(gu[1]);
  }
  __syncthreads();
  {
    const int i = tid & 63, dq = tid >> 6;
    float z[16];
#pragma unroll
    for (int dd = 0; dd < 16; ++dd) z[dd] = P.gla_b_gate[h * 64 + dq * 16 + dd];
#pragma unroll 1
    for (int r = 0; r < 16; ++r) {
      const float gv = sg[i * 17 + r];
#pragma unroll
      for (int dd = 0; dd < 16; ++dd) z[dd] += gv * sw[r * 64 + dq * 16 + dd];
    }
#pragma unroll
    for (int dd = 0; dd < 16; ++dd) {
      const float zz = z[dd];
      const float ls = fminf(zz, 0.f) - __logf(1.f + __expf(-fabsf(zz)));
      sb[i * 65 + dq * 16 + dd] = ls * (1.f / 16.f);
    }
  }
  __syncthreads();
  const int d = tid & 63, seg = tid >> 6;
  float pre[16]; float run = 0.f;
#pragma unroll
  for (int ii = 0; ii < 16; ++ii) { run += sb[(seg * 16 + ii) * 65 + d]; pre[ii] = run; }
  sseg[seg * 64 + d] = run;
  __syncthreads();
  float off = 0.f;
#pragma unroll
  for (int s = 0; s < 4; ++s) off += (s < seg) ? sseg[s * 64 + d] : 0.f;
#pragma unroll
  for (int ii = 0; ii < 16; ++ii) sb[(seg * 16 + ii) * 65 + d] = pre[ii] + off;
  __syncthreads();
}

DI void gla_stage_vT(const bf16_t* proj, int b, int h, int n, bf16_t* vT) {
  const int tid = TIDX & 255, j = tid & 63, q4 = tid >> 6;
  const size_t t = (size_t)b * SEQ + n * 64 + j;
  const bf16_t* src = proj + t * PW + C_GV + h * 128 + q4 * 32;
#pragma unroll
  for (int c = 0; c < 4; ++c) {
    const u32x4 u = *(const u32x4*)(src + c * 8);
#pragma unroll
    for (int e = 0; e < 4; ++e) {
      vT[(q4 * 32 + c * 8 + 2 * e) * 72 + j] = (bf16_t)(u[e] & 0xffffu);
      vT[(q4 * 32 + c * 8 + 2 * e + 1) * 72 + j] = (bf16_t)(u[e] >> 16);
    }
  }
}

DI void gla_p1_item(const Params& P, int item, char* smem) {
  const bf16_t* proj = (const bf16_t*)(P.ws + R1);
  float* states = (float*)(P.ws + R2);
  float* decay = (float*)(P.ws + R_DECAY);
  float* sb = (float*)smem; float* sseg = sb + 64 * 65;
  bf16_t* kendT = (bf16_t*)(sseg + 256); bf16_t* vT = kendT + 64 * 72;
  const int n = item & 127, h = (item >> 7) & 3, b = item >> 9;
  const int tid = TIDX & 255, lane = tid & 63, wave = tid >> 6, l32 = lane & 31, kb = lane >> 5;
  gla_gates(P, proj, b, h, n, sb, sseg, (float*)vT);
  {
    const int j = tid & 63, dq = tid >> 6;
    const size_t t = (size_t)b * SEQ + n * 64 + j;
    const u32x4 k0 = *(const u32x4*)(proj + t * PW + C_GK + h * 64 + dq * 16), k1 = *(const u32x4*)(proj + t * PW + C_GK + h * 64 + dq * 16 + 8);
    float kv[16];
#pragma unroll
    for (int e = 0; e < 4; ++e) { kv[2 * e] = bflo(k0[e]); kv[2 * e + 1] = bfhi(k0[e]); kv[8 + 2 * e] = bflo(k1[e]); kv[8 + 2 * e + 1] = bfhi(k1[e]); }
#pragma unroll
    for (int dd = 0; dd < 16; ++dd) {
      const int d = dq * 16 + dd;
      kendT[d * 72 + j] = f2bf(kv[dd] * __expf(sb[63 * 65 + d] - sb[j * 65 + d]));
    }
    if (tid < 64) decay[((size_t)(b * 4 + h) * 128 + n) * 64 + tid] = __expf(sb[63 * 65 + tid]);
  }
  gla_stage_vT(proj, b, h, n, vT);
  __syncthreads();
#pragma unroll
  for (int dt = 0; dt < 2; ++dt) {
    f32x16 acc = zero16();
#pragma unroll
    for (int s = 0; s < 4; ++s) {
      const bf16x8 a = *(const bf16x8*)(vT + (wave * 32 + l32) * 72 + s * 16 + kb * 8);
      const bf16x8 bb = *(const bf16x8*)(kendT + (dt * 32 + l32) * 72 + s * 16 + kb * 8);
      acc = mfma(a, bb, acc);
    }
    float* dst = states + ((size_t)((b * 4 + h) * 128 + n) * 128) * 64;
#pragma unroll
    for (int r = 0; r < 16; ++r) dst[(size_t)(wave * 32 + crow(r, kb)) * 64 + dt * 32 + l32] = acc[r];
  }
  __syncthreads();
}

DI void gla_scan(const Params& P) {
  float* states = (float*)(P.ws + R2);
  const float* decay = (const float*)(P.ws + R_DECAY);
  const int total = 32 * 8192;
  for (int e = blockIdx.x * blockDim.x + TIDX; e < total; e += gridDim.x * blockDim.x) {
    const int bh = e >> 13, idx = e & 8191, d = idx & 63;
    float* p = states + (size_t)bh * 128 * 8192 + idx;
    const float* dc = decay + (size_t)bh * 128 * 64 + d;
    float S = 0.f;
#pragma unroll 8
    for (int n = 0; n < 128; ++n) {
      const float ds = p[(size_t)n * 8192];
      const float dec = dc[n * 64];
      p[(size_t)n * 8192] = S;
      S = dec * S + ds;
    }
  }
}

DI void gla_p3_item(const Params& P, int item, char* smem) {
  const bf16_t* proj = (const bf16_t*)(P.ws + R1);
  const float* states = (const float*)(P.ws + R2);
  bf16_t* mix = (bf16_t*)(P.ws + R3);
  float* sb = (float*)smem; float* sseg = sb + 64 * 65; float* sred = sseg + 256;
  bf16_t* sq = (bf16_t*)(sred + 256); bf16_t* sk = sq + 64 * 72; bf16_t* vT = sk + 64 * 72;
  const int n = item & 127, h = (item >> 7) & 3, b = item >> 9;
  const int tid = TIDX & 255, lane = tid & 63, wave = tid >> 6, l32 = lane & 31, kb = lane >> 5;
  gla_gates(P, proj, b, h, n, sb, sseg, (float*)vT);
  {
    const int i = tid & 63, dq = tid >> 6;
    const size_t t = (size_t)b * SEQ + n * 64 + i;
    const u32x4 q0 = *(const u32x4*)(proj + t * PW + C_GQ + h * 64 + dq * 16), q1 = *(const u32x4*)(proj + t * PW + C_GQ + h * 64 + dq * 16 + 8);
    const u32x4 k0 = *(const u32x4*)(proj + t * PW + C_GK + h * 64 + dq * 16), k1 = *(const u32x4*)(proj + t * PW + C_GK + h * 64 + dq * 16 + 8);
    float qv[16], kv[16];
#pragma unroll
    for (int e = 0; e < 4; ++e) {
      qv[2 * e] = bflo(q0[e]); qv[2 * e + 1] = bfhi(q0[e]); qv[8 + 2 * e] = bflo(q1[e]); qv[8 + 2 * e + 1] = bfhi(q1[e]);
      kv[2 * e] = bflo(k0[e]); kv[2 * e + 1] = bfhi(k0[e]); kv[8 + 2 * e] = bflo(k1[e]); kv[8 + 2 * e + 1] = bfhi(k1[e]);
    }
#pragma unroll
    for (int dd = 0; dd < 16; ++dd) {
      const int d = dq * 16 + dd;
      const float bb = sb[i * 65 + d];
      sq[i * 72 + d] = f2bf(qv[dd] * 0.125f * __expf(bb));
      sk[i * 72 + d] = f2bf(kv[dd] * __expf(-bb));
    }
  }
  gla_stage_vT(proj, b, h, n, vT);
  __syncthreads();
  f32x16 x00 = zero16(), x01 = zero16(), x11 = zero16();
#pragma unroll
  for (int s = 0; s < 4; ++s) {
    const bf16x8 kj0 = *(const bf16x8*)(sk + (l32)*72 + s * 16 + kb * 8);
    const bf16x8 kj1 = *(const bf16x8*)(sk + (32 + l32) * 72 + s * 16 + kb * 8);
    const bf16x8 qi0 = *(const bf16x8*)(sq + (l32)*72 + s * 16 + kb * 8);
    const bf16x8 qi1 = *(const bf16x8*)(sq + (32 + l32) * 72 + s * 16 + kb * 8);
    x00 = mfma(kj0, qi0, x00); x01 = mfma(kj0, qi1, x01); x11 = mfma(kj1, qi1, x11);
  }
#pragma unroll
  for (int r = 0; r < 16; ++r) { const bool keep = crow(r, kb) <= l32; x00[r] = keep ? x00[r] : 0.f; x11[r] = keep ? x11[r] : 0.f; }
  f32x16 o0 = zero16(), o1 = zero16();
  const int dvr = wave * 32 + l32;
#pragma unroll
  for (int s = 0; s < 2; ++s) {
    const bf16x8 p00 = pack8(x00[8 * s], x00[8 * s + 1], x00[8 * s + 2], x00[8 * s + 3], x00[8 * s + 4], x00[8 * s + 5], x00[8 * s + 6], x00[8 * s + 7]);
    const bf16x8 p01 = pack8(x01[8 * s], x01[8 * s + 1], x01[8 * s + 2], x01[8 * s + 3], x01[8 * s + 4], x01[8 * s + 5], x01[8 * s + 6], x01[8 * s + 7]);
    const bf16x8 p11 = pack8(x11[8 * s], x11[8 * s + 1], x11[8 * s + 2], x11[8 * s + 3], x11[8 * s + 4], x11[8 * s + 5], x11[8 * s + 6], x11[8 * s + 7]);
    const bf16x8 v0 = ld2x4(vT + dvr * 72 + 16 * s + 4 * kb);
    const bf16x8 v1 = ld2x4(vT + dvr * 72 + 32 + 16 * s + 4 * kb);
    o0 = mfma(v0, p00, o0); o1 = mfma(v0, p01, o1); o1 = mfma(v1, p11, o1);
  }
  {
    const float* sp = states + ((size_t)((b * 4 + h) * 128 + n) * 128 + dvr) * 64;
#pragma unroll
    for (int s = 0; s < 4; ++s) {
      const float4 f0 = *(const float4*)(sp + s * 16 + kb * 8), f1 = *(const float4*)(sp + s * 16 + kb * 8 + 4);
      const bf16x8 a = pack8(f0.x, f0.y, f0.z, f0.w, f1.x, f1.y, f1.z, f1.w);
      const bf16x8 qi0 = *(const bf16x8*)(sq + (l32)*72 + s * 16 + kb * 8);
      const bf16x8 qi1 = *(const bf16x8*)(sq + (32 + l32) * 72 + s * 16 + kb * 8);
      o0 = mfma(a, qi0, o0); o1 = mfma(a, qi1, o1);
    }
  }
  float s0 = 0.f, s1 = 0.f;
#pragma unroll
  for (int r = 0; r < 16; ++r) { s0 += o0[r] * o0[r]; s1 += o1[r] * o1[r]; }
  s0 += __shfl_xor(s0, 32); s1 += __shfl_xor(s1, 32);
  if (kb == 0) { sred[wave * 64 + l32] = s0; sred[wave * 64 + 32 + l32] = s1; }
  __syncthreads();
  const float t0s = sred[l32] + sred[64 + l32] + sred[128 + l32] + sred[192 + l32];
  const float t1s = sred[32 + l32] + sred[64 + 32 + l32] + sred[128 + 32 + l32] + sred[192 + 32 + l32];
  const float r0 = rsqrtf(t0s * (1.f / 128.f) + EPS), r1 = rsqrtf(t1s * (1.f / 128.f) + EPS);
#pragma unroll
  for (int it = 0; it < 2; ++it) {
    const size_t t = (size_t)b * SEQ + n * 64 + it * 32 + l32;
    const float rr = it ? r1 : r0;
#pragma unroll
    for (int gq = 0; gq < 4; ++gq) {
      const int dv = wave * 32 + 8 * gq + 4 * kb;
      const u32x2 ru = *(const u32x2*)(proj + t * PW + C_GR + h * 128 + dv);
      const float4 gn = *(const float4*)(P.gla_norm + h * 128 + dv);
      float rv[4] = {bflo(ru[0]), bfhi(ru[0]), bflo(ru[1]), bfhi(ru[1])};
      float gv[4] = {gn.x, gn.y, gn.z, gn.w};
      float ov[4];
#pragma unroll
      for (int e = 0; e < 4; ++e) {
        const float a = it ? o1[gq * 4 + e] : o0[gq * 4 + e];
        ov[e] = a * rr * gv[e] * (rv[e] / (1.f + __expf(-rv[e])));
      }
      u32x2 o; o[0] = pk2(ov[0], ov[1]); o[1] = pk2(ov[2], ov[3]);
      *(u32x2*)(mix + t * DM + h * 128 + dv) = o;
    }
  }
  __syncthreads();
}

DI void nsa_compress_task(const Params& P, int task) {
  const bf16_t* proj = (const bf16_t*)(P.ws + R1);
  const int lane = TIDX & 63, l32 = lane & 31, kb = lane >> 5;
  const int ct = task & 15, g = (task >> 4) & 1, b = (task >> 5) & 7, br = task >> 8;
  const bf16_t* w1T = (const bf16_t*)(P.ws + W_CW1) + (size_t)br * 128 * 2048;
  const bf16_t* w2T = (const bf16_t*)(P.ws + W_CW2) + (size_t)br * 64 * 128;
  const float* bias1 = (const float*)(P.ws + W_BIAS1) + br * 128;
  const int c = ct * 32 + l32;
  const int cc = c < 511 ? c : 510;
  const bf16_t* src = proj + ((size_t)b * SEQ + cc * 16) * PW + (br ? C_VC : C_KC) + g * 64 + kb * 8;
  f32x16 acc[4];
#pragma unroll
  for (int i = 0; i < 4; ++i) acc[i] = zero16();
#pragma unroll 1
  for (int ks = 0; ks < 128; ++ks) {
    const int l = ks >> 2, dh0 = (ks & 3) * 16;
    const bf16x8 bf = *(const bf16x8*)(src + (size_t)l * PW + dh0);
#pragma unroll
    for (int ht = 0; ht < 4; ++ht) {
      const bf16x8 af = *(const bf16x8*)(w1T + (size_t)(ht * 32 + l32) * 2048 + ks * 16 + kb * 8);
      acc[ht] = mfma(af, bf, acc[ht]);
    }
  }
#pragma unroll
  for (int ht = 0; ht < 4; ++ht)
#pragma unroll
    for (int r = 0; r < 16; ++r) acc[ht][r] = gelu_tanh(acc[ht][r] + bias1[ht * 32 + crow(r, kb)]);
  f32x16 o[2]; o[0] = zero16(); o[1] = zero16();
#pragma unroll
  for (int ht = 0; ht < 4; ++ht)
#pragma unroll
    for (int s = 0; s < 2; ++s) {
      const bf16x8 hf = pack8(acc[ht][8 * s], acc[ht][8 * s + 1], acc[ht][8 * s + 2], acc[ht][8 * s + 3], acc[ht][8 * s + 4], acc[ht][8 * s + 5], acc[ht][8 * s + 6], acc[ht][8 * s + 7]);
#pragma unroll
      for (int dt = 0; dt < 2; ++dt) {
        const bf16x8 wf = ld2x4(w2T + (size_t)(dt * 32 + l32) * 128 + ht * 32 + 16 * s + 4 * kb);
        o[dt] = mfma(wf, hf, o[dt]);
      }
    }
  if (c < 511) {
    if (br == 0) {
      bf16_t* dst = (bf16_t*)(P.ws + R_KCMP) + ((size_t)(b * 2 + g) * 512 + c) * 64;
#pragma unroll
      for (int dt = 0; dt < 2; ++dt)
#pragma unroll
        for (int gq = 0; gq < 4; ++gq) {
          u32x2 u; u[0] = pk2(o[dt][gq * 4], o[dt][gq * 4 + 1]); u[1] = pk2(o[dt][gq * 4 + 2], o[dt][gq * 4 + 3]);
          *(u32x2*)(dst + dt * 32 + 8 * gq + 4 * kb) = u;
        }
    } else {
      bf16_t* dst = (bf16_t*)(P.ws + R_VCMPT) + (size_t)(b * 2 + g) * 64 * 512 + c;
#pragma unroll
      for (int dt = 0; dt < 2; ++dt)
#pragma unroll
        for (int r = 0; r < 16; ++r) dst[(size_t)(dt * 32 + crow(r, kb)) * 512] = f2bf(o[dt][r]);
    }
  }
}

DI void nsa_transpose_v(const Params& P) {
  const bf16_t* proj = (const bf16_t*)(P.ws + R1);
  const int total = 2 * 8 * 2 * 1024 * 64;
  for (int u = blockIdx.x * blockDim.x + TIDX; u < total; u += gridDim.x * blockDim.x) {
    const int dh = u & 63; int rest = u >> 6; const int t8 = rest & 1023; rest >>= 10;
    const int g = rest & 1, b = (rest >> 1) & 7, which = rest >> 4;
    const bf16_t* src = proj + ((size_t)b * SEQ + t8 * 8) * PW + (which ? C_VW : C_VS) + g * 64 + dh;
    bf16_t v[8];
#pragma unroll
    for (int j = 0; j < 8; ++j) v[j] = src[(size_t)j * PW];
    u32x4 o;
#pragma unroll
    for (int j = 0; j < 4; ++j) o[j] = (unsigned)v[2 * j] | ((unsigned)v[2 * j + 1] << 16);
    bf16_t* dst = (bf16_t*)(P.ws + (which ? R_VWT : R_VST)) + ((size_t)(b * 2 + g) * 64 + dh) * SEQ + t8 * 8;
    *(u32x4*)dst = o;
  }
}

DI f32x16 qk_tile(const bf16_t* krow, const bf16x8 (&qf)[4]) {
  f32x16 s = zero16();
#pragma unroll
  for (int i = 0; i < 4; ++i) { const bf16x8 kf = *(const bf16x8*)(krow + i * 16); s = mfma(kf, qf[i], s); }
  return s;
}

DI float half_max(float x) {
  const auto r = __builtin_amdgcn_permlane32_swap(__float_as_uint(x), __float_as_uint(x), false, false);
  return fmaxf(__uint_as_float(r[0]), __uint_as_float(r[1]));
}
DI float half_sum(float x) {
  const auto r = __builtin_amdgcn_permlane32_swap(__float_as_uint(x), __float_as_uint(x), false, false);
  return __uint_as_float(r[0]) + __uint_as_float(r[1]);
}
DI s16x4 lds_tr(const char* p) { return __builtin_amdgcn_ds_read_tr16_b64_v4i16((__attribute__((address_space(3))) s16x4*)p); }

template <bool EDGE>
DI void softmax_tile(f32x16& s, int k0, int tq, int lo, bool bit, int kb, f32x16& o0, f32x16& o1, float& m, float& l) {
  constexpr float CS = 0.125f * 1.4426950408889634f;
  float tmax = -1e30f;
  if (EDGE) {
#pragma unroll
    for (int r = 0; r < 16; ++r) {
      const int key = k0 + crow(r, kb);
      const bool vd = (key <= tq) && (key > lo);
      s[r] = vd ? s[r] * CS : -1e30f;
      tmax = fmaxf(tmax, s[r]);
    }
  } else {
#pragma unroll
    for (int r = 0; r < 16; ++r) tmax = fmaxf(tmax, s[r]);
    tmax *= CS;
  }
  tmax = bit ? tmax : -1e30f;
  tmax = half_max(tmax);
  if (__ballot(tmax > m) != 0ull) {
    const float mn = fmaxf(m, tmax);
    const float alpha = __builtin_amdgcn_exp2f(m - mn);
    l *= alpha; m = mn;
#pragma unroll
    for (int r = 0; r < 16; ++r) { o0[r] *= alpha; o1[r] *= alpha; }
  }
  const bool live = bit && (m > -5e29f);
  float ps = 0.f;
#pragma unroll
  for (int r = 0; r < 16; ++r) {
    const float e = EDGE ? __builtin_amdgcn_exp2f(s[r] - m) : __builtin_amdgcn_exp2f(__builtin_fmaf(s[r], CS, -m));
    s[r] = live ? e : 0.f;
    ps += s[r];
  }
  l += ps;
}

struct HeadAcc { f32x16 o0, o1; float m, l; };

template <bool EDGE>
DI void attn_step2(const bf16_t* sKt, const char* sVt, const bf16x8 (&qa)[4], const bf16x8 (&qb)[4], int k0, int tq, int lo, bool bit,
                   int lane, HeadAcc& A, HeadAcc& B) {
  const int l32 = lane & 31, kb = lane >> 5, i16 = lane & 15, q = i16 >> 2, p = i16 & 3, gc = (lane >> 4) & 1;
  f32x16 sa = zero16(), sb = zero16();
#pragma unroll
  for (int i = 0; i < 4; ++i) {
    const bf16x8 kf = *(const bf16x8*)(sKt + l32 * 72 + i * 16 + kb * 8);
    sa = mfma(kf, qa[i], sa); sb = mfma(kf, qb[i], sb);
  }
  bf16x8 vf[2][2];
#pragma unroll
  for (int dt = 0; dt < 2; ++dt)
#pragma unroll
    for (int sI = 0; sI < 2; ++sI) {
      const char* vp = sVt + (16 * sI + 4 * kb + q) * 144 + (dt * 32 + gc * 16 + 4 * p) * 2;
      const s16x4 lo4 = lds_tr(vp), hi4 = lds_tr(vp + 8 * 144);
      vf[dt][sI] = __builtin_shufflevector(lo4, hi4, 0, 1, 2, 3, 4, 5, 6, 7);
    }
  softmax_tile<EDGE>(sa, k0, tq, lo, bit, kb, A.o0, A.o1, A.m, A.l);
  softmax_tile<EDGE>(sb, k0, tq, lo, bit, kb, B.o0, B.o1, B.m, B.l);
#pragma unroll
  for (int sI = 0; sI < 2; ++sI) {
    const bf16x8 pa = pack8(sa[8 * sI], sa[8 * sI + 1], sa[8 * sI + 2], sa[8 * sI + 3], sa[8 * sI + 4], sa[8 * sI + 5], sa[8 * sI + 6], sa[8 * sI + 7]);
    const bf16x8 pb = pack8(sb[8 * sI], sb[8 * sI + 1], sb[8 * sI + 2], sb[8 * sI + 3], sb[8 * sI + 4], sb[8 * sI + 5], sb[8 * sI + 6], sb[8 * sI + 7]);
    A.o0 = mfma(vf[0][sI], pa, A.o0); A.o1 = mfma(vf[1][sI], pa, A.o1);
    B.o0 = mfma(vf[0][sI], pb, B.o0); B.o1 = mfma(vf[1][sI], pb, B.o1);
  }
}

template <bool WIN>
DI void nsa_branch2(const bf16_t* kbase, const bf16_t* vbase, char* smem, int st0, int st1, int qt, int tq, const bf16x8 (&qa)[4],
                    const bf16x8 (&qb)[4], unsigned mk0, unsigned mk1, unsigned mk2, unsigned mk3, HeadAcc& A, HeadAcc& B) {
  const int tid = TIDX, lane = tid & 63;
  const int srow = tid >> 3, schunk = (tid & 7) * 8;
  const bf16_t* kg = kbase + (size_t)srow * PW + schunk;
  const bf16_t* vg = vbase + (size_t)srow * PW + schunk;
  const int soff = (srow * 72 + schunk) * 2;
  u32x4 rk = *(const u32x4*)(kg + (size_t)st0 * 64 * PW), rv = *(const u32x4*)(vg + (size_t)st0 * 64 * PW);
  *(u32x4*)(smem + soff) = rk; *(u32x4*)(smem + 9216 + soff) = rv;
  __syncthreads();
  for (int st = st0; st <= st1; ++st) {
    const int cur = (st - st0) & 1;
    if (st < st1) { rk = *(const u32x4*)(kg + (size_t)(st + 1) * 64 * PW); rv = *(const u32x4*)(vg + (size_t)(st + 1) * 64 * PW); }
    const bf16_t* bK = (const bf16_t*)(smem + cur * 18432);
    const char* bV = smem + cur * 18432 + 9216;
    bool bit = true;
    if (!WIN) { const unsigned mw = st < 32 ? mk0 : (st < 64 ? mk1 : (st < 96 ? mk2 : mk3)); bit = (mw >> (st & 31)) & 1u; }
    const bool any = WIN ? true : (__ballot(bit) != 0ull);
#pragma unroll
    for (int tt = 0; tt < 2; ++tt) {
      const int kt = 2 * st + tt;
      const bool in_range = WIN ? (kt <= qt && kt >= qt - 16) : (kt <= qt);
      if (in_range && any) {
        const bool edge = WIN ? (kt == qt || kt == qt - 16) : (kt == qt);
        if (edge) attn_step2<true>(bK + tt * 32 * 72, bV + tt * 32 * 144, qa, qb, kt * 32, tq, WIN ? tq - 512 : -1, bit, lane, A, B);
        else attn_step2<false>(bK + tt * 32 * 72, bV + tt * 32 * 144, qa, qb, kt * 32, tq, WIN ? tq - 512 : -1, bit, lane, A, B);
      }
    }
    if (st < st1) { *(u32x4*)(smem + (cur ^ 1) * 18432 + soff) = rk; *(u32x4*)(smem + (cur ^ 1) * 18432 + 9216 + soff) = rv; }
    __syncthreads();
  }
}

DI void fold_partial(bf16_t* dst, float f, const f32x16& a0, const f32x16& a1, int kb) {
#pragma unroll
  for (int gq = 0; gq < 4; ++gq) {
    bf16_t* d0 = dst + 8 * gq + 4 * kb;
    bf16_t* d1 = d0 + 32;
    const u32x2 p0 = *(const u32x2*)d0, p1 = *(const u32x2*)d1;
    u32x2 u0, u1;
    u0[0] = pk2(bflo(p0[0]) + f * a0[gq * 4], bfhi(p0[0]) + f * a0[gq * 4 + 1]);
    u0[1] = pk2(bflo(p0[1]) + f * a0[gq * 4 + 2], bfhi(p0[1]) + f * a0[gq * 4 + 3]);
    u1[0] = pk2(bflo(p1[0]) + f * a1[gq * 4], bfhi(p1[0]) + f * a1[gq * 4 + 1]);
    u1[1] = pk2(bflo(p1[1]) + f * a1[gq * 4 + 2], bfhi(p1[1]) + f * a1[gq * 4 + 3]);
    *(u32x2*)d0 = u0; *(u32x2*)d1 = u1;
  }
}

DI void nsa_block(const Params& P, int b, int g, int qb, char* smem) {
  const int wv = __builtin_amdgcn_readfirstlane(TIDX >> 6);
  const int qt = qb * 8 + wv;
  float* imp = (float*)smem + wv * 4096;
  const bf16_t* proj = (const bf16_t*)(P.ws + R1);
  bf16_t* mix = (bf16_t*)(P.ws + R3);
  const int lane = TIDX & 63, l32 = lane & 31, kb = lane >> 5;
  const int t0 = qt * 32, tq = t0 + l32;
  const size_t tokq = (size_t)b * SEQ + tq;
  const bf16_t* qrow = proj + tokq * PW;
  const bf16_t* kcmp = (const bf16_t*)(P.ws + R_KCMP) + (size_t)(b * 2 + g) * 512 * 64;
  const bf16_t* vcmpT = (const bf16_t*)(P.ws + R_VCMPT) + (size_t)(b * 2 + g) * 64 * 512;
  const int nct = (qt >> 4) + 1;
  {
  for (int i = lane; i < 4096; i += 64) imp[i] = 0.f;
  for (int hh = 0; hh < 4; ++hh) {
    const int head = g * 4 + hh;
    bf16x8 qf[4];
#pragma unroll
    for (int i = 0; i < 4; ++i) qf[i] = *(const bf16x8*)(qrow + C_NQ + head * 64 + i * 16 + kb * 8);
    float m = -1e30f, l = 0.f;
    for (int ct = 0; ct < nct; ++ct) {
      f32x16 s = qk_tile(kcmp + (size_t)(ct * 32 + l32) * 64 + kb * 8, qf);
      float tmax = -1e30f;
#pragma unroll
      for (int r = 0; r < 16; ++r) {
        const int c = ct * 32 + crow(r, kb);
        const bool vd = (c * 16 + 31 <= tq);
        s[r] = vd ? s[r] * 0.125f : -1e30f;
        tmax = fmaxf(tmax, s[r]);
      }
      const float mn = fmaxf(m, tmax);
      float ps = 0.f;
#pragma unroll
      for (int r = 0; r < 16; ++r) ps += (s[r] > -5e29f) ? __expf(s[r] - mn) : 0.f;
      l = l * __expf(m - mn) + ps; m = mn;
    }
    const float mo = __shfl_xor(m, 32), lo_ = __shfl_xor(l, 32);
    const float M = fmaxf(m, mo);
    const float L = l * __expf(m - M) + lo_ * __expf(mo - M);
    const float invL = 1.f / fmaxf(L, 1e-30f);
    f32x16 o0 = zero16(), o1 = zero16();
    float carry = 0.f;
    for (int ct = 0; ct < nct; ++ct) {
      f32x16 s = qk_tile(kcmp + (size_t)(ct * 32 + l32) * 64 + kb * 8, qf);
#pragma unroll
      for (int r = 0; r < 16; ++r) {
        const int c = ct * 32 + crow(r, kb);
        const bool vd = (c * 16 + 31 <= tq);
        s[r] = vd ? __expf(s[r] * 0.125f - M) * invL : 0.f;
      }
      float y[4];
#pragma unroll
      for (int gi = 0; gi < 4; ++gi) y[gi] = __shfl_xor(s[4 * gi + 3], 32);
#pragma unroll
      for (int gi = 0; gi < 4; ++gi) {
        const float s4 = (s[4 * gi] + s[4 * gi + 1]) + (s[4 * gi + 2] + s[4 * gi + 3]);
        const float extra = kb ? y[gi] : (gi == 0 ? carry : y[gi > 0 ? gi - 1 : 0]);
        const int j = ct * 8 + 2 * gi + kb;
        imp[j * 32 + l32] += s4 + extra;
      }
      carry = y[3];
#pragma unroll
      for (int sI = 0; sI < 2; ++sI) {
        const bf16x8 pf = pack8(s[8 * sI], s[8 * sI + 1], s[8 * sI + 2], s[8 * sI + 3], s[8 * sI + 4], s[8 * sI + 5], s[8 * sI + 6], s[8 * sI + 7]);
        const bf16x8 va = ld2x4(vcmpT + (size_t)(l32)*512 + ct * 32 + 16 * sI + 4 * kb);
        const bf16x8 vb = ld2x4(vcmpT + (size_t)(32 + l32) * 512 + ct * 32 + 16 * sI + 4 * kb);
        o0 = mfma(va, pf, o0); o1 = mfma(vb, pf, o1);
      }
    }
    const float g0 = sigmoidf_(bf2f(qrow[C_NG + head * 3 + 0]) + P.nsa_gate_b[head * 3 + 0]);
#pragma unroll
    for (int gq = 0; gq < 4; ++gq) {
      u32x2 u0, u1;
      u0[0] = pk2(g0 * o0[gq * 4], g0 * o0[gq * 4 + 1]); u0[1] = pk2(g0 * o0[gq * 4 + 2], g0 * o0[gq * 4 + 3]);
      u1[0] = pk2(g0 * o1[gq * 4], g0 * o1[gq * 4 + 1]); u1[1] = pk2(g0 * o1[gq * 4 + 2], g0 * o1[gq * 4 + 3]);
      *(u32x2*)(mix + tokq * DM + 512 + head * 64 + 8 * gq + 4 * kb) = u0;
      *(u32x2*)(mix + tokq * DM + 512 + head * 64 + 32 + 8 * gq + 4 * kb) = u1;
    }
  }
  asm volatile("s_waitcnt lgkmcnt(0)" ::: "memory");
  __builtin_amdgcn_wave_barrier();
  }
  unsigned mk0 = 0, mk1 = 0, mk2 = 0, mk3 = 0;
  {
    const int cur = tq >> 6, jb = kb * 64;
    unsigned key[64];
#pragma unroll
    for (int i = 0; i < 64; ++i) {
      const int j = jb + i;
      const float v = imp[j * 32 + l32];
      const bool forced = (j == 0) || (j == cur) || (j == cur - 1);
      key[i] = forced ? 0xffffffffu : (j <= cur ? __float_as_uint(v) + 1u : 0u);
    }
    unsigned T = 0u;
#pragma unroll 1
    for (int bit = 31; bit >= 0; --bit) {
      const unsigned Tc = T | (1u << bit);
      int cnt = 0;
#pragma unroll
      for (int i = 0; i < 64; ++i) cnt += (key[i] >= Tc) ? 1 : 0;
      const auto r = __builtin_amdgcn_permlane32_swap((unsigned)cnt, (unsigned)cnt, false, false);
      cnt = (int)(r[0] + r[1]);
      T = (cnt >= 16) ? Tc : T;
    }
    int cgt = 0, ceq = 0;
#pragma unroll
    for (int i = 0; i < 64; ++i) { cgt += (key[i] > T) ? 1 : 0; ceq += (key[i] == T) ? 1 : 0; }
    const auto rg = __builtin_amdgcn_permlane32_swap((unsigned)cgt, (unsigned)cgt, false, false);
    const int need = 16 - (int)(rg[0] + rg[1]);
    const auto re = __builtin_amdgcn_permlane32_swap((unsigned)ceq, (unsigned)ceq, false, false);
    int running = kb ? (int)(re[0] + re[1]) - ceq : 0;
    unsigned mlo = 0u, mhi = 0u;
#pragma unroll
    for (int i = 0; i < 64; ++i) {
      const bool eq = key[i] == T;
      const bool sl = (key[i] != 0u) && ((key[i] > T) || (eq && running < need));
      running += eq ? 1 : 0;
      if (i < 32) mlo |= sl ? (1u << i) : 0u; else mhi |= sl ? (1u << (i - 32)) : 0u;
    }
    const auto rl = __builtin_amdgcn_permlane32_swap(mlo, mlo, false, false);
    const auto rh = __builtin_amdgcn_permlane32_swap(mhi, mhi, false, false);
    const unsigned olo = rl[0] ^ rl[1] ^ mlo, ohi = rh[0] ^ rh[1] ^ mhi;
    mk0 = kb ? olo : mlo; mk1 = kb ? ohi : mhi; mk2 = kb ? mlo : olo; mk3 = kb ? mhi : ohi;
  }
  asm volatile("" ::: "memory");
  __syncthreads();
  const bf16_t* ksel = proj + (size_t)b * SEQ * PW + C_KS + g * 64;
  const bf16_t* vsel = proj + (size_t)b * SEQ * PW + C_VS + g * 64;
  const bf16_t* kwin = proj + (size_t)b * SEQ * PW + C_KW + g * 64;
  const bf16_t* vwin = proj + (size_t)b * SEQ * PW + C_VW + g * 64;
  const int st1 = 4 * qb + 3, wst0 = qb > 2 ? 4 * qb - 8 : 0;
#pragma unroll 1
  for (int hp = 0; hp < 2; ++hp) {
    const int head = g * 4 + hp * 2;
    bf16x8 qa[4], qb_[4];
#pragma unroll
    for (int i = 0; i < 4; ++i) {
      qa[i] = *(const bf16x8*)(qrow + C_NQ + head * 64 + i * 16 + kb * 8);
      qb_[i] = *(const bf16x8*)(qrow + C_NQ + (head + 1) * 64 + i * 16 + kb * 8);
    }
    bf16_t* dstA = mix + tokq * DM + 512 + head * 64;
    bf16_t* dstB = dstA + 64;
    HeadAcc A, B;
    A.o0 = zero16(); A.o1 = zero16(); A.m = -1e30f; A.l = 0.f; B.o0 = zero16(); B.o1 = zero16(); B.m = -1e30f; B.l = 0.f;
    nsa_branch2<false>(ksel, vsel, smem, 0, st1, qt, tq, qa, qb_, mk0, mk1, mk2, mk3, A, B);
    {
      const float gA = sigmoidf_(bf2f(qrow[C_NG + head * 3 + 1]) + P.nsa_gate_b[head * 3 + 1]);
      const float gB = sigmoidf_(bf2f(qrow[C_NG + (head + 1) * 3 + 1]) + P.nsa_gate_b[(head + 1) * 3 + 1]);
      fold_partial(dstA, gA / fmaxf(half_sum(A.l), 1e-30f), A.o0, A.o1, kb);
      fold_partial(dstB, gB / fmaxf(half_sum(B.l), 1e-30f), B.o0, B.o1, kb);
    }
    A.o0 = zero16(); A.o1 = zero16(); A.m = -1e30f; A.l = 0.f; B.o0 = zero16(); B.o1 = zero16(); B.m = -1e30f; B.l = 0.f;
    nsa_branch2<true>(kwin, vwin, smem, wst0, st1, qt, tq, qa, qb_, 0u, 0u, 0u, 0u, A, B);
    {
      const float gA = sigmoidf_(bf2f(qrow[C_NG + head * 3 + 2]) + P.nsa_gate_b[head * 3 + 2]);
      const float gB = sigmoidf_(bf2f(qrow[C_NG + (head + 1) * 3 + 2]) + P.nsa_gate_b[(head + 1) * 3 + 2]);
      fold_partial(dstA, gA / fmaxf(half_sum(A.l), 1e-30f), A.o0, A.o1, kb);
      fold_partial(dstB, gB / fmaxf(half_sum(B.l), 1e-30f), B.o0, B.o1, kb);
    }
  }
}

DI void sgu_item(const Params& P, int item, char* smem) {
  const bf16_t* H = (const bf16_t*)(P.ws + R1);
  bf16_t* Y = (bf16_t*)P.out;
  float* smu = (float*)smem; float* srs = smu + 128; float* sc1 = srs + 128; float* srw = sc1 + 128;
  bf16_t* sW = (bf16_t*)(smem + 2048);
  char* sV = smem + 2048 + 34816;
  const int tid = TIDX, lane = tid & 63, wave = __builtin_amdgcn_readfirstlane(tid >> 6), l32 = lane & 31, kb = lane >> 5;
  const size_t tok0 = (size_t)item * 128;
#pragma unroll 1
  for (int tb = 0; tb < 16; tb += 4) {
    u32x4 uu[4][4];
#pragma unroll
    for (int a = 0; a < 4; ++a)
#pragma unroll
      for (int k = 0; k < 4; ++k) uu[a][k] = *(const u32x4*)(H + (tok0 + wave * 16 + tb + a) * 4096 + 2048 + k * 512 + lane * 8);
#pragma unroll
    for (int a = 0; a < 4; ++a) {
      float sm = 0.f, s2 = 0.f;
#pragma unroll
      for (int k = 0; k < 4; ++k)
#pragma unroll
        for (int e = 0; e < 4; ++e) { const float x0 = bflo(uu[a][k][e]), x1 = bfhi(uu[a][k][e]); sm += x0 + x1; s2 += x0 * x0 + x1 * x1; }
      sm = wave_sum(sm); s2 = wave_sum(s2);
      const float mu = sm * (1.f / 2048.f);
      const float var = fmaxf(s2 * (1.f / 2048.f) - mu * mu, 0.f);
      if (lane == 0) { smu[wave * 16 + tb + a] = mu; srs[wave * 16 + tb + a] = rsqrtf(var + EPS); }
    }
  }
  __syncthreads();
  const int srow = tid >> 5, schunk = tid & 31;
#pragma unroll 1
  for (int g = 0; g < 8; ++g) {
    u32x4 vreg[8], ureg[8];
#pragma unroll
    for (int i = 0; i < 8; ++i) {
      const bf16_t* hp = H + (tok0 + srow + 16 * i) * 4096 + g * 256 + schunk * 8;
      vreg[i] = *(const u32x4*)(hp + 2048);
      ureg[i] = *(const u32x4*)hp;
    }
    {
      const int t = tid >> 2, qr = tid & 3;
      const float* wrow = P.o_w_s + ((size_t)g * 128 + t) * 128 + qr * 32;
      float c1 = 0.f, rw = 0.f;
#pragma unroll 1
      for (int c8 = 0; c8 < 4; ++c8) {
        const float4 f0 = *(const float4*)(wrow + c8 * 8), f1 = *(const float4*)(wrow + c8 * 8 + 4);
        float wv[8] = {f0.x, f0.y, f0.z, f0.w, f1.x, f1.y, f1.z, f1.w};
        float ov[8];
#pragma unroll
        for (int e = 0; e < 8; ++e) {
          const int sx = qr * 32 + c8 * 8 + e;
          const float w = (sx <= t) ? wv[e] : 0.f;
          rw += w;
          const float wp = bf2f(f2bf(w * srs[sx]));
          c1 += wp * smu[sx];
          ov[e] = wp;
        }
        u32x4 o; o[0] = pk2(ov[0], ov[1]); o[1] = pk2(ov[2], ov[3]); o[2] = pk2(ov[4], ov[5]); o[3] = pk2(ov[6], ov[7]);
        *(u32x4*)(sW + t * 136 + qr * 32 + c8 * 8) = o;
      }
      c1 += __shfl_xor(c1, 1); rw += __shfl_xor(rw, 1);
      c1 += __shfl_xor(c1, 2); rw += __shfl_xor(rw, 2);
      if (qr == 0) { sc1[t] = c1; srw[t] = rw; }
    }
#pragma unroll
    for (int i = 0; i < 8; ++i) *(u32x4*)(sV + (srow + 16 * i) * 544 + schunk * 16) = vreg[i];
    __syncthreads();
    const int tt = wave & 3, chh = wave >> 2;
    f32x16 acc[4];
#pragma unroll
    for (int c = 0; c < 4; ++c) acc[c] = zero16();
    {
      const int i16 = lane & 15, q = i16 >> 2, p = i16 & 3, gc = (lane >> 4) & 1;
      const char* vb = sV + (8 * kb + q) * 544 + (chh * 128 + gc * 16 + 4 * p) * 2;
      const bf16_t* wb = sW + (tt * 32 + l32) * 136 + kb * 8;
      const int nks = 2 * (tt + 1);
      for (int ks = 0; ks < nks; ++ks) {
        const bf16x8 wf = *(const bf16x8*)(wb + ks * 16);
#pragma unroll
        for (int c = 0; c < 4; ++c) {
          const s16x4 lo = lds_tr(vb + ks * 16 * 544 + c * 64);
          const s16x4 hi = lds_tr(vb + (ks * 16 + 4) * 544 + c * 64);
          const bf16x8 vf = __builtin_shufflevector(lo, hi, 0, 1, 2, 3, 4, 5, 6, 7);
          acc[c] = mfma(vf, wf, acc[c]);
        }
      }
    }
    __syncthreads();
    {
      const int t = tt * 32 + l32;
      const float c1 = sc1[t], rw = srw[t], bs = P.o_b_s[g * 128 + t];
#pragma unroll
      for (int c = 0; c < 4; ++c)
#pragma unroll
        for (int gq = 0; gq < 4; ++gq) {
          const int chl = (chh * 4 + c) * 32 + 8 * gq + 4 * kb;
          const float4 lg = *(const float4*)(P.o_ln_g + g * 256 + chl), lb = *(const float4*)(P.o_ln_b + g * 256 + chl);
          const float m0 = lg.x * (acc[c][gq * 4 + 0] - c1) + lb.x * rw + bs;
          const float m1 = lg.y * (acc[c][gq * 4 + 1] - c1) + lb.y * rw + bs;
          const float m2 = lg.z * (acc[c][gq * 4 + 2] - c1) + lb.z * rw + bs;
          const float m3 = lg.w * (acc[c][gq * 4 + 3] - c1) + lb.w * rw + bs;
          u32x2 o; o[0] = pk2(m0, m1); o[1] = pk2(m2, m3);
          *(u32x2*)(sV + t * 520 + chl * 2) = o;
        }
    }
    __syncthreads();
#pragma unroll
    for (int i = 0; i < 8; ++i) {
      const char* mp = sV + (srow + 16 * i) * 520 + schunk * 16;
      const u32x2 ma = *(const u32x2*)mp, mb = *(const u32x2*)(mp + 8);
      const u32x4 uu = ureg[i];
      u32x4 o;
      o[0] = pk2(bflo(uu[0]) * bflo(ma[0]), bfhi(uu[0]) * bfhi(ma[0]));
      o[1] = pk2(bflo(uu[1]) * bflo(ma[1]), bfhi(uu[1]) * bfhi(ma[1]));
      o[2] = pk2(bflo(uu[2]) * bflo(mb[0]), bfhi(uu[2]) * bfhi(mb[0]));
      o[3] = pk2(bflo(uu[3]) * bflo(mb[1]), bfhi(uu[3]) * bfhi(mb[1]));
      *(u32x4*)(Y + (tok0 + srow + 16 * i) * 2048 + g * 256 + schunk * 8) = o;
    }
    __syncthreads();
  }
}

constexpr int NPHASE = 17;
DI void run_phase(const Params& P, int ph, char* smem) {
  char* ws = P.ws;
  bf16_t* r1 = (bf16_t*)(ws + R1); bf16_t* r2 = (bf16_t*)(ws + R2); bf16_t* r3 = (bf16_t*)(ws + R3); bf16_t* r4 = (bf16_t*)(ws + R4);
  unsigned* cnt = (unsigned*)(ws + W_CNT);
  const int lane = TIDX & 63, wave = TIDX >> 6, half = TIDX >> 8;
  char* hsmem = smem + half * 65536;
  switch (ph) {
    case 0: phase_prep(P); break;
    case 1: gemm_run<0>(r2, (const bf16_t*)(ws + W_EIN), PW, 1024, r1, PW, smem); break;
    case 2: {
      if (blockIdx.x < 64) nsa_compress_task(P, blockIdx.x * WPB + wave);
      volatile int* s_item = (volatile int*)(smem + LDS_BYTES - 16);
      for (;;) {
        __syncthreads();
        if (TIDX == 0) *s_item = (int)atomicAdd(cnt + 0, 1u);
        __syncthreads();
        const int pair = *s_item;
        if (pair >= 2048) break;
        gla_p1_item(P, pair * 2 + half, hsmem);
      }
    } break;
    case 3: gla_scan(P);
    case 30: {
      volatile int* s_item = (volatile int*)(smem + 131072);
      for (;;) {
        __syncthreads();
        if (TIDX == 0) *s_item = (int)atomicAdd(cnt + 1, 1u);
        __syncthreads();
        const int it = *s_item;
        if (it >= 512) break;
        nsa_block(P, (it & 15) >> 1, it & 1, 31 - (it >> 4), smem);
      }
    } break;
    case 4:
      for (int item = blockIdx.x * 2 + half; item < 4096; item += gridDim.x * 2) gla_p3_item(P, item, hsmem);
      break;
    case 5: gemm_run<0>(r3, (const bf16_t*)(ws + W_EOUT), 1024, 1024, r4, 1024, smem); break;
    case 6: resnorm_rows<true, false>(r4, P.x, nullptr, nullptr, r3, P.norm_g + 1 * 1024, P.norm_g + 2 * 1024, r2); break;
    case 7: gemm_run<1>(r2, (const bf16_t*)(ws + W_FFN1_0), 4096, 1024, r1, 4096, smem); break;
    case 8: gemm_run<0>(r1, (const bf16_t*)(ws + W_FFN2_0), 1024, 4096, r4, 1024, smem); break;
    case 9: resnorm_rows<false, false>(r4, nullptr, r3, nullptr, r3, P.norm_g + 3 * 1024, P.norm_g + 4 * 1024, r2); break;
    case 10: gemm_run<2>(r2, (const bf16_t*)(ws + W_OIN), 4096, 1024, r1, 4096, smem); break;
    case 11:
      for (int item = blockIdx.x; item < 512; item += gridDim.x) sgu_item(P, item, smem);
      break;
    case 12: gemm_run<0>((const bf16_t*)P.out, (const bf16_t*)(ws + W_OOUT), 1024, 2048, r4, 1024, smem); break;
    case 13: resnorm_rows<false, false>(r4, nullptr, r3, nullptr, r3, P.norm_g + 5 * 1024, P.norm_g + 6 * 1024, r2); break;
    case 14: gemm_run<1>(r2, (const bf16_t*)(ws + W_FFN1_1), 4096, 1024, r1, 4096, smem); break;
    case 15: gemm_run<0>(r1, (const bf16_t*)(ws + W_FFN2_1), 1024, 4096, r4, 1024, smem); break;
    case 16: resnorm_rows<false, true>(r4, nullptr, r3, P.out, nullptr, P.norm_g + 7 * 1024, nullptr, nullptr); break;
    default: break;
  }
}

#if !MEGA
extern __shared__ __attribute__((aligned(16))) unsigned char lds_dyn[];
__global__ void __launch_bounds__(NTHR, 2) k_phase(Params P, int ph) {
  char* smem = (char*)lds_dyn;
  run_phase(P, ph, smem);
}
#endif

#if MEGA
extern __shared__ __attribute__((aligned(16))) unsigned char lds_dyn[];
__global__ void __launch_bounds__(NTHR, 2) k_mega(Params P) {
  char* smem = (char*)lds_dyn;
  cg::grid_group grid = cg::this_grid();
#define GEMM_PH(n) run_phase(P, n, smem); grid.sync(); if (PROBE == 1) { run_phase(P, n, smem); grid.sync(); }
  run_phase(P, 0, smem); grid.sync();
  if (PROBE == 3) { run_phase(P, 0, smem); grid.sync(); }
  GEMM_PH(1)
  run_phase(P, 2, smem); grid.sync();
  if (PROBE == 4) { if (blockIdx.x == 0 && TIDX == 0) ((unsigned*)(P.ws + W_CNT))[0] = 0u; grid.sync(); run_phase(P, 2, smem); grid.sync(); }
  run_phase(P, 3, smem); grid.sync();
  if (PROBE == 2) {
    if (blockIdx.x == 0 && TIDX == 0) ((unsigned*)(P.ws + W_CNT))[1] = 0u;
    grid.sync();
    run_phase(P, 30, smem); grid.sync();
  }
  run_phase(P, 4, smem); grid.sync();
  if (PROBE == 5) { run_phase(P, 4, smem); grid.sync(); }
  GEMM_PH(5)
  run_phase(P, 6, smem); grid.sync();
  if (PROBE == 6) { run_phase(P, 6, smem); grid.sync(); run_phase(P, 6, smem); grid.sync(); run_phase(P, 6, smem); grid.sync(); }
  GEMM_PH(7)
  GEMM_PH(8)
  run_phase(P, 9, smem); grid.sync();
  GEMM_PH(10)
  run_phase(P, 11, smem); grid.sync();
  if (PROBE == 7) { run_phase(P, 11, smem); grid.sync(); }
  GEMM_PH(12)
  run_phase(P, 13, smem); grid.sync();
  GEMM_PH(14)
  GEMM_PH(15)
  run_phase(P, 16, smem);
}
#endif

extern "C" void kernel_launch(void* const* d_in, const int* in_sizes, int n_in, void* d_out, int out_size, void* d_ws, size_t ws_size,
                              hipStream_t stream) {
  Params p{};
  p.x = (const float*)d_in[0]; p.norm_g = (const float*)d_in[1]; p.ffn_w1 = (const float*)d_in[2]; p.ffn_w2 = (const float*)d_in[3];
  p.e_w_in = (const float*)d_in[4]; p.e_w_out = (const float*)d_in[5]; p.gla_w_gate = (const float*)d_in[6]; p.gla_b_gate = (const float*)d_in[7];
  p.gla_norm = (const float*)d_in[8]; p.nsa_gate_b = (const float*)d_in[9]; p.cmp_pos = (const float*)d_in[10]; p.cmp_w1 = (const float*)d_in[11];
  p.cmp_w2 = (const float*)d_in[12]; p.o_w_in = (const float*)d_in[13]; p.o_ln_g = (const float*)d_in[14]; p.o_ln_b = (const float*)d_in[15];
  p.o_w_s = (const float*)d_in[16]; p.o_b_s = (const float*)d_in[17]; p.o_w_out = (const float*)d_in[18];
  p.out = (float*)d_out; p.ws = (char*)d_ws;
  if (ws_size < 1024ull * MiB) { fprintf(stderr, "workspace too small: %zu\n", ws_size); return; }
  static int grid_blocks = 0;
  if (!grid_blocks) {
    int dev = 0, cus = 0, per_cu = 0;
    (void)hipGetDevice(&dev);
    (void)hipDeviceGetAttribute(&cus, hipDeviceAttributeMultiprocessorCount, dev);
#if MEGA
    if (hipFuncSetAttribute((const void*)k_mega, hipFuncAttributeMaxDynamicSharedMemorySize, LDS_BYTES) != hipSuccess) fprintf(stderr, "hipFuncSetAttribute failed\n");
    (void)hipOccupancyMaxActiveBlocksPerMultiprocessor(&per_cu, (const void*)k_mega, NTHR, LDS_BYTES);
#else
    if (hipFuncSetAttribute((const void*)k_phase, hipFuncAttributeMaxDynamicSharedMemorySize, LDS_BYTES) != hipSuccess) fprintf(stderr, "hipFuncSetAttribute failed\n");
    (void)hipOccupancyMaxActiveBlocksPerMultiprocessor(&per_cu, (const void*)k_phase, NTHR, LDS_BYTES);
#endif
    if (per_cu < 1) fprintf(stderr, "occupancy query returned %d\n", per_cu);
    grid_blocks = cus;
  }
#if MEGA
  void* args[] = {&p};
  hipError_t e = hipLaunchCooperativeKernel((void*)k_mega, dim3(grid_blocks), dim3(NTHR), args, LDS_BYTES, stream);
  if (e != hipSuccess) fprintf(stderr, "cooperative launch failed: %s (grid %d)\n", hipGetErrorString(e), grid_blocks);
#else
  for (int ph = 0; ph < NPHASE; ++ph) k_phase<<<grid_blocks, NTHR, LDS_BYTES, stream>>>(p, ph);
#endif
}
```

```cpp
#include <hip/hip_runtime.h>
#include <hip/hip_cooperative_groups.h>
#include <cstdio>
namespace cg = cooperative_groups;

#ifndef MEGA
#define MEGA 1
#endif
#ifndef PROBE
#define PROBE 0
#endif

typedef unsigned short bf16_t;
typedef short bf16x8 __attribute__((ext_vector_type(8)));
typedef short s16x4 __attribute__((ext_vector_type(4)));
typedef float f32x16 __attribute__((ext_vector_type(16)));
typedef float f32v2 __attribute__((ext_vector_type(2)));
typedef __bf16 bf16v2 __attribute__((ext_vector_type(2)));
typedef unsigned u32x4 __attribute__((ext_vector_type(4)));
typedef unsigned u32x2 __attribute__((ext_vector_type(2)));
#define DI __device__ __forceinline__
DI int tid_opaque() { int t = threadIdx.x; asm volatile("" : "+v"(t)); return t; }
#define TIDX tid_opaque()

constexpr int T_TOK = 65536, SEQ = 8192, DM = 1024;
constexpr int PW = 3072;
constexpr int C_GQ = 0, C_GK = 256, C_GV = 512, C_GLR = 1024, C_GR = 1040, C_NQ = 1552, C_KC = 2064, C_VC = 2192,
              C_KS = 2320, C_VS = 2448, C_KW = 2576, C_VW = 2704, C_NG = 2832;
constexpr float EPS = 1e-6f;
constexpr int NTHR = 512, WPB = 8, LDS_CMP_STAGE = 131072 + 64, LDS_BYTES = 131072 + 64 + 18432;
constexpr size_t MiB = 1024ull * 1024ull;
constexpr size_t W_FFN1_0 = 0, W_FFN1_1 = 8 * MiB, W_FFN2_0 = 16 * MiB, W_FFN2_1 = 24 * MiB, W_EIN = 32 * MiB, W_EOUT = 38 * MiB,
                 W_OIN = 40 * MiB, W_OOUT = 48 * MiB, W_CW1 = 52 * MiB, W_CW2 = 53 * MiB, W_BIAS1 = 53 * MiB + 65536,
                 W_CNT = 53 * MiB + 131072;
constexpr size_t R1 = 64 * MiB, R2 = 576 * MiB, R3 = 704 * MiB, R4 = 832 * MiB, R5 = 960 * MiB;
constexpr size_t R_KCMP = R5, R_VCMPT = R5 + 1 * MiB, R_VST = R5 + 2 * MiB, R_VWT = R5 + 18 * MiB, R_DECAY = R5 + 34 * MiB;

struct Params {
  const float* x; const float* norm_g; const float* ffn_w1; const float* ffn_w2; const float* e_w_in; const float* e_w_out;
  const float* gla_w_gate; const float* gla_b_gate; const float* gla_norm; const float* nsa_gate_b; const float* cmp_pos;
  const float* cmp_w1; const float* cmp_w2; const float* o_w_in; const float* o_ln_g; const float* o_ln_b; const float* o_w_s;
  const float* o_b_s; const float* o_w_out;
  float* out; char* ws;
};

DI int crow(int r, int kb) { return (r & 3) + 8 * (r >> 2) + 4 * kb; }
DI f32x16 mfma(bf16x8 a, bf16x8 b, f32x16 c) { return __builtin_amdgcn_mfma_f32_32x32x16_bf16(a, b, c, 0, 0, 0); }
DI unsigned pk2(float a, float b) { f32v2 v = {a, b}; bf16v2 r = __builtin_convertvector(v, bf16v2); return __builtin_bit_cast(unsigned, r); }
DI bf16_t f2bf(float a) { return (bf16_t)(pk2(a, 0.f) & 0xffffu); }
DI float bf2f(bf16_t u) { return __uint_as_float(((unsigned)u) << 16); }
DI float bflo(unsigned u) { return __uint_as_float(u << 16); }
DI float bfhi(unsigned u) { return __uint_as_float(u & 0xffff0000u); }
DI bf16x8 pack8(float a0, float a1, float a2, float a3, float a4, float a5, float a6, float a7) {
  u32x4 p; p[0] = pk2(a0, a1); p[1] = pk2(a2, a3); p[2] = pk2(a4, a5); p[3] = pk2(a6, a7);
  return __builtin_bit_cast(bf16x8, p);
}
DI bf16x8 ld2x4(const bf16_t* p) {
  s16x4 lo = *(const s16x4*)p; s16x4 hi = *(const s16x4*)(p + 8);
  return __builtin_shufflevector(lo, hi, 0, 1, 2, 3, 4, 5, 6, 7);
}
DI float wave_sum(float v) {
#pragma unroll
  for (int o = 32; o > 0; o >>= 1) v += __shfl_xor(v, o);
  return v;
}
DI f32x16 zero16() { f32x16 z;
#pragma unroll
  for (int i = 0; i < 16; ++i) z[i] = 0.f; return z; }
DI float gelu_tanh(float x) { float u = 1.5957691216f * (x + 0.044715f * x * x * x); return x / (1.f + __expf(-u)); }
DI float sigmoidf_(float x) { return 1.f / (1.f + __expf(-x)); }

DI void conv_weight(const float* __restrict__ src, bf16_t* __restrict__ dst, int K, int N, int Npad) {
  const long total = (long)Npad * (K >> 3);
  const long stride = (long)gridDim.x * blockDim.x;
  for (long i = (long)blockIdx.x * blockDim.x + TIDX; i < total; i += stride) {
    const int n = (int)(i % Npad); const int k8 = (int)(i / Npad);
    float v[8];
#pragma unroll
    for (int j = 0; j < 8; ++j) v[j] = (n < N) ? src[(size_t)(k8 * 8 + j) * N + n] : 0.f;
    u32x4 o; o[0] = pk2(v[0], v[1]); o[1] = pk2(v[2], v[3]); o[2] = pk2(v[4], v[5]); o[3] = pk2(v[6], v[7]);
    *(u32x4*)(dst + (size_t)n * K + k8 * 8) = o;
  }
}

DI void prenorm_rows(const float* __restrict__ x, const float* __restrict__ g, bf16_t* __restrict__ xn) {
  const int lane = TIDX & 63, wave = TIDX >> 6;
  const int nw = gridDim.x * WPB;
  for (int row = blockIdx.x * WPB + wave; row < T_TOK; row += nw) {
    const float4* xr = (const float4*)(x + (size_t)row * DM);
    float4 a[4]; float ss = 0.f;
#pragma unroll
    for (int k = 0; k < 4; ++k) { a[k] = xr[k * 64 + lane]; ss += a[k].x * a[k].x + a[k].y * a[k].y + a[k].z * a[k].z + a[k].w * a[k].w; }
    ss = wave_sum(ss);
    const float rs = rsqrtf(ss * (1.f / DM) + EPS);
#pragma unroll
    for (int k = 0; k < 4; ++k) {
      const float4 gg = ((const float4*)g)[k * 64 + lane];
      u32x2 o; o[0] = pk2(a[k].x * rs * gg.x, a[k].y * rs * gg.y); o[1] = pk2(a[k].z * rs * gg.z, a[k].w * rs * gg.w);
      *(u32x2*)(xn + (size_t)row * DM + k * 256 + lane * 4) = o;
    }
  }
}

template <bool HIN_F32, bool HOUT_F32>
DI void resnorm_rows(const bf16_t* __restrict__ m, const float* __restrict__ hin_f, const bf16_t* hin_b, float* __restrict__ hout_f,
                     bf16_t* hout_b, const float* __restrict__ gpost, const float* __restrict__ gnext, bf16_t* __restrict__ xn) {
  const int lane = TIDX & 63, wave = TIDX >> 6;
  const int nw = gridDim.x * WPB;
  for (int row = blockIdx.x * WPB + wave; row < T_TOK; row += nw) {
    float mv[16]; float ss = 0.f;
#pragma unroll
    for (int k = 0; k < 4; ++k) {
      const u32x2 u = *(const u32x2*)(m + (size_t)row * DM + k * 256 + lane * 4);
      mv[k * 4 + 0] = bflo(u[0]); mv[k * 4 + 1] = bfhi(u[0]); mv[k * 4 + 2] = bflo(u[1]); mv[k * 4 + 3] = bfhi(u[1]);
    }
    float hv[16];
#pragma unroll
    for (int k = 0; k < 4; ++k) {
      if (HIN_F32) {
        const float4 h4 = ((const float4*)(hin_f + (size_t)row * DM))[k * 64 + lane];
        hv[k * 4 + 0] = h4.x; hv[k * 4 + 1] = h4.y; hv[k * 4 + 2] = h4.z; hv[k * 4 + 3] = h4.w;
      } else {
        const u32x2 u = *(const u32x2*)(hin_b + (size_t)row * DM + k * 256 + lane * 4);
        hv[k * 4 + 0] = bflo(u[0]); hv[k * 4 + 1] = bfhi(u[0]); hv[k * 4 + 2] = bflo(u[1]); hv[k * 4 + 3] = bfhi(u[1]);
      }
    }
#pragma unroll
    for (int i = 0; i < 16; ++i) ss += mv[i] * mv[i];
    ss = wave_sum(ss);
    const float rs = rsqrtf(ss * (1.f / DM) + EPS);
    float s2 = 0.f;
#pragma unroll
    for (int k = 0; k < 4; ++k) {
      const float4 gg = ((const float4*)gpost)[k * 64 + lane];
      hv[k * 4 + 0] += mv[k * 4 + 0] * rs * gg.x; hv[k * 4 + 1] += mv[k * 4 + 1] * rs * gg.y;
      hv[k * 4 + 2] += mv[k * 4 + 2] * rs * gg.z; hv[k * 4 + 3] += mv[k * 4 + 3] * rs * gg.w;
      if (HOUT_F32) {
        float4 o; o.x = hv[k * 4 + 0]; o.y = hv[k * 4 + 1]; o.z = hv[k * 4 + 2]; o.w = hv[k * 4 + 3];
        ((float4*)(hout_f + (size_t)row * DM))[k * 64 + lane] = o;
      } else {
        u32x2 o; o[0] = pk2(hv[k * 4 + 0], hv[k * 4 + 1]); o[1] = pk2(hv[k * 4 + 2], hv[k * 4 + 3]);
        *(u32x2*)(hout_b + (size_t)row * DM + k * 256 + lane * 4) = o;
      }
    }
    if (xn) {
#pragma unroll
      for (int i = 0; i < 16; ++i) s2 += hv[i] * hv[i];
      s2 = wave_sum(s2);
      const float r2 = rsqrtf(s2 * (1.f / DM) + EPS);
#pragma unroll
      for (int k = 0; k < 4; ++k) {
        const float4 gg = ((const float4*)gnext)[k * 64 + lane];
        u32x2 o; o[0] = pk2(hv[k * 4 + 0] * r2 * gg.x, hv[k * 4 + 1] * r2 * gg.y); o[1] = pk2(hv[k * 4 + 2] * r2 * gg.z, hv[k * 4 + 3] * r2 * gg.w);
        *(u32x2*)(xn + (size_t)row * DM + k * 256 + lane * 4) = o;
      }
    }
  }
}

DI void phase_prep(const Params& P) {
  char* ws = P.ws;
  conv_weight(P.ffn_w1, (bf16_t*)(ws + W_FFN1_0), 1024, 4096, 4096);
  conv_weight(P.ffn_w1 + (size_t)1024 * 4096, (bf16_t*)(ws + W_FFN1_1), 1024, 4096, 4096);
  conv_weight(P.ffn_w2, (bf16_t*)(ws + W_FFN2_0), 4096, 1024, 1024);
  conv_weight(P.ffn_w2 + (size_t)1024 * 4096, (bf16_t*)(ws + W_FFN2_1), 4096, 1024, 1024);
  conv_weight(P.e_w_in, (bf16_t*)(ws + W_EIN), 1024, 2856, PW);
  conv_weight(P.e_w_out, (bf16_t*)(ws + W_EOUT), 1024, 1024, 1024);
  conv_weight(P.o_w_in, (bf16_t*)(ws + W_OIN), 1024, 4096, 4096);
  conv_weight(P.o_w_out, (bf16_t*)(ws + W_OOUT), 2048, 1024, 1024);
  conv_weight(P.cmp_w1, (bf16_t*)(ws + W_CW1), 2048, 128, 128);
  conv_weight(P.cmp_w1 + 2048 * 128, (bf16_t*)(ws + W_CW1) + 128 * 2048, 2048, 128, 128);
  conv_weight(P.cmp_w2, (bf16_t*)(ws + W_CW2), 128, 64, 64);
  conv_weight(P.cmp_w2 + 128 * 64, (bf16_t*)(ws + W_CW2) + 64 * 128, 128, 64, 64);
  const int lane = TIDX & 63, wave = TIDX >> 6;
  const int gw = blockIdx.x * WPB + wave;
  if (gw < 256) {
    const int i = gw >> 7, hid = gw & 127;
    float s = 0.f;
    for (int kk = lane; kk < 2048; kk += 64) s += P.cmp_pos[i * 2048 + kk] * P.cmp_w1[((size_t)i * 2048 + kk) * 128 + hid];
    s = wave_sum(s);
    if (lane == 0) ((float*)(ws + W_BIAS1))[gw] = s;
  }
  const int gt = blockIdx.x * blockDim.x + TIDX;
  if (gt < 16) ((unsigned*)(ws + W_CNT))[gt] = 0u;
  if (gt < 16 * 64) {
    const int bg = gt >> 6, d = gt & 63;
    ((bf16_t*)(ws + R_KCMP))[((size_t)bg * 512 + 511) * 64 + d] = 0;
    ((bf16_t*)(ws + R_VCMPT))[((size_t)bg * 512 + 511) * 64 + d] = 0;
  }
  prenorm_rows(P.x, P.norm_g, (bf16_t*)(ws + R2));
}

namespace pg8 {
#define PG8_LAS __attribute__((address_space(3)))
typedef float f32x4 __attribute__((ext_vector_type(4)));
constexpr int BM = 256, BK = 64, HALF = 128, HTB = HALF * BK * 2, STAGE_BYTES = 8 * HTB, NXCD = 8, WGM = 8;
DI int lds_byte(int r, int c) { const int st = (r >> 4) * 2 + (c >> 5), rr = r & 15, cc = c & 31, ob = rr * 64 + cc * 2; return st * 1024 + (ob ^ (((ob >> 9) & 1) << 5)); }
DI void stage_rc(int b, int& R, int& C) { const int st = b / 1024, sb = b % 1024, swz = sb ^ (((sb >> 9) & 1) << 5); R = (st >> 1) * 16 + swz / 64; C = (st & 1) * 32 + (swz % 64) / 2; }
DI int perm32(int rho) { const int n = rho >> 4, i = rho & 15; return 8 * (i >> 2) + 4 * n + (i & 3); }
struct Unit { int pm, pn; };
struct Gemm { const bf16_t* A; const bf16_t* Bt; int M, N, K; };
struct StaticOrder {
  int nM, nN, nwg, G, c;
  DI void init(int M, int N, int G_, int c_) { nM = M / BM; nN = N / BM; nwg = nM * nN; G = G_; c = c_; }
  DI bool next(int i, Unit& u) const {
    const long L = (long)i * G + c; if (L >= nwg) return false;
    int wgid = (int)L; { const int q = nwg / NXCD, r = nwg % NXCD, xcd = wgid % NXCD, off = wgid / NXCD; wgid = (xcd < r ? xcd * (q + 1) : r * (q + 1) + (xcd - r) * q) + off; }
    const int nig = WGM * nN, gid = wgid / nig, fm = gid * WGM, gsz = (nM - fm) < WGM ? (nM - fm) : WGM;
    u.pm = fm + ((wgid % nig) % gsz); u.pn = (wgid % nig) / gsz; return true;
  }
};
template <int ACT> struct EpiB {
  static constexpr bool PERM = true;
  bf16_t* O; int ldc;
  DI void operator()(const f32x4 (&acc)[2][2][4][2], const Unit& u, int wr, int wc, int fr, int fq) const {
    const int row0 = u.pm * BM + wr * 64 + fr; const int col0 = u.pn * BM + wc * 32 + 8 * fq;
#pragma unroll
    for (int ai = 0; ai < 2; ++ai)
#pragma unroll
      for (int m = 0; m < 4; ++m) {
        bf16_t* rowp = O + (size_t)(row0 + ai * HALF + m * 16) * ldc + col0;
#pragma unroll
        for (int bj = 0; bj < 2; ++bj) {
          f32x4 v0 = acc[ai][bj][m][0], v1 = acc[ai][bj][m][1];
          if (ACT == 1) {
#pragma unroll
            for (int j = 0; j < 4; ++j) { const float a = fmaxf(v0[j], 0.f), b = fmaxf(v1[j], 0.f); v0[j] = a * a; v1[j] = b * b; }
          }
          if (ACT == 2) {
#pragma unroll
            for (int j = 0; j < 4; ++j) { v0[j] = gelu_tanh(v0[j]); v1[j] = gelu_tanh(v1[j]); }
          }
          u32x4 w; w[0] = pk2(v0[0], v0[1]); w[1] = pk2(v0[2], v0[3]); w[2] = pk2(v1[0], v1[1]); w[3] = pk2(v1[2], v1[3]);
          *(u32x4*)(rowp + bj * HALF) = w;
        }
      }
  }
};

template <class Epi, class Sched>
DI void gemm_phase(PG8_LAS unsigned char* lds, const Gemm g, const Sched& S, const Epi& E) {
  const int tid_ = TIDX;
  const int tid = tid_, wid = __builtin_amdgcn_readfirstlane(tid >> 6), lane = tid & 63, wr = wid >> 2, wc = wid & 3, fr = lane & 15, fq = lane >> 4;
  const int K = g.K, nt = K / BK;
  unsigned voffA[2], voffB[2];
#pragma unroll
  for (int i = 0; i < 2; ++i) { int R, C; stage_rc(tid * 16 + i * 8192, R, C); const int Rb = Epi::PERM ? ((R & ~31) + perm32(R & 31)) : R;
    voffA[i] = (unsigned)(R * K + C) * 2u; voffB[i] = (unsigned)(Rb * K + C) * 2u; }
  const size_t kstep = (size_t)(BK * 2);
  const size_t hstep = (size_t)HALF * K * 2;
  const size_t tstep = 2 * hstep;
  const unsigned ldsw = (unsigned)wid * 1024u;
  const int aoff = lds_byte(wr * 64 + fr, fq * 8), boff = lds_byte(wc * 32 + fr, fq * 8);
#define PG8_SA(b, h) (((b) * 2 + (h)) * HTB)
#define PG8_SB(b, h) ((4 + (b) * 2 + (h)) * HTB)
#define PG8_STAGE(bufoff, gbase, voff) do { _Pragma("unroll") for (int _i = 0; _i < 2; ++_i) \
    __builtin_amdgcn_global_load_lds((const unsigned*)((const char*)(gbase) + (voff)[_i]), (PG8_LAS unsigned*)(lds + (bufoff) + ldsw + _i * 8192), 16, 0, 0); } while (0)
#define PG8_LDA(dst, b, h) do { _Pragma("unroll") for (int m = 0; m < 4; ++m) _Pragma("unroll") for (int k = 0; k < 2; ++k) dst[m][k] = *(const PG8_LAS bf16x8*)(lds + PG8_SA(b, h) + aoff + m * 2048 + k * 1024); } while (0)
#define PG8_LDB(dst, b, h) do { _Pragma("unroll") for (int n = 0; n < 2; ++n) _Pragma("unroll") for (int k = 0; k < 2; ++k) dst[n][k] = *(const PG8_LAS bf16x8*)(lds + PG8_SB(b, h) + boff + n * 2048 + k * 1024); } while (0)
#define PG8_MMA(ai, bj, At, Bt) do { __builtin_amdgcn_s_setprio(1); _Pragma("unroll") for (int m = 0; m < 4; ++m) _Pragma("unroll") for (int n = 0; n < 2; ++n) _Pragma("unroll") for (int k = 0; k < 2; ++k) \
    acc[ai][bj][m][n] = __builtin_amdgcn_mfma_f32_16x16x32_bf16(Bt[n][k], At[m][k], acc[ai][bj][m][n], 0, 0, 0); __builtin_amdgcn_s_setprio(0); } while (0)
#define PG8_WAIT_V(n) asm volatile("s_waitcnt vmcnt(" #n ")" ::: "memory")
#define PG8_WAIT_L(n) asm volatile("s_waitcnt lgkmcnt(" #n ")" ::: "memory")
#define PG8_BAR __builtin_amdgcn_s_barrier()
#define PG8_SCHED __builtin_amdgcn_sched_barrier(0)
  Unit cur, nxt; int ui = 0;
  if (!S.next(0, cur)) return;
  f32x4 acc[2][2][4][2];
#pragma unroll
  for (int a = 0; a < 2; ++a)
#pragma unroll
    for (int b = 0; b < 2; ++b)
#pragma unroll
      for (int m = 0; m < 4; ++m)
#pragma unroll
        for (int n = 0; n < 2; ++n) acc[a][b][m][n] = (f32x4){0.f, 0.f, 0.f, 0.f};
  bf16x8 At[4][2], B0[2][2], B1[2][2];
  const char* cA = (const char*)g.A + (size_t)cur.pm * tstep; const char* cB = (const char*)g.Bt + (size_t)cur.pn * tstep;
  PG8_STAGE(PG8_SB(0, 0), cB, voffB); PG8_STAGE(PG8_SA(0, 0), cA, voffA); PG8_STAGE(PG8_SB(0, 1), cB + hstep, voffB); PG8_STAGE(PG8_SA(0, 1), cA + hstep, voffA);
  if (wr == 1) PG8_BAR;
  PG8_WAIT_V(4); PG8_BAR;
  PG8_STAGE(PG8_SB(1, 0), cB + kstep, voffB); PG8_STAGE(PG8_SA(1, 0), cA + kstep, voffA); PG8_STAGE(PG8_SB(1, 1), cB + hstep + kstep, voffB);
  PG8_WAIT_V(6); PG8_BAR;
  for (;;) {
    const bool has_next = S.next(ui + 1, nxt);
    const char* nA = has_next ? (const char*)g.A + (size_t)nxt.pm * tstep : cA; const char* nB = has_next ? (const char*)g.Bt + (size_t)nxt.pn * tstep : cB;
    for (int t = 0; t < nt; t += 2) {
      const bool last = (t == nt - 2);
      const char* a1 = cA + (size_t)(t + 1) * kstep;
      const char* a2 = last ? nA : cA + (size_t)(t + 2) * kstep; const char* b2 = last ? nB : cB + (size_t)(t + 2) * kstep;
      const char* a3 = a2 + kstep; const char* b3 = b2 + kstep;
      PG8_LDB(B0, 0, 0); PG8_SCHED; PG8_LDA(At, 0, 0); PG8_STAGE(PG8_SA(1, 1), a1 + hstep, voffA);
      PG8_WAIT_L(8); PG8_BAR; PG8_WAIT_L(0); PG8_MMA(0, 0, At, B0); PG8_BAR; PG8_SCHED;
      PG8_LDB(B1, 0, 1); PG8_STAGE(PG8_SB(0, 0), b2, voffB);
      PG8_BAR; PG8_WAIT_L(0); PG8_MMA(0, 1, At, B1); PG8_BAR;
      PG8_LDA(At, 0, 1); PG8_STAGE(PG8_SA(0, 0), a2, voffA);
      PG8_BAR; PG8_WAIT_L(0); PG8_MMA(1, 0, At, B0); PG8_BAR; PG8_SCHED;
      PG8_STAGE(PG8_SB(0, 1), b2 + hstep, voffB);
      PG8_WAIT_V(6); PG8_BAR; PG8_MMA(1, 1, At, B1); PG8_BAR;
      PG8_LDB(B0, 1, 0); PG8_SCHED; PG8_LDA(At, 1, 0); PG8_STAGE(PG8_SA(0, 1), a2 + hstep, voffA);
      PG8_WAIT_L(8); PG8_BAR; PG8_WAIT_L(0); PG8_MMA(0, 0, At, B0); PG8_BAR; PG8_SCHED;
      PG8_LDB(B1, 1, 1); PG8_STAGE(PG8_SB(1, 0), b3, voffB);
      PG8_BAR; PG8_WAIT_L(0); PG8_MMA(0, 1, At, B1); PG8_BAR;
      PG8_LDA(At, 1, 1); PG8_STAGE(PG8_SA(1, 0), a3, voffA);
      PG8_BAR; PG8_WAIT_L(0); PG8_MMA(1, 0, At, B0); PG8_BAR; PG8_SCHED;
      PG8_STAGE(PG8_SB(1, 1), b3 + hstep, voffB);
      PG8_WAIT_V(6); PG8_BAR; PG8_MMA(1, 1, At, B1); PG8_BAR;
    }
    E(acc, cur, wr, wc, fr, fq);
    if (!has_next) break;
#pragma unroll
    for (int a = 0; a < 2; ++a)
#pragma unroll
      for (int b = 0; b < 2; ++b)
#pragma unroll
        for (int m = 0; m < 4; ++m)
#pragma unroll
          for (int n = 0; n < 2; ++n) acc[a][b][m][n] = (f32x4){0.f, 0.f, 0.f, 0.f};
    cur = nxt; cA = nA; cB = nB; ++ui;
  }
  PG8_WAIT_V(0);
  if (wr == 0) PG8_BAR;
  PG8_BAR;
#undef PG8_SA
#undef PG8_SB
#undef PG8_STAGE
#undef PG8_LDA
#undef PG8_LDB
#undef PG8_MMA
#undef PG8_WAIT_V
#undef PG8_WAIT_L
#undef PG8_BAR
#undef PG8_SCHED
}
}

template <int ACT>
DI void gemm_run(const bf16_t* A, const bf16_t* Bt, int N, int K, bf16_t* C, int ldc, char* smem) {
  pg8::Gemm g; g.A = A; g.Bt = Bt; g.M = T_TOK; g.N = N; g.K = K;
  pg8::StaticOrder S; S.init(T_TOK, N, (int)gridDim.x, (int)blockIdx.x);
  pg8::EpiB<ACT> E; E.O = C; E.ldc = ldc;
  pg8::gemm_phase(( PG8_LAS unsigned char*)smem, g, S, E);
  __syncthreads();
}

DI void gla_gates(const Params& P, const bf16_t* proj, int b, int h, int n, float* sb, float* sseg, float* tmp) {
  const int tid = TIDX & 255;
  float* sw = tmp;
  float* sg = tmp + 1024;
  {
    for (int e = tid; e < 1024; e += 256) sw[e] = P.gla_w_gate[(e >> 6) * 256 + h * 64 + (e & 63)];
    const int i = tid >> 2, part = tid & 3;
    const size_t t = (size_t)b * SEQ + n * 64 + i;
    const u32x2 gu = *(const u32x2*)(proj + t * PW + C_GLR + part * 4);
    sg[i * 17 + part * 4 + 0] = bflo(gu[0]); sg[i * 17 + part * 4 + 1] = bfhi(gu[0]);
    sg[i * 17 + part * 4 + 2] = bflo(gu[1]); sg[i * 17 + part * 4 + 3] = bfhi(gu[1]);
  }
  __syncthreads();
  {
    const int i = tid & 63, dq = tid >> 6;
    float z[16];
#pragma unroll
    for (int dd = 0; dd < 16; ++dd) z[dd] = P.gla_b_gate[h * 64 + dq * 16 + dd];
#pragma unroll 1
    for (int r = 0; r < 16; ++r) {
      const float gv = sg[i * 17 + r];
#pragma unroll
      for (int dd = 0; dd < 16; ++dd) z[dd] += gv * sw[r * 64 + dq * 16 + dd];
    }
#pragma unroll
    for (int dd = 0; dd < 16; ++dd) {
      const float zz = z[dd];
      const float ls = fminf(zz, 0.f) - __logf(1.f + __expf(-fabsf(zz)));
      sb[i * 65 + dq * 16 + dd] = ls * (1.f / 16.f);
    }
  }
  __syncthreads();
  const int d = tid & 63, seg = tid >> 6;
  float pre[16]; float run = 0.f;
#pragma unroll
  for (int ii = 0; ii < 16; ++ii) { run += sb[(seg * 16 + ii) * 65 + d]; pre[ii] = run; }
  sseg[seg * 64 + d] = run;
  __syncthreads();
  float off = 0.f;
#pragma unroll
  for (int s = 0; s < 4; ++s) off += (s < seg) ? sseg[s * 64 + d] : 0.f;
#pragma unroll
  for (int ii = 0; ii < 16; ++ii) sb[(seg * 16 + ii) * 65 + d] = pre[ii] + off;
  __syncthreads();
}

DI void gla_stage_vT(const bf16_t* proj, int b, int h, int n, bf16_t* vT) {
  const int tid = TIDX & 255, j = tid & 63, q4 = tid >> 6;
  const size_t t = (size_t)b * SEQ + n * 64 + j;
  const bf16_t* src = proj + t * PW + C_GV + h * 128 + q4 * 32;
#pragma unroll
  for (int c = 0; c < 4; ++c) {
    const u32x4 u = *(const u32x4*)(src + c * 8);
#pragma unroll
    for (int e = 0; e < 4; ++e) {
      vT[(q4 * 32 + c * 8 + 2 * e) * 72 + j] = (bf16_t)(u[e] & 0xffffu);
      vT[(q4 * 32 + c * 8 + 2 * e + 1) * 72 + j] = (bf16_t)(u[e] >> 16);
    }
  }
}

DI void gla_p1_item(const Params& P, int item, char* smem) {
  const bf16_t* proj = (const bf16_t*)(P.ws + R1);
  float* states = (float*)(P.ws + R2);
  float* decay = (float*)(P.ws + R_DECAY);
  float* sb = (float*)smem; float* sseg = sb + 64 * 65;
  bf16_t* kendT = (bf16_t*)(sseg + 256); bf16_t* vT = kendT + 64 * 72;
  const int n = item & 127, h = (item >> 7) & 3, b = item >> 9;
  const int tid = TIDX & 255, lane = tid & 63, wave = tid >> 6, l32 = lane & 31, kb = lane >> 5;
  gla_gates(P, proj, b, h, n, sb, sseg, (float*)vT);
  {
    const int j = tid & 63, dq = tid >> 6;
    const size_t t = (size_t)b * SEQ + n * 64 + j;
    const u32x4 k0 = *(const u32x4*)(proj + t * PW + C_GK + h * 64 + dq * 16), k1 = *(const u32x4*)(proj + t * PW + C_GK + h * 64 + dq * 16 + 8);
    float kv[16];
#pragma unroll
    for (int e = 0; e < 4; ++e) { kv[2 * e] = bflo(k0[e]); kv[2 * e + 1] = bfhi(k0[e]); kv[8 + 2 * e] = bflo(k1[e]); kv[8 + 2 * e + 1] = bfhi(k1[e]); }
#pragma unroll
    for (int dd = 0; dd < 16; ++dd) {
      const int d = dq * 16 + dd;
      kendT[d * 72 + j] = f2bf(kv[dd] * __expf(sb[63 * 65 + d] - sb[j * 65 + d]));
    }
    if (tid < 64) decay[((size_t)(b * 4 + h) * 128 + n) * 64 + tid] = __expf(sb[63 * 65 + tid]);
  }
  gla_stage_vT(proj, b, h, n, vT);
  __syncthreads();
#pragma unroll
  for (int dt = 0; dt < 2; ++dt) {
    f32x16 acc = zero16();
#pragma unroll
    for (int s = 0; s < 4; ++s) {
      const bf16x8 a = *(const bf16x8*)(vT + (wave * 32 + l32) * 72 + s * 16 + kb * 8);
      const bf16x8 bb = *(const bf16x8*)(kendT + (dt * 32 + l32) * 72 + s * 16 + kb * 8);
      acc = mfma(a, bb, acc);
    }
    float* dst = states + ((size_t)((b * 4 + h) * 128 + n) * 128) * 64;
#pragma unroll
    for (int r = 0; r < 16; ++r) dst[(size_t)(wave * 32 + crow(r, kb)) * 64 + dt * 32 + l32] = acc[r];
  }
  __syncthreads();
}

DI void gla_scan(const Params& P) {
  float* states = (float*)(P.ws + R2);
  const float* decay = (const float*)(P.ws + R_DECAY);
  const int total = 32 * 8192;
  for (int e = blockIdx.x * blockDim.x + TIDX; e < total; e += gridDim.x * blockDim.x) {
    const int bh = e >> 13, idx = e & 8191, d = idx & 63;
    float* p = states + (size_t)bh * 128 * 8192 + idx;
    const float* dc = decay + (size_t)bh * 128 * 64 + d;
    float S = 0.f;
#pragma unroll 8
    for (int n = 0; n < 128; ++n) {
      const float ds = p[(size_t)n * 8192];
      const float dec = dc[n * 64];
      p[(size_t)n * 8192] = S;
      S = dec * S + ds;
    }
  }
}

DI void gla_p3_item(const Params& P, int item, char* smem) {
  const bf16_t* proj = (const bf16_t*)(P.ws + R1);
  const float* states = (const float*)(P.ws + R2);
  bf16_t* mix = (bf16_t*)(P.ws + R3);
  float* sb = (float*)smem; float* sseg = sb + 64 * 65; float* sred = sseg + 256;
  bf16_t* sq = (bf16_t*)(sred + 256); bf16_t* sk = sq + 64 * 72; bf16_t* vT = sk + 64 * 72;
  const int n = item & 127, h = (item >> 7) & 3, b = item >> 9;
  const int tid = TIDX & 255, lane = tid & 63, wave = tid >> 6, l32 = lane & 31, kb = lane >> 5;
  gla_gates(P, proj, b, h, n, sb, sseg, (float*)vT);
  {
    const int i = tid & 63, dq = tid >> 6;
    const size_t t = (size_t)b * SEQ + n * 64 + i;
    const u32x4 q0 = *(const u32x4*)(proj + t * PW + C_GQ + h * 64 + dq * 16), q1 = *(const u32x4*)(proj + t * PW + C_GQ + h * 64 + dq * 16 + 8);
    const u32x4 k0 = *(const u32x4*)(proj + t * PW + C_GK + h * 64 + dq * 16), k1 = *(const u32x4*)(proj + t * PW + C_GK + h * 64 + dq * 16 + 8);
    float qv[16], kv[16];
#pragma unroll
    for (int e = 0; e < 4; ++e) {
      qv[2 * e] = bflo(q0[e]); qv[2 * e + 1] = bfhi(q0[e]); qv[8 + 2 * e] = bflo(q1[e]); qv[8 + 2 * e + 1] = bfhi(q1[e]);
      kv[2 * e] = bflo(k0[e]); kv[2 * e + 1] = bfhi(k0[e]); kv[8 + 2 * e] = bflo(k1[e]); kv[8 + 2 * e + 1] = bfhi(k1[e]);
    }
#pragma unroll
    for (int dd = 0; dd < 16; ++dd) {
      const int d = dq * 16 + dd;
      const float bb = sb[i * 65 + d];
      sq[i * 72 + d] = f2bf(qv[dd] * 0.125f * __expf(bb));
      sk[i * 72 + d] = f2bf(kv[dd] * __expf(-bb));
    }
  }
  gla_stage_vT(proj, b, h, n, vT);
  __syncthreads();
  f32x16 x00 = zero16(), x01 = zero16(), x11 = zero16();
#pragma unroll
  for (int s = 0; s < 4; ++s) {
    const bf16x8 kj0 = *(const bf16x8*)(sk + (l32)*72 + s * 16 + kb * 8);
    const bf16x8 kj1 = *(const bf16x8*)(sk + (32 + l32) * 72 + s * 16 + kb * 8);
    const bf16x8 qi0 = *(const bf16x8*)(sq + (l32)*72 + s * 16 + kb * 8);
    const bf16x8 qi1 = *(const bf16x8*)(sq + (32 + l32) * 72 + s * 16 + kb * 8);
    x00 = mfma(kj0, qi0, x00); x01 = mfma(kj0, qi1, x01); x11 = mfma(kj1, qi1, x11);
  }
#pragma unroll
  for (int r = 0; r < 16; ++r) { const bool keep = crow(r, kb) <= l32; x00[r] = keep ? x00[r] : 0.f; x11[r] = keep ? x11[r] : 0.f; }
  f32x16 o0 = zero16(), o1 = zero16();
  const int dvr = wave * 32 + l32;
#pragma unroll
  for (int s = 0; s < 2; ++s) {
    const bf16x8 p00 = pack8(x00[8 * s], x00[8 * s + 1], x00[8 * s + 2], x00[8 * s + 3], x00[8 * s + 4], x00[8 * s + 5], x00[8 * s + 6], x00[8 * s + 7]);
    const bf16x8 p01 = pack8(x01[8 * s], x01[8 * s + 1], x01[8 * s + 2], x01[8 * s + 3], x01[8 * s + 4], x01[8 * s + 5], x01[8 * s + 6], x01[8 * s + 7]);
    const bf16x8 p11 = pack8(x11[8 * s], x11[8 * s + 1], x11[8 * s + 2], x11[8 * s + 3], x11[8 * s + 4], x11[8 * s + 5], x11[8 * s + 6], x11[8 * s + 7]);
    const bf16x8 v0 = ld2x4(vT + dvr * 72 + 16 * s + 4 * kb);
    const bf16x8 v1 = ld2x4(vT + dvr * 72 + 32 + 16 * s + 4 * kb);
    o0 = mfma(v0, p00, o0); o1 = mfma(v0, p01, o1); o1 = mfma(v1, p11, o1);
  }
  {
    const float* sp = states + ((size_t)((b * 4 + h) * 128 + n) * 128 + dvr) * 64;
#pragma unroll
    for (int s = 0; s < 4; ++s) {
      const float4 f0 = *(const float4*)(sp + s * 16 + kb * 8), f1 = *(const float4*)(sp + s * 16 + kb * 8 + 4);
      const bf16x8 a = pack8(f0.x, f0.y, f0.z, f0.w, f1.x, f1.y, f1.z, f1.w);
      const bf16x8 qi0 = *(const bf16x8*)(sq + (l32)*72 + s * 16 + kb * 8);
      const bf16x8 qi1 = *(const bf16x8*)(sq + (32 + l32) * 72 + s * 16 + kb * 8);
      o0 = mfma(a, qi0, o0); o1 = mfma(a, qi1, o1);
    }
  }
  float s0 = 0.f, s1 = 0.f;
#pragma unroll
  for (int r = 0; r < 16; ++r) { s0 += o0[r] * o0[r]; s1 += o1[r] * o1[r]; }
  s0 += __shfl_xor(s0, 32); s1 += __shfl_xor(s1, 32);
  if (kb == 0) { sred[wave * 64 + l32] = s0; sred[wave * 64 + 32 + l32] = s1; }
  __syncthreads();
  const float t0s = sred[l32] + sred[64 + l32] + sred[128 + l32] + sred[192 + l32];
  const float t1s = sred[32 + l32] + sred[64 + 32 + l32] + sred[128 + 32 + l32] + sred[192 + 32 + l32];
  const float r0 = rsqrtf(t0s * (1.f / 128.f) + EPS), r1 = rsqrtf(t1s * (1.f / 128.f) + EPS);
#pragma unroll
  for (int it = 0; it < 2; ++it) {
    const size_t t = (size_t)b * SEQ + n * 64 + it * 32 + l32;
    const float rr = it ? r1 : r0;
#pragma unroll
    for (int gq = 0; gq < 4; ++gq) {
      const int dv = wave * 32 + 8 * gq + 4 * kb;
      const u32x2 ru = *(const u32x2*)(proj + t * PW + C_GR + h * 128 + dv);
      const float4 gn = *(const float4*)(P.gla_norm + h * 128 + dv);
      float rv[4] = {bflo(ru[0]), bfhi(ru[0]), bflo(ru[1]), bfhi(ru[1])};
      float gv[4] = {gn.x, gn.y, gn.z, gn.w};
      float ov[4];
#pragma unroll
      for (int e = 0; e < 4; ++e) {
        const float a = it ? o1[gq * 4 + e] : o0[gq * 4 + e];
        ov[e] = a * rr * gv[e] * (rv[e] / (1.f + __expf(-rv[e])));
      }
      u32x2 o; o[0] = pk2(ov[0], ov[1]); o[1] = pk2(ov[2], ov[3]);
      *(u32x2*)(mix + t * DM + h * 128 + dv) = o;
    }
  }
  __syncthreads();
}

DI void nsa_compress_task(const Params& P, int task) {
  const bf16_t* proj = (const bf16_t*)(P.ws + R1);
  const int lane = TIDX & 63, l32 = lane & 31, kb = lane >> 5;
  const int ct = task & 15, g = (task >> 4) & 1, b = (task >> 5) & 7, br = task >> 8;
  const bf16_t* w1T = (const bf16_t*)(P.ws + W_CW1) + (size_t)br * 128 * 2048;
  const bf16_t* w2T = (const bf16_t*)(P.ws + W_CW2) + (size_t)br * 64 * 128;
  const float* bias1 = (const float*)(P.ws + W_BIAS1) + br * 128;
  const int c = ct * 32 + l32;
  const int cc = c < 511 ? c : 510;
  const bf16_t* src = proj + ((size_t)b * SEQ + cc * 16) * PW + (br ? C_VC : C_KC) + g * 64 + kb * 8;
  f32x16 acc[4];
#pragma unroll
  for (int i = 0; i < 4; ++i) acc[i] = zero16();
#pragma unroll 1
  for (int ks = 0; ks < 128; ++ks) {
    const int l = ks >> 2, dh0 = (ks & 3) * 16;
    const bf16x8 bf = *(const bf16x8*)(src + (size_t)l * PW + dh0);
#pragma unroll
    for (int ht = 0; ht < 4; ++ht) {
      const bf16x8 af = *(const bf16x8*)(w1T + (size_t)(ht * 32 + l32) * 2048 + ks * 16 + kb * 8);
      acc[ht] = mfma(af, bf, acc[ht]);
    }
  }
#pragma unroll
  for (int ht = 0; ht < 4; ++ht)
#pragma unroll
    for (int r = 0; r < 16; ++r) acc[ht][r] = gelu_tanh(acc[ht][r] + bias1[ht * 32 + crow(r, kb)]);
  f32x16 o[2]; o[0] = zero16(); o[1] = zero16();
#pragma unroll
  for (int ht = 0; ht < 4; ++ht)
#pragma unroll
    for (int s = 0; s < 2; ++s) {
      const bf16x8 hf = pack8(acc[ht][8 * s], acc[ht][8 * s + 1], acc[ht][8 * s + 2], acc[ht][8 * s + 3], acc[ht][8 * s + 4], acc[ht][8 * s + 5], acc[ht][8 * s + 6], acc[ht][8 * s + 7]);
#pragma unroll
      for (int dt = 0; dt < 2; ++dt) {
        const bf16x8 wf = ld2x4(w2T + (size_t)(dt * 32 + l32) * 128 + ht * 32 + 16 * s + 4 * kb);
        o[dt] = mfma(wf, hf, o[dt]);
      }
    }
  if (c < 511) {
    {
      bf16_t* dst = (bf16_t*)(P.ws + (br ? R_VCMPT : R_KCMP)) + ((size_t)(b * 2 + g) * 512 + c) * 64;
#pragma unroll
      for (int dt = 0; dt < 2; ++dt)
#pragma unroll
        for (int gq = 0; gq < 4; ++gq) {
          u32x2 u; u[0] = pk2(o[dt][gq * 4], o[dt][gq * 4 + 1]); u[1] = pk2(o[dt][gq * 4 + 2], o[dt][gq * 4 + 3]);
          *(u32x2*)(dst + dt * 32 + 8 * gq + 4 * kb) = u;
        }
    }
  }
}

DI void nsa_transpose_v(const Params& P) {
  const bf16_t* proj = (const bf16_t*)(P.ws + R1);
  const int total = 2 * 8 * 2 * 1024 * 64;
  for (int u = blockIdx.x * blockDim.x + TIDX; u < total; u += gridDim.x * blockDim.x) {
    const int dh = u & 63; int rest = u >> 6; const int t8 = rest & 1023; rest >>= 10;
    const int g = rest & 1, b = (rest >> 1) & 7, which = rest >> 4;
    const bf16_t* src = proj + ((size_t)b * SEQ + t8 * 8) * PW + (which ? C_VW : C_VS) + g * 64 + dh;
    bf16_t v[8];
#pragma unroll
    for (int j = 0; j < 8; ++j) v[j] = src[(size_t)j * PW];
    u32x4 o;
#pragma unroll
    for (int j = 0; j < 4; ++j) o[j] = (unsigned)v[2 * j] | ((unsigned)v[2 * j + 1] << 16);
    bf16_t* dst = (bf16_t*)(P.ws + (which ? R_VWT : R_VST)) + ((size_t)(b * 2 + g) * 64 + dh) * SEQ + t8 * 8;
    *(u32x4*)dst = o;
  }
}

DI f32x16 qk_tile(const bf16_t* krow, const bf16x8 (&qf)[4]) {
  f32x16 s = zero16();
#pragma unroll
  for (int i = 0; i < 4; ++i) { const bf16x8 kf = *(const bf16x8*)(krow + i * 16); s = mfma(kf, qf[i], s); }
  return s;
}

DI float half_max(float x) {
  const auto r = __builtin_amdgcn_permlane32_swap(__float_as_uint(x), __float_as_uint(x), false, false);
  return fmaxf(__uint_as_float(r[0]), __uint_as_float(r[1]));
}
DI float half_sum(float x) {
  const auto r = __builtin_amdgcn_permlane32_swap(__float_as_uint(x), __float_as_uint(x), false, false);
  return __uint_as_float(r[0]) + __uint_as_float(r[1]);
}
DI s16x4 lds_tr(const char* p) { return __builtin_amdgcn_ds_read_tr16_b64_v4i16((__attribute__((address_space(3))) s16x4*)p); }

template <bool EDGE>
DI void softmax_tile(f32x16& s, int k0, int tq, int lo, bool bit, int kb, f32x16& o0, f32x16& o1, float& m, float& l) {
  constexpr float CS = 0.125f * 1.4426950408889634f;
  float tmax = -1e30f;
  if (EDGE) {
#pragma unroll
    for (int r = 0; r < 16; ++r) {
      const int key = k0 + crow(r, kb);
      const bool vd = (key <= tq) && (key > lo);
      s[r] = vd ? s[r] * CS : -1e30f;
      tmax = fmaxf(tmax, s[r]);
    }
  } else {
#pragma unroll
    for (int r = 0; r < 16; ++r) tmax = fmaxf(tmax, s[r]);
    tmax *= CS;
  }
  tmax = bit ? tmax : -1e30f;
  tmax = half_max(tmax);
  if (__ballot(tmax > m) != 0ull) {
    const float mn = fmaxf(m, tmax);
    const float alpha = __builtin_amdgcn_exp2f(m - mn);
    l *= alpha; m = mn;
#pragma unroll
    for (int r = 0; r < 16; ++r) { o0[r] *= alpha; o1[r] *= alpha; }
  }
  const bool live = bit && (m > -5e29f);
  float ps = 0.f;
#pragma unroll
  for (int r = 0; r < 16; ++r) {
    const float e = EDGE ? __builtin_amdgcn_exp2f(s[r] - m) : __builtin_amdgcn_exp2f(__builtin_fmaf(s[r], CS, -m));
    s[r] = live ? e : 0.f;
    ps += s[r];
  }
  l += ps;
}

struct HeadAcc { f32x16 o0, o1; float m, l; };

template <bool EDGE>
DI void attn_step2(const bf16_t* sKt, const char* sVt, const bf16x8 (&qa)[4], const bf16x8 (&qb)[4], int k0, int tq, int lo, bool bit,
                   int lane, HeadAcc& A, HeadAcc& B) {
  const int l32 = lane & 31, kb = lane >> 5, i16 = lane & 15, q = i16 >> 2, p = i16 & 3, gc = (lane >> 4) & 1;
  f32x16 sa = zero16(), sb = zero16();
#pragma unroll
  for (int i = 0; i < 4; ++i) {
    const bf16x8 kf = *(const bf16x8*)(sKt + l32 * 72 + i * 16 + kb * 8);
    sa = mfma(kf, qa[i], sa); sb = mfma(kf, qb[i], sb);
  }
  bf16x8 vf[2][2];
#pragma unroll
  for (int dt = 0; dt < 2; ++dt)
#pragma unroll
    for (int sI = 0; sI < 2; ++sI) {
      const char* vp = sVt + (16 * sI + 4 * kb + q) * 144 + (dt * 32 + gc * 16 + 4 * p) * 2;
      const s16x4 lo4 = lds_tr(vp), hi4 = lds_tr(vp + 8 * 144);
      vf[dt][sI] = __builtin_shufflevector(lo4, hi4, 0, 1, 2, 3, 4, 5, 6, 7);
    }
  softmax_tile<EDGE>(sa, k0, tq, lo, bit, kb, A.o0, A.o1, A.m, A.l);
  softmax_tile<EDGE>(sb, k0, tq, lo, bit, kb, B.o0, B.o1, B.m, B.l);
#pragma unroll
  for (int sI = 0; sI < 2; ++sI) {
    const bf16x8 pa = pack8(sa[8 * sI], sa[8 * sI + 1], sa[8 * sI + 2], sa[8 * sI + 3], sa[8 * sI + 4], sa[8 * sI + 5], sa[8 * sI + 6], sa[8 * sI + 7]);
    const bf16x8 pb = pack8(sb[8 * sI], sb[8 * sI + 1], sb[8 * sI + 2], sb[8 * sI + 3], sb[8 * sI + 4], sb[8 * sI + 5], sb[8 * sI + 6], sb[8 * sI + 7]);
    A.o0 = mfma(vf[0][sI], pa, A.o0); A.o1 = mfma(vf[1][sI], pa, A.o1);
    B.o0 = mfma(vf[0][sI], pb, B.o0); B.o1 = mfma(vf[1][sI], pb, B.o1);
  }
}

template <bool WIN>
DI void nsa_branch2(const bf16_t* kbase, const bf16_t* vbase, char* smem, int st0, int st1, int qt, int tq, const bf16x8 (&qa)[4],
                    const bf16x8 (&qb)[4], unsigned mk0, unsigned mk1, unsigned mk2, unsigned mk3, HeadAcc& A, HeadAcc& B) {
  const int tid = TIDX, lane = tid & 63;
  const int srow = tid >> 3, schunk = (tid & 7) * 8;
  const bf16_t* kg = kbase + (size_t)srow * PW + schunk;
  const bf16_t* vg = vbase + (size_t)srow * PW + schunk;
  const int soff = (srow * 72 + schunk) * 2;
  u32x4 rk = *(const u32x4*)(kg + (size_t)st0 * 64 * PW), rv = *(const u32x4*)(vg + (size_t)st0 * 64 * PW);
  *(u32x4*)(smem + soff) = rk; *(u32x4*)(smem + 9216 + soff) = rv;
  __syncthreads();
  for (int st = st0; st <= st1; ++st) {
    const int cur = (st - st0) & 1;
    if (st < st1) { rk = *(const u32x4*)(kg + (size_t)(st + 1) * 64 * PW); rv = *(const u32x4*)(vg + (size_t)(st + 1) * 64 * PW); }
    const bf16_t* bK = (const bf16_t*)(smem + cur * 18432);
    const char* bV = smem + cur * 18432 + 9216;
    bool bit = true;
    if (!WIN) { const unsigned mw = st < 32 ? mk0 : (st < 64 ? mk1 : (st < 96 ? mk2 : mk3)); bit = (mw >> (st & 31)) & 1u; }
    const bool any = WIN ? true : (__ballot(bit) != 0ull);
#pragma unroll
    for (int tt = 0; tt < 2; ++tt) {
      const int kt = 2 * st + tt;
      const bool in_range = WIN ? (kt <= qt && kt >= qt - 16) : (kt <= qt);
      if (in_range && any) {
        const bool edge = WIN ? (kt == qt || kt == qt - 16) : (kt == qt);
        if (edge) attn_step2<true>(bK + tt * 32 * 72, bV + tt * 32 * 144, qa, qb, kt * 32, tq, WIN ? tq - 512 : -1, bit, lane, A, B);
        else attn_step2<false>(bK + tt * 32 * 72, bV + tt * 32 * 144, qa, qb, kt * 32, tq, WIN ? tq - 512 : -1, bit, lane, A, B);
      }
    }
    if (st < st1) { *(u32x4*)(smem + (cur ^ 1) * 18432 + soff) = rk; *(u32x4*)(smem + (cur ^ 1) * 18432 + 9216 + soff) = rv; }
    __syncthreads();
  }
}

DI void fold_partial(bf16_t* dst, float f, const f32x16& a0, const f32x16& a1, int kb) {
#pragma unroll
  for (int gq = 0; gq < 4; ++gq) {
    bf16_t* d0 = dst + 8 * gq + 4 * kb;
    bf16_t* d1 = d0 + 32;
    const u32x2 p0 = *(const u32x2*)d0, p1 = *(const u32x2*)d1;
    u32x2 u0, u1;
    u0[0] = pk2(bflo(p0[0]) + f * a0[gq * 4], bfhi(p0[0]) + f * a0[gq * 4 + 1]);
    u0[1] = pk2(bflo(p0[1]) + f * a0[gq * 4 + 2], bfhi(p0[1]) + f * a0[gq * 4 + 3]);
    u1[0] = pk2(bflo(p1[0]) + f * a1[gq * 4], bfhi(p1[0]) + f * a1[gq * 4 + 1]);
    u1[1] = pk2(bflo(p1[1]) + f * a1[gq * 4 + 2], bfhi(p1[1]) + f * a1[gq * 4 + 3]);
    *(u32x2*)d0 = u0; *(u32x2*)d1 = u1;
  }
}

DI void nsa_block(const Params& P, int b, int g, int qb, char* smem) {
  const int wv = __builtin_amdgcn_readfirstlane(TIDX >> 6);
  const int qt = qb * 8 + wv;
  float* imp = (float*)smem + wv * 4096;
  const bf16_t* proj = (const bf16_t*)(P.ws + R1);
  bf16_t* mix = (bf16_t*)(P.ws + R3);
  const int lane = TIDX & 63, l32 = lane & 31, kb = lane >> 5;
  const int t0 = qt * 32, tq = t0 + l32;
  const size_t tokq = (size_t)b * SEQ + tq;
  const bf16_t* qrow = proj + tokq * PW;
  const bf16_t* kcmp = (const bf16_t*)(P.ws + R_KCMP) + (size_t)(b * 2 + g) * 512 * 64;
  const bf16_t* vcmp = (const bf16_t*)(P.ws + R_VCMPT) + (size_t)(b * 2 + g) * 512 * 64;
  const int nct = (qb >> 1) + 1;
  const int nst = (nct + 1) >> 1;
  for (int i = lane; i < 4096; i += 64) imp[i] = 0.f;
  {
    constexpr float CS = 0.125f * 1.4426950408889634f;
    char* stg = smem + LDS_CMP_STAGE;
    const int tid = TIDX;
    const int srow = tid >> 3, schunk = (tid & 7) * 8, soff = (srow * 72 + schunk) * 2;
    const int i16 = lane & 15, q4 = i16 >> 2, p4 = i16 & 3, gc = (lane >> 4) & 1;
#pragma unroll 1
    for (int hp = 0; hp < 2; ++hp) {
      const int head = g * 4 + hp * 2;
      bf16x8 qa[4], qb_[4];
#pragma unroll
      for (int i = 0; i < 4; ++i) {
        qa[i] = *(const bf16x8*)(qrow + C_NQ + head * 64 + i * 16 + kb * 8);
        qb_[i] = *(const bf16x8*)(qrow + C_NQ + (head + 1) * 64 + i * 16 + kb * 8);
      }
      float mA = -1e30f, lA = 0.f, mB = -1e30f, lB = 0.f;
      u32x4 rk = *(const u32x4*)(kcmp + (size_t)srow * 64 + schunk), rv;
      for (int st = 0; st < nst; ++st) {
        *(u32x4*)(stg + soff) = rk;
        __syncthreads();
        if (st + 1 < nst) rk = *(const u32x4*)(kcmp + (size_t)((st + 1) * 64 + srow) * 64 + schunk);
#pragma unroll
        for (int tt = 0; tt < 2; ++tt) {
          const int ct = 2 * st + tt;
          if (ct < nct) {
            const bf16_t* sKt = (const bf16_t*)stg + tt * 32 * 72;
            f32x16 sa = zero16(), sb = zero16();
#pragma unroll
            for (int i = 0; i < 4; ++i) {
              const bf16x8 kf = *(const bf16x8*)(sKt + l32 * 72 + i * 16 + kb * 8);
              sa = mfma(kf, qa[i], sa); sb = mfma(kf, qb_[i], sb);
            }
            float tA = -1e30f, tB = -1e30f;
#pragma unroll
            for (int r = 0; r < 16; ++r) {
              const int c = ct * 32 + crow(r, kb);
              const bool vd = (c * 16 + 31 <= tq);
              sa[r] = vd ? sa[r] * CS : -1e30f; sb[r] = vd ? sb[r] * CS : -1e30f;
              tA = fmaxf(tA, sa[r]); tB = fmaxf(tB, sb[r]);
            }
            const float nA = fmaxf(mA, tA), nB = fmaxf(mB, tB);
            float pA = 0.f, pB = 0.f;
#pragma unroll
            for (int r = 0; r < 16; ++r) {
              pA += (sa[r] > -5e29f) ? __builtin_amdgcn_exp2f(sa[r] - nA) : 0.f;
              pB += (sb[r] > -5e29f) ? __builtin_amdgcn_exp2f(sb[r] - nB) : 0.f;
            }
            lA = lA * __builtin_amdgcn_exp2f(mA - nA) + pA; mA = nA;
            lB = lB * __builtin_amdgcn_exp2f(mB - nB) + pB; mB = nB;
          }
        }
        __syncthreads();
      }
      float MA, iLA, MB, iLB;
      {
        const float mo = __shfl_xor(mA, 32), lo_ = __shfl_xor(lA, 32);
        MA = fmaxf(mA, mo);
        iLA = 1.f / fmaxf(lA * __builtin_amdgcn_exp2f(mA - MA) + lo_ * __builtin_amdgcn_exp2f(mo - MA), 1e-30f);
        const float mo2 = __shfl_xor(mB, 32), lo2 = __shfl_xor(lB, 32);
        MB = fmaxf(mB, mo2);
        iLB = 1.f / fmaxf(lB * __builtin_amdgcn_exp2f(mB - MB) + lo2 * __builtin_amdgcn_exp2f(mo2 - MB), 1e-30f);
      }
      f32x16 oA0 = zero16(), oA1 = zero16(), oB0 = zero16(), oB1 = zero16();
      float carry = 0.f;
      rk = *(const u32x4*)(kcmp + (size_t)srow * 64 + schunk); rv = *(const u32x4*)(vcmp + (size_t)srow * 64 + schunk);
      for (int st = 0; st < nst; ++st) {
        *(u32x4*)(stg + soff) = rk; *(u32x4*)(stg + 9216 + soff) = rv;
        __syncthreads();
        if (st + 1 < nst) {
          rk = *(const u32x4*)(kcmp + (size_t)((st + 1) * 64 + srow) * 64 + schunk);
          rv = *(const u32x4*)(vcmp + (size_t)((st + 1) * 64 + srow) * 64 + schunk);
        }
#pragma unroll
        for (int tt = 0; tt < 2; ++tt) {
          const int ct = 2 * st + tt;
          if (ct < nct) {
            const bf16_t* sKt = (const bf16_t*)stg + tt * 32 * 72;
            const char* sVt = stg + 9216 + tt * 32 * 144;
            f32x16 sa = zero16(), sb = zero16();
#pragma unroll
            for (int i = 0; i < 4; ++i) {
              const bf16x8 kf = *(const bf16x8*)(sKt + l32 * 72 + i * 16 + kb * 8);
              sa = mfma(kf, qa[i], sa); sb = mfma(kf, qb_[i], sb);
            }
            bf16x8 vf[2][2];
#pragma unroll
            for (int dt = 0; dt < 2; ++dt)
#pragma unroll
              for (int sI = 0; sI < 2; ++sI) {
                const char* vp = sVt + (16 * sI + 4 * kb + q4) * 144 + (dt * 32 + gc * 16 + 4 * p4) * 2;
                const s16x4 lo4 = lds_tr(vp), hi4 = lds_tr(vp + 8 * 144);
                vf[dt][sI] = __builtin_shufflevector(lo4, hi4, 0, 1, 2, 3, 4, 5, 6, 7);
              }
            f32x16 ps;
#pragma unroll
            for (int r = 0; r < 16; ++r) {
              const int c = ct * 32 + crow(r, kb);
              const bool vd = (c * 16 + 31 <= tq);
              sa[r] = vd ? __builtin_amdgcn_exp2f(__builtin_fmaf(sa[r], CS, -MA)) * iLA : 0.f;
              sb[r] = vd ? __builtin_amdgcn_exp2f(__builtin_fmaf(sb[r], CS, -MB)) * iLB : 0.f;
              ps[r] = sa[r] + sb[r];
            }
            float y[4];
#pragma unroll
            for (int gi = 0; gi < 4; ++gi) y[gi] = __shfl_xor(ps[4 * gi + 3], 32);
#pragma unroll
            for (int gi = 0; gi < 4; ++gi) {
              const float s4 = (ps[4 * gi] + ps[4 * gi + 1]) + (ps[4 * gi + 2] + ps[4 * gi + 3]);
              const float extra = kb ? y[gi] : (gi == 0 ? carry : y[gi > 0 ? gi - 1 : 0]);
              const int j = ct * 8 + 2 * gi + kb;
              imp[j * 32 + l32] += s4 + extra;
            }
            carry = y[3];
#pragma unroll
            for (int sI = 0; sI < 2; ++sI) {
              const bf16x8 pa = pack8(sa[8 * sI], sa[8 * sI + 1], sa[8 * sI + 2], sa[8 * sI + 3], sa[8 * sI + 4], sa[8 * sI + 5], sa[8 * sI + 6], sa[8 * sI + 7]);
              const bf16x8 pb = pack8(sb[8 * sI], sb[8 * sI + 1], sb[8 * sI + 2], sb[8 * sI + 3], sb[8 * sI + 4], sb[8 * sI + 5], sb[8 * sI + 6], sb[8 * sI + 7]);
              oA0 = mfma(vf[0][sI], pa, oA0); oA1 = mfma(vf[1][sI], pa, oA1);
              oB0 = mfma(vf[0][sI], pb, oB0); oB1 = mfma(vf[1][sI], pb, oB1);
            }
          }
        }
        __syncthreads();
      }
      const float gA = sigmoidf_(bf2f(qrow[C_NG + head * 3 + 0]) + P.nsa_gate_b[head * 3 + 0]);
      const float gB = sigmoidf_(bf2f(qrow[C_NG + (head + 1) * 3 + 0]) + P.nsa_gate_b[(head + 1) * 3 + 0]);
#pragma unroll
      for (int gq = 0; gq < 4; ++gq) {
        u32x2 u0, u1, u2, u3;
        u0[0] = pk2(gA * oA0[gq * 4], gA * oA0[gq * 4 + 1]); u0[1] = pk2(gA * oA0[gq * 4 + 2], gA * oA0[gq * 4 + 3]);
        u1[0] = pk2(gA * oA1[gq * 4], gA * oA1[gq * 4 + 1]); u1[1] = pk2(gA * oA1[gq * 4 + 2], gA * oA1[gq * 4 + 3]);
        u2[0] = pk2(gB * oB0[gq * 4], gB * oB0[gq * 4 + 1]); u2[1] = pk2(gB * oB0[gq * 4 + 2], gB * oB0[gq * 4 + 3]);
        u3[0] = pk2(gB * oB1[gq * 4], gB * oB1[gq * 4 + 1]); u3[1] = pk2(gB * oB1[gq * 4 + 2], gB * oB1[gq * 4 + 3]);
        bf16_t* d = mix + tokq * DM + 512 + head * 64 + 8 * gq + 4 * kb;
        *(u32x2*)d = u0; *(u32x2*)(d + 32) = u1; *(u32x2*)(d + 64) = u2; *(u32x2*)(d + 96) = u3;
      }
    }
  }
  asm volatile("s_waitcnt lgkmcnt(0)" ::: "memory");
  __builtin_amdgcn_wave_barrier();
  unsigned mk0 = 0, mk1 = 0, mk2 = 0, mk3 = 0;
  {
    const int cur = tq >> 6, jb = kb * 64;
    unsigned key[64];
#pragma unroll
    for (int i = 0; i < 64; ++i) {
      const int j = jb + i;
      const float v = imp[j * 32 + l32];
      const bool forced = (j == 0) || (j == cur) || (j == cur - 1);
      key[i] = forced ? 0xffffffffu : (j <= cur ? __float_as_uint(v) + 1u : 0u);
    }
    unsigned T = 0u;
#pragma unroll 1
    for (int bit = 31; bit >= 0; --bit) {
      const unsigned Tc = T | (1u << bit);
      int cnt = 0;
#pragma unroll
      for (int i = 0; i < 64; ++i) cnt += (key[i] >= Tc) ? 1 : 0;
      const auto r = __builtin_amdgcn_permlane32_swap((unsigned)cnt, (unsigned)cnt, false, false);
      cnt = (int)(r[0] + r[1]);
      T = (cnt >= 16) ? Tc : T;
    }
    int cgt = 0, ceq = 0;
#pragma unroll
    for (int i = 0; i < 64; ++i) { cgt += (key[i] > T) ? 1 : 0; ceq += (key[i] == T) ? 1 : 0; }
    const auto rg = __builtin_amdgcn_permlane32_swap((unsigned)cgt, (unsigned)cgt, false, false);
    const int need = 16 - (int)(rg[0] + rg[1]);
    const auto re = __builtin_amdgcn_permlane32_swap((unsigned)ceq, (unsigned)ceq, false, false);
    int running = kb ? (int)(re[0] + re[1]) - ceq : 0;
    unsigned mlo = 0u, mhi = 0u;
#pragma unroll
    for (int i = 0; i < 64; ++i) {
      const bool eq = key[i] == T;
      const bool sl = (key[i] != 0u) && ((key[i] > T) || (eq && running < need));
      running += eq ? 1 : 0;
      if (i < 32) mlo |= sl ? (1u << i) : 0u; else mhi |= sl ? (1u << (i - 32)) : 0u;
    }
    const auto rl = __builtin_amdgcn_permlane32_swap(mlo, mlo, false, false);
    const auto rh = __builtin_amdgcn_permlane32_swap(mhi, mhi, false, false);
    const unsigned olo = rl[0] ^ rl[1] ^ mlo, ohi = rh[0] ^ rh[1] ^ mhi;
    mk0 = kb ? olo : mlo; mk1 = kb ? ohi : mhi; mk2 = kb ? mlo : olo; mk3 = kb ? mhi : ohi;
  }
  asm volatile("" ::: "memory");
  __syncthreads();
  const bf16_t* ksel = proj + (size_t)b * SEQ * PW + C_KS + g * 64;
  const bf16_t* vsel = proj + (size_t)b * SEQ * PW + C_VS + g * 64;
  const bf16_t* kwin = proj + (size_t)b * SEQ * PW + C_KW + g * 64;
  const bf16_t* vwin = proj + (size_t)b * SEQ * PW + C_VW + g * 64;
  const int st1 = 4 * qb + 3, wst0 = qb > 2 ? 4 * qb - 8 : 0;
#pragma unroll 1
  for (int hp = 0; hp < 2; ++hp) {
    const int head = g * 4 + hp * 2;
    bf16x8 qa[4], qb_[4];
#pragma unroll
    for (int i = 0; i < 4; ++i) {
      qa[i] = *(const bf16x8*)(qrow + C_NQ + head * 64 + i * 16 + kb * 8);
      qb_[i] = *(const bf16x8*)(qrow + C_NQ + (head + 1) * 64 + i * 16 + kb * 8);
    }
    bf16_t* dstA = mix + tokq * DM + 512 + head * 64;
    bf16_t* dstB = dstA + 64;
    HeadAcc A, B;
    A.o0 = zero16(); A.o1 = zero16(); A.m = -1e30f; A.l = 0.f; B.o0 = zero16(); B.o1 = zero16(); B.m = -1e30f; B.l = 0.f;
    nsa_branch2<false>(ksel, vsel, smem, 0, st1, qt, tq, qa, qb_, mk0, mk1, mk2, mk3, A, B);
    {
      const float gA = sigmoidf_(bf2f(qrow[C_NG + head * 3 + 1]) + P.nsa_gate_b[head * 3 + 1]);
      const float gB = sigmoidf_(bf2f(qrow[C_NG + (head + 1) * 3 + 1]) + P.nsa_gate_b[(head + 1) * 3 + 1]);
      fold_partial(dstA, gA / fmaxf(half_sum(A.l), 1e-30f), A.o0, A.o1, kb);
      fold_partial(dstB, gB / fmaxf(half_sum(B.l), 1e-30f), B.o0, B.o1, kb);
    }
    A.o0 = zero16(); A.o1 = zero16(); A.m = -1e30f; A.l = 0.f; B.o0 = zero16(); B.o1 = zero16(); B.m = -1e30f; B.l = 0.f;
    nsa_branch2<true>(kwin, vwin, smem, wst0, st1, qt, tq, qa, qb_, 0u, 0u, 0u, 0u, A, B);
    {
      const float gA = sigmoidf_(bf2f(qrow[C_NG + head * 3 + 2]) + P.nsa_gate_b[head * 3 + 2]);
      const float gB = sigmoidf_(bf2f(qrow[C_NG + (head + 1) * 3 + 2]) + P.nsa_gate_b[(head + 1) * 3 + 2]);
      fold_partial(dstA, gA / fmaxf(half_sum(A.l), 1e-30f), A.o0, A.o1, kb);
      fold_partial(dstB, gB / fmaxf(half_sum(B.l), 1e-30f), B.o0, B.o1, kb);
    }
  }
}

DI void sgu_item(const Params& P, int item, char* smem) {
  const bf16_t* H = (const bf16_t*)(P.ws + R1);
  bf16_t* Y = (bf16_t*)P.out;
  float* smu = (float*)smem; float* srs = smu + 128; float* sc1 = srs + 128; float* srw = sc1 + 128;
  bf16_t* sW = (bf16_t*)(smem + 2048);
  char* sV = smem + 2048 + 34816;
  const int tid = TIDX, lane = tid & 63, wave = __builtin_amdgcn_readfirstlane(tid >> 6), l32 = lane & 31, kb = lane >> 5;
  const size_t tok0 = (size_t)item * 128;
#pragma unroll 1
  for (int tb = 0; tb < 16; tb += 4) {
    u32x4 uu[4][4];
#pragma unroll
    for (int a = 0; a < 4; ++a)
#pragma unroll
      for (int k = 0; k < 4; ++k) uu[a][k] = *(const u32x4*)(H + (tok0 + wave * 16 + tb + a) * 4096 + 2048 + k * 512 + lane * 8);
#pragma unroll
    for (int a = 0; a < 4; ++a) {
      float sm = 0.f, s2 = 0.f;
#pragma unroll
      for (int k = 0; k < 4; ++k)
#pragma unroll
        for (int e = 0; e < 4; ++e) { const float x0 = bflo(uu[a][k][e]), x1 = bfhi(uu[a][k][e]); sm += x0 + x1; s2 += x0 * x0 + x1 * x1; }
      sm = wave_sum(sm); s2 = wave_sum(s2);
      const float mu = sm * (1.f / 2048.f);
      const float var = fmaxf(s2 * (1.f / 2048.f) - mu * mu, 0.f);
      if (lane == 0) { smu[wave * 16 + tb + a] = mu; srs[wave * 16 + tb + a] = rsqrtf(var + EPS); }
    }
  }
  __syncthreads();
  const int srow = tid >> 5, schunk = tid & 31;
#pragma unroll 1
  for (int g = 0; g < 8; ++g) {
    u32x4 vreg[8], ureg[8];
#pragma unroll
    for (int i = 0; i < 8; ++i) {
      const bf16_t* hp = H + (tok0 + srow + 16 * i) * 4096 + g * 256 + schunk * 8;
      vreg[i] = *(const u32x4*)(hp + 2048);
      ureg[i] = *(const u32x4*)hp;
    }
    {
      const int t = tid >> 2, qr = tid & 3;
      const float* wrow = P.o_w_s + ((size_t)g * 128 + t) * 128 + qr * 32;
      float c1 = 0.f, rw = 0.f;
#pragma unroll 1
      for (int c8 = 0; c8 < 4; ++c8) {
        const float4 f0 = *(const float4*)(wrow + c8 * 8), f1 = *(const float4*)(wrow + c8 * 8 + 4);
        float wv[8] = {f0.x, f0.y, f0.z, f0.w, f1.x, f1.y, f1.z, f1.w};
        float ov[8];
#pragma unroll
        for (int e = 0; e < 8; ++e) {
          const int sx = qr * 32 + c8 * 8 + e;
          const float w = (sx <= t) ? wv[e] : 0.f;
          rw += w;
          const float wp = bf2f(f2bf(w * srs[sx]));
          c1 += wp * smu[sx];
          ov[e] = wp;
        }
        u32x4 o; o[0] = pk2(ov[0], ov[1]); o[1] = pk2(ov[2], ov[3]); o[2] = pk2(ov[4], ov[5]); o[3] = pk2(ov[6], ov[7]);
        *(u32x4*)(sW + t * 136 + qr * 32 + c8 * 8) = o;
      }
      c1 += __shfl_xor(c1, 1); rw += __shfl_xor(rw, 1);
      c1 += __shfl_xor(c1, 2); rw += __shfl_xor(rw, 2);
      if (qr == 0) { sc1[t] = c1; srw[t] = rw; }
    }
#pragma unroll
    for (int i = 0; i < 8; ++i) *(u32x4*)(sV + (srow + 16 * i) * 544 + schunk * 16) = vreg[i];
    __syncthreads();
    const int tt = wave & 3, chh = wave >> 2;
    f32x16 acc[4];
#pragma unroll
    for (int c = 0; c < 4; ++c) acc[c] = zero16();
    {
      const int i16 = lane & 15, q = i16 >> 2, p = i16 & 3, gc = (lane >> 4) & 1;
      const char* vb = sV + (8 * kb + q) * 544 + (chh * 128 + gc * 16 + 4 * p) * 2;
      const bf16_t* wb = sW + (tt * 32 + l32) * 136 + kb * 8;
      const int nks = 2 * (tt + 1);
      for (int ks = 0; ks < nks; ++ks) {
        const bf16x8 wf = *(const bf16x8*)(wb + ks * 16);
#pragma unroll
        for (int c = 0; c < 4; ++c) {
          const s16x4 lo = lds_tr(vb + ks * 16 * 544 + c * 64);
          const s16x4 hi = lds_tr(vb + (ks * 16 + 4) * 544 + c * 64);
          const bf16x8 vf = __builtin_shufflevector(lo, hi, 0, 1, 2, 3, 4, 5, 6, 7);
          acc[c] = mfma(vf, wf, acc[c]);
        }
      }
    }
    __syncthreads();
    {
      const int t = tt * 32 + l32;
      const float c1 = sc1[t], rw = srw[t], bs = P.o_b_s[g * 128 + t];
#pragma unroll
      for (int c = 0; c < 4; ++c)
#pragma unroll
        for (int gq = 0; gq < 4; ++gq) {
          const int chl = (chh * 4 + c) * 32 + 8 * gq + 4 * kb;
          const float4 lg = *(const float4*)(P.o_ln_g + g * 256 + chl), lb = *(const float4*)(P.o_ln_b + g * 256 + chl);
          const float m0 = lg.x * (acc[c][gq * 4 + 0] - c1) + lb.x * rw + bs;
          const float m1 = lg.y * (acc[c][gq * 4 + 1] - c1) + lb.y * rw + bs;
          const float m2 = lg.z * (acc[c][gq * 4 + 2] - c1) + lb.z * rw + bs;
          const float m3 = lg.w * (acc[c][gq * 4 + 3] - c1) + lb.w * rw + bs;
          u32x2 o; o[0] = pk2(m0, m1); o[1] = pk2(m2, m3);
          *(u32x2*)(sV + t * 520 + chl * 2) = o;
        }
    }
    __syncthreads();
#pragma unroll
    for (int i = 0; i < 8; ++i) {
      const char* mp = sV + (srow + 16 * i) * 520 + schunk * 16;
      const u32x2 ma = *(const u32x2*)mp, mb = *(const u32x2*)(mp + 8);
      const u32x4 uu = ureg[i];
      u32x4 o;
      o[0] = pk2(bflo(uu[0]) * bflo(ma[0]), bfhi(uu[0]) * bfhi(ma[0]));
      o[1] = pk2(bflo(uu[1]) * bflo(ma[1]), bfhi(uu[1]) * bfhi(ma[1]));
      o[2] = pk2(bflo(uu[2]) * bflo(mb[0]), bfhi(uu[2]) * bfhi(mb[0]));
      o[3] = pk2(bflo(uu[3]) * bflo(mb[1]), bfhi(uu[3]) * bfhi(mb[1]));
      *(u32x4*)(Y + (tok0 + srow + 16 * i) * 2048 + g * 256 + schunk * 8) = o;
    }
    __syncthreads();
  }
}

constexpr int NPHASE = 17;
DI void run_phase(const Params& P, int ph, char* smem) {
  char* ws = P.ws;
  bf16_t* r1 = (bf16_t*)(ws + R1); bf16_t* r2 = (bf16_t*)(ws + R2); bf16_t* r3 = (bf16_t*)(ws + R3); bf16_t* r4 = (bf16_t*)(ws + R4);
  unsigned* cnt = (unsigned*)(ws + W_CNT);
  const int lane = TIDX & 63, wave = TIDX >> 6, half = TIDX >> 8;
  char* hsmem = smem + half * 65536;
  switch (ph) {
    case 0: phase_prep(P); break;
    case 1: gemm_run<0>(r2, (const bf16_t*)(ws + W_EIN), PW, 1024, r1, PW, smem); break;
    case 2: {
      if (blockIdx.x < 64) nsa_compress_task(P, blockIdx.x * WPB + wave);
      volatile int* s_item = (volatile int*)(smem + LDS_BYTES - 16);
      for (;;) {
        __syncthreads();
        if (TIDX == 0) *s_item = (int)atomicAdd(cnt + 0, 1u);
        __syncthreads();
        const int pair = *s_item;
        if (pair >= 2048) break;
        gla_p1_item(P, pair * 2 + half, hsmem);
      }
    } break;
    case 3: gla_scan(P);
    case 30: {
      volatile int* s_item = (volatile int*)(smem + 131072);
      for (;;) {
        __syncthreads();
        if (TIDX == 0) *s_item = (int)atomicAdd(cnt + 1, 1u);
        __syncthreads();
        const int it = *s_item;
        if (it >= 512) break;
        nsa_block(P, (it & 15) >> 1, it & 1, 31 - (it >> 4), smem);
      }
    } break;
    case 4:
      for (int item = blockIdx.x * 2 + half; item < 4096; item += gridDim.x * 2) gla_p3_item(P, item, hsmem);
      break;
    case 5: gemm_run<0>(r3, (const bf16_t*)(ws + W_EOUT), 1024, 1024, r4, 1024, smem); break;
    case 6: resnorm_rows<true, false>(r4, P.x, nullptr, nullptr, r3, P.norm_g + 1 * 1024, P.norm_g + 2 * 1024, r2); break;
    case 7: gemm_run<1>(r2, (const bf16_t*)(ws + W_FFN1_0), 4096, 1024, r1, 4096, smem); break;
    case 8: gemm_run<0>(r1, (const bf16_t*)(ws + W_FFN2_0), 1024, 4096, r4, 1024, smem); break;
    case 9: resnorm_rows<false, false>(r4, nullptr, r3, nullptr, r3, P.norm_g + 3 * 1024, P.norm_g + 4 * 1024, r2); break;
    case 10: gemm_run<2>(r2, (const bf16_t*)(ws + W_OIN), 4096, 1024, r1, 4096, smem); break;
    case 11:
      for (int item = blockIdx.x; item < 512; item += gridDim.x) sgu_item(P, item, smem);
      break;
    case 12: gemm_run<0>((const bf16_t*)P.out, (const bf16_t*)(ws + W_OOUT), 1024, 2048, r4, 1024, smem); break;
    case 13: resnorm_rows<false, false>(r4, nullptr, r3, nullptr, r3, P.norm_g + 5 * 1024, P.norm_g + 6 * 1024, r2); break;
    case 14: gemm_run<1>(r2, (const bf16_t*)(ws + W_FFN1_1), 4096, 1024, r1, 4096, smem); break;
    case 15: gemm_run<0>(r1, (const bf16_t*)(ws + W_FFN2_1), 1024, 4096, r4, 1024, smem); break;
    case 16: resnorm_rows<false, true>(r4, nullptr, r3, P.out, nullptr, P.norm_g + 7 * 1024, nullptr, nullptr); break;
    default: break;
  }
}

#if !MEGA
extern __shared__ __attribute__((aligned(16))) unsigned char lds_dyn[];
__global__ void __launch_bounds__(NTHR, 2) k_phase(Params P, int ph) {
  char* smem = (char*)lds_dyn;
  run_phase(P, ph, smem);
}
#endif

#if MEGA
extern __shared__ __attribute__((aligned(16))) unsigned char lds_dyn[];
__global__ void __launch_bounds__(NTHR, 2) k_mega(Params P) {
  char* smem = (char*)lds_dyn;
  cg::grid_group grid = cg::this_grid();
#define GEMM_PH(n) run_phase(P, n, smem); grid.sync(); if (PROBE == 1) { run_phase(P, n, smem); grid.sync(); }
  run_phase(P, 0, smem); grid.sync();
  if (PROBE == 3) { run_phase(P, 0, smem); grid.sync(); }
  GEMM_PH(1)
  run_phase(P, 2, smem); grid.sync();
  if (PROBE == 4) { if (blockIdx.x == 0 && TIDX == 0) ((unsigned*)(P.ws + W_CNT))[0] = 0u; grid.sync(); run_phase(P, 2, smem); grid.sync(); }
  run_phase(P, 3, smem); grid.sync();
  if (PROBE == 2) {
    if (blockIdx.x == 0 && TIDX == 0) ((unsigned*)(P.ws + W_CNT))[1] = 0u;
    grid.sync();
    run_phase(P, 30, smem); grid.sync();
  }
  run_phase(P, 4, smem); grid.sync();
  if (PROBE == 5) { run_phase(P, 4, smem); grid.sync(); }
  GEMM_PH(5)
  run_phase(P, 6, smem); grid.sync();
  if (PROBE == 6) { run_phase(P, 6, smem); grid.sync(); run_phase(P, 6, smem); grid.sync(); run_phase(P, 6, smem); grid.sync(); }
  GEMM_PH(7)
  GEMM_PH(8)
  run_phase(P, 9, smem); grid.sync();
  GEMM_PH(10)
  run_phase(P, 11, smem); grid.sync();
  if (PROBE == 7) { run_phase(P, 11, smem); grid.sync(); }
  GEMM_PH(12)
  run_phase(P, 13, smem); grid.sync();
  GEMM_PH(14)
  GEMM_PH(15)
  run_phase(P, 16, smem);
}
#endif

extern "C" void kernel_launch(void* const* d_in, const int* in_sizes, int n_in, void* d_out, int out_size, void* d_ws, size_t ws_size,
                              hipStream_t stream) {
  Params p{};
  p.x = (const float*)d_in[0]; p.norm_g = (const float*)d_in[1]; p.ffn_w1 = (const float*)d_in[2]; p.ffn_w2 = (const float*)d_in[3];
  p.e_w_in = (const float*)d_in[4]; p.e_w_out = (const float*)d_in[5]; p.gla_w_gate = (const float*)d_in[6]; p.gla_b_gate = (const float*)d_in[7];
  p.gla_norm = (const float*)d_in[8]; p.nsa_gate_b = (const float*)d_in[9]; p.cmp_pos = (const float*)d_in[10]; p.cmp_w1 = (const float*)d_in[11];
  p.cmp_w2 = (const float*)d_in[12]; p.o_w_in = (const float*)d_in[13]; p.o_ln_g = (const float*)d_in[14]; p.o_ln_b = (const float*)d_in[15];
  p.o_w_s = (const float*)d_in[16]; p.o_b_s = (const float*)d_in[17]; p.o_w_out = (const float*)d_in[18];
  p.out = (float*)d_out; p.ws = (char*)d_ws;
  if (ws_size < 1024ull * MiB) { fprintf(stderr, "workspace too small: %zu\n", ws_size); return; }
  static int grid_blocks = 0;
  if (!grid_blocks) {
    int dev = 0, cus = 0, per_cu = 0;
    (void)hipGetDevice(&dev);
    (void)hipDeviceGetAttribute(&cus, hipDeviceAttributeMultiprocessorCount, dev);
#if MEGA
    if (hipFuncSetAttribute((const void*)k_mega, hipFuncAttributeMaxDynamicSharedMemorySize, LDS_BYTES) != hipSuccess) fprintf(stderr, "hipFuncSetAttribute failed\n");
    (void)hipOccupancyMaxActiveBlocksPerMultiprocessor(&per_cu, (const void*)k_mega, NTHR, LDS_BYTES);
#else
    if (hipFuncSetAttribute((const void*)k_phase, hipFuncAttributeMaxDynamicSharedMemorySize, LDS_BYTES) != hipSuccess) fprintf(stderr, "hipFuncSetAttribute failed\n");
    (void)hipOccupancyMaxActiveBlocksPerMultiprocessor(&per_cu, (const void*)k_phase, NTHR, LDS_BYTES);
#endif
    if (per_cu < 1) fprintf(stderr, "occupancy query returned %d\n", per_cu);
    grid_blocks = cus;
  }
#if MEGA
  void* args[] = {&p};
  hipError_t e = hipLaunchCooperativeKernel((void*)k_mega, dim3(grid_blocks), dim3(NTHR), args, LDS_BYTES, stream);
  if (e != hipSuccess) fprintf(stderr, "cooperative launch failed: %s (grid %d)\n", hipGetErrorString(e), grid_blocks);
#else
  for (int ph = 0; ph < NPHASE; ++ph) k_phase<<<grid_blocks, NTHR, LDS_BYTES, stream>>>(p, ph);
#endif
}
```

```cpp
#include <hip/hip_runtime.h>
#include <hip/hip_cooperative_groups.h>
#include <cstdio>
namespace cg = cooperative_groups;

#ifndef MEGA
#define MEGA 1
#endif
#ifndef PROBE
#define PROBE 0
#endif

typedef unsigned short bf16_t;
typedef short bf16x8 __attribute__((ext_vector_type(8)));
typedef short s16x4 __attribute__((ext_vector_type(4)));
typedef float f32x16 __attribute__((ext_vector_type(16)));
typedef float f32v2 __attribute__((ext_vector_type(2)));
typedef __bf16 bf16v2 __attribute__((ext_vector_type(2)));
typedef unsigned u32x4 __attribute__((ext_vector_type(4)));
typedef unsigned u32x2 __attribute__((ext_vector_type(2)));
#define DI __device__ __forceinline__
DI int tid_opaque() { int t = threadIdx.x; asm volatile("" : "+v"(t)); return t; }
#define TIDX tid_opaque()

constexpr int T_TOK = 65536, SEQ = 8192, DM = 1024;
constexpr int PW = 3072;
constexpr int C_GQ = 0, C_GK = 256, C_GV = 512, C_GLR = 1024, C_GR = 1040, C_NQ = 1552, C_KC = 2064, C_VC = 2192,
              C_KS = 2320, C_VS = 2448, C_KW = 2576, C_VW = 2704, C_NG = 2832;
constexpr float EPS = 1e-6f;
constexpr int NTHR = 512, WPB = 8, LDS_CMP_STAGE = 131072 + 64, LDS_BYTES = 131072 + 64 + 18432;
constexpr size_t MiB = 1024ull * 1024ull;
constexpr size_t W_FFN1_0 = 0, W_FFN1_1 = 8 * MiB, W_FFN2_0 = 16 * MiB, W_FFN2_1 = 24 * MiB, W_EIN = 32 * MiB, W_EOUT = 38 * MiB,
                 W_OIN = 40 * MiB, W_OOUT = 48 * MiB, W_CW1 = 52 * MiB, W_CW2 = 53 * MiB, W_BIAS1 = 53 * MiB + 65536,
                 W_CNT = 53 * MiB + 131072, W_BAR = 54 * MiB;
constexpr size_t R1 = 64 * MiB, R2 = 576 * MiB, R3 = 704 * MiB, R4 = 832 * MiB, R5 = 960 * MiB;
constexpr size_t R_KCMP = R5, R_VCMPT = R5 + 1 * MiB, R_VST = R5 + 2 * MiB, R_VWT = R5 + 18 * MiB, R_DECAY = R5 + 34 * MiB;

struct Params {
  const float* x; const float* norm_g; const float* ffn_w1; const float* ffn_w2; const float* e_w_in; const float* e_w_out;
  const float* gla_w_gate; const float* gla_b_gate; const float* gla_norm; const float* nsa_gate_b; const float* cmp_pos;
  const float* cmp_w1; const float* cmp_w2; const float* o_w_in; const float* o_ln_g; const float* o_ln_b; const float* o_w_s;
  const float* o_b_s; const float* o_w_out;
  float* out; char* ws;
};

DI int crow(int r, int kb) { return (r & 3) + 8 * (r >> 2) + 4 * kb; }
DI f32x16 mfma(bf16x8 a, bf16x8 b, f32x16 c) { return __builtin_amdgcn_mfma_f32_32x32x16_bf16(a, b, c, 0, 0, 0); }
DI unsigned pk2(float a, float b) { f32v2 v = {a, b}; bf16v2 r = __builtin_convertvector(v, bf16v2); return __builtin_bit_cast(unsigned, r); }
DI bf16_t f2bf(float a) { return (bf16_t)(pk2(a, 0.f) & 0xffffu); }
DI float bf2f(bf16_t u) { return __uint_as_float(((unsigned)u) << 16); }
DI float bflo(unsigned u) { return __uint_as_float(u << 16); }
DI float bfhi(unsigned u) { return __uint_as_float(u & 0xffff0000u); }
DI bf16x8 pack8(float a0, float a1, float a2, float a3, float a4, float a5, float a6, float a7) {
  u32x4 p; p[0] = pk2(a0, a1); p[1] = pk2(a2, a3); p[2] = pk2(a4, a5); p[3] = pk2(a6, a7);
  return __builtin_bit_cast(bf16x8, p);
}
DI bf16x8 ld2x4(const bf16_t* p) {
  s16x4 lo = *(const s16x4*)p; s16x4 hi = *(const s16x4*)(p + 8);
  return __builtin_shufflevector(lo, hi, 0, 1, 2, 3, 4, 5, 6, 7);
}
DI float wave_sum(float v) {
#pragma unroll
  for (int o = 32; o > 0; o >>= 1) v += __shfl_xor(v, o);
  return v;
}
DI f32x16 zero16() { f32x16 z;
#pragma unroll
  for (int i = 0; i < 16; ++i) z[i] = 0.f; return z; }
DI float gelu_tanh(float x) { float u = 1.5957691216f * (x + 0.044715f * x * x * x); return x / (1.f + __expf(-u)); }
DI float sigmoidf_(float x) { return 1.f / (1.f + __expf(-x)); }

DI void conv_weight(const float* __restrict__ src, bf16_t* __restrict__ dst, int K, int N, int Npad) {
  const long total = (long)Npad * (K >> 3);
  const long stride = (long)gridDim.x * blockDim.x;
  for (long i = (long)blockIdx.x * blockDim.x + TIDX; i < total; i += stride) {
    const int n = (int)(i % Npad); const int k8 = (int)(i / Npad);
    float v[8];
#pragma unroll
    for (int j = 0; j < 8; ++j) v[j] = (n < N) ? src[(size_t)(k8 * 8 + j) * N + n] : 0.f;
    u32x4 o; o[0] = pk2(v[0], v[1]); o[1] = pk2(v[2], v[3]); o[2] = pk2(v[4], v[5]); o[3] = pk2(v[6], v[7]);
    *(u32x4*)(dst + (size_t)n * K + k8 * 8) = o;
  }
}

DI void prenorm_rows(const float* __restrict__ x, const float* __restrict__ g, bf16_t* __restrict__ xn) {
  const int lane = TIDX & 63, wave = TIDX >> 6;
  const int nw = gridDim.x * WPB;
  for (int row = blockIdx.x * WPB + wave; row < T_TOK; row += nw) {
    const float4* xr = (const float4*)(x + (size_t)row * DM);
    float4 a[4]; float ss = 0.f;
#pragma unroll
    for (int k = 0; k < 4; ++k) { a[k] = xr[k * 64 + lane]; ss += a[k].x * a[k].x + a[k].y * a[k].y + a[k].z * a[k].z + a[k].w * a[k].w; }
    ss = wave_sum(ss);
    const float rs = rsqrtf(ss * (1.f / DM) + EPS);
#pragma unroll
    for (int k = 0; k < 4; ++k) {
      const float4 gg = ((const float4*)g)[k * 64 + lane];
      u32x2 o; o[0] = pk2(a[k].x * rs * gg.x, a[k].y * rs * gg.y); o[1] = pk2(a[k].z * rs * gg.z, a[k].w * rs * gg.w);
      *(u32x2*)(xn + (size_t)row * DM + k * 256 + lane * 4) = o;
    }
  }
}

template <bool HIN_F32, bool HOUT_F32>
DI void resnorm_rows(const bf16_t* __restrict__ m, const float* __restrict__ hin_f, const bf16_t* hin_b, float* __restrict__ hout_f,
                     bf16_t* hout_b, const float* __restrict__ gpost, const float* __restrict__ gnext, bf16_t* __restrict__ xn) {
  const int lane = TIDX & 63, wave = TIDX >> 6;
  const int nw = gridDim.x * WPB;
  for (int row = blockIdx.x * WPB + wave; row < T_TOK; row += nw) {
    float mv[16]; float ss = 0.f;
#pragma unroll
    for (int k = 0; k < 4; ++k) {
      const u32x2 u = *(const u32x2*)(m + (size_t)row * DM + k * 256 + lane * 4);
      mv[k * 4 + 0] = bflo(u[0]); mv[k * 4 + 1] = bfhi(u[0]); mv[k * 4 + 2] = bflo(u[1]); mv[k * 4 + 3] = bfhi(u[1]);
    }
    float hv[16];
#pragma unroll
    for (int k = 0; k < 4; ++k) {
      if (HIN_F32) {
        const float4 h4 = ((const float4*)(hin_f + (size_t)row * DM))[k * 64 + lane];
        hv[k * 4 + 0] = h4.x; hv[k * 4 + 1] = h4.y; hv[k * 4 + 2] = h4.z; hv[k * 4 + 3] = h4.w;
      } else {
        const u32x2 u = *(const u32x2*)(hin_b + (size_t)row * DM + k * 256 + lane * 4);
        hv[k * 4 + 0] = bflo(u[0]); hv[k * 4 + 1] = bfhi(u[0]); hv[k * 4 + 2] = bflo(u[1]); hv[k * 4 + 3] = bfhi(u[1]);
      }
    }
#pragma unroll
    for (int i = 0; i < 16; ++i) ss += mv[i] * mv[i];
    ss = wave_sum(ss);
    const float rs = rsqrtf(ss * (1.f / DM) + EPS);
    float s2 = 0.f;
#pragma unroll
    for (int k = 0; k < 4; ++k) {
      const float4 gg = ((const float4*)gpost)[k * 64 + lane];
      hv[k * 4 + 0] += mv[k * 4 + 0] * rs * gg.x; hv[k * 4 + 1] += mv[k * 4 + 1] * rs * gg.y;
      hv[k * 4 + 2] += mv[k * 4 + 2] * rs * gg.z; hv[k * 4 + 3] += mv[k * 4 + 3] * rs * gg.w;
      if (HOUT_F32) {
        float4 o; o.x = hv[k * 4 + 0]; o.y = hv[k * 4 + 1]; o.z = hv[k * 4 + 2]; o.w = hv[k * 4 + 3];
        ((float4*)(hout_f + (size_t)row * DM))[k * 64 + lane] = o;
      } else {
        u32x2 o; o[0] = pk2(hv[k * 4 + 0], hv[k * 4 + 1]); o[1] = pk2(hv[k * 4 + 2], hv[k * 4 + 3]);
        *(u32x2*)(hout_b + (size_t)row * DM + k * 256 + lane * 4) = o;
      }
    }
    if (xn) {
#pragma unroll
      for (int i = 0; i < 16; ++i) s2 += hv[i] * hv[i];
      s2 = wave_sum(s2);
      const float r2 = rsqrtf(s2 * (1.f / DM) + EPS);
#pragma unroll
      for (int k = 0; k < 4; ++k) {
        const float4 gg = ((const float4*)gnext)[k * 64 + lane];
        u32x2 o; o[0] = pk2(hv[k * 4 + 0] * r2 * gg.x, hv[k * 4 + 1] * r2 * gg.y); o[1] = pk2(hv[k * 4 + 2] * r2 * gg.z, hv[k * 4 + 3] * r2 * gg.w);
        *(u32x2*)(xn + (size_t)row * DM + k * 256 + lane * 4) = o;
      }
    }
  }
}

DI void phase_prep(const Params& P) {
  char* ws = P.ws;
  conv_weight(P.ffn_w1, (bf16_t*)(ws + W_FFN1_0), 1024, 4096, 4096);
  conv_weight(P.ffn_w1 + (size_t)1024 * 4096, (bf16_t*)(ws + W_FFN1_1), 1024, 4096, 4096);
  conv_weight(P.ffn_w2, (bf16_t*)(ws + W_FFN2_0), 4096, 1024, 1024);
  conv_weight(P.ffn_w2 + (size_t)1024 * 4096, (bf16_t*)(ws + W_FFN2_1), 4096, 1024, 1024);
  conv_weight(P.e_w_in, (bf16_t*)(ws + W_EIN), 1024, 2856, PW);
  conv_weight(P.e_w_out, (bf16_t*)(ws + W_EOUT), 1024, 1024, 1024);
  conv_weight(P.o_w_in, (bf16_t*)(ws + W_OIN), 1024, 4096, 4096);
  conv_weight(P.o_w_out, (bf16_t*)(ws + W_OOUT), 2048, 1024, 1024);
  conv_weight(P.cmp_w1, (bf16_t*)(ws + W_CW1), 2048, 128, 128);
  conv_weight(P.cmp_w1 + 2048 * 128, (bf16_t*)(ws + W_CW1) + 128 * 2048, 2048, 128, 128);
  conv_weight(P.cmp_w2, (bf16_t*)(ws + W_CW2), 128, 64, 64);
  conv_weight(P.cmp_w2 + 128 * 64, (bf16_t*)(ws + W_CW2) + 64 * 128, 128, 64, 64);
  const int lane = TIDX & 63, wave = TIDX >> 6;
  const int gw = blockIdx.x * WPB + wave;
  if (gw < 256) {
    const int i = gw >> 7, hid = gw & 127;
    float s = 0.f;
    for (int kk = lane; kk < 2048; kk += 64) s += P.cmp_pos[i * 2048 + kk] * P.cmp_w1[((size_t)i * 2048 + kk) * 128 + hid];
    s = wave_sum(s);
    if (lane == 0) ((float*)(ws + W_BIAS1))[gw] = s;
  }
  const int gt = blockIdx.x * blockDim.x + TIDX;
  if (gt < 16) ((unsigned*)(ws + W_CNT))[gt] = 0u;
  if (gt < 16 * 64) {
    const int bg = gt >> 6, d = gt & 63;
    ((bf16_t*)(ws + R_KCMP))[((size_t)bg * 512 + 511) * 64 + d] = 0;
    ((bf16_t*)(ws + R_VCMPT))[((size_t)bg * 512 + 511) * 64 + d] = 0;
  }
  prenorm_rows(P.x, P.norm_g, (bf16_t*)(ws + R2));
}

namespace pg8 {
#define PG8_LAS __attribute__((address_space(3)))
typedef float f32x4 __attribute__((ext_vector_type(4)));
constexpr int BM = 256, BK = 64, HALF = 128, HTB = HALF * BK * 2, STAGE_BYTES = 8 * HTB, NXCD = 8, WGM = 8;
DI int lds_byte(int r, int c) { const int st = (r >> 4) * 2 + (c >> 5), rr = r & 15, cc = c & 31, ob = rr * 64 + cc * 2; return st * 1024 + (ob ^ (((ob >> 9) & 1) << 5)); }
DI void stage_rc(int b, int& R, int& C) { const int st = b / 1024, sb = b % 1024, swz = sb ^ (((sb >> 9) & 1) << 5); R = (st >> 1) * 16 + swz / 64; C = (st & 1) * 32 + (swz % 64) / 2; }
DI int perm32(int rho) { const int n = rho >> 4, i = rho & 15; return 8 * (i >> 2) + 4 * n + (i & 3); }
struct Unit { int pm, pn; };
struct Gemm { const bf16_t* A; const bf16_t* Bt; int M, N, K; };
struct StaticOrder {
  int nM, nN, nwg, G, c;
  DI void init(int M, int N, int G_, int c_) { nM = M / BM; nN = N / BM; nwg = nM * nN; G = G_; c = c_; }
  DI bool next(int i, Unit& u) const {
    const long L = (long)i * G + c; if (L >= nwg) return false;
    int wgid = (int)L; { const int q = nwg / NXCD, r = nwg % NXCD, xcd = wgid % NXCD, off = wgid / NXCD; wgid = (xcd < r ? xcd * (q + 1) : r * (q + 1) + (xcd - r) * q) + off; }
    const int nig = WGM * nN, gid = wgid / nig, fm = gid * WGM, gsz = (nM - fm) < WGM ? (nM - fm) : WGM;
    u.pm = fm + ((wgid % nig) % gsz); u.pn = (wgid % nig) / gsz; return true;
  }
};
template <int ACT> struct EpiB {
  static constexpr bool PERM = true;
  bf16_t* O; int ldc;
  DI void operator()(const f32x4 (&acc)[2][2][4][2], const Unit& u, int wr, int wc, int fr, int fq) const {
    const int row0 = u.pm * BM + wr * 64 + fr; const int col0 = u.pn * BM + wc * 32 + 8 * fq;
#pragma unroll
    for (int ai = 0; ai < 2; ++ai)
#pragma unroll
      for (int m = 0; m < 4; ++m) {
        bf16_t* rowp = O + (size_t)(row0 + ai * HALF + m * 16) * ldc + col0;
#pragma unroll
        for (int bj = 0; bj < 2; ++bj) {
          f32x4 v0 = acc[ai][bj][m][0], v1 = acc[ai][bj][m][1];
          if (ACT == 1) {
#pragma unroll
            for (int j = 0; j < 4; ++j) { const float a = fmaxf(v0[j], 0.f), b = fmaxf(v1[j], 0.f); v0[j] = a * a; v1[j] = b * b; }
          }
          if (ACT == 2) {
#pragma unroll
            for (int j = 0; j < 4; ++j) { v0[j] = gelu_tanh(v0[j]); v1[j] = gelu_tanh(v1[j]); }
          }
          u32x4 w; w[0] = pk2(v0[0], v0[1]); w[1] = pk2(v0[2], v0[3]); w[2] = pk2(v1[0], v1[1]); w[3] = pk2(v1[2], v1[3]);
          *(u32x4*)(rowp + bj * HALF) = w;
        }
      }
  }
};

template <class Epi, class Sched>
DI void gemm_phase(PG8_LAS unsigned char* lds, const Gemm g, const Sched& S, const Epi& E) {
  const int tid_ = TIDX;
  const int tid = tid_, wid = __builtin_amdgcn_readfirstlane(tid >> 6), lane = tid & 63, wr = wid >> 2, wc = wid & 3, fr = lane & 15, fq = lane >> 4;
  const int K = g.K, nt = K / BK;
  unsigned voffA[2], voffB[2];
#pragma unroll
  for (int i = 0; i < 2; ++i) { int R, C; stage_rc(tid * 16 + i * 8192, R, C); const int Rb = Epi::PERM ? ((R & ~31) + perm32(R & 31)) : R;
    voffA[i] = (unsigned)(R * K + C) * 2u; voffB[i] = (unsigned)(Rb * K + C) * 2u; }
  const size_t kstep = (size_t)(BK * 2);
  const size_t hstep = (size_t)HALF * K * 2;
  const size_t tstep = 2 * hstep;
  const unsigned ldsw = (unsigned)wid * 1024u;
  const int aoff = lds_byte(wr * 64 + fr, fq * 8), boff = lds_byte(wc * 32 + fr, fq * 8);
#define PG8_SA(b, h) (((b) * 2 + (h)) * HTB)
#define PG8_SB(b, h) ((4 + (b) * 2 + (h)) * HTB)
#define PG8_STAGE(bufoff, gbase, voff) do { _Pragma("unroll") for (int _i = 0; _i < 2; ++_i) \
    __builtin_amdgcn_global_load_lds((const unsigned*)((const char*)(gbase) + (voff)[_i]), (PG8_LAS unsigned*)(lds + (bufoff) + ldsw + _i * 8192), 16, 0, 0); } while (0)
#define PG8_LDA(dst, b, h) do { _Pragma("unroll") for (int m = 0; m < 4; ++m) _Pragma("unroll") for (int k = 0; k < 2; ++k) dst[m][k] = *(const PG8_LAS bf16x8*)(lds + PG8_SA(b, h) + aoff + m * 2048 + k * 1024); } while (0)
#define PG8_LDB(dst, b, h) do { _Pragma("unroll") for (int n = 0; n < 2; ++n) _Pragma("unroll") for (int k = 0; k < 2; ++k) dst[n][k] = *(const PG8_LAS bf16x8*)(lds + PG8_SB(b, h) + boff + n * 2048 + k * 1024); } while (0)
#define PG8_MMA(ai, bj, At, Bt) do { __builtin_amdgcn_s_setprio(1); _Pragma("unroll") for (int m = 0; m < 4; ++m) _Pragma("unroll") for (int n = 0; n < 2; ++n) _Pragma("unroll") for (int k = 0; k < 2; ++k) \
    acc[ai][bj][m][n] = __builtin_amdgcn_mfma_f32_16x16x32_bf16(Bt[n][k], At[m][k], acc[ai][bj][m][n], 0, 0, 0); __builtin_amdgcn_s_setprio(0); } while (0)
#define PG8_WAIT_V(n) asm volatile("s_waitcnt vmcnt(" #n ")" ::: "memory")
#define PG8_WAIT_L(n) asm volatile("s_waitcnt lgkmcnt(" #n ")" ::: "memory")
#define PG8_BAR __builtin_amdgcn_s_barrier()
#define PG8_SCHED __builtin_amdgcn_sched_barrier(0)
  Unit cur, nxt; int ui = 0;
  if (!S.next(0, cur)) return;
  f32x4 acc[2][2][4][2];
#pragma unroll
  for (int a = 0; a < 2; ++a)
#pragma unroll
    for (int b = 0; b < 2; ++b)
#pragma unroll
      for (int m = 0; m < 4; ++m)
#pragma unroll
        for (int n = 0; n < 2; ++n) acc[a][b][m][n] = (f32x4){0.f, 0.f, 0.f, 0.f};
  bf16x8 At[4][2], B0[2][2], B1[2][2];
  const char* cA = (const char*)g.A + (size_t)cur.pm * tstep; const char* cB = (const char*)g.Bt + (size_t)cur.pn * tstep;
  PG8_STAGE(PG8_SB(0, 0), cB, voffB); PG8_STAGE(PG8_SA(0, 0), cA, voffA); PG8_STAGE(PG8_SB(0, 1), cB + hstep, voffB); PG8_STAGE(PG8_SA(0, 1), cA + hstep, voffA);
  if (wr == 1) PG8_BAR;
  PG8_WAIT_V(4); PG8_BAR;
  PG8_STAGE(PG8_SB(1, 0), cB + kstep, voffB); PG8_STAGE(PG8_SA(1, 0), cA + kstep, voffA); PG8_STAGE(PG8_SB(1, 1), cB + hstep + kstep, voffB);
  PG8_WAIT_V(6); PG8_BAR;
  for (;;) {
    const bool has_next = S.next(ui + 1, nxt);
    const char* nA = has_next ? (const char*)g.A + (size_t)nxt.pm * tstep : cA; const char* nB = has_next ? (const char*)g.Bt + (size_t)nxt.pn * tstep : cB;
    for (int t = 0; t < nt; t += 2) {
      const bool last = (t == nt - 2);
      const char* a1 = cA + (size_t)(t + 1) * kstep;
      const char* a2 = last ? nA : cA + (size_t)(t + 2) * kstep; const char* b2 = last ? nB : cB + (size_t)(t + 2) * kstep;
      const char* a3 = a2 + kstep; const char* b3 = b2 + kstep;
      PG8_LDB(B0, 0, 0); PG8_SCHED; PG8_LDA(At, 0, 0); PG8_STAGE(PG8_SA(1, 1), a1 + hstep, voffA);
      PG8_WAIT_L(8); PG8_BAR; PG8_WAIT_L(0); PG8_MMA(0, 0, At, B0); PG8_BAR; PG8_SCHED;
      PG8_LDB(B1, 0, 1); PG8_STAGE(PG8_SB(0, 0), b2, voffB);
      PG8_BAR; PG8_WAIT_L(0); PG8_MMA(0, 1, At, B1); PG8_BAR;
      PG8_LDA(At, 0, 1); PG8_STAGE(PG8_SA(0, 0), a2, voffA);
      PG8_BAR; PG8_WAIT_L(0); PG8_MMA(1, 0, At, B0); PG8_BAR; PG8_SCHED;
      PG8_STAGE(PG8_SB(0, 1), b2 + hstep, voffB);
      PG8_WAIT_V(6); PG8_BAR; PG8_MMA(1, 1, At, B1); PG8_BAR;
      PG8_LDB(B0, 1, 0); PG8_SCHED; PG8_LDA(At, 1, 0); PG8_STAGE(PG8_SA(0, 1), a2 + hstep, voffA);
      PG8_WAIT_L(8); PG8_BAR; PG8_WAIT_L(0); PG8_MMA(0, 0, At, B0); PG8_BAR; PG8_SCHED;
      PG8_LDB(B1, 1, 1); PG8_STAGE(PG8_SB(1, 0), b3, voffB);
      PG8_BAR; PG8_WAIT_L(0); PG8_MMA(0, 1, At, B1); PG8_BAR;
      PG8_LDA(At, 1, 1); PG8_STAGE(PG8_SA(1, 0), a3, voffA);
      PG8_BAR; PG8_WAIT_L(0); PG8_MMA(1, 0, At, B0); PG8_BAR; PG8_SCHED;
      PG8_STAGE(PG8_SB(1, 1), b3 + hstep, voffB);
      PG8_WAIT_V(6); PG8_BAR; PG8_MMA(1, 1, At, B1); PG8_BAR;
    }
    E(acc, cur, wr, wc, fr, fq);
    if (PROBE == 10) { asm volatile("" ::: "memory"); E(acc, cur, wr, wc, fr, fq); }
    if (!has_next) break;
#pragma unroll
    for (int a = 0; a < 2; ++a)
#pragma unroll
      for (int b = 0; b < 2; ++b)
#pragma unroll
        for (int m = 0; m < 4; ++m)
#pragma unroll
          for (int n = 0; n < 2; ++n) acc[a][b][m][n] = (f32x4){0.f, 0.f, 0.f, 0.f};
    cur = nxt; cA = nA; cB = nB; ++ui;
  }
  PG8_WAIT_V(0);
  if (wr == 0) PG8_BAR;
  PG8_BAR;
#undef PG8_SA
#undef PG8_SB
#undef PG8_STAGE
#undef PG8_LDA
#undef PG8_LDB
#undef PG8_MMA
#undef PG8_WAIT_V
#undef PG8_WAIT_L
#undef PG8_BAR
#undef PG8_SCHED
}
}

template <int ACT>
DI void gemm_run(const bf16_t* A, const bf16_t* Bt, int N, int K, bf16_t* C, int ldc, char* smem) {
  pg8::Gemm g; g.A = A; g.Bt = Bt; g.M = T_TOK; g.N = N; g.K = K;
  pg8::StaticOrder S; S.init(T_TOK, N, (int)gridDim.x, (int)blockIdx.x);
  pg8::EpiB<ACT> E; E.O = C; E.ldc = ldc;
#ifndef STAGGER_TICKS
#define STAGGER_TICKS 0
#endif
  if (K <= 1024 && STAGGER_TICKS > 0) {
    const unsigned long long t0 = __builtin_amdgcn_s_memrealtime();
    const unsigned long long d = (unsigned long long)(((blockIdx.x >> 3) & 3) * STAGGER_TICKS);
    while (__builtin_amdgcn_s_memrealtime() - t0 < d) __builtin_amdgcn_s_sleep(8);
  }
  pg8::gemm_phase(( PG8_LAS unsigned char*)smem, g, S, E);
  __syncthreads();
}

DI void gla_gates(const Params& P, const bf16_t* proj, int b, int h, int n, float* sb, float* sseg, float* tmp) {
  const int tid = TIDX & 255;
  float* sw = tmp;
  float* sg = tmp + 1024;
  {
    for (int e = tid; e < 1024; e += 256) sw[e] = P.gla_w_gate[(e >> 6) * 256 + h * 64 + (e & 63)];
    const int i = tid >> 2, part = tid & 3;
    const size_t t = (size_t)b * SEQ + n * 64 + i;
    const u32x2 gu = *(const u32x2*)(proj + t * PW + C_GLR + part * 4);
    sg[i * 17 + part * 4 + 0] = bflo(gu[0]); sg[i * 17 + part * 4 + 1] = bfhi(gu[0]);
    sg[i * 17 + part * 4 + 2] = bflo(gu[1]); sg[i * 17 + part * 4 + 3] = bfhi(gu[1]);
  }
  __syncthreads();
  {
    const int i = tid & 63, dq = tid >> 6;
    float z[16];
#pragma unroll
    for (int dd = 0; dd < 16; ++dd) z[dd] = P.gla_b_gate[h * 64 + dq * 16 + dd];
#pragma unroll 1
    for (int r = 0; r < 16; ++r) {
      const float gv = sg[i * 17 + r];
#pragma unroll
      for (int dd = 0; dd < 16; ++dd) z[dd] += gv * sw[r * 64 + dq * 16 + dd];
    }
#pragma unroll
    for (int dd = 0; dd < 16; ++dd) {
      const float zz = z[dd];
      const float ls = fminf(zz, 0.f) - __logf(1.f + __expf(-fabsf(zz)));
      sb[i * 65 + dq * 16 + dd] = ls * (1.f / 16.f);
    }
  }
  __syncthreads();
  const int d = tid & 63, seg = tid >> 6;
  float pre[16]; float run = 0.f;
#pragma unroll
  for (int ii = 0; ii < 16; ++ii) { run += sb[(seg * 16 + ii) * 65 + d]; pre[ii] = run; }
  sseg[seg * 64 + d] = run;
  __syncthreads();
  float off = 0.f;
#pragma unroll
  for (int s = 0; s < 4; ++s) off += (s < seg) ? sseg[s * 64 + d] : 0.f;
#pragma unroll
  for (int ii = 0; ii < 16; ++ii) sb[(seg * 16 + ii) * 65 + d] = pre[ii] + off;
  __syncthreads();
}

struct VRegs { u32x4 u[4]; };
DI void gla_load_v(const bf16_t* proj, int b, int h, int n, VRegs& vr) {
  const int tid = TIDX & 255, j = tid & 63, q4 = tid >> 6;
  const size_t t = (size_t)b * SEQ + n * 64 + j;
  const bf16_t* src = proj + t * PW + C_GV + h * 128 + q4 * 32;
#pragma unroll
  for (int c = 0; c < 4; ++c) vr.u[c] = *(const u32x4*)(src + c * 8);
}
DI void gla_store_vT(const VRegs& vr, bf16_t* vT) {
  const int tid = TIDX & 255, j = tid & 63, q4 = tid >> 6;
#pragma unroll
  for (int c = 0; c < 4; ++c) {
#pragma unroll
    for (int e = 0; e < 4; ++e) {
      vT[(q4 * 32 + c * 8 + 2 * e) * 72 + j] = (bf16_t)(vr.u[c][e] & 0xffffu);
      vT[(q4 * 32 + c * 8 + 2 * e + 1) * 72 + j] = (bf16_t)(vr.u[c][e] >> 16);
    }
  }
}

DI void gla_p1_item(const Params& P, int item, char* smem) {
  const bf16_t* proj = (const bf16_t*)(P.ws + R1);
  bf16_t* states = (bf16_t*)(P.ws + R2);
  float* decay = (float*)(P.ws + R_DECAY);
  float* sb = (float*)smem; float* sseg = sb + 64 * 65;
  bf16_t* kendT = (bf16_t*)(sseg + 256); bf16_t* vT = kendT + 64 * 72;
  const int n = item & 127, h = (item >> 7) & 3, b = item >> 9;
  const int tid = TIDX & 255, lane = tid & 63, wave = tid >> 6, l32 = lane & 31, kb = lane >> 5;
  VRegs vr; gla_load_v(proj, b, h, n, vr);
  u32x4 k0, k1;
  {
    const int j = tid & 63, dq = tid >> 6;
    const size_t t = (size_t)b * SEQ + n * 64 + j;
    k0 = *(const u32x4*)(proj + t * PW + C_GK + h * 64 + dq * 16); k1 = *(const u32x4*)(proj + t * PW + C_GK + h * 64 + dq * 16 + 8);
  }
  gla_gates(P, proj, b, h, n, sb, sseg, (float*)vT);
  {
    const int j = tid & 63, dq = tid >> 6;
    float kv[16];
#pragma unroll
    for (int e = 0; e < 4; ++e) { kv[2 * e] = bflo(k0[e]); kv[2 * e + 1] = bfhi(k0[e]); kv[8 + 2 * e] = bflo(k1[e]); kv[8 + 2 * e + 1] = bfhi(k1[e]); }
#pragma unroll
    for (int dd = 0; dd < 16; ++dd) {
      const int d = dq * 16 + dd;
      kendT[d * 72 + j] = f2bf(kv[dd] * __expf(sb[63 * 65 + d] - sb[j * 65 + d]));
    }
    if (tid < 64) decay[((size_t)(b * 4 + h) * 128 + n) * 64 + tid] = __expf(sb[63 * 65 + tid]);
  }
  gla_store_vT(vr, vT);
  __syncthreads();
#pragma unroll
  for (int dt = 0; dt < 2; ++dt) {
    f32x16 acc = zero16();
#pragma unroll
    for (int s = 0; s < 4; ++s) {
      const bf16x8 a = *(const bf16x8*)(vT + (wave * 32 + l32) * 72 + s * 16 + kb * 8);
      const bf16x8 bb = *(const bf16x8*)(kendT + (dt * 32 + l32) * 72 + s * 16 + kb * 8);
      acc = mfma(a, bb, acc);
    }
    bf16_t* dst = states + ((size_t)((b * 4 + h) * 128 + n) * 128) * 64;
#pragma unroll
    for (int r = 0; r < 16; ++r) dst[(size_t)(wave * 32 + crow(r, kb)) * 64 + dt * 32 + l32] = f2bf(acc[r]);
  }
  __syncthreads();
}

DI void gla_scan(const Params& P) {
  bf16_t* states = (bf16_t*)(P.ws + R2);
  const float* decay = (const float*)(P.ws + R_DECAY);
  const int total = 32 * 4096;
  for (int e = blockIdx.x * blockDim.x + TIDX; e < total; e += gridDim.x * blockDim.x) {
    const int bh = e >> 12, idx = (e & 4095) * 2, d = idx & 63;
    bf16_t* p = states + (size_t)bh * 128 * 8192 + idx;
    const float* dc = decay + (size_t)bh * 128 * 64 + d;
    float S0 = 0.f, S1 = 0.f;
#pragma unroll 8
    for (int n = 0; n < 128; ++n) {
      const unsigned ds = *(const unsigned*)(p + (size_t)n * 8192);
      const float2 dec = *(const float2*)(dc + n * 64);
      *(unsigned*)(p + (size_t)n * 8192) = pk2(S0, S1);
      S0 = dec.x * S0 + bflo(ds); S1 = dec.y * S1 + bfhi(ds);
    }
  }
}

struct P3Pref { u32x4 q0, q1, k0, k1; VRegs v; bf16x8 sf[4]; u32x2 glr; u32x2 ru[2][4]; };
DI void gla_p3_load(const Params& P, int item, P3Pref& f) {
  const bf16_t* proj = (const bf16_t*)(P.ws + R1);
  const bf16_t* states = (const bf16_t*)(P.ws + R2);
  const int n = item & 127, h = (item >> 7) & 3, b = item >> 9;
  const int tid = TIDX & 255, lane = tid & 63, wave = tid >> 6, l32 = lane & 31, kb = lane >> 5;
  gla_load_v(proj, b, h, n, f.v);
  {
    const int i = tid & 63, dq = tid >> 6;
    const size_t t = (size_t)b * SEQ + n * 64 + i;
    f.q0 = *(const u32x4*)(proj + t * PW + C_GQ + h * 64 + dq * 16); f.q1 = *(const u32x4*)(proj + t * PW + C_GQ + h * 64 + dq * 16 + 8);
    f.k0 = *(const u32x4*)(proj + t * PW + C_GK + h * 64 + dq * 16); f.k1 = *(const u32x4*)(proj + t * PW + C_GK + h * 64 + dq * 16 + 8);
    const bf16_t* sp = states + ((size_t)((b * 4 + h) * 128 + n) * 128 + wave * 32 + l32) * 64;
#pragma unroll
    for (int s4 = 0; s4 < 4; ++s4) f.sf[s4] = *(const bf16x8*)(sp + s4 * 16 + kb * 8);
  }
  {
    const int i = tid >> 2, part = tid & 3;
    f.glr = *(const u32x2*)(proj + ((size_t)b * SEQ + n * 64 + i) * PW + C_GLR + part * 4);
  }
#pragma unroll
  for (int it = 0; it < 2; ++it)
#pragma unroll
    for (int gq = 0; gq < 4; ++gq)
      f.ru[it][gq] = *(const u32x2*)(proj + ((size_t)b * SEQ + n * 64 + it * 32 + l32) * PW + C_GR + h * 128 + wave * 32 + 8 * gq + 4 * kb);
}

DI void gla_gates_pre(const Params& P, int h, const u32x2& glr, float* sb, float* sseg, float* sg, const float* sw) {
  const int tid = TIDX & 255;
  {
    const int i = tid >> 2, part = tid & 3;
    sg[i * 17 + part * 4 + 0] = bflo(glr[0]); sg[i * 17 + part * 4 + 1] = bfhi(glr[0]);
    sg[i * 17 + part * 4 + 2] = bflo(glr[1]); sg[i * 17 + part * 4 + 3] = bfhi(glr[1]);
  }
  __syncthreads();
  {
    const int i = tid & 63, dq = tid >> 6;
    float z[16];
#pragma unroll
    for (int dd = 0; dd < 16; ++dd) z[dd] = sw[1024 + dq * 16 + dd];
#pragma unroll 1
    for (int r = 0; r < 16; ++r) {
      const float gv = sg[i * 17 + r];
#pragma unroll
      for (int dd = 0; dd < 16; ++dd) z[dd] += gv * sw[r * 64 + dq * 16 + dd];
    }
#pragma unroll
    for (int dd = 0; dd < 16; ++dd) {
      const float zz = z[dd];
      const float ls = fminf(zz, 0.f) - __logf(1.f + __expf(-fabsf(zz)));
      sb[i * 65 + dq * 16 + dd] = ls * (1.f / 16.f);
    }
  }
  __syncthreads();
  const int d = tid & 63, seg = tid >> 6;
  float pre[16]; float run = 0.f;
#pragma unroll
  for (int ii = 0; ii < 16; ++ii) { run += sb[(seg * 16 + ii) * 65 + d]; pre[ii] = run; }
  sseg[seg * 64 + d] = run;
  __syncthreads();
  float off = 0.f;
#pragma unroll
  for (int s = 0; s < 4; ++s) off += (s < seg) ? sseg[s * 64 + d] : 0.f;
#pragma unroll
  for (int ii = 0; ii < 16; ++ii) sb[(seg * 16 + ii) * 65 + d] = pre[ii] + off;
  __syncthreads();
}

DI void gla_p3_item(const Params& P, int item, char* smem, const P3Pref& f) {
  bf16_t* mix = (bf16_t*)(P.ws + R3);
  float* sb = (float*)smem; float* sseg = sb + 64 * 65; float* sred = sseg + 256;
  bf16_t* sq = (bf16_t*)(sred + 256); bf16_t* sk = sq + 64 * 72; bf16_t* vT = sk + 64 * 72;
  const float* sw = (const float*)(smem + 57344);
  const int n = item & 127, h = (item >> 7) & 3, b = item >> 9;
  const int tid = TIDX & 255, lane = tid & 63, wave = tid >> 6, l32 = lane & 31, kb = lane >> 5;
  const u32x4 q0 = f.q0, q1 = f.q1, k0 = f.k0, k1 = f.k1;
  gla_gates_pre(P, h, f.glr, sb, sseg, (float*)vT, sw);
  {
    const int i = tid & 63, dq = tid >> 6;
    float qv[16], kv[16];
#pragma unroll
    for (int e = 0; e < 4; ++e) {
      qv[2 * e] = bflo(q0[e]); qv[2 * e + 1] = bfhi(q0[e]); qv[8 + 2 * e] = bflo(q1[e]); qv[8 + 2 * e + 1] = bfhi(q1[e]);
      kv[2 * e] = bflo(k0[e]); kv[2 * e + 1] = bfhi(k0[e]); kv[8 + 2 * e] = bflo(k1[e]); kv[8 + 2 * e + 1] = bfhi(k1[e]);
    }
#pragma unroll
    for (int dd = 0; dd < 16; ++dd) {
      const int d = dq * 16 + dd;
      const float bb = sb[i * 65 + d];
      sq[i * 72 + d] = f2bf(qv[dd] * 0.125f * __expf(bb));
      sk[i * 72 + d] = f2bf(kv[dd] * __expf(-bb));
    }
  }
  gla_store_vT(f.v, vT);
  __syncthreads();
  f32x16 x00 = zero16(), x01 = zero16(), x11 = zero16();
#pragma unroll
  for (int s = 0; s < 4; ++s) {
    const bf16x8 kj0 = *(const bf16x8*)(sk + (l32)*72 + s * 16 + kb * 8);
    const bf16x8 kj1 = *(const bf16x8*)(sk + (32 + l32) * 72 + s * 16 + kb * 8);
    const bf16x8 qi0 = *(const bf16x8*)(sq + (l32)*72 + s * 16 + kb * 8);
    const bf16x8 qi1 = *(const bf16x8*)(sq + (32 + l32) * 72 + s * 16 + kb * 8);
    x00 = mfma(kj0, qi0, x00); x01 = mfma(kj0, qi1, x01); x11 = mfma(kj1, qi1, x11);
  }
#pragma unroll
  for (int r = 0; r < 16; ++r) { const bool keep = crow(r, kb) <= l32; x00[r] = keep ? x00[r] : 0.f; x11[r] = keep ? x11[r] : 0.f; }
  f32x16 o0 = zero16(), o1 = zero16();
  const int dvr = wave * 32 + l32;
#pragma unroll
  for (int s = 0; s < 2; ++s) {
    const bf16x8 p00 = pack8(x00[8 * s], x00[8 * s + 1], x00[8 * s + 2], x00[8 * s + 3], x00[8 * s + 4], x00[8 * s + 5], x00[8 * s + 6], x00[8 * s + 7]);
    const bf16x8 p01 = pack8(x01[8 * s], x01[8 * s + 1], x01[8 * s + 2], x01[8 * s + 3], x01[8 * s + 4], x01[8 * s + 5], x01[8 * s + 6], x01[8 * s + 7]);
    const bf16x8 p11 = pack8(x11[8 * s], x11[8 * s + 1], x11[8 * s + 2], x11[8 * s + 3], x11[8 * s + 4], x11[8 * s + 5], x11[8 * s + 6], x11[8 * s + 7]);
    const bf16x8 v0 = ld2x4(vT + dvr * 72 + 16 * s + 4 * kb);
    const bf16x8 v1 = ld2x4(vT + dvr * 72 + 32 + 16 * s + 4 * kb);
    o0 = mfma(v0, p00, o0); o1 = mfma(v0, p01, o1); o1 = mfma(v1, p11, o1);
  }
  {
#pragma unroll
    for (int s = 0; s < 4; ++s) {
      const bf16x8 a = f.sf[s];
      const bf16x8 qi0 = *(const bf16x8*)(sq + (l32)*72 + s * 16 + kb * 8);
      const bf16x8 qi1 = *(const bf16x8*)(sq + (32 + l32) * 72 + s * 16 + kb * 8);
      o0 = mfma(a, qi0, o0); o1 = mfma(a, qi1, o1);
    }
  }
  float s0 = 0.f, s1 = 0.f;
#pragma unroll
  for (int r = 0; r < 16; ++r) { s0 += o0[r] * o0[r]; s1 += o1[r] * o1[r]; }
  s0 += __shfl_xor(s0, 32); s1 += __shfl_xor(s1, 32);
  if (kb == 0) { sred[wave * 64 + l32] = s0; sred[wave * 64 + 32 + l32] = s1; }
  __syncthreads();
  const float t0s = sred[l32] + sred[64 + l32] + sred[128 + l32] + sred[192 + l32];
  const float t1s = sred[32 + l32] + sred[64 + 32 + l32] + sred[128 + 32 + l32] + sred[192 + 32 + l32];
  const float r0 = rsqrtf(t0s * (1.f / 128.f) + EPS), r1 = rsqrtf(t1s * (1.f / 128.f) + EPS);
#pragma unroll
  for (int it = 0; it < 2; ++it) {
    const size_t t = (size_t)b * SEQ + n * 64 + it * 32 + l32;
    const float rr = it ? r1 : r0;
#pragma unroll
    for (int gq = 0; gq < 4; ++gq) {
      const int dv = wave * 32 + 8 * gq + 4 * kb;
      const u32x2 ru = f.ru[it][gq];
      const float4 gn = *(const float4*)(sw + 1088 + dv);
      float rv[4] = {bflo(ru[0]), bfhi(ru[0]), bflo(ru[1]), bfhi(ru[1])};
      float gv[4] = {gn.x, gn.y, gn.z, gn.w};
      float ov[4];
#pragma unroll
      for (int e = 0; e < 4; ++e) {
        const float a = it ? o1[gq * 4 + e] : o0[gq * 4 + e];
        ov[e] = a * rr * gv[e] * (rv[e] / (1.f + __expf(-rv[e])));
      }
      u32x2 o; o[0] = pk2(ov[0], ov[1]); o[1] = pk2(ov[2], ov[3]);
      *(u32x2*)(mix + t * DM + h * 128 + dv) = o;
    }
  }
  __syncthreads();
}

DI void nsa_compress_task(const Params& P, int task) {
  const bf16_t* proj = (const bf16_t*)(P.ws + R1);
  const int lane = TIDX & 63, l32 = lane & 31, kb = lane >> 5;
  const int ct = task & 15, g = (task >> 4) & 1, b = (task >> 5) & 7, br = task >> 8;
  const bf16_t* w1T = (const bf16_t*)(P.ws + W_CW1) + (size_t)br * 128 * 2048;
  const bf16_t* w2T = (const bf16_t*)(P.ws + W_CW2) + (size_t)br * 64 * 128;
  const float* bias1 = (const float*)(P.ws + W_BIAS1) + br * 128;
  const int c = ct * 32 + l32;
  const int cc = c < 511 ? c : 510;
  const bf16_t* src = proj + ((size_t)b * SEQ + cc * 16) * PW + (br ? C_VC : C_KC) + g * 64 + kb * 8;
  f32x16 acc[4];
#pragma unroll
  for (int i = 0; i < 4; ++i) acc[i] = zero16();
#pragma unroll 1
  for (int ks = 0; ks < 128; ++ks) {
    const int l = ks >> 2, dh0 = (ks & 3) * 16;
    const bf16x8 bf = *(const bf16x8*)(src + (size_t)l * PW + dh0);
#pragma unroll
    for (int ht = 0; ht < 4; ++ht) {
      const bf16x8 af = *(const bf16x8*)(w1T + (size_t)(ht * 32 + l32) * 2048 + ks * 16 + kb * 8);
      acc[ht] = mfma(af, bf, acc[ht]);
    }
  }
#pragma unroll
  for (int ht = 0; ht < 4; ++ht)
#pragma unroll
    for (int r = 0; r < 16; ++r) acc[ht][r] = gelu_tanh(acc[ht][r] + bias1[ht * 32 + crow(r, kb)]);
  f32x16 o[2]; o[0] = zero16(); o[1] = zero16();
#pragma unroll
  for (int ht = 0; ht < 4; ++ht)
#pragma unroll
    for (int s = 0; s < 2; ++s) {
      const bf16x8 hf = pack8(acc[ht][8 * s], acc[ht][8 * s + 1], acc[ht][8 * s + 2], acc[ht][8 * s + 3], acc[ht][8 * s + 4], acc[ht][8 * s + 5], acc[ht][8 * s + 6], acc[ht][8 * s + 7]);
#pragma unroll
      for (int dt = 0; dt < 2; ++dt) {
        const bf16x8 wf = ld2x4(w2T + (size_t)(dt * 32 + l32) * 128 + ht * 32 + 16 * s + 4 * kb);
        o[dt] = mfma(wf, hf, o[dt]);
      }
    }
  if (c < 511) {
    {
      bf16_t* dst = (bf16_t*)(P.ws + (br ? R_VCMPT : R_KCMP)) + ((size_t)(b * 2 + g) * 512 + c) * 64;
#pragma unroll
      for (int dt = 0; dt < 2; ++dt)
#pragma unroll
        for (int gq = 0; gq < 4; ++gq) {
          u32x2 u; u[0] = pk2(o[dt][gq * 4], o[dt][gq * 4 + 1]); u[1] = pk2(o[dt][gq * 4 + 2], o[dt][gq * 4 + 3]);
          *(u32x2*)(dst + dt * 32 + 8 * gq + 4 * kb) = u;
        }
    }
  }
}

DI void nsa_transpose_v(const Params& P) {
  const bf16_t* proj = (const bf16_t*)(P.ws + R1);
  const int total = 2 * 8 * 2 * 1024 * 64;
  for (int u = blockIdx.x * blockDim.x + TIDX; u < total; u += gridDim.x * blockDim.x) {
    const int dh = u & 63; int rest = u >> 6; const int t8 = rest & 1023; rest >>= 10;
    const int g = rest & 1, b = (rest >> 1) & 7, which = rest >> 4;
    const bf16_t* src = proj + ((size_t)b * SEQ + t8 * 8) * PW + (which ? C_VW : C_VS) + g * 64 + dh;
    bf16_t v[8];
#pragma unroll
    for (int j = 0; j < 8; ++j) v[j] = src[(size_t)j * PW];
    u32x4 o;
#pragma unroll
    for (int j = 0; j < 4; ++j) o[j] = (unsigned)v[2 * j] | ((unsigned)v[2 * j + 1] << 16);
    bf16_t* dst = (bf16_t*)(P.ws + (which ? R_VWT : R_VST)) + ((size_t)(b * 2 + g) * 64 + dh) * SEQ + t8 * 8;
    *(u32x4*)dst = o;
  }
}

DI f32x16 qk_tile(const bf16_t* krow, const bf16x8 (&qf)[4]) {
  f32x16 s = zero16();
#pragma unroll
  for (int i = 0; i < 4; ++i) { const bf16x8 kf = *(const bf16x8*)(krow + i * 16); s = mfma(kf, qf[i], s); }
  return s;
}

DI float half_max(float x) {
  const auto r = __builtin_amdgcn_permlane32_swap(__float_as_uint(x), __float_as_uint(x), false, false);
  return fmaxf(__uint_as_float(r[0]), __uint_as_float(r[1]));
}
DI float half_sum(float x) {
  const auto r = __builtin_amdgcn_permlane32_swap(__float_as_uint(x), __float_as_uint(x), false, false);
  return __uint_as_float(r[0]) + __uint_as_float(r[1]);
}
DI s16x4 lds_tr(const char* p) { return __builtin_amdgcn_ds_read_tr16_b64_v4i16((__attribute__((address_space(3))) s16x4*)p); }

template <bool EDGE>
DI void softmax_tile(f32x16& s, int k0, int tq, int lo, bool bit, int kb, f32x16& o0, f32x16& o1, float& m, float& l) {
  constexpr float CS = 0.125f * 1.4426950408889634f;
  float tmax = -1e30f;
  if (EDGE) {
#pragma unroll
    for (int r = 0; r < 16; ++r) {
      const int key = k0 + crow(r, kb);
      const bool vd = (key <= tq) && (key > lo);
      s[r] = vd ? s[r] * CS : -1e30f;
      tmax = fmaxf(tmax, s[r]);
    }
  } else {
#pragma unroll
    for (int r = 0; r < 16; ++r) tmax = fmaxf(tmax, s[r]);
    tmax *= CS;
  }
  tmax = bit ? tmax : -1e30f;
  tmax = half_max(tmax);
  if (__ballot(tmax > m) != 0ull) {
    const float mn = fmaxf(m, tmax);
    const float alpha = __builtin_amdgcn_exp2f(m - mn);
    l *= alpha; m = mn;
#pragma unroll
    for (int r = 0; r < 16; ++r) { o0[r] *= alpha; o1[r] *= alpha; }
  }
  float ps = 0.f;
  if (EDGE) {
    const bool live = bit && (m > -5e29f);
#pragma unroll
    for (int r = 0; r < 16; ++r) {
      const float e = __builtin_amdgcn_exp2f(s[r] - m);
      s[r] = live ? e : 0.f;
      ps += s[r];
    }
  } else {
    const float me = bit ? m : 1e30f;
#pragma unroll
    for (int r = 0; r < 16; ++r) {
      s[r] = __builtin_amdgcn_exp2f(__builtin_fmaf(s[r], CS, -me));
      ps += s[r];
    }
  }
  l += ps;
}

struct HeadAcc { f32x16 o0, o1; float m, l; };

template <bool EDGE>
DI void attn_step2(const bf16_t* sKt, const char* sVt, const bf16x8 (&qa)[4], const bf16x8 (&qb)[4], int k0, int tq, int lo, bool bit,
                   int lane, HeadAcc& A, HeadAcc& B) {
  const int l32 = lane & 31, kb = lane >> 5, i16 = lane & 15, q = i16 >> 2, p = i16 & 3, gc = (lane >> 4) & 1;
  f32x16 sa = zero16(), sb = zero16();
#pragma unroll
  for (int i = 0; i < 4; ++i) {
    const bf16x8 kf = *(const bf16x8*)(sKt + l32 * 72 + i * 16 + kb * 8);
    sa = mfma(kf, qa[i], sa); sb = mfma(kf, qb[i], sb);
  }
  bf16x8 vf[2][2];
#pragma unroll
  for (int dt = 0; dt < 2; ++dt)
#pragma unroll
    for (int sI = 0; sI < 2; ++sI) {
      const char* vp = sVt + (16 * sI + 4 * kb + q) * 144 + (dt * 32 + gc * 16 + 4 * p) * 2;
      const s16x4 lo4 = lds_tr(vp), hi4 = lds_tr(vp + 8 * 144);
      vf[dt][sI] = __builtin_shufflevector(lo4, hi4, 0, 1, 2, 3, 4, 5, 6, 7);
    }
  softmax_tile<EDGE>(sa, k0, tq, lo, bit, kb, A.o0, A.o1, A.m, A.l);
  softmax_tile<EDGE>(sb, k0, tq, lo, bit, kb, B.o0, B.o1, B.m, B.l);
#pragma unroll
  for (int sI = 0; sI < 2; ++sI) {
    const bf16x8 pa = pack8(sa[8 * sI], sa[8 * sI + 1], sa[8 * sI + 2], sa[8 * sI + 3], sa[8 * sI + 4], sa[8 * sI + 5], sa[8 * sI + 6], sa[8 * sI + 7]);
    const bf16x8 pb = pack8(sb[8 * sI], sb[8 * sI + 1], sb[8 * sI + 2], sb[8 * sI + 3], sb[8 * sI + 4], sb[8 * sI + 5], sb[8 * sI + 6], sb[8 * sI + 7]);
    A.o0 = mfma(vf[0][sI], pa, A.o0); A.o1 = mfma(vf[1][sI], pa, A.o1);
    B.o0 = mfma(vf[0][sI], pb, B.o0); B.o1 = mfma(vf[1][sI], pb, B.o1);
  }
}

template <bool WIN>
DI void nsa_branch2(const bf16_t* kbase, const bf16_t* vbase, char* smem, int st0, int st1, int qt, int tq, const bf16x8 (&qa)[4],
                    const bf16x8 (&qb)[4], unsigned mk0, unsigned mk1, unsigned mk2, unsigned mk3, HeadAcc& A, HeadAcc& B) {
  const int tid = TIDX, lane = tid & 63;
  const int srow = tid >> 3, schunk = (tid & 7) * 8;
  const bf16_t* kg = kbase + (size_t)srow * PW + schunk;
  const bf16_t* vg = vbase + (size_t)srow * PW + schunk;
  const int soff = (srow * 72 + schunk) * 2;
  u32x4 rk = *(const u32x4*)(kg + (size_t)st0 * 64 * PW), rv = *(const u32x4*)(vg + (size_t)st0 * 64 * PW);
  *(u32x4*)(smem + soff) = rk; *(u32x4*)(smem + 9216 + soff) = rv;
  __syncthreads();
  for (int st = st0; st <= st1; ++st) {
    const int cur = (st - st0) & 1;
    if (st < st1) { rk = *(const u32x4*)(kg + (size_t)(st + 1) * 64 * PW); rv = *(const u32x4*)(vg + (size_t)(st + 1) * 64 * PW); }
    const bf16_t* bK = (const bf16_t*)(smem + cur * 18432);
    const char* bV = smem + cur * 18432 + 9216;
    bool bit = true;
    if (!WIN) { const unsigned mw = st < 32 ? mk0 : (st < 64 ? mk1 : (st < 96 ? mk2 : mk3)); bit = (mw >> (st & 31)) & 1u; }
    const bool any = WIN ? true : (__ballot(bit) != 0ull);
#pragma unroll
    for (int tt = 0; tt < 2; ++tt) {
      const int kt = 2 * st + tt;
      const bool in_range = WIN ? (kt <= qt && kt >= qt - 16) : (kt <= qt);
      if (in_range && any) {
        const bool edge = WIN ? (kt == qt || kt == qt - 16) : (kt == qt);
        if (edge) attn_step2<true>(bK + tt * 32 * 72, bV + tt * 32 * 144, qa, qb, kt * 32, tq, WIN ? tq - 512 : -1, bit, lane, A, B);
        else attn_step2<false>(bK + tt * 32 * 72, bV + tt * 32 * 144, qa, qb, kt * 32, tq, WIN ? tq - 512 : -1, bit, lane, A, B);
      }
    }
    if (st < st1) { *(u32x4*)(smem + (cur ^ 1) * 18432 + soff) = rk; *(u32x4*)(smem + (cur ^ 1) * 18432 + 9216 + soff) = rv; }
    __syncthreads();
  }
}

DI void fold_partial(bf16_t* dst, float f, const f32x16& a0, const f32x16& a1, int kb) {
#pragma unroll
  for (int gq = 0; gq < 4; ++gq) {
    bf16_t* d0 = dst + 8 * gq + 4 * kb;
    bf16_t* d1 = d0 + 32;
    const u32x2 p0 = *(const u32x2*)d0, p1 = *(const u32x2*)d1;
    u32x2 u0, u1;
    u0[0] = pk2(bflo(p0[0]) + f * a0[gq * 4], bfhi(p0[0]) + f * a0[gq * 4 + 1]);
    u0[1] = pk2(bflo(p0[1]) + f * a0[gq * 4 + 2], bfhi(p0[1]) + f * a0[gq * 4 + 3]);
    u1[0] = pk2(bflo(p1[0]) + f * a1[gq * 4], bfhi(p1[0]) + f * a1[gq * 4 + 1]);
    u1[1] = pk2(bflo(p1[1]) + f * a1[gq * 4 + 2], bfhi(p1[1]) + f * a1[gq * 4 + 3]);
    *(u32x2*)d0 = u0; *(u32x2*)d1 = u1;
  }
}

DI void nsa_block(const Params& P, int b, int g, int qb, char* smem) {
  const int wv = __builtin_amdgcn_readfirstlane(TIDX >> 6);
  const int qt = qb * 8 + wv;
  float* imp = (float*)smem + wv * 4096;
  const bf16_t* proj = (const bf16_t*)(P.ws + R1);
  bf16_t* mix = (bf16_t*)(P.ws + R3);
  const int lane = TIDX & 63, l32 = lane & 31, kb = lane >> 5;
  const int t0 = qt * 32, tq = t0 + l32;
  const size_t tokq = (size_t)b * SEQ + tq;
  const bf16_t* qrow = proj + tokq * PW;
  const bf16_t* kcmp = (const bf16_t*)(P.ws + R_KCMP) + (size_t)(b * 2 + g) * 512 * 64;
  const bf16_t* vcmp = (const bf16_t*)(P.ws + R_VCMPT) + (size_t)(b * 2 + g) * 512 * 64;
  const int nct = (qb >> 1) + 1;
  const int nst = (nct + 1) >> 1;
  for (int i = lane; i < 4096; i += 64) imp[i] = 0.f;
  {
    constexpr float CS = 0.125f * 1.4426950408889634f;
    char* stg = smem + LDS_CMP_STAGE;
    const int tid = TIDX;
    const int srow = tid >> 3, schunk = (tid & 7) * 8, soff = (srow * 72 + schunk) * 2;
    const int i16 = lane & 15, q4 = i16 >> 2, p4 = i16 & 3, gc = (lane >> 4) & 1;
#pragma unroll 1
    for (int hp = 0; hp < 2; ++hp) {
      const int head = g * 4 + hp * 2;
      bf16x8 qa[4], qb_[4];
#pragma unroll
      for (int i = 0; i < 4; ++i) {
        qa[i] = *(const bf16x8*)(qrow + C_NQ + head * 64 + i * 16 + kb * 8);
        qb_[i] = *(const bf16x8*)(qrow + C_NQ + (head + 1) * 64 + i * 16 + kb * 8);
      }
      float mA = -1e30f, lA = 0.f, mB = -1e30f, lB = 0.f;
      u32x4 rk = *(const u32x4*)(kcmp + (size_t)srow * 64 + schunk), rv;
      for (int st = 0; st < nst; ++st) {
        *(u32x4*)(stg + soff) = rk;
        __syncthreads();
        if (st + 1 < nst) rk = *(const u32x4*)(kcmp + (size_t)((st + 1) * 64 + srow) * 64 + schunk);
#pragma unroll
        for (int tt = 0; tt < 2; ++tt) {
          const int ct = 2 * st + tt;
          if (ct < nct) {
            const bf16_t* sKt = (const bf16_t*)stg + tt * 32 * 72;
            f32x16 sa = zero16(), sb = zero16();
#pragma unroll
            for (int i = 0; i < 4; ++i) {
              const bf16x8 kf = *(const bf16x8*)(sKt + l32 * 72 + i * 16 + kb * 8);
              sa = mfma(kf, qa[i], sa); sb = mfma(kf, qb_[i], sb);
            }
            float tA = -1e30f, tB = -1e30f;
#pragma unroll
            for (int r = 0; r < 16; ++r) {
              const int c = ct * 32 + crow(r, kb);
              const bool vd = (c * 16 + 31 <= tq);
              sa[r] = vd ? sa[r] * CS : -1e30f; sb[r] = vd ? sb[r] * CS : -1e30f;
              tA = fmaxf(tA, sa[r]); tB = fmaxf(tB, sb[r]);
            }
            const float nA = fmaxf(mA, tA), nB = fmaxf(mB, tB);
            float pA = 0.f, pB = 0.f;
#pragma unroll
            for (int r = 0; r < 16; ++r) {
              pA += (sa[r] > -5e29f) ? __builtin_amdgcn_exp2f(sa[r] - nA) : 0.f;
              pB += (sb[r] > -5e29f) ? __builtin_amdgcn_exp2f(sb[r] - nB) : 0.f;
            }
            lA = lA * __builtin_amdgcn_exp2f(mA - nA) + pA; mA = nA;
            lB = lB * __builtin_amdgcn_exp2f(mB - nB) + pB; mB = nB;
          }
        }
        __syncthreads();
      }
      float MA, iLA, MB, iLB;
      {
        const float mo = __shfl_xor(mA, 32), lo_ = __shfl_xor(lA, 32);
        MA = fmaxf(mA, mo);
        iLA = 1.f / fmaxf(lA * __builtin_amdgcn_exp2f(mA - MA) + lo_ * __builtin_amdgcn_exp2f(mo - MA), 1e-30f);
        const float mo2 = __shfl_xor(mB, 32), lo2 = __shfl_xor(lB, 32);
        MB = fmaxf(mB, mo2);
        iLB = 1.f / fmaxf(lB * __builtin_amdgcn_exp2f(mB - MB) + lo2 * __builtin_amdgcn_exp2f(mo2 - MB), 1e-30f);
      }
      f32x16 oA0 = zero16(), oA1 = zero16(), oB0 = zero16(), oB1 = zero16();
      float carry = 0.f;
      rk = *(const u32x4*)(kcmp + (size_t)srow * 64 + schunk); rv = *(const u32x4*)(vcmp + (size_t)srow * 64 + schunk);
      for (int st = 0; st < nst; ++st) {
        *(u32x4*)(stg + soff) = rk; *(u32x4*)(stg + 9216 + soff) = rv;
        __syncthreads();
        if (st + 1 < nst) {
          rk = *(const u32x4*)(kcmp + (size_t)((st + 1) * 64 + srow) * 64 + schunk);
          rv = *(const u32x4*)(vcmp + (size_t)((st + 1) * 64 + srow) * 64 + schunk);
        }
#pragma unroll
        for (int tt = 0; tt < 2; ++tt) {
          const int ct = 2 * st + tt;
          if (ct < nct) {
            const bf16_t* sKt = (const bf16_t*)stg + tt * 32 * 72;
            const char* sVt = stg + 9216 + tt * 32 * 144;
            f32x16 sa = zero16(), sb = zero16();
#pragma unroll
            for (int i = 0; i < 4; ++i) {
              const bf16x8 kf = *(const bf16x8*)(sKt + l32 * 72 + i * 16 + kb * 8);
              sa = mfma(kf, qa[i], sa); sb = mfma(kf, qb_[i], sb);
            }
            bf16x8 vf[2][2];
#pragma unroll
            for (int dt = 0; dt < 2; ++dt)
#pragma unroll
              for (int sI = 0; sI < 2; ++sI) {
                const char* vp = sVt + (16 * sI + 4 * kb + q4) * 144 + (dt * 32 + gc * 16 + 4 * p4) * 2;
                const s16x4 lo4 = lds_tr(vp), hi4 = lds_tr(vp + 8 * 144);
                vf[dt][sI] = __builtin_shufflevector(lo4, hi4, 0, 1, 2, 3, 4, 5, 6, 7);
              }
            f32x16 ps;
#pragma unroll
            for (int r = 0; r < 16; ++r) {
              const int c = ct * 32 + crow(r, kb);
              const bool vd = (c * 16 + 31 <= tq);
              sa[r] = vd ? __builtin_amdgcn_exp2f(__builtin_fmaf(sa[r], CS, -MA)) * iLA : 0.f;
              sb[r] = vd ? __builtin_amdgcn_exp2f(__builtin_fmaf(sb[r], CS, -MB)) * iLB : 0.f;
              ps[r] = sa[r] + sb[r];
            }
            float y[4];
#pragma unroll
            for (int gi = 0; gi < 4; ++gi) y[gi] = __shfl_xor(ps[4 * gi + 3], 32);
#pragma unroll
            for (int gi = 0; gi < 4; ++gi) {
              const float s4 = (ps[4 * gi] + ps[4 * gi + 1]) + (ps[4 * gi + 2] + ps[4 * gi + 3]);
              const float extra = kb ? y[gi] : (gi == 0 ? carry : y[gi > 0 ? gi - 1 : 0]);
              const int j = ct * 8 + 2 * gi + kb;
              imp[j * 32 + l32] += s4 + extra;
            }
            carry = y[3];
#pragma unroll
            for (int sI = 0; sI < 2; ++sI) {
              const bf16x8 pa = pack8(sa[8 * sI], sa[8 * sI + 1], sa[8 * sI + 2], sa[8 * sI + 3], sa[8 * sI + 4], sa[8 * sI + 5], sa[8 * sI + 6], sa[8 * sI + 7]);
              const bf16x8 pb = pack8(sb[8 * sI], sb[8 * sI + 1], sb[8 * sI + 2], sb[8 * sI + 3], sb[8 * sI + 4], sb[8 * sI + 5], sb[8 * sI + 6], sb[8 * sI + 7]);
              oA0 = mfma(vf[0][sI], pa, oA0); oA1 = mfma(vf[1][sI], pa, oA1);
              oB0 = mfma(vf[0][sI], pb, oB0); oB1 = mfma(vf[1][sI], pb, oB1);
            }
          }
        }
        __syncthreads();
      }
      const float gA = sigmoidf_(bf2f(qrow[C_NG + head * 3 + 0]) + P.nsa_gate_b[head * 3 + 0]);
      const float gB = sigmoidf_(bf2f(qrow[C_NG + (head + 1) * 3 + 0]) + P.nsa_gate_b[(head + 1) * 3 + 0]);
#pragma unroll
      for (int gq = 0; gq < 4; ++gq) {
        u32x2 u0, u1, u2, u3;
        u0[0] = pk2(gA * oA0[gq * 4], gA * oA0[gq * 4 + 1]); u0[1] = pk2(gA * oA0[gq * 4 + 2], gA * oA0[gq * 4 + 3]);
        u1[0] = pk2(gA * oA1[gq * 4], gA * oA1[gq * 4 + 1]); u1[1] = pk2(gA * oA1[gq * 4 + 2], gA * oA1[gq * 4 + 3]);
        u2[0] = pk2(gB * oB0[gq * 4], gB * oB0[gq * 4 + 1]); u2[1] = pk2(gB * oB0[gq * 4 + 2], gB * oB0[gq * 4 + 3]);
        u3[0] = pk2(gB * oB1[gq * 4], gB * oB1[gq * 4 + 1]); u3[1] = pk2(gB * oB1[gq * 4 + 2], gB * oB1[gq * 4 + 3]);
        bf16_t* d = mix + tokq * DM + 512 + head * 64 + 8 * gq + 4 * kb;
        *(u32x2*)d = u0; *(u32x2*)(d + 32) = u1; *(u32x2*)(d + 64) = u2; *(u32x2*)(d + 96) = u3;
      }
    }
  }
  asm volatile("s_waitcnt lgkmcnt(0)" ::: "memory");
  __builtin_amdgcn_wave_barrier();
  unsigned mk0 = 0, mk1 = 0, mk2 = 0, mk3 = 0;
  {
    const int cur = tq >> 6, jb = kb * 64;
    unsigned key[64];
#pragma unroll
    for (int i = 0; i < 64; ++i) {
      const int j = jb + i;
      const float v = imp[j * 32 + l32];
      const bool forced = (j == 0) || (j == cur) || (j == cur - 1);
      key[i] = forced ? 0xffffffffu : (j <= cur ? __float_as_uint(v) + 1u : 0u);
    }
    unsigned T = 0u;
#pragma unroll 1
    for (int bit = 31; bit >= 0; --bit) {
      const unsigned Tc = T | (1u << bit);
      int cnt = 0;
#pragma unroll
      for (int i = 0; i < 64; ++i) cnt += (key[i] >= Tc) ? 1 : 0;
      const auto r = __builtin_amdgcn_permlane32_swap((unsigned)cnt, (unsigned)cnt, false, false);
      cnt = (int)(r[0] + r[1]);
      T = (cnt >= 16) ? Tc : T;
    }
    int cgt = 0, ceq = 0;
#pragma unroll
    for (int i = 0; i < 64; ++i) { cgt += (key[i] > T) ? 1 : 0; ceq += (key[i] == T) ? 1 : 0; }
    const auto rg = __builtin_amdgcn_permlane32_swap((unsigned)cgt, (unsigned)cgt, false, false);
    const int need = 16 - (int)(rg[0] + rg[1]);
    const auto re = __builtin_amdgcn_permlane32_swap((unsigned)ceq, (unsigned)ceq, false, false);
    int running = kb ? (int)(re[0] + re[1]) - ceq : 0;
    unsigned mlo = 0u, mhi = 0u;
#pragma unroll
    for (int i = 0; i < 64; ++i) {
      const bool eq = key[i] == T;
      const bool sl = (key[i] != 0u) && ((key[i] > T) || (eq && running < need));
      running += eq ? 1 : 0;
      if (i < 32) mlo |= sl ? (1u << i) : 0u; else mhi |= sl ? (1u << (i - 32)) : 0u;
    }
    const auto rl = __builtin_amdgcn_permlane32_swap(mlo, mlo, false, false);
    const auto rh = __builtin_amdgcn_permlane32_swap(mhi, mhi, false, false);
    const unsigned olo = rl[0] ^ rl[1] ^ mlo, ohi = rh[0] ^ rh[1] ^ mhi;
    mk0 = kb ? olo : mlo; mk1 = kb ? ohi : mhi; mk2 = kb ? mlo : olo; mk3 = kb ? mhi : ohi;
  }
  asm volatile("" ::: "memory");
  __syncthreads();
  const bf16_t* ksel = proj + (size_t)b * SEQ * PW + C_KS + g * 64;
  const bf16_t* vsel = proj + (size_t)b * SEQ * PW + C_VS + g * 64;
  const bf16_t* kwin = proj + (size_t)b * SEQ * PW + C_KW + g * 64;
  const bf16_t* vwin = proj + (size_t)b * SEQ * PW + C_VW + g * 64;
  const int st1 = 4 * qb + 3, wst0 = qb > 2 ? 4 * qb - 8 : 0;
#pragma unroll 1
  for (int hp = 0; hp < 2; ++hp) {
    const int head = g * 4 + hp * 2;
    bf16x8 qa[4], qb_[4];
#pragma unroll
    for (int i = 0; i < 4; ++i) {
      qa[i] = *(const bf16x8*)(qrow + C_NQ + head * 64 + i * 16 + kb * 8);
      qb_[i] = *(const bf16x8*)(qrow + C_NQ + (head + 1) * 64 + i * 16 + kb * 8);
    }
    bf16_t* dstA = mix + tokq * DM + 512 + head * 64;
    bf16_t* dstB = dstA + 64;
    HeadAcc A, B;
    A.o0 = zero16(); A.o1 = zero16(); A.m = -1e30f; A.l = 0.f; B.o0 = zero16(); B.o1 = zero16(); B.m = -1e30f; B.l = 0.f;
    nsa_branch2<false>(ksel, vsel, smem, 0, st1, qt, tq, qa, qb_, mk0, mk1, mk2, mk3, A, B);
    {
      const float gA = sigmoidf_(bf2f(qrow[C_NG + head * 3 + 1]) + P.nsa_gate_b[head * 3 + 1]);
      const float gB = sigmoidf_(bf2f(qrow[C_NG + (head + 1) * 3 + 1]) + P.nsa_gate_b[(head + 1) * 3 + 1]);
      fold_partial(dstA, gA / fmaxf(half_sum(A.l), 1e-30f), A.o0, A.o1, kb);
      fold_partial(dstB, gB / fmaxf(half_sum(B.l), 1e-30f), B.o0, B.o1, kb);
    }
    A.o0 = zero16(); A.o1 = zero16(); A.m = -1e30f; A.l = 0.f; B.o0 = zero16(); B.o1 = zero16(); B.m = -1e30f; B.l = 0.f;
    nsa_branch2<true>(kwin, vwin, smem, wst0, st1, qt, tq, qa, qb_, 0u, 0u, 0u, 0u, A, B);
    {
      const float gA = sigmoidf_(bf2f(qrow[C_NG + head * 3 + 2]) + P.nsa_gate_b[head * 3 + 2]);
      const float gB = sigmoidf_(bf2f(qrow[C_NG + (head + 1) * 3 + 2]) + P.nsa_gate_b[(head + 1) * 3 + 2]);
      fold_partial(dstA, gA / fmaxf(half_sum(A.l), 1e-30f), A.o0, A.o1, kb);
      fold_partial(dstB, gB / fmaxf(half_sum(B.l), 1e-30f), B.o0, B.o1, kb);
    }
  }
}

DI void sgu_item(const Params& P, int item, char* smem) {
  const bf16_t* H = (const bf16_t*)(P.ws + R1);
  bf16_t* Y = (bf16_t*)P.out;
  float* smu = (float*)smem; float* srs = smu + 128; float* sc1 = srs + 128; float* srw = sc1 + 128; float* slg = srw + 128; float* slb = slg + 256;
  bf16_t* sW = (bf16_t*)(smem + 4096);
  char* sV = smem + 4096 + 34816;
  const int tid = TIDX, lane = tid & 63, wave = __builtin_amdgcn_readfirstlane(tid >> 6), l32 = lane & 31, kb = lane >> 5;
  const size_t tok0 = (size_t)item * 128;
#pragma unroll 1
  for (int tb = 0; tb < 16; tb += 4) {
    u32x4 uu[4][4];
#pragma unroll
    for (int a = 0; a < 4; ++a)
#pragma unroll
      for (int k = 0; k < 4; ++k) uu[a][k] = *(const u32x4*)(H + (tok0 + wave * 16 + tb + a) * 4096 + 2048 + k * 512 + lane * 8);
#pragma unroll
    for (int a = 0; a < 4; ++a) {
      float sm = 0.f, s2 = 0.f;
#pragma unroll
      for (int k = 0; k < 4; ++k)
#pragma unroll
        for (int e = 0; e < 4; ++e) { const float x0 = bflo(uu[a][k][e]), x1 = bfhi(uu[a][k][e]); sm += x0 + x1; s2 += x0 * x0 + x1 * x1; }
      sm = wave_sum(sm); s2 = wave_sum(s2);
      const float mu = sm * (1.f / 2048.f);
      const float var = fmaxf(s2 * (1.f / 2048.f) - mu * mu, 0.f);
      if (lane == 0) { smu[wave * 16 + tb + a] = mu; srs[wave * 16 + tb + a] = rsqrtf(var + EPS); }
    }
  }
  __syncthreads();
  const int srow = tid >> 5, schunk = tid & 31;
#pragma unroll 1
  for (int g = 0; g < 8; ++g) {
    u32x4 vreg[8], ureg[8];
#pragma unroll
    for (int i = 0; i < 8; ++i) {
      const bf16_t* hp = H + (tok0 + srow + 16 * i) * 4096 + g * 256 + schunk * 8;
      vreg[i] = *(const u32x4*)(hp + 2048);
      ureg[i] = *(const u32x4*)hp;
    }
    {
      const int t = tid >> 2, qr = tid & 3;
      const float* wrow = P.o_w_s + ((size_t)g * 128 + t) * 128 + qr * 32;
      float4 wq[8];
#pragma unroll
      for (int c4 = 0; c4 < 8; ++c4) wq[c4] = *(const float4*)(wrow + c4 * 4);
      float c1 = 0.f, rw = 0.f;
#pragma unroll
      for (int c8 = 0; c8 < 4; ++c8) {
        const float4 f0 = wq[2 * c8], f1 = wq[2 * c8 + 1];
        float wv[8] = {f0.x, f0.y, f0.z, f0.w, f1.x, f1.y, f1.z, f1.w};
        float ov[8];
#pragma unroll
        for (int e = 0; e < 8; ++e) {
          const int sx = qr * 32 + c8 * 8 + e;
          const float w = (sx <= t) ? wv[e] : 0.f;
          rw += w;
          const float wp = bf2f(f2bf(w * srs[sx]));
          c1 += wp * smu[sx];
          ov[e] = wp;
        }
        u32x4 o; o[0] = pk2(ov[0], ov[1]); o[1] = pk2(ov[2], ov[3]); o[2] = pk2(ov[4], ov[5]); o[3] = pk2(ov[6], ov[7]);
        *(u32x4*)(sW + t * 136 + qr * 32 + c8 * 8) = o;
      }
      c1 += __shfl_xor(c1, 1); rw += __shfl_xor(rw, 1);
      c1 += __shfl_xor(c1, 2); rw += __shfl_xor(rw, 2);
      if (qr == 0) { sc1[t] = c1; srw[t] = rw; }
      if (tid < 256) { slg[tid] = P.o_ln_g[g * 256 + tid]; slb[tid] = P.o_ln_b[g * 256 + tid]; }
    }
#pragma unroll
    for (int i = 0; i < 8; ++i) *(u32x4*)(sV + (srow + 16 * i) * 544 + schunk * 16) = vreg[i];
    __syncthreads();
    const int tt = wave & 3, chh = wave >> 2;
    f32x16 acc[4];
#pragma unroll
    for (int c = 0; c < 4; ++c) acc[c] = zero16();
    {
      const int i16 = lane & 15, q = i16 >> 2, p = i16 & 3, gc = (lane >> 4) & 1;
      const char* vb = sV + (8 * kb + q) * 544 + (chh * 128 + gc * 16 + 4 * p) * 2;
      const bf16_t* wb = sW + (tt * 32 + l32) * 136 + kb * 8;
      const int nks = 2 * (tt + 1);
      for (int ks = 0; ks < nks; ++ks) {
        const bf16x8 wf = *(const bf16x8*)(wb + ks * 16);
#pragma unroll
        for (int c = 0; c < 4; ++c) {
          const s16x4 lo = lds_tr(vb + ks * 16 * 544 + c * 64);
          const s16x4 hi = lds_tr(vb + (ks * 16 + 4) * 544 + c * 64);
          const bf16x8 vf = __builtin_shufflevector(lo, hi, 0, 1, 2, 3, 4, 5, 6, 7);
          acc[c] = mfma(vf, wf, acc[c]);
        }
      }
    }
    __syncthreads();
    {
      const int t = tt * 32 + l32;
      const float c1 = sc1[t], rw = srw[t], bs = P.o_b_s[g * 128 + t];
#pragma unroll
      for (int c = 0; c < 4; ++c)
#pragma unroll
        for (int gq = 0; gq < 4; ++gq) {
          const int chl = (chh * 4 + c) * 32 + 8 * gq + 4 * kb;
          const float4 lg = *(const float4*)(slg + chl), lb = *(const float4*)(slb + chl);
          const float m0 = lg.x * (acc[c][gq * 4 + 0] - c1) + lb.x * rw + bs;
          const float m1 = lg.y * (acc[c][gq * 4 + 1] - c1) + lb.y * rw + bs;
          const float m2 = lg.z * (acc[c][gq * 4 + 2] - c1) + lb.z * rw + bs;
          const float m3 = lg.w * (acc[c][gq * 4 + 3] - c1) + lb.w * rw + bs;
          u32x2 o; o[0] = pk2(m0, m1); o[1] = pk2(m2, m3);
          *(u32x2*)(sV + t * 520 + chl * 2) = o;
        }
    }
    __syncthreads();
#pragma unroll
    for (int i = 0; i < 8; ++i) {
      const char* mp = sV + (srow + 16 * i) * 520 + schunk * 16;
      const u32x2 ma = *(const u32x2*)mp, mb = *(const u32x2*)(mp + 8);
      const u32x4 uu = ureg[i];
      u32x4 o;
      o[0] = pk2(bflo(uu[0]) * bflo(ma[0]), bfhi(uu[0]) * bfhi(ma[0]));
      o[1] = pk2(bflo(uu[1]) * bflo(ma[1]), bfhi(uu[1]) * bfhi(ma[1]));
      o[2] = pk2(bflo(uu[2]) * bflo(mb[0]), bfhi(uu[2]) * bfhi(mb[0]));
      o[3] = pk2(bflo(uu[3]) * bflo(mb[1]), bfhi(uu[3]) * bfhi(mb[1]));
      *(u32x4*)(Y + (tok0 + srow + 16 * i) * 2048 + g * 256 + schunk * 8) = o;
    }
    __syncthreads();
  }
}

constexpr int NPHASE = 17;
DI void run_phase(const Params& P, int ph, char* smem) {
  char* ws = P.ws;
  bf16_t* r1 = (bf16_t*)(ws + R1); bf16_t* r2 = (bf16_t*)(ws + R2); bf16_t* r3 = (bf16_t*)(ws + R3); bf16_t* r4 = (bf16_t*)(ws + R4);
  unsigned* cnt = (unsigned*)(ws + W_CNT);
  const int lane = TIDX & 63, wave = TIDX >> 6, half = TIDX >> 8;
  char* hsmem = smem + half * 65536;
  switch (ph) {
    case 0: phase_prep(P); break;
    case 1: gemm_run<0>(r2, (const bf16_t*)(ws + W_EIN), PW, 1024, r1, PW, smem); break;
    case 2: {
      if (blockIdx.x < 64) nsa_compress_task(P, blockIdx.x * WPB + wave);
      volatile int* s_item = (volatile int*)(smem + LDS_BYTES - 16);
      for (;;) {
        __syncthreads();
        if (TIDX == 0) *s_item = (int)atomicAdd(cnt + 0, 1u);
        __syncthreads();
        const int pair = *s_item;
        if (pair >= 2048) break;
        gla_p1_item(P, pair * 2 + half, hsmem);
      }
    } break;
    case 3: gla_scan(P);
    case 30: {
      volatile int* s_item = (volatile int*)(smem + 131072);
      for (;;) {
        __syncthreads();
        if (TIDX == 0) *s_item = (int)atomicAdd(cnt + 1, 1u);
        __syncthreads();
        const int it = *s_item;
        if (it >= 512) break;
        nsa_block(P, (it & 15) >> 1, it & 1, 31 - (it >> 4), smem);
      }
    } break;
    case 4: {
      int item = blockIdx.x * 2 + half;
      const int tid4 = TIDX & 255;
      int hcur = -1;
      P3Pref cur;
      if (item < 4096) gla_p3_load(P, item, cur);
      for (; item < 4096; item += gridDim.x * 2) {
        const int h = (item >> 7) & 3;
        if (h != hcur) {
          __syncthreads();
          float* sw = (float*)(hsmem + 57344);
          for (int e = tid4; e < 1024; e += 256) sw[e] = P.gla_w_gate[(e >> 6) * 256 + h * 64 + (e & 63)];
          if (tid4 < 64) sw[1024 + tid4] = P.gla_b_gate[h * 64 + tid4];
          if (tid4 < 128) sw[1088 + tid4] = P.gla_norm[h * 128 + tid4];
          hcur = h;
          __syncthreads();
        }
        P3Pref nxt;
        const int ni = item + gridDim.x * 2;
        if (ni < 4096) gla_p3_load(P, ni, nxt); else nxt = cur;
        gla_p3_item(P, item, hsmem, cur);
        cur = nxt;
      }
    } break;
    case 5: gemm_run<0>(r3, (const bf16_t*)(ws + W_EOUT), 1024, 1024, r4, 1024, smem); break;
    case 6: resnorm_rows<true, false>(r4, P.x, nullptr, nullptr, r3, P.norm_g + 1 * 1024, P.norm_g + 2 * 1024, r2); break;
    case 7: gemm_run<1>(r2, (const bf16_t*)(ws + W_FFN1_0), 4096, 1024, r1, 4096, smem); break;
    case 8: gemm_run<0>(r1, (const bf16_t*)(ws + W_FFN2_0), 1024, 4096, r4, 1024, smem); break;
    case 9: resnorm_rows<false, false>(r4, nullptr, r3, nullptr, r3, P.norm_g + 3 * 1024, P.norm_g + 4 * 1024, r2); break;
    case 10: gemm_run<2>(r2, (const bf16_t*)(ws + W_OIN), 4096, 1024, r1, 4096, smem); break;
    case 11:
      for (int item = blockIdx.x; item < 512; item += gridDim.x) sgu_item(P, item, smem);
      break;
    case 12: gemm_run<0>((const bf16_t*)P.out, (const bf16_t*)(ws + W_OOUT), 1024, 2048, r4, 1024, smem); break;
    case 13: resnorm_rows<false, false>(r4, nullptr, r3, nullptr, r3, P.norm_g + 5 * 1024, P.norm_g + 6 * 1024, r2); break;
    case 14: gemm_run<1>(r2, (const bf16_t*)(ws + W_FFN1_1), 4096, 1024, r1, 4096, smem); break;
    case 15: gemm_run<0>(r1, (const bf16_t*)(ws + W_FFN2_1), 1024, 4096, r4, 1024, smem); break;
    case 16: resnorm_rows<false, true>(r4, nullptr, r3, P.out, nullptr, P.norm_g + 7 * 1024, nullptr, nullptr); break;
    default: break;
  }
}

#if !MEGA
extern __shared__ __attribute__((aligned(16))) unsigned char lds_dyn[];
__global__ void __launch_bounds__(NTHR, 2) k_phase(Params P, int ph) {
  char* smem = (char*)lds_dyn;
  run_phase(P, ph, smem);
}
#endif

#define XB_TMO      128
#define XB_XCNT(j)  (256  + 64 * (j))
#define XB_XSUB(j)  (1280 + 64 * (j))
#define XB_XGEN(j)  (2304 + 64 * (j))
#define XB_TOP      3328
#define XB_TOPGEN   3392
#define XCD_BAR_WORDS 3456
#define XB_SPIN_CAP (1u << 20)
#define LAS3 __attribute__((address_space(3)))
DI unsigned xb_ld(unsigned* p) { return __hip_atomic_load(p, __ATOMIC_RELAXED, __HIP_MEMORY_SCOPE_AGENT); }
DI unsigned xb_add(unsigned* p, unsigned v) { return __hip_atomic_fetch_add(p, v, __ATOMIC_RELAXED, __HIP_MEMORY_SCOPE_AGENT); }
DI unsigned xb_xcc_id() { return (unsigned)__builtin_amdgcn_s_getreg((3 << 11) | 20) & 0xFu; }
#define XB_SPIN(cond, bar) do { unsigned _sp = 0; while (cond) { __builtin_amdgcn_s_sleep(1); \
    if ((++_sp & 255u) == 0u) { if (xb_ld(&(bar)[XB_TMO])) break; if (_sp > XB_SPIN_CAP) { atomicAdd(&(bar)[XB_TMO], 1u); break; } } } } while (0)
struct XcdBarrier { unsigned* bar; unsigned x; volatile LAS3 unsigned* st; };
DI XcdBarrier xcd_barrier_post(unsigned* bar, volatile LAS3 unsigned* st) {
  XcdBarrier b; b.bar = bar; b.x = xb_xcc_id(); b.st = st;
  if (threadIdx.x == 0) (void)xb_add(&bar[XB_XCNT(b.x)], 1u);
  return b;
}
DI void xcd_barrier_complete(unsigned* bar, unsigned x, unsigned& nloc, unsigned& nx) {
  const unsigned G = gridDim.x * gridDim.y * gridDim.z;
  unsigned sum, cnt, mine, sp = 0u;
  for (;;) {
    sum = 0u; cnt = 0u; mine = 0u;
#pragma unroll
    for (unsigned j = 0; j < 16; ++j) { const unsigned c = xb_ld(&bar[XB_XCNT(j)]); sum += c; cnt += (c > 0u) ? 1u : 0u; mine = (j == x) ? c : mine; }
    if (sum == G) break;
    __builtin_amdgcn_s_sleep(1);
    if ((++sp & 255u) == 0u) { if (xb_ld(&bar[XB_TMO])) break; if (sp > XB_SPIN_CAP) { atomicAdd(&bar[XB_TMO], 1u); break; } }
  }
  nloc = mine > 0u ? mine : 1u; nx = cnt > 0u ? cnt : 1u;
}
DI void xcd_barrier(const XcdBarrier& b) {
  asm volatile("s_waitcnt vmcnt(0)" ::: "memory");
  __syncthreads();
  if (threadIdx.x == 0) {
    unsigned* bar = b.bar;
    __builtin_amdgcn_s_waitcnt(0);
    unsigned nloc = b.st[0], nx = b.st[1];
    if (nloc == 0u) { xcd_barrier_complete(bar, b.x, nloc, nx); b.st[0] = nloc; b.st[1] = nx; }
    const unsigned old = xb_add(&bar[XB_XSUB(b.x)], 1u);
    const unsigned gen = old / nloc;
    if (old + 1u == (gen + 1u) * nloc) {
      __builtin_amdgcn_fence(__ATOMIC_RELEASE, "agent");
      asm volatile("s_waitcnt vmcnt(0)" ::: "memory");
      const unsigned og = xb_add(&bar[XB_TOP], 1u);
      const unsigned tg = og / nx;
      if (og + 1u == (tg + 1u) * nx) xb_add(&bar[XB_TOPGEN], 1u);
      else XB_SPIN(xb_ld(&bar[XB_TOPGEN]) == tg, bar);
      __builtin_amdgcn_fence(__ATOMIC_ACQUIRE, "agent");
      xb_add(&bar[XB_XGEN(b.x)], 1u);
      asm volatile("s_waitcnt vmcnt(0)" ::: "memory");
    } else {
      XB_SPIN(xb_ld(&bar[XB_XGEN(b.x)]) == gen, bar);
      __builtin_amdgcn_fence(__ATOMIC_ACQUIRE, "agent");
      asm volatile("s_waitcnt vmcnt(0)" ::: "memory");
    }
  }
  __syncthreads();
}

#if MEGA
extern __shared__ __attribute__((aligned(16))) unsigned char lds_dyn[];
__global__ void __launch_bounds__(NTHR, 2) k_mega(Params P) {
  char* smem = (char*)lds_dyn;
  cg::grid_group grid = cg::this_grid();
  volatile LAS3 unsigned* xst = (volatile LAS3 unsigned*)(smem + 131072 + 16);
  if (threadIdx.x == 0) { xst[0] = 0u; xst[1] = 0u; }
  __syncthreads();
  const XcdBarrier xb = xcd_barrier_post((unsigned*)(P.ws + W_BAR), xst);
#define GSYNC() xcd_barrier(xb)
#define GEMM_PH(n) run_phase(P, n, smem); GSYNC(); if (PROBE == 1) { run_phase(P, n, smem); GSYNC(); }
  if (P.ws == nullptr) grid.sync();
  run_phase(P, 0, smem); GSYNC();
  if (PROBE == 3) { run_phase(P, 0, smem); GSYNC(); }
  GEMM_PH(1)
  run_phase(P, 2, smem); GSYNC();
  if (PROBE == 4) { if (blockIdx.x == 0 && TIDX == 0) ((unsigned*)(P.ws + W_CNT))[0] = 0u; GSYNC(); run_phase(P, 2, smem); GSYNC(); }
  run_phase(P, 3, smem); GSYNC();
  if (PROBE == 2) {
    if (blockIdx.x == 0 && TIDX == 0) ((unsigned*)(P.ws + W_CNT))[1] = 0u;
    GSYNC();
    run_phase(P, 30, smem); GSYNC();
  }
  run_phase(P, 4, smem); GSYNC();
  if (PROBE == 5) { run_phase(P, 4, smem); GSYNC(); }
  GEMM_PH(5)
  run_phase(P, 6, smem); GSYNC();
  if (PROBE == 6) { run_phase(P, 6, smem); GSYNC(); run_phase(P, 6, smem); GSYNC(); run_phase(P, 6, smem); GSYNC(); }
  GEMM_PH(7)
  GEMM_PH(8)
  run_phase(P, 9, smem); GSYNC();
  GEMM_PH(10)
  run_phase(P, 11, smem); GSYNC();
  if (PROBE == 7) { run_phase(P, 11, smem); GSYNC(); }
  GEMM_PH(12)
  run_phase(P, 13, smem); GSYNC();
  GEMM_PH(14)
  GEMM_PH(15)
  if (PROBE == 11) { GSYNC(); GSYNC(); GSYNC(); GSYNC(); GSYNC(); GSYNC(); GSYNC(); GSYNC(); }
  run_phase(P, 16, smem);
}
#endif

extern "C" void kernel_launch(void* const* d_in, const int* in_sizes, int n_in, void* d_out, int out_size, void* d_ws, size_t ws_size,
                              hipStream_t stream) {
  Params p{};
  p.x = (const float*)d_in[0]; p.norm_g = (const float*)d_in[1]; p.ffn_w1 = (const float*)d_in[2]; p.ffn_w2 = (const float*)d_in[3];
  p.e_w_in = (const float*)d_in[4]; p.e_w_out = (const float*)d_in[5]; p.gla_w_gate = (const float*)d_in[6]; p.gla_b_gate = (const float*)d_in[7];
  p.gla_norm = (const float*)d_in[8]; p.nsa_gate_b = (const float*)d_in[9]; p.cmp_pos = (const float*)d_in[10]; p.cmp_w1 = (const float*)d_in[11];
  p.cmp_w2 = (const float*)d_in[12]; p.o_w_in = (const float*)d_in[13]; p.o_ln_g = (const float*)d_in[14]; p.o_ln_b = (const float*)d_in[15];
  p.o_w_s = (const float*)d_in[16]; p.o_b_s = (const float*)d_in[17]; p.o_w_out = (const float*)d_in[18];
  p.out = (float*)d_out; p.ws = (char*)d_ws;
  if (ws_size < 1024ull * MiB) { fprintf(stderr, "workspace too small: %zu\n", ws_size); return; }
  static int grid_blocks = 0;
  if (!grid_blocks) {
    int dev = 0, cus = 0, per_cu = 0;
    (void)hipGetDevice(&dev);
    (void)hipDeviceGetAttribute(&cus, hipDeviceAttributeMultiprocessorCount, dev);
#if MEGA
    if (hipFuncSetAttribute((const void*)k_mega, hipFuncAttributeMaxDynamicSharedMemorySize, LDS_BYTES) != hipSuccess) fprintf(stderr, "hipFuncSetAttribute failed\n");
    (void)hipOccupancyMaxActiveBlocksPerMultiprocessor(&per_cu, (const void*)k_mega, NTHR, LDS_BYTES);
#else
    if (hipFuncSetAttribute((const void*)k_phase, hipFuncAttributeMaxDynamicSharedMemorySize, LDS_BYTES) != hipSuccess) fprintf(stderr, "hipFuncSetAttribute failed\n");
    (void)hipOccupancyMaxActiveBlocksPerMultiprocessor(&per_cu, (const void*)k_phase, NTHR, LDS_BYTES);
#endif
    if (per_cu < 1) fprintf(stderr, "occupancy query returned %d\n", per_cu);
    grid_blocks = cus;
  }
#if MEGA
  if (hipMemsetAsync((char*)d_ws + W_BAR, 0, XCD_BAR_WORDS * sizeof(unsigned), stream) != hipSuccess) fprintf(stderr, "memset of barrier words failed\n");
  void* args[] = {&p};
  hipError_t e = hipLaunchCooperativeKernel((void*)k_mega, dim3(grid_blocks), dim3(NTHR), args, LDS_BYTES, stream);
  if (e != hipSuccess) fprintf(stderr, "cooperative launch failed: %s (grid %d)\n", hipGetErrorString(e), grid_blocks);
#else
  for (int ph = 0; ph < NPHASE; ++ph) k_phase<<<grid_blocks, NTHR, LDS_BYTES, stream>>>(p, ph);
#endif
}
```

```cpp
#include <hip/hip_runtime.h>
#include <hip/hip_cooperative_groups.h>
#include <cstdio>
namespace cg = cooperative_groups;

#ifndef MEGA
#define MEGA 1
#endif
#ifndef PROBE
#define PROBE 0
#endif

typedef unsigned short bf16_t;
typedef short bf16x8 __attribute__((ext_vector_type(8)));
typedef short s16x4 __attribute__((ext_vector_type(4)));
typedef float f32x16 __attribute__((ext_vector_type(16)));
typedef float f32v2 __attribute__((ext_vector_type(2)));
typedef __bf16 bf16v2 __attribute__((ext_vector_type(2)));
typedef unsigned u32x4 __attribute__((ext_vector_type(4)));
typedef unsigned u32x2 __attribute__((ext_vector_type(2)));
#define DI __device__ __forceinline__
DI int tid_opaque() { int t = threadIdx.x; asm volatile("" : "+v"(t)); return t; }
#define TIDX tid_opaque()

constexpr int T_TOK = 65536, SEQ = 8192, DM = 1024;
constexpr int PW = 3072;
constexpr int C_GQ = 0, C_GK = 256, C_GV = 512, C_GLR = 1024, C_GR = 1040, C_NQ = 1552, C_KC = 2064, C_VC = 2192,
              C_KS = 2320, C_VS = 2448, C_KW = 2576, C_VW = 2704, C_NG = 2832;
constexpr float EPS = 1e-6f;
constexpr int NTHR = 512, WPB = 8, LDS_CMP_STAGE = 131072 + 64, LDS_BYTES = 131072 + 64 + 18432;
constexpr size_t MiB = 1024ull * 1024ull;
constexpr size_t W_FFN1_0 = 0, W_FFN1_1 = 8 * MiB, W_FFN2_0 = 16 * MiB, W_FFN2_1 = 24 * MiB, W_EIN = 32 * MiB, W_EOUT = 38 * MiB,
                 W_OIN = 40 * MiB, W_OOUT = 48 * MiB, W_CW1 = 52 * MiB, W_CW2 = 53 * MiB, W_BIAS1 = 53 * MiB + 65536,
                 W_CNT = 53 * MiB + 131072, W_BAR = 54 * MiB;
constexpr size_t R1 = 64 * MiB, R2 = 576 * MiB, R3 = 704 * MiB, R4 = 832 * MiB, R5 = 960 * MiB;
constexpr size_t R_KCMP = R5, R_VCMPT = R5 + 1 * MiB, R_VST = R5 + 2 * MiB, R_VWT = R5 + 18 * MiB, R_DECAY = R5 + 34 * MiB;

struct Params {
  const float* x; const float* norm_g; const float* ffn_w1; const float* ffn_w2; const float* e_w_in; const float* e_w_out;
  const float* gla_w_gate; const float* gla_b_gate; const float* gla_norm; const float* nsa_gate_b; const float* cmp_pos;
  const float* cmp_w1; const float* cmp_w2; const float* o_w_in; const float* o_ln_g; const float* o_ln_b; const float* o_w_s;
  const float* o_b_s; const float* o_w_out;
  float* out; char* ws;
};

DI int crow(int r, int kb) { return (r & 3) + 8 * (r >> 2) + 4 * kb; }
DI f32x16 mfma(bf16x8 a, bf16x8 b, f32x16 c) { return __builtin_amdgcn_mfma_f32_32x32x16_bf16(a, b, c, 0, 0, 0); }
DI unsigned pk2(float a, float b) { f32v2 v = {a, b}; bf16v2 r = __builtin_convertvector(v, bf16v2); return __builtin_bit_cast(unsigned, r); }
DI bf16_t f2bf(float a) { return (bf16_t)(pk2(a, 0.f) & 0xffffu); }
DI float bf2f(bf16_t u) { return __uint_as_float(((unsigned)u) << 16); }
DI float bflo(unsigned u) { return __uint_as_float(u << 16); }
DI float bfhi(unsigned u) { return __uint_as_float(u & 0xffff0000u); }
DI bf16x8 pack8(float a0, float a1, float a2, float a3, float a4, float a5, float a6, float a7) {
  u32x4 p; p[0] = pk2(a0, a1); p[1] = pk2(a2, a3); p[2] = pk2(a4, a5); p[3] = pk2(a6, a7);
  return __builtin_bit_cast(bf16x8, p);
}
DI bf16x8 ld2x4(const bf16_t* p) {
  s16x4 lo = *(const s16x4*)p; s16x4 hi = *(const s16x4*)(p + 8);
  return __builtin_shufflevector(lo, hi, 0, 1, 2, 3, 4, 5, 6, 7);
}
DI float wave_sum(float v) {
#pragma unroll
  for (int o = 32; o > 0; o >>= 1) v += __shfl_xor(v, o);
  return v;
}
DI f32x16 zero16() { f32x16 z;
#pragma unroll
  for (int i = 0; i < 16; ++i) z[i] = 0.f; return z; }
DI float gelu_tanh(float x) { float u = 1.5957691216f * (x + 0.044715f * x * x * x); return x / (1.f + __expf(-u)); }
DI float sigmoidf_(float x) { return 1.f / (1.f + __expf(-x)); }

DI void conv_weight(const float* __restrict__ src, bf16_t* __restrict__ dst, int K, int N, int Npad) {
  const long total = (long)Npad * (K >> 3);
  const long stride = (long)gridDim.x * blockDim.x;
  for (long i = (long)blockIdx.x * blockDim.x + TIDX; i < total; i += stride) {
    const int n = (int)(i % Npad); const int k8 = (int)(i / Npad);
    float v[8];
#pragma unroll
    for (int j = 0; j < 8; ++j) v[j] = (n < N) ? src[(size_t)(k8 * 8 + j) * N + n] : 0.f;
    u32x4 o; o[0] = pk2(v[0], v[1]); o[1] = pk2(v[2], v[3]); o[2] = pk2(v[4], v[5]); o[3] = pk2(v[6], v[7]);
    *(u32x4*)(dst + (size_t)n * K + k8 * 8) = o;
  }
}

DI void prenorm_rows(const float* __restrict__ x, const float* __restrict__ g, bf16_t* __restrict__ xn) {
  const int lane = TIDX & 63, wave = TIDX >> 6;
  const int nw = gridDim.x * WPB;
  for (int row = blockIdx.x * WPB + wave; row < T_TOK; row += nw) {
    const float4* xr = (const float4*)(x + (size_t)row * DM);
    float4 a[4]; float ss = 0.f;
#pragma unroll
    for (int k = 0; k < 4; ++k) { a[k] = xr[k * 64 + lane]; ss += a[k].x * a[k].x + a[k].y * a[k].y + a[k].z * a[k].z + a[k].w * a[k].w; }
    ss = wave_sum(ss);
    const float rs = rsqrtf(ss * (1.f / DM) + EPS);
#pragma unroll
    for (int k = 0; k < 4; ++k) {
      const float4 gg = ((const float4*)g)[k * 64 + lane];
      u32x2 o; o[0] = pk2(a[k].x * rs * gg.x, a[k].y * rs * gg.y); o[1] = pk2(a[k].z * rs * gg.z, a[k].w * rs * gg.w);
      *(u32x2*)(xn + (size_t)row * DM + k * 256 + lane * 4) = o;
    }
  }
}

template <bool HIN_F32, bool HOUT_F32>
DI void resnorm_rows(const bf16_t* __restrict__ m, const float* __restrict__ hin_f, const bf16_t* hin_b, float* __restrict__ hout_f,
                     bf16_t* hout_b, const float* __restrict__ gpost, const float* __restrict__ gnext, bf16_t* __restrict__ xn) {
  const int lane = TIDX & 63, wave = TIDX >> 6;
  const int nw = gridDim.x * WPB;
  for (int row = blockIdx.x * WPB + wave; row < T_TOK; row += nw) {
    float mv[16]; float ss = 0.f;
#pragma unroll
    for (int k = 0; k < 4; ++k) {
      const u32x2 u = *(const u32x2*)(m + (size_t)row * DM + k * 256 + lane * 4);
      mv[k * 4 + 0] = bflo(u[0]); mv[k * 4 + 1] = bfhi(u[0]); mv[k * 4 + 2] = bflo(u[1]); mv[k * 4 + 3] = bfhi(u[1]);
    }
    float hv[16];
#pragma unroll
    for (int k = 0; k < 4; ++k) {
      if (HIN_F32) {
        const float4 h4 = ((const float4*)(hin_f + (size_t)row * DM))[k * 64 + lane];
        hv[k * 4 + 0] = h4.x; hv[k * 4 + 1] = h4.y; hv[k * 4 + 2] = h4.z; hv[k * 4 + 3] = h4.w;
      } else {
        const u32x2 u = *(const u32x2*)(hin_b + (size_t)row * DM + k * 256 + lane * 4);
        hv[k * 4 + 0] = bflo(u[0]); hv[k * 4 + 1] = bfhi(u[0]); hv[k * 4 + 2] = bflo(u[1]); hv[k * 4 + 3] = bfhi(u[1]);
      }
    }
#pragma unroll
    for (int i = 0; i < 16; ++i) ss += mv[i] * mv[i];
    ss = wave_sum(ss);
    const float rs = rsqrtf(ss * (1.f / DM) + EPS);
    float s2 = 0.f;
#pragma unroll
    for (int k = 0; k < 4; ++k) {
      const float4 gg = ((const float4*)gpost)[k * 64 + lane];
      hv[k * 4 + 0] += mv[k * 4 + 0] * rs * gg.x; hv[k * 4 + 1] += mv[k * 4 + 1] * rs * gg.y;
      hv[k * 4 + 2] += mv[k * 4 + 2] * rs * gg.z; hv[k * 4 + 3] += mv[k * 4 + 3] * rs * gg.w;
      if (HOUT_F32) {
        float4 o; o.x = hv[k * 4 + 0]; o.y = hv[k * 4 + 1]; o.z = hv[k * 4 + 2]; o.w = hv[k * 4 + 3];
        ((float4*)(hout_f + (size_t)row * DM))[k * 64 + lane] = o;
      } else {
        u32x2 o; o[0] = pk2(hv[k * 4 + 0], hv[k * 4 + 1]); o[1] = pk2(hv[k * 4 + 2], hv[k * 4 + 3]);
        *(u32x2*)(hout_b + (size_t)row * DM + k * 256 + lane * 4) = o;
      }
    }
    if (xn) {
#pragma unroll
      for (int i = 0; i < 16; ++i) s2 += hv[i] * hv[i];
      s2 = wave_sum(s2);
      const float r2 = rsqrtf(s2 * (1.f / DM) + EPS);
#pragma unroll
      for (int k = 0; k < 4; ++k) {
        const float4 gg = ((const float4*)gnext)[k * 64 + lane];
        u32x2 o; o[0] = pk2(hv[k * 4 + 0] * r2 * gg.x, hv[k * 4 + 1] * r2 * gg.y); o[1] = pk2(hv[k * 4 + 2] * r2 * gg.z, hv[k * 4 + 3] * r2 * gg.w);
        *(u32x2*)(xn + (size_t)row * DM + k * 256 + lane * 4) = o;
      }
    }
  }
}

DI void phase_prep(const Params& P) {
  char* ws = P.ws;
  conv_weight(P.ffn_w1, (bf16_t*)(ws + W_FFN1_0), 1024, 4096, 4096);
  conv_weight(P.ffn_w1 + (size_t)1024 * 4096, (bf16_t*)(ws + W_FFN1_1), 1024, 4096, 4096);
  conv_weight(P.ffn_w2, (bf16_t*)(ws + W_FFN2_0), 4096, 1024, 1024);
  conv_weight(P.ffn_w2 + (size_t)1024 * 4096, (bf16_t*)(ws + W_FFN2_1), 4096, 1024, 1024);
  conv_weight(P.e_w_in, (bf16_t*)(ws + W_EIN), 1024, 2856, PW);
  conv_weight(P.e_w_out, (bf16_t*)(ws + W_EOUT), 1024, 1024, 1024);
  conv_weight(P.o_w_in, (bf16_t*)(ws + W_OIN), 1024, 4096, 4096);
  conv_weight(P.o_w_out, (bf16_t*)(ws + W_OOUT), 2048, 1024, 1024);
  conv_weight(P.cmp_w1, (bf16_t*)(ws + W_CW1), 2048, 128, 128);
  conv_weight(P.cmp_w1 + 2048 * 128, (bf16_t*)(ws + W_CW1) + 128 * 2048, 2048, 128, 128);
  conv_weight(P.cmp_w2, (bf16_t*)(ws + W_CW2), 128, 64, 64);
  conv_weight(P.cmp_w2 + 128 * 64, (bf16_t*)(ws + W_CW2) + 64 * 128, 128, 64, 64);
  const int lane = TIDX & 63, wave = TIDX >> 6;
  const int gw = blockIdx.x * WPB + wave;
  if (gw < 256) {
    const int i = gw >> 7, hid = gw & 127;
    float s = 0.f;
    for (int kk = lane; kk < 2048; kk += 64) s += P.cmp_pos[i * 2048 + kk] * P.cmp_w1[((size_t)i * 2048 + kk) * 128 + hid];
    s = wave_sum(s);
    if (lane == 0) ((float*)(ws + W_BIAS1))[gw] = s;
  }
  const int gt = blockIdx.x * blockDim.x + TIDX;
  if (gt < 16) ((unsigned*)(ws + W_CNT))[gt] = 0u;
  if (gt < 16 * 64) {
    const int bg = gt >> 6, d = gt & 63;
    ((bf16_t*)(ws + R_KCMP))[((size_t)bg * 512 + 511) * 64 + d] = 0;
    ((bf16_t*)(ws + R_VCMPT))[((size_t)bg * 512 + 511) * 64 + d] = 0;
  }
  prenorm_rows(P.x, P.norm_g, (bf16_t*)(ws + R2));
}

namespace pg8 {
#define PG8_LAS __attribute__((address_space(3)))
typedef float f32x4 __attribute__((ext_vector_type(4)));
constexpr int BM = 256, BK = 64, HALF = 128, HTB = HALF * BK * 2, STAGE_BYTES = 8 * HTB, NXCD = 8, WGM = 8;
DI int lds_byte(int r, int c) { const int st = (r >> 4) * 2 + (c >> 5), rr = r & 15, cc = c & 31, ob = rr * 64 + cc * 2; return st * 1024 + (ob ^ (((ob >> 9) & 1) << 5)); }
DI void stage_rc(int b, int& R, int& C) { const int st = b / 1024, sb = b % 1024, swz = sb ^ (((sb >> 9) & 1) << 5); R = (st >> 1) * 16 + swz / 64; C = (st & 1) * 32 + (swz % 64) / 2; }
DI int perm32(int rho) { const int n = rho >> 4, i = rho & 15; return 8 * (i >> 2) + 4 * n + (i & 3); }
struct Unit { int pm, pn; };
struct Gemm { const bf16_t* A; const bf16_t* Bt; int M, N, K; };
struct StaticOrder {
  int nM, nN, nwg, G, c;
  DI void init(int M, int N, int G_, int c_) { nM = M / BM; nN = N / BM; nwg = nM * nN; G = G_; c = c_; }
  DI bool next(int i, Unit& u) const {
    const long L = (long)i * G + c; if (L >= nwg) return false;
    int wgid = (int)L; { const int q = nwg / NXCD, r = nwg % NXCD, xcd = wgid % NXCD, off = wgid / NXCD; wgid = (xcd < r ? xcd * (q + 1) : r * (q + 1) + (xcd - r) * q) + off; }
    const int nig = WGM * nN, gid = wgid / nig, fm = gid * WGM, gsz = (nM - fm) < WGM ? (nM - fm) : WGM;
    u.pm = fm + ((wgid % nig) % gsz); u.pn = (wgid % nig) / gsz; return true;
  }
};
template <int ACT> struct EpiB {
  static constexpr bool PERM = true;
  bf16_t* O; int ldc;
  DI void operator()(const f32x4 (&acc)[2][2][4][2], const Unit& u, int wr, int wc, int fr, int fq) const {
    const int row0 = u.pm * BM + wr * 64 + fr; const int col0 = u.pn * BM + wc * 32 + 8 * fq;
#pragma unroll
    for (int ai = 0; ai < 2; ++ai)
#pragma unroll
      for (int m = 0; m < 4; ++m) {
        bf16_t* rowp = O + (size_t)(row0 + ai * HALF + m * 16) * ldc + col0;
#pragma unroll
        for (int bj = 0; bj < 2; ++bj) {
          f32x4 v0 = acc[ai][bj][m][0], v1 = acc[ai][bj][m][1];
          if (ACT == 1) {
#pragma unroll
            for (int j = 0; j < 4; ++j) { const float a = fmaxf(v0[j], 0.f), b = fmaxf(v1[j], 0.f); v0[j] = a * a; v1[j] = b * b; }
          }
          if (ACT == 2) {
#pragma unroll
            for (int j = 0; j < 4; ++j) { v0[j] = gelu_tanh(v0[j]); v1[j] = gelu_tanh(v1[j]); }
          }
          u32x4 w; w[0] = pk2(v0[0], v0[1]); w[1] = pk2(v0[2], v0[3]); w[2] = pk2(v1[0], v1[1]); w[3] = pk2(v1[2], v1[3]);
          *(u32x4*)(rowp + bj * HALF) = w;
        }
      }
  }
};

template <class Epi, class Sched>
DI void gemm_phase(PG8_LAS unsigned char* lds, const Gemm g, const Sched& S, const Epi& E) {
  const int tid_ = TIDX;
  const int tid = tid_, wid = __builtin_amdgcn_readfirstlane(tid >> 6), lane = tid & 63, wr = wid >> 2, wc = wid & 3, fr = lane & 15, fq = lane >> 4;
  const int K = g.K, nt = K / BK;
  unsigned voffA[2], voffB[2];
#pragma unroll
  for (int i = 0; i < 2; ++i) { int R, C; stage_rc(tid * 16 + i * 8192, R, C); const int Rb = Epi::PERM ? ((R & ~31) + perm32(R & 31)) : R;
    voffA[i] = (unsigned)(R * K + C) * 2u; voffB[i] = (unsigned)(Rb * K + C) * 2u; }
  const size_t kstep = (size_t)(BK * 2);
  const size_t hstep = (size_t)HALF * K * 2;
  const size_t tstep = 2 * hstep;
  const unsigned ldsw = (unsigned)wid * 1024u;
  const int aoff = lds_byte(wr * 64 + fr, fq * 8), boff = lds_byte(wc * 32 + fr, fq * 8);
#define PG8_SA(b, h) (((b) * 2 + (h)) * HTB)
#define PG8_SB(b, h) ((4 + (b) * 2 + (h)) * HTB)
#define PG8_STAGE(bufoff, gbase, voff) do { _Pragma("unroll") for (int _i = 0; _i < 2; ++_i) \
    __builtin_amdgcn_global_load_lds((const unsigned*)((const char*)(gbase) + (voff)[_i]), (PG8_LAS unsigned*)(lds + (bufoff) + ldsw + _i * 8192), 16, 0, 0); } while (0)
#define PG8_LDA(dst, b, h) do { _Pragma("unroll") for (int m = 0; m < 4; ++m) _Pragma("unroll") for (int k = 0; k < 2; ++k) dst[m][k] = *(const PG8_LAS bf16x8*)(lds + PG8_SA(b, h) + aoff + m * 2048 + k * 1024); } while (0)
#define PG8_LDB(dst, b, h) do { _Pragma("unroll") for (int n = 0; n < 2; ++n) _Pragma("unroll") for (int k = 0; k < 2; ++k) dst[n][k] = *(const PG8_LAS bf16x8*)(lds + PG8_SB(b, h) + boff + n * 2048 + k * 1024); } while (0)
#define PG8_MMA(ai, bj, At, Bt) do { __builtin_amdgcn_s_setprio(1); _Pragma("unroll") for (int m = 0; m < 4; ++m) _Pragma("unroll") for (int n = 0; n < 2; ++n) _Pragma("unroll") for (int k = 0; k < 2; ++k) \
    acc[ai][bj][m][n] = __builtin_amdgcn_mfma_f32_16x16x32_bf16(Bt[n][k], At[m][k], acc[ai][bj][m][n], 0, 0, 0); __builtin_amdgcn_s_setprio(0); } while (0)
#define PG8_WAIT_V(n) asm volatile("s_waitcnt vmcnt(" #n ")" ::: "memory")
#define PG8_WAIT_L(n) asm volatile("s_waitcnt lgkmcnt(" #n ")" ::: "memory")
#define PG8_BAR __builtin_amdgcn_s_barrier()
#define PG8_SCHED __builtin_amdgcn_sched_barrier(0)
  Unit cur, nxt; int ui = 0;
  if (!S.next(0, cur)) return;
  f32x4 acc[2][2][4][2];
#pragma unroll
  for (int a = 0; a < 2; ++a)
#pragma unroll
    for (int b = 0; b < 2; ++b)
#pragma unroll
      for (int m = 0; m < 4; ++m)
#pragma unroll
        for (int n = 0; n < 2; ++n) acc[a][b][m][n] = (f32x4){0.f, 0.f, 0.f, 0.f};
  bf16x8 At[4][2], B0[2][2], B1[2][2];
  const char* cA = (const char*)g.A + (size_t)cur.pm * tstep; const char* cB = (const char*)g.Bt + (size_t)cur.pn * tstep;
  PG8_STAGE(PG8_SB(0, 0), cB, voffB); PG8_STAGE(PG8_SA(0, 0), cA, voffA); PG8_STAGE(PG8_SB(0, 1), cB + hstep, voffB); PG8_STAGE(PG8_SA(0, 1), cA + hstep, voffA);
  if (wr == 1) PG8_BAR;
  PG8_WAIT_V(4); PG8_BAR;
  PG8_STAGE(PG8_SB(1, 0), cB + kstep, voffB); PG8_STAGE(PG8_SA(1, 0), cA + kstep, voffA); PG8_STAGE(PG8_SB(1, 1), cB + hstep + kstep, voffB);
  PG8_WAIT_V(6); PG8_BAR;
  for (;;) {
    const bool has_next = S.next(ui + 1, nxt);
    const char* nA = has_next ? (const char*)g.A + (size_t)nxt.pm * tstep : cA; const char* nB = has_next ? (const char*)g.Bt + (size_t)nxt.pn * tstep : cB;
    for (int t = 0; t < nt; t += 2) {
      const bool last = (t == nt - 2);
      const char* a1 = cA + (size_t)(t + 1) * kstep;
      const char* a2 = last ? nA : cA + (size_t)(t + 2) * kstep; const char* b2 = last ? nB : cB + (size_t)(t + 2) * kstep;
      const char* a3 = a2 + kstep; const char* b3 = b2 + kstep;
      PG8_LDB(B0, 0, 0); PG8_SCHED; PG8_LDA(At, 0, 0); PG8_STAGE(PG8_SA(1, 1), a1 + hstep, voffA);
      PG8_WAIT_L(8); PG8_BAR; PG8_WAIT_L(0); PG8_MMA(0, 0, At, B0); PG8_BAR; PG8_SCHED;
      PG8_LDB(B1, 0, 1); PG8_STAGE(PG8_SB(0, 0), b2, voffB);
      PG8_BAR; PG8_WAIT_L(0); PG8_MMA(0, 1, At, B1); PG8_BAR;
      PG8_LDA(At, 0, 1); PG8_STAGE(PG8_SA(0, 0), a2, voffA);
      PG8_BAR; PG8_WAIT_L(0); PG8_MMA(1, 0, At, B0); PG8_BAR; PG8_SCHED;
      PG8_STAGE(PG8_SB(0, 1), b2 + hstep, voffB);
      PG8_WAIT_V(6); PG8_BAR; PG8_MMA(1, 1, At, B1); PG8_BAR;
      PG8_LDB(B0, 1, 0); PG8_SCHED; PG8_LDA(At, 1, 0); PG8_STAGE(PG8_SA(0, 1), a2 + hstep, voffA);
      PG8_WAIT_L(8); PG8_BAR; PG8_WAIT_L(0); PG8_MMA(0, 0, At, B0); PG8_BAR; PG8_SCHED;
      PG8_LDB(B1, 1, 1); PG8_STAGE(PG8_SB(1, 0), b3, voffB);
      PG8_BAR; PG8_WAIT_L(0); PG8_MMA(0, 1, At, B1); PG8_BAR;
      PG8_LDA(At, 1, 1); PG8_STAGE(PG8_SA(1, 0), a3, voffA);
      PG8_BAR; PG8_WAIT_L(0); PG8_MMA(1, 0, At, B0); PG8_BAR; PG8_SCHED;
      PG8_STAGE(PG8_SB(1, 1), b3 + hstep, voffB);
      PG8_WAIT_V(6); PG8_BAR; PG8_MMA(1, 1, At, B1); PG8_BAR;
    }
    E(acc, cur, wr, wc, fr, fq);
    if (PROBE == 10) { asm volatile("" ::: "memory"); E(acc, cur, wr, wc, fr, fq); }
    if (!has_next) break;
#pragma unroll
    for (int a = 0; a < 2; ++a)
#pragma unroll
      for (int b = 0; b < 2; ++b)
#pragma unroll
        for (int m = 0; m < 4; ++m)
#pragma unroll
          for (int n = 0; n < 2; ++n) acc[a][b][m][n] = (f32x4){0.f, 0.f, 0.f, 0.f};
    cur = nxt; cA = nA; cB = nB; ++ui;
  }
  PG8_WAIT_V(0);
  if (wr == 0) PG8_BAR;
  PG8_BAR;
#undef PG8_SA
#undef PG8_SB
#undef PG8_STAGE
#undef PG8_LDA
#undef PG8_LDB
#undef PG8_MMA
#undef PG8_WAIT_V
#undef PG8_WAIT_L
#undef PG8_BAR
#undef PG8_SCHED
}
}

template <int ACT>
DI void gemm_run(const bf16_t* A, const bf16_t* Bt, int N, int K, bf16_t* C, int ldc, char* smem) {
  pg8::Gemm g; g.A = A; g.Bt = Bt; g.M = T_TOK; g.N = N; g.K = K;
  pg8::StaticOrder S; S.init(T_TOK, N, (int)gridDim.x, (int)blockIdx.x);
  pg8::EpiB<ACT> E; E.O = C; E.ldc = ldc;
#ifndef STAGGER_TICKS
#define STAGGER_TICKS 0
#endif
  if (K <= 1024 && STAGGER_TICKS > 0) {
    const unsigned long long t0 = __builtin_amdgcn_s_memrealtime();
    const unsigned long long d = (unsigned long long)(((blockIdx.x >> 3) & 3) * STAGGER_TICKS);
    while (__builtin_amdgcn_s_memrealtime() - t0 < d) __builtin_amdgcn_s_sleep(8);
  }
  pg8::gemm_phase(( PG8_LAS unsigned char*)smem, g, S, E);
  __syncthreads();
}

DI void gla_gates(const Params& P, const bf16_t* proj, int b, int h, int n, float* sb, float* sseg, float* tmp) {
  const int tid = TIDX & 255;
  float* sw = tmp;
  float* sg = tmp + 1024;
  {
    for (int e = tid; e < 1024; e += 256) sw[e] = P.gla_w_gate[(e >> 6) * 256 + h * 64 + (e & 63)];
    const int i = tid >> 2, part = tid & 3;
    const size_t t = (size_t)b * SEQ + n * 64 + i;
    const u32x2 gu = *(const u32x2*)(proj + t * PW + C_GLR + part * 4);
    sg[i * 17 + part * 4 + 0] = bflo(gu[0]); sg[i * 17 + part * 4 + 1] = bfhi(gu[0]);
    sg[i * 17 + part * 4 + 2] = bflo(gu[1]); sg[i * 17 + part * 4 + 3] = bfhi(gu[1]);
  }
  __syncthreads();
  {
    const int i = tid & 63, dq = tid >> 6;
    float z[16];
#pragma unroll
    for (int dd = 0; dd < 16; ++dd) z[dd] = P.gla_b_gate[h * 64 + dq * 16 + dd];
#pragma unroll 1
    for (int r = 0; r < 16; ++r) {
      const float gv = sg[i * 17 + r];
#pragma unroll
      for (int dd = 0; dd < 16; ++dd) z[dd] += gv * sw[r * 64 + dq * 16 + dd];
    }
#pragma unroll
    for (int dd = 0; dd < 16; ++dd) {
      const float zz = z[dd];
      const float ls = fminf(zz, 0.f) - __logf(1.f + __expf(-fabsf(zz)));
      sb[i * 65 + dq * 16 + dd] = ls * (1.f / 16.f);
    }
  }
  __syncthreads();
  const int d = tid & 63, seg = tid >> 6;
  float pre[16]; float run = 0.f;
#pragma unroll
  for (int ii = 0; ii < 16; ++ii) { run += sb[(seg * 16 + ii) * 65 + d]; pre[ii] = run; }
  sseg[seg * 64 + d] = run;
  __syncthreads();
  float off = 0.f;
#pragma unroll
  for (int s = 0; s < 4; ++s) off += (s < seg) ? sseg[s * 64 + d] : 0.f;
#pragma unroll
  for (int ii = 0; ii < 16; ++ii) sb[(seg * 16 + ii) * 65 + d] = pre[ii] + off;
  __syncthreads();
}

struct VRegs { u32x4 u[4]; };
DI void gla_load_v(const bf16_t* proj, int b, int h, int n, VRegs& vr) {
  const int tid = TIDX & 255, j = tid & 63, q4 = tid >> 6;
  const size_t t = (size_t)b * SEQ + n * 64 + j;
  const bf16_t* src = proj + t * PW + C_GV + h * 128 + q4 * 32;
#pragma unroll
  for (int c = 0; c < 4; ++c) vr.u[c] = *(const u32x4*)(src + c * 8);
}
DI void gla_store_vT(const VRegs& vr, bf16_t* vT) {
  const int tid = TIDX & 255, j = tid & 63, q4 = tid >> 6;
#pragma unroll
  for (int c = 0; c < 4; ++c) {
#pragma unroll
    for (int e = 0; e < 4; ++e) {
      vT[(q4 * 32 + c * 8 + 2 * e) * 72 + j] = (bf16_t)(vr.u[c][e] & 0xffffu);
      vT[(q4 * 32 + c * 8 + 2 * e + 1) * 72 + j] = (bf16_t)(vr.u[c][e] >> 16);
    }
  }
}

DI void gla_p1_item(const Params& P, int item, char* smem) {
  const bf16_t* proj = (const bf16_t*)(P.ws + R1);
  bf16_t* states = (bf16_t*)(P.ws + R2);
  float* decay = (float*)(P.ws + R_DECAY);
  float* sb = (float*)smem; float* sseg = sb + 64 * 65;
  bf16_t* kendT = (bf16_t*)(sseg + 256); bf16_t* vT = kendT + 64 * 72;
  const int n = item & 127, h = (item >> 7) & 3, b = item >> 9;
  const int tid = TIDX & 255, lane = tid & 63, wave = tid >> 6, l32 = lane & 31, kb = lane >> 5;
  VRegs vr; gla_load_v(proj, b, h, n, vr);
  u32x4 k0, k1;
  {
    const int j = tid & 63, dq = tid >> 6;
    const size_t t = (size_t)b * SEQ + n * 64 + j;
    k0 = *(const u32x4*)(proj + t * PW + C_GK + h * 64 + dq * 16); k1 = *(const u32x4*)(proj + t * PW + C_GK + h * 64 + dq * 16 + 8);
  }
  gla_gates(P, proj, b, h, n, sb, sseg, (float*)vT);
  {
    const int j = tid & 63, dq = tid >> 6;
    float kv[16];
#pragma unroll
    for (int e = 0; e < 4; ++e) { kv[2 * e] = bflo(k0[e]); kv[2 * e + 1] = bfhi(k0[e]); kv[8 + 2 * e] = bflo(k1[e]); kv[8 + 2 * e + 1] = bfhi(k1[e]); }
#pragma unroll
    for (int dd = 0; dd < 16; ++dd) {
      const int d = dq * 16 + dd;
      kendT[d * 72 + j] = f2bf(kv[dd] * __expf(sb[63 * 65 + d] - sb[j * 65 + d]));
    }
    if (tid < 64) decay[((size_t)(b * 4 + h) * 128 + n) * 64 + tid] = __expf(sb[63 * 65 + tid]);
  }
  gla_store_vT(vr, vT);
  __syncthreads();
#pragma unroll
  for (int dt = 0; dt < 2; ++dt) {
    f32x16 acc = zero16();
#pragma unroll
    for (int s = 0; s < 4; ++s) {
      const bf16x8 a = *(const bf16x8*)(vT + (wave * 32 + l32) * 72 + s * 16 + kb * 8);
      const bf16x8 bb = *(const bf16x8*)(kendT + (dt * 32 + l32) * 72 + s * 16 + kb * 8);
      acc = mfma(a, bb, acc);
    }
    bf16_t* dst = states + ((size_t)((b * 4 + h) * 128 + n) * 128) * 64;
#pragma unroll
    for (int r = 0; r < 16; ++r) dst[(size_t)(wave * 32 + crow(r, kb)) * 64 + dt * 32 + l32] = f2bf(acc[r]);
  }
  __syncthreads();
}

DI void gla_scan(const Params& P) {
  bf16_t* states = (bf16_t*)(P.ws + R2);
  const float* decay = (const float*)(P.ws + R_DECAY);
  const int total = 32 * 4096;
  for (int e = blockIdx.x * blockDim.x + TIDX; e < total; e += gridDim.x * blockDim.x) {
    const int bh = e >> 12, idx = (e & 4095) * 2, d = idx & 63;
    bf16_t* p = states + (size_t)bh * 128 * 8192 + idx;
    const float* dc = decay + (size_t)bh * 128 * 64 + d;
    float S0 = 0.f, S1 = 0.f;
#pragma unroll 8
    for (int n = 0; n < 128; ++n) {
      const unsigned ds = *(const unsigned*)(p + (size_t)n * 8192);
      const float2 dec = *(const float2*)(dc + n * 64);
      *(unsigned*)(p + (size_t)n * 8192) = pk2(S0, S1);
      S0 = dec.x * S0 + bflo(ds); S1 = dec.y * S1 + bfhi(ds);
    }
  }
}

DI void gla_p3_item(const Params& P, int item, char* smem) {
  const bf16_t* proj = (const bf16_t*)(P.ws + R1);
  const bf16_t* states = (const bf16_t*)(P.ws + R2);
  bf16_t* mix = (bf16_t*)(P.ws + R3);
  float* sb = (float*)smem; float* sseg = sb + 64 * 65; float* sred = sseg + 256;
  bf16_t* sq = (bf16_t*)(sred + 256); bf16_t* sk = sq + 64 * 72; bf16_t* vT = sk + 64 * 72;
  const int n = item & 127, h = (item >> 7) & 3, b = item >> 9;
  const int tid = TIDX & 255, lane = tid & 63, wave = tid >> 6, l32 = lane & 31, kb = lane >> 5;
  VRegs vr; gla_load_v(proj, b, h, n, vr);
  u32x4 q0, q1, k0, k1;
  bf16x8 sf[4];
  {
    const int i = tid & 63, dq = tid >> 6;
    const size_t t = (size_t)b * SEQ + n * 64 + i;
    q0 = *(const u32x4*)(proj + t * PW + C_GQ + h * 64 + dq * 16); q1 = *(const u32x4*)(proj + t * PW + C_GQ + h * 64 + dq * 16 + 8);
    k0 = *(const u32x4*)(proj + t * PW + C_GK + h * 64 + dq * 16); k1 = *(const u32x4*)(proj + t * PW + C_GK + h * 64 + dq * 16 + 8);
    const bf16_t* sp = states + ((size_t)((b * 4 + h) * 128 + n) * 128 + wave * 32 + l32) * 64;
#pragma unroll
    for (int s4 = 0; s4 < 4; ++s4) sf[s4] = *(const bf16x8*)(sp + s4 * 16 + kb * 8);
  }
  gla_gates(P, proj, b, h, n, sb, sseg, (float*)vT);
  {
    const int i = tid & 63, dq = tid >> 6;
    float qv[16], kv[16];
#pragma unroll
    for (int e = 0; e < 4; ++e) {
      qv[2 * e] = bflo(q0[e]); qv[2 * e + 1] = bfhi(q0[e]); qv[8 + 2 * e] = bflo(q1[e]); qv[8 + 2 * e + 1] = bfhi(q1[e]);
      kv[2 * e] = bflo(k0[e]); kv[2 * e + 1] = bfhi(k0[e]); kv[8 + 2 * e] = bflo(k1[e]); kv[8 + 2 * e + 1] = bfhi(k1[e]);
    }
#pragma unroll
    for (int dd = 0; dd < 16; ++dd) {
      const int d = dq * 16 + dd;
      const float bb = sb[i * 65 + d];
      sq[i * 72 + d] = f2bf(qv[dd] * 0.125f * __expf(bb));
      sk[i * 72 + d] = f2bf(kv[dd] * __expf(-bb));
    }
  }
  gla_store_vT(vr, vT);
  __syncthreads();
  f32x16 x00 = zero16(), x01 = zero16(), x11 = zero16();
#pragma unroll
  for (int s = 0; s < 4; ++s) {
    const bf16x8 kj0 = *(const bf16x8*)(sk + (l32)*72 + s * 16 + kb * 8);
    const bf16x8 kj1 = *(const bf16x8*)(sk + (32 + l32) * 72 + s * 16 + kb * 8);
    const bf16x8 qi0 = *(const bf16x8*)(sq + (l32)*72 + s * 16 + kb * 8);
    const bf16x8 qi1 = *(const bf16x8*)(sq + (32 + l32) * 72 + s * 16 + kb * 8);
    x00 = mfma(kj0, qi0, x00); x01 = mfma(kj0, qi1, x01); x11 = mfma(kj1, qi1, x11);
  }
#pragma unroll
  for (int r = 0; r < 16; ++r) { const bool keep = crow(r, kb) <= l32; x00[r] = keep ? x00[r] : 0.f; x11[r] = keep ? x11[r] : 0.f; }
  f32x16 o0 = zero16(), o1 = zero16();
  const int dvr = wave * 32 + l32;
#pragma unroll
  for (int s = 0; s < 2; ++s) {
    const bf16x8 p00 = pack8(x00[8 * s], x00[8 * s + 1], x00[8 * s + 2], x00[8 * s + 3], x00[8 * s + 4], x00[8 * s + 5], x00[8 * s + 6], x00[8 * s + 7]);
    const bf16x8 p01 = pack8(x01[8 * s], x01[8 * s + 1], x01[8 * s + 2], x01[8 * s + 3], x01[8 * s + 4], x01[8 * s + 5], x01[8 * s + 6], x01[8 * s + 7]);
    const bf16x8 p11 = pack8(x11[8 * s], x11[8 * s + 1], x11[8 * s + 2], x11[8 * s + 3], x11[8 * s + 4], x11[8 * s + 5], x11[8 * s + 6], x11[8 * s + 7]);
    const bf16x8 v0 = ld2x4(vT + dvr * 72 + 16 * s + 4 * kb);
    const bf16x8 v1 = ld2x4(vT + dvr * 72 + 32 + 16 * s + 4 * kb);
    o0 = mfma(v0, p00, o0); o1 = mfma(v0, p01, o1); o1 = mfma(v1, p11, o1);
  }
  {
#pragma unroll
    for (int s = 0; s < 4; ++s) {
      const bf16x8 a = sf[s];
      const bf16x8 qi0 = *(const bf16x8*)(sq + (l32)*72 + s * 16 + kb * 8);
      const bf16x8 qi1 = *(const bf16x8*)(sq + (32 + l32) * 72 + s * 16 + kb * 8);
      o0 = mfma(a, qi0, o0); o1 = mfma(a, qi1, o1);
    }
  }
  float s0 = 0.f, s1 = 0.f;
#pragma unroll
  for (int r = 0; r < 16; ++r) { s0 += o0[r] * o0[r]; s1 += o1[r] * o1[r]; }
  s0 += __shfl_xor(s0, 32); s1 += __shfl_xor(s1, 32);
  if (kb == 0) { sred[wave * 64 + l32] = s0; sred[wave * 64 + 32 + l32] = s1; }
  __syncthreads();
  const float t0s = sred[l32] + sred[64 + l32] + sred[128 + l32] + sred[192 + l32];
  const float t1s = sred[32 + l32] + sred[64 + 32 + l32] + sred[128 + 32 + l32] + sred[192 + 32 + l32];
  const float r0 = rsqrtf(t0s * (1.f / 128.f) + EPS), r1 = rsqrtf(t1s * (1.f / 128.f) + EPS);
#pragma unroll
  for (int it = 0; it < 2; ++it) {
    const size_t t = (size_t)b * SEQ + n * 64 + it * 32 + l32;
    const float rr = it ? r1 : r0;
#pragma unroll
    for (int gq = 0; gq < 4; ++gq) {
      const int dv = wave * 32 + 8 * gq + 4 * kb;
      const u32x2 ru = *(const u32x2*)(proj + t * PW + C_GR + h * 128 + dv);
      const float4 gn = *(const float4*)(P.gla_norm + h * 128 + dv);
      float rv[4] = {bflo(ru[0]), bfhi(ru[0]), bflo(ru[1]), bfhi(ru[1])};
      float gv[4] = {gn.x, gn.y, gn.z, gn.w};
      float ov[4];
#pragma unroll
      for (int e = 0; e < 4; ++e) {
        const float a = it ? o1[gq * 4 + e] : o0[gq * 4 + e];
        ov[e] = a * rr * gv[e] * (rv[e] / (1.f + __expf(-rv[e])));
      }
      u32x2 o; o[0] = pk2(ov[0], ov[1]); o[1] = pk2(ov[2], ov[3]);
      *(u32x2*)(mix + t * DM + h * 128 + dv) = o;
    }
  }
  __syncthreads();
}

DI void nsa_compress_task(const Params& P, int task) {
  const bf16_t* proj = (const bf16_t*)(P.ws + R1);
  const int lane = TIDX & 63, l32 = lane & 31, kb = lane >> 5;
  const int ct = task & 15, g = (task >> 4) & 1, b = (task >> 5) & 7, br = task >> 8;
  const bf16_t* w1T = (const bf16_t*)(P.ws + W_CW1) + (size_t)br * 128 * 2048;
  const bf16_t* w2T = (const bf16_t*)(P.ws + W_CW2) + (size_t)br * 64 * 128;
  const float* bias1 = (const float*)(P.ws + W_BIAS1) + br * 128;
  const int c = ct * 32 + l32;
  const int cc = c < 511 ? c : 510;
  const bf16_t* src = proj + ((size_t)b * SEQ + cc * 16) * PW + (br ? C_VC : C_KC) + g * 64 + kb * 8;
  f32x16 acc[4];
#pragma unroll
  for (int i = 0; i < 4; ++i) acc[i] = zero16();
#pragma unroll 1
  for (int ks = 0; ks < 128; ++ks) {
    const int l = ks >> 2, dh0 = (ks & 3) * 16;
    const bf16x8 bf = *(const bf16x8*)(src + (size_t)l * PW + dh0);
#pragma unroll
    for (int ht = 0; ht < 4; ++ht) {
      const bf16x8 af = *(const bf16x8*)(w1T + (size_t)(ht * 32 + l32) * 2048 + ks * 16 + kb * 8);
      acc[ht] = mfma(af, bf, acc[ht]);
    }
  }
#pragma unroll
  for (int ht = 0; ht < 4; ++ht)
#pragma unroll
    for (int r = 0; r < 16; ++r) acc[ht][r] = gelu_tanh(acc[ht][r] + bias1[ht * 32 + crow(r, kb)]);
  f32x16 o[2]; o[0] = zero16(); o[1] = zero16();
#pragma unroll
  for (int ht = 0; ht < 4; ++ht)
#pragma unroll
    for (int s = 0; s < 2; ++s) {
      const bf16x8 hf = pack8(acc[ht][8 * s], acc[ht][8 * s + 1], acc[ht][8 * s + 2], acc[ht][8 * s + 3], acc[ht][8 * s + 4], acc[ht][8 * s + 5], acc[ht][8 * s + 6], acc[ht][8 * s + 7]);
#pragma unroll
      for (int dt = 0; dt < 2; ++dt) {
        const bf16x8 wf = ld2x4(w2T + (size_t)(dt * 32 + l32) * 128 + ht * 32 + 16 * s + 4 * kb);
        o[dt] = mfma(wf, hf, o[dt]);
      }
    }
  if (c < 511) {
    {
      bf16_t* dst = (bf16_t*)(P.ws + (br ? R_VCMPT : R_KCMP)) + ((size_t)(b * 2 + g) * 512 + c) * 64;
#pragma unroll
      for (int dt = 0; dt < 2; ++dt)
#pragma unroll
        for (int gq = 0; gq < 4; ++gq) {
          u32x2 u; u[0] = pk2(o[dt][gq * 4], o[dt][gq * 4 + 1]); u[1] = pk2(o[dt][gq * 4 + 2], o[dt][gq * 4 + 3]);
          *(u32x2*)(dst + dt * 32 + 8 * gq + 4 * kb) = u;
        }
    }
  }
}

DI void nsa_transpose_v(const Params& P) {
  const bf16_t* proj = (const bf16_t*)(P.ws + R1);
  const int total = 2 * 8 * 2 * 1024 * 64;
  for (int u = blockIdx.x * blockDim.x + TIDX; u < total; u += gridDim.x * blockDim.x) {
    const int dh = u & 63; int rest = u >> 6; const int t8 = rest & 1023; rest >>= 10;
    const int g = rest & 1, b = (rest >> 1) & 7, which = rest >> 4;
    const bf16_t* src = proj + ((size_t)b * SEQ + t8 * 8) * PW + (which ? C_VW : C_VS) + g * 64 + dh;
    bf16_t v[8];
#pragma unroll
    for (int j = 0; j < 8; ++j) v[j] = src[(size_t)j * PW];
    u32x4 o;
#pragma unroll
    for (int j = 0; j < 4; ++j) o[j] = (unsigned)v[2 * j] | ((unsigned)v[2 * j + 1] << 16);
    bf16_t* dst = (bf16_t*)(P.ws + (which ? R_VWT : R_VST)) + ((size_t)(b * 2 + g) * 64 + dh) * SEQ + t8 * 8;
    *(u32x4*)dst = o;
  }
}

DI f32x16 qk_tile(const bf16_t* krow, const bf16x8 (&qf)[4]) {
  f32x16 s = zero16();
#pragma unroll
  for (int i = 0; i < 4; ++i) { const bf16x8 kf = *(const bf16x8*)(krow + i * 16); s = mfma(kf, qf[i], s); }
  return s;
}

DI float half_max(float x) {
  const auto r = __builtin_amdgcn_permlane32_swap(__float_as_uint(x), __float_as_uint(x), false, false);
  return fmaxf(__uint_as_float(r[0]), __uint_as_float(r[1]));
}
DI float half_sum(float x) {
  const auto r = __builtin_amdgcn_permlane32_swap(__float_as_uint(x), __float_as_uint(x), false, false);
  return __uint_as_float(r[0]) + __uint_as_float(r[1]);
}
DI s16x4 lds_tr(const char* p) { return __builtin_amdgcn_ds_read_tr16_b64_v4i16((__attribute__((address_space(3))) s16x4*)p); }

template <bool EDGE>
DI void softmax_tile(f32x16& s, int k0, int tq, int lo, bool bit, int kb, f32x16& o0, f32x16& o1, float& m, float& l) {
  constexpr float CS = 0.125f * 1.4426950408889634f;
  float tmax = -1e30f;
  if (EDGE) {
#pragma unroll
    for (int r = 0; r < 16; ++r) {
      const int key = k0 + crow(r, kb);
      const bool vd = (key <= tq) && (key > lo);
      s[r] = vd ? s[r] * CS : -1e30f;
      tmax = fmaxf(tmax, s[r]);
    }
  } else {
#pragma unroll
    for (int r = 0; r < 16; ++r) tmax = fmaxf(tmax, s[r]);
    tmax *= CS;
  }
  tmax = bit ? tmax : -1e30f;
  tmax = half_max(tmax);
  if (__ballot(tmax > m + 8.0f) != 0ull) {
    const float mn = fmaxf(m, tmax);
    const float alpha = __builtin_amdgcn_exp2f(m - mn);
    l *= alpha; m = mn;
#pragma unroll
    for (int r = 0; r < 16; ++r) { o0[r] *= alpha; o1[r] *= alpha; }
  }
  float ps = 0.f;
  if (EDGE) {
    const bool live = bit && (m > -5e29f);
#pragma unroll
    for (int r = 0; r < 16; ++r) {
      const float e = __builtin_amdgcn_exp2f(s[r] - m);
      s[r] = live ? e : 0.f;
      ps += s[r];
    }
  } else {
    const float me = bit ? m : 1e30f;
#pragma unroll
    for (int r = 0; r < 16; ++r) {
      s[r] = __builtin_amdgcn_exp2f(__builtin_fmaf(s[r], CS, -me));
      ps += s[r];
    }
  }
  l += ps;
}

struct HeadAcc { f32x16 o0, o1; float m, l; };

template <bool EDGE>
DI void attn_step2(const bf16_t* sKt, const char* sVt, const bf16x8 (&qa)[4], const bf16x8 (&qb)[4], int k0, int tq, int lo, bool bit,
                   int lane, HeadAcc& A, HeadAcc& B) {
  const int l32 = lane & 31, kb = lane >> 5, i16 = lane & 15, q = i16 >> 2, p = i16 & 3, gc = (lane >> 4) & 1;
  f32x16 sa = zero16(), sb = zero16();
#pragma unroll
  for (int i = 0; i < 4; ++i) {
    const bf16x8 kf = *(const bf16x8*)(sKt + l32 * 72 + i * 16 + kb * 8);
    sa = mfma(kf, qa[i], sa); sb = mfma(kf, qb[i], sb);
  }
  bf16x8 vf[2][2];
#pragma unroll
  for (int dt = 0; dt < 2; ++dt)
#pragma unroll
    for (int sI = 0; sI < 2; ++sI) {
      const char* vp = sVt + (16 * sI + 4 * kb + q) * 144 + (dt * 32 + gc * 16 + 4 * p) * 2;
      const s16x4 lo4 = lds_tr(vp), hi4 = lds_tr(vp + 8 * 144);
      vf[dt][sI] = __builtin_shufflevector(lo4, hi4, 0, 1, 2, 3, 4, 5, 6, 7);
    }
  softmax_tile<EDGE>(sa, k0, tq, lo, bit, kb, A.o0, A.o1, A.m, A.l);
  softmax_tile<EDGE>(sb, k0, tq, lo, bit, kb, B.o0, B.o1, B.m, B.l);
#pragma unroll
  for (int sI = 0; sI < 2; ++sI) {
    const bf16x8 pa = pack8(sa[8 * sI], sa[8 * sI + 1], sa[8 * sI + 2], sa[8 * sI + 3], sa[8 * sI + 4], sa[8 * sI + 5], sa[8 * sI + 6], sa[8 * sI + 7]);
    const bf16x8 pb = pack8(sb[8 * sI], sb[8 * sI + 1], sb[8 * sI + 2], sb[8 * sI + 3], sb[8 * sI + 4], sb[8 * sI + 5], sb[8 * sI + 6], sb[8 * sI + 7]);
    A.o0 = mfma(vf[0][sI], pa, A.o0); A.o1 = mfma(vf[1][sI], pa, A.o1);
    B.o0 = mfma(vf[0][sI], pb, B.o0); B.o1 = mfma(vf[1][sI], pb, B.o1);
  }
}

template <bool WIN>
DI void nsa_branch2(const bf16_t* kbase, const bf16_t* vbase, char* smem, int st0, int st1, int qt, int tq, const bf16x8 (&qa)[4],
                    const bf16x8 (&qb)[4], unsigned mk0, unsigned mk1, unsigned mk2, unsigned mk3, HeadAcc& A, HeadAcc& B) {
  const int tid = TIDX, lane = tid & 63;
  const int srow = tid >> 3, schunk = (tid & 7) * 8;
  const bf16_t* kg = kbase + (size_t)srow * PW + schunk;
  const bf16_t* vg = vbase + (size_t)srow * PW + schunk;
  const int soff = (srow * 72 + schunk) * 2;
  u32x4 rk = *(const u32x4*)(kg + (size_t)st0 * 64 * PW), rv = *(const u32x4*)(vg + (size_t)st0 * 64 * PW);
  *(u32x4*)(smem + soff) = rk; *(u32x4*)(smem + 9216 + soff) = rv;
  __syncthreads();
  for (int st = st0; st <= st1; ++st) {
    const int cur = (st - st0) & 1;
    if (st < st1) { rk = *(const u32x4*)(kg + (size_t)(st + 1) * 64 * PW); rv = *(const u32x4*)(vg + (size_t)(st + 1) * 64 * PW); }
    const bf16_t* bK = (const bf16_t*)(smem + cur * 18432);
    const char* bV = smem + cur * 18432 + 9216;
    bool bit = true;
    if (!WIN) { const unsigned mw = st < 32 ? mk0 : (st < 64 ? mk1 : (st < 96 ? mk2 : mk3)); bit = (mw >> (st & 31)) & 1u; }
    const bool any = WIN ? true : (__ballot(bit) != 0ull);
#pragma unroll
    for (int tt = 0; tt < 2; ++tt) {
      const int kt = 2 * st + tt;
      const bool in_range = WIN ? (kt <= qt && kt >= qt - 16) : (kt <= qt);
      if (in_range && any) {
        const bool edge = WIN ? (kt == qt || kt == qt - 16) : (kt == qt);
        if (edge) attn_step2<true>(bK + tt * 32 * 72, bV + tt * 32 * 144, qa, qb, kt * 32, tq, WIN ? tq - 512 : -1, bit, lane, A, B);
        else attn_step2<false>(bK + tt * 32 * 72, bV + tt * 32 * 144, qa, qb, kt * 32, tq, WIN ? tq - 512 : -1, bit, lane, A, B);
      }
    }
    if (st < st1) { *(u32x4*)(smem + (cur ^ 1) * 18432 + soff) = rk; *(u32x4*)(smem + (cur ^ 1) * 18432 + 9216 + soff) = rv; }
    __syncthreads();
  }
}

DI void fold_partial(bf16_t* dst, float f, const f32x16& a0, const f32x16& a1, int kb) {
#pragma unroll
  for (int gq = 0; gq < 4; ++gq) {
    bf16_t* d0 = dst + 8 * gq + 4 * kb;
    bf16_t* d1 = d0 + 32;
    const u32x2 p0 = *(const u32x2*)d0, p1 = *(const u32x2*)d1;
    u32x2 u0, u1;
    u0[0] = pk2(bflo(p0[0]) + f * a0[gq * 4], bfhi(p0[0]) + f * a0[gq * 4 + 1]);
    u0[1] = pk2(bflo(p0[1]) + f * a0[gq * 4 + 2], bfhi(p0[1]) + f * a0[gq * 4 + 3]);
    u1[0] = pk2(bflo(p1[0]) + f * a1[gq * 4], bfhi(p1[0]) + f * a1[gq * 4 + 1]);
    u1[1] = pk2(bflo(p1[1]) + f * a1[gq * 4 + 2], bfhi(p1[1]) + f * a1[gq * 4 + 3]);
    *(u32x2*)d0 = u0; *(u32x2*)d1 = u1;
  }
}

DI void nsa_block(const Params& P, int b, int g, int qb, char* smem) {
  const int wv = __builtin_amdgcn_readfirstlane(TIDX >> 6);
  const int qt = qb * 8 + wv;
  float* imp = (float*)smem + wv * 4096;
  const bf16_t* proj = (const bf16_t*)(P.ws + R1);
  bf16_t* mix = (bf16_t*)(P.ws + R3);
  const int lane = TIDX & 63, l32 = lane & 31, kb = lane >> 5;
  const int t0 = qt * 32, tq = t0 + l32;
  const size_t tokq = (size_t)b * SEQ + tq;
  const bf16_t* qrow = proj + tokq * PW;
  const bf16_t* kcmp = (const bf16_t*)(P.ws + R_KCMP) + (size_t)(b * 2 + g) * 512 * 64;
  const bf16_t* vcmp = (const bf16_t*)(P.ws + R_VCMPT) + (size_t)(b * 2 + g) * 512 * 64;
  const int nct = (qb >> 1) + 1;
  const int nst = (nct + 1) >> 1;
  for (int i = lane; i < 4096; i += 64) imp[i] = 0.f;
  {
    constexpr float CS = 0.125f * 1.4426950408889634f;
    char* stg = smem + LDS_CMP_STAGE;
    const int tid = TIDX;
    const int srow = tid >> 3, schunk = (tid & 7) * 8, soff = (srow * 72 + schunk) * 2;
    const int i16 = lane & 15, q4 = i16 >> 2, p4 = i16 & 3, gc = (lane >> 4) & 1;
#pragma unroll 1
    for (int hp = 0; hp < 2; ++hp) {
      const int head = g * 4 + hp * 2;
      bf16x8 qa[4], qb_[4];
#pragma unroll
      for (int i = 0; i < 4; ++i) {
        qa[i] = *(const bf16x8*)(qrow + C_NQ + head * 64 + i * 16 + kb * 8);
        qb_[i] = *(const bf16x8*)(qrow + C_NQ + (head + 1) * 64 + i * 16 + kb * 8);
      }
      float mA = -1e30f, lA = 0.f, mB = -1e30f, lB = 0.f;
      u32x4 rk = *(const u32x4*)(kcmp + (size_t)srow * 64 + schunk), rv;
      for (int st = 0; st < nst; ++st) {
        *(u32x4*)(stg + soff) = rk;
        __syncthreads();
        if (st + 1 < nst) rk = *(const u32x4*)(kcmp + (size_t)((st + 1) * 64 + srow) * 64 + schunk);
#pragma unroll
        for (int tt = 0; tt < 2; ++tt) {
          const int ct = 2 * st + tt;
          if (ct < nct) {
            const bf16_t* sKt = (const bf16_t*)stg + tt * 32 * 72;
            f32x16 sa = zero16(), sb = zero16();
#pragma unroll
            for (int i = 0; i < 4; ++i) {
              const bf16x8 kf = *(const bf16x8*)(sKt + l32 * 72 + i * 16 + kb * 8);
              sa = mfma(kf, qa[i], sa); sb = mfma(kf, qb_[i], sb);
            }
            float tA = -1e30f, tB = -1e30f;
#pragma unroll
            for (int r = 0; r < 16; ++r) {
              const int c = ct * 32 + crow(r, kb);
              const bool vd = (c * 16 + 31 <= tq);
              sa[r] = vd ? sa[r] * CS : -1e30f; sb[r] = vd ? sb[r] * CS : -1e30f;
              tA = fmaxf(tA, sa[r]); tB = fmaxf(tB, sb[r]);
            }
            const float nA = fmaxf(mA, tA), nB = fmaxf(mB, tB);
            float pA = 0.f, pB = 0.f;
#pragma unroll
            for (int r = 0; r < 16; ++r) {
              pA += (sa[r] > -5e29f) ? __builtin_amdgcn_exp2f(sa[r] - nA) : 0.f;
              pB += (sb[r] > -5e29f) ? __builtin_amdgcn_exp2f(sb[r] - nB) : 0.f;
            }
            lA = lA * __builtin_amdgcn_exp2f(mA - nA) + pA; mA = nA;
            lB = lB * __builtin_amdgcn_exp2f(mB - nB) + pB; mB = nB;
          }
        }
        __syncthreads();
      }
      float MA, iLA, MB, iLB;
      {
        const float mo = __shfl_xor(mA, 32), lo_ = __shfl_xor(lA, 32);
        MA = fmaxf(mA, mo);
        iLA = 1.f / fmaxf(lA * __builtin_amdgcn_exp2f(mA - MA) + lo_ * __builtin_amdgcn_exp2f(mo - MA), 1e-30f);
        const float mo2 = __shfl_xor(mB, 32), lo2 = __shfl_xor(lB, 32);
        MB = fmaxf(mB, mo2);
        iLB = 1.f / fmaxf(lB * __builtin_amdgcn_exp2f(mB - MB) + lo2 * __builtin_amdgcn_exp2f(mo2 - MB), 1e-30f);
      }
      f32x16 oA0 = zero16(), oA1 = zero16(), oB0 = zero16(), oB1 = zero16();
      float carry = 0.f;
      rk = *(const u32x4*)(kcmp + (size_t)srow * 64 + schunk); rv = *(const u32x4*)(vcmp + (size_t)srow * 64 + schunk);
      for (int st = 0; st < nst; ++st) {
        *(u32x4*)(stg + soff) = rk; *(u32x4*)(stg + 9216 + soff) = rv;
        __syncthreads();
        if (st + 1 < nst) {
          rk = *(const u32x4*)(kcmp + (size_t)((st + 1) * 64 + srow) * 64 + schunk);
          rv = *(const u32x4*)(vcmp + (size_t)((st + 1) * 64 + srow) * 64 + schunk);
        }
#pragma unroll
        for (int tt = 0; tt < 2; ++tt) {
          const int ct = 2 * st + tt;
          if (ct < nct) {
            const bf16_t* sKt = (const bf16_t*)stg + tt * 32 * 72;
            const char* sVt = stg + 9216 + tt * 32 * 144;
            f32x16 sa = zero16(), sb = zero16();
#pragma unroll
            for (int i = 0; i < 4; ++i) {
              const bf16x8 kf = *(const bf16x8*)(sKt + l32 * 72 + i * 16 + kb * 8);
              sa = mfma(kf, qa[i], sa); sb = mfma(kf, qb_[i], sb);
            }
            bf16x8 vf[2][2];
#pragma unroll
            for (int dt = 0; dt < 2; ++dt)
#pragma unroll
              for (int sI = 0; sI < 2; ++sI) {
                const char* vp = sVt + (16 * sI + 4 * kb + q4) * 144 + (dt * 32 + gc * 16 + 4 * p4) * 2;
                const s16x4 lo4 = lds_tr(vp), hi4 = lds_tr(vp + 8 * 144);
                vf[dt][sI] = __builtin_shufflevector(lo4, hi4, 0, 1, 2, 3, 4, 5, 6, 7);
              }
            f32x16 ps;
#pragma unroll
            for (int r = 0; r < 16; ++r) {
              const int c = ct * 32 + crow(r, kb);
              const bool vd = (c * 16 + 31 <= tq);
              sa[r] = vd ? __builtin_amdgcn_exp2f(__builtin_fmaf(sa[r], CS, -MA)) * iLA : 0.f;
              sb[r] = vd ? __builtin_amdgcn_exp2f(__builtin_fmaf(sb[r], CS, -MB)) * iLB : 0.f;
              ps[r] = sa[r] + sb[r];
            }
            float y[4];
#pragma unroll
            for (int gi = 0; gi < 4; ++gi) y[gi] = __shfl_xor(ps[4 * gi + 3], 32);
#pragma unroll
            for (int gi = 0; gi < 4; ++gi) {
              const float s4 = (ps[4 * gi] + ps[4 * gi + 1]) + (ps[4 * gi + 2] + ps[4 * gi + 3]);
              const float extra = kb ? y[gi] : (gi == 0 ? carry : y[gi > 0 ? gi - 1 : 0]);
              const int j = ct * 8 + 2 * gi + kb;
              imp[j * 32 + l32] += s4 + extra;
            }
            carry = y[3];
#pragma unroll
            for (int sI = 0; sI < 2; ++sI) {
              const bf16x8 pa = pack8(sa[8 * sI], sa[8 * sI + 1], sa[8 * sI + 2], sa[8 * sI + 3], sa[8 * sI + 4], sa[8 * sI + 5], sa[8 * sI + 6], sa[8 * sI + 7]);
              const bf16x8 pb = pack8(sb[8 * sI], sb[8 * sI + 1], sb[8 * sI + 2], sb[8 * sI + 3], sb[8 * sI + 4], sb[8 * sI + 5], sb[8 * sI + 6], sb[8 * sI + 7]);
              oA0 = mfma(vf[0][sI], pa, oA0); oA1 = mfma(vf[1][sI], pa, oA1);
              oB0 = mfma(vf[0][sI], pb, oB0); oB1 = mfma(vf[1][sI], pb, oB1);
            }
          }
        }
        __syncthreads();
      }
      const float gA = sigmoidf_(bf2f(qrow[C_NG + head * 3 + 0]) + P.nsa_gate_b[head * 3 + 0]);
      const float gB = sigmoidf_(bf2f(qrow[C_NG + (head + 1) * 3 + 0]) + P.nsa_gate_b[(head + 1) * 3 + 0]);
#pragma unroll
      for (int gq = 0; gq < 4; ++gq) {
        u32x2 u0, u1, u2, u3;
        u0[0] = pk2(gA * oA0[gq * 4], gA * oA0[gq * 4 + 1]); u0[1] = pk2(gA * oA0[gq * 4 + 2], gA * oA0[gq * 4 + 3]);
        u1[0] = pk2(gA * oA1[gq * 4], gA * oA1[gq * 4 + 1]); u1[1] = pk2(gA * oA1[gq * 4 + 2], gA * oA1[gq * 4 + 3]);
        u2[0] = pk2(gB * oB0[gq * 4], gB * oB0[gq * 4 + 1]); u2[1] = pk2(gB * oB0[gq * 4 + 2], gB * oB0[gq * 4 + 3]);
        u3[0] = pk2(gB * oB1[gq * 4], gB * oB1[gq * 4 + 1]); u3[1] = pk2(gB * oB1[gq * 4 + 2], gB * oB1[gq * 4 + 3]);
        bf16_t* d = mix + tokq * DM + 512 + head * 64 + 8 * gq + 4 * kb;
        *(u32x2*)d = u0; *(u32x2*)(d + 32) = u1; *(u32x2*)(d + 64) = u2; *(u32x2*)(d + 96) = u3;
      }
    }
  }
  asm volatile("s_waitcnt lgkmcnt(0)" ::: "memory");
  __builtin_amdgcn_wave_barrier();
  unsigned mk0 = 0, mk1 = 0, mk2 = 0, mk3 = 0;
  {
    const int cur = tq >> 6, jb = kb * 64;
    unsigned key[64];
#pragma unroll
    for (int i = 0; i < 64; ++i) {
      const int j = jb + i;
      const float v = imp[j * 32 + l32];
      const bool forced = (j == 0) || (j == cur) || (j == cur - 1);
      key[i] = forced ? 0xffffffffu : (j <= cur ? __float_as_uint(v) + 1u : 0u);
    }
    unsigned T = 0u;
#pragma unroll 1
    for (int bit = 31; bit >= 0; --bit) {
      const unsigned Tc = T | (1u << bit);
      int cnt = 0;
#pragma unroll
      for (int i = 0; i < 64; ++i) cnt += (key[i] >= Tc) ? 1 : 0;
      const auto r = __builtin_amdgcn_permlane32_swap((unsigned)cnt, (unsigned)cnt, false, false);
      cnt = (int)(r[0] + r[1]);
      T = (cnt >= 16) ? Tc : T;
    }
    int cgt = 0, ceq = 0;
#pragma unroll
    for (int i = 0; i < 64; ++i) { cgt += (key[i] > T) ? 1 : 0; ceq += (key[i] == T) ? 1 : 0; }
    const auto rg = __builtin_amdgcn_permlane32_swap((unsigned)cgt, (unsigned)cgt, false, false);
    const int need = 16 - (int)(rg[0] + rg[1]);
    const auto re = __builtin_amdgcn_permlane32_swap((unsigned)ceq, (unsigned)ceq, false, false);
    int running = kb ? (int)(re[0] + re[1]) - ceq : 0;
    unsigned mlo = 0u, mhi = 0u;
#pragma unroll
    for (int i = 0; i < 64; ++i) {
      const bool eq = key[i] == T;
      const bool sl = (key[i] != 0u) && ((key[i] > T) || (eq && running < need));
      running += eq ? 1 : 0;
      if (i < 32) mlo |= sl ? (1u << i) : 0u; else mhi |= sl ? (1u << (i - 32)) : 0u;
    }
    const auto rl = __builtin_amdgcn_permlane32_swap(mlo, mlo, false, false);
    const auto rh = __builtin_amdgcn_permlane32_swap(mhi, mhi, false, false);
    const unsigned olo = rl[0] ^ rl[1] ^ mlo, ohi = rh[0] ^ rh[1] ^ mhi;
    mk0 = kb ? olo : mlo; mk1 = kb ? ohi : mhi; mk2 = kb ? mlo : olo; mk3 = kb ? mhi : ohi;
  }
  asm volatile("" ::: "memory");
  __syncthreads();
  const bf16_t* ksel = proj + (size_t)b * SEQ * PW + C_KS + g * 64;
  const bf16_t* vsel = proj + (size_t)b * SEQ * PW + C_VS + g * 64;
  const bf16_t* kwin = proj + (size_t)b * SEQ * PW + C_KW + g * 64;
  const bf16_t* vwin = proj + (size_t)b * SEQ * PW + C_VW + g * 64;
  const int st1 = 4 * qb + 3, wst0 = qb > 2 ? 4 * qb - 8 : 0;
#pragma unroll 1
  for (int hp = 0; hp < 2; ++hp) {
    const int head = g * 4 + hp * 2;
    bf16x8 qa[4], qb_[4];
#pragma unroll
    for (int i = 0; i < 4; ++i) {
      qa[i] = *(const bf16x8*)(qrow + C_NQ + head * 64 + i * 16 + kb * 8);
      qb_[i] = *(const bf16x8*)(qrow + C_NQ + (head + 1) * 64 + i * 16 + kb * 8);
    }
    bf16_t* dstA = mix + tokq * DM + 512 + head * 64;
    bf16_t* dstB = dstA + 64;
    HeadAcc A, B;
    A.o0 = zero16(); A.o1 = zero16(); A.m = -1e30f; A.l = 0.f; B.o0 = zero16(); B.o1 = zero16(); B.m = -1e30f; B.l = 0.f;
    nsa_branch2<false>(ksel, vsel, smem, 0, st1, qt, tq, qa, qb_, mk0, mk1, mk2, mk3, A, B);
    {
      const float gA = sigmoidf_(bf2f(qrow[C_NG + head * 3 + 1]) + P.nsa_gate_b[head * 3 + 1]);
      const float gB = sigmoidf_(bf2f(qrow[C_NG + (head + 1) * 3 + 1]) + P.nsa_gate_b[(head + 1) * 3 + 1]);
      fold_partial(dstA, gA / fmaxf(half_sum(A.l), 1e-30f), A.o0, A.o1, kb);
      fold_partial(dstB, gB / fmaxf(half_sum(B.l), 1e-30f), B.o0, B.o1, kb);
    }
    A.o0 = zero16(); A.o1 = zero16(); A.m = -1e30f; A.l = 0.f; B.o0 = zero16(); B.o1 = zero16(); B.m = -1e30f; B.l = 0.f;
    nsa_branch2<true>(kwin, vwin, smem, wst0, st1, qt, tq, qa, qb_, 0u, 0u, 0u, 0u, A, B);
    {
      const float gA = sigmoidf_(bf2f(qrow[C_NG + head * 3 + 2]) + P.nsa_gate_b[head * 3 + 2]);
      const float gB = sigmoidf_(bf2f(qrow[C_NG + (head + 1) * 3 + 2]) + P.nsa_gate_b[(head + 1) * 3 + 2]);
      fold_partial(dstA, gA / fmaxf(half_sum(A.l), 1e-30f), A.o0, A.o1, kb);
      fold_partial(dstB, gB / fmaxf(half_sum(B.l), 1e-30f), B.o0, B.o1, kb);
    }
  }
}

DI void sgu_item(const Params& P, int item, char* smem) {
  const bf16_t* H = (const bf16_t*)(P.ws + R1);
  bf16_t* Y = (bf16_t*)P.out;
  float* smu = (float*)smem; float* srs = smu + 128; float* sc1 = srs + 128; float* srw = sc1 + 128; float* slg = srw + 128; float* slb = slg + 256;
  bf16_t* sW = (bf16_t*)(smem + 4096);
  char* sV = smem + 4096 + 34816;
  const int tid = TIDX, lane = tid & 63, wave = __builtin_amdgcn_readfirstlane(tid >> 6), l32 = lane & 31, kb = lane >> 5;
  const size_t tok0 = (size_t)item * 128;
#pragma unroll 1
  for (int tb = 0; tb < 16; tb += 4) {
    u32x4 uu[4][4];
#pragma unroll
    for (int a = 0; a < 4; ++a)
#pragma unroll
      for (int k = 0; k < 4; ++k) uu[a][k] = *(const u32x4*)(H + (tok0 + wave * 16 + tb + a) * 4096 + 2048 + k * 512 + lane * 8);
#pragma unroll
    for (int a = 0; a < 4; ++a) {
      float sm = 0.f, s2 = 0.f;
#pragma unroll
      for (int k = 0; k < 4; ++k)
#pragma unroll
        for (int e = 0; e < 4; ++e) { const float x0 = bflo(uu[a][k][e]), x1 = bfhi(uu[a][k][e]); sm += x0 + x1; s2 += x0 * x0 + x1 * x1; }
      sm = wave_sum(sm); s2 = wave_sum(s2);
      const float mu = sm * (1.f / 2048.f);
      const float var = fmaxf(s2 * (1.f / 2048.f) - mu * mu, 0.f);
      if (lane == 0) { smu[wave * 16 + tb + a] = mu; srs[wave * 16 + tb + a] = rsqrtf(var + EPS); }
    }
  }
  __syncthreads();
  const int srow = tid >> 5, schunk = tid & 31;
#pragma unroll 1
  for (int g = 0; g < 8; ++g) {
    u32x4 vreg[8], ureg[8];
#pragma unroll
    for (int i = 0; i < 8; ++i) {
      const bf16_t* hp = H + (tok0 + srow + 16 * i) * 4096 + g * 256 + schunk * 8;
      vreg[i] = *(const u32x4*)(hp + 2048);
      ureg[i] = *(const u32x4*)hp;
    }
    {
      const int t = tid >> 2, qr = tid & 3;
      const float* wrow = P.o_w_s + ((size_t)g * 128 + t) * 128 + qr * 32;
      float4 wq[8];
#pragma unroll
      for (int c4 = 0; c4 < 8; ++c4) wq[c4] = *(const float4*)(wrow + c4 * 4);
      float c1 = 0.f, rw = 0.f;
#pragma unroll
      for (int c8 = 0; c8 < 4; ++c8) {
        const float4 f0 = wq[2 * c8], f1 = wq[2 * c8 + 1];
        float wv[8] = {f0.x, f0.y, f0.z, f0.w, f1.x, f1.y, f1.z, f1.w};
        float ov[8];
#pragma unroll
        for (int e = 0; e < 8; ++e) {
          const int sx = qr * 32 + c8 * 8 + e;
          const float w = (sx <= t) ? wv[e] : 0.f;
          rw += w;
          const float wp = bf2f(f2bf(w * srs[sx]));
          c1 += wp * smu[sx];
          ov[e] = wp;
        }
        u32x4 o; o[0] = pk2(ov[0], ov[1]); o[1] = pk2(ov[2], ov[3]); o[2] = pk2(ov[4], ov[5]); o[3] = pk2(ov[6], ov[7]);
        *(u32x4*)(sW + t * 136 + qr * 32 + c8 * 8) = o;
      }
      c1 += __shfl_xor(c1, 1); rw += __shfl_xor(rw, 1);
      c1 += __shfl_xor(c1, 2); rw += __shfl_xor(rw, 2);
      if (qr == 0) { sc1[t] = c1; srw[t] = rw; }
      if (tid < 256) { slg[tid] = P.o_ln_g[g * 256 + tid]; slb[tid] = P.o_ln_b[g * 256 + tid]; }
    }
#pragma unroll
    for (int i = 0; i < 8; ++i) *(u32x4*)(sV + (srow + 16 * i) * 544 + schunk * 16) = vreg[i];
    __syncthreads();
    const int tt = wave & 3, chh = wave >> 2;
    f32x16 acc[4];
#pragma unroll
    for (int c = 0; c < 4; ++c) acc[c] = zero16();
    {
      const int i16 = lane & 15, q = i16 >> 2, p = i16 & 3, gc = (lane >> 4) & 1;
      const char* vb = sV + (8 * kb + q) * 544 + (chh * 128 + gc * 16 + 4 * p) * 2;
      const bf16_t* wb = sW + (tt * 32 + l32) * 136 + kb * 8;
      const int nks = 2 * (tt + 1);
      for (int ks = 0; ks < nks; ++ks) {
        const bf16x8 wf = *(const bf16x8*)(wb + ks * 16);
#pragma unroll
        for (int c = 0; c < 4; ++c) {
          const s16x4 lo = lds_tr(vb + ks * 16 * 544 + c * 64);
          const s16x4 hi = lds_tr(vb + (ks * 16 + 4) * 544 + c * 64);
          const bf16x8 vf = __builtin_shufflevector(lo, hi, 0, 1, 2, 3, 4, 5, 6, 7);
          acc[c] = mfma(vf, wf, acc[c]);
        }
      }
    }
    __syncthreads();
    {
      const int t = tt * 32 + l32;
      const float c1 = sc1[t], rw = srw[t], bs = P.o_b_s[g * 128 + t];
#pragma unroll
      for (int c = 0; c < 4; ++c)
#pragma unroll
        for (int gq = 0; gq < 4; ++gq) {
          const int chl = (chh * 4 + c) * 32 + 8 * gq + 4 * kb;
          const float4 lg = *(const float4*)(slg + chl), lb = *(const float4*)(slb + chl);
          const float m0 = lg.x * (acc[c][gq * 4 + 0] - c1) + lb.x * rw + bs;
          const float m1 = lg.y * (acc[c][gq * 4 + 1] - c1) + lb.y * rw + bs;
          const float m2 = lg.z * (acc[c][gq * 4 + 2] - c1) + lb.z * rw + bs;
          const float m3 = lg.w * (acc[c][gq * 4 + 3] - c1) + lb.w * rw + bs;
          u32x2 o; o[0] = pk2(m0, m1); o[1] = pk2(m2, m3);
          *(u32x2*)(sV + t * 520 + chl * 2) = o;
        }
    }
    __syncthreads();
#pragma unroll
    for (int i = 0; i < 8; ++i) {
      const char* mp = sV + (srow + 16 * i) * 520 + schunk * 16;
      const u32x2 ma = *(const u32x2*)mp, mb = *(const u32x2*)(mp + 8);
      const u32x4 uu = ureg[i];
      u32x4 o;
      o[0] = pk2(bflo(uu[0]) * bflo(ma[0]), bfhi(uu[0]) * bfhi(ma[0]));
      o[1] = pk2(bflo(uu[1]) * bflo(ma[1]), bfhi(uu[1]) * bfhi(ma[1]));
      o[2] = pk2(bflo(uu[2]) * bflo(mb[0]), bfhi(uu[2]) * bfhi(mb[0]));
      o[3] = pk2(bflo(uu[3]) * bflo(mb[1]), bfhi(uu[3]) * bfhi(mb[1]));
      *(u32x4*)(Y + (tok0 + srow + 16 * i) * 2048 + g * 256 + schunk * 8) = o;
    }
    __syncthreads();
  }
}

constexpr int NPHASE = 17;
DI void run_phase(const Params& P, int ph, char* smem) {
  char* ws = P.ws;
  bf16_t* r1 = (bf16_t*)(ws + R1); bf16_t* r2 = (bf16_t*)(ws + R2); bf16_t* r3 = (bf16_t*)(ws + R3); bf16_t* r4 = (bf16_t*)(ws + R4);
  unsigned* cnt = (unsigned*)(ws + W_CNT);
  const int lane = TIDX & 63, wave = TIDX >> 6, half = TIDX >> 8;
  char* hsmem = smem + half * 65536;
  switch (ph) {
    case 0: phase_prep(P); break;
    case 1: gemm_run<0>(r2, (const bf16_t*)(ws + W_EIN), PW, 1024, r1, PW, smem); break;
    case 2: {
      if (blockIdx.x < 64) nsa_compress_task(P, blockIdx.x * WPB + wave);
      volatile int* s_item = (volatile int*)(smem + LDS_BYTES - 16);
      for (;;) {
        __syncthreads();
        if (TIDX == 0) *s_item = (int)atomicAdd(cnt + 0, 1u);
        __syncthreads();
        const int pair = *s_item;
        if (pair >= 2048) break;
        gla_p1_item(P, pair * 2 + half, hsmem);
      }
    } break;
    case 3: gla_scan(P);
    case 30: {
      volatile int* s_item = (volatile int*)(smem + 131072);
      for (;;) {
        __syncthreads();
        if (TIDX == 0) *s_item = (int)atomicAdd(cnt + 1, 1u);
        __syncthreads();
        const int it = *s_item;
        if (it >= 512) break;
        nsa_block(P, (it & 15) >> 1, it & 1, 31 - (it >> 4), smem);
      }
    } break;
    case 4:
      for (int item = blockIdx.x * 2 + half; item < 4096; item += gridDim.x * 2) gla_p3_item(P, item, hsmem);
      break;
    case 5: gemm_run<0>(r3, (const bf16_t*)(ws + W_EOUT), 1024, 1024, r4, 1024, smem); break;
    case 6: resnorm_rows<true, false>(r4, P.x, nullptr, nullptr, r3, P.norm_g + 1 * 1024, P.norm_g + 2 * 1024, r2); break;
    case 7: gemm_run<1>(r2, (const bf16_t*)(ws + W_FFN1_0), 4096, 1024, r1, 4096, smem); break;
    case 8: gemm_run<0>(r1, (const bf16_t*)(ws + W_FFN2_0), 1024, 4096, r4, 1024, smem); break;
    case 9: resnorm_rows<false, false>(r4, nullptr, r3, nullptr, r3, P.norm_g + 3 * 1024, P.norm_g + 4 * 1024, r2); break;
    case 10: gemm_run<2>(r2, (const bf16_t*)(ws + W_OIN), 4096, 1024, r1, 4096, smem); break;
    case 11:
      for (int item = blockIdx.x; item < 512; item += gridDim.x) sgu_item(P, item, smem);
      break;
    case 12: gemm_run<0>((const bf16_t*)P.out, (const bf16_t*)(ws + W_OOUT), 1024, 2048, r4, 1024, smem); break;
    case 13: resnorm_rows<false, false>(r4, nullptr, r3, nullptr, r3, P.norm_g + 5 * 1024, P.norm_g + 6 * 1024, r2); break;
    case 14: gemm_run<1>(r2, (const bf16_t*)(ws + W_FFN1_1), 4096, 1024, r1, 4096, smem); break;
    case 15: gemm_run<0>(r1, (const bf16_t*)(ws + W_FFN2_1), 1024, 4096, r4, 1024, smem); break;
    case 16: resnorm_rows<false, true>(r4, nullptr, r3, P.out, nullptr, P.norm_g + 7 * 1024, nullptr, nullptr); break;
    default: break;
  }
}

#if !MEGA
extern __shared__ __attribute__((aligned(16))) unsigned char lds_dyn[];
__global__ void __launch_bounds__(NTHR, 2) k_phase(Params P, int ph) {
  char* smem = (char*)lds_dyn;
  run_phase(P, ph, smem);
}
#endif

#define XB_TMO      128
#define XB_XCNT(j)  (256  + 64 * (j))
#define XB_XSUB(j)  (1280 + 64 * (j))
#define XB_XGEN(j)  (2304 + 64 * (j))
#define XB_TOP      3328
#define XB_TOPGEN   3392
#define XCD_BAR_WORDS 3456
#define XB_SPIN_CAP (1u << 20)
#define LAS3 __attribute__((address_space(3)))
DI unsigned xb_ld(unsigned* p) { return __hip_atomic_load(p, __ATOMIC_RELAXED, __HIP_MEMORY_SCOPE_AGENT); }
DI unsigned xb_add(unsigned* p, unsigned v) { return __hip_atomic_fetch_add(p, v, __ATOMIC_RELAXED, __HIP_MEMORY_SCOPE_AGENT); }
DI unsigned xb_xcc_id() { return (unsigned)__builtin_amdgcn_s_getreg((3 << 11) | 20) & 0xFu; }
#define XB_SPIN(cond, bar) do { unsigned _sp = 0; while (cond) { __builtin_amdgcn_s_sleep(1); \
    if ((++_sp & 255u) == 0u) { if (xb_ld(&(bar)[XB_TMO])) break; if (_sp > XB_SPIN_CAP) { atomicAdd(&(bar)[XB_TMO], 1u); break; } } } } while (0)
struct XcdBarrier { unsigned* bar; unsigned x; volatile LAS3 unsigned* st; };
DI XcdBarrier xcd_barrier_post(unsigned* bar, volatile LAS3 unsigned* st) {
  XcdBarrier b; b.bar = bar; b.x = xb_xcc_id(); b.st = st;
  if (threadIdx.x == 0) (void)xb_add(&bar[XB_XCNT(b.x)], 1u);
  return b;
}
DI void xcd_barrier_complete(unsigned* bar, unsigned x, unsigned& nloc, unsigned& nx) {
  const unsigned G = gridDim.x * gridDim.y * gridDim.z;
  unsigned sum, cnt, mine, sp = 0u;
  for (;;) {
    sum = 0u; cnt = 0u; mine = 0u;
#pragma unroll
    for (unsigned j = 0; j < 16; ++j) { const unsigned c = xb_ld(&bar[XB_XCNT(j)]); sum += c; cnt += (c > 0u) ? 1u : 0u; mine = (j == x) ? c : mine; }
    if (sum == G) break;
    __builtin_amdgcn_s_sleep(1);
    if ((++sp & 255u) == 0u) { if (xb_ld(&bar[XB_TMO])) break; if (sp > XB_SPIN_CAP) { atomicAdd(&bar[XB_TMO], 1u); break; } }
  }
  nloc = mine > 0u ? mine : 1u; nx = cnt > 0u ? cnt : 1u;
}
DI void xcd_barrier(const XcdBarrier& b) {
  asm volatile("s_waitcnt vmcnt(0)" ::: "memory");
  __syncthreads();
  if (threadIdx.x == 0) {
    unsigned* bar = b.bar;
    __builtin_amdgcn_s_waitcnt(0);
    unsigned nloc = b.st[0], nx = b.st[1];
    if (nloc == 0u) { xcd_barrier_complete(bar, b.x, nloc, nx); b.st[0] = nloc; b.st[1] = nx; }
    const unsigned old = xb_add(&bar[XB_XSUB(b.x)], 1u);
    const unsigned gen = old / nloc;
    if (old + 1u == (gen + 1u) * nloc) {
      __builtin_amdgcn_fence(__ATOMIC_RELEASE, "agent");
      asm volatile("s_waitcnt vmcnt(0)" ::: "memory");
      const unsigned og = xb_add(&bar[XB_TOP], 1u);
      const unsigned tg = og / nx;
      if (og + 1u == (tg + 1u) * nx) xb_add(&bar[XB_TOPGEN], 1u);
      else XB_SPIN(xb_ld(&bar[XB_TOPGEN]) == tg, bar);
      __builtin_amdgcn_fence(__ATOMIC_ACQUIRE, "agent");
      xb_add(&bar[XB_XGEN(b.x)], 1u);
      asm volatile("s_waitcnt vmcnt(0)" ::: "memory");
    } else {
      XB_SPIN(xb_ld(&bar[XB_XGEN(b.x)]) == gen, bar);
      __builtin_amdgcn_fence(__ATOMIC_ACQUIRE, "agent");
      asm volatile("s_waitcnt vmcnt(0)" ::: "memory");
    }
  }
  __syncthreads();
}

#if MEGA
extern __shared__ __attribute__((aligned(16))) unsigned char lds_dyn[];
__global__ void __launch_bounds__(NTHR, 2) k_mega(Params P) {
  char* smem = (char*)lds_dyn;
  cg::grid_group grid = cg::this_grid();
  volatile LAS3 unsigned* xst = (volatile LAS3 unsigned*)(smem + 131072 + 16);
  if (threadIdx.x == 0) { xst[0] = 0u; xst[1] = 0u; }
  __syncthreads();
  const XcdBarrier xb = xcd_barrier_post((unsigned*)(P.ws + W_BAR), xst);
#define GSYNC() xcd_barrier(xb)
#define GEMM_PH(n) run_phase(P, n, smem); GSYNC(); if (PROBE == 1) { run_phase(P, n, smem); GSYNC(); }
  if (P.ws == nullptr) grid.sync();
  run_phase(P, 0, smem); GSYNC();
  if (PROBE == 3) { run_phase(P, 0, smem); GSYNC(); }
  GEMM_PH(1)
  run_phase(P, 2, smem); GSYNC();
  if (PROBE == 4) { if (blockIdx.x == 0 && TIDX == 0) ((unsigned*)(P.ws + W_CNT))[0] = 0u; GSYNC(); run_phase(P, 2, smem); GSYNC(); }
  run_phase(P, 3, smem); GSYNC();
  if (PROBE == 2) {
    if (blockIdx.x == 0 && TIDX == 0) ((unsigned*)(P.ws + W_CNT))[1] = 0u;
    GSYNC();
    run_phase(P, 30, smem); GSYNC();
  }
  run_phase(P, 4, smem); GSYNC();
  if (PROBE == 5) { run_phase(P, 4, smem); GSYNC(); }
  GEMM_PH(5)
  run_phase(P, 6, smem); GSYNC();
  if (PROBE == 6) { run_phase(P, 6, smem); GSYNC(); run_phase(P, 6, smem); GSYNC(); run_phase(P, 6, smem); GSYNC(); }
  GEMM_PH(7)
  GEMM_PH(8)
  run_phase(P, 9, smem); GSYNC();
  GEMM_PH(10)
  run_phase(P, 11, smem); GSYNC();
  if (PROBE == 7) { run_phase(P, 11, smem); GSYNC(); }
  GEMM_PH(12)
  run_phase(P, 13, smem); GSYNC();
  GEMM_PH(14)
  GEMM_PH(15)
  if (PROBE == 11) { GSYNC(); GSYNC(); GSYNC(); GSYNC(); GSYNC(); GSYNC(); GSYNC(); GSYNC(); }
  run_phase(P, 16, smem);
}
#endif

extern "C" void kernel_launch(void* const* d_in, const int* in_sizes, int n_in, void* d_out, int out_size, void* d_ws, size_t ws_size,
                              hipStream_t stream) {
  Params p{};
  p.x = (const float*)d_in[0]; p.norm_g = (const float*)d_in[1]; p.ffn_w1 = (const float*)d_in[2]; p.ffn_w2 = (const float*)d_in[3];
  p.e_w_in = (const float*)d_in[4]; p.e_w_out = (const float*)d_in[5]; p.gla_w_gate = (const float*)d_in[6]; p.gla_b_gate = (const float*)d_in[7];
  p.gla_norm = (const float*)d_in[8]; p.nsa_gate_b = (const float*)d_in[9]; p.cmp_pos = (const float*)d_in[10]; p.cmp_w1 = (const float*)d_in[11];
  p.cmp_w2 = (const float*)d_in[12]; p.o_w_in = (const float*)d_in[13]; p.o_ln_g = (const float*)d_in[14]; p.o_ln_b = (const float*)d_in[15];
  p.o_w_s = (const float*)d_in[16]; p.o_b_s = (const float*)d_in[17]; p.o_w_out = (const float*)d_in[18];
  p.out = (float*)d_out; p.ws = (char*)d_ws;
  if (ws_size < 1024ull * MiB) { fprintf(stderr, "workspace too small: %zu\n", ws_size); return; }
  static int grid_blocks = 0;
  if (!grid_blocks) {
    int dev = 0, cus = 0, per_cu = 0;
    (void)hipGetDevice(&dev);
    (void)hipDeviceGetAttribute(&cus, hipDeviceAttributeMultiprocessorCount, dev);
#if MEGA
    if (hipFuncSetAttribute((const void*)k_mega, hipFuncAttributeMaxDynamicSharedMemorySize, LDS_BYTES) != hipSuccess) fprintf(stderr, "hipFuncSetAttribute failed\n");
    (void)hipOccupancyMaxActiveBlocksPerMultiprocessor(&per_cu, (const void*)k_mega, NTHR, LDS_BYTES);
#else
    if (hipFuncSetAttribute((const void*)k_phase, hipFuncAttributeMaxDynamicSharedMemorySize, LDS_BYTES) != hipSuccess) fprintf(stderr, "hipFuncSetAttribute failed\n");
    (void)hipOccupancyMaxActiveBlocksPerMultiprocessor(&per_cu, (const void*)k_phase, NTHR, LDS_BYTES);
#endif
    if (per_cu < 1) fprintf(stderr, "occupancy query returned %d\n", per_cu);
    grid_blocks = cus;
  }
#if MEGA
  if (hipMemsetAsync((char*)d_ws + W_BAR, 0, XCD_BAR_WORDS * sizeof(unsigned), stream) != hipSuccess) fprintf(stderr, "memset of barrier words failed\n");
  void* args[] = {&p};
  hipError_t e = hipLaunchCooperativeKernel((void*)k_mega, dim3(grid_blocks), dim3(NTHR), args, LDS_BYTES, stream);
  if (e != hipSuccess) fprintf(stderr, "cooperative launch failed: %s (grid %d)\n", hipGetErrorString(e), grid_blocks);
#else
  for (int ph = 0; ph < NPHASE; ++ph) k_phase<<<grid_blocks, NTHR, LDS_BYTES, stream>>>(p, ph);
#endif
}
```

```cpp
#include <hip/hip_runtime.h>
#include <hip/hip_cooperative_groups.h>
#include <cstdio>
namespace cg = cooperative_groups;

#ifndef MEGA
#define MEGA 1
#endif
#ifndef PROBE
#define PROBE 0
#endif

typedef unsigned short bf16_t;
typedef short bf16x8 __attribute__((ext_vector_type(8)));
typedef short s16x4 __attribute__((ext_vector_type(4)));
typedef float f32x16 __attribute__((ext_vector_type(16)));
typedef float f32v2 __attribute__((ext_vector_type(2)));
typedef __bf16 bf16v2 __attribute__((ext_vector_type(2)));
typedef unsigned u32x4 __attribute__((ext_vector_type(4)));
typedef unsigned u32x2 __attribute__((ext_vector_type(2)));
#define DI __device__ __forceinline__
DI int tid_opaque() { int t = threadIdx.x; asm volatile("" : "+v"(t)); return t; }
#define TIDX tid_opaque()

constexpr int T_TOK = 65536, SEQ = 8192, DM = 1024;
constexpr int PW = 3072;
constexpr int C_GQ = 0, C_GK = 256, C_GV = 512, C_GLR = 1024, C_GR = 1040, C_NQ = 1552, C_KC = 2064, C_VC = 2192,
              C_KS = 2320, C_VS = 2448, C_KW = 2576, C_VW = 2704, C_NG = 2832;
constexpr float EPS = 1e-6f;
constexpr int NTHR = 512, WPB = 8, LDS_CMP_STAGE = 131072 + 64, LDS_BYTES = 131072 + 64 + 18432;
constexpr size_t MiB = 1024ull * 1024ull;
constexpr size_t W_FFN1_0 = 0, W_FFN1_1 = 8 * MiB, W_FFN2_0 = 16 * MiB, W_FFN2_1 = 24 * MiB, W_EIN = 32 * MiB, W_EOUT = 38 * MiB,
                 W_OIN = 40 * MiB, W_OOUT = 48 * MiB, W_CW1 = 52 * MiB, W_CW2 = 53 * MiB, W_BIAS1 = 53 * MiB + 65536,
                 W_CNT = 53 * MiB + 131072, W_BAR = 54 * MiB;
constexpr size_t R1 = 64 * MiB, R2 = 576 * MiB, R3 = 704 * MiB, R4 = 832 * MiB, R5 = 960 * MiB;
constexpr size_t R_KCMP = R5, R_VCMPT = R5 + 1 * MiB, R_VST = R5 + 2 * MiB, R_VWT = R5 + 18 * MiB, R_DECAY = R5 + 34 * MiB;

struct Params {
  const float* x; const float* norm_g; const float* ffn_w1; const float* ffn_w2; const float* e_w_in; const float* e_w_out;
  const float* gla_w_gate; const float* gla_b_gate; const float* gla_norm; const float* nsa_gate_b; const float* cmp_pos;
  const float* cmp_w1; const float* cmp_w2; const float* o_w_in; const float* o_ln_g; const float* o_ln_b; const float* o_w_s;
  const float* o_b_s; const float* o_w_out;
  float* out; char* ws;
};

DI int crow(int r, int kb) { return (r & 3) + 8 * (r >> 2) + 4 * kb; }
DI f32x16 mfma(bf16x8 a, bf16x8 b, f32x16 c) { return __builtin_amdgcn_mfma_f32_32x32x16_bf16(a, b, c, 0, 0, 0); }
DI unsigned pk2(float a, float b) { f32v2 v = {a, b}; bf16v2 r = __builtin_convertvector(v, bf16v2); return __builtin_bit_cast(unsigned, r); }
DI bf16_t f2bf(float a) { return (bf16_t)(pk2(a, 0.f) & 0xffffu); }
DI float bf2f(bf16_t u) { return __uint_as_float(((unsigned)u) << 16); }
DI float bflo(unsigned u) { return __uint_as_float(u << 16); }
DI float bfhi(unsigned u) { return __uint_as_float(u & 0xffff0000u); }
DI bf16x8 pack8(float a0, float a1, float a2, float a3, float a4, float a5, float a6, float a7) {
  u32x4 p; p[0] = pk2(a0, a1); p[1] = pk2(a2, a3); p[2] = pk2(a4, a5); p[3] = pk2(a6, a7);
  return __builtin_bit_cast(bf16x8, p);
}
DI bf16x8 ld2x4(const bf16_t* p) {
  s16x4 lo = *(const s16x4*)p; s16x4 hi = *(const s16x4*)(p + 8);
  return __builtin_shufflevector(lo, hi, 0, 1, 2, 3, 4, 5, 6, 7);
}
DI float wave_sum(float v) {
#pragma unroll
  for (int o = 32; o > 0; o >>= 1) v += __shfl_xor(v, o);
  return v;
}
DI f32x16 zero16() { f32x16 z;
#pragma unroll
  for (int i = 0; i < 16; ++i) z[i] = 0.f; return z; }
DI float frcp(float x) { return __builtin_amdgcn_rcpf(x); }
DI float gelu_tanh(float x) { const float t = x * x; const float p = __builtin_fmaf(t, -2.3022082f * 0.044715f, -2.3022082f); return x * frcp(1.f + __builtin_amdgcn_exp2f(x * p)); }
DI float sigmoidf_(float x) { return frcp(1.f + __expf(-x)); }

DI void conv_weight(const float* __restrict__ src, bf16_t* __restrict__ dst, int K, int N, int Npad) {
  const long total = (long)Npad * (K >> 3);
  const long stride = (long)gridDim.x * blockDim.x;
  for (long i = (long)blockIdx.x * blockDim.x + TIDX; i < total; i += stride) {
    const int n = (int)(i % Npad); const int k8 = (int)(i / Npad);
    float v[8];
#pragma unroll
    for (int j = 0; j < 8; ++j) v[j] = (n < N) ? src[(size_t)(k8 * 8 + j) * N + n] : 0.f;
    u32x4 o; o[0] = pk2(v[0], v[1]); o[1] = pk2(v[2], v[3]); o[2] = pk2(v[4], v[5]); o[3] = pk2(v[6], v[7]);
    *(u32x4*)(dst + (size_t)n * K + k8 * 8) = o;
  }
}

DI void prenorm_rows(const float* __restrict__ x, const float* __restrict__ g, bf16_t* __restrict__ xn) {
  const int lane = TIDX & 63, wave = TIDX >> 6;
  const int nw = gridDim.x * WPB;
  for (int row = blockIdx.x * WPB + wave; row < T_TOK; row += nw) {
    const float4* xr = (const float4*)(x + (size_t)row * DM);
    float4 a[4]; float ss = 0.f;
#pragma unroll
    for (int k = 0; k < 4; ++k) { a[k] = xr[k * 64 + lane]; ss += a[k].x * a[k].x + a[k].y * a[k].y + a[k].z * a[k].z + a[k].w * a[k].w; }
    ss = wave_sum(ss);
    const float rs = rsqrtf(ss * (1.f / DM) + EPS);
#pragma unroll
    for (int k = 0; k < 4; ++k) {
      const float4 gg = ((const float4*)g)[k * 64 + lane];
      u32x2 o; o[0] = pk2(a[k].x * rs * gg.x, a[k].y * rs * gg.y); o[1] = pk2(a[k].z * rs * gg.z, a[k].w * rs * gg.w);
      *(u32x2*)(xn + (size_t)row * DM + k * 256 + lane * 4) = o;
    }
  }
}

template <bool HIN_F32, bool HOUT_F32>
DI void resnorm_rows(const bf16_t* __restrict__ m, const float* __restrict__ hin_f, const bf16_t* hin_b, float* __restrict__ hout_f,
                     bf16_t* hout_b, const float* __restrict__ gpost, const float* __restrict__ gnext, bf16_t* __restrict__ xn) {
  const int lane = TIDX & 63, wave = TIDX >> 6;
  const int nw = gridDim.x * WPB;
  for (int row = blockIdx.x * WPB + wave; row < T_TOK; row += nw) {
    float mv[16]; float ss = 0.f;
#pragma unroll
    for (int k = 0; k < 4; ++k) {
      const u32x2 u = *(const u32x2*)(m + (size_t)row * DM + k * 256 + lane * 4);
      mv[k * 4 + 0] = bflo(u[0]); mv[k * 4 + 1] = bfhi(u[0]); mv[k * 4 + 2] = bflo(u[1]); mv[k * 4 + 3] = bfhi(u[1]);
    }
    float hv[16];
#pragma unroll
    for (int k = 0; k < 4; ++k) {
      if (HIN_F32) {
        const float4 h4 = ((const float4*)(hin_f + (size_t)row * DM))[k * 64 + lane];
        hv[k * 4 + 0] = h4.x; hv[k * 4 + 1] = h4.y; hv[k * 4 + 2] = h4.z; hv[k * 4 + 3] = h4.w;
      } else {
        const u32x2 u = *(const u32x2*)(hin_b + (size_t)row * DM + k * 256 + lane * 4);
        hv[k * 4 + 0] = bflo(u[0]); hv[k * 4 + 1] = bfhi(u[0]); hv[k * 4 + 2] = bflo(u[1]); hv[k * 4 + 3] = bfhi(u[1]);
      }
    }
#pragma unroll
    for (int i = 0; i < 16; ++i) ss += mv[i] * mv[i];
    ss = wave_sum(ss);
    const float rs = rsqrtf(ss * (1.f / DM) + EPS);
    float s2 = 0.f;
#pragma unroll
    for (int k = 0; k < 4; ++k) {
      const float4 gg = ((const float4*)gpost)[k * 64 + lane];
      hv[k * 4 + 0] += mv[k * 4 + 0] * rs * gg.x; hv[k * 4 + 1] += mv[k * 4 + 1] * rs * gg.y;
      hv[k * 4 + 2] += mv[k * 4 + 2] * rs * gg.z; hv[k * 4 + 3] += mv[k * 4 + 3] * rs * gg.w;
      if (HOUT_F32) {
        float4 o; o.x = hv[k * 4 + 0]; o.y = hv[k * 4 + 1]; o.z = hv[k * 4 + 2]; o.w = hv[k * 4 + 3];
        ((float4*)(hout_f + (size_t)row * DM))[k * 64 + lane] = o;
      } else {
        u32x2 o; o[0] = pk2(hv[k * 4 + 0], hv[k * 4 + 1]); o[1] = pk2(hv[k * 4 + 2], hv[k * 4 + 3]);
        *(u32x2*)(hout_b + (size_t)row * DM + k * 256 + lane * 4) = o;
      }
    }
    if (xn) {
#pragma unroll
      for (int i = 0; i < 16; ++i) s2 += hv[i] * hv[i];
      s2 = wave_sum(s2);
      const float r2 = rsqrtf(s2 * (1.f / DM) + EPS);
#pragma unroll
      for (int k = 0; k < 4; ++k) {
        const float4 gg = ((const float4*)gnext)[k * 64 + lane];
        u32x2 o; o[0] = pk2(hv[k * 4 + 0] * r2 * gg.x, hv[k * 4 + 1] * r2 * gg.y); o[1] = pk2(hv[k * 4 + 2] * r2 * gg.z, hv[k * 4 + 3] * r2 * gg.w);
        *(u32x2*)(xn + (size_t)row * DM + k * 256 + lane * 4) = o;
      }
    }
  }
}

DI void phase_prep(const Params& P) {
  char* ws = P.ws;
  conv_weight(P.ffn_w1, (bf16_t*)(ws + W_FFN1_0), 1024, 4096, 4096);
  conv_weight(P.ffn_w1 + (size_t)1024 * 4096, (bf16_t*)(ws + W_FFN1_1), 1024, 4096, 4096);
  conv_weight(P.ffn_w2, (bf16_t*)(ws + W_FFN2_0), 4096, 1024, 1024);
  conv_weight(P.ffn_w2 + (size_t)1024 * 4096, (bf16_t*)(ws + W_FFN2_1), 4096, 1024, 1024);
  conv_weight(P.e_w_in, (bf16_t*)(ws + W_EIN), 1024, 2856, PW);
  conv_weight(P.e_w_out, (bf16_t*)(ws + W_EOUT), 1024, 1024, 1024);
  conv_weight(P.o_w_in, (bf16_t*)(ws + W_OIN), 1024, 4096, 4096);
  conv_weight(P.o_w_out, (bf16_t*)(ws + W_OOUT), 2048, 1024, 1024);
  conv_weight(P.cmp_w1, (bf16_t*)(ws + W_CW1), 2048, 128, 128);
  conv_weight(P.cmp_w1 + 2048 * 128, (bf16_t*)(ws + W_CW1) + 128 * 2048, 2048, 128, 128);
  conv_weight(P.cmp_w2, (bf16_t*)(ws + W_CW2), 128, 64, 64);
  conv_weight(P.cmp_w2 + 128 * 64, (bf16_t*)(ws + W_CW2) + 64 * 128, 128, 64, 64);
  const int lane = TIDX & 63, wave = TIDX >> 6;
  const int gw = blockIdx.x * WPB + wave;
  if (gw < 256) {
    const int i = gw >> 7, hid = gw & 127;
    float s = 0.f;
    for (int kk = lane; kk < 2048; kk += 64) s += P.cmp_pos[i * 2048 + kk] * P.cmp_w1[((size_t)i * 2048 + kk) * 128 + hid];
    s = wave_sum(s);
    if (lane == 0) ((float*)(ws + W_BIAS1))[gw] = s;
  }
  const int gt = blockIdx.x * blockDim.x + TIDX;
  if (gt < 16) ((unsigned*)(ws + W_CNT))[gt] = 0u;
  if (gt < 16 * 64) {
    const int bg = gt >> 6, d = gt & 63;
    ((bf16_t*)(ws + R_KCMP))[((size_t)bg * 512 + 511) * 64 + d] = 0;
    ((bf16_t*)(ws + R_VCMPT))[((size_t)bg * 512 + 511) * 64 + d] = 0;
  }
  prenorm_rows(P.x, P.norm_g, (bf16_t*)(ws + R2));
}

namespace pg8 {
#define PG8_LAS __attribute__((address_space(3)))
typedef float f32x4 __attribute__((ext_vector_type(4)));
constexpr int BM = 256, BK = 64, HALF = 128, HTB = HALF * BK * 2, STAGE_BYTES = 8 * HTB, NXCD = 8, WGM = 8;
DI int lds_byte(int r, int c) { const int st = (r >> 4) * 2 + (c >> 5), rr = r & 15, cc = c & 31, ob = rr * 64 + cc * 2; return st * 1024 + (ob ^ (((ob >> 9) & 1) << 5)); }
DI void stage_rc(int b, int& R, int& C) { const int st = b / 1024, sb = b % 1024, swz = sb ^ (((sb >> 9) & 1) << 5); R = (st >> 1) * 16 + swz / 64; C = (st & 1) * 32 + (swz % 64) / 2; }
DI int perm32(int rho) { const int n = rho >> 4, i = rho & 15; return 8 * (i >> 2) + 4 * n + (i & 3); }
struct Unit { int pm, pn; };
struct Gemm { const bf16_t* A; const bf16_t* Bt; int M, N, K; };
struct StaticOrder {
  int nM, nN, nwg, G, c;
  DI void init(int M, int N, int G_, int c_) { nM = M / BM; nN = N / BM; nwg = nM * nN; G = G_; c = c_; }
  DI bool next(int i, Unit& u) const {
    const long L = (long)i * G + c; if (L >= nwg) return false;
    int wgid = (int)L; { const int q = nwg / NXCD, r = nwg % NXCD, xcd = wgid % NXCD, off = wgid / NXCD; wgid = (xcd < r ? xcd * (q + 1) : r * (q + 1) + (xcd - r) * q) + off; }
    const int nig = WGM * nN, gid = wgid / nig, fm = gid * WGM, gsz = (nM - fm) < WGM ? (nM - fm) : WGM;
    u.pm = fm + ((wgid % nig) % gsz); u.pn = (wgid % nig) / gsz; return true;
  }
};
template <int ACT> struct EpiB {
  static constexpr bool PERM = true;
  bf16_t* O; int ldc;
  DI void operator()(const f32x4 (&acc)[2][2][4][2], const Unit& u, int wr, int wc, int fr, int fq) const {
    const int row0 = u.pm * BM + wr * 64 + fr; const int col0 = u.pn * BM + wc * 32 + 8 * fq;
#pragma unroll
    for (int ai = 0; ai < 2; ++ai)
#pragma unroll
      for (int m = 0; m < 4; ++m) {
        bf16_t* rowp = O + (size_t)(row0 + ai * HALF + m * 16) * ldc + col0;
#pragma unroll
        for (int bj = 0; bj < 2; ++bj) {
          f32x4 v0 = acc[ai][bj][m][0], v1 = acc[ai][bj][m][1];
          if (ACT == 1) {
#pragma unroll
            for (int j = 0; j < 4; ++j) { const float a = fmaxf(v0[j], 0.f), b = fmaxf(v1[j], 0.f); v0[j] = a * a; v1[j] = b * b; }
          }
          if (ACT == 2) {
#pragma unroll
            for (int j = 0; j < 4; ++j) { v0[j] = gelu_tanh(v0[j]); v1[j] = gelu_tanh(v1[j]); }
          }
          u32x4 w; w[0] = pk2(v0[0], v0[1]); w[1] = pk2(v0[2], v0[3]); w[2] = pk2(v1[0], v1[1]); w[3] = pk2(v1[2], v1[3]);
          *(u32x4*)(rowp + bj * HALF) = w;
        }
      }
  }
};

template <class Epi, class Sched>
DI void gemm_phase(PG8_LAS unsigned char* lds, const Gemm g, const Sched& S, const Epi& E) {
  const int tid_ = TIDX;
  const int tid = tid_, wid = __builtin_amdgcn_readfirstlane(tid >> 6), lane = tid & 63, wr = wid >> 2, wc = wid & 3, fr = lane & 15, fq = lane >> 4;
  const int K = g.K, nt = K / BK;
  unsigned voffA[2], voffB[2];
#pragma unroll
  for (int i = 0; i < 2; ++i) { int R, C; stage_rc(tid * 16 + i * 8192, R, C); const int Rb = Epi::PERM ? ((R & ~31) + perm32(R & 31)) : R;
    voffA[i] = (unsigned)(R * K + C) * 2u; voffB[i] = (unsigned)(Rb * K + C) * 2u; }
  const size_t kstep = (size_t)(BK * 2);
  const size_t hstep = (size_t)HALF * K * 2;
  const size_t tstep = 2 * hstep;
  const unsigned ldsw = (unsigned)wid * 1024u;
  const int aoff = lds_byte(wr * 64 + fr, fq * 8), boff = lds_byte(wc * 32 + fr, fq * 8);
#define PG8_SA(b, h) (((b) * 2 + (h)) * HTB)
#define PG8_SB(b, h) ((4 + (b) * 2 + (h)) * HTB)
#define PG8_STAGE(bufoff, gbase, voff) do { _Pragma("unroll") for (int _i = 0; _i < 2; ++_i) \
    __builtin_amdgcn_global_load_lds((const unsigned*)((const char*)(gbase) + (voff)[_i]), (PG8_LAS unsigned*)(lds + (bufoff) + ldsw + _i * 8192), 16, 0, 0); } while (0)
#define PG8_LDA(dst, b, h) do { _Pragma("unroll") for (int m = 0; m < 4; ++m) _Pragma("unroll") for (int k = 0; k < 2; ++k) dst[m][k] = *(const PG8_LAS bf16x8*)(lds + PG8_SA(b, h) + aoff + m * 2048 + k * 1024); } while (0)
#define PG8_LDB(dst, b, h) do { _Pragma("unroll") for (int n = 0; n < 2; ++n) _Pragma("unroll") for (int k = 0; k < 2; ++k) dst[n][k] = *(const PG8_LAS bf16x8*)(lds + PG8_SB(b, h) + boff + n * 2048 + k * 1024); } while (0)
#define PG8_MMA(ai, bj, At, Bt) do { __builtin_amdgcn_s_setprio(1); _Pragma("unroll") for (int m = 0; m < 4; ++m) _Pragma("unroll") for (int n = 0; n < 2; ++n) _Pragma("unroll") for (int k = 0; k < 2; ++k) \
    acc[ai][bj][m][n] = __builtin_amdgcn_mfma_f32_16x16x32_bf16(Bt[n][k], At[m][k], acc[ai][bj][m][n], 0, 0, 0); __builtin_amdgcn_s_setprio(0); } while (0)
#define PG8_WAIT_V(n) asm volatile("s_waitcnt vmcnt(" #n ")" ::: "memory")
#define PG8_WAIT_L(n) asm volatile("s_waitcnt lgkmcnt(" #n ")" ::: "memory")
#define PG8_BAR __builtin_amdgcn_s_barrier()
#define PG8_SCHED __builtin_amdgcn_sched_barrier(0)
  Unit cur, nxt; int ui = 0;
  if (!S.next(0, cur)) return;
  f32x4 acc[2][2][4][2];
#pragma unroll
  for (int a = 0; a < 2; ++a)
#pragma unroll
    for (int b = 0; b < 2; ++b)
#pragma unroll
      for (int m = 0; m < 4; ++m)
#pragma unroll
        for (int n = 0; n < 2; ++n) acc[a][b][m][n] = (f32x4){0.f, 0.f, 0.f, 0.f};
  bf16x8 At[4][2], B0[2][2], B1[2][2];
  const char* cA = (const char*)g.A + (size_t)cur.pm * tstep; const char* cB = (const char*)g.Bt + (size_t)cur.pn * tstep;
  PG8_STAGE(PG8_SB(0, 0), cB, voffB); PG8_STAGE(PG8_SA(0, 0), cA, voffA); PG8_STAGE(PG8_SB(0, 1), cB + hstep, voffB); PG8_STAGE(PG8_SA(0, 1), cA + hstep, voffA);
  if (wr == 1) PG8_BAR;
  PG8_WAIT_V(4); PG8_BAR;
  PG8_STAGE(PG8_SB(1, 0), cB + kstep, voffB); PG8_STAGE(PG8_SA(1, 0), cA + kstep, voffA); PG8_STAGE(PG8_SB(1, 1), cB + hstep + kstep, voffB);
  PG8_WAIT_V(6); PG8_BAR;
  for (;;) {
    const bool has_next = S.next(ui + 1, nxt);
    const char* nA = has_next ? (const char*)g.A + (size_t)nxt.pm * tstep : cA; const char* nB = has_next ? (const char*)g.Bt + (size_t)nxt.pn * tstep : cB;
    for (int t = 0; t < nt; t += 2) {
      const bool last = (t == nt - 2);
      const char* a1 = cA + (size_t)(t + 1) * kstep;
      const char* a2 = last ? nA : cA + (size_t)(t + 2) * kstep; const char* b2 = last ? nB : cB + (size_t)(t + 2) * kstep;
      const char* a3 = a2 + kstep; const char* b3 = b2 + kstep;
      PG8_LDB(B0, 0, 0); PG8_SCHED; PG8_LDA(At, 0, 0); PG8_STAGE(PG8_SA(1, 1), a1 + hstep, voffA);
      PG8_WAIT_L(8); PG8_BAR; PG8_WAIT_L(0); PG8_MMA(0, 0, At, B0); PG8_BAR; PG8_SCHED;
      PG8_LDB(B1, 0, 1); PG8_STAGE(PG8_SB(0, 0), b2, voffB);
      PG8_BAR; PG8_WAIT_L(0); PG8_MMA(0, 1, At, B1); PG8_BAR;
      PG8_LDA(At, 0, 1); PG8_STAGE(PG8_SA(0, 0), a2, voffA);
      PG8_BAR; PG8_WAIT_L(0); PG8_MMA(1, 0, At, B0); PG8_BAR; PG8_SCHED;
      PG8_STAGE(PG8_SB(0, 1), b2 + hstep, voffB);
      PG8_WAIT_V(6); PG8_BAR; PG8_MMA(1, 1, At, B1); PG8_BAR;
      PG8_LDB(B0, 1, 0); PG8_SCHED; PG8_LDA(At, 1, 0); PG8_STAGE(PG8_SA(0, 1), a2 + hstep, voffA);
      PG8_WAIT_L(8); PG8_BAR; PG8_WAIT_L(0); PG8_MMA(0, 0, At, B0); PG8_BAR; PG8_SCHED;
      PG8_LDB(B1, 1, 1); PG8_STAGE(PG8_SB(1, 0), b3, voffB);
      PG8_BAR; PG8_WAIT_L(0); PG8_MMA(0, 1, At, B1); PG8_BAR;
      PG8_LDA(At, 1, 1); PG8_STAGE(PG8_SA(1, 0), a3, voffA);
      PG8_BAR; PG8_WAIT_L(0); PG8_MMA(1, 0, At, B0); PG8_BAR; PG8_SCHED;
      PG8_STAGE(PG8_SB(1, 1), b3 + hstep, voffB);
      PG8_WAIT_V(6); PG8_BAR; PG8_MMA(1, 1, At, B1); PG8_BAR;
    }
    E(acc, cur, wr, wc, fr, fq);
    if (PROBE == 10) { asm volatile("" ::: "memory"); E(acc, cur, wr, wc, fr, fq); }
    if (!has_next) break;
#pragma unroll
    for (int a = 0; a < 2; ++a)
#pragma unroll
      for (int b = 0; b < 2; ++b)
#pragma unroll
        for (int m = 0; m < 4; ++m)
#pragma unroll
          for (int n = 0; n < 2; ++n) acc[a][b][m][n] = (f32x4){0.f, 0.f, 0.f, 0.f};
    cur = nxt; cA = nA; cB = nB; ++ui;
  }
  PG8_WAIT_V(0);
  if (wr == 0) PG8_BAR;
  PG8_BAR;
#undef PG8_SA
#undef PG8_SB
#undef PG8_STAGE
#undef PG8_LDA
#undef PG8_LDB
#undef PG8_MMA
#undef PG8_WAIT_V
#undef PG8_WAIT_L
#undef PG8_BAR
#undef PG8_SCHED
}
}

template <int ACT>
DI void gemm_run(const bf16_t* A, const bf16_t* Bt, int N, int K, bf16_t* C, int ldc, char* smem) {
  pg8::Gemm g; g.A = A; g.Bt = Bt; g.M = T_TOK; g.N = N; g.K = K;
  pg8::StaticOrder S; S.init(T_TOK, N, (int)gridDim.x, (int)blockIdx.x);
  pg8::EpiB<ACT> E; E.O = C; E.ldc = ldc;
#ifndef STAGGER_TICKS
#define STAGGER_TICKS 0
#endif
  if (K <= 1024 && STAGGER_TICKS > 0) {
    const unsigned long long t0 = __builtin_amdgcn_s_memrealtime();
    const unsigned long long d = (unsigned long long)(((blockIdx.x >> 3) & 3) * STAGGER_TICKS);
    while (__builtin_amdgcn_s_memrealtime() - t0 < d) __builtin_amdgcn_s_sleep(8);
  }
  pg8::gemm_phase(( PG8_LAS unsigned char*)smem, g, S, E);
  __syncthreads();
}

DI void gla_gates(const Params& P, const bf16_t* proj, int b, int h, int n, float* sb, float* sseg, float* tmp) {
  const int tid = TIDX & 255;
  float* sw = tmp;
  float* sg = tmp + 1024;
  {
    for (int e = tid; e < 1024; e += 256) sw[e] = P.gla_w_gate[(e >> 6) * 256 + h * 64 + (e & 63)];
    const int i = tid >> 2, part = tid & 3;
    const size_t t = (size_t)b * SEQ + n * 64 + i;
    const u32x2 gu = *(const u32x2*)(proj + t * PW + C_GLR + part * 4);
    sg[i * 17 + part * 4 + 0] = bflo(gu[0]); sg[i * 17 + part * 4 + 1] = bfhi(gu[0]);
    sg[i * 17 + part * 4 + 2] = bflo(gu[1]); sg[i * 17 + part * 4 + 3] = bfhi(gu[1]);
  }
  __syncthreads();
  {
    const int i = tid & 63, dq = tid >> 6;
    float z[16];
#pragma unroll
    for (int dd = 0; dd < 16; ++dd) z[dd] = P.gla_b_gate[h * 64 + dq * 16 + dd];
#pragma unroll 1
    for (int r = 0; r < 16; ++r) {
      const float gv = sg[i * 17 + r];
#pragma unroll
      for (int dd = 0; dd < 16; ++dd) z[dd] += gv * sw[r * 64 + dq * 16 + dd];
    }
#pragma unroll
    for (int dd = 0; dd < 16; ++dd) {
      const float zz = z[dd];
      const float ls = fminf(zz, 0.f) - __logf(1.f + __expf(-fabsf(zz)));
      sb[i * 65 + dq * 16 + dd] = ls * (1.f / 16.f);
    }
  }
  __syncthreads();
  const int d = tid & 63, seg = tid >> 6;
  float pre[16]; float run = 0.f;
#pragma unroll
  for (int ii = 0; ii < 16; ++ii) { run += sb[(seg * 16 + ii) * 65 + d]; pre[ii] = run; }
  sseg[seg * 64 + d] = run;
  __syncthreads();
  float off = 0.f;
#pragma unroll
  for (int s = 0; s < 4; ++s) off += (s < seg) ? sseg[s * 64 + d] : 0.f;
#pragma unroll
  for (int ii = 0; ii < 16; ++ii) sb[(seg * 16 + ii) * 65 + d] = pre[ii] + off;
  __syncthreads();
}

struct VRegs { u32x4 u[4]; };
DI void gla_load_v(const bf16_t* proj, int b, int h, int n, VRegs& vr) {
  const int tid = TIDX & 255, j = tid & 63, q4 = tid >> 6;
  const size_t t = (size_t)b * SEQ + n * 64 + j;
  const bf16_t* src = proj + t * PW + C_GV + h * 128 + q4 * 32;
#pragma unroll
  for (int c = 0; c < 4; ++c) vr.u[c] = *(const u32x4*)(src + c * 8);
}
DI void gla_store_vT(const VRegs& vr, bf16_t* vT) {
  const int tid = TIDX & 255, j = tid & 63, q4 = tid >> 6;
#pragma unroll
  for (int c = 0; c < 4; ++c) {
#pragma unroll
    for (int e = 0; e < 4; ++e) {
      vT[(q4 * 32 + c * 8 + 2 * e) * 72 + j] = (bf16_t)(vr.u[c][e] & 0xffffu);
      vT[(q4 * 32 + c * 8 + 2 * e + 1) * 72 + j] = (bf16_t)(vr.u[c][e] >> 16);
    }
  }
}

DI void gla_p1_item(const Params& P, int item, char* smem) {
  const bf16_t* proj = (const bf16_t*)(P.ws + R1);
  bf16_t* states = (bf16_t*)(P.ws + R2);
  float* decay = (float*)(P.ws + R_DECAY);
  float* sb = (float*)smem; float* sseg = sb + 64 * 65;
  bf16_t* kendT = (bf16_t*)(sseg + 256); bf16_t* vT = kendT + 64 * 72;
  const int n = item & 127, h = (item >> 7) & 3, b = item >> 9;
  const int tid = TIDX & 255, lane = tid & 63, wave = tid >> 6, l32 = lane & 31, kb = lane >> 5;
  VRegs vr; gla_load_v(proj, b, h, n, vr);
  u32x4 k0, k1;
  {
    const int j = tid & 63, dq = tid >> 6;
    const size_t t = (size_t)b * SEQ + n * 64 + j;
    k0 = *(const u32x4*)(proj + t * PW + C_GK + h * 64 + dq * 16); k1 = *(const u32x4*)(proj + t * PW + C_GK + h * 64 + dq * 16 + 8);
  }
  gla_gates(P, proj, b, h, n, sb, sseg, (float*)vT);
  {
    const int j = tid & 63, dq = tid >> 6;
    float kv[16];
#pragma unroll
    for (int e = 0; e < 4; ++e) { kv[2 * e] = bflo(k0[e]); kv[2 * e + 1] = bfhi(k0[e]); kv[8 + 2 * e] = bflo(k1[e]); kv[8 + 2 * e + 1] = bfhi(k1[e]); }
#pragma unroll
    for (int dd = 0; dd < 16; ++dd) {
      const int d = dq * 16 + dd;
      kendT[d * 72 + j] = f2bf(kv[dd] * __expf(sb[63 * 65 + d] - sb[j * 65 + d]));
    }
    if (tid < 64) decay[((size_t)(b * 4 + h) * 128 + n) * 64 + tid] = __expf(sb[63 * 65 + tid]);
  }
  gla_store_vT(vr, vT);
  __syncthreads();
#pragma unroll
  for (int dt = 0; dt < 2; ++dt) {
    f32x16 acc = zero16();
#pragma unroll
    for (int s = 0; s < 4; ++s) {
      const bf16x8 a = *(const bf16x8*)(vT + (wave * 32 + l32) * 72 + s * 16 + kb * 8);
      const bf16x8 bb = *(const bf16x8*)(kendT + (dt * 32 + l32) * 72 + s * 16 + kb * 8);
      acc = mfma(a, bb, acc);
    }
    bf16_t* dst = states + ((size_t)((b * 4 + h) * 128 + n) * 128) * 64;
#pragma unroll
    for (int r = 0; r < 16; ++r) dst[(size_t)(wave * 32 + crow(r, kb)) * 64 + dt * 32 + l32] = f2bf(acc[r]);
  }
  __syncthreads();
}

DI void gla_scan(const Params& P) {
  bf16_t* states = (bf16_t*)(P.ws + R2);
  const float* decay = (const float*)(P.ws + R_DECAY);
  const int total = 32 * 4096;
  for (int e = blockIdx.x * blockDim.x + TIDX; e < total; e += gridDim.x * blockDim.x) {
    const int bh = e >> 12, idx = (e & 4095) * 2, d = idx & 63;
    bf16_t* p = states + (size_t)bh * 128 * 8192 + idx;
    const float* dc = decay + (size_t)bh * 128 * 64 + d;
    float S0 = 0.f, S1 = 0.f;
#pragma unroll 8
    for (int n = 0; n < 128; ++n) {
      const unsigned ds = *(const unsigned*)(p + (size_t)n * 8192);
      const float2 dec = *(const float2*)(dc + n * 64);
      *(unsigned*)(p + (size_t)n * 8192) = pk2(S0, S1);
      S0 = dec.x * S0 + bflo(ds); S1 = dec.y * S1 + bfhi(ds);
    }
  }
}

DI void gla_p3_item(const Params& P, int item, char* smem) {
  const bf16_t* proj = (const bf16_t*)(P.ws + R1);
  const bf16_t* states = (const bf16_t*)(P.ws + R2);
  bf16_t* mix = (bf16_t*)(P.ws + R3);
  float* sb = (float*)smem; float* sseg = sb + 64 * 65; float* sred = sseg + 256;
  bf16_t* sq = (bf16_t*)(sred + 256); bf16_t* sk = sq + 64 * 72; bf16_t* vT = sk + 64 * 72;
  const int n = item & 127, h = (item >> 7) & 3, b = item >> 9;
  const int tid = TIDX & 255, lane = tid & 63, wave = tid >> 6, l32 = lane & 31, kb = lane >> 5;
  VRegs vr; gla_load_v(proj, b, h, n, vr);
  u32x4 q0, q1, k0, k1;
  bf16x8 sf[4];
  {
    const int i = tid & 63, dq = tid >> 6;
    const size_t t = (size_t)b * SEQ + n * 64 + i;
    q0 = *(const u32x4*)(proj + t * PW + C_GQ + h * 64 + dq * 16); q1 = *(const u32x4*)(proj + t * PW + C_GQ + h * 64 + dq * 16 + 8);
    k0 = *(const u32x4*)(proj + t * PW + C_GK + h * 64 + dq * 16); k1 = *(const u32x4*)(proj + t * PW + C_GK + h * 64 + dq * 16 + 8);
    const bf16_t* sp = states + ((size_t)((b * 4 + h) * 128 + n) * 128 + wave * 32 + l32) * 64;
#pragma unroll
    for (int s4 = 0; s4 < 4; ++s4) sf[s4] = *(const bf16x8*)(sp + s4 * 16 + kb * 8);
  }
  gla_gates(P, proj, b, h, n, sb, sseg, (float*)vT);
  {
    const int i = tid & 63, dq = tid >> 6;
    float qv[16], kv[16];
#pragma unroll
    for (int e = 0; e < 4; ++e) {
      qv[2 * e] = bflo(q0[e]); qv[2 * e + 1] = bfhi(q0[e]); qv[8 + 2 * e] = bflo(q1[e]); qv[8 + 2 * e + 1] = bfhi(q1[e]);
      kv[2 * e] = bflo(k0[e]); kv[2 * e + 1] = bfhi(k0[e]); kv[8 + 2 * e] = bflo(k1[e]); kv[8 + 2 * e + 1] = bfhi(k1[e]);
    }
#pragma unroll
    for (int dd = 0; dd < 16; ++dd) {
      const int d = dq * 16 + dd;
      const float bb = sb[i * 65 + d];
      sq[i * 72 + d] = f2bf(qv[dd] * 0.125f * __expf(bb));
      sk[i * 72 + d] = f2bf(kv[dd] * __expf(-bb));
    }
  }
  gla_store_vT(vr, vT);
  __syncthreads();
  f32x16 x00 = zero16(), x01 = zero16(), x11 = zero16();
#pragma unroll
  for (int s = 0; s < 4; ++s) {
    const bf16x8 kj0 = *(const bf16x8*)(sk + (l32)*72 + s * 16 + kb * 8);
    const bf16x8 kj1 = *(const bf16x8*)(sk + (32 + l32) * 72 + s * 16 + kb * 8);
    const bf16x8 qi0 = *(const bf16x8*)(sq + (l32)*72 + s * 16 + kb * 8);
    const bf16x8 qi1 = *(const bf16x8*)(sq + (32 + l32) * 72 + s * 16 + kb * 8);
    x00 = mfma(kj0, qi0, x00); x01 = mfma(kj0, qi1, x01); x11 = mfma(kj1, qi1, x11);
  }
#pragma unroll
  for (int r = 0; r < 16; ++r) { const bool keep = crow(r, kb) <= l32; x00[r] = keep ? x00[r] : 0.f; x11[r] = keep ? x11[r] : 0.f; }
  f32x16 o0 = zero16(), o1 = zero16();
  const int dvr = wave * 32 + l32;
#pragma unroll
  for (int s = 0; s < 2; ++s) {
    const bf16x8 p00 = pack8(x00[8 * s], x00[8 * s + 1], x00[8 * s + 2], x00[8 * s + 3], x00[8 * s + 4], x00[8 * s + 5], x00[8 * s + 6], x00[8 * s + 7]);
    const bf16x8 p01 = pack8(x01[8 * s], x01[8 * s + 1], x01[8 * s + 2], x01[8 * s + 3], x01[8 * s + 4], x01[8 * s + 5], x01[8 * s + 6], x01[8 * s + 7]);
    const bf16x8 p11 = pack8(x11[8 * s], x11[8 * s + 1], x11[8 * s + 2], x11[8 * s + 3], x11[8 * s + 4], x11[8 * s + 5], x11[8 * s + 6], x11[8 * s + 7]);
    const bf16x8 v0 = ld2x4(vT + dvr * 72 + 16 * s + 4 * kb);
    const bf16x8 v1 = ld2x4(vT + dvr * 72 + 32 + 16 * s + 4 * kb);
    o0 = mfma(v0, p00, o0); o1 = mfma(v0, p01, o1); o1 = mfma(v1, p11, o1);
  }
  {
#pragma unroll
    for (int s = 0; s < 4; ++s) {
      const bf16x8 a = sf[s];
      const bf16x8 qi0 = *(const bf16x8*)(sq + (l32)*72 + s * 16 + kb * 8);
      const bf16x8 qi1 = *(const bf16x8*)(sq + (32 + l32) * 72 + s * 16 + kb * 8);
      o0 = mfma(a, qi0, o0); o1 = mfma(a, qi1, o1);
    }
  }
  float s0 = 0.f, s1 = 0.f;
#pragma unroll
  for (int r = 0; r < 16; ++r) { s0 += o0[r] * o0[r]; s1 += o1[r] * o1[r]; }
  s0 += __shfl_xor(s0, 32); s1 += __shfl_xor(s1, 32);
  if (kb == 0) { sred[wave * 64 + l32] = s0; sred[wave * 64 + 32 + l32] = s1; }
  __syncthreads();
  const float t0s = sred[l32] + sred[64 + l32] + sred[128 + l32] + sred[192 + l32];
  const float t1s = sred[32 + l32] + sred[64 + 32 + l32] + sred[128 + 32 + l32] + sred[192 + 32 + l32];
  const float r0 = rsqrtf(t0s * (1.f / 128.f) + EPS), r1 = rsqrtf(t1s * (1.f / 128.f) + EPS);
#pragma unroll
  for (int it = 0; it < 2; ++it) {
    const size_t t = (size_t)b * SEQ + n * 64 + it * 32 + l32;
    const float rr = it ? r1 : r0;
#pragma unroll
    for (int gq = 0; gq < 4; ++gq) {
      const int dv = wave * 32 + 8 * gq + 4 * kb;
      const u32x2 ru = *(const u32x2*)(proj + t * PW + C_GR + h * 128 + dv);
      const float4 gn = *(const float4*)(P.gla_norm + h * 128 + dv);
      float rv[4] = {bflo(ru[0]), bfhi(ru[0]), bflo(ru[1]), bfhi(ru[1])};
      float gv[4] = {gn.x, gn.y, gn.z, gn.w};
      float ov[4];
#pragma unroll
      for (int e = 0; e < 4; ++e) {
        const float a = it ? o1[gq * 4 + e] : o0[gq * 4 + e];
        ov[e] = a * rr * gv[e] * (rv[e] * frcp(1.f + __expf(-rv[e])));
      }
      u32x2 o; o[0] = pk2(ov[0], ov[1]); o[1] = pk2(ov[2], ov[3]);
      *(u32x2*)(mix + t * DM + h * 128 + dv) = o;
    }
  }
  __syncthreads();
}

DI void nsa_compress_task(const Params& P, int task) {
  const bf16_t* proj = (const bf16_t*)(P.ws + R1);
  const int lane = TIDX & 63, l32 = lane & 31, kb = lane >> 5;
  const int ct = task & 15, g = (task >> 4) & 1, b = (task >> 5) & 7, br = task >> 8;
  const bf16_t* w1T = (const bf16_t*)(P.ws + W_CW1) + (size_t)br * 128 * 2048;
  const bf16_t* w2T = (const bf16_t*)(P.ws + W_CW2) + (size_t)br * 64 * 128;
  const float* bias1 = (const float*)(P.ws + W_BIAS1) + br * 128;
  const int c = ct * 32 + l32;
  const int cc = c < 511 ? c : 510;
  const bf16_t* src = proj + ((size_t)b * SEQ + cc * 16) * PW + (br ? C_VC : C_KC) + g * 64 + kb * 8;
  f32x16 acc[4];
#pragma unroll
  for (int i = 0; i < 4; ++i) acc[i] = zero16();
#pragma unroll 1
  for (int ks = 0; ks < 128; ++ks) {
    const int l = ks >> 2, dh0 = (ks & 3) * 16;
    const bf16x8 bf = *(const bf16x8*)(src + (size_t)l * PW + dh0);
#pragma unroll
    for (int ht = 0; ht < 4; ++ht) {
      const bf16x8 af = *(const bf16x8*)(w1T + (size_t)(ht * 32 + l32) * 2048 + ks * 16 + kb * 8);
      acc[ht] = mfma(af, bf, acc[ht]);
    }
  }
#pragma unroll
  for (int ht = 0; ht < 4; ++ht)
#pragma unroll
    for (int r = 0; r < 16; ++r) acc[ht][r] = gelu_tanh(acc[ht][r] + bias1[ht * 32 + crow(r, kb)]);
  f32x16 o[2]; o[0] = zero16(); o[1] = zero16();
#pragma unroll
  for (int ht = 0; ht < 4; ++ht)
#pragma unroll
    for (int s = 0; s < 2; ++s) {
      const bf16x8 hf = pack8(acc[ht][8 * s], acc[ht][8 * s + 1], acc[ht][8 * s + 2], acc[ht][8 * s + 3], acc[ht][8 * s + 4], acc[ht][8 * s + 5], acc[ht][8 * s + 6], acc[ht][8 * s + 7]);
#pragma unroll
      for (int dt = 0; dt < 2; ++dt) {
        const bf16x8 wf = ld2x4(w2T + (size_t)(dt * 32 + l32) * 128 + ht * 32 + 16 * s + 4 * kb);
        o[dt] = mfma(wf, hf, o[dt]);
      }
    }
  if (c < 511) {
    {
      bf16_t* dst = (bf16_t*)(P.ws + (br ? R_VCMPT : R_KCMP)) + ((size_t)(b * 2 + g) * 512 + c) * 64;
#pragma unroll
      for (int dt = 0; dt < 2; ++dt)
#pragma unroll
        for (int gq = 0; gq < 4; ++gq) {
          u32x2 u; u[0] = pk2(o[dt][gq * 4], o[dt][gq * 4 + 1]); u[1] = pk2(o[dt][gq * 4 + 2], o[dt][gq * 4 + 3]);
          *(u32x2*)(dst + dt * 32 + 8 * gq + 4 * kb) = u;
        }
    }
  }
}

DI void nsa_transpose_v(const Params& P) {
  const bf16_t* proj = (const bf16_t*)(P.ws + R1);
  const int total = 2 * 8 * 2 * 1024 * 64;
  for (int u = blockIdx.x * blockDim.x + TIDX; u < total; u += gridDim.x * blockDim.x) {
    const int dh = u & 63; int rest = u >> 6; const int t8 = rest & 1023; rest >>= 10;
    const int g = rest & 1, b = (rest >> 1) & 7, which = rest >> 4;
    const bf16_t* src = proj + ((size_t)b * SEQ + t8 * 8) * PW + (which ? C_VW : C_VS) + g * 64 + dh;
    bf16_t v[8];
#pragma unroll
    for (int j = 0; j < 8; ++j) v[j] = src[(size_t)j * PW];
    u32x4 o;
#pragma unroll
    for (int j = 0; j < 4; ++j) o[j] = (unsigned)v[2 * j] | ((unsigned)v[2 * j + 1] << 16);
    bf16_t* dst = (bf16_t*)(P.ws + (which ? R_VWT : R_VST)) + ((size_t)(b * 2 + g) * 64 + dh) * SEQ + t8 * 8;
    *(u32x4*)dst = o;
  }
}

DI f32x16 qk_tile(const bf16_t* krow, const bf16x8 (&qf)[4]) {
  f32x16 s = zero16();
#pragma unroll
  for (int i = 0; i < 4; ++i) { const bf16x8 kf = *(const bf16x8*)(krow + i * 16); s = mfma(kf, qf[i], s); }
  return s;
}

DI float half_max(float x) {
  const auto r = __builtin_amdgcn_permlane32_swap(__float_as_uint(x), __float_as_uint(x), false, false);
  return fmaxf(__uint_as_float(r[0]), __uint_as_float(r[1]));
}
DI float half_sum(float x) {
  const auto r = __builtin_amdgcn_permlane32_swap(__float_as_uint(x), __float_as_uint(x), false, false);
  return __uint_as_float(r[0]) + __uint_as_float(r[1]);
}
DI s16x4 lds_tr(const char* p) { return __builtin_amdgcn_ds_read_tr16_b64_v4i16((__attribute__((address_space(3))) s16x4*)p); }

template <bool EDGE>
DI void softmax_tile(f32x16& s, int k0, int tq, int lo, bool bit, int kb, f32x16& o0, f32x16& o1, float& m, float& l) {
  constexpr float CS = 0.125f * 1.4426950408889634f;
  float tmax = -1e30f;
  if (EDGE) {
#pragma unroll
    for (int r = 0; r < 16; ++r) {
      const int key = k0 + crow(r, kb);
      const bool vd = (key <= tq) && (key > lo);
      s[r] = vd ? s[r] * CS : -1e30f;
      tmax = fmaxf(tmax, s[r]);
    }
  } else {
#pragma unroll
    for (int r = 0; r < 16; ++r) tmax = fmaxf(tmax, s[r]);
    tmax *= CS;
  }
  tmax = bit ? tmax : -1e30f;
  tmax = half_max(tmax);
  if (__ballot(tmax > m + 8.0f) != 0ull) {
    const float mn = fmaxf(m, tmax);
    const float alpha = __builtin_amdgcn_exp2f(m - mn);
    l *= alpha; m = mn;
#pragma unroll
    for (int r = 0; r < 16; ++r) { o0[r] *= alpha; o1[r] *= alpha; }
  }
  float ps = 0.f;
  if (EDGE) {
    const bool live = bit && (m > -5e29f);
#pragma unroll
    for (int r = 0; r < 16; ++r) {
      const float e = __builtin_amdgcn_exp2f(s[r] - m);
      s[r] = live ? e : 0.f;
      ps += s[r];
    }
  } else {
    const float me = bit ? m : 1e30f;
#pragma unroll
    for (int r = 0; r < 16; ++r) {
      s[r] = __builtin_amdgcn_exp2f(__builtin_fmaf(s[r], CS, -me));
      ps += s[r];
    }
  }
  l += ps;
}

struct HeadAcc { f32x16 o0, o1; float m, l; };

template <bool EDGE>
DI void attn_step2(const bf16_t* sKt, const char* sVt, const bf16x8 (&qa)[4], const bf16x8 (&qb)[4], int k0, int tq, int lo, bool bit,
                   int lane, HeadAcc& A, HeadAcc& B) {
  const int l32 = lane & 31, kb = lane >> 5, i16 = lane & 15, q = i16 >> 2, p = i16 & 3, gc = (lane >> 4) & 1;
  f32x16 sa = zero16(), sb = zero16();
#pragma unroll
  for (int i = 0; i < 4; ++i) {
    const bf16x8 kf = *(const bf16x8*)(sKt + l32 * 72 + i * 16 + kb * 8);
    sa = mfma(kf, qa[i], sa); sb = mfma(kf, qb[i], sb);
  }
  bf16x8 vf[2][2];
#pragma unroll
  for (int dt = 0; dt < 2; ++dt)
#pragma unroll
    for (int sI = 0; sI < 2; ++sI) {
      const char* vp = sVt + (16 * sI + 4 * kb + q) * 144 + (dt * 32 + gc * 16 + 4 * p) * 2;
      const s16x4 lo4 = lds_tr(vp), hi4 = lds_tr(vp + 8 * 144);
      vf[dt][sI] = __builtin_shufflevector(lo4, hi4, 0, 1, 2, 3, 4, 5, 6, 7);
    }
  softmax_tile<EDGE>(sa, k0, tq, lo, bit, kb, A.o0, A.o1, A.m, A.l);
  softmax_tile<EDGE>(sb, k0, tq, lo, bit, kb, B.o0, B.o1, B.m, B.l);
#pragma unroll
  for (int sI = 0; sI < 2; ++sI) {
    const bf16x8 pa = pack8(sa[8 * sI], sa[8 * sI + 1], sa[8 * sI + 2], sa[8 * sI + 3], sa[8 * sI + 4], sa[8 * sI + 5], sa[8 * sI + 6], sa[8 * sI + 7]);
    const bf16x8 pb = pack8(sb[8 * sI], sb[8 * sI + 1], sb[8 * sI + 2], sb[8 * sI + 3], sb[8 * sI + 4], sb[8 * sI + 5], sb[8 * sI + 6], sb[8 * sI + 7]);
    A.o0 = mfma(vf[0][sI], pa, A.o0); A.o1 = mfma(vf[1][sI], pa, A.o1);
    B.o0 = mfma(vf[0][sI], pb, B.o0); B.o1 = mfma(vf[1][sI], pb, B.o1);
  }
}

template <bool WIN>
DI void nsa_branch2(const bf16_t* kbase, const bf16_t* vbase, char* smem, int st0, int st1, int qt, int tq, const bf16x8 (&qa)[4],
                    const bf16x8 (&qb)[4], unsigned mk0, unsigned mk1, unsigned mk2, unsigned mk3, HeadAcc& A, HeadAcc& B) {
  const int tid = TIDX, lane = tid & 63;
  const int srow = tid >> 3, schunk = (tid & 7) * 8;
  const bf16_t* kg = kbase + (size_t)srow * PW + schunk;
  const bf16_t* vg = vbase + (size_t)srow * PW + schunk;
  const int soff = (srow * 72 + schunk) * 2;
  u32x4 rk = *(const u32x4*)(kg + (size_t)st0 * 64 * PW), rv = *(const u32x4*)(vg + (size_t)st0 * 64 * PW);
  *(u32x4*)(smem + soff) = rk; *(u32x4*)(smem + 9216 + soff) = rv;
  __syncthreads();
  for (int st = st0; st <= st1; ++st) {
    const int cur = (st - st0) & 1;
    if (st < st1) { rk = *(const u32x4*)(kg + (size_t)(st + 1) * 64 * PW); rv = *(const u32x4*)(vg + (size_t)(st + 1) * 64 * PW); }
    const bf16_t* bK = (const bf16_t*)(smem + cur * 18432);
    const char* bV = smem + cur * 18432 + 9216;
    bool bit = true;
    if (!WIN) { const unsigned mw = st < 32 ? mk0 : (st < 64 ? mk1 : (st < 96 ? mk2 : mk3)); bit = (mw >> (st & 31)) & 1u; }
    const bool any = WIN ? true : (__ballot(bit) != 0ull);
#pragma unroll
    for (int tt = 0; tt < 2; ++tt) {
      const int kt = 2 * st + tt;
      const bool in_range = WIN ? (kt <= qt && kt >= qt - 16) : (kt <= qt);
      if (in_range && any) {
        const bool edge = WIN ? (kt == qt || kt == qt - 16) : (kt == qt);
        if (edge) attn_step2<true>(bK + tt * 32 * 72, bV + tt * 32 * 144, qa, qb, kt * 32, tq, WIN ? tq - 512 : -1, bit, lane, A, B);
        else attn_step2<false>(bK + tt * 32 * 72, bV + tt * 32 * 144, qa, qb, kt * 32, tq, WIN ? tq - 512 : -1, bit, lane, A, B);
      }
    }
    if (st < st1) { *(u32x4*)(smem + (cur ^ 1) * 18432 + soff) = rk; *(u32x4*)(smem + (cur ^ 1) * 18432 + 9216 + soff) = rv; }
    __syncthreads();
  }
}

DI void fold_partial(bf16_t* dst, float f, const f32x16& a0, const f32x16& a1, int kb) {
#pragma unroll
  for (int gq = 0; gq < 4; ++gq) {
    bf16_t* d0 = dst + 8 * gq + 4 * kb;
    bf16_t* d1 = d0 + 32;
    const u32x2 p0 = *(const u32x2*)d0, p1 = *(const u32x2*)d1;
    u32x2 u0, u1;
    u0[0] = pk2(bflo(p0[0]) + f * a0[gq * 4], bfhi(p0[0]) + f * a0[gq * 4 + 1]);
    u0[1] = pk2(bflo(p0[1]) + f * a0[gq * 4 + 2], bfhi(p0[1]) + f * a0[gq * 4 + 3]);
    u1[0] = pk2(bflo(p1[0]) + f * a1[gq * 4], bfhi(p1[0]) + f * a1[gq * 4 + 1]);
    u1[1] = pk2(bflo(p1[1]) + f * a1[gq * 4 + 2], bfhi(p1[1]) + f * a1[gq * 4 + 3]);
    *(u32x2*)d0 = u0; *(u32x2*)d1 = u1;
  }
}

DI void nsa_block(const Params& P, int b, int g, int qb, char* smem) {
  const int wv = __builtin_amdgcn_readfirstlane(TIDX >> 6);
  const int qt = qb * 8 + wv;
  float* imp = (float*)smem + wv * 4096;
  const bf16_t* proj = (const bf16_t*)(P.ws + R1);
  bf16_t* mix = (bf16_t*)(P.ws + R3);
  const int lane = TIDX & 63, l32 = lane & 31, kb = lane >> 5;
  const int t0 = qt * 32, tq = t0 + l32;
  const size_t tokq = (size_t)b * SEQ + tq;
  const bf16_t* qrow = proj + tokq * PW;
  const bf16_t* kcmp = (const bf16_t*)(P.ws + R_KCMP) + (size_t)(b * 2 + g) * 512 * 64;
  const bf16_t* vcmp = (const bf16_t*)(P.ws + R_VCMPT) + (size_t)(b * 2 + g) * 512 * 64;
  const int nct = (qb >> 1) + 1;
  const int nst = (nct + 1) >> 1;
  for (int i = lane; i < 4096; i += 64) imp[i] = 0.f;
  {
    constexpr float CS = 0.125f * 1.4426950408889634f;
    char* stg = smem + LDS_CMP_STAGE;
    const int tid = TIDX;
    const int srow = tid >> 3, schunk = (tid & 7) * 8, soff = (srow * 72 + schunk) * 2;
    const int i16 = lane & 15, q4 = i16 >> 2, p4 = i16 & 3, gc = (lane >> 4) & 1;
#pragma unroll 1
    for (int hp = 0; hp < 2; ++hp) {
      const int head = g * 4 + hp * 2;
      bf16x8 qa[4], qb_[4];
#pragma unroll
      for (int i = 0; i < 4; ++i) {
        qa[i] = *(const bf16x8*)(qrow + C_NQ + head * 64 + i * 16 + kb * 8);
        qb_[i] = *(const bf16x8*)(qrow + C_NQ + (head + 1) * 64 + i * 16 + kb * 8);
      }
      float mA = -1e30f, lA = 0.f, mB = -1e30f, lB = 0.f;
      u32x4 rk = *(const u32x4*)(kcmp + (size_t)srow * 64 + schunk), rv;
      for (int st = 0; st < nst; ++st) {
        *(u32x4*)(stg + soff) = rk;
        __syncthreads();
        if (st + 1 < nst) rk = *(const u32x4*)(kcmp + (size_t)((st + 1) * 64 + srow) * 64 + schunk);
#pragma unroll
        for (int tt = 0; tt < 2; ++tt) {
          const int ct = 2 * st + tt;
          if (ct < nct) {
            const bf16_t* sKt = (const bf16_t*)stg + tt * 32 * 72;
            f32x16 sa = zero16(), sb = zero16();
#pragma unroll
            for (int i = 0; i < 4; ++i) {
              const bf16x8 kf = *(const bf16x8*)(sKt + l32 * 72 + i * 16 + kb * 8);
              sa = mfma(kf, qa[i], sa); sb = mfma(kf, qb_[i], sb);
            }
            float tA = -1e30f, tB = -1e30f;
#pragma unroll
            for (int r = 0; r < 16; ++r) {
              const int c = ct * 32 + crow(r, kb);
              const bool vd = (c * 16 + 31 <= tq);
              sa[r] = vd ? sa[r] * CS : -1e30f; sb[r] = vd ? sb[r] * CS : -1e30f;
              tA = fmaxf(tA, sa[r]); tB = fmaxf(tB, sb[r]);
            }
            const float nA = fmaxf(mA, tA), nB = fmaxf(mB, tB);
            float pA = 0.f, pB = 0.f;
#pragma unroll
            for (int r = 0; r < 16; ++r) {
              pA += (sa[r] > -5e29f) ? __builtin_amdgcn_exp2f(sa[r] - nA) : 0.f;
              pB += (sb[r] > -5e29f) ? __builtin_amdgcn_exp2f(sb[r] - nB) : 0.f;
            }
            lA = lA * __builtin_amdgcn_exp2f(mA - nA) + pA; mA = nA;
            lB = lB * __builtin_amdgcn_exp2f(mB - nB) + pB; mB = nB;
          }
        }
        __syncthreads();
      }
      float MA, iLA, MB, iLB;
      {
        const float mo = __shfl_xor(mA, 32), lo_ = __shfl_xor(lA, 32);
        MA = fmaxf(mA, mo);
        iLA = frcp(fmaxf(lA * __builtin_amdgcn_exp2f(mA - MA) + lo_ * __builtin_amdgcn_exp2f(mo - MA), 1e-30f));
        const float mo2 = __shfl_xor(mB, 32), lo2 = __shfl_xor(lB, 32);
        MB = fmaxf(mB, mo2);
        iLB = frcp(fmaxf(lB * __builtin_amdgcn_exp2f(mB - MB) + lo2 * __builtin_amdgcn_exp2f(mo2 - MB), 1e-30f));
      }
      f32x16 oA0 = zero16(), oA1 = zero16(), oB0 = zero16(), oB1 = zero16();
      float carry = 0.f;
      rk = *(const u32x4*)(kcmp + (size_t)srow * 64 + schunk); rv = *(const u32x4*)(vcmp + (size_t)srow * 64 + schunk);
      for (int st = 0; st < nst; ++st) {
        *(u32x4*)(stg + soff) = rk; *(u32x4*)(stg + 9216 + soff) = rv;
        __syncthreads();
        if (st + 1 < nst) {
          rk = *(const u32x4*)(kcmp + (size_t)((st + 1) * 64 + srow) * 64 + schunk);
          rv = *(const u32x4*)(vcmp + (size_t)((st + 1) * 64 + srow) * 64 + schunk);
        }
#pragma unroll
        for (int tt = 0; tt < 2; ++tt) {
          const int ct = 2 * st + tt;
          if (ct < nct) {
            const bf16_t* sKt = (const bf16_t*)stg + tt * 32 * 72;
            const char* sVt = stg + 9216 + tt * 32 * 144;
            f32x16 sa = zero16(), sb = zero16();
#pragma unroll
            for (int i = 0; i < 4; ++i) {
              const bf16x8 kf = *(const bf16x8*)(sKt + l32 * 72 + i * 16 + kb * 8);
              sa = mfma(kf, qa[i], sa); sb = mfma(kf, qb_[i], sb);
            }
            bf16x8 vf[2][2];
#pragma unroll
            for (int dt = 0; dt < 2; ++dt)
#pragma unroll
              for (int sI = 0; sI < 2; ++sI) {
                const char* vp = sVt + (16 * sI + 4 * kb + q4) * 144 + (dt * 32 + gc * 16 + 4 * p4) * 2;
                const s16x4 lo4 = lds_tr(vp), hi4 = lds_tr(vp + 8 * 144);
                vf[dt][sI] = __builtin_shufflevector(lo4, hi4, 0, 1, 2, 3, 4, 5, 6, 7);
              }
            f32x16 ps;
#pragma unroll
            for (int r = 0; r < 16; ++r) {
              const int c = ct * 32 + crow(r, kb);
              const bool vd = (c * 16 + 31 <= tq);
              sa[r] = vd ? __builtin_amdgcn_exp2f(__builtin_fmaf(sa[r], CS, -MA)) * iLA : 0.f;
              sb[r] = vd ? __builtin_amdgcn_exp2f(__builtin_fmaf(sb[r], CS, -MB)) * iLB : 0.f;
              ps[r] = sa[r] + sb[r];
            }
            float y[4];
#pragma unroll
            for (int gi = 0; gi < 4; ++gi) y[gi] = __shfl_xor(ps[4 * gi + 3], 32);
#pragma unroll
            for (int gi = 0; gi < 4; ++gi) {
              const float s4 = (ps[4 * gi] + ps[4 * gi + 1]) + (ps[4 * gi + 2] + ps[4 * gi + 3]);
              const float extra = kb ? y[gi] : (gi == 0 ? carry : y[gi > 0 ? gi - 1 : 0]);
              const int j = ct * 8 + 2 * gi + kb;
              imp[j * 32 + l32] += s4 + extra;
            }
            carry = y[3];
#pragma unroll
            for (int sI = 0; sI < 2; ++sI) {
              const bf16x8 pa = pack8(sa[8 * sI], sa[8 * sI + 1], sa[8 * sI + 2], sa[8 * sI + 3], sa[8 * sI + 4], sa[8 * sI + 5], sa[8 * sI + 6], sa[8 * sI + 7]);
              const bf16x8 pb = pack8(sb[8 * sI], sb[8 * sI + 1], sb[8 * sI + 2], sb[8 * sI + 3], sb[8 * sI + 4], sb[8 * sI + 5], sb[8 * sI + 6], sb[8 * sI + 7]);
              oA0 = mfma(vf[0][sI], pa, oA0); oA1 = mfma(vf[1][sI], pa, oA1);
              oB0 = mfma(vf[0][sI], pb, oB0); oB1 = mfma(vf[1][sI], pb, oB1);
            }
          }
        }
        __syncthreads();
      }
      const float gA = sigmoidf_(bf2f(qrow[C_NG + head * 3 + 0]) + P.nsa_gate_b[head * 3 + 0]);
      const float gB = sigmoidf_(bf2f(qrow[C_NG + (head + 1) * 3 + 0]) + P.nsa_gate_b[(head + 1) * 3 + 0]);
#pragma unroll
      for (int gq = 0; gq < 4; ++gq) {
        u32x2 u0, u1, u2, u3;
        u0[0] = pk2(gA * oA0[gq * 4], gA * oA0[gq * 4 + 1]); u0[1] = pk2(gA * oA0[gq * 4 + 2], gA * oA0[gq * 4 + 3]);
        u1[0] = pk2(gA * oA1[gq * 4], gA * oA1[gq * 4 + 1]); u1[1] = pk2(gA * oA1[gq * 4 + 2], gA * oA1[gq * 4 + 3]);
        u2[0] = pk2(gB * oB0[gq * 4], gB * oB0[gq * 4 + 1]); u2[1] = pk2(gB * oB0[gq * 4 + 2], gB * oB0[gq * 4 + 3]);
        u3[0] = pk2(gB * oB1[gq * 4], gB * oB1[gq * 4 + 1]); u3[1] = pk2(gB * oB1[gq * 4 + 2], gB * oB1[gq * 4 + 3]);
        bf16_t* d = mix + tokq * DM + 512 + head * 64 + 8 * gq + 4 * kb;
        *(u32x2*)d = u0; *(u32x2*)(d + 32) = u1; *(u32x2*)(d + 64) = u2; *(u32x2*)(d + 96) = u3;
      }
    }
  }
  asm volatile("s_waitcnt lgkmcnt(0)" ::: "memory");
  __builtin_amdgcn_wave_barrier();
  unsigned mk0 = 0, mk1 = 0, mk2 = 0, mk3 = 0;
  {
    const int cur = tq >> 6, jb = kb * 64;
    unsigned key[64];
#pragma unroll
    for (int i = 0; i < 64; ++i) {
      const int j = jb + i;
      const float v = imp[j * 32 + l32];
      const bool forced = (j == 0) || (j == cur) || (j == cur - 1);
      key[i] = forced ? 0xffffffffu : (j <= cur ? __float_as_uint(v) + 1u : 0u);
    }
    unsigned T = 0u;
#pragma unroll 1
    for (int bit = 31; bit >= 0; --bit) {
      const unsigned Tc = T | (1u << bit);
      int cnt = 0;
#pragma unroll
      for (int i = 0; i < 64; ++i) cnt += (key[i] >= Tc) ? 1 : 0;
      const auto r = __builtin_amdgcn_permlane32_swap((unsigned)cnt, (unsigned)cnt, false, false);
      cnt = (int)(r[0] + r[1]);
      T = (cnt >= 16) ? Tc : T;
    }
    int cgt = 0, ceq = 0;
#pragma unroll
    for (int i = 0; i < 64; ++i) { cgt += (key[i] > T) ? 1 : 0; ceq += (key[i] == T) ? 1 : 0; }
    const auto rg = __builtin_amdgcn_permlane32_swap((unsigned)cgt, (unsigned)cgt, false, false);
    const int need = 16 - (int)(rg[0] + rg[1]);
    const auto re = __builtin_amdgcn_permlane32_swap((unsigned)ceq, (unsigned)ceq, false, false);
    int running = kb ? (int)(re[0] + re[1]) - ceq : 0;
    unsigned mlo = 0u, mhi = 0u;
#pragma unroll
    for (int i = 0; i < 64; ++i) {
      const bool eq = key[i] == T;
      const bool sl = (key[i] != 0u) && ((key[i] > T) || (eq && running < need));
      running += eq ? 1 : 0;
      if (i < 32) mlo |= sl ? (1u << i) : 0u; else mhi |= sl ? (1u << (i - 32)) : 0u;
    }
    const auto rl = __builtin_amdgcn_permlane32_swap(mlo, mlo, false, false);
    const auto rh = __builtin_amdgcn_permlane32_swap(mhi, mhi, false, false);
    const unsigned olo = rl[0] ^ rl[1] ^ mlo, ohi = rh[0] ^ rh[1] ^ mhi;
    mk0 = kb ? olo : mlo; mk1 = kb ? ohi : mhi; mk2 = kb ? mlo : olo; mk3 = kb ? mhi : ohi;
  }
  asm volatile("" ::: "memory");
  __syncthreads();
  const bf16_t* ksel = proj + (size_t)b * SEQ * PW + C_KS + g * 64;
  const bf16_t* vsel = proj + (size_t)b * SEQ * PW + C_VS + g * 64;
  const bf16_t* kwin = proj + (size_t)b * SEQ * PW + C_KW + g * 64;
  const bf16_t* vwin = proj + (size_t)b * SEQ * PW + C_VW + g * 64;
  const int st1 = 4 * qb + 3, wst0 = qb > 2 ? 4 * qb - 8 : 0;
#pragma unroll 1
  for (int hp = 0; hp < 2; ++hp) {
    const int head = g * 4 + hp * 2;
    bf16x8 qa[4], qb_[4];
#pragma unroll
    for (int i = 0; i < 4; ++i) {
      qa[i] = *(const bf16x8*)(qrow + C_NQ + head * 64 + i * 16 + kb * 8);
      qb_[i] = *(const bf16x8*)(qrow + C_NQ + (head + 1) * 64 + i * 16 + kb * 8);
    }
    bf16_t* dstA = mix + tokq * DM + 512 + head * 64;
    bf16_t* dstB = dstA + 64;
    HeadAcc A, B;
    A.o0 = zero16(); A.o1 = zero16(); A.m = -1e30f; A.l = 0.f; B.o0 = zero16(); B.o1 = zero16(); B.m = -1e30f; B.l = 0.f;
    nsa_branch2<false>(ksel, vsel, smem, 0, st1, qt, tq, qa, qb_, mk0, mk1, mk2, mk3, A, B);
    {
      const float gA = sigmoidf_(bf2f(qrow[C_NG + head * 3 + 1]) + P.nsa_gate_b[head * 3 + 1]);
      const float gB = sigmoidf_(bf2f(qrow[C_NG + (head + 1) * 3 + 1]) + P.nsa_gate_b[(head + 1) * 3 + 1]);
      fold_partial(dstA, gA * frcp(fmaxf(half_sum(A.l), 1e-30f)), A.o0, A.o1, kb);
      fold_partial(dstB, gB * frcp(fmaxf(half_sum(B.l), 1e-30f)), B.o0, B.o1, kb);
    }
    A.o0 = zero16(); A.o1 = zero16(); A.m = -1e30f; A.l = 0.f; B.o0 = zero16(); B.o1 = zero16(); B.m = -1e30f; B.l = 0.f;
    nsa_branch2<true>(kwin, vwin, smem, wst0, st1, qt, tq, qa, qb_, 0u, 0u, 0u, 0u, A, B);
    {
      const float gA = sigmoidf_(bf2f(qrow[C_NG + head * 3 + 2]) + P.nsa_gate_b[head * 3 + 2]);
      const float gB = sigmoidf_(bf2f(qrow[C_NG + (head + 1) * 3 + 2]) + P.nsa_gate_b[(head + 1) * 3 + 2]);
      fold_partial(dstA, gA * frcp(fmaxf(half_sum(A.l), 1e-30f)), A.o0, A.o1, kb);
      fold_partial(dstB, gB * frcp(fmaxf(half_sum(B.l), 1e-30f)), B.o0, B.o1, kb);
    }
  }
}

DI void sgu_item(const Params& P, int item, char* smem) {
  const bf16_t* H = (const bf16_t*)(P.ws + R1);
  bf16_t* Y = (bf16_t*)P.out;
  float* smu = (float*)smem; float* srs = smu + 128; float* sc1 = srs + 128; float* srw = sc1 + 128; float* slg = srw + 128; float* slb = slg + 256;
  bf16_t* sW = (bf16_t*)(smem + 4096);
  char* sV = smem + 4096 + 34816;
  const int tid = TIDX, lane = tid & 63, wave = __builtin_amdgcn_readfirstlane(tid >> 6), l32 = lane & 31, kb = lane >> 5;
  const size_t tok0 = (size_t)item * 128;
#pragma unroll 1
  for (int tb = 0; tb < 16; tb += 4) {
    u32x4 uu[4][4];
#pragma unroll
    for (int a = 0; a < 4; ++a)
#pragma unroll
      for (int k = 0; k < 4; ++k) uu[a][k] = *(const u32x4*)(H + (tok0 + wave * 16 + tb + a) * 4096 + 2048 + k * 512 + lane * 8);
#pragma unroll
    for (int a = 0; a < 4; ++a) {
      float sm = 0.f, s2 = 0.f;
#pragma unroll
      for (int k = 0; k < 4; ++k)
#pragma unroll
        for (int e = 0; e < 4; ++e) { const float x0 = bflo(uu[a][k][e]), x1 = bfhi(uu[a][k][e]); sm += x0 + x1; s2 += x0 * x0 + x1 * x1; }
      sm = wave_sum(sm); s2 = wave_sum(s2);
      const float mu = sm * (1.f / 2048.f);
      const float var = fmaxf(s2 * (1.f / 2048.f) - mu * mu, 0.f);
      if (lane == 0) { smu[wave * 16 + tb + a] = mu; srs[wave * 16 + tb + a] = rsqrtf(var + EPS); }
    }
  }
  __syncthreads();
  const int srow = tid >> 5, schunk = tid & 31;
#pragma unroll 1
  for (int g = 0; g < 8; ++g) {
    u32x4 vreg[8], ureg[8];
#pragma unroll
    for (int i = 0; i < 8; ++i) {
      const bf16_t* hp = H + (tok0 + srow + 16 * i) * 4096 + g * 256 + schunk * 8;
      vreg[i] = *(const u32x4*)(hp + 2048);
      ureg[i] = *(const u32x4*)hp;
    }
    {
      const int t = tid >> 2, qr = tid & 3;
      const float* wrow = P.o_w_s + ((size_t)g * 128 + t) * 128 + qr * 32;
      float4 wq[8];
#pragma unroll
      for (int c4 = 0; c4 < 8; ++c4) wq[c4] = *(const float4*)(wrow + c4 * 4);
      float c1 = 0.f, rw = 0.f;
#pragma unroll
      for (int c8 = 0; c8 < 4; ++c8) {
        const float4 f0 = wq[2 * c8], f1 = wq[2 * c8 + 1];
        float wv[8] = {f0.x, f0.y, f0.z, f0.w, f1.x, f1.y, f1.z, f1.w};
        float ov[8];
#pragma unroll
        for (int e = 0; e < 8; ++e) {
          const int sx = qr * 32 + c8 * 8 + e;
          const float w = (sx <= t) ? wv[e] : 0.f;
          rw += w;
          const float wp = bf2f(f2bf(w * srs[sx]));
          c1 += wp * smu[sx];
          ov[e] = wp;
        }
        u32x4 o; o[0] = pk2(ov[0], ov[1]); o[1] = pk2(ov[2], ov[3]); o[2] = pk2(ov[4], ov[5]); o[3] = pk2(ov[6], ov[7]);
        *(u32x4*)(sW + t * 136 + qr * 32 + c8 * 8) = o;
      }
      c1 += __shfl_xor(c1, 1); rw += __shfl_xor(rw, 1);
      c1 += __shfl_xor(c1, 2); rw += __shfl_xor(rw, 2);
      if (qr == 0) { sc1[t] = c1; srw[t] = rw; }
      if (tid < 256) { slg[tid] = P.o_ln_g[g * 256 + tid]; slb[tid] = P.o_ln_b[g * 256 + tid]; }
    }
#pragma unroll
    for (int i = 0; i < 8; ++i) *(u32x4*)(sV + (srow + 16 * i) * 544 + schunk * 16) = vreg[i];
    __syncthreads();
    const int tt = wave & 3, chh = wave >> 2;
    f32x16 acc[4];
#pragma unroll
    for (int c = 0; c < 4; ++c) acc[c] = zero16();
    {
      const int i16 = lane & 15, q = i16 >> 2, p = i16 & 3, gc = (lane >> 4) & 1;
      const char* vb = sV + (8 * kb + q) * 544 + (chh * 128 + gc * 16 + 4 * p) * 2;
      const bf16_t* wb = sW + (tt * 32 + l32) * 136 + kb * 8;
      const int nks = 2 * (tt + 1);
      for (int ks = 0; ks < nks; ++ks) {
        const bf16x8 wf = *(const bf16x8*)(wb + ks * 16);
#pragma unroll
        for (int c = 0; c < 4; ++c) {
          const s16x4 lo = lds_tr(vb + ks * 16 * 544 + c * 64);
          const s16x4 hi = lds_tr(vb + (ks * 16 + 4) * 544 + c * 64);
          const bf16x8 vf = __builtin_shufflevector(lo, hi, 0, 1, 2, 3, 4, 5, 6, 7);
          acc[c] = mfma(vf, wf, acc[c]);
        }
      }
    }
    __syncthreads();
    {
      const int t = tt * 32 + l32;
      const float c1 = sc1[t], rw = srw[t], bs = P.o_b_s[g * 128 + t];
#pragma unroll
      for (int c = 0; c < 4; ++c)
#pragma unroll
        for (int gq = 0; gq < 4; ++gq) {
          const int chl = (chh * 4 + c) * 32 + 8 * gq + 4 * kb;
          const float4 lg = *(const float4*)(slg + chl), lb = *(const float4*)(slb + chl);
          const float m0 = lg.x * (acc[c][gq * 4 + 0] - c1) + lb.x * rw + bs;
          const float m1 = lg.y * (acc[c][gq * 4 + 1] - c1) + lb.y * rw + bs;
          const float m2 = lg.z * (acc[c][gq * 4 + 2] - c1) + lb.z * rw + bs;
          const float m3 = lg.w * (acc[c][gq * 4 + 3] - c1) + lb.w * rw + bs;
          u32x2 o; o[0] = pk2(m0, m1); o[1] = pk2(m2, m3);
          *(u32x2*)(sV + t * 520 + chl * 2) = o;
        }
    }
    __syncthreads();
#pragma unroll
    for (int i = 0; i < 8; ++i) {
      const char* mp = sV + (srow + 16 * i) * 520 + schunk * 16;
      const u32x2 ma = *(const u32x2*)mp, mb = *(const u32x2*)(mp + 8);
      const u32x4 uu = ureg[i];
      u32x4 o;
      o[0] = pk2(bflo(uu[0]) * bflo(ma[0]), bfhi(uu[0]) * bfhi(ma[0]));
      o[1] = pk2(bflo(uu[1]) * bflo(ma[1]), bfhi(uu[1]) * bfhi(ma[1]));
      o[2] = pk2(bflo(uu[2]) * bflo(mb[0]), bfhi(uu[2]) * bfhi(mb[0]));
      o[3] = pk2(bflo(uu[3]) * bflo(mb[1]), bfhi(uu[3]) * bfhi(mb[1]));
      *(u32x4*)(Y + (tok0 + srow + 16 * i) * 2048 + g * 256 + schunk * 8) = o;
    }
    __syncthreads();
  }
}

constexpr int NPHASE = 17;
DI void run_phase(const Params& P, int ph, char* smem) {
  char* ws = P.ws;
  bf16_t* r1 = (bf16_t*)(ws + R1); bf16_t* r2 = (bf16_t*)(ws + R2); bf16_t* r3 = (bf16_t*)(ws + R3); bf16_t* r4 = (bf16_t*)(ws + R4);
  unsigned* cnt = (unsigned*)(ws + W_CNT);
  const int lane = TIDX & 63, wave = TIDX >> 6, half = TIDX >> 8;
  char* hsmem = smem + half * 65536;
  switch (ph) {
    case 0: phase_prep(P); break;
    case 1: gemm_run<0>(r2, (const bf16_t*)(ws + W_EIN), PW, 1024, r1, PW, smem); break;
    case 2: {
      if (blockIdx.x < 64) nsa_compress_task(P, blockIdx.x * WPB + wave);
      volatile int* s_item = (volatile int*)(smem + LDS_BYTES - 16);
      for (;;) {
        __syncthreads();
        if (TIDX == 0) *s_item = (int)atomicAdd(cnt + 0, 1u);
        __syncthreads();
        const int pair = *s_item;
        if (pair >= 2048) break;
        gla_p1_item(P, pair * 2 + half, hsmem);
      }
    } break;
    case 3: gla_scan(P);
    case 30: {
      volatile int* s_item = (volatile int*)(smem + 131072);
      for (;;) {
        __syncthreads();
        if (TIDX == 0) *s_item = (int)atomicAdd(cnt + 1, 1u);
        __syncthreads();
        const int it = *s_item;
        if (it >= 512) break;
        nsa_block(P, (it & 15) >> 1, it & 1, 31 - (it >> 4), smem);
      }
    } break;
    case 4:
      for (int item = blockIdx.x * 2 + half; item < 4096; item += gridDim.x * 2) gla_p3_item(P, item, hsmem);
      break;
    case 5: gemm_run<0>(r3, (const bf16_t*)(ws + W_EOUT), 1024, 1024, r4, 1024, smem); break;
    case 6: resnorm_rows<true, false>(r4, P.x, nullptr, nullptr, r3, P.norm_g + 1 * 1024, P.norm_g + 2 * 1024, r2); break;
    case 7: gemm_run<1>(r2, (const bf16_t*)(ws + W_FFN1_0), 4096, 1024, r1, 4096, smem); break;
    case 8: gemm_run<0>(r1, (const bf16_t*)(ws + W_FFN2_0), 1024, 4096, r4, 1024, smem); break;
    case 9: resnorm_rows<false, false>(r4, nullptr, r3, nullptr, r3, P.norm_g + 3 * 1024, P.norm_g + 4 * 1024, r2); break;
    case 10: gemm_run<2>(r2, (const bf16_t*)(ws + W_OIN), 4096, 1024, r1, 4096, smem); break;
    case 11:
      for (int item = blockIdx.x; item < 512; item += gridDim.x) sgu_item(P, item, smem);
      break;
    case 12: gemm_run<0>((const bf16_t*)P.out, (const bf16_t*)(ws + W_OOUT), 1024, 2048, r4, 1024, smem); break;
    case 13: resnorm_rows<false, false>(r4, nullptr, r3, nullptr, r3, P.norm_g + 5 * 1024, P.norm_g + 6 * 1024, r2); break;
    case 14: gemm_run<1>(r2, (const bf16_t*)(ws + W_FFN1_1), 4096, 1024, r1, 4096, smem); break;
    case 15: gemm_run<0>(r1, (const bf16_t*)(ws + W_FFN2_1), 1024, 4096, r4, 1024, smem); break;
    case 16: resnorm_rows<false, true>(r4, nullptr, r3, P.out, nullptr, P.norm_g + 7 * 1024, nullptr, nullptr); break;
    default: break;
  }
}

#if !MEGA
extern __shared__ __attribute__((aligned(16))) unsigned char lds_dyn[];
__global__ void __launch_bounds__(NTHR, 2) k_phase(Params P, int ph) {
  char* smem = (char*)lds_dyn;
  run_phase(P, ph, smem);
}
#endif

#define XB_TMO      128
#define XB_XCNT(j)  (256  + 64 * (j))
#define XB_XSUB(j)  (1280 + 64 * (j))
#define XB_XGEN(j)  (2304 + 64 * (j))
#define XB_TOP      3328
#define XB_TOPGEN   3392
#define XCD_BAR_WORDS 3456
#define XB_SPIN_CAP (1u << 20)
#define LAS3 __attribute__((address_space(3)))
DI unsigned xb_ld(unsigned* p) { return __hip_atomic_load(p, __ATOMIC_RELAXED, __HIP_MEMORY_SCOPE_AGENT); }
DI unsigned xb_add(unsigned* p, unsigned v) { return __hip_atomic_fetch_add(p, v, __ATOMIC_RELAXED, __HIP_MEMORY_SCOPE_AGENT); }
DI unsigned xb_xcc_id() { return (unsigned)__builtin_amdgcn_s_getreg((3 << 11) | 20) & 0xFu; }
#define XB_SPIN(cond, bar) do { unsigned _sp = 0; while (cond) { __builtin_amdgcn_s_sleep(1); \
    if ((++_sp & 255u) == 0u) { if (xb_ld(&(bar)[XB_TMO])) break; if (_sp > XB_SPIN_CAP) { atomicAdd(&(bar)[XB_TMO], 1u); break; } } } } while (0)
struct XcdBarrier { unsigned* bar; unsigned x; volatile LAS3 unsigned* st; };
DI XcdBarrier xcd_barrier_post(unsigned* bar, volatile LAS3 unsigned* st) {
  XcdBarrier b; b.bar = bar; b.x = xb_xcc_id(); b.st = st;
  if (threadIdx.x == 0) (void)xb_add(&bar[XB_XCNT(b.x)], 1u);
  return b;
}
DI void xcd_barrier_complete(unsigned* bar, unsigned x, unsigned& nloc, unsigned& nx) {
  const unsigned G = gridDim.x * gridDim.y * gridDim.z;
  unsigned sum, cnt, mine, sp = 0u;
  for (;;) {
    sum = 0u; cnt = 0u; mine = 0u;
#pragma unroll
    for (unsigned j = 0; j < 16; ++j) { const unsigned c = xb_ld(&bar[XB_XCNT(j)]); sum += c; cnt += (c > 0u) ? 1u : 0u; mine = (j == x) ? c : mine; }
    if (sum == G) break;
    __builtin_amdgcn_s_sleep(1);
    if ((++sp & 255u) == 0u) { if (xb_ld(&bar[XB_TMO])) break; if (sp > XB_SPIN_CAP) { atomicAdd(&bar[XB_TMO], 1u); break; } }
  }
  nloc = mine > 0u ? mine : 1u; nx = cnt > 0u ? cnt : 1u;
}
DI void xcd_barrier(const XcdBarrier& b) {
  asm volatile("s_waitcnt vmcnt(0)" ::: "memory");
  __syncthreads();
  if (threadIdx.x == 0) {
    unsigned* bar = b.bar;
    __builtin_amdgcn_s_waitcnt(0);
    unsigned nloc = b.st[0], nx = b.st[1];
    if (nloc == 0u) { xcd_barrier_complete(bar, b.x, nloc, nx); b.st[0] = nloc; b.st[1] = nx; }
    const unsigned old = xb_add(&bar[XB_XSUB(b.x)], 1u);
    const unsigned gen = old / nloc;
    if (old + 1u == (gen + 1u) * nloc) {
      __builtin_amdgcn_fence(__ATOMIC_RELEASE, "agent");
      asm volatile("s_waitcnt vmcnt(0)" ::: "memory");
      const unsigned og = xb_add(&bar[XB_TOP], 1u);
      const unsigned tg = og / nx;
      if (og + 1u == (tg + 1u) * nx) xb_add(&bar[XB_TOPGEN], 1u);
      else XB_SPIN(xb_ld(&bar[XB_TOPGEN]) == tg, bar);
      __builtin_amdgcn_fence(__ATOMIC_ACQUIRE, "agent");
      xb_add(&bar[XB_XGEN(b.x)], 1u);
      asm volatile("s_waitcnt vmcnt(0)" ::: "memory");
    } else {
      XB_SPIN(xb_ld(&bar[XB_XGEN(b.x)]) == gen, bar);
      __builtin_amdgcn_fence(__ATOMIC_ACQUIRE, "agent");
      asm volatile("s_waitcnt vmcnt(0)" ::: "memory");
    }
  }
  __syncthreads();
}

#if MEGA
extern __shared__ __attribute__((aligned(16))) unsigned char lds_dyn[];
__global__ void __launch_bounds__(NTHR, 2) k_mega(Params P) {
  char* smem = (char*)lds_dyn;
  cg::grid_group grid = cg::this_grid();
  volatile LAS3 unsigned* xst = (volatile LAS3 unsigned*)(smem + 131072 + 16);
  if (threadIdx.x == 0) { xst[0] = 0u; xst[1] = 0u; }
  __syncthreads();
  const XcdBarrier xb = xcd_barrier_post((unsigned*)(P.ws + W_BAR), xst);
#define GSYNC() xcd_barrier(xb)
#define GEMM_PH(n) run_phase(P, n, smem); GSYNC(); if (PROBE == 1) { run_phase(P, n, smem); GSYNC(); }
  if (P.ws == nullptr) grid.sync();
  run_phase(P, 0, smem); GSYNC();
  if (PROBE == 3) { run_phase(P, 0, smem); GSYNC(); }
  GEMM_PH(1)
  run_phase(P, 2, smem); GSYNC();
  if (PROBE == 4) { if (blockIdx.x == 0 && TIDX == 0) ((unsigned*)(P.ws + W_CNT))[0] = 0u; GSYNC(); run_phase(P, 2, smem); GSYNC(); }
  run_phase(P, 3, smem); GSYNC();
  if (PROBE == 2) {
    if (blockIdx.x == 0 && TIDX == 0) ((unsigned*)(P.ws + W_CNT))[1] = 0u;
    GSYNC();
    run_phase(P, 30, smem); GSYNC();
  }
  run_phase(P, 4, smem); GSYNC();
  if (PROBE == 5) { run_phase(P, 4, smem); GSYNC(); }
  GEMM_PH(5)
  run_phase(P, 6, smem); GSYNC();
  if (PROBE == 6) { run_phase(P, 6, smem); GSYNC(); run_phase(P, 6, smem); GSYNC(); run_phase(P, 6, smem); GSYNC(); }
  GEMM_PH(7)
  GEMM_PH(8)
  run_phase(P, 9, smem); GSYNC();
  GEMM_PH(10)
  run_phase(P, 11, smem); GSYNC();
  if (PROBE == 7) { run_phase(P, 11, smem); GSYNC(); }
  GEMM_PH(12)
  run_phase(P, 13, smem); GSYNC();
  GEMM_PH(14)
  GEMM_PH(15)
  if (PROBE == 11) { GSYNC(); GSYNC(); GSYNC(); GSYNC(); GSYNC(); GSYNC(); GSYNC(); GSYNC(); }
  run_phase(P, 16, smem);
}
#endif

extern "C" void kernel_launch(void* const* d_in, const int* in_sizes, int n_in, void* d_out, int out_size, void* d_ws, size_t ws_size,
                              hipStream_t stream) {
  Params p{};
  p.x = (const float*)d_in[0]; p.norm_g = (const float*)d_in[1]; p.ffn_w1 = (const float*)d_in[2]; p.ffn_w2 = (const float*)d_in[3];
  p.e_w_in = (const float*)d_in[4]; p.e_w_out = (const float*)d_in[5]; p.gla_w_gate = (const float*)d_in[6]; p.gla_b_gate = (const float*)d_in[7];
  p.gla_norm = (const float*)d_in[8]; p.nsa_gate_b = (const float*)d_in[9]; p.cmp_pos = (const float*)d_in[10]; p.cmp_w1 = (const float*)d_in[11];
  p.cmp_w2 = (const float*)d_in[12]; p.o_w_in = (const float*)d_in[13]; p.o_ln_g = (const float*)d_in[14]; p.o_ln_b = (const float*)d_in[15];
  p.o_w_s = (const float*)d_in[16]; p.o_b_s = (const float*)d_in[17]; p.o_w_out = (const float*)d_in[18];
  p.out = (float*)d_out; p.ws = (char*)d_ws;
  if (ws_size < 1024ull * MiB) { fprintf(stderr, "workspace too small: %zu\n", ws_size); return; }
  static int grid_blocks = 0;
  if (!grid_blocks) {
    int dev = 0, cus = 0, per_cu = 0;
    (void)hipGetDevice(&dev);
    (void)hipDeviceGetAttribute(&cus, hipDeviceAttributeMultiprocessorCount, dev);
#if MEGA
    if (hipFuncSetAttribute((const void*)k_mega, hipFuncAttributeMaxDynamicSharedMemorySize, LDS_BYTES) != hipSuccess) fprintf(stderr, "hipFuncSetAttribute failed\n");
    (void)hipOccupancyMaxActiveBlocksPerMultiprocessor(&per_cu, (const void*)k_mega, NTHR, LDS_BYTES);
#else
    if (hipFuncSetAttribute((const void*)k_phase, hipFuncAttributeMaxDynamicSharedMemorySize, LDS_BYTES) != hipSuccess) fprintf(stderr, "hipFuncSetAttribute failed\n");
    (void)hipOccupancyMaxActiveBlocksPerMultiprocessor(&per_cu, (const void*)k_phase, NTHR, LDS_BYTES);
#endif
    if (per_cu < 1) fprintf(stderr, "occupancy query returned %d\n", per_cu);
    grid_blocks = cus;
  }
#if MEGA
  if (hipMemsetAsync((char*)d_ws + W_BAR, 0, XCD_BAR_WORDS * sizeof(unsigned), stream) != hipSuccess) fprintf(stderr, "memset of barrier words failed\n");
  void* args[] = {&p};
  hipError_t e = hipLaunchCooperativeKernel((void*)k_mega, dim3(grid_blocks), dim3(NTHR), args, LDS_BYTES, stream);
  if (e != hipSuccess) fprintf(stderr, "cooperative launch failed: %s (grid %d)\n", hipGetErrorString(e), grid_blocks);
#else
  for (int ph = 0; ph < NPHASE; ++ph) k_phase<<<grid_blocks, NTHR, LDS_BYTES, stream>>>(p, ph);
#endif
}
```

```cpp
#include <hip/hip_runtime.h>
#include <hip/hip_cooperative_groups.h>
#include <cstdio>
namespace cg = cooperative_groups;

#ifndef MEGA
#define MEGA 1
#endif
#ifndef PROBE
#define PROBE 0
#endif

typedef unsigned short bf16_t;
typedef short bf16x8 __attribute__((ext_vector_type(8)));
typedef short s16x4 __attribute__((ext_vector_type(4)));
typedef float f32x16 __attribute__((ext_vector_type(16)));
typedef float f32v2 __attribute__((ext_vector_type(2)));
typedef __bf16 bf16v2 __attribute__((ext_vector_type(2)));
typedef unsigned u32x4 __attribute__((ext_vector_type(4)));
typedef unsigned u32x2 __attribute__((ext_vector_type(2)));
#define DI __device__ __forceinline__
DI int tid_opaque() { int t = threadIdx.x; asm volatile("" : "+v"(t)); return t; }
#define TIDX tid_opaque()

constexpr int T_TOK = 65536, SEQ = 8192, DM = 1024;
constexpr int PW = 3072;
constexpr int C_GQ = 0, C_GK = 256, C_GV = 512, C_GLR = 1024, C_GR = 1040, C_NQ = 1552, C_KC = 2064, C_VC = 2192,
              C_KS = 2320, C_VS = 2448, C_KW = 2576, C_VW = 2704, C_NG = 2832;
constexpr float EPS = 1e-6f;
constexpr int NTHR = 512, WPB = 8, LDS_CMP_STAGE = 131072 + 64, LDS_BYTES = 131072 + 64 + 18432;
constexpr size_t MiB = 1024ull * 1024ull;
constexpr size_t W_FFN1_0 = 0, W_FFN1_1 = 8 * MiB, W_FFN2_0 = 16 * MiB, W_FFN2_1 = 24 * MiB, W_EIN = 32 * MiB, W_EOUT = 38 * MiB,
                 W_OIN = 40 * MiB, W_OOUT = 48 * MiB, W_CW1 = 52 * MiB, W_CW2 = 53 * MiB, W_BIAS1 = 53 * MiB + 65536,
                 W_CNT = 53 * MiB + 131072, W_BAR = 54 * MiB;
constexpr size_t R1 = 64 * MiB, R2 = 576 * MiB, R3 = 704 * MiB, R4 = 832 * MiB, R5 = 960 * MiB;
constexpr size_t R_KCMP = R5, R_VCMPT = R5 + 1 * MiB, R_VST = R5 + 2 * MiB, R_VWT = R5 + 18 * MiB, R_DECAY = R5 + 34 * MiB;

struct Params {
  const float* x; const float* norm_g; const float* ffn_w1; const float* ffn_w2; const float* e_w_in; const float* e_w_out;
  const float* gla_w_gate; const float* gla_b_gate; const float* gla_norm; const float* nsa_gate_b; const float* cmp_pos;
  const float* cmp_w1; const float* cmp_w2; const float* o_w_in; const float* o_ln_g; const float* o_ln_b; const float* o_w_s;
  const float* o_b_s; const float* o_w_out;
  float* out; char* ws;
};

DI int crow(int r, int kb) { return (r & 3) + 8 * (r >> 2) + 4 * kb; }
DI f32x16 mfma(bf16x8 a, bf16x8 b, f32x16 c) { return __builtin_amdgcn_mfma_f32_32x32x16_bf16(a, b, c, 0, 0, 0); }
DI unsigned pk2(float a, float b) { f32v2 v = {a, b}; bf16v2 r = __builtin_convertvector(v, bf16v2); return __builtin_bit_cast(unsigned, r); }
DI bf16_t f2bf(float a) { return (bf16_t)(pk2(a, 0.f) & 0xffffu); }
DI float bf2f(bf16_t u) { return __uint_as_float(((unsigned)u) << 16); }
DI float bflo(unsigned u) { return __uint_as_float(u << 16); }
DI float bfhi(unsigned u) { return __uint_as_float(u & 0xffff0000u); }
DI bf16x8 pack8(float a0, float a1, float a2, float a3, float a4, float a5, float a6, float a7) {
  u32x4 p; p[0] = pk2(a0, a1); p[1] = pk2(a2, a3); p[2] = pk2(a4, a5); p[3] = pk2(a6, a7);
  return __builtin_bit_cast(bf16x8, p);
}
DI bf16x8 ld2x4(const bf16_t* p) {
  s16x4 lo = *(const s16x4*)p; s16x4 hi = *(const s16x4*)(p + 8);
  return __builtin_shufflevector(lo, hi, 0, 1, 2, 3, 4, 5, 6, 7);
}
DI float wave_sum(float v) {
#pragma unroll
  for (int o = 32; o > 0; o >>= 1) v += __shfl_xor(v, o);
  return v;
}
DI f32x16 zero16() { f32x16 z;
#pragma unroll
  for (int i = 0; i < 16; ++i) z[i] = 0.f; return z; }
DI float frcp(float x) { return __builtin_amdgcn_rcpf(x); }
DI float gelu_tanh(float x) { const float t = x * x; const float p = __builtin_fmaf(t, -2.3022082f * 0.044715f, -2.3022082f); return x * frcp(1.f + __builtin_amdgcn_exp2f(x * p)); }
DI float sigmoidf_(float x) { return frcp(1.f + __expf(-x)); }

DI void conv_weight(const float* __restrict__ src, bf16_t* __restrict__ dst, int K, int N, int Npad) {
  const long total = (long)Npad * (K >> 3);
  const long stride = (long)gridDim.x * blockDim.x;
  for (long i = (long)blockIdx.x * blockDim.x + TIDX; i < total; i += stride) {
    const int n = (int)(i % Npad); const int k8 = (int)(i / Npad);
    float v[8];
#pragma unroll
    for (int j = 0; j < 8; ++j) v[j] = (n < N) ? src[(size_t)(k8 * 8 + j) * N + n] : 0.f;
    u32x4 o; o[0] = pk2(v[0], v[1]); o[1] = pk2(v[2], v[3]); o[2] = pk2(v[4], v[5]); o[3] = pk2(v[6], v[7]);
    *(u32x4*)(dst + (size_t)n * K + k8 * 8) = o;
  }
}

DI void prenorm_rows(const float* __restrict__ x, const float* __restrict__ g, bf16_t* __restrict__ xn) {
  const int lane = TIDX & 63, wave = TIDX >> 6;
  const int nw = gridDim.x * WPB;
  for (int row = blockIdx.x * WPB + wave; row < T_TOK; row += nw) {
    const float4* xr = (const float4*)(x + (size_t)row * DM);
    float4 a[4]; float ss = 0.f;
#pragma unroll
    for (int k = 0; k < 4; ++k) { a[k] = xr[k * 64 + lane]; ss += a[k].x * a[k].x + a[k].y * a[k].y + a[k].z * a[k].z + a[k].w * a[k].w; }
    ss = wave_sum(ss);
    const float rs = rsqrtf(ss * (1.f / DM) + EPS);
#pragma unroll
    for (int k = 0; k < 4; ++k) {
      const float4 gg = ((const float4*)g)[k * 64 + lane];
      u32x2 o; o[0] = pk2(a[k].x * rs * gg.x, a[k].y * rs * gg.y); o[1] = pk2(a[k].z * rs * gg.z, a[k].w * rs * gg.w);
      *(u32x2*)(xn + (size_t)row * DM + k * 256 + lane * 4) = o;
    }
  }
}

template <bool HIN_F32, bool HOUT_F32>
DI void resnorm_rows(const bf16_t* __restrict__ m, const float* __restrict__ hin_f, const bf16_t* hin_b, float* __restrict__ hout_f,
                     bf16_t* hout_b, const float* __restrict__ gpost, const float* __restrict__ gnext, bf16_t* __restrict__ xn) {
  const int lane = TIDX & 63, wave = TIDX >> 6;
  const int nw = gridDim.x * WPB;
  for (int row = blockIdx.x * WPB + wave; row < T_TOK; row += nw) {
    float mv[16]; float ss = 0.f;
#pragma unroll
    for (int k = 0; k < 4; ++k) {
      const u32x2 u = *(const u32x2*)(m + (size_t)row * DM + k * 256 + lane * 4);
      mv[k * 4 + 0] = bflo(u[0]); mv[k * 4 + 1] = bfhi(u[0]); mv[k * 4 + 2] = bflo(u[1]); mv[k * 4 + 3] = bfhi(u[1]);
    }
    float hv[16];
#pragma unroll
    for (int k = 0; k < 4; ++k) {
      if (HIN_F32) {
        const float4 h4 = ((const float4*)(hin_f + (size_t)row * DM))[k * 64 + lane];
        hv[k * 4 + 0] = h4.x; hv[k * 4 + 1] = h4.y; hv[k * 4 + 2] = h4.z; hv[k * 4 + 3] = h4.w;
      } else {
        const u32x2 u = *(const u32x2*)(hin_b + (size_t)row * DM + k * 256 + lane * 4);
        hv[k * 4 + 0] = bflo(u[0]); hv[k * 4 + 1] = bfhi(u[0]); hv[k * 4 + 2] = bflo(u[1]); hv[k * 4 + 3] = bfhi(u[1]);
      }
    }
#pragma unroll
    for (int i = 0; i < 16; ++i) ss += mv[i] * mv[i];
    ss = wave_sum(ss);
    const float rs = rsqrtf(ss * (1.f / DM) + EPS);
    float s2 = 0.f;
#pragma unroll
    for (int k = 0; k < 4; ++k) {
      const float4 gg = ((const float4*)gpost)[k * 64 + lane];
      hv[k * 4 + 0] += mv[k * 4 + 0] * rs * gg.x; hv[k * 4 + 1] += mv[k * 4 + 1] * rs * gg.y;
      hv[k * 4 + 2] += mv[k * 4 + 2] * rs * gg.z; hv[k * 4 + 3] += mv[k * 4 + 3] * rs * gg.w;
      if (HOUT_F32) {
        float4 o; o.x = hv[k * 4 + 0]; o.y = hv[k * 4 + 1]; o.z = hv[k * 4 + 2]; o.w = hv[k * 4 + 3];
        ((float4*)(hout_f + (size_t)row * DM))[k * 64 + lane] = o;
      } else {
        u32x2 o; o[0] = pk2(hv[k * 4 + 0], hv[k * 4 + 1]); o[1] = pk2(hv[k * 4 + 2], hv[k * 4 + 3]);
        *(u32x2*)(hout_b + (size_t)row * DM + k * 256 + lane * 4) = o;
      }
    }
    if (xn) {
#pragma unroll
      for (int i = 0; i < 16; ++i) s2 += hv[i] * hv[i];
      s2 = wave_sum(s2);
      const float r2 = rsqrtf(s2 * (1.f / DM) + EPS);
#pragma unroll
      for (int k = 0; k < 4; ++k) {
        const float4 gg = ((const float4*)gnext)[k * 64 + lane];
        u32x2 o; o[0] = pk2(hv[k * 4 + 0] * r2 * gg.x, hv[k * 4 + 1] * r2 * gg.y); o[1] = pk2(hv[k * 4 + 2] * r2 * gg.z, hv[k * 4 + 3] * r2 * gg.w);
        *(u32x2*)(xn + (size_t)row * DM + k * 256 + lane * 4) = o;
      }
    }
  }
}

DI void phase_prep(const Params& P) {
  char* ws = P.ws;
  conv_weight(P.ffn_w1, (bf16_t*)(ws + W_FFN1_0), 1024, 4096, 4096);
  conv_weight(P.ffn_w1 + (size_t)1024 * 4096, (bf16_t*)(ws + W_FFN1_1), 1024, 4096, 4096);
  conv_weight(P.ffn_w2, (bf16_t*)(ws + W_FFN2_0), 4096, 1024, 1024);
  conv_weight(P.ffn_w2 + (size_t)1024 * 4096, (bf16_t*)(ws + W_FFN2_1), 4096, 1024, 1024);
  conv_weight(P.e_w_in, (bf16_t*)(ws + W_EIN), 1024, 2856, PW);
  conv_weight(P.e_w_out, (bf16_t*)(ws + W_EOUT), 1024, 1024, 1024);
  conv_weight(P.o_w_in, (bf16_t*)(ws + W_OIN), 1024, 4096, 4096);
  conv_weight(P.o_w_out, (bf16_t*)(ws + W_OOUT), 2048, 1024, 1024);
  conv_weight(P.cmp_w1, (bf16_t*)(ws + W_CW1), 2048, 128, 128);
  conv_weight(P.cmp_w1 + 2048 * 128, (bf16_t*)(ws + W_CW1) + 128 * 2048, 2048, 128, 128);
  conv_weight(P.cmp_w2, (bf16_t*)(ws + W_CW2), 128, 64, 64);
  conv_weight(P.cmp_w2 + 128 * 64, (bf16_t*)(ws + W_CW2) + 64 * 128, 128, 64, 64);
  const int lane = TIDX & 63, wave = TIDX >> 6;
  const int gw = blockIdx.x * WPB + wave;
  if (gw < 256) {
    const int i = gw >> 7, hid = gw & 127;
    float s = 0.f;
    for (int kk = lane; kk < 2048; kk += 64) s += P.cmp_pos[i * 2048 + kk] * P.cmp_w1[((size_t)i * 2048 + kk) * 128 + hid];
    s = wave_sum(s);
    if (lane == 0) ((float*)(ws + W_BIAS1))[gw] = s;
  }
  const int gt = blockIdx.x * blockDim.x + TIDX;
  if (gt < 16) ((unsigned*)(ws + W_CNT))[gt] = 0u;
  if (gt < 16 * 64) {
    const int bg = gt >> 6, d = gt & 63;
    ((bf16_t*)(ws + R_KCMP))[((size_t)bg * 512 + 511) * 64 + d] = 0;
    ((bf16_t*)(ws + R_VCMPT))[((size_t)bg * 512 + 511) * 64 + d] = 0;
  }
  prenorm_rows(P.x, P.norm_g, (bf16_t*)(ws + R2));
}

namespace pg8 {
#define PG8_LAS __attribute__((address_space(3)))
typedef float f32x4 __attribute__((ext_vector_type(4)));
constexpr int BM = 256, BK = 64, HALF = 128, HTB = HALF * BK * 2, STAGE_BYTES = 8 * HTB, NXCD = 8, WGM = 8;
DI int lds_byte(int r, int c) { const int st = (r >> 4) * 2 + (c >> 5), rr = r & 15, cc = c & 31, ob = rr * 64 + cc * 2; return st * 1024 + (ob ^ (((ob >> 9) & 1) << 5)); }
DI void stage_rc(int b, int& R, int& C) { const int st = b / 1024, sb = b % 1024, swz = sb ^ (((sb >> 9) & 1) << 5); R = (st >> 1) * 16 + swz / 64; C = (st & 1) * 32 + (swz % 64) / 2; }
DI int perm32(int rho) { const int n = rho >> 4, i = rho & 15; return 8 * (i >> 2) + 4 * n + (i & 3); }
struct Unit { int pm, pn; };
struct Gemm { const bf16_t* A; const bf16_t* Bt; int M, N, K; };
struct StaticOrder {
  int nM, nN, nwg, G, c;
  DI void init(int M, int N, int G_, int c_) { nM = M / BM; nN = N / BM; nwg = nM * nN; G = G_; c = c_; }
  DI bool next(int i, Unit& u) const {
    const long L = (long)i * G + c; if (L >= nwg) return false;
    int wgid = (int)L; { const int q = nwg / NXCD, r = nwg % NXCD, xcd = wgid % NXCD, off = wgid / NXCD; wgid = (xcd < r ? xcd * (q + 1) : r * (q + 1) + (xcd - r) * q) + off; }
    const int nig = WGM * nN, gid = wgid / nig, fm = gid * WGM, gsz = (nM - fm) < WGM ? (nM - fm) : WGM;
    u.pm = fm + ((wgid % nig) % gsz); u.pn = (wgid % nig) / gsz; return true;
  }
};
template <int ACT> struct EpiB {
  static constexpr bool PERM = true;
  bf16_t* O; int ldc;
  DI void operator()(const f32x4 (&acc)[2][2][4][2], const Unit& u, int wr, int wc, int fr, int fq) const {
    const int row0 = u.pm * BM + wr * 64 + fr; const int col0 = u.pn * BM + wc * 32 + 8 * fq;
#pragma unroll
    for (int ai = 0; ai < 2; ++ai)
#pragma unroll
      for (int m = 0; m < 4; ++m) {
        bf16_t* rowp = O + (size_t)(row0 + ai * HALF + m * 16) * ldc + col0;
#pragma unroll
        for (int bj = 0; bj < 2; ++bj) {
          f32x4 v0 = acc[ai][bj][m][0], v1 = acc[ai][bj][m][1];
          if (ACT == 1) {
#pragma unroll
            for (int j = 0; j < 4; ++j) { const float a = fmaxf(v0[j], 0.f), b = fmaxf(v1[j], 0.f); v0[j] = a * a; v1[j] = b * b; }
          }
          if (ACT == 2) {
#pragma unroll
            for (int j = 0; j < 4; ++j) { v0[j] = gelu_tanh(v0[j]); v1[j] = gelu_tanh(v1[j]); }
          }
          u32x4 w; w[0] = pk2(v0[0], v0[1]); w[1] = pk2(v0[2], v0[3]); w[2] = pk2(v1[0], v1[1]); w[3] = pk2(v1[2], v1[3]);
          *(u32x4*)(rowp + bj * HALF) = w;
        }
      }
  }
};

template <class Epi, class Sched>
DI void gemm_phase(PG8_LAS unsigned char* lds, const Gemm g, const Sched& S, const Epi& E) {
  const int tid_ = TIDX;
  const int tid = tid_, wid = __builtin_amdgcn_readfirstlane(tid >> 6), lane = tid & 63, wr = wid >> 2, wc = wid & 3, fr = lane & 15, fq = lane >> 4;
  const int K = g.K, nt = K / BK;
  unsigned voffA[2], voffB[2];
#pragma unroll
  for (int i = 0; i < 2; ++i) { int R, C; stage_rc(tid * 16 + i * 8192, R, C); const int Rb = Epi::PERM ? ((R & ~31) + perm32(R & 31)) : R;
    voffA[i] = (unsigned)(R * K + C) * 2u; voffB[i] = (unsigned)(Rb * K + C) * 2u; }
  const size_t kstep = (size_t)(BK * 2);
  const size_t hstep = (size_t)HALF * K * 2;
  const size_t tstep = 2 * hstep;
  const unsigned ldsw = (unsigned)wid * 1024u;
  const int aoff = lds_byte(wr * 64 + fr, fq * 8), boff = lds_byte(wc * 32 + fr, fq * 8);
#define PG8_SA(b, h) (((b) * 2 + (h)) * HTB)
#define PG8_SB(b, h) ((4 + (b) * 2 + (h)) * HTB)
#define PG8_STAGE(bufoff, gbase, voff) do { _Pragma("unroll") for (int _i = 0; _i < 2; ++_i) \
    __builtin_amdgcn_global_load_lds((const unsigned*)((const char*)(gbase) + (voff)[_i]), (PG8_LAS unsigned*)(lds + (bufoff) + ldsw + _i * 8192), 16, 0, 0); } while (0)
#define PG8_LDA(dst, b, h) do { _Pragma("unroll") for (int m = 0; m < 4; ++m) _Pragma("unroll") for (int k = 0; k < 2; ++k) dst[m][k] = *(const PG8_LAS bf16x8*)(lds + PG8_SA(b, h) + aoff + m * 2048 + k * 1024); } while (0)
#define PG8_LDB(dst, b, h) do { _Pragma("unroll") for (int n = 0; n < 2; ++n) _Pragma("unroll") for (int k = 0; k < 2; ++k) dst[n][k] = *(const PG8_LAS bf16x8*)(lds + PG8_SB(b, h) + boff + n * 2048 + k * 1024); } while (0)
#define PG8_MMA(ai, bj, At, Bt) do { __builtin_amdgcn_s_setprio(1); _Pragma("unroll") for (int m = 0; m < 4; ++m) _Pragma("unroll") for (int n = 0; n < 2; ++n) _Pragma("unroll") for (int k = 0; k < 2; ++k) \
    acc[ai][bj][m][n] = __builtin_amdgcn_mfma_f32_16x16x32_bf16(Bt[n][k], At[m][k], acc[ai][bj][m][n], 0, 0, 0); __builtin_amdgcn_s_setprio(0); } while (0)
#define PG8_WAIT_V(n) asm volatile("s_waitcnt vmcnt(" #n ")" ::: "memory")
#define PG8_WAIT_L(n) asm volatile("s_waitcnt lgkmcnt(" #n ")" ::: "memory")
#define PG8_BAR __builtin_amdgcn_s_barrier()
#define PG8_SCHED __builtin_amdgcn_sched_barrier(0)
  Unit cur, nxt; int ui = 0;
  if (!S.next(0, cur)) return;
  f32x4 acc[2][2][4][2];
#pragma unroll
  for (int a = 0; a < 2; ++a)
#pragma unroll
    for (int b = 0; b < 2; ++b)
#pragma unroll
      for (int m = 0; m < 4; ++m)
#pragma unroll
        for (int n = 0; n < 2; ++n) acc[a][b][m][n] = (f32x4){0.f, 0.f, 0.f, 0.f};
  bf16x8 At[4][2], B0[2][2], B1[2][2];
  const char* cA = (const char*)g.A + (size_t)cur.pm * tstep; const char* cB = (const char*)g.Bt + (size_t)cur.pn * tstep;
  PG8_STAGE(PG8_SB(0, 0), cB, voffB); PG8_STAGE(PG8_SA(0, 0), cA, voffA); PG8_STAGE(PG8_SB(0, 1), cB + hstep, voffB); PG8_STAGE(PG8_SA(0, 1), cA + hstep, voffA);
  if (wr == 1) PG8_BAR;
  PG8_WAIT_V(4); PG8_BAR;
  PG8_STAGE(PG8_SB(1, 0), cB + kstep, voffB); PG8_STAGE(PG8_SA(1, 0), cA + kstep, voffA); PG8_STAGE(PG8_SB(1, 1), cB + hstep + kstep, voffB);
  PG8_WAIT_V(6); PG8_BAR;
  for (;;) {
    const bool has_next = S.next(ui + 1, nxt);
    const char* nA = has_next ? (const char*)g.A + (size_t)nxt.pm * tstep : cA; const char* nB = has_next ? (const char*)g.Bt + (size_t)nxt.pn * tstep : cB;
    for (int t = 0; t < nt; t += 2) {
      const bool last = (t == nt - 2);
      const char* a1 = cA + (size_t)(t + 1) * kstep;
      const char* a2 = last ? nA : cA + (size_t)(t + 2) * kstep; const char* b2 = last ? nB : cB + (size_t)(t + 2) * kstep;
      const char* a3 = a2 + kstep; const char* b3 = b2 + kstep;
      PG8_LDB(B0, 0, 0); PG8_SCHED; PG8_LDA(At, 0, 0); PG8_STAGE(PG8_SA(1, 1), a1 + hstep, voffA);
      PG8_WAIT_L(8); PG8_BAR; PG8_WAIT_L(0); PG8_MMA(0, 0, At, B0); PG8_BAR; PG8_SCHED;
      PG8_LDB(B1, 0, 1); PG8_STAGE(PG8_SB(0, 0), b2, voffB);
      PG8_BAR; PG8_WAIT_L(0); PG8_MMA(0, 1, At, B1); PG8_BAR;
      PG8_LDA(At, 0, 1); PG8_STAGE(PG8_SA(0, 0), a2, voffA);
      PG8_BAR; PG8_WAIT_L(0); PG8_MMA(1, 0, At, B0); PG8_BAR; PG8_SCHED;
      PG8_STAGE(PG8_SB(0, 1), b2 + hstep, voffB);
      PG8_WAIT_V(6); PG8_BAR; PG8_MMA(1, 1, At, B1); PG8_BAR;
      PG8_LDB(B0, 1, 0); PG8_SCHED; PG8_LDA(At, 1, 0); PG8_STAGE(PG8_SA(0, 1), a2 + hstep, voffA);
      PG8_WAIT_L(8); PG8_BAR; PG8_WAIT_L(0); PG8_MMA(0, 0, At, B0); PG8_BAR; PG8_SCHED;
      PG8_LDB(B1, 1, 1); PG8_STAGE(PG8_SB(1, 0), b3, voffB);
      PG8_BAR; PG8_WAIT_L(0); PG8_MMA(0, 1, At, B1); PG8_BAR;
      PG8_LDA(At, 1, 1); PG8_STAGE(PG8_SA(1, 0), a3, voffA);
      PG8_BAR; PG8_WAIT_L(0); PG8_MMA(1, 0, At, B0); PG8_BAR; PG8_SCHED;
      PG8_STAGE(PG8_SB(1, 1), b3 + hstep, voffB);
      PG8_WAIT_V(6); PG8_BAR; PG8_MMA(1, 1, At, B1); PG8_BAR;
    }
    E(acc, cur, wr, wc, fr, fq);
    if (PROBE == 10) { asm volatile("" ::: "memory"); E(acc, cur, wr, wc, fr, fq); }
    if (!has_next) break;
#pragma unroll
    for (int a = 0; a < 2; ++a)
#pragma unroll
      for (int b = 0; b < 2; ++b)
#pragma unroll
        for (int m = 0; m < 4; ++m)
#pragma unroll
          for (int n = 0; n < 2; ++n) acc[a][b][m][n] = (f32x4){0.f, 0.f, 0.f, 0.f};
    cur = nxt; cA = nA; cB = nB; ++ui;
  }
  PG8_WAIT_V(0);
  if (wr == 0) PG8_BAR;
  PG8_BAR;
#undef PG8_SA
#undef PG8_SB
#undef PG8_STAGE
#undef PG8_LDA
#undef PG8_LDB
#undef PG8_MMA
#undef PG8_WAIT_V
#undef PG8_WAIT_L
#undef PG8_BAR
#undef PG8_SCHED
}
}

template <int ACT>
DI void gemm_run(const bf16_t* A, const bf16_t* Bt, int N, int K, bf16_t* C, int ldc, char* smem) {
  pg8::Gemm g; g.A = A; g.Bt = Bt; g.M = T_TOK; g.N = N; g.K = K;
  pg8::StaticOrder S; S.init(T_TOK, N, (int)gridDim.x, (int)blockIdx.x);
  pg8::EpiB<ACT> E; E.O = C; E.ldc = ldc;
#ifndef STAGGER_TICKS
#define STAGGER_TICKS 0
#endif
  if (K <= 1024 && STAGGER_TICKS > 0) {
    const unsigned long long t0 = __builtin_amdgcn_s_memrealtime();
    const unsigned long long d = (unsigned long long)(((blockIdx.x >> 3) & 3) * STAGGER_TICKS);
    while (__builtin_amdgcn_s_memrealtime() - t0 < d) __builtin_amdgcn_s_sleep(8);
  }
  pg8::gemm_phase(( PG8_LAS unsigned char*)smem, g, S, E);
  __syncthreads();
}

DI void gla_gates(const Params& P, const bf16_t* proj, int b, int h, int n, float* sb, float* sseg, float* tmp) {
  const int tid = TIDX & 255;
  float* sw = tmp;
  float* sg = tmp + 1024;
  {
    for (int e = tid; e < 1024; e += 256) sw[e] = P.gla_w_gate[(e >> 6) * 256 + h * 64 + (e & 63)];
    const int i = tid >> 2, part = tid & 3;
    const size_t t = (size_t)b * SEQ + n * 64 + i;
    const u32x2 gu = *(const u32x2*)(proj + t * PW + C_GLR + part * 4);
    sg[i * 17 + part * 4 + 0] = bflo(gu[0]); sg[i * 17 + part * 4 + 1] = bfhi(gu[0]);
    sg[i * 17 + part * 4 + 2] = bflo(gu[1]); sg[i * 17 + part * 4 + 3] = bfhi(gu[1]);
  }
  __syncthreads();
  {
    const int i = tid & 63, dq = tid >> 6;
    float z[16];
#pragma unroll
    for (int dd = 0; dd < 16; ++dd) z[dd] = P.gla_b_gate[h * 64 + dq * 16 + dd];
#pragma unroll 1
    for (int r = 0; r < 16; ++r) {
      const float gv = sg[i * 17 + r];
#pragma unroll
      for (int dd = 0; dd < 16; ++dd) z[dd] += gv * sw[r * 64 + dq * 16 + dd];
    }
#pragma unroll
    for (int dd = 0; dd < 16; ++dd) {
      const float zz = z[dd];
      const float ls = fminf(zz, 0.f) - __logf(1.f + __expf(-fabsf(zz)));
      sb[i * 65 + dq * 16 + dd] = ls * (1.f / 16.f);
    }
  }
  __syncthreads();
  const int d = tid & 63, seg = tid >> 6;
  float pre[16]; float run = 0.f;
#pragma unroll
  for (int ii = 0; ii < 16; ++ii) { run += sb[(seg * 16 + ii) * 65 + d]; pre[ii] = run; }
  sseg[seg * 64 + d] = run;
  __syncthreads();
  float off = 0.f;
#pragma unroll
  for (int s = 0; s < 4; ++s) off += (s < seg) ? sseg[s * 64 + d] : 0.f;
#pragma unroll
  for (int ii = 0; ii < 16; ++ii) sb[(seg * 16 + ii) * 65 + d] = pre[ii] + off;
  __syncthreads();
}

struct VRegs { u32x4 u[4]; };
DI void gla_load_v(const bf16_t* proj, int b, int h, int n, VRegs& vr) {
  const int tid = TIDX & 255, j = tid & 63, q4 = tid >> 6;
  const size_t t = (size_t)b * SEQ + n * 64 + j;
  const bf16_t* src = proj + t * PW + C_GV + h * 128 + q4 * 32;
#pragma unroll
  for (int c = 0; c < 4; ++c) vr.u[c] = *(const u32x4*)(src + c * 8);
}
DI void gla_store_vT(const VRegs& vr, bf16_t* vT) {
  const int tid = TIDX & 255, j = tid & 63, q4 = tid >> 6;
#pragma unroll
  for (int c = 0; c < 4; ++c) {
#pragma unroll
    for (int e = 0; e < 4; ++e) {
      vT[(q4 * 32 + c * 8 + 2 * e) * 72 + j] = (bf16_t)(vr.u[c][e] & 0xffffu);
      vT[(q4 * 32 + c * 8 + 2 * e + 1) * 72 + j] = (bf16_t)(vr.u[c][e] >> 16);
    }
  }
}

DI void gla_p1_item(const Params& P, int item, char* smem) {
  const bf16_t* proj = (const bf16_t*)(P.ws + R1);
  bf16_t* states = (bf16_t*)(P.ws + R2);
  float* decay = (float*)(P.ws + R_DECAY);
  float* sb = (float*)smem; float* sseg = sb + 64 * 65;
  bf16_t* kendT = (bf16_t*)(sseg + 256); bf16_t* vT = kendT + 64 * 72;
  const int n = item & 127, h = (item >> 7) & 3, b = item >> 9;
  const int tid = TIDX & 255, lane = tid & 63, wave = tid >> 6, l32 = lane & 31, kb = lane >> 5;
  VRegs vr; gla_load_v(proj, b, h, n, vr);
  u32x4 k0, k1;
  {
    const int j = tid & 63, dq = tid >> 6;
    const size_t t = (size_t)b * SEQ + n * 64 + j;
    k0 = *(const u32x4*)(proj + t * PW + C_GK + h * 64 + dq * 16); k1 = *(const u32x4*)(proj + t * PW + C_GK + h * 64 + dq * 16 + 8);
  }
  gla_gates(P, proj, b, h, n, sb, sseg, (float*)vT);
  {
    const int j = tid & 63, dq = tid >> 6;
    float kv[16];
#pragma unroll
    for (int e = 0; e < 4; ++e) { kv[2 * e] = bflo(k0[e]); kv[2 * e + 1] = bfhi(k0[e]); kv[8 + 2 * e] = bflo(k1[e]); kv[8 + 2 * e + 1] = bfhi(k1[e]); }
#pragma unroll
    for (int dd = 0; dd < 16; ++dd) {
      const int d = dq * 16 + dd;
      kendT[d * 72 + j] = f2bf(kv[dd] * __expf(sb[63 * 65 + d] - sb[j * 65 + d]));
    }
    if (tid < 64) decay[((size_t)(b * 4 + h) * 128 + n) * 64 + tid] = __expf(sb[63 * 65 + tid]);
  }
  gla_store_vT(vr, vT);
  __syncthreads();
#pragma unroll
  for (int dt = 0; dt < 2; ++dt) {
    f32x16 acc = zero16();
#pragma unroll
    for (int s = 0; s < 4; ++s) {
      const bf16x8 a = *(const bf16x8*)(vT + (wave * 32 + l32) * 72 + s * 16 + kb * 8);
      const bf16x8 bb = *(const bf16x8*)(kendT + (dt * 32 + l32) * 72 + s * 16 + kb * 8);
      acc = mfma(a, bb, acc);
    }
    bf16_t* dst = states + ((size_t)((b * 4 + h) * 128 + n) * 128) * 64;
#pragma unroll
    for (int r = 0; r < 16; ++r) dst[(size_t)(wave * 32 + crow(r, kb)) * 64 + dt * 32 + l32] = f2bf(acc[r]);
  }
  __syncthreads();
}

DI void gla_scan(const Params& P) {
  bf16_t* states = (bf16_t*)(P.ws + R2);
  const float* decay = (const float*)(P.ws + R_DECAY);
  const int total = 32 * 4096;
  for (int e = blockIdx.x * blockDim.x + TIDX; e < total; e += gridDim.x * blockDim.x) {
    const int bh = e >> 12, idx = (e & 4095) * 2, d = idx & 63;
    bf16_t* p = states + (size_t)bh * 128 * 8192 + idx;
    const float* dc = decay + (size_t)bh * 128 * 64 + d;
    float S0 = 0.f, S1 = 0.f;
#pragma unroll 8
    for (int n = 0; n < 128; ++n) {
      const unsigned ds = *(const unsigned*)(p + (size_t)n * 8192);
      const float2 dec = *(const float2*)(dc + n * 64);
      *(unsigned*)(p + (size_t)n * 8192) = pk2(S0, S1);
      S0 = dec.x * S0 + bflo(ds); S1 = dec.y * S1 + bfhi(ds);
    }
  }
}

DI void gla_p3_item(const Params& P, int item, char* smem) {
  const bf16_t* proj = (const bf16_t*)(P.ws + R1);
  const bf16_t* states = (const bf16_t*)(P.ws + R2);
  bf16_t* mix = (bf16_t*)(P.ws + R3);
  float* sb = (float*)smem; float* sseg = sb + 64 * 65; float* sred = sseg + 256;
  bf16_t* sq = (bf16_t*)(sred + 256); bf16_t* sk = sq + 64 * 72; bf16_t* vT = sk + 64 * 72;
  const int n = item & 127, h = (item >> 7) & 3, b = item >> 9;
  const int tid = TIDX & 255, lane = tid & 63, wave = tid >> 6, l32 = lane & 31, kb = lane >> 5;
  VRegs vr; gla_load_v(proj, b, h, n, vr);
  u32x4 q0, q1, k0, k1;
  bf16x8 sf[4];
  {
    const int i = tid & 63, dq = tid >> 6;
    const size_t t = (size_t)b * SEQ + n * 64 + i;
    q0 = *(const u32x4*)(proj + t * PW + C_GQ + h * 64 + dq * 16); q1 = *(const u32x4*)(proj + t * PW + C_GQ + h * 64 + dq * 16 + 8);
    k0 = *(const u32x4*)(proj + t * PW + C_GK + h * 64 + dq * 16); k1 = *(const u32x4*)(proj + t * PW + C_GK + h * 64 + dq * 16 + 8);
    const bf16_t* sp = states + ((size_t)((b * 4 + h) * 128 + n) * 128 + wave * 32 + l32) * 64;
#pragma unroll
    for (int s4 = 0; s4 < 4; ++s4) sf[s4] = *(const bf16x8*)(sp + s4 * 16 + kb * 8);
  }
  gla_gates(P, proj, b, h, n, sb, sseg, (float*)vT);
  {
    const int i = tid & 63, dq = tid >> 6;
    float qv[16], kv[16];
#pragma unroll
    for (int e = 0; e < 4; ++e) {
      qv[2 * e] = bflo(q0[e]); qv[2 * e + 1] = bfhi(q0[e]); qv[8 + 2 * e] = bflo(q1[e]); qv[8 + 2 * e + 1] = bfhi(q1[e]);
      kv[2 * e] = bflo(k0[e]); kv[2 * e + 1] = bfhi(k0[e]); kv[8 + 2 * e] = bflo(k1[e]); kv[8 + 2 * e + 1] = bfhi(k1[e]);
    }
#pragma unroll
    for (int dd = 0; dd < 16; ++dd) {
      const int d = dq * 16 + dd;
      const float bb = sb[i * 65 + d];
      sq[i * 72 + d] = f2bf(qv[dd] * 0.125f * __expf(bb));
      sk[i * 72 + d] = f2bf(kv[dd] * __expf(-bb));
    }
  }
  gla_store_vT(vr, vT);
  __syncthreads();
  f32x16 x00 = zero16(), x01 = zero16(), x11 = zero16();
#pragma unroll
  for (int s = 0; s < 4; ++s) {
    const bf16x8 kj0 = *(const bf16x8*)(sk + (l32)*72 + s * 16 + kb * 8);
    const bf16x8 kj1 = *(const bf16x8*)(sk + (32 + l32) * 72 + s * 16 + kb * 8);
    const bf16x8 qi0 = *(const bf16x8*)(sq + (l32)*72 + s * 16 + kb * 8);
    const bf16x8 qi1 = *(const bf16x8*)(sq + (32 + l32) * 72 + s * 16 + kb * 8);
    x00 = mfma(kj0, qi0, x00); x01 = mfma(kj0, qi1, x01); x11 = mfma(kj1, qi1, x11);
  }
#pragma unroll
  for (int r = 0; r < 16; ++r) { const bool keep = crow(r, kb) <= l32; x00[r] = keep ? x00[r] : 0.f; x11[r] = keep ? x11[r] : 0.f; }
  f32x16 o0 = zero16(), o1 = zero16();
  const int dvr = wave * 32 + l32;
#pragma unroll
  for (int s = 0; s < 2; ++s) {
    const bf16x8 p00 = pack8(x00[8 * s], x00[8 * s + 1], x00[8 * s + 2], x00[8 * s + 3], x00[8 * s + 4], x00[8 * s + 5], x00[8 * s + 6], x00[8 * s + 7]);
    const bf16x8 p01 = pack8(x01[8 * s], x01[8 * s + 1], x01[8 * s + 2], x01[8 * s + 3], x01[8 * s + 4], x01[8 * s + 5], x01[8 * s + 6], x01[8 * s + 7]);
    const bf16x8 p11 = pack8(x11[8 * s], x11[8 * s + 1], x11[8 * s + 2], x11[8 * s + 3], x11[8 * s + 4], x11[8 * s + 5], x11[8 * s + 6], x11[8 * s + 7]);
    const bf16x8 v0 = ld2x4(vT + dvr * 72 + 16 * s + 4 * kb);
    const bf16x8 v1 = ld2x4(vT + dvr * 72 + 32 + 16 * s + 4 * kb);
    o0 = mfma(v0, p00, o0); o1 = mfma(v0, p01, o1); o1 = mfma(v1, p11, o1);
  }
  {
#pragma unroll
    for (int s = 0; s < 4; ++s) {
      const bf16x8 a = sf[s];
      const bf16x8 qi0 = *(const bf16x8*)(sq + (l32)*72 + s * 16 + kb * 8);
      const bf16x8 qi1 = *(const bf16x8*)(sq + (32 + l32) * 72 + s * 16 + kb * 8);
      o0 = mfma(a, qi0, o0); o1 = mfma(a, qi1, o1);
    }
  }
  float s0 = 0.f, s1 = 0.f;
#pragma unroll
  for (int r = 0; r < 16; ++r) { s0 += o0[r] * o0[r]; s1 += o1[r] * o1[r]; }
  s0 += __shfl_xor(s0, 32); s1 += __shfl_xor(s1, 32);
  if (kb == 0) { sred[wave * 64 + l32] = s0; sred[wave * 64 + 32 + l32] = s1; }
  __syncthreads();
  const float t0s = sred[l32] + sred[64 + l32] + sred[128 + l32] + sred[192 + l32];
  const float t1s = sred[32 + l32] + sred[64 + 32 + l32] + sred[128 + 32 + l32] + sred[192 + 32 + l32];
  const float r0 = rsqrtf(t0s * (1.f / 128.f) + EPS), r1 = rsqrtf(t1s * (1.f / 128.f) + EPS);
#pragma unroll
  for (int it = 0; it < 2; ++it) {
    const size_t t = (size_t)b * SEQ + n * 64 + it * 32 + l32;
    const float rr = it ? r1 : r0;
#pragma unroll
    for (int gq = 0; gq < 4; ++gq) {
      const int dv = wave * 32 + 8 * gq + 4 * kb;
      const u32x2 ru = *(const u32x2*)(proj + t * PW + C_GR + h * 128 + dv);
      const float4 gn = *(const float4*)(P.gla_norm + h * 128 + dv);
      float rv[4] = {bflo(ru[0]), bfhi(ru[0]), bflo(ru[1]), bfhi(ru[1])};
      float gv[4] = {gn.x, gn.y, gn.z, gn.w};
      float ov[4];
#pragma unroll
      for (int e = 0; e < 4; ++e) {
        const float a = it ? o1[gq * 4 + e] : o0[gq * 4 + e];
        ov[e] = a * rr * gv[e] * (rv[e] * frcp(1.f + __expf(-rv[e])));
      }
      u32x2 o; o[0] = pk2(ov[0], ov[1]); o[1] = pk2(ov[2], ov[3]);
      *(u32x2*)(mix + t * DM + h * 128 + dv) = o;
    }
  }
  __syncthreads();
}

DI void nsa_compress_task(const Params& P, int task) {
  const bf16_t* proj = (const bf16_t*)(P.ws + R1);
  const int lane = TIDX & 63, l32 = lane & 31, kb = lane >> 5;
  const int ct = task & 15, g = (task >> 4) & 1, b = (task >> 5) & 7, br = task >> 8;
  const bf16_t* w1T = (const bf16_t*)(P.ws + W_CW1) + (size_t)br * 128 * 2048;
  const bf16_t* w2T = (const bf16_t*)(P.ws + W_CW2) + (size_t)br * 64 * 128;
  const float* bias1 = (const float*)(P.ws + W_BIAS1) + br * 128;
  const int c = ct * 32 + l32;
  const int cc = c < 511 ? c : 510;
  const bf16_t* src = proj + ((size_t)b * SEQ + cc * 16) * PW + (br ? C_VC : C_KC) + g * 64 + kb * 8;
  f32x16 acc[4];
#pragma unroll
  for (int i = 0; i < 4; ++i) acc[i] = zero16();
#pragma unroll 1
  for (int ks = 0; ks < 128; ++ks) {
    const int l = ks >> 2, dh0 = (ks & 3) * 16;
    const bf16x8 bf = *(const bf16x8*)(src + (size_t)l * PW + dh0);
#pragma unroll
    for (int ht = 0; ht < 4; ++ht) {
      const bf16x8 af = *(const bf16x8*)(w1T + (size_t)(ht * 32 + l32) * 2048 + ks * 16 + kb * 8);
      acc[ht] = mfma(af, bf, acc[ht]);
    }
  }
#pragma unroll
  for (int ht = 0; ht < 4; ++ht)
#pragma unroll
    for (int r = 0; r < 16; ++r) acc[ht][r] = gelu_tanh(acc[ht][r] + bias1[ht * 32 + crow(r, kb)]);
  f32x16 o[2]; o[0] = zero16(); o[1] = zero16();
#pragma unroll
  for (int ht = 0; ht < 4; ++ht)
#pragma unroll
    for (int s = 0; s < 2; ++s) {
      const bf16x8 hf = pack8(acc[ht][8 * s], acc[ht][8 * s + 1], acc[ht][8 * s + 2], acc[ht][8 * s + 3], acc[ht][8 * s + 4], acc[ht][8 * s + 5], acc[ht][8 * s + 6], acc[ht][8 * s + 7]);
#pragma unroll
      for (int dt = 0; dt < 2; ++dt) {
        const bf16x8 wf = ld2x4(w2T + (size_t)(dt * 32 + l32) * 128 + ht * 32 + 16 * s + 4 * kb);
        o[dt] = mfma(wf, hf, o[dt]);
      }
    }
  if (c < 511) {
    {
      bf16_t* dst = (bf16_t*)(P.ws + (br ? R_VCMPT : R_KCMP)) + ((size_t)(b * 2 + g) * 512 + c) * 64;
#pragma unroll
      for (int dt = 0; dt < 2; ++dt)
#pragma unroll
        for (int gq = 0; gq < 4; ++gq) {
          u32x2 u; u[0] = pk2(o[dt][gq * 4], o[dt][gq * 4 + 1]); u[1] = pk2(o[dt][gq * 4 + 2], o[dt][gq * 4 + 3]);
          *(u32x2*)(dst + dt * 32 + 8 * gq + 4 * kb) = u;
        }
    }
  }
}

DI void nsa_transpose_v(const Params& P) {
  const bf16_t* proj = (const bf16_t*)(P.ws + R1);
  const int total = 2 * 8 * 2 * 1024 * 64;
  for (int u = blockIdx.x * blockDim.x + TIDX; u < total; u += gridDim.x * blockDim.x) {
    const int dh = u & 63; int rest = u >> 6; const int t8 = rest & 1023; rest >>= 10;
    const int g = rest & 1, b = (rest >> 1) & 7, which = rest >> 4;
    const bf16_t* src = proj + ((size_t)b * SEQ + t8 * 8) * PW + (which ? C_VW : C_VS) + g * 64 + dh;
    bf16_t v[8];
#pragma unroll
    for (int j = 0; j < 8; ++j) v[j] = src[(size_t)j * PW];
    u32x4 o;
#pragma unroll
    for (int j = 0; j < 4; ++j) o[j] = (unsigned)v[2 * j] | ((unsigned)v[2 * j + 1] << 16);
    bf16_t* dst = (bf16_t*)(P.ws + (which ? R_VWT : R_VST)) + ((size_t)(b * 2 + g) * 64 + dh) * SEQ + t8 * 8;
    *(u32x4*)dst = o;
  }
}

DI f32x16 qk_tile(const bf16_t* krow, const bf16x8 (&qf)[4]) {
  f32x16 s = zero16();
#pragma unroll
  for (int i = 0; i < 4; ++i) { const bf16x8 kf = *(const bf16x8*)(krow + i * 16); s = mfma(kf, qf[i], s); }
  return s;
}

DI float half_max(float x) {
  const auto r = __builtin_amdgcn_permlane32_swap(__float_as_uint(x), __float_as_uint(x), false, false);
  return fmaxf(__uint_as_float(r[0]), __uint_as_float(r[1]));
}
DI float half_sum(float x) {
  const auto r = __builtin_amdgcn_permlane32_swap(__float_as_uint(x), __float_as_uint(x), false, false);
  return __uint_as_float(r[0]) + __uint_as_float(r[1]);
}
DI s16x4 lds_tr(const char* p) { return __builtin_amdgcn_ds_read_tr16_b64_v4i16((__attribute__((address_space(3))) s16x4*)p); }

template <bool EDGE>
DI void softmax_tile(f32x16& s, int k0, int tq, int lo, bool bit, int kb, f32x16& o0, f32x16& o1, float& m, float& l) {
  constexpr float CS = 0.125f * 1.4426950408889634f;
  float tmax = -1e30f;
  if (EDGE) {
#pragma unroll
    for (int r = 0; r < 16; ++r) {
      const int key = k0 + crow(r, kb);
      const bool vd = (key <= tq) && (key > lo);
      s[r] = vd ? s[r] * CS : -1e30f;
      tmax = fmaxf(tmax, s[r]);
    }
  } else {
#pragma unroll
    for (int r = 0; r < 16; ++r) tmax = fmaxf(tmax, s[r]);
    tmax *= CS;
  }
  tmax = bit ? tmax : -1e30f;
  tmax = half_max(tmax);
  if (__ballot(tmax > m + 8.0f) != 0ull) {
    const float mn = fmaxf(m, tmax);
    const float alpha = __builtin_amdgcn_exp2f(m - mn);
    l *= alpha; m = mn;
#pragma unroll
    for (int r = 0; r < 16; ++r) { o0[r] *= alpha; o1[r] *= alpha; }
  }
  float ps = 0.f;
  if (EDGE) {
    const bool live = bit && (m > -5e29f);
#pragma unroll
    for (int r = 0; r < 16; ++r) {
      const float e = __builtin_amdgcn_exp2f(s[r] - m);
      s[r] = live ? e : 0.f;
      ps += s[r];
    }
  } else {
    const float me = bit ? m : 1e30f;
#pragma unroll
    for (int r = 0; r < 16; ++r) {
      s[r] = __builtin_amdgcn_exp2f(__builtin_fmaf(s[r], CS, -me));
      ps += s[r];
    }
  }
  l += ps;
}

struct HeadAcc { f32x16 o0, o1; float m, l; };

template <bool EDGE>
DI void attn_step2(const bf16_t* sKt, const char* sVt, const bf16x8 (&qa)[4], const bf16x8 (&qb)[4], int k0, int tq, int lo, bool bit,
                   int lane, HeadAcc& A, HeadAcc& B) {
  const int l32 = lane & 31, kb = lane >> 5, i16 = lane & 15, q = i16 >> 2, p = i16 & 3, gc = (lane >> 4) & 1;
  f32x16 sa = zero16(), sb = zero16();
#pragma unroll
  for (int i = 0; i < 4; ++i) {
    const bf16x8 kf = *(const bf16x8*)(sKt + l32 * 72 + i * 16 + kb * 8);
    sa = mfma(kf, qa[i], sa); sb = mfma(kf, qb[i], sb);
  }
  bf16x8 vf[2][2];
#pragma unroll
  for (int dt = 0; dt < 2; ++dt)
#pragma unroll
    for (int sI = 0; sI < 2; ++sI) {
      const char* vp = sVt + (16 * sI + 4 * kb + q) * 144 + (dt * 32 + gc * 16 + 4 * p) * 2;
      const s16x4 lo4 = lds_tr(vp), hi4 = lds_tr(vp + 8 * 144);
      vf[dt][sI] = __builtin_shufflevector(lo4, hi4, 0, 1, 2, 3, 4, 5, 6, 7);
    }
  softmax_tile<EDGE>(sa, k0, tq, lo, bit, kb, A.o0, A.o1, A.m, A.l);
  softmax_tile<EDGE>(sb, k0, tq, lo, bit, kb, B.o0, B.o1, B.m, B.l);
#pragma unroll
  for (int sI = 0; sI < 2; ++sI) {
    const bf16x8 pa = pack8(sa[8 * sI], sa[8 * sI + 1], sa[8 * sI + 2], sa[8 * sI + 3], sa[8 * sI + 4], sa[8 * sI + 5], sa[8 * sI + 6], sa[8 * sI + 7]);
    const bf16x8 pb = pack8(sb[8 * sI], sb[8 * sI + 1], sb[8 * sI + 2], sb[8 * sI + 3], sb[8 * sI + 4], sb[8 * sI + 5], sb[8 * sI + 6], sb[8 * sI + 7]);
    A.o0 = mfma(vf[0][sI], pa, A.o0); A.o1 = mfma(vf[1][sI], pa, A.o1);
    B.o0 = mfma(vf[0][sI], pb, B.o0); B.o1 = mfma(vf[1][sI], pb, B.o1);
  }
}

template <bool WIN>
DI void nsa_branch2(const bf16_t* kbase, const bf16_t* vbase, char* smem, int st0, int st1, int qt, int tq, const bf16x8 (&qa)[4],
                    const bf16x8 (&qb)[4], unsigned mk0, unsigned mk1, unsigned mk2, unsigned mk3, HeadAcc& A, HeadAcc& B) {
  const int tid = TIDX, lane = tid & 63;
  const int srow = tid >> 3, schunk = (tid & 7) * 8;
  const bf16_t* kg = kbase + (size_t)srow * PW + schunk;
  const bf16_t* vg = vbase + (size_t)srow * PW + schunk;
  const int soff = (srow * 72 + schunk) * 2;
  u32x4 rk = *(const u32x4*)(kg + (size_t)st0 * 64 * PW), rv = *(const u32x4*)(vg + (size_t)st0 * 64 * PW);
  *(u32x4*)(smem + soff) = rk; *(u32x4*)(smem + 9216 + soff) = rv;
  __syncthreads();
  for (int st = st0; st <= st1; ++st) {
    const int cur = (st - st0) & 1;
    if (st < st1) { rk = *(const u32x4*)(kg + (size_t)(st + 1) * 64 * PW); rv = *(const u32x4*)(vg + (size_t)(st + 1) * 64 * PW); }
    const bf16_t* bK = (const bf16_t*)(smem + cur * 18432);
    const char* bV = smem + cur * 18432 + 9216;
    bool bit = true;
    if (!WIN) { const unsigned mw = st < 32 ? mk0 : (st < 64 ? mk1 : (st < 96 ? mk2 : mk3)); bit = (mw >> (st & 31)) & 1u; }
    const bool any = WIN ? true : (__ballot(bit) != 0ull);
#pragma unroll
    for (int tt = 0; tt < 2; ++tt) {
      const int kt = 2 * st + tt;
      const bool in_range = WIN ? (kt <= qt && kt >= qt - 16) : (kt <= qt);
      if (in_range && any) {
        const bool edge = WIN ? (kt == qt || kt == qt - 16) : (kt == qt);
        if (edge) attn_step2<true>(bK + tt * 32 * 72, bV + tt * 32 * 144, qa, qb, kt * 32, tq, WIN ? tq - 512 : -1, bit, lane, A, B);
        else attn_step2<false>(bK + tt * 32 * 72, bV + tt * 32 * 144, qa, qb, kt * 32, tq, WIN ? tq - 512 : -1, bit, lane, A, B);
      }
    }
    if (st < st1) { *(u32x4*)(smem + (cur ^ 1) * 18432 + soff) = rk; *(u32x4*)(smem + (cur ^ 1) * 18432 + 9216 + soff) = rv; }
    __syncthreads();
  }
}

DI void fold_partial(bf16_t* dst, float f, const f32x16& a0, const f32x16& a1, int kb) {
#pragma unroll
  for (int gq = 0; gq < 4; ++gq) {
    bf16_t* d0 = dst + 8 * gq + 4 * kb;
    bf16_t* d1 = d0 + 32;
    const u32x2 p0 = *(const u32x2*)d0, p1 = *(const u32x2*)d1;
    u32x2 u0, u1;
    u0[0] = pk2(bflo(p0[0]) + f * a0[gq * 4], bfhi(p0[0]) + f * a0[gq * 4 + 1]);
    u0[1] = pk2(bflo(p0[1]) + f * a0[gq * 4 + 2], bfhi(p0[1]) + f * a0[gq * 4 + 3]);
    u1[0] = pk2(bflo(p1[0]) + f * a1[gq * 4], bfhi(p1[0]) + f * a1[gq * 4 + 1]);
    u1[1] = pk2(bflo(p1[1]) + f * a1[gq * 4 + 2], bfhi(p1[1]) + f * a1[gq * 4 + 3]);
    *(u32x2*)d0 = u0; *(u32x2*)d1 = u1;
  }
}

template <bool ADD>
DI void lds_fold(bf16_t* scr, int hoff, float f, const f32x16& a0, const f32x16& a1, int l32, int kb) {
#pragma unroll
  for (int gq = 0; gq < 4; ++gq) {
    bf16_t* d0 = scr + l32 * 136 + hoff + 8 * gq + 4 * kb;
    bf16_t* d1 = d0 + 32;
    u32x2 u0, u1;
    if (ADD) {
      const u32x2 p0 = *(const u32x2*)d0, p1 = *(const u32x2*)d1;
      u0[0] = pk2(bflo(p0[0]) + f * a0[gq * 4], bfhi(p0[0]) + f * a0[gq * 4 + 1]);
      u0[1] = pk2(bflo(p0[1]) + f * a0[gq * 4 + 2], bfhi(p0[1]) + f * a0[gq * 4 + 3]);
      u1[0] = pk2(bflo(p1[0]) + f * a1[gq * 4], bfhi(p1[0]) + f * a1[gq * 4 + 1]);
      u1[1] = pk2(bflo(p1[1]) + f * a1[gq * 4 + 2], bfhi(p1[1]) + f * a1[gq * 4 + 3]);
    } else {
      u0[0] = pk2(f * a0[gq * 4], f * a0[gq * 4 + 1]); u0[1] = pk2(f * a0[gq * 4 + 2], f * a0[gq * 4 + 3]);
      u1[0] = pk2(f * a1[gq * 4], f * a1[gq * 4 + 1]); u1[1] = pk2(f * a1[gq * 4 + 2], f * a1[gq * 4 + 3]);
    }
    *(u32x2*)d0 = u0; *(u32x2*)d1 = u1;
  }
}

DI void nsa_block(const Params& P, int b, int g, int qb, char* smem) {
  const int wv = __builtin_amdgcn_readfirstlane(TIDX >> 6);
  const int qt = qb * 8 + wv;
  float* imp = (float*)smem + wv * 4096;
  const bf16_t* proj = (const bf16_t*)(P.ws + R1);
  bf16_t* mix = (bf16_t*)(P.ws + R3);
  const int lane = TIDX & 63, l32 = lane & 31, kb = lane >> 5;
  const int t0 = qt * 32, tq = t0 + l32;
  const size_t tokq = (size_t)b * SEQ + tq;
  const bf16_t* qrow = proj + tokq * PW;
  const bf16_t* kcmp = (const bf16_t*)(P.ws + R_KCMP) + (size_t)(b * 2 + g) * 512 * 64;
  const bf16_t* vcmp = (const bf16_t*)(P.ws + R_VCMPT) + (size_t)(b * 2 + g) * 512 * 64;
  const int nct = (qb >> 1) + 1;
  const int nst = (nct + 1) >> 1;
  for (int i = lane; i < 4096; i += 64) imp[i] = 0.f;
  {
    constexpr float CS = 0.125f * 1.4426950408889634f;
    char* stg = smem + LDS_CMP_STAGE;
    const int tid = TIDX;
    const int srow = tid >> 3, schunk = (tid & 7) * 8, soff = (srow * 72 + schunk) * 2;
    const int i16 = lane & 15, q4 = i16 >> 2, p4 = i16 & 3, gc = (lane >> 4) & 1;
#pragma unroll 1
    for (int hp = 0; hp < 2; ++hp) {
      const int head = g * 4 + hp * 2;
      bf16x8 qa[4], qb_[4];
#pragma unroll
      for (int i = 0; i < 4; ++i) {
        qa[i] = *(const bf16x8*)(qrow + C_NQ + head * 64 + i * 16 + kb * 8);
        qb_[i] = *(const bf16x8*)(qrow + C_NQ + (head + 1) * 64 + i * 16 + kb * 8);
      }
      float mA = -1e30f, lA = 0.f, mB = -1e30f, lB = 0.f;
      u32x4 rk = *(const u32x4*)(kcmp + (size_t)srow * 64 + schunk), rv;
      for (int st = 0; st < nst; ++st) {
        *(u32x4*)(stg + soff) = rk;
        __syncthreads();
        if (st + 1 < nst) rk = *(const u32x4*)(kcmp + (size_t)((st + 1) * 64 + srow) * 64 + schunk);
#pragma unroll
        for (int tt = 0; tt < 2; ++tt) {
          const int ct = 2 * st + tt;
          if (ct < nct) {
            const bf16_t* sKt = (const bf16_t*)stg + tt * 32 * 72;
            f32x16 sa = zero16(), sb = zero16();
#pragma unroll
            for (int i = 0; i < 4; ++i) {
              const bf16x8 kf = *(const bf16x8*)(sKt + l32 * 72 + i * 16 + kb * 8);
              sa = mfma(kf, qa[i], sa); sb = mfma(kf, qb_[i], sb);
            }
            float tA = -1e30f, tB = -1e30f;
#pragma unroll
            for (int r = 0; r < 16; ++r) {
              const int c = ct * 32 + crow(r, kb);
              const bool vd = (c * 16 + 31 <= tq);
              sa[r] = vd ? sa[r] * CS : -1e30f; sb[r] = vd ? sb[r] * CS : -1e30f;
              tA = fmaxf(tA, sa[r]); tB = fmaxf(tB, sb[r]);
            }
            const float nA = fmaxf(mA, tA), nB = fmaxf(mB, tB);
            float pA = 0.f, pB = 0.f;
#pragma unroll
            for (int r = 0; r < 16; ++r) {
              pA += (sa[r] > -5e29f) ? __builtin_amdgcn_exp2f(sa[r] - nA) : 0.f;
              pB += (sb[r] > -5e29f) ? __builtin_amdgcn_exp2f(sb[r] - nB) : 0.f;
            }
            lA = lA * __builtin_amdgcn_exp2f(mA - nA) + pA; mA = nA;
            lB = lB * __builtin_amdgcn_exp2f(mB - nB) + pB; mB = nB;
          }
        }
        __syncthreads();
      }
      float MA, iLA, MB, iLB;
      {
        const float mo = __shfl_xor(mA, 32), lo_ = __shfl_xor(lA, 32);
        MA = fmaxf(mA, mo);
        iLA = frcp(fmaxf(lA * __builtin_amdgcn_exp2f(mA - MA) + lo_ * __builtin_amdgcn_exp2f(mo - MA), 1e-30f));
        const float mo2 = __shfl_xor(mB, 32), lo2 = __shfl_xor(lB, 32);
        MB = fmaxf(mB, mo2);
        iLB = frcp(fmaxf(lB * __builtin_amdgcn_exp2f(mB - MB) + lo2 * __builtin_amdgcn_exp2f(mo2 - MB), 1e-30f));
      }
      f32x16 oA0 = zero16(), oA1 = zero16(), oB0 = zero16(), oB1 = zero16();
      float carry = 0.f;
      rk = *(const u32x4*)(kcmp + (size_t)srow * 64 + schunk); rv = *(const u32x4*)(vcmp + (size_t)srow * 64 + schunk);
      for (int st = 0; st < nst; ++st) {
        *(u32x4*)(stg + soff) = rk; *(u32x4*)(stg + 9216 + soff) = rv;
        __syncthreads();
        if (st + 1 < nst) {
          rk = *(const u32x4*)(kcmp + (size_t)((st + 1) * 64 + srow) * 64 + schunk);
          rv = *(const u32x4*)(vcmp + (size_t)((st + 1) * 64 + srow) * 64 + schunk);
        }
#pragma unroll
        for (int tt = 0; tt < 2; ++tt) {
          const int ct = 2 * st + tt;
          if (ct < nct) {
            const bf16_t* sKt = (const bf16_t*)stg + tt * 32 * 72;
            const char* sVt = stg + 9216 + tt * 32 * 144;
            f32x16 sa = zero16(), sb = zero16();
#pragma unroll
            for (int i = 0; i < 4; ++i) {
              const bf16x8 kf = *(const bf16x8*)(sKt + l32 * 72 + i * 16 + kb * 8);
              sa = mfma(kf, qa[i], sa); sb = mfma(kf, qb_[i], sb);
            }
            bf16x8 vf[2][2];
#pragma unroll
            for (int dt = 0; dt < 2; ++dt)
#pragma unroll
              for (int sI = 0; sI < 2; ++sI) {
                const char* vp = sVt + (16 * sI + 4 * kb + q4) * 144 + (dt * 32 + gc * 16 + 4 * p4) * 2;
                const s16x4 lo4 = lds_tr(vp), hi4 = lds_tr(vp + 8 * 144);
                vf[dt][sI] = __builtin_shufflevector(lo4, hi4, 0, 1, 2, 3, 4, 5, 6, 7);
              }
            f32x16 ps;
#pragma unroll
            for (int r = 0; r < 16; ++r) {
              const int c = ct * 32 + crow(r, kb);
              const bool vd = (c * 16 + 31 <= tq);
              sa[r] = vd ? __builtin_amdgcn_exp2f(__builtin_fmaf(sa[r], CS, -MA)) * iLA : 0.f;
              sb[r] = vd ? __builtin_amdgcn_exp2f(__builtin_fmaf(sb[r], CS, -MB)) * iLB : 0.f;
              ps[r] = sa[r] + sb[r];
            }
            float y[4];
#pragma unroll
            for (int gi = 0; gi < 4; ++gi) y[gi] = __shfl_xor(ps[4 * gi + 3], 32);
#pragma unroll
            for (int gi = 0; gi < 4; ++gi) {
              const float s4 = (ps[4 * gi] + ps[4 * gi + 1]) + (ps[4 * gi + 2] + ps[4 * gi + 3]);
              const float extra = kb ? y[gi] : (gi == 0 ? carry : y[gi > 0 ? gi - 1 : 0]);
              const int j = ct * 8 + 2 * gi + kb;
              imp[j * 32 + l32] += s4 + extra;
            }
            carry = y[3];
#pragma unroll
            for (int sI = 0; sI < 2; ++sI) {
              const bf16x8 pa = pack8(sa[8 * sI], sa[8 * sI + 1], sa[8 * sI + 2], sa[8 * sI + 3], sa[8 * sI + 4], sa[8 * sI + 5], sa[8 * sI + 6], sa[8 * sI + 7]);
              const bf16x8 pb = pack8(sb[8 * sI], sb[8 * sI + 1], sb[8 * sI + 2], sb[8 * sI + 3], sb[8 * sI + 4], sb[8 * sI + 5], sb[8 * sI + 6], sb[8 * sI + 7]);
              oA0 = mfma(vf[0][sI], pa, oA0); oA1 = mfma(vf[1][sI], pa, oA1);
              oB0 = mfma(vf[0][sI], pb, oB0); oB1 = mfma(vf[1][sI], pb, oB1);
            }
          }
        }
        __syncthreads();
      }
      const float gA = sigmoidf_(bf2f(qrow[C_NG + head * 3 + 0]) + P.nsa_gate_b[head * 3 + 0]);
      const float gB = sigmoidf_(bf2f(qrow[C_NG + (head + 1) * 3 + 0]) + P.nsa_gate_b[(head + 1) * 3 + 0]);
#pragma unroll
      for (int gq = 0; gq < 4; ++gq) {
        u32x2 u0, u1, u2, u3;
        u0[0] = pk2(gA * oA0[gq * 4], gA * oA0[gq * 4 + 1]); u0[1] = pk2(gA * oA0[gq * 4 + 2], gA * oA0[gq * 4 + 3]);
        u1[0] = pk2(gA * oA1[gq * 4], gA * oA1[gq * 4 + 1]); u1[1] = pk2(gA * oA1[gq * 4 + 2], gA * oA1[gq * 4 + 3]);
        u2[0] = pk2(gB * oB0[gq * 4], gB * oB0[gq * 4 + 1]); u2[1] = pk2(gB * oB0[gq * 4 + 2], gB * oB0[gq * 4 + 3]);
        u3[0] = pk2(gB * oB1[gq * 4], gB * oB1[gq * 4 + 1]); u3[1] = pk2(gB * oB1[gq * 4 + 2], gB * oB1[gq * 4 + 3]);
        bf16_t* d = mix + tokq * DM + 512 + head * 64 + 8 * gq + 4 * kb;
        *(u32x2*)d = u0; *(u32x2*)(d + 32) = u1; *(u32x2*)(d + 64) = u2; *(u32x2*)(d + 96) = u3;
      }
    }
  }
  asm volatile("s_waitcnt lgkmcnt(0)" ::: "memory");
  __builtin_amdgcn_wave_barrier();
  unsigned mk0 = 0, mk1 = 0, mk2 = 0, mk3 = 0;
  {
    const int cur = tq >> 6, jb = kb * 64;
    unsigned key[64];
#pragma unroll
    for (int i = 0; i < 64; ++i) {
      const int j = jb + i;
      const float v = imp[j * 32 + l32];
      const bool forced = (j == 0) || (j == cur) || (j == cur - 1);
      key[i] = forced ? 0xffffffffu : (j <= cur ? __float_as_uint(v) + 1u : 0u);
    }
    unsigned T = 0u;
#pragma unroll 1
    for (int bit = 31; bit >= 0; --bit) {
      const unsigned Tc = T | (1u << bit);
      int cnt = 0;
#pragma unroll
      for (int i = 0; i < 64; ++i) cnt += (key[i] >= Tc) ? 1 : 0;
      const auto r = __builtin_amdgcn_permlane32_swap((unsigned)cnt, (unsigned)cnt, false, false);
      cnt = (int)(r[0] + r[1]);
      T = (cnt >= 16) ? Tc : T;
    }
    int cgt = 0, ceq = 0;
#pragma unroll
    for (int i = 0; i < 64; ++i) { cgt += (key[i] > T) ? 1 : 0; ceq += (key[i] == T) ? 1 : 0; }
    const auto rg = __builtin_amdgcn_permlane32_swap((unsigned)cgt, (unsigned)cgt, false, false);
    const int need = 16 - (int)(rg[0] + rg[1]);
    const auto re = __builtin_amdgcn_permlane32_swap((unsigned)ceq, (unsigned)ceq, false, false);
    int running = kb ? (int)(re[0] + re[1]) - ceq : 0;
    unsigned mlo = 0u, mhi = 0u;
#pragma unroll
    for (int i = 0; i < 64; ++i) {
      const bool eq = key[i] == T;
      const bool sl = (key[i] != 0u) && ((key[i] > T) || (eq && running < need));
      running += eq ? 1 : 0;
      if (i < 32) mlo |= sl ? (1u << i) : 0u; else mhi |= sl ? (1u << (i - 32)) : 0u;
    }
    const auto rl = __builtin_amdgcn_permlane32_swap(mlo, mlo, false, false);
    const auto rh = __builtin_amdgcn_permlane32_swap(mhi, mhi, false, false);
    const unsigned olo = rl[0] ^ rl[1] ^ mlo, ohi = rh[0] ^ rh[1] ^ mhi;
    mk0 = kb ? olo : mlo; mk1 = kb ? ohi : mhi; mk2 = kb ? mlo : olo; mk3 = kb ? mhi : ohi;
  }
  asm volatile("" ::: "memory");
  __syncthreads();
  const bf16_t* ksel = proj + (size_t)b * SEQ * PW + C_KS + g * 64;
  const bf16_t* vsel = proj + (size_t)b * SEQ * PW + C_VS + g * 64;
  const bf16_t* kwin = proj + (size_t)b * SEQ * PW + C_KW + g * 64;
  const bf16_t* vwin = proj + (size_t)b * SEQ * PW + C_VW + g * 64;
  const int st1 = 4 * qb + 3, wst0 = qb > 2 ? 4 * qb - 8 : 0;
#pragma unroll 1
  for (int hp = 0; hp < 2; ++hp) {
    const int head = g * 4 + hp * 2;
    bf16x8 qa[4], qb_[4];
#pragma unroll
    for (int i = 0; i < 4; ++i) {
      qa[i] = *(const bf16x8*)(qrow + C_NQ + head * 64 + i * 16 + kb * 8);
      qb_[i] = *(const bf16x8*)(qrow + C_NQ + (head + 1) * 64 + i * 16 + kb * 8);
    }
    bf16_t* scr = (bf16_t*)(smem + 40960 + wv * 8704);
    HeadAcc A, B;
    A.o0 = zero16(); A.o1 = zero16(); A.m = -1e30f; A.l = 0.f; B.o0 = zero16(); B.o1 = zero16(); B.m = -1e30f; B.l = 0.f;
    nsa_branch2<false>(ksel, vsel, smem, 0, st1, qt, tq, qa, qb_, mk0, mk1, mk2, mk3, A, B);
    {
      const float gA = sigmoidf_(bf2f(qrow[C_NG + head * 3 + 1]) + P.nsa_gate_b[head * 3 + 1]);
      const float gB = sigmoidf_(bf2f(qrow[C_NG + (head + 1) * 3 + 1]) + P.nsa_gate_b[(head + 1) * 3 + 1]);
      lds_fold<false>(scr, 0, gA * frcp(fmaxf(half_sum(A.l), 1e-30f)), A.o0, A.o1, l32, kb);
      lds_fold<false>(scr, 64, gB * frcp(fmaxf(half_sum(B.l), 1e-30f)), B.o0, B.o1, l32, kb);
    }
    A.o0 = zero16(); A.o1 = zero16(); A.m = -1e30f; A.l = 0.f; B.o0 = zero16(); B.o1 = zero16(); B.m = -1e30f; B.l = 0.f;
    nsa_branch2<true>(kwin, vwin, smem, wst0, st1, qt, tq, qa, qb_, 0u, 0u, 0u, 0u, A, B);
    {
      const float gA = sigmoidf_(bf2f(qrow[C_NG + head * 3 + 2]) + P.nsa_gate_b[head * 3 + 2]);
      const float gB = sigmoidf_(bf2f(qrow[C_NG + (head + 1) * 3 + 2]) + P.nsa_gate_b[(head + 1) * 3 + 2]);
      lds_fold<true>(scr, 0, gA * frcp(fmaxf(half_sum(A.l), 1e-30f)), A.o0, A.o1, l32, kb);
      lds_fold<true>(scr, 64, gB * frcp(fmaxf(half_sum(B.l), 1e-30f)), B.o0, B.o1, l32, kb);
    }
    asm volatile("s_waitcnt lgkmcnt(0)" ::: "memory");
    __builtin_amdgcn_wave_barrier();
    {
      bf16_t* mrow = mix + ((size_t)b * SEQ + t0) * DM + 512 + head * 64;
#pragma unroll
      for (int i = 0; i < 8; ++i) {
        const int c = lane + 64 * i, token = c >> 4, col = (c & 15) * 8;
        const u32x4 sv = *(const u32x4*)(scr + token * 136 + col);
        bf16_t* gp = mrow + (size_t)token * DM + col;
        const u32x4 gv = *(const u32x4*)gp;
        u32x4 o;
#pragma unroll
        for (int e = 0; e < 4; ++e) o[e] = pk2(bflo(sv[e]) + bflo(gv[e]), bfhi(sv[e]) + bfhi(gv[e]));
        *(u32x4*)gp = o;
      }
    }
    asm volatile("s_waitcnt lgkmcnt(0)" ::: "memory");
    __builtin_amdgcn_wave_barrier();
  }
}

DI void sgu_item(const Params& P, int item, char* smem) {
  const bf16_t* H = (const bf16_t*)(P.ws + R1);
  bf16_t* Y = (bf16_t*)P.out;
  float* smu = (float*)smem; float* srs = smu + 128; float* sc1 = srs + 128; float* srw = sc1 + 128; float* slg = srw + 128; float* slb = slg + 256;
  bf16_t* sW = (bf16_t*)(smem + 4096);
  char* sV = smem + 4096 + 34816;
  const int tid = TIDX, lane = tid & 63, wave = __builtin_amdgcn_readfirstlane(tid >> 6), l32 = lane & 31, kb = lane >> 5;
  const size_t tok0 = (size_t)item * 128;
#pragma unroll 1
  for (int tb = 0; tb < 16; tb += 4) {
    u32x4 uu[4][4];
#pragma unroll
    for (int a = 0; a < 4; ++a)
#pragma unroll
      for (int k = 0; k < 4; ++k) uu[a][k] = *(const u32x4*)(H + (tok0 + wave * 16 + tb + a) * 4096 + 2048 + k * 512 + lane * 8);
#pragma unroll
    for (int a = 0; a < 4; ++a) {
      float sm = 0.f, s2 = 0.f;
#pragma unroll
      for (int k = 0; k < 4; ++k)
#pragma unroll
        for (int e = 0; e < 4; ++e) { const float x0 = bflo(uu[a][k][e]), x1 = bfhi(uu[a][k][e]); sm += x0 + x1; s2 += x0 * x0 + x1 * x1; }
      sm = wave_sum(sm); s2 = wave_sum(s2);
      const float mu = sm * (1.f / 2048.f);
      const float var = fmaxf(s2 * (1.f / 2048.f) - mu * mu, 0.f);
      if (lane == 0) { smu[wave * 16 + tb + a] = mu; srs[wave * 16 + tb + a] = rsqrtf(var + EPS); }
    }
  }
  __syncthreads();
  const int srow = tid >> 5, schunk = tid & 31;
#pragma unroll 1
  for (int g = 0; g < 8; ++g) {
    u32x4 vreg[8], ureg[8];
#pragma unroll
    for (int i = 0; i < 8; ++i) {
      const bf16_t* hp = H + (tok0 + srow + 16 * i) * 4096 + g * 256 + schunk * 8;
      vreg[i] = *(const u32x4*)(hp + 2048);
      ureg[i] = *(const u32x4*)hp;
    }
    {
      const int t = tid >> 2, qr = tid & 3;
      const float* wrow = P.o_w_s + ((size_t)g * 128 + t) * 128 + qr * 32;
      float4 wq[8];
#pragma unroll
      for (int c4 = 0; c4 < 8; ++c4) wq[c4] = *(const float4*)(wrow + c4 * 4);
      float c1 = 0.f, rw = 0.f;
#pragma unroll
      for (int c8 = 0; c8 < 4; ++c8) {
        const float4 f0 = wq[2 * c8], f1 = wq[2 * c8 + 1];
        float wv[8] = {f0.x, f0.y, f0.z, f0.w, f1.x, f1.y, f1.z, f1.w};
        float ov[8];
#pragma unroll
        for (int e = 0; e < 8; ++e) {
          const int sx = qr * 32 + c8 * 8 + e;
          const float w = (sx <= t) ? wv[e] : 0.f;
          rw += w;
          const float wp = bf2f(f2bf(w * srs[sx]));
          c1 += wp * smu[sx];
          ov[e] = wp;
        }
        u32x4 o; o[0] = pk2(ov[0], ov[1]); o[1] = pk2(ov[2], ov[3]); o[2] = pk2(ov[4], ov[5]); o[3] = pk2(ov[6], ov[7]);
        *(u32x4*)(sW + t * 136 + qr * 32 + c8 * 8) = o;
      }
      c1 += __shfl_xor(c1, 1); rw += __shfl_xor(rw, 1);
      c1 += __shfl_xor(c1, 2); rw += __shfl_xor(rw, 2);
      if (qr == 0) { sc1[t] = c1; srw[t] = rw; }
      if (tid < 256) { slg[tid] = P.o_ln_g[g * 256 + tid]; slb[tid] = P.o_ln_b[g * 256 + tid]; }
    }
#pragma unroll
    for (int i = 0; i < 8; ++i) *(u32x4*)(sV + (srow + 16 * i) * 544 + schunk * 16) = vreg[i];
    __syncthreads();
    const int tt = wave & 3, chh = wave >> 2;
    f32x16 acc[4];
#pragma unroll
    for (int c = 0; c < 4; ++c) acc[c] = zero16();
    {
      const int i16 = lane & 15, q = i16 >> 2, p = i16 & 3, gc = (lane >> 4) & 1;
      const char* vb = sV + (8 * kb + q) * 544 + (chh * 128 + gc * 16 + 4 * p) * 2;
      const bf16_t* wb = sW + (tt * 32 + l32) * 136 + kb * 8;
      const int nks = 2 * (tt + 1);
      for (int ks = 0; ks < nks; ++ks) {
        const bf16x8 wf = *(const bf16x8*)(wb + ks * 16);
#pragma unroll
        for (int c = 0; c < 4; ++c) {
          const s16x4 lo = lds_tr(vb + ks * 16 * 544 + c * 64);
          const s16x4 hi = lds_tr(vb + (ks * 16 + 4) * 544 + c * 64);
          const bf16x8 vf = __builtin_shufflevector(lo, hi, 0, 1, 2, 3, 4, 5, 6, 7);
          acc[c] = mfma(vf, wf, acc[c]);
        }
      }
    }
    __syncthreads();
    {
      const int t = tt * 32 + l32;
      const float c1 = sc1[t], rw = srw[t], bs = P.o_b_s[g * 128 + t];
#pragma unroll
      for (int c = 0; c < 4; ++c)
#pragma unroll
        for (int gq = 0; gq < 4; ++gq) {
          const int chl = (chh * 4 + c) * 32 + 8 * gq + 4 * kb;
          const float4 lg = *(const float4*)(slg + chl), lb = *(const float4*)(slb + chl);
          const float m0 = lg.x * (acc[c][gq * 4 + 0] - c1) + lb.x * rw + bs;
          const float m1 = lg.y * (acc[c][gq * 4 + 1] - c1) + lb.y * rw + bs;
          const float m2 = lg.z * (acc[c][gq * 4 + 2] - c1) + lb.z * rw + bs;
          const float m3 = lg.w * (acc[c][gq * 4 + 3] - c1) + lb.w * rw + bs;
          u32x2 o; o[0] = pk2(m0, m1); o[1] = pk2(m2, m3);
          *(u32x2*)(sV + t * 520 + chl * 2) = o;
        }
    }
    __syncthreads();
#pragma unroll
    for (int i = 0; i < 8; ++i) {
      const char* mp = sV + (srow + 16 * i) * 520 + schunk * 16;
      const u32x2 ma = *(const u32x2*)mp, mb = *(const u32x2*)(mp + 8);
      const u32x4 uu = ureg[i];
      u32x4 o;
      o[0] = pk2(bflo(uu[0]) * bflo(ma[0]), bfhi(uu[0]) * bfhi(ma[0]));
      o[1] = pk2(bflo(uu[1]) * bflo(ma[1]), bfhi(uu[1]) * bfhi(ma[1]));
      o[2] = pk2(bflo(uu[2]) * bflo(mb[0]), bfhi(uu[2]) * bfhi(mb[0]));
      o[3] = pk2(bflo(uu[3]) * bflo(mb[1]), bfhi(uu[3]) * bfhi(mb[1]));
      *(u32x4*)(Y + (tok0 + srow + 16 * i) * 2048 + g * 256 + schunk * 8) = o;
    }
    __syncthreads();
  }
}

constexpr int NPHASE = 17;
DI void run_phase(const Params& P, int ph, char* smem) {
  char* ws = P.ws;
  bf16_t* r1 = (bf16_t*)(ws + R1); bf16_t* r2 = (bf16_t*)(ws + R2); bf16_t* r3 = (bf16_t*)(ws + R3); bf16_t* r4 = (bf16_t*)(ws + R4);
  unsigned* cnt = (unsigned*)(ws + W_CNT);
  const int lane = TIDX & 63, wave = TIDX >> 6, half = TIDX >> 8;
  char* hsmem = smem + half * 65536;
  switch (ph) {
    case 0: phase_prep(P); break;
    case 1: gemm_run<0>(r2, (const bf16_t*)(ws + W_EIN), PW, 1024, r1, PW, smem); break;
    case 2: {
      if (blockIdx.x < 64) nsa_compress_task(P, blockIdx.x * WPB + wave);
      volatile int* s_item = (volatile int*)(smem + LDS_BYTES - 16);
      for (;;) {
        __syncthreads();
        if (TIDX == 0) *s_item = (int)atomicAdd(cnt + 0, 1u);
        __syncthreads();
        const int pair = *s_item;
        if (pair >= 2048) break;
        gla_p1_item(P, pair * 2 + half, hsmem);
      }
    } break;
    case 3: gla_scan(P);
    case 30: {
      volatile int* s_item = (volatile int*)(smem + 131072);
      for (;;) {
        __syncthreads();
        if (TIDX == 0) *s_item = (int)atomicAdd(cnt + 1, 1u);
        __syncthreads();
        const int it = *s_item;
        if (it >= 512) break;
        nsa_block(P, (it & 15) >> 1, it & 1, 31 - (it >> 4), smem);
      }
    } break;
    case 4:
      for (int item = blockIdx.x * 2 + half; item < 4096; item += gridDim.x * 2) gla_p3_item(P, item, hsmem);
      break;
    case 5: gemm_run<0>(r3, (const bf16_t*)(ws + W_EOUT), 1024, 1024, r4, 1024, smem); break;
    case 6: resnorm_rows<true, false>(r4, P.x, nullptr, nullptr, r3, P.norm_g + 1 * 1024, P.norm_g + 2 * 1024, r2); break;
    case 7: gemm_run<1>(r2, (const bf16_t*)(ws + W_FFN1_0), 4096, 1024, r1, 4096, smem); break;
    case 8: gemm_run<0>(r1, (const bf16_t*)(ws + W_FFN2_0), 1024, 4096, r4, 1024, smem); break;
    case 9: resnorm_rows<false, false>(r4, nullptr, r3, nullptr, r3, P.norm_g + 3 * 1024, P.norm_g + 4 * 1024, r2); break;
    case 10: gemm_run<2>(r2, (const bf16_t*)(ws + W_OIN), 4096, 1024, r1, 4096, smem); break;
    case 11:
      for (int item = blockIdx.x; item < 512; item += gridDim.x) sgu_item(P, item, smem);
      break;
    case 12: gemm_run<0>((const bf16_t*)P.out, (const bf16_t*)(ws + W_OOUT), 1024, 2048, r4, 1024, smem); break;
    case 13: resnorm_rows<false, false>(r4, nullptr, r3, nullptr, r3, P.norm_g + 5 * 1024, P.norm_g + 6 * 1024, r2); break;
    case 14: gemm_run<1>(r2, (const bf16_t*)(ws + W_FFN1_1), 4096, 1024, r1, 4096, smem); break;
    case 15: gemm_run<0>(r1, (const bf16_t*)(ws + W_FFN2_1), 1024, 4096, r4, 1024, smem); break;
    case 16: resnorm_rows<false, true>(r4, nullptr, r3, P.out, nullptr, P.norm_g + 7 * 1024, nullptr, nullptr); break;
    default: break;
  }
}

#if !MEGA
extern __shared__ __attribute__((aligned(16))) unsigned char lds_dyn[];
__global__ void __launch_bounds__(NTHR, 2) k_phase(Params P, int ph) {
  char* smem = (char*)lds_dyn;
  run_phase(P, ph, smem);
}
#endif

#define XB_TMO      128
#define XB_XCNT(j)  (256  + 64 * (j))
#define XB_XSUB(j)  (1280 + 64 * (j))
#define XB_XGEN(j)  (2304 + 64 * (j))
#define XB_TOP      3328
#define XB_TOPGEN   3392
#define XCD_BAR_WORDS 3456
#define XB_SPIN_CAP (1u << 20)
#define LAS3 __attribute__((address_space(3)))
DI unsigned xb_ld(unsigned* p) { return __hip_atomic_load(p, __ATOMIC_RELAXED, __HIP_MEMORY_SCOPE_AGENT); }
DI unsigned xb_add(unsigned* p, unsigned v) { return __hip_atomic_fetch_add(p, v, __ATOMIC_RELAXED, __HIP_MEMORY_SCOPE_AGENT); }
DI unsigned xb_xcc_id() { return (unsigned)__builtin_amdgcn_s_getreg((3 << 11) | 20) & 0xFu; }
#define XB_SPIN(cond, bar) do { unsigned _sp = 0; while (cond) { __builtin_amdgcn_s_sleep(1); \
    if ((++_sp & 255u) == 0u) { if (xb_ld(&(bar)[XB_TMO])) break; if (_sp > XB_SPIN_CAP) { atomicAdd(&(bar)[XB_TMO], 1u); break; } } } } while (0)
struct XcdBarrier { unsigned* bar; unsigned x; volatile LAS3 unsigned* st; };
DI XcdBarrier xcd_barrier_post(unsigned* bar, volatile LAS3 unsigned* st) {
  XcdBarrier b; b.bar = bar; b.x = xb_xcc_id(); b.st = st;
  if (threadIdx.x == 0) (void)xb_add(&bar[XB_XCNT(b.x)], 1u);
  return b;
}
DI void xcd_barrier_complete(unsigned* bar, unsigned x, unsigned& nloc, unsigned& nx) {
  const unsigned G = gridDim.x * gridDim.y * gridDim.z;
  unsigned sum, cnt, mine, sp = 0u;
  for (;;) {
    sum = 0u; cnt = 0u; mine = 0u;
#pragma unroll
    for (unsigned j = 0; j < 16; ++j) { const unsigned c = xb_ld(&bar[XB_XCNT(j)]); sum += c; cnt += (c > 0u) ? 1u : 0u; mine = (j == x) ? c : mine; }
    if (sum == G) break;
    __builtin_amdgcn_s_sleep(1);
    if ((++sp & 255u) == 0u) { if (xb_ld(&bar[XB_TMO])) break; if (sp > XB_SPIN_CAP) { atomicAdd(&bar[XB_TMO], 1u); break; } }
  }
  nloc = mine > 0u ? mine : 1u; nx = cnt > 0u ? cnt : 1u;
}
DI void xcd_barrier(const XcdBarrier& b) {
  asm volatile("s_waitcnt vmcnt(0)" ::: "memory");
  __syncthreads();
  if (threadIdx.x == 0) {
    unsigned* bar = b.bar;
    __builtin_amdgcn_s_waitcnt(0);
    unsigned nloc = b.st[0], nx = b.st[1];
    if (nloc == 0u) { xcd_barrier_complete(bar, b.x, nloc, nx); b.st[0] = nloc; b.st[1] = nx; }
    const unsigned old = xb_add(&bar[XB_XSUB(b.x)], 1u);
    const unsigned gen = old / nloc;
    if (old + 1u == (gen + 1u) * nloc) {
      __builtin_amdgcn_fence(__ATOMIC_RELEASE, "agent");
      asm volatile("s_waitcnt vmcnt(0)" ::: "memory");
      const unsigned og = xb_add(&bar[XB_TOP], 1u);
      const unsigned tg = og / nx;
      if (og + 1u == (tg + 1u) * nx) xb_add(&bar[XB_TOPGEN], 1u);
      else XB_SPIN(xb_ld(&bar[XB_TOPGEN]) == tg, bar);
      __builtin_amdgcn_fence(__ATOMIC_ACQUIRE, "agent");
      xb_add(&bar[XB_XGEN(b.x)], 1u);
      asm volatile("s_waitcnt vmcnt(0)" ::: "memory");
    } else {
      XB_SPIN(xb_ld(&bar[XB_XGEN(b.x)]) == gen, bar);
      __builtin_amdgcn_fence(__ATOMIC_ACQUIRE, "agent");
      asm volatile("s_waitcnt vmcnt(0)" ::: "memory");
    }
  }
  __syncthreads();
}

#if MEGA
extern __shared__ __attribute__((aligned(16))) unsigned char lds_dyn[];
__global__ void __launch_bounds__(NTHR, 2) k_mega(Params P) {
  char* smem = (char*)lds_dyn;
  cg::grid_group grid = cg::this_grid();
  volatile LAS3 unsigned* xst = (volatile LAS3 unsigned*)(smem + 131072 + 16);
  if (threadIdx.x == 0) { xst[0] = 0u; xst[1] = 0u; }
  __syncthreads();
  const XcdBarrier xb = xcd_barrier_post((unsigned*)(P.ws + W_BAR), xst);
#define GSYNC() xcd_barrier(xb)
#define GEMM_PH(n) run_phase(P, n, smem); GSYNC(); if (PROBE == 1) { run_phase(P, n, smem); GSYNC(); }
  if (P.ws == nullptr) grid.sync();
  run_phase(P, 0, smem); GSYNC();
  if (PROBE == 3) { run_phase(P, 0, smem); GSYNC(); }
  GEMM_PH(1)
  run_phase(P, 2, smem); GSYNC();
  if (PROBE == 4) { if (blockIdx.x == 0 && TIDX == 0) ((unsigned*)(P.ws + W_CNT))[0] = 0u; GSYNC(); run_phase(P, 2, smem); GSYNC(); }
  run_phase(P, 3, smem); GSYNC();
  if (PROBE == 2) {
    if (blockIdx.x == 0 && TIDX == 0) ((unsigned*)(P.ws + W_CNT))[1] = 0u;
    GSYNC();
    run_phase(P, 30, smem); GSYNC();
  }
  run_phase(P, 4, smem); GSYNC();
  if (PROBE == 5) { run_phase(P, 4, smem); GSYNC(); }
  GEMM_PH(5)
  run_phase(P, 6, smem); GSYNC();
  if (PROBE == 6) { run_phase(P, 6, smem); GSYNC(); run_phase(P, 6, smem); GSYNC(); run_phase(P, 6, smem); GSYNC(); }
  GEMM_PH(7)
  GEMM_PH(8)
  run_phase(P, 9, smem); GSYNC();
  GEMM_PH(10)
  run_phase(P, 11, smem); GSYNC();
  if (PROBE == 7) { run_phase(P, 11, smem); GSYNC(); }
  GEMM_PH(12)
  run_phase(P, 13, smem); GSYNC();
  GEMM_PH(14)
  GEMM_PH(15)
  if (PROBE == 11) { GSYNC(); GSYNC(); GSYNC(); GSYNC(); GSYNC(); GSYNC(); GSYNC(); GSYNC(); }
  run_phase(P, 16, smem);
}
#endif

extern "C" void kernel_launch(void* const* d_in, const int* in_sizes, int n_in, void* d_out, int out_size, void* d_ws, size_t ws_size,
                              hipStream_t stream) {
  Params p{};
  p.x = (const float*)d_in[0]; p.norm_g = (const float*)d_in[1]; p.ffn_w1 = (const float*)d_in[2]; p.ffn_w2 = (const float*)d_in[3];
  p.e_w_in = (const float*)d_in[4]; p.e_w_out = (const float*)d_in[5]; p.gla_w_gate = (const float*)d_in[6]; p.gla_b_gate = (const float*)d_in[7];
  p.gla_norm = (const float*)d_in[8]; p.nsa_gate_b = (const float*)d_in[9]; p.cmp_pos = (const float*)d_in[10]; p.cmp_w1 = (const float*)d_in[11];
  p.cmp_w2 = (const float*)d_in[12]; p.o_w_in = (const float*)d_in[13]; p.o_ln_g = (const float*)d_in[14]; p.o_ln_b = (const float*)d_in[15];
  p.o_w_s = (const float*)d_in[16]; p.o_b_s = (const float*)d_in[17]; p.o_w_out = (const float*)d_in[18];
  p.out = (float*)d_out; p.ws = (char*)d_ws;
  if (ws_size < 1024ull * MiB) { fprintf(stderr, "workspace too small: %zu\n", ws_size); return; }
  static int grid_blocks = 0;
  if (!grid_blocks) {
    int dev = 0, cus = 0, per_cu = 0;
    (void)hipGetDevice(&dev);
    (void)hipDeviceGetAttribute(&cus, hipDeviceAttributeMultiprocessorCount, dev);
#if MEGA
    if (hipFuncSetAttribute((const void*)k_mega, hipFuncAttributeMaxDynamicSharedMemorySize, LDS_BYTES) != hipSuccess) fprintf(stderr, "hipFuncSetAttribute failed\n");
    (void)hipOccupancyMaxActiveBlocksPerMultiprocessor(&per_cu, (const void*)k_mega, NTHR, LDS_BYTES);
#else
    if (hipFuncSetAttribute((const void*)k_phase, hipFuncAttributeMaxDynamicSharedMemorySize, LDS_BYTES) != hipSuccess) fprintf(stderr, "hipFuncSetAttribute failed\n");
    (void)hipOccupancyMaxActiveBlocksPerMultiprocessor(&per_cu, (const void*)k_phase, NTHR, LDS_BYTES);
#endif
    if (per_cu < 1) fprintf(stderr, "occupancy query returned %d\n", per_cu);
    grid_blocks = cus;
  }
#if MEGA
  if (hipMemsetAsync((char*)d_ws + W_BAR, 0, XCD_BAR_WORDS * sizeof(unsigned), stream) != hipSuccess) fprintf(stderr, "memset of barrier words failed\n");
  void* args[] = {&p};
  hipError_t e = hipLaunchCooperativeKernel((void*)k_mega, dim3(grid_blocks), dim3(NTHR), args, LDS_BYTES, stream);
  if (e != hipSuccess) fprintf(stderr, "cooperative launch failed: %s (grid %d)\n", hipGetErrorString(e), grid_blocks);
#else
  for (int ph = 0; ph < NPHASE; ++ph) k_phase<<<grid_blocks, NTHR, LDS_BYTES, stream>>>(p, ph);
#endif
}
```

```cpp
#include <hip/hip_runtime.h>
#include <hip/hip_cooperative_groups.h>
#include <cstdio>
namespace cg = cooperative_groups;

#ifndef MEGA
#define MEGA 1
#endif
#ifndef PROBE
#define PROBE 0
#endif

typedef unsigned short bf16_t;
typedef short bf16x8 __attribute__((ext_vector_type(8)));
typedef short s16x4 __attribute__((ext_vector_type(4)));
typedef float f32x16 __attribute__((ext_vector_type(16)));
typedef float f32v2 __attribute__((ext_vector_type(2)));
typedef __bf16 bf16v2 __attribute__((ext_vector_type(2)));
typedef unsigned u32x4 __attribute__((ext_vector_type(4)));
typedef unsigned u32x2 __attribute__((ext_vector_type(2)));
#define DI __device__ __forceinline__
DI int tid_opaque() { int t = threadIdx.x; asm volatile("" : "+v"(t)); return t; }
#define TIDX tid_opaque()

constexpr int T_TOK = 65536, SEQ = 8192, DM = 1024;
constexpr int PW = 3072;
constexpr int C_GQ = 0, C_GK = 256, C_GV = 512, C_GLR = 1024, C_GR = 1040, C_NQ = 1552, C_KC = 2064, C_VC = 2192,
              C_KS = 2320, C_VS = 2448, C_KW = 2576, C_VW = 2704, C_NG = 2832;
constexpr float EPS = 1e-6f;
constexpr int NTHR = 512, WPB = 8, LDS_CMP_STAGE = 131072 + 64, LDS_BYTES = 131072 + 64 + 18432;
constexpr size_t MiB = 1024ull * 1024ull;
constexpr size_t W_FFN1_0 = 0, W_FFN1_1 = 8 * MiB, W_FFN2_0 = 16 * MiB, W_FFN2_1 = 24 * MiB, W_EIN = 32 * MiB, W_EOUT = 38 * MiB,
                 W_OIN = 40 * MiB, W_OOUT = 48 * MiB, W_CW1 = 52 * MiB, W_CW2 = 53 * MiB, W_BIAS1 = 53 * MiB + 65536,
                 W_CNT = 53 * MiB + 131072, W_BAR = 54 * MiB;
constexpr size_t R1 = 64 * MiB, R2 = 576 * MiB, R3 = 704 * MiB, R4 = 832 * MiB, R5 = 960 * MiB;
constexpr size_t R_KCMP = R5, R_VCMPT = R5 + 1 * MiB, R_VST = R5 + 2 * MiB, R_VWT = R5 + 18 * MiB, R_DECAY = R5 + 34 * MiB;

struct Params {
  const float* x; const float* norm_g; const float* ffn_w1; const float* ffn_w2; const float* e_w_in; const float* e_w_out;
  const float* gla_w_gate; const float* gla_b_gate; const float* gla_norm; const float* nsa_gate_b; const float* cmp_pos;
  const float* cmp_w1; const float* cmp_w2; const float* o_w_in; const float* o_ln_g; const float* o_ln_b; const float* o_w_s;
  const float* o_b_s; const float* o_w_out;
  float* out; char* ws;
};

DI int crow(int r, int kb) { return (r & 3) + 8 * (r >> 2) + 4 * kb; }
DI f32x16 mfma(bf16x8 a, bf16x8 b, f32x16 c) { return __builtin_amdgcn_mfma_f32_32x32x16_bf16(a, b, c, 0, 0, 0); }
DI unsigned pk2(float a, float b) { f32v2 v = {a, b}; bf16v2 r = __builtin_convertvector(v, bf16v2); return __builtin_bit_cast(unsigned, r); }
DI bf16_t f2bf(float a) { return (bf16_t)(pk2(a, 0.f) & 0xffffu); }
DI float bf2f(bf16_t u) { return __uint_as_float(((unsigned)u) << 16); }
DI float bflo(unsigned u) { return __uint_as_float(u << 16); }
DI float bfhi(unsigned u) { return __uint_as_float(u & 0xffff0000u); }
DI bf16x8 pack8(float a0, float a1, float a2, float a3, float a4, float a5, float a6, float a7) {
  u32x4 p; p[0] = pk2(a0, a1); p[1] = pk2(a2, a3); p[2] = pk2(a4, a5); p[3] = pk2(a6, a7);
  return __builtin_bit_cast(bf16x8, p);
}
DI bf16x8 ld2x4(const bf16_t* p) {
  s16x4 lo = *(const s16x4*)p; s16x4 hi = *(const s16x4*)(p + 8);
  return __builtin_shufflevector(lo, hi, 0, 1, 2, 3, 4, 5, 6, 7);
}
DI float wave_sum(float v) {
#pragma unroll
  for (int o = 32; o > 0; o >>= 1) v += __shfl_xor(v, o);
  return v;
}
DI f32x16 zero16() { f32x16 z;
#pragma unroll
  for (int i = 0; i < 16; ++i) z[i] = 0.f; return z; }
DI float frcp(float x) { return __builtin_amdgcn_rcpf(x); }
DI float gelu_tanh(float x) { const float t = x * x; const float p = __builtin_fmaf(t, -2.3022082f * 0.044715f, -2.3022082f); return x * frcp(1.f + __builtin_amdgcn_exp2f(x * p)); }
DI float sigmoidf_(float x) { return frcp(1.f + __expf(-x)); }

DI void conv_weight(const float* __restrict__ src, bf16_t* __restrict__ dst, int K, int N, int Npad) {
  const long total = (long)Npad * (K >> 3);
  const long stride = (long)gridDim.x * blockDim.x;
  for (long i = (long)blockIdx.x * blockDim.x + TIDX; i < total; i += stride) {
    const int n = (int)(i % Npad); const int k8 = (int)(i / Npad);
    float v[8];
#pragma unroll
    for (int j = 0; j < 8; ++j) v[j] = (n < N) ? src[(size_t)(k8 * 8 + j) * N + n] : 0.f;
    u32x4 o; o[0] = pk2(v[0], v[1]); o[1] = pk2(v[2], v[3]); o[2] = pk2(v[4], v[5]); o[3] = pk2(v[6], v[7]);
    *(u32x4*)(dst + (size_t)n * K + k8 * 8) = o;
  }
}

DI void prenorm_rows(const float* __restrict__ x, const float* __restrict__ g, bf16_t* __restrict__ xn) {
  const int lane = TIDX & 63, wave = TIDX >> 6;
  const int nw = gridDim.x * WPB;
  for (int row = blockIdx.x * WPB + wave; row < T_TOK; row += nw) {
    const float4* xr = (const float4*)(x + (size_t)row * DM);
    float4 a[4]; float ss = 0.f;
#pragma unroll
    for (int k = 0; k < 4; ++k) { a[k] = xr[k * 64 + lane]; ss += a[k].x * a[k].x + a[k].y * a[k].y + a[k].z * a[k].z + a[k].w * a[k].w; }
    ss = wave_sum(ss);
    const float rs = rsqrtf(ss * (1.f / DM) + EPS);
#pragma unroll
    for (int k = 0; k < 4; ++k) {
      const float4 gg = ((const float4*)g)[k * 64 + lane];
      u32x2 o; o[0] = pk2(a[k].x * rs * gg.x, a[k].y * rs * gg.y); o[1] = pk2(a[k].z * rs * gg.z, a[k].w * rs * gg.w);
      *(u32x2*)(xn + (size_t)row * DM + k * 256 + lane * 4) = o;
    }
  }
}

template <bool HIN_F32, bool HOUT_F32>
DI void resnorm_rows(const bf16_t* __restrict__ m, const float* __restrict__ hin_f, const bf16_t* hin_b, float* __restrict__ hout_f,
                     bf16_t* hout_b, const float* __restrict__ gpost, const float* __restrict__ gnext, bf16_t* __restrict__ xn) {
  const int lane = TIDX & 63, wave = TIDX >> 6;
  const int nw = gridDim.x * WPB;
  for (int row = blockIdx.x * WPB + wave; row < T_TOK; row += nw) {
    float mv[16]; float ss = 0.f;
#pragma unroll
    for (int k = 0; k < 4; ++k) {
      const u32x2 u = *(const u32x2*)(m + (size_t)row * DM + k * 256 + lane * 4);
      mv[k * 4 + 0] = bflo(u[0]); mv[k * 4 + 1] = bfhi(u[0]); mv[k * 4 + 2] = bflo(u[1]); mv[k * 4 + 3] = bfhi(u[1]);
    }
    float hv[16];
#pragma unroll
    for (int k = 0; k < 4; ++k) {
      if (HIN_F32) {
        const float4 h4 = ((const float4*)(hin_f + (size_t)row * DM))[k * 64 + lane];
        hv[k * 4 + 0] = h4.x; hv[k * 4 + 1] = h4.y; hv[k * 4 + 2] = h4.z; hv[k * 4 + 3] = h4.w;
      } else {
        const u32x2 u = *(const u32x2*)(hin_b + (size_t)row * DM + k * 256 + lane * 4);
        hv[k * 4 + 0] = bflo(u[0]); hv[k * 4 + 1] = bfhi(u[0]); hv[k * 4 + 2] = bflo(u[1]); hv[k * 4 + 3] = bfhi(u[1]);
      }
    }
#pragma unroll
    for (int i = 0; i < 16; ++i) ss += mv[i] * mv[i];
    ss = wave_sum(ss);
    const float rs = rsqrtf(ss * (1.f / DM) + EPS);
    float s2 = 0.f;
#pragma unroll
    for (int k = 0; k < 4; ++k) {
      const float4 gg = ((const float4*)gpost)[k * 64 + lane];
      hv[k * 4 + 0] += mv[k * 4 + 0] * rs * gg.x; hv[k * 4 + 1] += mv[k * 4 + 1] * rs * gg.y;
      hv[k * 4 + 2] += mv[k * 4 + 2] * rs * gg.z; hv[k * 4 + 3] += mv[k * 4 + 3] * rs * gg.w;
      if (HOUT_F32) {
        float4 o; o.x = hv[k * 4 + 0]; o.y = hv[k * 4 + 1]; o.z = hv[k * 4 + 2]; o.w = hv[k * 4 + 3];
        ((float4*)(hout_f + (size_t)row * DM))[k * 64 + lane] = o;
      } else {
        u32x2 o; o[0] = pk2(hv[k * 4 + 0], hv[k * 4 + 1]); o[1] = pk2(hv[k * 4 + 2], hv[k * 4 + 3]);
        *(u32x2*)(hout_b + (size_t)row * DM + k * 256 + lane * 4) = o;
      }
    }
    if (xn) {
#pragma unroll
      for (int i = 0; i < 16; ++i) s2 += hv[i] * hv[i];
      s2 = wave_sum(s2);
      const float r2 = rsqrtf(s2 * (1.f / DM) + EPS);
#pragma unroll
      for (int k = 0; k < 4; ++k) {
        const float4 gg = ((const float4*)gnext)[k * 64 + lane];
        u32x2 o; o[0] = pk2(hv[k * 4 + 0] * r2 * gg.x, hv[k * 4 + 1] * r2 * gg.y); o[1] = pk2(hv[k * 4 + 2] * r2 * gg.z, hv[k * 4 + 3] * r2 * gg.w);
        *(u32x2*)(xn + (size_t)row * DM + k * 256 + lane * 4) = o;
      }
    }
  }
}

DI void phase_prep(const Params& P) {
  char* ws = P.ws;
  conv_weight(P.ffn_w1, (bf16_t*)(ws + W_FFN1_0), 1024, 4096, 4096);
  conv_weight(P.ffn_w1 + (size_t)1024 * 4096, (bf16_t*)(ws + W_FFN1_1), 1024, 4096, 4096);
  conv_weight(P.ffn_w2, (bf16_t*)(ws + W_FFN2_0), 4096, 1024, 1024);
  conv_weight(P.ffn_w2 + (size_t)1024 * 4096, (bf16_t*)(ws + W_FFN2_1), 4096, 1024, 1024);
  conv_weight(P.e_w_in, (bf16_t*)(ws + W_EIN), 1024, 2856, PW);
  conv_weight(P.e_w_out, (bf16_t*)(ws + W_EOUT), 1024, 1024, 1024);
  conv_weight(P.o_w_in, (bf16_t*)(ws + W_OIN), 1024, 4096, 4096);
  conv_weight(P.o_w_out, (bf16_t*)(ws + W_OOUT), 2048, 1024, 1024);
  conv_weight(P.cmp_w1, (bf16_t*)(ws + W_CW1), 2048, 128, 128);
  conv_weight(P.cmp_w1 + 2048 * 128, (bf16_t*)(ws + W_CW1) + 128 * 2048, 2048, 128, 128);
  conv_weight(P.cmp_w2, (bf16_t*)(ws + W_CW2), 128, 64, 64);
  conv_weight(P.cmp_w2 + 128 * 64, (bf16_t*)(ws + W_CW2) + 64 * 128, 128, 64, 64);
  const int lane = TIDX & 63, wave = TIDX >> 6;
  const int gw = blockIdx.x * WPB + wave;
  if (gw < 256) {
    const int i = gw >> 7, hid = gw & 127;
    float s = 0.f;
    for (int kk = lane; kk < 2048; kk += 64) s += P.cmp_pos[i * 2048 + kk] * P.cmp_w1[((size_t)i * 2048 + kk) * 128 + hid];
    s = wave_sum(s);
    if (lane == 0) ((float*)(ws + W_BIAS1))[gw] = s;
  }
  const int gt = blockIdx.x * blockDim.x + TIDX;
  if (gt < 16) ((unsigned*)(ws + W_CNT))[gt] = 0u;
  if (gt < 16 * 64) {
    const int bg = gt >> 6, d = gt & 63;
    ((bf16_t*)(ws + R_KCMP))[((size_t)bg * 512 + 511) * 64 + d] = 0;
    ((bf16_t*)(ws + R_VCMPT))[((size_t)bg * 512 + 511) * 64 + d] = 0;
  }
  prenorm_rows(P.x, P.norm_g, (bf16_t*)(ws + R2));
}

namespace pg8 {
#define PG8_LAS __attribute__((address_space(3)))
typedef float f32x4 __attribute__((ext_vector_type(4)));
constexpr int BM = 256, BK = 64, HALF = 128, HTB = HALF * BK * 2, STAGE_BYTES = 8 * HTB, NXCD = 8, WGM = 8;
DI int lds_byte(int r, int c) { const int st = (r >> 4) * 2 + (c >> 5), rr = r & 15, cc = c & 31, ob = rr * 64 + cc * 2; return st * 1024 + (ob ^ (((ob >> 9) & 1) << 5)); }
DI void stage_rc(int b, int& R, int& C) { const int st = b / 1024, sb = b % 1024, swz = sb ^ (((sb >> 9) & 1) << 5); R = (st >> 1) * 16 + swz / 64; C = (st & 1) * 32 + (swz % 64) / 2; }
DI int perm32(int rho) { const int n = rho >> 4, i = rho & 15; return 8 * (i >> 2) + 4 * n + (i & 3); }
struct Unit { int pm, pn; };
struct Gemm { const bf16_t* A; const bf16_t* Bt; int M, N, K; };
struct StaticOrder {
  int nM, nN, nwg, G, c;
  DI void init(int M, int N, int G_, int c_) { nM = M / BM; nN = N / BM; nwg = nM * nN; G = G_; c = c_; }
  DI bool next(int i, Unit& u) const {
    const long L = (long)i * G + c; if (L >= nwg) return false;
    int wgid = (int)L; { const int q = nwg / NXCD, r = nwg % NXCD, xcd = wgid % NXCD, off = wgid / NXCD; wgid = (xcd < r ? xcd * (q + 1) : r * (q + 1) + (xcd - r) * q) + off; }
    const int nig = WGM * nN, gid = wgid / nig, fm = gid * WGM, gsz = (nM - fm) < WGM ? (nM - fm) : WGM;
    u.pm = fm + ((wgid % nig) % gsz); u.pn = (wgid % nig) / gsz; return true;
  }
};
template <int ACT> struct EpiB {
  static constexpr bool PERM = true;
  bf16_t* O; int ldc;
  DI void operator()(const f32x4 (&acc)[2][2][4][2], const Unit& u, int wr, int wc, int fr, int fq) const {
    const int row0 = u.pm * BM + wr * 64 + fr; const int col0 = u.pn * BM + wc * 32 + 8 * fq;
#pragma unroll
    for (int ai = 0; ai < 2; ++ai)
#pragma unroll
      for (int m = 0; m < 4; ++m) {
        bf16_t* rowp = O + (size_t)(row0 + ai * HALF + m * 16) * ldc + col0;
#pragma unroll
        for (int bj = 0; bj < 2; ++bj) {
          f32x4 v0 = acc[ai][bj][m][0], v1 = acc[ai][bj][m][1];
          if (ACT == 1) {
#pragma unroll
            for (int j = 0; j < 4; ++j) { const float a = fmaxf(v0[j], 0.f), b = fmaxf(v1[j], 0.f); v0[j] = a * a; v1[j] = b * b; }
          }
          if (ACT == 2) {
#pragma unroll
            for (int j = 0; j < 4; ++j) { v0[j] = gelu_tanh(v0[j]); v1[j] = gelu_tanh(v1[j]); }
          }
          u32x4 w; w[0] = pk2(v0[0], v0[1]); w[1] = pk2(v0[2], v0[3]); w[2] = pk2(v1[0], v1[1]); w[3] = pk2(v1[2], v1[3]);
          *(u32x4*)(rowp + bj * HALF) = w;
        }
      }
  }
};

template <class Epi, class Sched>
DI void gemm_phase(PG8_LAS unsigned char* lds, const Gemm g, const Sched& S, const Epi& E) {
  const int tid_ = TIDX;
  const int tid = tid_, wid = __builtin_amdgcn_readfirstlane(tid >> 6), lane = tid & 63, wr = wid >> 2, wc = wid & 3, fr = lane & 15, fq = lane >> 4;
  const int K = g.K, nt = K / BK;
  unsigned voffA[2], voffB[2];
#pragma unroll
  for (int i = 0; i < 2; ++i) { int R, C; stage_rc(tid * 16 + i * 8192, R, C); const int Rb = Epi::PERM ? ((R & ~31) + perm32(R & 31)) : R;
    voffA[i] = (unsigned)(R * K + C) * 2u; voffB[i] = (unsigned)(Rb * K + C) * 2u; }
  const size_t kstep = (size_t)(BK * 2);
  const size_t hstep = (size_t)HALF * K * 2;
  const size_t tstep = 2 * hstep;
  const unsigned ldsw = (unsigned)wid * 1024u;
  const int aoff = lds_byte(wr * 64 + fr, fq * 8), boff = lds_byte(wc * 32 + fr, fq * 8);
#define PG8_SA(b, h) (((b) * 2 + (h)) * HTB)
#define PG8_SB(b, h) ((4 + (b) * 2 + (h)) * HTB)
#define PG8_STAGE(bufoff, gbase, voff) do { _Pragma("unroll") for (int _i = 0; _i < 2; ++_i) \
    __builtin_amdgcn_global_load_lds((const unsigned*)((const char*)(gbase) + (voff)[_i]), (PG8_LAS unsigned*)(lds + (bufoff) + ldsw + _i * 8192), 16, 0, 0); } while (0)
#define PG8_LDA(dst, b, h) do { _Pragma("unroll") for (int m = 0; m < 4; ++m) _Pragma("unroll") for (int k = 0; k < 2; ++k) dst[m][k] = *(const PG8_LAS bf16x8*)(lds + PG8_SA(b, h) + aoff + m * 2048 + k * 1024); } while (0)
#define PG8_LDB(dst, b, h) do { _Pragma("unroll") for (int n = 0; n < 2; ++n) _Pragma("unroll") for (int k = 0; k < 2; ++k) dst[n][k] = *(const PG8_LAS bf16x8*)(lds + PG8_SB(b, h) + boff + n * 2048 + k * 1024); } while (0)
#define PG8_MMA(ai, bj, At, Bt) do { __builtin_amdgcn_s_setprio(1); _Pragma("unroll") for (int m = 0; m < 4; ++m) _Pragma("unroll") for (int n = 0; n < 2; ++n) _Pragma("unroll") for (int k = 0; k < 2; ++k) \
    acc[ai][bj][m][n] = __builtin_amdgcn_mfma_f32_16x16x32_bf16(Bt[n][k], At[m][k], acc[ai][bj][m][n], 0, 0, 0); __builtin_amdgcn_s_setprio(0); } while (0)
#define PG8_WAIT_V(n) asm volatile("s_waitcnt vmcnt(" #n ")" ::: "memory")
#define PG8_WAIT_L(n) asm volatile("s_waitcnt lgkmcnt(" #n ")" ::: "memory")
#define PG8_BAR __builtin_amdgcn_s_barrier()
#define PG8_SCHED __builtin_amdgcn_sched_barrier(0)
  Unit cur, nxt; int ui = 0;
  if (!S.next(0, cur)) return;
  f32x4 acc[2][2][4][2];
#pragma unroll
  for (int a = 0; a < 2; ++a)
#pragma unroll
    for (int b = 0; b < 2; ++b)
#pragma unroll
      for (int m = 0; m < 4; ++m)
#pragma unroll
        for (int n = 0; n < 2; ++n) acc[a][b][m][n] = (f32x4){0.f, 0.f, 0.f, 0.f};
  bf16x8 At[4][2], B0[2][2], B1[2][2];
  const char* cA = (const char*)g.A + (size_t)cur.pm * tstep; const char* cB = (const char*)g.Bt + (size_t)cur.pn * tstep;
  PG8_STAGE(PG8_SB(0, 0), cB, voffB); PG8_STAGE(PG8_SA(0, 0), cA, voffA); PG8_STAGE(PG8_SB(0, 1), cB + hstep, voffB); PG8_STAGE(PG8_SA(0, 1), cA + hstep, voffA);
  if (wr == 1) PG8_BAR;
  PG8_WAIT_V(4); PG8_BAR;
  PG8_STAGE(PG8_SB(1, 0), cB + kstep, voffB); PG8_STAGE(PG8_SA(1, 0), cA + kstep, voffA); PG8_STAGE(PG8_SB(1, 1), cB + hstep + kstep, voffB);
  PG8_WAIT_V(6); PG8_BAR;
  for (;;) {
    const bool has_next = S.next(ui + 1, nxt);
    const char* nA = has_next ? (const char*)g.A + (size_t)nxt.pm * tstep : cA; const char* nB = has_next ? (const char*)g.Bt + (size_t)nxt.pn * tstep : cB;
    for (int t = 0; t < nt; t += 2) {
      const bool last = (t == nt - 2);
      const char* a1 = cA + (size_t)(t + 1) * kstep;
      const char* a2 = last ? nA : cA + (size_t)(t + 2) * kstep; const char* b2 = last ? nB : cB + (size_t)(t + 2) * kstep;
      const char* a3 = a2 + kstep; const char* b3 = b2 + kstep;
      PG8_LDB(B0, 0, 0); PG8_SCHED; PG8_LDA(At, 0, 0); PG8_STAGE(PG8_SA(1, 1), a1 + hstep, voffA);
      PG8_WAIT_L(8); PG8_BAR; PG8_WAIT_L(0); PG8_MMA(0, 0, At, B0); PG8_BAR; PG8_SCHED;
      PG8_LDB(B1, 0, 1); PG8_STAGE(PG8_SB(0, 0), b2, voffB);
      PG8_BAR; PG8_WAIT_L(0); PG8_MMA(0, 1, At, B1); PG8_BAR;
      PG8_LDA(At, 0, 1); PG8_STAGE(PG8_SA(0, 0), a2, voffA);
      PG8_BAR; PG8_WAIT_L(0); PG8_MMA(1, 0, At, B0); PG8_BAR; PG8_SCHED;
      PG8_STAGE(PG8_SB(0, 1), b2 + hstep, voffB);
      PG8_WAIT_V(6); PG8_BAR; PG8_MMA(1, 1, At, B1); PG8_BAR;
      PG8_LDB(B0, 1, 0); PG8_SCHED; PG8_LDA(At, 1, 0); PG8_STAGE(PG8_SA(0, 1), a2 + hstep, voffA);
      PG8_WAIT_L(8); PG8_BAR; PG8_WAIT_L(0); PG8_MMA(0, 0, At, B0); PG8_BAR; PG8_SCHED;
      PG8_LDB(B1, 1, 1); PG8_STAGE(PG8_SB(1, 0), b3, voffB);
      PG8_BAR; PG8_WAIT_L(0); PG8_MMA(0, 1, At, B1); PG8_BAR;
      PG8_LDA(At, 1, 1); PG8_STAGE(PG8_SA(1, 0), a3, voffA);
      PG8_BAR; PG8_WAIT_L(0); PG8_MMA(1, 0, At, B0); PG8_BAR; PG8_SCHED;
      PG8_STAGE(PG8_SB(1, 1), b3 + hstep, voffB);
      PG8_WAIT_V(6); PG8_BAR; PG8_MMA(1, 1, At, B1); PG8_BAR;
    }
    E(acc, cur, wr, wc, fr, fq);
    if (PROBE == 10) { asm volatile("" ::: "memory"); E(acc, cur, wr, wc, fr, fq); }
    if (!has_next) break;
#pragma unroll
    for (int a = 0; a < 2; ++a)
#pragma unroll
      for (int b = 0; b < 2; ++b)
#pragma unroll
        for (int m = 0; m < 4; ++m)
#pragma unroll
          for (int n = 0; n < 2; ++n) acc[a][b][m][n] = (f32x4){0.f, 0.f, 0.f, 0.f};
    cur = nxt; cA = nA; cB = nB; ++ui;
  }
  PG8_WAIT_V(0);
  if (wr == 0) PG8_BAR;
  PG8_BAR;
#undef PG8_SA
#undef PG8_SB
#undef PG8_STAGE
#undef PG8_LDA
#undef PG8_LDB
#undef PG8_MMA
#undef PG8_WAIT_V
#undef PG8_WAIT_L
#undef PG8_BAR
#undef PG8_SCHED
}
}

template <int ACT>
DI void gemm_run(const bf16_t* A, const bf16_t* Bt, int N, int K, bf16_t* C, int ldc, char* smem) {
  pg8::Gemm g; g.A = A; g.Bt = Bt; g.M = T_TOK; g.N = N; g.K = K;
  pg8::StaticOrder S; S.init(T_TOK, N, (int)gridDim.x, (int)blockIdx.x);
  pg8::EpiB<ACT> E; E.O = C; E.ldc = ldc;
#ifndef STAGGER_TICKS
#define STAGGER_TICKS 0
#endif
  if (K <= 1024 && STAGGER_TICKS > 0) {
    const unsigned long long t0 = __builtin_amdgcn_s_memrealtime();
    const unsigned long long d = (unsigned long long)(((blockIdx.x >> 3) & 3) * STAGGER_TICKS);
    while (__builtin_amdgcn_s_memrealtime() - t0 < d) __builtin_amdgcn_s_sleep(8);
  }
  pg8::gemm_phase(( PG8_LAS unsigned char*)smem, g, S, E);
  __syncthreads();
}

DI void gla_gates(const Params& P, const bf16_t* proj, int b, int h, int n, float* sb, float* sseg, float* tmp) {
  const int tid = TIDX & 255;
  float* sw = tmp;
  float* sg = tmp + 1024;
  {
    for (int e = tid; e < 1024; e += 256) sw[e] = P.gla_w_gate[(e >> 6) * 256 + h * 64 + (e & 63)];
    const int i = tid >> 2, part = tid & 3;
    const size_t t = (size_t)b * SEQ + n * 64 + i;
    const u32x2 gu = *(const u32x2*)(proj + t * PW + C_GLR + part * 4);
    sg[i * 17 + part * 4 + 0] = bflo(gu[0]); sg[i * 17 + part * 4 + 1] = bfhi(gu[0]);
    sg[i * 17 + part * 4 + 2] = bflo(gu[1]); sg[i * 17 + part * 4 + 3] = bfhi(gu[1]);
  }
  __syncthreads();
  {
    const int i = tid & 63, dq = tid >> 6;
    float z[16];
#pragma unroll
    for (int dd = 0; dd < 16; ++dd) z[dd] = P.gla_b_gate[h * 64 + dq * 16 + dd];
#pragma unroll 1
    for (int r = 0; r < 16; ++r) {
      const float gv = sg[i * 17 + r];
#pragma unroll
      for (int dd = 0; dd < 16; ++dd) z[dd] += gv * sw[r * 64 + dq * 16 + dd];
    }
#pragma unroll
    for (int dd = 0; dd < 16; ++dd) {
      const float zz = z[dd];
      const float ls = fminf(zz, 0.f) - __logf(1.f + __expf(-fabsf(zz)));
      sb[i * 65 + dq * 16 + dd] = ls * (1.f / 16.f);
    }
  }
  __syncthreads();
  const int d = tid & 63, seg = tid >> 6;
  float pre[16]; float run = 0.f;
#pragma unroll
  for (int ii = 0; ii < 16; ++ii) { run += sb[(seg * 16 + ii) * 65 + d]; pre[ii] = run; }
  sseg[seg * 64 + d] = run;
  __syncthreads();
  float off = 0.f;
#pragma unroll
  for (int s = 0; s < 4; ++s) off += (s < seg) ? sseg[s * 64 + d] : 0.f;
#pragma unroll
  for (int ii = 0; ii < 16; ++ii) sb[(seg * 16 + ii) * 65 + d] = pre[ii] + off;
  __syncthreads();
}

struct VRegs { u32x4 u[4]; };
DI void gla_load_v(const bf16_t* proj, int b, int h, int n, VRegs& vr) {
  const int tid = TIDX & 255, j = tid & 63, q4 = tid >> 6;
  const size_t t = (size_t)b * SEQ + n * 64 + j;
  const bf16_t* src = proj + t * PW + C_GV + h * 128 + q4 * 32;
#pragma unroll
  for (int c = 0; c < 4; ++c) vr.u[c] = *(const u32x4*)(src + c * 8);
}
DI void gla_store_vT(const VRegs& vr, bf16_t* vT) {
  const int tid = TIDX & 255, j = tid & 63, q4 = tid >> 6;
#pragma unroll
  for (int c = 0; c < 4; ++c) {
#pragma unroll
    for (int e = 0; e < 4; ++e) {
      vT[(q4 * 32 + c * 8 + 2 * e) * 72 + j] = (bf16_t)(vr.u[c][e] & 0xffffu);
      vT[(q4 * 32 + c * 8 + 2 * e + 1) * 72 + j] = (bf16_t)(vr.u[c][e] >> 16);
    }
  }
}

DI void gla_p1_item(const Params& P, int item, char* smem) {
  const bf16_t* proj = (const bf16_t*)(P.ws + R1);
  bf16_t* states = (bf16_t*)(P.ws + R2);
  float* decay = (float*)(P.ws + R_DECAY);
  float* sb = (float*)smem; float* sseg = sb + 64 * 65;
  bf16_t* kendT = (bf16_t*)(sseg + 256); bf16_t* vT = kendT + 64 * 72;
  const int n = item & 127, h = (item >> 7) & 3, b = item >> 9;
  const int tid = TIDX & 255, lane = tid & 63, wave = tid >> 6, l32 = lane & 31, kb = lane >> 5;
  VRegs vr; gla_load_v(proj, b, h, n, vr);
  u32x4 k0, k1;
  {
    const int j = tid & 63, dq = tid >> 6;
    const size_t t = (size_t)b * SEQ + n * 64 + j;
    k0 = *(const u32x4*)(proj + t * PW + C_GK + h * 64 + dq * 16); k1 = *(const u32x4*)(proj + t * PW + C_GK + h * 64 + dq * 16 + 8);
  }
  gla_gates(P, proj, b, h, n, sb, sseg, (float*)vT);
  {
    const int j = tid & 63, dq = tid >> 6;
    float kv[16];
#pragma unroll
    for (int e = 0; e < 4; ++e) { kv[2 * e] = bflo(k0[e]); kv[2 * e + 1] = bfhi(k0[e]); kv[8 + 2 * e] = bflo(k1[e]); kv[8 + 2 * e + 1] = bfhi(k1[e]); }
#pragma unroll
    for (int dd = 0; dd < 16; ++dd) {
      const int d = dq * 16 + dd;
      kendT[d * 72 + j] = f2bf(kv[dd] * __expf(sb[63 * 65 + d] - sb[j * 65 + d]));
    }
    if (tid < 64) decay[((size_t)(b * 4 + h) * 128 + n) * 64 + tid] = __expf(sb[63 * 65 + tid]);
  }
  gla_store_vT(vr, vT);
  __syncthreads();
#pragma unroll
  for (int dt = 0; dt < 2; ++dt) {
    f32x16 acc = zero16();
#pragma unroll
    for (int s = 0; s < 4; ++s) {
      const bf16x8 a = *(const bf16x8*)(vT + (wave * 32 + l32) * 72 + s * 16 + kb * 8);
      const bf16x8 bb = *(const bf16x8*)(kendT + (dt * 32 + l32) * 72 + s * 16 + kb * 8);
      acc = mfma(a, bb, acc);
    }
    bf16_t* dst = states + ((size_t)((b * 4 + h) * 128 + n) * 128) * 64;
#pragma unroll
    for (int r = 0; r < 16; ++r) dst[(size_t)(wave * 32 + crow(r, kb)) * 64 + dt * 32 + l32] = f2bf(acc[r]);
  }
  __syncthreads();
}

DI void gla_scan(const Params& P) {
  bf16_t* states = (bf16_t*)(P.ws + R2);
  const float* decay = (const float*)(P.ws + R_DECAY);
  const int total = 32 * 4096;
  for (int e = blockIdx.x * blockDim.x + TIDX; e < total; e += gridDim.x * blockDim.x) {
    const int bh = e >> 12, idx = (e & 4095) * 2, d = idx & 63;
    bf16_t* p = states + (size_t)bh * 128 * 8192 + idx;
    const float* dc = decay + (size_t)bh * 128 * 64 + d;
    float S0 = 0.f, S1 = 0.f;
#pragma unroll 8
    for (int n = 0; n < 128; ++n) {
      const unsigned ds = *(const unsigned*)(p + (size_t)n * 8192);
      const float2 dec = *(const float2*)(dc + n * 64);
      *(unsigned*)(p + (size_t)n * 8192) = pk2(S0, S1);
      S0 = dec.x * S0 + bflo(ds); S1 = dec.y * S1 + bfhi(ds);
    }
  }
}

DI void gla_p3_item(const Params& P, int item, char* smem) {
  const bf16_t* proj = (const bf16_t*)(P.ws + R1);
  const bf16_t* states = (const bf16_t*)(P.ws + R2);
  bf16_t* mix = (bf16_t*)(P.ws + R3);
  float* sb = (float*)smem; float* sseg = sb + 64 * 65; float* sred = sseg + 256;
  bf16_t* sq = (bf16_t*)(sred + 256); bf16_t* sk = sq + 64 * 72; bf16_t* vT = sk + 64 * 72;
  const int n = item & 127, h = (item >> 7) & 3, b = item >> 9;
  const int tid = TIDX & 255, lane = tid & 63, wave = tid >> 6, l32 = lane & 31, kb = lane >> 5;
  VRegs vr; gla_load_v(proj, b, h, n, vr);
  u32x4 q0, q1, k0, k1;
  bf16x8 sf[4];
  {
    const int i = tid & 63, dq = tid >> 6;
    const size_t t = (size_t)b * SEQ + n * 64 + i;
    q0 = *(const u32x4*)(proj + t * PW + C_GQ + h * 64 + dq * 16); q1 = *(const u32x4*)(proj + t * PW + C_GQ + h * 64 + dq * 16 + 8);
    k0 = *(const u32x4*)(proj + t * PW + C_GK + h * 64 + dq * 16); k1 = *(const u32x4*)(proj + t * PW + C_GK + h * 64 + dq * 16 + 8);
    const bf16_t* sp = states + ((size_t)((b * 4 + h) * 128 + n) * 128 + wave * 32 + l32) * 64;
#pragma unroll
    for (int s4 = 0; s4 < 4; ++s4) sf[s4] = *(const bf16x8*)(sp + s4 * 16 + kb * 8);
  }
  gla_gates(P, proj, b, h, n, sb, sseg, (float*)vT);
  {
    const int i = tid & 63, dq = tid >> 6;
    float qv[16], kv[16];
#pragma unroll
    for (int e = 0; e < 4; ++e) {
      qv[2 * e] = bflo(q0[e]); qv[2 * e + 1] = bfhi(q0[e]); qv[8 + 2 * e] = bflo(q1[e]); qv[8 + 2 * e + 1] = bfhi(q1[e]);
      kv[2 * e] = bflo(k0[e]); kv[2 * e + 1] = bfhi(k0[e]); kv[8 + 2 * e] = bflo(k1[e]); kv[8 + 2 * e + 1] = bfhi(k1[e]);
    }
#pragma unroll
    for (int dd = 0; dd < 16; ++dd) {
      const int d = dq * 16 + dd;
      const float bb = sb[i * 65 + d];
      sq[i * 72 + d] = f2bf(qv[dd] * 0.125f * __expf(bb));
      sk[i * 72 + d] = f2bf(kv[dd] * __expf(-bb));
    }
  }
  gla_store_vT(vr, vT);
  __syncthreads();
  f32x16 x00 = zero16(), x01 = zero16(), x11 = zero16();
#pragma unroll
  for (int s = 0; s < 4; ++s) {
    const bf16x8 kj0 = *(const bf16x8*)(sk + (l32)*72 + s * 16 + kb * 8);
    const bf16x8 kj1 = *(const bf16x8*)(sk + (32 + l32) * 72 + s * 16 + kb * 8);
    const bf16x8 qi0 = *(const bf16x8*)(sq + (l32)*72 + s * 16 + kb * 8);
    const bf16x8 qi1 = *(const bf16x8*)(sq + (32 + l32) * 72 + s * 16 + kb * 8);
    x00 = mfma(kj0, qi0, x00); x01 = mfma(kj0, qi1, x01); x11 = mfma(kj1, qi1, x11);
  }
#pragma unroll
  for (int r = 0; r < 16; ++r) { const bool keep = crow(r, kb) <= l32; x00[r] = keep ? x00[r] : 0.f; x11[r] = keep ? x11[r] : 0.f; }
  f32x16 o0 = zero16(), o1 = zero16();
  const int dvr = wave * 32 + l32;
#pragma unroll
  for (int s = 0; s < 2; ++s) {
    const bf16x8 p00 = pack8(x00[8 * s], x00[8 * s + 1], x00[8 * s + 2], x00[8 * s + 3], x00[8 * s + 4], x00[8 * s + 5], x00[8 * s + 6], x00[8 * s + 7]);
    const bf16x8 p01 = pack8(x01[8 * s], x01[8 * s + 1], x01[8 * s + 2], x01[8 * s + 3], x01[8 * s + 4], x01[8 * s + 5], x01[8 * s + 6], x01[8 * s + 7]);
    const bf16x8 p11 = pack8(x11[8 * s], x11[8 * s + 1], x11[8 * s + 2], x11[8 * s + 3], x11[8 * s + 4], x11[8 * s + 5], x11[8 * s + 6], x11[8 * s + 7]);
    const bf16x8 v0 = ld2x4(vT + dvr * 72 + 16 * s + 4 * kb);
    const bf16x8 v1 = ld2x4(vT + dvr * 72 + 32 + 16 * s + 4 * kb);
    o0 = mfma(v0, p00, o0); o1 = mfma(v0, p01, o1); o1 = mfma(v1, p11, o1);
  }
  {
#pragma unroll
    for (int s = 0; s < 4; ++s) {
      const bf16x8 a = sf[s];
      const bf16x8 qi0 = *(const bf16x8*)(sq + (l32)*72 + s * 16 + kb * 8);
      const bf16x8 qi1 = *(const bf16x8*)(sq + (32 + l32) * 72 + s * 16 + kb * 8);
      o0 = mfma(a, qi0, o0); o1 = mfma(a, qi1, o1);
    }
  }
  float s0 = 0.f, s1 = 0.f;
#pragma unroll
  for (int r = 0; r < 16; ++r) { s0 += o0[r] * o0[r]; s1 += o1[r] * o1[r]; }
  s0 += __shfl_xor(s0, 32); s1 += __shfl_xor(s1, 32);
  if (kb == 0) { sred[wave * 64 + l32] = s0; sred[wave * 64 + 32 + l32] = s1; }
  __syncthreads();
  const float t0s = sred[l32] + sred[64 + l32] + sred[128 + l32] + sred[192 + l32];
  const float t1s = sred[32 + l32] + sred[64 + 32 + l32] + sred[128 + 32 + l32] + sred[192 + 32 + l32];
  const float r0 = rsqrtf(t0s * (1.f / 128.f) + EPS), r1 = rsqrtf(t1s * (1.f / 128.f) + EPS);
#pragma unroll
  for (int it = 0; it < 2; ++it) {
    const size_t t = (size_t)b * SEQ + n * 64 + it * 32 + l32;
    const float rr = it ? r1 : r0;
#pragma unroll
    for (int gq = 0; gq < 4; ++gq) {
      const int dv = wave * 32 + 8 * gq + 4 * kb;
      const u32x2 ru = *(const u32x2*)(proj + t * PW + C_GR + h * 128 + dv);
      const float4 gn = *(const float4*)(P.gla_norm + h * 128 + dv);
      float rv[4] = {bflo(ru[0]), bfhi(ru[0]), bflo(ru[1]), bfhi(ru[1])};
      float gv[4] = {gn.x, gn.y, gn.z, gn.w};
      float ov[4];
#pragma unroll
      for (int e = 0; e < 4; ++e) {
        const float a = it ? o1[gq * 4 + e] : o0[gq * 4 + e];
        ov[e] = a * rr * gv[e] * (rv[e] * frcp(1.f + __expf(-rv[e])));
      }
      u32x2 o; o[0] = pk2(ov[0], ov[1]); o[1] = pk2(ov[2], ov[3]);
      *(u32x2*)(mix + t * DM + h * 128 + dv) = o;
    }
  }
  __syncthreads();
}

DI void nsa_compress_task(const Params& P, int task) {
  const bf16_t* proj = (const bf16_t*)(P.ws + R1);
  const int lane = TIDX & 63, l32 = lane & 31, kb = lane >> 5;
  const int ct = task & 15, g = (task >> 4) & 1, b = (task >> 5) & 7, br = task >> 8;
  const bf16_t* w1T = (const bf16_t*)(P.ws + W_CW1) + (size_t)br * 128 * 2048;
  const bf16_t* w2T = (const bf16_t*)(P.ws + W_CW2) + (size_t)br * 64 * 128;
  const float* bias1 = (const float*)(P.ws + W_BIAS1) + br * 128;
  const int c = ct * 32 + l32;
  const int cc = c < 511 ? c : 510;
  const bf16_t* src = proj + ((size_t)b * SEQ + cc * 16) * PW + (br ? C_VC : C_KC) + g * 64 + kb * 8;
  f32x16 acc[4];
#pragma unroll
  for (int i = 0; i < 4; ++i) acc[i] = zero16();
#pragma unroll 1
  for (int ks = 0; ks < 128; ++ks) {
    const int l = ks >> 2, dh0 = (ks & 3) * 16;
    const bf16x8 bf = *(const bf16x8*)(src + (size_t)l * PW + dh0);
#pragma unroll
    for (int ht = 0; ht < 4; ++ht) {
      const bf16x8 af = *(const bf16x8*)(w1T + (size_t)(ht * 32 + l32) * 2048 + ks * 16 + kb * 8);
      acc[ht] = mfma(af, bf, acc[ht]);
    }
  }
#pragma unroll
  for (int ht = 0; ht < 4; ++ht)
#pragma unroll
    for (int r = 0; r < 16; ++r) acc[ht][r] = gelu_tanh(acc[ht][r] + bias1[ht * 32 + crow(r, kb)]);
  f32x16 o[2]; o[0] = zero16(); o[1] = zero16();
#pragma unroll
  for (int ht = 0; ht < 4; ++ht)
#pragma unroll
    for (int s = 0; s < 2; ++s) {
      const bf16x8 hf = pack8(acc[ht][8 * s], acc[ht][8 * s + 1], acc[ht][8 * s + 2], acc[ht][8 * s + 3], acc[ht][8 * s + 4], acc[ht][8 * s + 5], acc[ht][8 * s + 6], acc[ht][8 * s + 7]);
#pragma unroll
      for (int dt = 0; dt < 2; ++dt) {
        const bf16x8 wf = ld2x4(w2T + (size_t)(dt * 32 + l32) * 128 + ht * 32 + 16 * s + 4 * kb);
        o[dt] = mfma(wf, hf, o[dt]);
      }
    }
  if (c < 511) {
    {
      bf16_t* dst = (bf16_t*)(P.ws + (br ? R_VCMPT : R_KCMP)) + ((size_t)(b * 2 + g) * 512 + c) * 64;
#pragma unroll
      for (int dt = 0; dt < 2; ++dt)
#pragma unroll
        for (int gq = 0; gq < 4; ++gq) {
          u32x2 u; u[0] = pk2(o[dt][gq * 4], o[dt][gq * 4 + 1]); u[1] = pk2(o[dt][gq * 4 + 2], o[dt][gq * 4 + 3]);
          *(u32x2*)(dst + dt * 32 + 8 * gq + 4 * kb) = u;
        }
    }
  }
}

DI void nsa_transpose_v(const Params& P) {
  const bf16_t* proj = (const bf16_t*)(P.ws + R1);
  const int total = 2 * 8 * 2 * 1024 * 64;
  for (int u = blockIdx.x * blockDim.x + TIDX; u < total; u += gridDim.x * blockDim.x) {
    const int dh = u & 63; int rest = u >> 6; const int t8 = rest & 1023; rest >>= 10;
    const int g = rest & 1, b = (rest >> 1) & 7, which = rest >> 4;
    const bf16_t* src = proj + ((size_t)b * SEQ + t8 * 8) * PW + (which ? C_VW : C_VS) + g * 64 + dh;
    bf16_t v[8];
#pragma unroll
    for (int j = 0; j < 8; ++j) v[j] = src[(size_t)j * PW];
    u32x4 o;
#pragma unroll
    for (int j = 0; j < 4; ++j) o[j] = (unsigned)v[2 * j] | ((unsigned)v[2 * j + 1] << 16);
    bf16_t* dst = (bf16_t*)(P.ws + (which ? R_VWT : R_VST)) + ((size_t)(b * 2 + g) * 64 + dh) * SEQ + t8 * 8;
    *(u32x4*)dst = o;
  }
}

DI f32x16 qk_tile(const bf16_t* krow, const bf16x8 (&qf)[4]) {
  f32x16 s = zero16();
#pragma unroll
  for (int i = 0; i < 4; ++i) { const bf16x8 kf = *(const bf16x8*)(krow + i * 16); s = mfma(kf, qf[i], s); }
  return s;
}

DI float half_max(float x) {
  const auto r = __builtin_amdgcn_permlane32_swap(__float_as_uint(x), __float_as_uint(x), false, false);
  return fmaxf(__uint_as_float(r[0]), __uint_as_float(r[1]));
}
DI float half_sum(float x) {
  const auto r = __builtin_amdgcn_permlane32_swap(__float_as_uint(x), __float_as_uint(x), false, false);
  return __uint_as_float(r[0]) + __uint_as_float(r[1]);
}
DI s16x4 lds_tr(const char* p) { return __builtin_amdgcn_ds_read_tr16_b64_v4i16((__attribute__((address_space(3))) s16x4*)p); }

template <bool EDGE>
DI void softmax_tile(f32x16& s, int k0, int tq, int lo, bool bit, int kb, f32x16& o0, f32x16& o1, float& m, float& l) {
  constexpr float CS = 0.125f * 1.4426950408889634f;
  float tmax = -1e30f;
  if (EDGE) {
#pragma unroll
    for (int r = 0; r < 16; ++r) {
      const int key = k0 + crow(r, kb);
      const bool vd = (key <= tq) && (key > lo);
      s[r] = vd ? s[r] * CS : -1e30f;
      tmax = fmaxf(tmax, s[r]);
    }
  } else {
#pragma unroll
    for (int r = 0; r < 16; ++r) tmax = fmaxf(tmax, s[r]);
    tmax *= CS;
  }
  tmax = bit ? tmax : -1e30f;
  tmax = half_max(tmax);
  if (__ballot(tmax > m + 8.0f) != 0ull) {
    const float mn = fmaxf(m, tmax);
    const float alpha = __builtin_amdgcn_exp2f(m - mn);
    l *= alpha; m = mn;
#pragma unroll
    for (int r = 0; r < 16; ++r) { o0[r] *= alpha; o1[r] *= alpha; }
  }
  float ps = 0.f;
  if (EDGE) {
    const bool live = bit && (m > -5e29f);
#pragma unroll
    for (int r = 0; r < 16; ++r) {
      const float e = __builtin_amdgcn_exp2f(s[r] - m);
      s[r] = live ? e : 0.f;
      ps += s[r];
    }
  } else {
    const float me = bit ? m : 1e30f;
#pragma unroll
    for (int r = 0; r < 16; ++r) {
      s[r] = __builtin_amdgcn_exp2f(__builtin_fmaf(s[r], CS, -me));
      ps += s[r];
    }
  }
  l += ps;
}

struct HeadAcc { f32x16 o0, o1; float m, l; };

DI float tile_max_raw(const f32x16& s) {
  float t = -1e30f;
#pragma unroll
  for (int r = 0; r < 16; ++r) t = fmaxf(t, s[r]);
  return t * (0.125f * 1.4426950408889634f);
}
DI void rescale_head(HeadAcc& H, float tmax) {
  const float mn = fmaxf(H.m, tmax);
  const float alpha = __builtin_amdgcn_exp2f(H.m - mn);
  H.l *= alpha; H.m = mn;
#pragma unroll
  for (int r = 0; r < 16; ++r) { H.o0[r] *= alpha; H.o1[r] *= alpha; }
}
DI void tile_exp_interior(f32x16& s, bool bit, float m, float& l) {
  constexpr float CS = 0.125f * 1.4426950408889634f;
  const float me = bit ? m : 1e30f;
  float ps = 0.f;
#pragma unroll
  for (int r = 0; r < 16; ++r) { s[r] = __builtin_amdgcn_exp2f(__builtin_fmaf(s[r], CS, -me)); ps += s[r]; }
  l += ps;
}

template <bool EDGE>
DI void attn_step2(const bf16_t* sKt, const char* sVt, const bf16x8 (&qa)[4], const bf16x8 (&qb)[4], int k0, int tq, int lo, bool bit,
                   int lane, HeadAcc& A, HeadAcc& B) {
  const int l32 = lane & 31, kb = lane >> 5, i16 = lane & 15, q = i16 >> 2, p = i16 & 3, gc = (lane >> 4) & 1;
  f32x16 sa = zero16(), sb = zero16();
#pragma unroll
  for (int i = 0; i < 4; ++i) {
    const bf16x8 kf = *(const bf16x8*)(sKt + l32 * 72 + i * 16 + kb * 8);
    sa = mfma(kf, qa[i], sa); sb = mfma(kf, qb[i], sb);
  }
  bf16x8 vf[2][2];
#pragma unroll
  for (int dt = 0; dt < 2; ++dt)
#pragma unroll
    for (int sI = 0; sI < 2; ++sI) {
      const char* vp = sVt + (16 * sI + 4 * kb + q) * 144 + (dt * 32 + gc * 16 + 4 * p) * 2;
      const s16x4 lo4 = lds_tr(vp), hi4 = lds_tr(vp + 8 * 144);
      vf[dt][sI] = __builtin_shufflevector(lo4, hi4, 0, 1, 2, 3, 4, 5, 6, 7);
    }
  if (EDGE) {
    softmax_tile<EDGE>(sa, k0, tq, lo, bit, kb, A.o0, A.o1, A.m, A.l);
    softmax_tile<EDGE>(sb, k0, tq, lo, bit, kb, B.o0, B.o1, B.m, B.l);
  } else {
    float ta = tile_max_raw(sa), tb = tile_max_raw(sb);
    if (__ballot(bit && ((ta > A.m + 8.0f) || (tb > B.m + 8.0f))) != 0ull) {
      ta = half_max(bit ? ta : -1e30f); tb = half_max(bit ? tb : -1e30f);
      rescale_head(A, ta); rescale_head(B, tb);
    }
    tile_exp_interior(sa, bit, A.m, A.l);
    tile_exp_interior(sb, bit, B.m, B.l);
  }
#pragma unroll
  for (int sI = 0; sI < 2; ++sI) {
    const bf16x8 pa = pack8(sa[8 * sI], sa[8 * sI + 1], sa[8 * sI + 2], sa[8 * sI + 3], sa[8 * sI + 4], sa[8 * sI + 5], sa[8 * sI + 6], sa[8 * sI + 7]);
    const bf16x8 pb = pack8(sb[8 * sI], sb[8 * sI + 1], sb[8 * sI + 2], sb[8 * sI + 3], sb[8 * sI + 4], sb[8 * sI + 5], sb[8 * sI + 6], sb[8 * sI + 7]);
    A.o0 = mfma(vf[0][sI], pa, A.o0); A.o1 = mfma(vf[1][sI], pa, A.o1);
    B.o0 = mfma(vf[0][sI], pb, B.o0); B.o1 = mfma(vf[1][sI], pb, B.o1);
  }
}

template <bool WIN>
DI void nsa_branch2(const bf16_t* kbase, const bf16_t* vbase, char* smem, int st0, int st1, int qt, int tq, const bf16x8 (&qa)[4],
                    const bf16x8 (&qb)[4], unsigned mk0, unsigned mk1, unsigned mk2, unsigned mk3, HeadAcc& A, HeadAcc& B) {
  const int tid = TIDX, lane = tid & 63;
  const int srow = tid >> 3, schunk = (tid & 7) * 8;
  const bf16_t* kg = kbase + (size_t)srow * PW + schunk;
  const bf16_t* vg = vbase + (size_t)srow * PW + schunk;
  const int soff = (srow * 72 + schunk) * 2;
  u32x4 rk = *(const u32x4*)(kg + (size_t)st0 * 64 * PW), rv = *(const u32x4*)(vg + (size_t)st0 * 64 * PW);
  *(u32x4*)(smem + soff) = rk; *(u32x4*)(smem + 9216 + soff) = rv;
  __syncthreads();
  for (int st = st0; st <= st1; ++st) {
    const int cur = (st - st0) & 1;
    if (st < st1) { rk = *(const u32x4*)(kg + (size_t)(st + 1) * 64 * PW); rv = *(const u32x4*)(vg + (size_t)(st + 1) * 64 * PW); }
    const bf16_t* bK = (const bf16_t*)(smem + cur * 18432);
    const char* bV = smem + cur * 18432 + 9216;
    bool bit = true;
    if (!WIN) { const unsigned mw = st < 32 ? mk0 : (st < 64 ? mk1 : (st < 96 ? mk2 : mk3)); bit = (mw >> (st & 31)) & 1u; }
    const bool any = WIN ? true : (__ballot(bit) != 0ull);
#pragma unroll
    for (int tt = 0; tt < 2; ++tt) {
      const int kt = 2 * st + tt;
      const bool in_range = WIN ? (kt <= qt && kt >= qt - 16) : (kt <= qt);
      if (in_range && any) {
        const bool edge = WIN ? (kt == qt || kt == qt - 16) : (kt == qt);
        if (edge) attn_step2<true>(bK + tt * 32 * 72, bV + tt * 32 * 144, qa, qb, kt * 32, tq, WIN ? tq - 512 : -1, bit, lane, A, B);
        else attn_step2<false>(bK + tt * 32 * 72, bV + tt * 32 * 144, qa, qb, kt * 32, tq, WIN ? tq - 512 : -1, bit, lane, A, B);
      }
    }
    if (st < st1) { *(u32x4*)(smem + (cur ^ 1) * 18432 + soff) = rk; *(u32x4*)(smem + (cur ^ 1) * 18432 + 9216 + soff) = rv; }
    __syncthreads();
  }
}

DI void fold_partial(bf16_t* dst, float f, const f32x16& a0, const f32x16& a1, int kb) {
#pragma unroll
  for (int gq = 0; gq < 4; ++gq) {
    bf16_t* d0 = dst + 8 * gq + 4 * kb;
    bf16_t* d1 = d0 + 32;
    const u32x2 p0 = *(const u32x2*)d0, p1 = *(const u32x2*)d1;
    u32x2 u0, u1;
    u0[0] = pk2(bflo(p0[0]) + f * a0[gq * 4], bfhi(p0[0]) + f * a0[gq * 4 + 1]);
    u0[1] = pk2(bflo(p0[1]) + f * a0[gq * 4 + 2], bfhi(p0[1]) + f * a0[gq * 4 + 3]);
    u1[0] = pk2(bflo(p1[0]) + f * a1[gq * 4], bfhi(p1[0]) + f * a1[gq * 4 + 1]);
    u1[1] = pk2(bflo(p1[1]) + f * a1[gq * 4 + 2], bfhi(p1[1]) + f * a1[gq * 4 + 3]);
    *(u32x2*)d0 = u0; *(u32x2*)d1 = u1;
  }
}

template <bool ADD>
DI void lds_fold(bf16_t* scr, int hoff, float f, const f32x16& a0, const f32x16& a1, int l32, int kb) {
#pragma unroll
  for (int gq = 0; gq < 4; ++gq) {
    bf16_t* d0 = scr + l32 * 136 + hoff + 8 * gq + 4 * kb;
    bf16_t* d1 = d0 + 32;
    u32x2 u0, u1;
    if (ADD) {
      const u32x2 p0 = *(const u32x2*)d0, p1 = *(const u32x2*)d1;
      u0[0] = pk2(bflo(p0[0]) + f * a0[gq * 4], bfhi(p0[0]) + f * a0[gq * 4 + 1]);
      u0[1] = pk2(bflo(p0[1]) + f * a0[gq * 4 + 2], bfhi(p0[1]) + f * a0[gq * 4 + 3]);
      u1[0] = pk2(bflo(p1[0]) + f * a1[gq * 4], bfhi(p1[0]) + f * a1[gq * 4 + 1]);
      u1[1] = pk2(bflo(p1[1]) + f * a1[gq * 4 + 2], bfhi(p1[1]) + f * a1[gq * 4 + 3]);
    } else {
      u0[0] = pk2(f * a0[gq * 4], f * a0[gq * 4 + 1]); u0[1] = pk2(f * a0[gq * 4 + 2], f * a0[gq * 4 + 3]);
      u1[0] = pk2(f * a1[gq * 4], f * a1[gq * 4 + 1]); u1[1] = pk2(f * a1[gq * 4 + 2], f * a1[gq * 4 + 3]);
    }
    *(u32x2*)d0 = u0; *(u32x2*)d1 = u1;
  }
}

DI void nsa_block(const Params& P, int b, int g, int qb, char* smem) {
  const int wv = __builtin_amdgcn_readfirstlane(TIDX >> 6);
  const int qt = qb * 8 + wv;
  float* imp = (float*)smem + wv * 4096;
  const bf16_t* proj = (const bf16_t*)(P.ws + R1);
  bf16_t* mix = (bf16_t*)(P.ws + R3);
  const int lane = TIDX & 63, l32 = lane & 31, kb = lane >> 5;
  const int t0 = qt * 32, tq = t0 + l32;
  const size_t tokq = (size_t)b * SEQ + tq;
  const bf16_t* qrow = proj + tokq * PW;
  const bf16_t* kcmp = (const bf16_t*)(P.ws + R_KCMP) + (size_t)(b * 2 + g) * 512 * 64;
  const bf16_t* vcmp = (const bf16_t*)(P.ws + R_VCMPT) + (size_t)(b * 2 + g) * 512 * 64;
  const int nct = (qb >> 1) + 1;
  const int nst = (nct + 1) >> 1;
  for (int i = lane; i < 4096; i += 64) imp[i] = 0.f;
  {
    constexpr float CS = 0.125f * 1.4426950408889634f;
    char* stg = smem + LDS_CMP_STAGE;
    const int tid = TIDX;
    const int srow = tid >> 3, schunk = (tid & 7) * 8, soff = (srow * 72 + schunk) * 2;
    const int i16 = lane & 15, q4 = i16 >> 2, p4 = i16 & 3, gc = (lane >> 4) & 1;
#pragma unroll 1
    for (int hp = 0; hp < 2; ++hp) {
      const int head = g * 4 + hp * 2;
      bf16x8 qa[4], qb_[4];
#pragma unroll
      for (int i = 0; i < 4; ++i) {
        qa[i] = *(const bf16x8*)(qrow + C_NQ + head * 64 + i * 16 + kb * 8);
        qb_[i] = *(const bf16x8*)(qrow + C_NQ + (head + 1) * 64 + i * 16 + kb * 8);
      }
      float mA = -1e30f, lA = 0.f, mB = -1e30f, lB = 0.f;
      u32x4 rk = *(const u32x4*)(kcmp + (size_t)srow * 64 + schunk), rv;
      for (int st = 0; st < nst; ++st) {
        *(u32x4*)(stg + soff) = rk;
        __syncthreads();
        if (st + 1 < nst) rk = *(const u32x4*)(kcmp + (size_t)((st + 1) * 64 + srow) * 64 + schunk);
#pragma unroll
        for (int tt = 0; tt < 2; ++tt) {
          const int ct = 2 * st + tt;
          if (ct < nct) {
            const bf16_t* sKt = (const bf16_t*)stg + tt * 32 * 72;
            f32x16 sa = zero16(), sb = zero16();
#pragma unroll
            for (int i = 0; i < 4; ++i) {
              const bf16x8 kf = *(const bf16x8*)(sKt + l32 * 72 + i * 16 + kb * 8);
              sa = mfma(kf, qa[i], sa); sb = mfma(kf, qb_[i], sb);
            }
            float tA = -1e30f, tB = -1e30f;
#pragma unroll
            for (int r = 0; r < 16; ++r) {
              const int c = ct * 32 + crow(r, kb);
              const bool vd = (c * 16 + 31 <= tq);
              sa[r] = vd ? sa[r] * CS : -1e30f; sb[r] = vd ? sb[r] * CS : -1e30f;
              tA = fmaxf(tA, sa[r]); tB = fmaxf(tB, sb[r]);
            }
            const float nA = fmaxf(mA, tA), nB = fmaxf(mB, tB);
            float pA = 0.f, pB = 0.f;
#pragma unroll
            for (int r = 0; r < 16; ++r) {
              pA += (sa[r] > -5e29f) ? __builtin_amdgcn_exp2f(sa[r] - nA) : 0.f;
              pB += (sb[r] > -5e29f) ? __builtin_amdgcn_exp2f(sb[r] - nB) : 0.f;
            }
            lA = lA * __builtin_amdgcn_exp2f(mA - nA) + pA; mA = nA;
            lB = lB * __builtin_amdgcn_exp2f(mB - nB) + pB; mB = nB;
          }
        }
        __syncthreads();
      }
      float MA, iLA, MB, iLB;
      {
        const float mo = __shfl_xor(mA, 32), lo_ = __shfl_xor(lA, 32);
        MA = fmaxf(mA, mo);
        iLA = frcp(fmaxf(lA * __builtin_amdgcn_exp2f(mA - MA) + lo_ * __builtin_amdgcn_exp2f(mo - MA), 1e-30f));
        const float mo2 = __shfl_xor(mB, 32), lo2 = __shfl_xor(lB, 32);
        MB = fmaxf(mB, mo2);
        iLB = frcp(fmaxf(lB * __builtin_amdgcn_exp2f(mB - MB) + lo2 * __builtin_amdgcn_exp2f(mo2 - MB), 1e-30f));
      }
      f32x16 oA0 = zero16(), oA1 = zero16(), oB0 = zero16(), oB1 = zero16();
      float carry = 0.f;
      rk = *(const u32x4*)(kcmp + (size_t)srow * 64 + schunk); rv = *(const u32x4*)(vcmp + (size_t)srow * 64 + schunk);
      for (int st = 0; st < nst; ++st) {
        *(u32x4*)(stg + soff) = rk; *(u32x4*)(stg + 9216 + soff) = rv;
        __syncthreads();
        if (st + 1 < nst) {
          rk = *(const u32x4*)(kcmp + (size_t)((st + 1) * 64 + srow) * 64 + schunk);
          rv = *(const u32x4*)(vcmp + (size_t)((st + 1) * 64 + srow) * 64 + schunk);
        }
#pragma unroll
        for (int tt = 0; tt < 2; ++tt) {
          const int ct = 2 * st + tt;
          if (ct < nct) {
            const bf16_t* sKt = (const bf16_t*)stg + tt * 32 * 72;
            const char* sVt = stg + 9216 + tt * 32 * 144;
            f32x16 sa = zero16(), sb = zero16();
#pragma unroll
            for (int i = 0; i < 4; ++i) {
              const bf16x8 kf = *(const bf16x8*)(sKt + l32 * 72 + i * 16 + kb * 8);
              sa = mfma(kf, qa[i], sa); sb = mfma(kf, qb_[i], sb);
            }
            bf16x8 vf[2][2];
#pragma unroll
            for (int dt = 0; dt < 2; ++dt)
#pragma unroll
              for (int sI = 0; sI < 2; ++sI) {
                const char* vp = sVt + (16 * sI + 4 * kb + q4) * 144 + (dt * 32 + gc * 16 + 4 * p4) * 2;
                const s16x4 lo4 = lds_tr(vp), hi4 = lds_tr(vp + 8 * 144);
                vf[dt][sI] = __builtin_shufflevector(lo4, hi4, 0, 1, 2, 3, 4, 5, 6, 7);
              }
            f32x16 ps;
#pragma unroll
            for (int r = 0; r < 16; ++r) {
              const int c = ct * 32 + crow(r, kb);
              const bool vd = (c * 16 + 31 <= tq);
              sa[r] = vd ? __builtin_amdgcn_exp2f(__builtin_fmaf(sa[r], CS, -MA)) * iLA : 0.f;
              sb[r] = vd ? __builtin_amdgcn_exp2f(__builtin_fmaf(sb[r], CS, -MB)) * iLB : 0.f;
              ps[r] = sa[r] + sb[r];
            }
            float y[4];
#pragma unroll
            for (int gi = 0; gi < 4; ++gi) y[gi] = __shfl_xor(ps[4 * gi + 3], 32);
#pragma unroll
            for (int gi = 0; gi < 4; ++gi) {
              const float s4 = (ps[4 * gi] + ps[4 * gi + 1]) + (ps[4 * gi + 2] + ps[4 * gi + 3]);
              const float extra = kb ? y[gi] : (gi == 0 ? carry : y[gi > 0 ? gi - 1 : 0]);
              const int j = ct * 8 + 2 * gi + kb;
              imp[j * 32 + l32] += s4 + extra;
            }
            carry = y[3];
#pragma unroll
            for (int sI = 0; sI < 2; ++sI) {
              const bf16x8 pa = pack8(sa[8 * sI], sa[8 * sI + 1], sa[8 * sI + 2], sa[8 * sI + 3], sa[8 * sI + 4], sa[8 * sI + 5], sa[8 * sI + 6], sa[8 * sI + 7]);
              const bf16x8 pb = pack8(sb[8 * sI], sb[8 * sI + 1], sb[8 * sI + 2], sb[8 * sI + 3], sb[8 * sI + 4], sb[8 * sI + 5], sb[8 * sI + 6], sb[8 * sI + 7]);
              oA0 = mfma(vf[0][sI], pa, oA0); oA1 = mfma(vf[1][sI], pa, oA1);
              oB0 = mfma(vf[0][sI], pb, oB0); oB1 = mfma(vf[1][sI], pb, oB1);
            }
          }
        }
        __syncthreads();
      }
      const float gA = sigmoidf_(bf2f(qrow[C_NG + head * 3 + 0]) + P.nsa_gate_b[head * 3 + 0]);
      const float gB = sigmoidf_(bf2f(qrow[C_NG + (head + 1) * 3 + 0]) + P.nsa_gate_b[(head + 1) * 3 + 0]);
#pragma unroll
      for (int gq = 0; gq < 4; ++gq) {
        u32x2 u0, u1, u2, u3;
        u0[0] = pk2(gA * oA0[gq * 4], gA * oA0[gq * 4 + 1]); u0[1] = pk2(gA * oA0[gq * 4 + 2], gA * oA0[gq * 4 + 3]);
        u1[0] = pk2(gA * oA1[gq * 4], gA * oA1[gq * 4 + 1]); u1[1] = pk2(gA * oA1[gq * 4 + 2], gA * oA1[gq * 4 + 3]);
        u2[0] = pk2(gB * oB0[gq * 4], gB * oB0[gq * 4 + 1]); u2[1] = pk2(gB * oB0[gq * 4 + 2], gB * oB0[gq * 4 + 3]);
        u3[0] = pk2(gB * oB1[gq * 4], gB * oB1[gq * 4 + 1]); u3[1] = pk2(gB * oB1[gq * 4 + 2], gB * oB1[gq * 4 + 3]);
        bf16_t* d = mix + tokq * DM + 512 + head * 64 + 8 * gq + 4 * kb;
        *(u32x2*)d = u0; *(u32x2*)(d + 32) = u1; *(u32x2*)(d + 64) = u2; *(u32x2*)(d + 96) = u3;
      }
    }
  }
  asm volatile("s_waitcnt lgkmcnt(0)" ::: "memory");
  __builtin_amdgcn_wave_barrier();
  unsigned mk0 = 0, mk1 = 0, mk2 = 0, mk3 = 0;
  {
    const int cur = tq >> 6, jb = kb * 64;
    unsigned key[64];
#pragma unroll
    for (int i = 0; i < 64; ++i) {
      const int j = jb + i;
      const float v = imp[j * 32 + l32];
      const bool forced = (j == 0) || (j == cur) || (j == cur - 1);
      key[i] = forced ? 0xffffffffu : (j <= cur ? __float_as_uint(v) + 1u : 0u);
    }
    unsigned T = 0u;
#pragma unroll 1
    for (int bit = 31; bit >= 0; --bit) {
      const unsigned Tc = T | (1u << bit);
      int cnt = 0;
#pragma unroll
      for (int i = 0; i < 64; ++i) cnt += (key[i] >= Tc) ? 1 : 0;
      const auto r = __builtin_amdgcn_permlane32_swap((unsigned)cnt, (unsigned)cnt, false, false);
      cnt = (int)(r[0] + r[1]);
      T = (cnt >= 16) ? Tc : T;
    }
    int cgt = 0, ceq = 0;
#pragma unroll
    for (int i = 0; i < 64; ++i) { cgt += (key[i] > T) ? 1 : 0; ceq += (key[i] == T) ? 1 : 0; }
    const auto rg = __builtin_amdgcn_permlane32_swap((unsigned)cgt, (unsigned)cgt, false, false);
    const int need = 16 - (int)(rg[0] + rg[1]);
    const auto re = __builtin_amdgcn_permlane32_swap((unsigned)ceq, (unsigned)ceq, false, false);
    int running = kb ? (int)(re[0] + re[1]) - ceq : 0;
    unsigned mlo = 0u, mhi = 0u;
#pragma unroll
    for (int i = 0; i < 64; ++i) {
      const bool eq = key[i] == T;
      const bool sl = (key[i] != 0u) && ((key[i] > T) || (eq && running < need));
      running += eq ? 1 : 0;
      if (i < 32) mlo |= sl ? (1u << i) : 0u; else mhi |= sl ? (1u << (i - 32)) : 0u;
    }
    const auto rl = __builtin_amdgcn_permlane32_swap(mlo, mlo, false, false);
    const auto rh = __builtin_amdgcn_permlane32_swap(mhi, mhi, false, false);
    const unsigned olo = rl[0] ^ rl[1] ^ mlo, ohi = rh[0] ^ rh[1] ^ mhi;
    mk0 = kb ? olo : mlo; mk1 = kb ? ohi : mhi; mk2 = kb ? mlo : olo; mk3 = kb ? mhi : ohi;
  }
  asm volatile("" ::: "memory");
  __syncthreads();
  const bf16_t* ksel = proj + (size_t)b * SEQ * PW + C_KS + g * 64;
  const bf16_t* vsel = proj + (size_t)b * SEQ * PW + C_VS + g * 64;
  const bf16_t* kwin = proj + (size_t)b * SEQ * PW + C_KW + g * 64;
  const bf16_t* vwin = proj + (size_t)b * SEQ * PW + C_VW + g * 64;
  const int st1 = 4 * qb + 3, wst0 = qb > 2 ? 4 * qb - 8 : 0;
#pragma unroll 1
  for (int hp = 0; hp < 2; ++hp) {
    const int head = g * 4 + hp * 2;
    bf16x8 qa[4], qb_[4];
#pragma unroll
    for (int i = 0; i < 4; ++i) {
      qa[i] = *(const bf16x8*)(qrow + C_NQ + head * 64 + i * 16 + kb * 8);
      qb_[i] = *(const bf16x8*)(qrow + C_NQ + (head + 1) * 64 + i * 16 + kb * 8);
    }
    bf16_t* scr = (bf16_t*)(smem + 40960 + wv * 8704);
    HeadAcc A, B;
    A.o0 = zero16(); A.o1 = zero16(); A.m = -1e30f; A.l = 0.f; B.o0 = zero16(); B.o1 = zero16(); B.m = -1e30f; B.l = 0.f;
    nsa_branch2<false>(ksel, vsel, smem, 0, st1, qt, tq, qa, qb_, mk0, mk1, mk2, mk3, A, B);
    {
      const float gA = sigmoidf_(bf2f(qrow[C_NG + head * 3 + 1]) + P.nsa_gate_b[head * 3 + 1]);
      const float gB = sigmoidf_(bf2f(qrow[C_NG + (head + 1) * 3 + 1]) + P.nsa_gate_b[(head + 1) * 3 + 1]);
      lds_fold<false>(scr, 0, gA * frcp(fmaxf(half_sum(A.l), 1e-30f)), A.o0, A.o1, l32, kb);
      lds_fold<false>(scr, 64, gB * frcp(fmaxf(half_sum(B.l), 1e-30f)), B.o0, B.o1, l32, kb);
    }
    A.o0 = zero16(); A.o1 = zero16(); A.m = -1e30f; A.l = 0.f; B.o0 = zero16(); B.o1 = zero16(); B.m = -1e30f; B.l = 0.f;
    nsa_branch2<true>(kwin, vwin, smem, wst0, st1, qt, tq, qa, qb_, 0u, 0u, 0u, 0u, A, B);
    {
      const float gA = sigmoidf_(bf2f(qrow[C_NG + head * 3 + 2]) + P.nsa_gate_b[head * 3 + 2]);
      const float gB = sigmoidf_(bf2f(qrow[C_NG + (head + 1) * 3 + 2]) + P.nsa_gate_b[(head + 1) * 3 + 2]);
      lds_fold<true>(scr, 0, gA * frcp(fmaxf(half_sum(A.l), 1e-30f)), A.o0, A.o1, l32, kb);
      lds_fold<true>(scr, 64, gB * frcp(fmaxf(half_sum(B.l), 1e-30f)), B.o0, B.o1, l32, kb);
    }
    asm volatile("s_waitcnt lgkmcnt(0)" ::: "memory");
    __builtin_amdgcn_wave_barrier();
    {
      bf16_t* mrow = mix + ((size_t)b * SEQ + t0) * DM + 512 + head * 64;
#pragma unroll
      for (int i = 0; i < 8; ++i) {
        const int c = lane + 64 * i, token = c >> 4, col = (c & 15) * 8;
        const u32x4 sv = *(const u32x4*)(scr + token * 136 + col);
        bf16_t* gp = mrow + (size_t)token * DM + col;
        const u32x4 gv = *(const u32x4*)gp;
        u32x4 o;
#pragma unroll
        for (int e = 0; e < 4; ++e) o[e] = pk2(bflo(sv[e]) + bflo(gv[e]), bfhi(sv[e]) + bfhi(gv[e]));
        *(u32x4*)gp = o;
      }
    }
    asm volatile("s_waitcnt lgkmcnt(0)" ::: "memory");
    __builtin_amdgcn_wave_barrier();
  }
}

DI void sgu_item(const Params& P, int item, char* smem) {
  const bf16_t* H = (const bf16_t*)(P.ws + R1);
  bf16_t* Y = (bf16_t*)P.out;
  float* smu = (float*)smem; float* srs = smu + 128; float* sc1 = srs + 128; float* srw = sc1 + 128; float* slg = srw + 128; float* slb = slg + 256;
  bf16_t* sW = (bf16_t*)(smem + 4096);
  char* sV = smem + 4096 + 34816;
  const int tid = TIDX, lane = tid & 63, wave = __builtin_amdgcn_readfirstlane(tid >> 6), l32 = lane & 31, kb = lane >> 5;
  const size_t tok0 = (size_t)item * 128;
#pragma unroll 1
  for (int tb = 0; tb < 16; tb += 4) {
    u32x4 uu[4][4];
#pragma unroll
    for (int a = 0; a < 4; ++a)
#pragma unroll
      for (int k = 0; k < 4; ++k) uu[a][k] = *(const u32x4*)(H + (tok0 + wave * 16 + tb + a) * 4096 + 2048 + k * 512 + lane * 8);
#pragma unroll
    for (int a = 0; a < 4; ++a) {
      float sm = 0.f, s2 = 0.f;
#pragma unroll
      for (int k = 0; k < 4; ++k)
#pragma unroll
        for (int e = 0; e < 4; ++e) { const float x0 = bflo(uu[a][k][e]), x1 = bfhi(uu[a][k][e]); sm += x0 + x1; s2 += x0 * x0 + x1 * x1; }
      sm = wave_sum(sm); s2 = wave_sum(s2);
      const float mu = sm * (1.f / 2048.f);
      const float var = fmaxf(s2 * (1.f / 2048.f) - mu * mu, 0.f);
      if (lane == 0) { smu[wave * 16 + tb + a] = mu; srs[wave * 16 + tb + a] = rsqrtf(var + EPS); }
    }
  }
  __syncthreads();
  const int srow = tid >> 5, schunk = tid & 31;
#pragma unroll 1
  for (int g = 0; g < 8; ++g) {
    u32x4 vreg[8], ureg[8];
#pragma unroll
    for (int i = 0; i < 8; ++i) {
      const bf16_t* hp = H + (tok0 + srow + 16 * i) * 4096 + g * 256 + schunk * 8;
      vreg[i] = *(const u32x4*)(hp + 2048);
      ureg[i] = *(const u32x4*)hp;
    }
    {
      const int t = tid >> 2, qr = tid & 3;
      const float* wrow = P.o_w_s + ((size_t)g * 128 + t) * 128 + qr * 32;
      float4 wq[8];
#pragma unroll
      for (int c4 = 0; c4 < 8; ++c4) wq[c4] = *(const float4*)(wrow + c4 * 4);
      float c1 = 0.f, rw = 0.f;
#pragma unroll
      for (int c8 = 0; c8 < 4; ++c8) {
        const float4 f0 = wq[2 * c8], f1 = wq[2 * c8 + 1];
        float wv[8] = {f0.x, f0.y, f0.z, f0.w, f1.x, f1.y, f1.z, f1.w};
        float ov[8];
#pragma unroll
        for (int e = 0; e < 8; ++e) {
          const int sx = qr * 32 + c8 * 8 + e;
          const float w = (sx <= t) ? wv[e] : 0.f;
          rw += w;
          const float wp = bf2f(f2bf(w * srs[sx]));
          c1 += wp * smu[sx];
          ov[e] = wp;
        }
        u32x4 o; o[0] = pk2(ov[0], ov[1]); o[1] = pk2(ov[2], ov[3]); o[2] = pk2(ov[4], ov[5]); o[3] = pk2(ov[6], ov[7]);
        *(u32x4*)(sW + t * 136 + qr * 32 + c8 * 8) = o;
      }
      c1 += __shfl_xor(c1, 1); rw += __shfl_xor(rw, 1);
      c1 += __shfl_xor(c1, 2); rw += __shfl_xor(rw, 2);
      if (qr == 0) { sc1[t] = c1; srw[t] = rw; }
      if (tid < 256) { slg[tid] = P.o_ln_g[g * 256 + tid]; slb[tid] = P.o_ln_b[g * 256 + tid]; }
    }
#pragma unroll
    for (int i = 0; i < 8; ++i) *(u32x4*)(sV + (srow + 16 * i) * 544 + schunk * 16) = vreg[i];
    __syncthreads();
    const int tt = wave & 3, chh = wave >> 2;
    f32x16 acc[4];
#pragma unroll
    for (int c = 0; c < 4; ++c) acc[c] = zero16();
    {
      const int i16 = lane & 15, q = i16 >> 2, p = i16 & 3, gc = (lane >> 4) & 1;
      const char* vb = sV + (8 * kb + q) * 544 + (chh * 128 + gc * 16 + 4 * p) * 2;
      const bf16_t* wb = sW + (tt * 32 + l32) * 136 + kb * 8;
      const int nks = 2 * (tt + 1);
      for (int ks = 0; ks < nks; ++ks) {
        const bf16x8 wf = *(const bf16x8*)(wb + ks * 16);
#pragma unroll
        for (int c = 0; c < 4; ++c) {
          const s16x4 lo = lds_tr(vb + ks * 16 * 544 + c * 64);
          const s16x4 hi = lds_tr(vb + (ks * 16 + 4) * 544 + c * 64);
          const bf16x8 vf = __builtin_shufflevector(lo, hi, 0, 1, 2, 3, 4, 5, 6, 7);
          acc[c] = mfma(vf, wf, acc[c]);
        }
      }
    }
    __syncthreads();
    {
      const int t = tt * 32 + l32;
      const float c1 = sc1[t], rw = srw[t], bs = P.o_b_s[g * 128 + t];
#pragma unroll
      for (int c = 0; c < 4; ++c)
#pragma unroll
        for (int gq = 0; gq < 4; ++gq) {
          const int chl = (chh * 4 + c) * 32 + 8 * gq + 4 * kb;
          const float4 lg = *(const float4*)(slg + chl), lb = *(const float4*)(slb + chl);
          const float m0 = lg.x * (acc[c][gq * 4 + 0] - c1) + lb.x * rw + bs;
          const float m1 = lg.y * (acc[c][gq * 4 + 1] - c1) + lb.y * rw + bs;
          const float m2 = lg.z * (acc[c][gq * 4 + 2] - c1) + lb.z * rw + bs;
          const float m3 = lg.w * (acc[c][gq * 4 + 3] - c1) + lb.w * rw + bs;
          u32x2 o; o[0] = pk2(m0, m1); o[1] = pk2(m2, m3);
          *(u32x2*)(sV + t * 520 + chl * 2) = o;
        }
    }
    __syncthreads();
#pragma unroll
    for (int i = 0; i < 8; ++i) {
      const char* mp = sV + (srow + 16 * i) * 520 + schunk * 16;
      const u32x2 ma = *(const u32x2*)mp, mb = *(const u32x2*)(mp + 8);
      const u32x4 uu = ureg[i];
      u32x4 o;
      o[0] = pk2(bflo(uu[0]) * bflo(ma[0]), bfhi(uu[0]) * bfhi(ma[0]));
      o[1] = pk2(bflo(uu[1]) * bflo(ma[1]), bfhi(uu[1]) * bfhi(ma[1]));
      o[2] = pk2(bflo(uu[2]) * bflo(mb[0]), bfhi(uu[2]) * bfhi(mb[0]));
      o[3] = pk2(bflo(uu[3]) * bflo(mb[1]), bfhi(uu[3]) * bfhi(mb[1]));
      *(u32x4*)(Y + (tok0 + srow + 16 * i) * 2048 + g * 256 + schunk * 8) = o;
    }
    __syncthreads();
  }
}

constexpr int NPHASE = 17;
DI void run_phase(const Params& P, int ph, char* smem) {
  char* ws = P.ws;
  bf16_t* r1 = (bf16_t*)(ws + R1); bf16_t* r2 = (bf16_t*)(ws + R2); bf16_t* r3 = (bf16_t*)(ws + R3); bf16_t* r4 = (bf16_t*)(ws + R4);
  unsigned* cnt = (unsigned*)(ws + W_CNT);
  const int lane = TIDX & 63, wave = TIDX >> 6, half = TIDX >> 8;
  char* hsmem = smem + half * 65536;
  switch (ph) {
    case 0: phase_prep(P); break;
    case 1: gemm_run<0>(r2, (const bf16_t*)(ws + W_EIN), PW, 1024, r1, PW, smem); break;
    case 2: {
      if (blockIdx.x < 64) nsa_compress_task(P, blockIdx.x * WPB + wave);
      volatile int* s_item = (volatile int*)(smem + LDS_BYTES - 16);
      for (;;) {
        __syncthreads();
        if (TIDX == 0) *s_item = (int)atomicAdd(cnt + 0, 1u);
        __syncthreads();
        const int pair = *s_item;
        if (pair >= 2048) break;
        gla_p1_item(P, pair * 2 + half, hsmem);
      }
    } break;
    case 3: gla_scan(P);
    case 30: {
      volatile int* s_item = (volatile int*)(smem + 131072);
      for (;;) {
        __syncthreads();
        if (TIDX == 0) *s_item = (int)atomicAdd(cnt + 1, 1u);
        __syncthreads();
        const int it = *s_item;
        if (it >= 512) break;
        nsa_block(P, (it & 15) >> 1, it & 1, 31 - (it >> 4), smem);
      }
    } break;
    case 4:
      for (int item = blockIdx.x * 2 + half; item < 4096; item += gridDim.x * 2) gla_p3_item(P, item, hsmem);
      break;
    case 5: gemm_run<0>(r3, (const bf16_t*)(ws + W_EOUT), 1024, 1024, r4, 1024, smem); break;
    case 6: resnorm_rows<true, false>(r4, P.x, nullptr, nullptr, r3, P.norm_g + 1 * 1024, P.norm_g + 2 * 1024, r2); break;
    case 7: gemm_run<1>(r2, (const bf16_t*)(ws + W_FFN1_0), 4096, 1024, r1, 4096, smem); break;
    case 8: gemm_run<0>(r1, (const bf16_t*)(ws + W_FFN2_0), 1024, 4096, r4, 1024, smem); break;
    case 9: resnorm_rows<false, false>(r4, nullptr, r3, nullptr, r3, P.norm_g + 3 * 1024, P.norm_g + 4 * 1024, r2); break;
    case 10: gemm_run<2>(r2, (const bf16_t*)(ws + W_OIN), 4096, 1024, r1, 4096, smem); break;
    case 11:
      for (int item = blockIdx.x; item < 512; item += gridDim.x) sgu_item(P, item, smem);
      break;
    case 12: gemm_run<0>((const bf16_t*)P.out, (const bf16_t*)(ws + W_OOUT), 1024, 2048, r4, 1024, smem); break;
    case 13: resnorm_rows<false, false>(r4, nullptr, r3, nullptr, r3, P.norm_g + 5 * 1024, P.norm_g + 6 * 1024, r2); break;
    case 14: gemm_run<1>(r2, (const bf16_t*)(ws + W_FFN1_1), 4096, 1024, r1, 4096, smem); break;
    case 15: gemm_run<0>(r1, (const bf16_t*)(ws + W_FFN2_1), 1024, 4096, r4, 1024, smem); break;
    case 16: resnorm_rows<false, true>(r4, nullptr, r3, P.out, nullptr, P.norm_g + 7 * 1024, nullptr, nullptr); break;
    default: break;
  }
}

#if !MEGA
extern __shared__ __attribute__((aligned(16))) unsigned char lds_dyn[];
__global__ void __launch_bounds__(NTHR, 2) k_phase(Params P, int ph) {
  char* smem = (char*)lds_dyn;
  run_phase(P, ph, smem);
}
#endif

#define XB_TMO      128
#define XB_XCNT(j)  (256  + 64 * (j))
#define XB_XSUB(j)  (1280 + 64 * (j))
#define XB_XGEN(j)  (2304 + 64 * (j))
#define XB_TOP      3328
#define XB_TOPGEN   3392
#define XCD_BAR_WORDS 3456
#define XB_SPIN_CAP (1u << 20)
#define LAS3 __attribute__((address_space(3)))
DI unsigned xb_ld(unsigned* p) { return __hip_atomic_load(p, __ATOMIC_RELAXED, __HIP_MEMORY_SCOPE_AGENT); }
DI unsigned xb_add(unsigned* p, unsigned v) { return __hip_atomic_fetch_add(p, v, __ATOMIC_RELAXED, __HIP_MEMORY_SCOPE_AGENT); }
DI unsigned xb_xcc_id() { return (unsigned)__builtin_amdgcn_s_getreg((3 << 11) | 20) & 0xFu; }
#define XB_SPIN(cond, bar) do { unsigned _sp = 0; while (cond) { __builtin_amdgcn_s_sleep(1); \
    if ((++_sp & 255u) == 0u) { if (xb_ld(&(bar)[XB_TMO])) break; if (_sp > XB_SPIN_CAP) { atomicAdd(&(bar)[XB_TMO], 1u); break; } } } } while (0)
struct XcdBarrier { unsigned* bar; unsigned x; volatile LAS3 unsigned* st; };
DI XcdBarrier xcd_barrier_post(unsigned* bar, volatile LAS3 unsigned* st) {
  XcdBarrier b; b.bar = bar; b.x = xb_xcc_id(); b.st = st;
  if (threadIdx.x == 0) (void)xb_add(&bar[XB_XCNT(b.x)], 1u);
  return b;
}
DI void xcd_barrier_complete(unsigned* bar, unsigned x, unsigned& nloc, unsigned& nx) {
  const unsigned G = gridDim.x * gridDim.y * gridDim.z;
  unsigned sum, cnt, mine, sp = 0u;
  for (;;) {
    sum = 0u; cnt = 0u; mine = 0u;
#pragma unroll
    for (unsigned j = 0; j < 16; ++j) { const unsigned c = xb_ld(&bar[XB_XCNT(j)]); sum += c; cnt += (c > 0u) ? 1u : 0u; mine = (j == x) ? c : mine; }
    if (sum == G) break;
    __builtin_amdgcn_s_sleep(1);
    if ((++sp & 255u) == 0u) { if (xb_ld(&bar[XB_TMO])) break; if (sp > XB_SPIN_CAP) { atomicAdd(&bar[XB_TMO], 1u); break; } }
  }
  nloc = mine > 0u ? mine : 1u; nx = cnt > 0u ? cnt : 1u;
}
DI void xcd_barrier(const XcdBarrier& b) {
  asm volatile("s_waitcnt vmcnt(0)" ::: "memory");
  __syncthreads();
  if (threadIdx.x == 0) {
    unsigned* bar = b.bar;
    __builtin_amdgcn_s_waitcnt(0);
    unsigned nloc = b.st[0], nx = b.st[1];
    if (nloc == 0u) { xcd_barrier_complete(bar, b.x, nloc, nx); b.st[0] = nloc; b.st[1] = nx; }
    const unsigned old = xb_add(&bar[XB_XSUB(b.x)], 1u);
    const unsigned gen = old / nloc;
    if (old + 1u == (gen + 1u) * nloc) {
      __builtin_amdgcn_fence(__ATOMIC_RELEASE, "agent");
      asm volatile("s_waitcnt vmcnt(0)" ::: "memory");
      const unsigned og = xb_add(&bar[XB_TOP], 1u);
      const unsigned tg = og / nx;
      if (og + 1u == (tg + 1u) * nx) xb_add(&bar[XB_TOPGEN], 1u);
      else XB_SPIN(xb_ld(&bar[XB_TOPGEN]) == tg, bar);
      __builtin_amdgcn_fence(__ATOMIC_ACQUIRE, "agent");
      xb_add(&bar[XB_XGEN(b.x)], 1u);
      asm volatile("s_waitcnt vmcnt(0)" ::: "memory");
    } else {
      XB_SPIN(xb_ld(&bar[XB_XGEN(b.x)]) == gen, bar);
      __builtin_amdgcn_fence(__ATOMIC_ACQUIRE, "agent");
      asm volatile("s_waitcnt vmcnt(0)" ::: "memory");
    }
  }
  __syncthreads();
}

#if MEGA
extern __shared__ __attribute__((aligned(16))) unsigned char lds_dyn[];
__global__ void __launch_bounds__(NTHR, 2) k_mega(Params P) {
  char* smem = (char*)lds_dyn;
  cg::grid_group grid = cg::this_grid();
  volatile LAS3 unsigned* xst = (volatile LAS3 unsigned*)(smem + 131072 + 16);
  if (threadIdx.x == 0) { xst[0] = 0u; xst[1] = 0u; }
  __syncthreads();
  const XcdBarrier xb = xcd_barrier_post((unsigned*)(P.ws + W_BAR), xst);
#define GSYNC() xcd_barrier(xb)
#define GEMM_PH(n) run_phase(P, n, smem); GSYNC(); if (PROBE == 1) { run_phase(P, n, smem); GSYNC(); }
  if (P.ws == nullptr) grid.sync();
  run_phase(P, 0, smem); GSYNC();
  if (PROBE == 3) { run_phase(P, 0, smem); GSYNC(); }
  GEMM_PH(1)
  run_phase(P, 2, smem); GSYNC();
  if (PROBE == 4) { if (blockIdx.x == 0 && TIDX == 0) ((unsigned*)(P.ws + W_CNT))[0] = 0u; GSYNC(); run_phase(P, 2, smem); GSYNC(); }
  run_phase(P, 3, smem); GSYNC();
  if (PROBE == 2) {
    if (blockIdx.x == 0 && TIDX == 0) ((unsigned*)(P.ws + W_CNT))[1] = 0u;
    GSYNC();
    run_phase(P, 30, smem); GSYNC();
  }
  run_phase(P, 4, smem); GSYNC();
  if (PROBE == 5) { run_phase(P, 4, smem); GSYNC(); }
  GEMM_PH(5)
  run_phase(P, 6, smem); GSYNC();
  if (PROBE == 6) { run_phase(P, 6, smem); GSYNC(); run_phase(P, 6, smem); GSYNC(); run_phase(P, 6, smem); GSYNC(); }
  GEMM_PH(7)
  GEMM_PH(8)
  run_phase(P, 9, smem); GSYNC();
  GEMM_PH(10)
  run_phase(P, 11, smem); GSYNC();
  if (PROBE == 7) { run_phase(P, 11, smem); GSYNC(); }
  GEMM_PH(12)
  run_phase(P, 13, smem); GSYNC();
  GEMM_PH(14)
  GEMM_PH(15)
  if (PROBE == 11) { GSYNC(); GSYNC(); GSYNC(); GSYNC(); GSYNC(); GSYNC(); GSYNC(); GSYNC(); }
  run_phase(P, 16, smem);
}
#endif

extern "C" void kernel_launch(void* const* d_in, const int* in_sizes, int n_in, void* d_out, int out_size, void* d_ws, size_t ws_size,
                              hipStream_t stream) {
  Params p{};
  p.x = (const float*)d_in[0]; p.norm_g = (const float*)d_in[1]; p.ffn_w1 = (const float*)d_in[2]; p.ffn_w2 = (const float*)d_in[3];
  p.e_w_in = (const float*)d_in[4]; p.e_w_out = (const float*)d_in[5]; p.gla_w_gate = (const float*)d_in[6]; p.gla_b_gate = (const float*)d_in[7];
  p.gla_norm = (const float*)d_in[8]; p.nsa_gate_b = (const float*)d_in[9]; p.cmp_pos = (const float*)d_in[10]; p.cmp_w1 = (const float*)d_in[11];
  p.cmp_w2 = (const float*)d_in[12]; p.o_w_in = (const float*)d_in[13]; p.o_ln_g = (const float*)d_in[14]; p.o_ln_b = (const float*)d_in[15];
  p.o_w_s = (const float*)d_in[16]; p.o_b_s = (const float*)d_in[17]; p.o_w_out = (const float*)d_in[18];
  p.out = (float*)d_out; p.ws = (char*)d_ws;
  if (ws_size < 1024ull * MiB) { fprintf(stderr, "workspace too small: %zu\n", ws_size); return; }
  static int grid_blocks = 0;
  if (!grid_blocks) {
    int dev = 0, cus = 0, per_cu = 0;
    (void)hipGetDevice(&dev);
    (void)hipDeviceGetAttribute(&cus, hipDeviceAttributeMultiprocessorCount, dev);
#if MEGA
    if (hipFuncSetAttribute((const void*)k_mega, hipFuncAttributeMaxDynamicSharedMemorySize, LDS_BYTES) != hipSuccess) fprintf(stderr, "hipFuncSetAttribute failed\n");
    (void)hipOccupancyMaxActiveBlocksPerMultiprocessor(&per_cu, (const void*)k_mega, NTHR, LDS_BYTES);
#else
    if (hipFuncSetAttribute((const void*)k_phase, hipFuncAttributeMaxDynamicSharedMemorySize, LDS_BYTES) != hipSuccess) fprintf(stderr, "hipFuncSetAttribute failed\n");
    (void)hipOccupancyMaxActiveBlocksPerMultiprocessor(&per_cu, (const void*)k_phase, NTHR, LDS_BYTES);
#endif
    if (per_cu < 1) fprintf(stderr, "occupancy query returned %d\n", per_cu);
    grid_blocks = cus;
  }
#if MEGA
  if (hipMemsetAsync((char*)d_ws + W_BAR, 0, XCD_BAR_WORDS * sizeof(unsigned), stream) != hipSuccess) fprintf(stderr, "memset of barrier words failed\n");
  void* args[] = {&p};
  hipError_t e = hipLaunchCooperativeKernel((void*)k_mega, dim3(grid_blocks), dim3(NTHR), args, LDS_BYTES, stream);
  if (e != hipSuccess) fprintf(stderr, "cooperative launch failed: %s (grid %d)\n", hipGetErrorString(e), grid_blocks);
#else
  for (int ph = 0; ph < NPHASE; ++ph) k_phase<<<grid_blocks, NTHR, LDS_BYTES, stream>>>(p, ph);
#endif
}
```
